# Optimizing an MI355X kernel written in HIP

```python
import math
import jax, jax.numpy as jnp
from jax import lax
import numpy as np

D_MODEL = 2048
BATCH = 16
SEQ = 256
DEPTH = 2
DEC_BATCH = 8
DEC_SEQ = 4096
PAST_LEN = 256

GRID_W = 64
MIX_HEAD = 128
N_MIX_HEADS = D_MODEL // MIX_HEAD
H_RET = N_MIX_HEADS // 4
DK_RET = MIX_HEAD
DV_RET = MIX_HEAD
H_GQA = N_MIX_HEADS // 2
KV_GQA = H_GQA // 4
HD_GQA = MIX_HEAD
H_DIFF = N_MIX_HEADS // 4
DK_DIFF = MIX_HEAD // 2
DV_DIFF = MIX_HEAD
D_FF = 11 * D_MODEL // 4
N_MOD = 9
Q_BLOCK = 128
RET_CHUNK = 128
ROPE_THETA = 10000.0
EPS = 1e-6
IN_SIZES = (H_RET * DK_RET, H_RET * DK_RET, H_RET * DV_RET, H_RET * DV_RET,
            H_GQA * HD_GQA, KV_GQA * HD_GQA, KV_GQA * HD_GQA,
            H_DIFF * 2 * DK_DIFF, H_DIFF * 2 * DK_DIFF, H_DIFF * DV_DIFF)
IN_COLS = sum(IN_SIZES)

kernel_name = 'hybrid_retention_gqa_diffattn_macaron_dit_step'

F32 = jnp.float32


def rmsnorm(x, w):
    xf = x.astype(F32)
    y = xf * lax.rsqrt(jnp.mean(xf * xf, axis=-1, keepdims=True) + EPS)
    return (y * w.astype(F32)).astype(x.dtype)


def head_groupnorm(x, w):
    xf = x.astype(F32)
    xc = xf - jnp.mean(xf, axis=-1, keepdims=True)
    var = jnp.mean(xc * xc, axis=-1, keepdims=True)
    return xc * lax.rsqrt(var + EPS) * w.astype(F32)


def swiglu(h, w_in, w_out):
    gate, up = jnp.split(h @ w_in, 2, axis=-1)
    return (jax.nn.silu(gate) * up) @ w_out


def modulation(cvec, w, b):
    m = jax.nn.silu(cvec) @ w + b
    return m.reshape(-1, N_MOD, 1, D_MODEL)


def axial_rope(rows, d):
    axis = d // 2
    inv = 1.0 / (ROPE_THETA ** (jnp.arange(0, axis, 2, dtype=F32) / axis))
    r = jnp.repeat(jnp.arange(rows, dtype=F32), GRID_W)
    cl = jnp.tile(jnp.arange(GRID_W, dtype=F32), rows)
    ang = jnp.concatenate([r[:, None] * inv, cl[:, None] * inv], axis=-1)
    return jnp.cos(ang), jnp.sin(ang)


def apply_rope(x, cos, sin):
    xf = x.astype(F32)
    x1, x2 = xf[..., 0::2], xf[..., 1::2]
    shape = (x.shape[1],) + (1,) * (x.ndim - 3) + (cos.shape[-1],)
    c = cos.reshape(shape)
    s = sin.reshape(shape)
    out = jnp.stack([x1 * c - x2 * s, x1 * s + x2 * c], axis=-1).reshape(x.shape)
    return out.astype(x.dtype)


def retention_scan(q, k, v, log_gamma, state0):
    B, T, H, _ = q.shape
    dv = v.shape[-1]
    n = T // RET_CHUNK
    idx = jnp.arange(RET_CHUNK, dtype=F32)
    dif = idx[:, None] - idx[None, :]
    lg = log_gamma.astype(F32)
    inner_decay = jnp.where((dif >= 0)[None], jnp.exp(jnp.maximum(dif, 0.0)[None] * lg[:, None, None]), 0.0)
    q_decay = jnp.exp((idx + 1.0)[:, None] * lg[None])
    k_decay = jnp.exp((RET_CHUNK - 1.0 - idx)[:, None] * lg[None])
    chunk_decay = jnp.exp(RET_CHUNK * lg)

    def to_chunks(a):
        return a.astype(F32).reshape(B, n, RET_CHUNK, H, a.shape[-1]).swapaxes(0, 1)

    def step(S, inp):
        qc, kc, vc = inp
        att = jnp.einsum('bihd,bjhd->bhij', qc, kc) * inner_decay
        o = (jnp.einsum('bhij,bjhe->bihe', att, vc)
             + jnp.einsum('bihd,bhde->bihe', qc, S) * q_decay[None, :, :, None])
        S = S * chunk_decay[None, :, None, None] + jnp.einsum(
            'bjhd,bjhe->bhde', kc * k_decay[None, :, :, None], vc)
        return S, o

    S, o = lax.scan(step, state0.astype(F32), (to_chunks(q), to_chunks(k), to_chunks(v)))
    return o.swapaxes(0, 1).reshape(B, T, H, dv), S


def bidir_retention(q, k, v, log_gammas, s_fwd, s_bwd):
    o_f, S_f = retention_scan(q, k, v, log_gammas[0], s_fwd)
    o_b, S_b = retention_scan(q[:, ::-1], k[:, ::-1], v[:, ::-1], log_gammas[1], s_bwd)
    return o_f + o_b[:, ::-1], jnp.stack([S_f, S_b], axis=1)


def gqa_blocks(q, k, v, scale):
    B, T = q.shape[:2]
    nb = T // Q_BLOCK
    qb = q.reshape((B, nb, Q_BLOCK) + q.shape[2:]).swapaxes(0, 1)

    def one(qi):
        s = jnp.einsum('bqkgd,bskd->bkgqs', qi, k, preferred_element_type=F32) * scale
        p = jax.nn.softmax(s, axis=-1).astype(v.dtype)
        return jnp.einsum('bkgqs,bskd->bqkgd', p, v)

    out = lax.map(one, qb)
    return out.swapaxes(0, 1).reshape((B, T) + out.shape[3:])


def diff_blocks(q, k, v, lam, scale):
    B, T = q.shape[:2]
    nb = T // Q_BLOCK
    qb = q.reshape((B, nb, Q_BLOCK) + q.shape[2:]).swapaxes(0, 1)

    def one(qi):
        s = jnp.einsum('bqhcd,bshcd->bhcqs', qi, k, preferred_element_type=F32) * scale
        p = jax.nn.softmax(s, axis=-1)
        w = (p[:, :, 0] - lam * p[:, :, 1]).astype(v.dtype)
        return jnp.einsum('bhqs,bshe->bqhe', w, v)

    out = lax.map(one, qb)
    return out.swapaxes(0, 1).reshape((B, T) + out.shape[3:])


def token_mixer(h, lp, lam_init, rope, ctx):
    B, T, _ = h.shape
    split_points = np.cumsum(IN_SIZES)[:-1].tolist()
    rq, rk, rv, rg, gq, gk, gv, dq, dk, dv = jnp.split(h @ lp['w_in'], split_points, axis=-1)

    q_r = rq.reshape(B, T, H_RET, DK_RET)
    k_r = rk.reshape(B, T, H_RET, DK_RET) * (DK_RET ** -0.5)
    v_r = rv.reshape(B, T, H_RET, DV_RET)
    log_g = jax.nn.log_sigmoid(lp['ret_decay'].astype(F32))
    if ctx is None:
        s_f = jnp.zeros((B, H_RET, DK_RET, DV_RET), F32)
        s_b = s_f
    else:
        s_f = ctx['state_ret'][:, 0]
        s_b = ctx['state_ret'][:, 1]
    o_r, s_new = bidir_retention(q_r, k_r, v_r, log_g, s_f, s_b)
    ret_out = head_groupnorm(o_r, lp['ret_gn_w']).astype(h.dtype) * jax.nn.silu(rg).reshape(B, T, H_RET, DV_RET)

    q_g = rmsnorm(gq.reshape(B, T, H_GQA, HD_GQA), lp['gqa_qk_norm'][0])
    k_g = rmsnorm(gk.reshape(B, T, KV_GQA, HD_GQA), lp['gqa_qk_norm'][1])
    v_g = gv.reshape(B, T, KV_GQA, HD_GQA)

    q_d = dq.reshape(B, T, H_DIFF, 2, DK_DIFF)
    k_d = dk.reshape(B, T, H_DIFF, 2, DK_DIFF)
    v_d = dv.reshape(B, T, H_DIFF, DV_DIFF)

    if ctx is None:
        keys_g, vals_g, keys_d, vals_d = k_g, v_g, k_d, v_d
        new = (s_new, k_g, v_g, k_d.reshape(B, T, H_DIFF, 2 * DK_DIFF), v_d)
    else:
        (cos_g, sin_g), (cos_d, sin_d) = rope
        q_g = apply_rope(q_g, cos_g, sin_g)
        keys_g = jnp.concatenate([apply_rope(k_g, cos_g, sin_g), ctx['k_gqa'].astype(h.dtype)], axis=1)
        vals_g = jnp.concatenate([v_g, ctx['v_gqa'].astype(h.dtype)], axis=1)
        q_d = apply_rope(q_d, cos_d, sin_d)
        c_kd = ctx['k_diff'].astype(h.dtype).reshape(B, -1, H_DIFF, 2, DK_DIFF)
        keys_d = jnp.concatenate([apply_rope(k_d, cos_d, sin_d), c_kd], axis=1)
        vals_d = jnp.concatenate([v_d, ctx['v_diff'].astype(h.dtype)], axis=1)
        new = None

    gqa_out = gqa_blocks(q_g.reshape(B, T, KV_GQA, H_GQA // KV_GQA, HD_GQA), keys_g, vals_g,
                         HD_GQA ** -0.5).reshape(B, T, H_GQA * HD_GQA)

    dl = lp['diff_lambda'].astype(F32)
    lam = jnp.exp(jnp.sum(dl[0] * dl[1])) - jnp.exp(jnp.sum(dl[2] * dl[3])) + lam_init
    o_d = diff_blocks(q_d, keys_d, vals_d, lam, DK_DIFF ** -0.5)
    diff_out = rmsnorm(o_d, lp['diff_norm_w']) * (1.0 - lam_init)

    mixed = jnp.concatenate([ret_out.reshape(B, T, -1), gqa_out, diff_out.reshape(B, T, -1)], axis=-1)
    return mixed @ lp['w_out'], new


def trunk_layer(x, mod, lp, lam_init, rope, ctx):
    def modulated(x, i):
        h = rmsnorm(x, lp['norm_w'][i])
        return h * (1.0 + mod[:, 3 * i + 1]) + mod[:, 3 * i]

    x = x + 0.5 * mod[:, 2] * swiglu(modulated(x, 0), lp['ffn_w_in'][0], lp['ffn_w_out'][0])
    out, new = token_mixer(modulated(x, 1), lp, lam_init, rope, ctx)
    x = x + mod[:, 5] * out
    x = x + 0.5 * mod[:, 8] * swiglu(modulated(x, 2), lp['ffn_w_in'][1], lp['ffn_w_out'][1])
    return x, new


def setup_inputs(seed: int = 0) -> dict:
    key = jax.random.key(seed)
    ks = jax.random.split(key, 24)

    def nrm(k, shape, scale):
        return jax.random.normal(k, shape, F32) * scale

    g = 1.0 - 2.0 ** (-5.0 - np.arange(H_RET))
    decay_logit = jnp.asarray(np.log(g / (1.0 - g)), dtype=F32)
    return {
        'x_prompt': nrm(ks[0], (BATCH, SEQ, D_MODEL), 1.0),
        'x_sample': nrm(ks[1], (DEC_BATCH, DEC_SEQ, D_MODEL), 1.0),
        'c': nrm(ks[2], (DEC_BATCH, D_MODEL), 1.0),
        'state_ret': nrm(ks[3], (DEC_BATCH, DEPTH, 2, H_RET, DK_RET, DV_RET), 0.5),
        'cache_gqa_k': nrm(ks[4], (DEC_BATCH, DEPTH, PAST_LEN, KV_GQA, HD_GQA), 1.0),
        'cache_gqa_v': nrm(ks[5], (DEC_BATCH, DEPTH, PAST_LEN, KV_GQA, HD_GQA), 1.0),
        'cache_diff_k': nrm(ks[6], (DEC_BATCH, DEPTH, PAST_LEN, H_DIFF, 2 * DK_DIFF), 1.0),
        'cache_diff_v': nrm(ks[7], (DEC_BATCH, DEPTH, PAST_LEN, H_DIFF, DV_DIFF), 1.0),
        'c_ctx': nrm(ks[8], (D_MODEL,), 1.0),
        'w_mod': nrm(ks[9], (DEPTH, D_MODEL, N_MOD * D_MODEL), 0.5 * D_MODEL ** -0.5),
        'b_mod': nrm(ks[10], (DEPTH, N_MOD * D_MODEL), 0.01),
        'norm_w': 1.0 + nrm(ks[11], (DEPTH, 3, D_MODEL), 0.02),
        'ffn_w_in': nrm(ks[12], (DEPTH, 2, D_MODEL, 2 * D_FF), D_MODEL ** -0.5),
        'ffn_w_out': nrm(ks[13], (DEPTH, 2, D_FF, D_MODEL), D_FF ** -0.5),
        'w_in': nrm(ks[14], (DEPTH, D_MODEL, IN_COLS), D_MODEL ** -0.5),
        'w_out': nrm(ks[15], (DEPTH, D_MODEL, D_MODEL), D_MODEL ** -0.5),
        'ret_decay': decay_logit[None, None, :] + nrm(ks[16], (DEPTH, 2, H_RET), 0.1),
        'ret_gn_w': 1.0 + nrm(ks[17], (DEPTH, H_RET, DV_RET), 0.02),
        'gqa_qk_norm': 1.0 + nrm(ks[18], (DEPTH, 2, HD_GQA), 0.02),
        'diff_lambda': nrm(ks[19], (DEPTH, 4, DK_DIFF), 0.1),
        'diff_norm_w': 1.0 + nrm(ks[20], (DEPTH, H_DIFF, DV_DIFF), 0.02),
        'final_norm_w': 1.0 + nrm(ks[21], (D_MODEL,), 0.02),
    }


def reference(x_prompt, x_sample, c, state_ret, cache_gqa_k, cache_gqa_v, cache_diff_k, cache_diff_v,
              c_ctx, w_mod, b_mod, norm_w, ffn_w_in, ffn_w_out, w_in, w_out, ret_decay, ret_gn_w,
              gqa_qk_norm, diff_lambda, diff_norm_w, final_norm_w):
    rows = x_sample.shape[1] // GRID_W
    rope = (axial_rope(rows, HD_GQA), axial_rope(rows, DK_DIFF))
    xp, xs = x_prompt, x_sample
    new_ret, new_gk, new_gv, new_dk, new_dv = [], [], [], [], []
    for l in range(DEPTH):
        lp = {'w_in': w_in[l], 'w_out': w_out[l], 'norm_w': norm_w[l],
              'ffn_w_in': ffn_w_in[l], 'ffn_w_out': ffn_w_out[l],
              'ret_decay': ret_decay[l], 'ret_gn_w': ret_gn_w[l], 'gqa_qk_norm': gqa_qk_norm[l],
              'diff_lambda': diff_lambda[l], 'diff_norm_w': diff_norm_w[l]}
        lam_init = 0.8 - 0.6 * math.exp(-0.3 * l)
        xp, new = trunk_layer(xp, modulation(c_ctx, w_mod[l], b_mod[l]), lp, lam_init, None, None)
        new_ret.append(new[0].astype(x_prompt.dtype))
        new_gk.append(new[1])
        new_gv.append(new[2])
        new_dk.append(new[3])
        new_dv.append(new[4])
        ctx_l = {'state_ret': state_ret[:, l], 'k_gqa': cache_gqa_k[:, l], 'v_gqa': cache_gqa_v[:, l],
                 'k_diff': cache_diff_k[:, l], 'v_diff': cache_diff_v[:, l]}
        xs, _ = trunk_layer(xs, modulation(c, w_mod[l], b_mod[l]), lp, lam_init, rope, ctx_l)
    y_prompt = rmsnorm(xp, final_norm_w)
    y_sample = rmsnorm(xs, final_norm_w)
    new_state_ret = jnp.stack(new_ret, axis=1)
    new_gqa_k = jnp.stack(new_gk, axis=1)
    new_gqa_v = jnp.stack(new_gv, axis=1)
    new_diff_k = jnp.stack(new_dk, axis=1)
    new_diff_v = jnp.stack(new_dv, axis=1)
    return (y_prompt, y_sample, new_state_ret, new_gqa_k, new_gqa_v, new_diff_k, new_diff_v)
```

```cpp
#include <hip/hip_runtime.h>
#include <hip/hip_bf16.h>
#include <cstdio>
#include <cstdint>
namespace pg8 {
#define PG8_LAS __attribute__((address_space(3)))
typedef unsigned short bf16_t;
typedef short bf16x8 __attribute__((ext_vector_type(8)));
typedef float f32x4 __attribute__((ext_vector_type(4)));
typedef unsigned u32x4 __attribute__((ext_vector_type(4)));
constexpr int BM = 256, BK = 64, HALF = 128, HTB = HALF * BK * 2  , STAGE_BYTES = 8 * HTB, NXCD = 8, WGM = 8;

__host__ __device__ __forceinline__ int lds_byte(int r, int c) { const int st = (r >> 4) * 2 + (c >> 5), rr = r & 15, cc = c & 31, ob = rr * 64 + cc * 2; return st * 1024 + (ob ^ (((ob >> 9) & 1) << 5)); }
__host__ __device__ __forceinline__ void stage_rc(int b, int& R, int& C) { const int st = b / 1024, sb = b % 1024, swz = sb ^ (((sb >> 9) & 1) << 5); R = (st >> 1) * 16 + swz / 64; C = (st & 1) * 32 + (swz % 64) / 2; }
__host__ __device__ __forceinline__ int perm32(int rho) { const int n = rho >> 4, i = rho & 15; return 8 * (i >> 2) + 4 * n + (i & 3); }

struct Unit { int pm, pn; };
struct Gemm { const bf16_t* A; const bf16_t* Bt; int M, N, K; };

struct StaticOrder {
    int nM, nN, nwg, G, c;
    __host__ __device__ void init(int M, int N, int G_, int c_) { nM = M / BM; nN = N / BM; nwg = nM * nN; G = G_; c = c_; }
    __host__ __device__ bool next(int i, Unit& u) const {
        const long L = (long)i * G + c; if (L >= nwg) return false;
        int wgid = (int)L; { const int q = nwg / NXCD, r = nwg % NXCD, xcd = wgid % NXCD, off = wgid / NXCD; wgid = (xcd < r ? xcd * (q + 1) : r * (q + 1) + (xcd - r) * q) + off; }
        const int nig = WGM * nN, gid = wgid / nig, fm = gid * WGM, gsz = (nM - fm) < WGM ? (nM - fm) : WGM;
        u.pm = fm + ((wgid % nig) % gsz); u.pn = (wgid % nig) / gsz; return true;
    }
    __device__ __forceinline__ void a_ready(const Unit&) const {}
    __device__ __forceinline__ void done(const Unit&) const {}
};

__device__ __forceinline__ unsigned cvt_pk_bf16(float lo, float hi) { unsigned r; asm volatile("v_cvt_pk_bf16_f32 %0, %1, %2" : "=v"(r) : "v"(lo), "v"(hi)); return r; }
typedef float f32x2 __attribute__((ext_vector_type(2)));
struct EpiStoreBf16 {
    static constexpr bool PERM = true, AFTER_DRAIN = false;
    bf16_t* O; int ldc;
    __device__ __forceinline__ void operator()(const f32x4 (&acc)[2][2][4][2], const Unit& u, int wr, int wc, int fr, int fq) const {
        const int row0 = u.pm * BM + wr * 64 + fr, col0 = u.pn * BM + wc * 32 + 8 * fq;
#pragma unroll
        for (int ai = 0; ai < 2; ++ai)
#pragma unroll
            for (int m = 0; m < 4; ++m) { bf16_t* rowp = O + (size_t)(row0 + ai * HALF + m * 16) * ldc + col0;
#pragma unroll
                for (int bj = 0; bj < 2; ++bj) { const f32x4 v0 = acc[ai][bj][m][0], v1 = acc[ai][bj][m][1];
                    u32x4 w; w.x = cvt_pk_bf16(v0[0], v0[1]); w.y = cvt_pk_bf16(v0[2], v0[3]); w.z = cvt_pk_bf16(v1[0], v1[1]); w.w = cvt_pk_bf16(v1[2], v1[3]);
                    *(u32x4*)(rowp + bj * HALF) = w; } }
    }
};
__device__ __forceinline__ float silu_f(float g) { return g * __builtin_amdgcn_rcpf(1.0f + __builtin_amdgcn_exp2f(-1.4426950408889634f * g)); }
struct EpiSwiGLU {
    static constexpr bool PERM = true, AFTER_DRAIN = false;
    bf16_t* O; int ldc;
    __device__ __forceinline__ void operator()(const f32x4 (&acc)[2][2][4][2], const Unit& u, int wr, int wc, int fr, int fq) const {
        const int row0 = u.pm * BM + wr * 64 + fr, col0 = u.pn * HALF + wc * 32 + 8 * fq;
#pragma unroll
        for (int ai = 0; ai < 2; ++ai)
#pragma unroll
            for (int m = 0; m < 4; ++m) { bf16_t* rowp = O + (size_t)(row0 + ai * HALF + m * 16) * ldc + col0;
                const f32x4 g0 = acc[ai][0][m][0], g1 = acc[ai][0][m][1], u0 = acc[ai][1][m][0], u1 = acc[ai][1][m][1];
                u32x4 w; w.x = cvt_pk_bf16(silu_f(g0[0]) * u0[0], silu_f(g0[1]) * u0[1]); w.y = cvt_pk_bf16(silu_f(g0[2]) * u0[2], silu_f(g0[3]) * u0[3]);
                w.z = cvt_pk_bf16(silu_f(g1[0]) * u1[0], silu_f(g1[1]) * u1[1]); w.w = cvt_pk_bf16(silu_f(g1[2]) * u1[2], silu_f(g1[3]) * u1[3]);
                *(u32x4*)rowp = w; }
    }
};
struct EpiResid {
    static constexpr bool PERM = false, AFTER_DRAIN = false;
    const float* baseP; const float* baseS; float* out; const float* gate; float coef;
    __device__ __forceinline__ void operator()(const f32x4 (&acc)[2][2][4][2], const Unit& u, int wr, int wc, int fr, int fq) const {
        const int cond = u.pm < 16 ? 0 : 1 + ((u.pm - 16) >> 4);
        const float* g = gate + (size_t)cond * 18432; const float* base = u.pm < 16 ? baseP : baseS;
        const int row0 = u.pm * BM + wr * 64 + fr, col0 = u.pn * BM + wc * 32 + 4 * fq;
        f32x4 gv[2][2];
#pragma unroll
        for (int bj = 0; bj < 2; ++bj)
#pragma unroll
            for (int n = 0; n < 2; ++n) gv[bj][n] = *(const f32x4*)(g + col0 + bj * HALF + n * 16) * coef;
#pragma unroll
        for (int ai = 0; ai < 2; ++ai)
#pragma unroll
            for (int m = 0; m < 4; ++m) { const size_t off = (size_t)(row0 + ai * HALF + m * 16) * 2048 + col0;
#pragma unroll
                for (int bj = 0; bj < 2; ++bj)
#pragma unroll
                    for (int n = 0; n < 2; ++n) { const f32x4 b = *(const f32x4*)(base + off + bj * HALF + n * 16);
                        *(f32x4*)(out + off + bj * HALF + n * 16) = b + gv[bj][n] * acc[ai][bj][m][n]; }
                if (m & 1) asm volatile("" ::: "memory"); }
    }
};
template <class Epi, class Sched, bool ALIGN_EPI = false, bool SP2 = false>
__device__ __forceinline__ void gemm_phase(PG8_LAS unsigned char* lds, const Gemm g, const Sched& S, const Epi& E) {
    int tid_ = threadIdx.x; asm volatile("" : "+v"(tid_));
    const int tid = tid_, wid = __builtin_amdgcn_readfirstlane(tid >> 6), lane = tid & 63, wr = wid >> 2, wc = wid & 3, fr = lane & 15, fq = lane >> 4;
    const int K = g.K, nt = K / BK;
    unsigned voffA[2], voffB[2];
#pragma unroll
    for (int i = 0; i < 2; ++i) { int R, C; stage_rc(tid * 16 + i * 8192, R, C); const int Rb = Epi::PERM ? ((R & ~31) + perm32(R & 31)) : R;
        voffA[i] = (unsigned)(R * K + C) * 2u; voffB[i] = (unsigned)(Rb * K + C) * 2u; }
    const size_t kstep = (size_t)(BK * 2);
    const size_t hstep = (size_t)HALF * K * 2;
    const size_t tstep = 2 * hstep;
    const unsigned ldsw = (unsigned)wid * 1024u;
    const int aoff = lds_byte(wr * 64 + fr, fq * 8), boff = lds_byte(wc * 32 + fr, fq * 8);
#define PG8_SA(b, h) (((b) * 2 + (h)) * HTB)
#define PG8_SB(b, h) ((4 + (b) * 2 + (h)) * HTB)
#define PG8_STAGE(bufoff, gbase, voff) do { _Pragma("unroll") for (int _i = 0; _i < 2; ++_i) \
        __builtin_amdgcn_global_load_lds((const unsigned*)((const char*)(gbase) + (voff)[_i]), (PG8_LAS unsigned*)(lds + (bufoff) + ldsw + _i * 8192), 16, 0, 0); } while (0)
#define PG8_LDA(dst, b, h) do { _Pragma("unroll") for (int m = 0; m < 4; ++m) _Pragma("unroll") for (int k = 0; k < 2; ++k) dst[m][k] = *(const PG8_LAS bf16x8*)(lds + PG8_SA(b, h) + aoff + m * 2048 + k * 1024); } while (0)
#define PG8_LDB(dst, b, h) do { _Pragma("unroll") for (int n = 0; n < 2; ++n) _Pragma("unroll") for (int k = 0; k < 2; ++k) dst[n][k] = *(const PG8_LAS bf16x8*)(lds + PG8_SB(b, h) + boff + n * 2048 + k * 1024); } while (0)
#define PG8_MMA(ai, bj, At, Bt) do { __builtin_amdgcn_s_setprio(1); _Pragma("unroll") for (int m = 0; m < 4; ++m) _Pragma("unroll") for (int n = 0; n < 2; ++n) _Pragma("unroll") for (int k = 0; k < 2; ++k) \
        acc[ai][bj][m][n] = __builtin_amdgcn_mfma_f32_16x16x32_bf16(Bt[n][k], At[m][k], acc[ai][bj][m][n], 0, 0, 0); __builtin_amdgcn_s_setprio(0); } while (0)
#define PG8_WAIT_V(n) asm volatile("s_waitcnt vmcnt(" #n ")" ::: "memory")
#define PG8_WAIT_L(n) asm volatile("s_waitcnt lgkmcnt(" #n ")" ::: "memory")
#define PG8_BAR __builtin_amdgcn_s_barrier()
#define PG8_SCHED __builtin_amdgcn_sched_barrier(0)
    Unit cur, nxt; int ui = 0;
    if (!S.next(0, cur)) return;
    f32x4 acc[2][2][4][2];
#pragma unroll
    for (int a = 0; a < 2; ++a)
#pragma unroll
        for (int b = 0; b < 2; ++b)
#pragma unroll
            for (int m = 0; m < 4; ++m)
#pragma unroll
                for (int n = 0; n < 2; ++n) acc[a][b][m][n] = (f32x4){0.f, 0.f, 0.f, 0.f};
    bf16x8 At[4][2], B0[2][2], B1[2][2];
    const char* cA = (const char*)g.A + (size_t)cur.pm * tstep; const char* cB = (const char*)g.Bt + (size_t)cur.pn * tstep;
    S.a_ready(cur);
    if constexpr (SP2) {
        PG8_STAGE(PG8_SB(0, 0), cB, voffB); PG8_STAGE(PG8_SB(0, 1), cB + hstep, voffB); PG8_STAGE(PG8_SA(0, 0), cA, voffA); PG8_STAGE(PG8_SA(0, 1), cA + hstep, voffA);
        if (wr == 1) PG8_BAR;
        PG8_WAIT_V(2); PG8_BAR;
        PG8_STAGE(PG8_SB(1, 0), cB + kstep, voffB); PG8_STAGE(PG8_SA(1, 0), cA + kstep, voffA); PG8_STAGE(PG8_SB(1, 1), cB + hstep + kstep, voffB);
        PG8_WAIT_V(6); PG8_BAR;
    } else {
        PG8_STAGE(PG8_SB(0, 0), cB, voffB); PG8_STAGE(PG8_SA(0, 0), cA, voffA); PG8_STAGE(PG8_SB(0, 1), cB + hstep, voffB); PG8_STAGE(PG8_SA(0, 1), cA + hstep, voffA);
        if (wr == 1) PG8_BAR;
        PG8_WAIT_V(4); PG8_BAR;
        PG8_STAGE(PG8_SB(1, 0), cB + kstep, voffB); PG8_STAGE(PG8_SA(1, 0), cA + kstep, voffA); PG8_STAGE(PG8_SB(1, 1), cB + hstep + kstep, voffB);
        PG8_WAIT_V(6); PG8_BAR;
    }
    for (;;) {
        const bool has_next = S.next(ui + 1, nxt);
        const char* nA = has_next ? (const char*)g.A + (size_t)nxt.pm * tstep : cA; const char* nB = has_next ? (const char*)g.Bt + (size_t)nxt.pn * tstep : cB;
        for (int t = 0; t < nt; t += 2) {
            const bool last = (t == nt - 2);
            const char* a1 = cA + (size_t)(t + 1) * kstep;
            const char* a2 = last ? nA : cA + (size_t)(t + 2) * kstep; const char* b2 = last ? nB : cB + (size_t)(t + 2) * kstep;
            const char* a3 = a2 + kstep; const char* b3 = b2 + kstep;
            if (last && has_next) S.a_ready(nxt);
            if constexpr (SP2) {
            PG8_LDB(B0, 0, 0); PG8_LDB(B1, 0, 1); PG8_SCHED; PG8_LDA(At, 0, 0); PG8_STAGE(PG8_SA(1, 1), a1 + hstep, voffA);
            PG8_WAIT_V(8); PG8_WAIT_L(0); PG8_BAR; PG8_MMA(0, 0, At, B0); PG8_MMA(0, 1, At, B1); PG8_BAR; PG8_SCHED;
            PG8_LDA(At, 0, 1); PG8_STAGE(PG8_SB(0, 0), b2, voffB); PG8_STAGE(PG8_SB(0, 1), b2 + hstep, voffB); PG8_STAGE(PG8_SA(0, 0), a2, voffA);
            PG8_WAIT_V(8); PG8_WAIT_L(0); PG8_BAR; PG8_MMA(1, 0, At, B0); PG8_MMA(1, 1, At, B1); PG8_BAR; PG8_SCHED;
            PG8_LDB(B0, 1, 0); PG8_LDB(B1, 1, 1); PG8_SCHED; PG8_LDA(At, 1, 0); PG8_STAGE(PG8_SA(0, 1), a2 + hstep, voffA);
            PG8_WAIT_V(8); PG8_WAIT_L(0); PG8_BAR; PG8_MMA(0, 0, At, B0); PG8_MMA(0, 1, At, B1); PG8_BAR; PG8_SCHED;
            PG8_LDA(At, 1, 1); PG8_STAGE(PG8_SB(1, 0), b3, voffB); PG8_STAGE(PG8_SB(1, 1), b3 + hstep, voffB); PG8_STAGE(PG8_SA(1, 0), a3, voffA);
            PG8_WAIT_V(8); PG8_WAIT_L(0); PG8_BAR; PG8_MMA(1, 0, At, B0); PG8_MMA(1, 1, At, B1); PG8_BAR; PG8_SCHED;
            } else {
            PG8_LDB(B0, 0, 0); PG8_SCHED; PG8_LDA(At, 0, 0); PG8_STAGE(PG8_SA(1, 1), a1 + hstep, voffA);
            PG8_WAIT_L(8); PG8_BAR; PG8_WAIT_L(0); PG8_MMA(0, 0, At, B0); PG8_BAR; PG8_SCHED;
            PG8_LDB(B1, 0, 1); PG8_STAGE(PG8_SB(0, 0), b2, voffB);
            PG8_BAR; PG8_WAIT_L(0); PG8_MMA(0, 1, At, B1); PG8_BAR;
            PG8_LDA(At, 0, 1); PG8_STAGE(PG8_SA(0, 0), a2, voffA);
            PG8_BAR; PG8_WAIT_L(0); PG8_MMA(1, 0, At, B0); PG8_BAR; PG8_SCHED;
            PG8_STAGE(PG8_SB(0, 1), b2 + hstep, voffB);
            PG8_WAIT_V(6); PG8_BAR; PG8_MMA(1, 1, At, B1); PG8_BAR;
            PG8_LDB(B0, 1, 0); PG8_SCHED; PG8_LDA(At, 1, 0); PG8_STAGE(PG8_SA(0, 1), a2 + hstep, voffA);
            PG8_WAIT_L(8); PG8_BAR; PG8_WAIT_L(0); PG8_MMA(0, 0, At, B0); PG8_BAR; PG8_SCHED;
            PG8_LDB(B1, 1, 1); PG8_STAGE(PG8_SB(1, 0), b3, voffB);
            PG8_BAR; PG8_WAIT_L(0); PG8_MMA(0, 1, At, B1); PG8_BAR;
            PG8_LDA(At, 1, 1); PG8_STAGE(PG8_SA(1, 0), a3, voffA);
            PG8_BAR; PG8_WAIT_L(0); PG8_MMA(1, 0, At, B0); PG8_BAR; PG8_SCHED;
            PG8_STAGE(PG8_SB(1, 1), b3 + hstep, voffB);
            PG8_WAIT_V(6); PG8_BAR; PG8_MMA(1, 1, At, B1); PG8_BAR;
            }
        }
        if constexpr (ALIGN_EPI) { if (wr == 0) PG8_BAR; }
        if constexpr (!Epi::AFTER_DRAIN) { E(acc, cur, wr, wc, fr, fq); S.done(cur); }
        if (!has_next) break;
#pragma unroll
        for (int a = 0; a < 2; ++a)
#pragma unroll
            for (int b = 0; b < 2; ++b)
#pragma unroll
                for (int m = 0; m < 4; ++m)
#pragma unroll
                    for (int n = 0; n < 2; ++n) acc[a][b][m][n] = (f32x4){0.f, 0.f, 0.f, 0.f};
        cur = nxt; cA = nA; cB = nB; ++ui;
        if constexpr (ALIGN_EPI) { if (wr == 1) PG8_BAR; }
    }
    PG8_WAIT_V(0);
    if constexpr (!ALIGN_EPI) { if (wr == 0) PG8_BAR; }
    PG8_BAR;
    if constexpr (Epi::AFTER_DRAIN) { E.fused(acc, cur, wr, wc, fr, fq, lds, wid, lane); S.done(cur); }
#undef PG8_SA
#undef PG8_SB
#undef PG8_STAGE
#undef PG8_LDA
#undef PG8_LDB
#undef PG8_MMA
#undef PG8_WAIT_V
#undef PG8_WAIT_L
#undef PG8_BAR
#undef PG8_SCHED
}
}
namespace att {
using bf16x8 = __attribute__((ext_vector_type(8))) short;
using s16x4  = __attribute__((ext_vector_type(4))) short;
using f32x16 = __attribute__((ext_vector_type(16))) float;
using u32x4  = __attribute__((ext_vector_type(4))) unsigned;
typedef unsigned short bf16_t;
constexpr int NW = 8, QBLK = 32, KVBLK = 64;
constexpr float THR = 8.f;
constexpr int SHM_V = 64 * 128 * 2, SHM_K = 64 * 128 * 2, SHM_ATTN = 2 * SHM_V + 2 * SHM_K + NW * 64 * 4;
#define KSWZ(row, colB) ((row) * 256 + ((colB) ^ (((row) & 7) << 4)))
#define KSWZ64(row, colB) ((row) * 128 + ((colB) ^ ((((row) >> 1) & 7) << 4)))
#define SBAR() __builtin_amdgcn_sched_barrier(0)
__device__ __forceinline__ int crow(int r, int hi) { return (r & 3) + 8 * (r >> 2) + 4 * hi; }
__device__ __forceinline__ unsigned cvtpk(float lo, float hi) { unsigned r; asm volatile("v_cvt_pk_bf16_f32 %0, %1, %2" : "=v"(r) : "v"(lo), "v"(hi)); return r; }
__device__ __forceinline__ float bf2f(unsigned short b) { return __uint_as_float((unsigned)b << 16); }
__device__ __forceinline__ bf16x8 ld8(const bf16_t* p) { return *reinterpret_cast<const bf16x8*>(p); }

template <int DQK> __device__ __forceinline__ void partialSM(f32x16& p0, f32x16& p1, float& m_reg, float& mn, float& alpha) {
  constexpr float SCALE = (DQK == 128) ? 0.088388347648318440f : 0.125f;
  constexpr float C = SCALE * 1.4426950408889634f;
  float pmax = p0[0];
#pragma unroll
  for (int r = 1; r < 16; ++r) pmax = fmaxf(pmax, p0[r]);
#pragma unroll
  for (int r = 0; r < 16; ++r) pmax = fmaxf(pmax, p1[r]);
  { auto rr = __builtin_amdgcn_permlane32_swap(__float_as_uint(pmax), __float_as_uint(pmax), false, false);
    pmax = fmaxf(__uint_as_float(rr[0]), __uint_as_float(rr[1])); }
  if (__builtin_expect(__all(pmax - m_reg <= THR / SCALE), 1)) { mn = m_reg; alpha = 1.f; }
  else { mn = fmaxf(m_reg, pmax); alpha = __builtin_amdgcn_exp2f((m_reg - mn) * C); m_reg = mn; }
  float mnC = -mn * C;
#pragma unroll
  for (int r = 0; r < 16; ++r) p0[r] = fmaf(p0[r], C, mnC);
#pragma unroll
  for (int r = 0; r < 16; ++r) p1[r] = fmaf(p1[r], C, mnC);
#pragma unroll
  for (int r = 0; r < 16; ++r) p0[r] = __builtin_amdgcn_exp2f(p0[r]);
}
#define PK4(P, BASE, OUT) do { unsigned a0 = cvtpk(P[BASE + 0], P[BASE + 1]), a1 = cvtpk(P[BASE + 2], P[BASE + 3]);   \
    unsigned b0 = cvtpk(P[BASE + 4], P[BASE + 5]), b1 = cvtpk(P[BASE + 6], P[BASE + 7]);                              \
    auto r0 = __builtin_amdgcn_permlane32_swap(a0, b0, false, false); auto r1 = __builtin_amdgcn_permlane32_swap(a1, b1, false, false); \
    u32x4 w = {r0[0], r1[0], r0[1], r1[1]}; OUT = *reinterpret_cast<bf16x8*>(&w); } while (0)
__device__ __forceinline__ void finishSM(f32x16& p0, f32x16& p1, float alpha, float& l_reg, bf16x8& pa0, bf16x8& pa1, bf16x8& pa2, bf16x8& pa3) {
#pragma unroll
  for (int r = 0; r < 16; ++r) p1[r] = __builtin_amdgcn_exp2f(p1[r]);
  float ps = 0;
#pragma unroll
  for (int r = 0; r < 16; ++r) ps += p0[r];
#pragma unroll
  for (int r = 0; r < 16; ++r) ps += p1[r];
  { auto rr = __builtin_amdgcn_permlane32_swap(__float_as_uint(ps), __float_as_uint(ps), false, false);
    ps = __uint_as_float(rr[0]) + __uint_as_float(rr[1]); }
  l_reg = l_reg * alpha + ps;
  PK4(p0, 0, pa0); PK4(p0, 8, pa1); PK4(p1, 0, pa2); PK4(p1, 8, pa3);
}
template <int DQK> __device__ __forceinline__ void qkt(f32x16& p0, f32x16& p1, const char* Ks, const bf16x8* qr, int r32, int hi) {
  p0 = f32x16{}; p1 = f32x16{};
#pragma unroll
  for (int d0 = 0; d0 < DQK / 16; ++d0) { const int cb = (d0 * 16 + hi * 8) * 2;
    bf16x8 b0, b1;
    if constexpr (DQK == 128) { b0 = *reinterpret_cast<const bf16x8*>(Ks + KSWZ(r32, cb)); b1 = *reinterpret_cast<const bf16x8*>(Ks + KSWZ(32 + r32, cb)); }
    else { b0 = *reinterpret_cast<const bf16x8*>(Ks + KSWZ64(r32, cb)); b1 = *reinterpret_cast<const bf16x8*>(Ks + KSWZ64(32 + r32, cb)); }
    p0 = __builtin_amdgcn_mfma_f32_32x32x16_bf16(b0, qr[d0], p0, 0, 0, 0);
    p1 = __builtin_amdgcn_mfma_f32_32x32x16_bf16(b1, qr[d0], p1, 0, 0, 0); }
}
__device__ __forceinline__ int v_st(int k, int c) { const int kk = (k & ~0xC) | ((k & 4) << 1) | ((k & 8) >> 1); return ((kk >> 3) * 4 + (c >> 5)) * 512 + ((kk & 7) * 32 + (c & 31)) * 2; }
__device__ __forceinline__ int v_rd_base(int lane) { return ((lane & 3) << 3) | (((lane >> 2) & 3) << 6) | (((lane >> 4) & 1) << 5) | (((lane >> 5) & 1) << 8); }
constexpr int v_rd_off(int d0, int ks, int half) { return d0 * 512 + ks * 4096 + half * 2048; }
template <int OFF> __device__ __forceinline__ s16x4 tr_read(int vb) {
  s16x4 r; asm volatile("ds_read_b64_tr_b16 %0, %1 offset:%2" : "=&v"(r) : "v"(vb), "i"(OFF) : "memory"); return r;
}
#define PKF(L, H) (bf16x8){L[0], L[1], L[2], L[3], H[0], H[1], H[2], H[3]}
template <int D0> __device__ __forceinline__ void pv_one(f32x16& od, int vb, bf16x8 pa0, bf16x8 pa1, bf16x8 pa2, bf16x8 pa3) {
  const s16x4 l0 = tr_read<v_rd_off(D0, 0, 0)>(vb), h0 = tr_read<v_rd_off(D0, 0, 1)>(vb), l1 = tr_read<v_rd_off(D0, 1, 0)>(vb), h1 = tr_read<v_rd_off(D0, 1, 1)>(vb);
  const s16x4 l2 = tr_read<v_rd_off(D0, 2, 0)>(vb), h2 = tr_read<v_rd_off(D0, 2, 1)>(vb), l3 = tr_read<v_rd_off(D0, 3, 0)>(vb), h3 = tr_read<v_rd_off(D0, 3, 1)>(vb);
  asm volatile("s_waitcnt lgkmcnt(0)" ::: "memory"); SBAR();
  od = __builtin_amdgcn_mfma_f32_32x32x16_bf16(pa0, PKF(l0, h0), od, 0, 0, 0);
  od = __builtin_amdgcn_mfma_f32_32x32x16_bf16(pa1, PKF(l1, h1), od, 0, 0, 0);
  od = __builtin_amdgcn_mfma_f32_32x32x16_bf16(pa2, PKF(l2, h2), od, 0, 0, 0);
  od = __builtin_amdgcn_mfma_f32_32x32x16_bf16(pa3, PKF(l3, h3), od, 0, 0, 0);
}
__device__ __forceinline__ void pv_d0(f32x16* o, int vb, bf16x8 pa0, bf16x8 pa1, bf16x8 pa2, bf16x8 pa3) {
  pv_one<0>(o[0], vb, pa0, pa1, pa2, pa3); pv_one<1>(o[1], vb, pa0, pa1, pa2, pa3); pv_one<2>(o[2], vb, pa0, pa1, pa2, pa3); pv_one<3>(o[3], vb, pa0, pa1, pa2, pa3);
}
__device__ __forceinline__ float half_sum32(float x) {
  x += __shfl_xor(x, 1); x += __shfl_xor(x, 2); x += __shfl_xor(x, 4); x += __shfl_xor(x, 8); x += __shfl_xor(x, 16); return x;
}

struct KVSrc { const bf16_t* K1; const bf16_t* V1; int n1; const bf16_t* K2; const bf16_t* V2; int n2; };
struct AttnOut { bf16_t* Ob; float* Of; const float* nw; float lam, post; int pass; };
template <int DQK, int MODE, int LD2>
__device__ __forceinline__ void attn_body(const bf16_t* __restrict__ Qb, const KVSrc kv, const AttnOut ao, char* lds) {
  constexpr long ldq = 5120, LD1 = 5120; constexpr int LDO = 2048, LDF = 512;
  int tid_ = threadIdx.x; asm volatile("" : "+v"(tid_));
  const int tid = tid_, wid = tid >> 6, lane = tid & 63, r32 = lane & 31, hi = lane >> 5;
  char* V_lds = lds; char* K_lds = lds + 2 * SHM_V;
  float* ws = (float*)(lds + 2 * SHM_V + 2 * SHM_K) + wid * 64; float* li_l = ws; float* al_l = ws + 32;
  float m_reg = -1e30f, l_reg = 0; f32x16 o[4] = {}; bf16x8 qr[DQK / 16];
  const bf16_t* Qw = Qb + (long)(wid * QBLK + r32) * ldq + hi * 8;
#pragma unroll
  for (int d0 = 0; d0 < DQK / 16; ++d0) qr[d0] = ld8(Qw + d0 * 16);
  const int sr = tid >> 4, sc = (tid & 15) * 8, vst0 = v_st(sr, sc), vst1 = v_st(32 + sr, sc);
  const int kr64 = tid >> 3, kc64 = (tid & 7) * 8;
  const int vb0 = (int)(uintptr_t)V_lds + v_rd_base(lane);
  struct { bf16x8 vs0, vs1, ks0, ks1; } sr_[2];
#define SLOAD(i, k0) do { const int k0_ = (k0); const bool s1_ = k0_ < kv.n1; const bf16_t* kp_ = s1_ ? kv.K1 + (long)k0_ * LD1 : kv.K2 + (long)(k0_ - kv.n1) * LD2; \
    const bf16_t* vp_ = s1_ ? kv.V1 + (long)k0_ * LD1 : kv.V2 + (long)(k0_ - kv.n1) * LD2; const long ld_ = s1_ ? LD1 : (long)LD2; \
    sr_[i].vs0 = ld8(vp_ + (long)sr * ld_ + sc); sr_[i].vs1 = ld8(vp_ + (long)(32 + sr) * ld_ + sc); \
    if constexpr (DQK == 128) { sr_[i].ks0 = ld8(kp_ + (long)sr * ld_ + sc); sr_[i].ks1 = ld8(kp_ + (long)(32 + sr) * ld_ + sc); } \
    else { sr_[i].ks0 = ld8(kp_ + (long)kr64 * ld_ + kc64); } } while (0)
#define SWRITE(b, i) do { *(bf16x8*)(V_lds + (b) * SHM_V + vst0) = sr_[i].vs0; *(bf16x8*)(V_lds + (b) * SHM_V + vst1) = sr_[i].vs1; \
    if constexpr (DQK == 128) { const int kc = sc * 2; *(bf16x8*)(K_lds + (b) * SHM_K + KSWZ(sr, kc)) = sr_[i].ks0; *(bf16x8*)(K_lds + (b) * SHM_K + KSWZ(32 + sr, kc)) = sr_[i].ks1; } \
    else { *(bf16x8*)(K_lds + (b) * SHM_K + KSWZ64(kr64, kc64 * 2)) = sr_[i].ks0; } } while (0)
#define SWAIT() do { if constexpr (DQK == 128) asm volatile("s_waitcnt vmcnt(4)" ::: "memory"); else asm volatile("s_waitcnt vmcnt(3)" ::: "memory"); } while (0)
#define RESC(a) do { if (__any((a) < 1.f)) { if (hi == 0) al_l[r32] = (a); asm volatile("s_waitcnt lgkmcnt(0)" ::: "memory"); \
    _Pragma("unroll") for (int d = 0; d < 4; ++d) _Pragma("unroll") for (int r = 0; r < 16; ++r) o[d][r] *= al_l[crow(r, hi)]; } } while (0)
  f32x16 pA0, pA1, pB0, pB1; float mnA, mnB, alA, alB; bf16x8 pa0, pa1, pa2, pa3; const int NT = (kv.n1 + kv.n2) / KVBLK;
  constexpr int SE = 0, SO = 1;
  SLOAD(SE, 0); asm volatile("s_waitcnt vmcnt(0)" ::: "memory"); SWRITE(0, SE); __syncthreads();
  qkt<DQK>(pA0, pA1, K_lds, qr, r32, hi); partialSM<DQK>(pA0, pA1, m_reg, mnA, alA);
  SLOAD(SO, KVBLK); if (2 < NT) SLOAD(SE, 2 * KVBLK);
  SWAIT(); SWRITE(1, SO); __syncthreads();
  for (int j = 1; j + 1 < NT; j += 2) {
    SBAR(); qkt<DQK>(pB0, pB1, K_lds + SHM_K, qr, r32, hi);
    finishSM(pA0, pA1, alA, l_reg, pa0, pa1, pa2, pa3); SBAR();
    SLOAD(SO, (j + 2) * KVBLK); SBAR();
    pv_d0(o, vb0, pa0, pa1, pa2, pa3); partialSM<DQK>(pB0, pB1, m_reg, mnB, alB);
    __syncthreads(); SWAIT(); SWRITE(0, SE);
    RESC(alB); __syncthreads();
    SBAR(); qkt<DQK>(pA0, pA1, K_lds, qr, r32, hi);
    finishSM(pB0, pB1, alB, l_reg, pa0, pa1, pa2, pa3); SBAR();
    if (j + 3 < NT) SLOAD(SE, (j + 3) * KVBLK); SBAR();
    pv_d0(o, vb0 + (int)SHM_V, pa0, pa1, pa2, pa3); partialSM<DQK>(pA0, pA1, m_reg, mnA, alA);
    __syncthreads(); SWAIT(); SWRITE(1, SO);
    RESC(alA); __syncthreads();
  }
  SBAR(); qkt<DQK>(pB0, pB1, K_lds + SHM_K, qr, r32, hi);
  finishSM(pA0, pA1, alA, l_reg, pa0, pa1, pa2, pa3); SBAR();
  pv_d0(o, vb0, pa0, pa1, pa2, pa3); partialSM<DQK>(pB0, pB1, m_reg, mnB, alB);
  __syncthreads(); RESC(alB);
  finishSM(pB0, pB1, alB, l_reg, pa0, pa1, pa2, pa3); SBAR();
  pv_d0(o, vb0 + (int)SHM_V, pa0, pa1, pa2, pa3);
  if (hi == 0) li_l[r32] = l_reg; asm volatile("s_waitcnt lgkmcnt(0)" ::: "memory");
  float rli[16];
#pragma unroll
  for (int r = 0; r < 16; ++r) rli[r] = __builtin_amdgcn_rcpf(li_l[crow(r, hi)]);
  if constexpr (MODE == 0) {
    bf16_t* Ow = ao.Ob + (long)(wid * QBLK) * LDO;
#pragma unroll
    for (int r = 0; r < 16; ++r) { const int orow = crow(r, hi);
#pragma unroll
      for (int d0 = 0; d0 < 4; ++d0) { const float v = o[d0][r] * rli[r]; Ow[(long)orow * LDO + d0 * 32 + r32] = (bf16_t)(cvtpk(v, v) & 0xffffu); } }
  } else {
    float* Fw = ao.Of + (long)(wid * QBLK) * LDF;
    if (ao.pass == 0) {
#pragma unroll
      for (int r = 0; r < 16; ++r) { const int orow = crow(r, hi);
#pragma unroll
        for (int d0 = 0; d0 < 4; ++d0) Fw[(long)orow * LDF + d0 * 32 + r32] = o[d0][r] * rli[r]; }
    } else {
      bf16_t* Ow = ao.Ob + (long)(wid * QBLK) * LDO;
#pragma unroll
      for (int r = 0; r < 16; ++r) { const int orow = crow(r, hi); float v[4]; float ss = 0.f;
#pragma unroll
        for (int d0 = 0; d0 < 4; ++d0) { v[d0] = Fw[(long)orow * LDF + d0 * 32 + r32] - ao.lam * (o[d0][r] * rli[r]); ss += v[d0] * v[d0]; }
        ss = half_sum32(ss); const float rs = rsqrtf(ss * (1.0f / 128.0f) + 1e-6f) * ao.post;
#pragma unroll
        for (int d0 = 0; d0 < 4; ++d0) { const float y = v[d0] * rs * ao.nw[d0 * 32 + r32]; Ow[(long)orow * LDO + d0 * 32 + r32] = (bf16_t)(cvtpk(y, y) & 0xffffu); } }
    }
  }
#undef SLOAD
#undef SWRITE
#undef SWAIT
#undef RESC
}
struct ChainArgs { const bf16_t* P;   int kcol, vcol; int nchunk; int dir; float lg2;
                   const float* S0;   bf16_t* ST;   float* Sfin;   };
__device__ __forceinline__ void ret_chain(const ChainArgs a, char* lds) {
  int tid_ = threadIdx.x; asm volatile("" : "+v"(tid_));
  const int tid = tid_, wid = tid >> 6, lane = tid & 63, r32 = lane & 31, hi = lane >> 5;
  const int eb = wid >> 1, dh = wid & 1;
  char* V_lds = lds; char* K_lds = lds + 2 * SHM_V;
  const int sr = tid >> 4, sc = (tid & 15) * 8;
  f32x16 acc[2];
#pragma unroll
  for (int j = 0; j < 2; ++j)
#pragma unroll
    for (int r = 0; r < 16; ++r) acc[j][r] = a.S0 ? a.S0[(size_t)(32 * (2 * dh + j) + r32) * 128 + 32 * eb + crow(r, hi)] : 0.f;
  const float gC = __builtin_amdgcn_exp2f(128.f * a.lg2);
  const int vbA = (int)(uintptr_t)V_lds + v_rd_base(lane) + eb * 512, vbB = (int)(uintptr_t)K_lds + v_rd_base(lane) + (2 * dh) * 512;
  for (int s = 0; s < a.nchunk; ++s) {
    const int c = a.dir == 0 ? s : a.nchunk - 1 - s;
    bf16_t* st = a.ST + (size_t)c * 16384;
#pragma unroll
    for (int j = 0; j < 2; ++j)
#pragma unroll
      for (int r = 0; r < 16; ++r) { const float v = acc[j][r]; st[(32 * eb + crow(r, hi)) * 128 + 32 * (2 * dh + j) + r32] = (bf16_t)(cvtpk(v, v) & 0xffffu); }
    const bf16_t* rowp = a.P + (size_t)(c * 128) * 5120;
    __syncthreads();
#pragma unroll
    for (int q = 0; q < 4; ++q) { const int k = 32 * q + sr;
      const bf16x8 kv_ = ld8(rowp + (size_t)k * 5120 + a.kcol + sc), vv_ = ld8(rowp + (size_t)k * 5120 + a.vcol + sc);
      const float f = 0.088388347648318440f * __builtin_amdgcn_exp2f((a.dir == 0 ? (float)(127 - k) : (float)k) * a.lg2);
      u32x4 w; w.x = cvtpk(bf2f((unsigned short)kv_[0]) * f, bf2f((unsigned short)kv_[1]) * f); w.y = cvtpk(bf2f((unsigned short)kv_[2]) * f, bf2f((unsigned short)kv_[3]) * f);
      w.z = cvtpk(bf2f((unsigned short)kv_[4]) * f, bf2f((unsigned short)kv_[5]) * f); w.w = cvtpk(bf2f((unsigned short)kv_[6]) * f, bf2f((unsigned short)kv_[7]) * f);
      const int off = (q >> 1) * SHM_V + v_st(32 * (q & 1) + sr, sc);
      *(u32x4*)(K_lds + off) = w; *(bf16x8*)(V_lds + off) = vv_; }
    __syncthreads();
#pragma unroll
    for (int j = 0; j < 2; ++j)
#pragma unroll
      for (int r = 0; r < 16; ++r) acc[j][r] *= gC;
#pragma unroll
    for (int tt = 0; tt < 2; ++tt) {
      s16x4 al[4], ah[4], b0l[4], b0h[4], b1l[4], b1h[4];
#define RD4(ks) do { al[ks] = tr_read<v_rd_off(0, ks, 0)>(vbA + tt * SHM_V); ah[ks] = tr_read<v_rd_off(0, ks, 1)>(vbA + tt * SHM_V); \
      b0l[ks] = tr_read<v_rd_off(0, ks, 0)>(vbB + tt * SHM_V); b0h[ks] = tr_read<v_rd_off(0, ks, 1)>(vbB + tt * SHM_V); \
      b1l[ks] = tr_read<v_rd_off(1, ks, 0)>(vbB + tt * SHM_V); b1h[ks] = tr_read<v_rd_off(1, ks, 1)>(vbB + tt * SHM_V); } while (0)
      RD4(0); RD4(1); RD4(2); RD4(3);
#undef RD4
      asm volatile("s_waitcnt lgkmcnt(0)" ::: "memory"); SBAR();
#pragma unroll
      for (int ks = 0; ks < 4; ++ks) {
        acc[0] = __builtin_amdgcn_mfma_f32_32x32x16_bf16(PKF(al[ks], ah[ks]), PKF(b0l[ks], b0h[ks]), acc[0], 0, 0, 0);
        acc[1] = __builtin_amdgcn_mfma_f32_32x32x16_bf16(PKF(al[ks], ah[ks]), PKF(b1l[ks], b1h[ks]), acc[1], 0, 0, 0); }
    }
  }
  if (a.Sfin) {
#pragma unroll
    for (int j = 0; j < 2; ++j)
#pragma unroll
      for (int r = 0; r < 16; ++r) a.Sfin[(size_t)(32 * (2 * dh + j) + r32) * 128 + 32 * eb + crow(r, hi)] = acc[j][r];
  }
}
struct RetCArgs { const bf16_t* P;   int qcol, kcol, vcol, gcol; float lg2f, lg2b; const bf16_t* STf; const bf16_t* STb;
                  const float* gnw; bf16_t* O;   };
__device__ __forceinline__ void ret_c(const RetCArgs a, char* lds) {
  int tid_ = threadIdx.x; asm volatile("" : "+v"(tid_));
  const int tid = tid_, wid = tid >> 6, lane = tid & 63, r32 = lane & 31, hi = lane >> 5;
  char* V_lds = lds; char* K_lds = lds + 2 * SHM_V;
  const int cw = wid >> 2, ipos = 32 * (wid & 3) + r32;
  const int sr = tid >> 4, sc = (tid & 15) * 8;
  const int vb0 = (int)(uintptr_t)V_lds + v_rd_base(lane);
  bf16x8 qr[8];
  const bf16_t* Qw = a.P + (size_t)(wid * 32 + r32) * 5120 + a.qcol + hi * 8;
#pragma unroll
  for (int d0 = 0; d0 < 8; ++d0) qr[d0] = ld8(Qw + d0 * 16);
  f32x16 o[4] = {};
  for (int ch = 0; ch < 2; ++ch) {
    const bf16_t* rowp = a.P + (size_t)(ch * 128) * 5120;
    __syncthreads();
#pragma unroll
    for (int q = 0; q < 4; ++q) { const int k = 32 * q + sr;
      const bf16x8 kv_ = ld8(rowp + (size_t)k * 5120 + a.kcol + sc), vv_ = ld8(rowp + (size_t)k * 5120 + a.vcol + sc);
      *(bf16x8*)(K_lds + (q >> 1) * SHM_K + KSWZ(32 * (q & 1) + sr, sc * 2)) = kv_;
      *(bf16x8*)(V_lds + (q >> 1) * SHM_V + v_st(32 * (q & 1) + sr, sc)) = vv_; }
    __syncthreads();
    if (cw == ch) {
#pragma unroll
      for (int tt = 0; tt < 2; ++tt) {
        f32x16 p0, p1; qkt<128>(p0, p1, K_lds + tt * SHM_K, qr, r32, hi);
        int ip_ = ipos, hi_ = hi; asm volatile("" : "+v"(ip_), "+v"(hi_));
#pragma unroll
        for (int r = 0; r < 16; ++r) {
          const int j0 = 64 * tt + crow(r, hi_), d0_ = ip_ - j0, d1_ = d0_ - 32;
          const float f0 = d0_ > 0 ? __builtin_amdgcn_exp2f((float)d0_ * a.lg2f) : (d0_ < 0 ? __builtin_amdgcn_exp2f((float)(-d0_) * a.lg2b) : 2.0f);
          const float f1 = d1_ > 0 ? __builtin_amdgcn_exp2f((float)d1_ * a.lg2f) : (d1_ < 0 ? __builtin_amdgcn_exp2f((float)(-d1_) * a.lg2b) : 2.0f);
          p0[r] *= f0 * 0.088388347648318440f; p1[r] *= f1 * 0.088388347648318440f; }
        bf16x8 pa0, pa1, pa2, pa3; PK4(p0, 0, pa0); PK4(p0, 8, pa1); PK4(p1, 0, pa2); PK4(p1, 8, pa3);
        pv_d0(o, vb0 + tt * SHM_V, pa0, pa1, pa2, pa3);
      }
    }
  }
#pragma unroll
  for (int dir = 0; dir < 2; ++dir) {
    const float rs = dir == 0 ? __builtin_amdgcn_exp2f((float)(ipos + 1) * a.lg2f) : __builtin_amdgcn_exp2f((float)(128 - ipos) * a.lg2b);
    const bf16_t* S = (dir == 0 ? a.STf : a.STb) + (size_t)cw * 16384 + (size_t)r32 * 128 + hi * 8;
#pragma unroll
    for (int d0 = 0; d0 < 8; ++d0) {
      const bf16x8 q_ = qr[d0]; u32x4 w;
      w.x = cvtpk(bf2f((unsigned short)q_[0]) * rs, bf2f((unsigned short)q_[1]) * rs); w.y = cvtpk(bf2f((unsigned short)q_[2]) * rs, bf2f((unsigned short)q_[3]) * rs);
      w.z = cvtpk(bf2f((unsigned short)q_[4]) * rs, bf2f((unsigned short)q_[5]) * rs); w.w = cvtpk(bf2f((unsigned short)q_[6]) * rs, bf2f((unsigned short)q_[7]) * rs);
      const bf16x8 qs = *reinterpret_cast<bf16x8*>(&w);
#pragma unroll
      for (int eb = 0; eb < 4; ++eb) { const bf16x8 b = ld8(S + (size_t)eb * 32 * 128 + d0 * 16); o[eb] = __builtin_amdgcn_mfma_f32_32x32x16_bf16(qs, b, o[eb], 0, 0, 0); }
    }
  }
#pragma unroll
  for (int r = 0; r < 16; ++r) {
    const int row = wid * 32 + crow(r, hi);
    float s = (o[0][r] + o[1][r]) + (o[2][r] + o[3][r]); s = half_sum32(s); const float mean = s * (1.0f / 128.0f);
    float q = 0.f;
#pragma unroll
    for (int eb = 0; eb < 4; ++eb) { const float d = o[eb][r] - mean; q += d * d; }
    q = half_sum32(q); const float rstd = rsqrtf(q * (1.0f / 128.0f) + 1e-6f);
#pragma unroll
    for (int eb = 0; eb < 4; ++eb) { const int col = eb * 32 + r32;
      const float g = bf2f(a.P[(size_t)row * 5120 + a.gcol + col]);
      const float y = (o[eb][r] - mean) * rstd * a.gnw[col] * (g * __builtin_amdgcn_rcpf(1.0f + __builtin_amdgcn_exp2f(-1.4426950408889634f * g)));
      a.O[(size_t)row * 2048 + col] = (bf16_t)(cvtpk(y, y) & 0xffffu); }
  }
}
#undef KSWZ
#undef KSWZ64
#undef SBAR
#undef PK4
#undef PKF
}
constexpr int DM = 2048, M_P = 4096, M_S = 32768, MTOK = M_P + M_S, DFF = 5632, NFF = 11264, NIN = 5120, NMODC = 18432, NCOND = 9;
constexpr int C_RQ = 0, C_RK = 512, C_RV = 1024, C_RG = 1536, C_GQ = 2048, C_GK = 3072, C_GV = 3328, C_DQ = 3584, C_DK = 4096, C_DV = 4608;
constexpr float EPS = 1e-6f;
constexpr size_t MiB = 1u << 20;
constexpr size_t WS_CTL = 0, CTL_ZERO_BYTES = 1 * MiB;
constexpr size_t WS_TAB = 1 * MiB;
constexpr size_t WS_CACHE = 4 * MiB;
constexpr size_t WS_W = 16 * MiB;
constexpr size_t W_LAYER = 160 * MiB, W_WI = 0, W_WO = 88 * MiB, W_WIN = 132 * MiB, W_WOUT = 152 * MiB;
constexpr size_t WS_XN = WS_W + 2 * W_LAYER;
constexpr size_t WS_ACT = WS_XN + 144 * MiB;
constexpr size_t WS_ST = WS_ACT + 396 * MiB;
constexpr size_t WS_DF = WS_ST + 72 * MiB;
constexpr size_t WS_END = WS_DF + 72 * MiB;
constexpr int TB_MOD = 0, TB_COSG = 2 * 9 * 18432, TB_SING = TB_COSG + 64 * 32, TB_COSD = TB_SING + 64 * 32, TB_SIND = TB_COSD + 64 * 16, TB_SCAL = TB_SIND + 64 * 16;
constexpr int CW_BAR = 4096;
constexpr size_t O_X = 0, O_STATE = 75497472, O_GK = 79691776, O_GV = 81788928, O_DK = 83886080, O_DV = 88080384, O_END = 92274688;
constexpr int LDS_BYTES = 147456, MISC_OFF = 131072 + 320;

typedef att::bf16_t bf16;
#define GAS __attribute__((address_space(1)))
#define LAS __attribute__((address_space(3)))
typedef unsigned v4u __attribute__((ext_vector_type(4)));
typedef float f32x4 __attribute__((ext_vector_type(4)));
typedef short bf16x8 __attribute__((ext_vector_type(8)));
typedef GAS unsigned gu32;
typedef GAS unsigned long long gu64;
#define RLX_AGENT __ATOMIC_RELAXED, __HIP_MEMORY_SCOPE_AGENT
#define LDS_WAIT() asm volatile("s_waitcnt lgkmcnt(0)" ::: "memory")
#define VM_WAIT() asm volatile("s_waitcnt vmcnt(0)" ::: "memory")
__device__ __forceinline__ unsigned long long rt() { return __builtin_amdgcn_s_memrealtime(); }
__device__ __forceinline__ unsigned f2bf(float f) { unsigned u = __builtin_bit_cast(unsigned, f); return (u + 0x7fffu + ((u >> 16) & 1u)) >> 16; }
__device__ __forceinline__ unsigned pk2(float lo, float hi) { return f2bf(lo) | (f2bf(hi) << 16); }
#define XB_TMO      128
#define XB_XCNT(j)  (256  + 64 * (j))
#define XB_XSUB(j)  (1280 + 64 * (j))
#define XB_XGEN(j)  (2304 + 64 * (j))
#define XB_TOP      3328
#define XB_TOPGEN   3392
#define XCD_BAR_WORDS 3456
#define XB_SPIN_CAP (1u << 18)

__device__ __forceinline__ unsigned xb_ld(unsigned* p)              { return __hip_atomic_load(p, __ATOMIC_RELAXED, __HIP_MEMORY_SCOPE_AGENT); }
__device__ __forceinline__ unsigned xb_add(unsigned* p, unsigned v) { return __hip_atomic_fetch_add(p, v, __ATOMIC_RELAXED, __HIP_MEMORY_SCOPE_AGENT); }
__device__ __forceinline__ unsigned xb_xcc_id() { return (unsigned)__builtin_amdgcn_s_getreg((3 << 11) | 20) & 0xFu; }
#define XB_SPIN(cond, bar) do { unsigned _sp = 0; while (cond) { __builtin_amdgcn_s_sleep(1); \
    if ((++_sp & 255u) == 0u) { if (xb_ld(&(bar)[XB_TMO])) break; if (_sp > XB_SPIN_CAP) { atomicAdd(&(bar)[XB_TMO], 1u); break; } } } } while (0)

struct XcdBarrier {
    unsigned* bar; unsigned x;
    volatile LAS unsigned* st;
};

__device__ __forceinline__ XcdBarrier xcd_barrier_post(unsigned* bar, volatile LAS unsigned* st) {
    XcdBarrier b; b.bar = bar; b.x = xb_xcc_id(); b.st = st;
    if (threadIdx.x == 0) (void)xb_add(&bar[XB_XCNT(b.x)], 1u);
    return b;
}
__device__ __forceinline__ void xcd_barrier_complete(unsigned* bar, unsigned x, unsigned& nloc, unsigned& nx) {
    const unsigned G = gridDim.x * gridDim.y * gridDim.z;
    unsigned sum, cnt, mine, sp = 0u;
    for (;;) {
        sum = 0u; cnt = 0u; mine = 0u;
#pragma unroll
        for (unsigned j = 0; j < 16; ++j) { const unsigned c = xb_ld(&bar[XB_XCNT(j)]); sum += c; cnt += (c > 0u) ? 1u : 0u; mine = (j == x) ? c : mine; }
        if (sum == G) break;
        __builtin_amdgcn_s_sleep(1);
        if ((++sp & 255u) == 0u) { if (xb_ld(&bar[XB_TMO])) break; if (sp > XB_SPIN_CAP) { atomicAdd(&bar[XB_TMO], 1u); break; } }
    }
    nloc = mine > 0u ? mine : 1u; nx = cnt > 0u ? cnt : 1u;
}

__device__ __forceinline__ void xcd_barrier(const XcdBarrier& b) {
    asm volatile("s_waitcnt vmcnt(0)" ::: "memory");
    __syncthreads();
    if (threadIdx.x == 0) {
        unsigned* bar = b.bar;
        __builtin_amdgcn_s_waitcnt(0);
        unsigned nloc = b.st[0], nx = b.st[1];
        if (nloc == 0u) { xcd_barrier_complete(bar, b.x, nloc, nx); b.st[0] = nloc; b.st[1] = nx; }
        const unsigned old = xb_add(&bar[XB_XSUB(b.x)], 1u);
        const unsigned gen = old / nloc;
        if (old + 1u == (gen + 1u) * nloc) {
            __builtin_amdgcn_fence(__ATOMIC_RELEASE, "agent");
            asm volatile("s_waitcnt vmcnt(0)" ::: "memory");
            const unsigned og = xb_add(&bar[XB_TOP], 1u);
            const unsigned tg = og / nx;
            if (og + 1u == (tg + 1u) * nx) xb_add(&bar[XB_TOPGEN], 1u);
            else XB_SPIN(xb_ld(&bar[XB_TOPGEN]) == tg, bar);
            __builtin_amdgcn_fence(__ATOMIC_ACQUIRE, "agent");
            xb_add(&bar[XB_XGEN(b.x)], 1u);
            asm volatile("s_waitcnt vmcnt(0)" ::: "memory");
        } else {
            XB_SPIN(xb_ld(&bar[XB_XGEN(b.x)]) == gen, bar);
            __builtin_amdgcn_fence(__ATOMIC_ACQUIRE, "agent");
            asm volatile("s_waitcnt vmcnt(0)" ::: "memory");
        }
    }
    __syncthreads();
}
__device__ __forceinline__ float wave_sum(float v) {
#pragma unroll
    for (int o = 1; o < 64; o <<= 1) v += __shfl_xor(v, o);
    return v;
}
__device__ __forceinline__ unsigned pkbf(float lo, float hi) { return pg8::cvt_pk_bf16(lo, hi); }
__device__ __forceinline__ float bf2f(unsigned short b) { return __uint_as_float((unsigned)b << 16); }
__device__ __forceinline__ void transpose_item(const float* W, int ldn, bf16* WT, int K, int k0, int srccol0, int dstrow0, LAS float* scr, int lane) {
#pragma unroll 8
    for (int i = 0; i < 32; ++i) { const int kk = 2 * i + (lane >> 5); scr[kk * 33 + (lane & 31)] = W[(size_t)(k0 + kk) * ldn + srccol0 + (lane & 31)]; }
    LDS_WAIT(); asm volatile("" ::: "memory");
    const int c = lane & 7;
#pragma unroll
    for (int j = 0; j < 4; ++j) { const int n = (lane >> 3) + 8 * j; const LAS float* s = scr + (8 * c) * 33 + n;
        v4u o; o.x = pkbf(s[0 * 33], s[1 * 33]); o.y = pkbf(s[2 * 33], s[3 * 33]); o.z = pkbf(s[4 * 33], s[5 * 33]); o.w = pkbf(s[6 * 33], s[7 * 33]);
        *(GAS v4u*)(WT + (size_t)(dstrow0 + n) * K + k0 + 8 * c) = o; }
    LDS_WAIT(); asm volatile("" ::: "memory");
}
__device__ __forceinline__ void prologue(const float* const* inp, unsigned char* ws, LAS unsigned char* lds, int G, int wg, int tid) {
    const int lane = tid & 63, wave = __builtin_amdgcn_readfirstlane(tid >> 6);
    float* tab = (float*)(ws + WS_TAB);
    {
        LAS float* sc = (LAS float*)lds;
        LAS float* red = sc + NCOND * DM;
        bool have = false;
        for (int it = wg; it < 288; it += G) {
            if (!have) { for (int i = tid; i < NCOND * DM; i += 512) { const int cd = i >> 11, k = i & 2047; const float v = cd == 0 ? inp[8][k] : inp[2][(cd - 1) * DM + k];
                              sc[i] = v / (1.0f + __expf(-v)); } have = true; __syncthreads(); }
            const int l = it / 144, cb = it % 144, col = tid & 127, g = tid >> 7;
            const float* W = inp[9] + (size_t)l * DM * NMODC + 128 * cb + col;
            float acc[NCOND];
#pragma unroll
            for (int c = 0; c < NCOND; ++c) acc[c] = 0.f;
            for (int k = 512 * g; k < 512 * g + 512; k += 8) {
                float w[8];
#pragma unroll
                for (int u = 0; u < 8; ++u) w[u] = W[(size_t)(k + u) * NMODC];
#pragma unroll
                for (int c = 0; c < NCOND; ++c) { const f32x4 s0 = *(const LAS f32x4*)(sc + c * DM + k), s1 = *(const LAS f32x4*)(sc + c * DM + k + 4);
                    acc[c] += (s0[0] * w[0] + s0[1] * w[1]) + (s0[2] * w[2] + s0[3] * w[3]) + (s1[0] * w[4] + s1[1] * w[5]) + (s1[2] * w[6] + s1[3] * w[7]); }
            }
#pragma unroll
            for (int c = 0; c < NCOND; ++c) red[(g * NCOND + c) * 128 + col] = acc[c];
            __syncthreads();
            for (int i = tid; i < NCOND * 128; i += 512) { const int c = i >> 7, cc = i & 127;
                const float s = ((red[(0 * NCOND + c) * 128 + cc] + red[(1 * NCOND + c) * 128 + cc]) + red[(2 * NCOND + c) * 128 + cc]) + red[(3 * NCOND + c) * 128 + cc];
                tab[TB_MOD + ((size_t)l * NCOND + c) * NMODC + 128 * cb + cc] = s + inp[10][(size_t)l * NMODC + 128 * cb + cc]; }
            __syncthreads();
        }
        __syncthreads();
    }
    if (wg == 0) {
        for (int i = tid; i < 64 * 32; i += 512) { const int pos = i >> 5, f = i & 31; const double inv = pow(10000.0, -(double)(2 * f) / 64.0), a = (double)pos * inv;
            tab[TB_COSG + i] = (float)cos(a); tab[TB_SING + i] = (float)sin(a); }
        for (int i = tid; i < 64 * 16; i += 512) { const int pos = i >> 4, f = i & 15; const double inv = pow(10000.0, -(double)(2 * f) / 32.0), a = (double)pos * inv;
            tab[TB_COSD + i] = (float)cos(a); tab[TB_SIND + i] = (float)sin(a); }
        if (tid < 2) { const int l = tid; const float* dl = inp[19] + l * 256; double s01 = 0.0, s23 = 0.0;
            for (int i = 0; i < 64; ++i) { s01 += (double)dl[i] * (double)dl[64 + i]; s23 += (double)dl[128 + i] * (double)dl[192 + i]; }
            const double li = 0.8 - 0.6 * exp(-0.3 * (double)l);
            tab[TB_SCAL + 16 * l + 0] = (float)(exp(s01) - exp(s23) + li); tab[TB_SCAL + 16 * l + 1] = (float)(1.0 - li); }
        if (tid >= 64 && tid < 80) { const int i = tid - 64, l = i >> 3, j = i & 7; const double x = (double)inp[16][l * 8 + j];
            tab[TB_SCAL + 16 * l + 2 + j] = (float)(-log1p(exp(-x)) * 1.4426950408889634); }
    }
    {
        bf16* cb = (bf16*)(ws + WS_CACHE);
        const long gt = (long)wg * 512 + tid, GT = (long)G * 512;
        for (int t = 0; t < 4; ++t) { const float* src = inp[4 + t]; const long n8 = (t < 2 ? 1048576 : 2097152) / 8; bf16* dst = cb + (t == 0 ? 0 : t == 1 ? 1048576 : t == 2 ? 2097152 : 4194304);
            for (long i = gt; i < n8; i += GT) { const f32x4 a = *(const f32x4*)(src + i * 8), b = *(const f32x4*)(src + i * 8 + 4);
                v4u o; o.x = pkbf(a[0], a[1]); o.y = pkbf(a[2], a[3]); o.z = pkbf(b[0], b[1]); o.w = pkbf(b[2], b[3]); *(v4u*)(dst + i * 8) = o; } }
    }
    {
        LAS float* scr = (LAS float*)(lds + wave * 16384);
        const int gw = wg * 8 + wave, NGW = G * 8;
        for (int it = gw; it < 81920; it += NGW) {
            const int l = it / 40960; int r = it % 40960;
            bf16* WL = (bf16*)(ws + WS_W + (size_t)l * W_LAYER);
            if (r < 22528) { const int f = r / 11264, q = r % 11264, kb = q / 352, nb = q % 352, s0 = 32 * nb;
                const int drow = s0 < DFF ? (s0 / 128) * 256 + (s0 % 128) : ((s0 - DFF) / 128) * 256 + 128 + ((s0 - DFF) % 128);
                transpose_item(inp[12] + (size_t)(l * 2 + f) * DM * NFF, NFF, WL + (W_WI + (size_t)f * 44 * MiB) / 2, DM, 64 * kb, s0, drow, scr, lane); continue; }
            r -= 22528;
            if (r < 11264) { const int f = r / 5632, q = r % 5632, kb = q / 64, nb = q % 64;
                transpose_item(inp[13] + (size_t)(l * 2 + f) * DFF * DM, DM, WL + (W_WO + (size_t)f * 22 * MiB) / 2, DFF, 64 * kb, 32 * nb, 32 * nb, scr, lane); continue; }
            r -= 11264;
            if (r < 5120) { const int kb = r / 160, nb = r % 160;
                transpose_item(inp[14] + (size_t)l * DM * NIN, NIN, WL + W_WIN / 2, DM, 64 * kb, 32 * nb, 32 * nb, scr, lane); continue; }
            r -= 5120;
            { const int kb = r / 64, nb = r % 64;
                transpose_item(inp[15] + (size_t)l * DM * DM, DM, WL + W_WOUT / 2, DM, 64 * kb, 32 * nb, 32 * nb, scr, lane); }
        }
    }
}
__device__ __forceinline__ void norm_phase(const float* xP, const float* xS, const float* nw, const float* mod  , int jshift, bf16* XN, int G, int wg, int tid) {
    const int lane = tid & 63, wave = tid >> 6, gw = wg * 8 + wave, NGW = G * 8;
    for (int m = gw; m < MTOK; m += NGW) {
        const float* xr = (m < M_P ? xP : xS) + (size_t)m * DM;
        const int cond = m < M_P ? 0 : 1 + ((m - M_P) >> 12);
        const float* sh = mod + (size_t)cond * NMODC + jshift * DM; const float* scl = sh + DM;
        f32x4 v[8]; float ss = 0.f;
#pragma unroll
        for (int j = 0; j < 8; ++j) { v[j] = *(const f32x4*)(xr + 256 * j + 4 * lane); ss += (v[j][0] * v[j][0] + v[j][1] * v[j][1]) + (v[j][2] * v[j][2] + v[j][3] * v[j][3]); }
        const float rstd = rsqrtf(wave_sum(ss) * (1.0f / DM) + EPS);
        bf16* orow = XN + (size_t)m * DM;
#pragma unroll
        for (int j = 0; j < 8; ++j) { const int c = 256 * j + 4 * lane; const f32x4 w = *(const f32x4*)(nw + c), s1 = *(const f32x4*)(scl + c), s0 = *(const f32x4*)(sh + c);
            const f32x4 h = (v[j] * rstd) * w * (s1 + 1.0f) + s0;
            uint2 o; o.x = pkbf(h[0], h[1]); o.y = pkbf(h[2], h[3]); *(uint2*)(orow + c) = o; }
    }
}
__device__ __forceinline__ void final_norm(float* x, const float* fw, int G, int wg, int tid) {
    const int lane = tid & 63, wave = tid >> 6, gw = wg * 8 + wave, NGW = G * 8;
    for (int m = gw; m < MTOK; m += NGW) {
        float* xr = x + (size_t)m * DM; f32x4 v[8]; float ss = 0.f;
#pragma unroll
        for (int j = 0; j < 8; ++j) { v[j] = *(const f32x4*)(xr + 256 * j + 4 * lane); ss += (v[j][0] * v[j][0] + v[j][1] * v[j][1]) + (v[j][2] * v[j][2] + v[j][3] * v[j][3]); }
        const float rstd = rsqrtf(wave_sum(ss) * (1.0f / DM) + EPS);
#pragma unroll
        for (int j = 0; j < 8; ++j) { const int c = 256 * j + 4 * lane; *(f32x4*)(xr + c) = (v[j] * rstd) * *(const f32x4*)(fw + c); }
    }
}
__device__ __forceinline__ void prep_row(int m, int l, bf16* PROJ, const float* tab, const float* qkw  , float* out, int lane) {
    bf16* pr = PROJ + (size_t)m * NIN;
    const bool lat = m >= M_P; const int t = lat ? ((m - M_P) & 4095) : (m & 255), b = lat ? ((m - M_P) >> 12) : (m >> 8);
    const int rr = t >> 6, cc = t & 63;
    float cs = 1.f, sn = 0.f;
    if (lat) { const int idx = lane < 32 ? rr * 32 + lane : cc * 32 + (lane - 32); cs = tab[TB_COSG + idx]; sn = tab[TB_SING + idx]; }
    for (int v = 0; v < 10; ++v) {
        const int col = (v < 8 ? C_GQ + 128 * v : C_GK + 128 * (v - 8)) + 2 * lane;
        const unsigned raw = *(const unsigned*)(pr + col); const float x1 = bf2f((unsigned short)(raw & 0xffffu)), x2 = bf2f((unsigned short)(raw >> 16));
        const float rs = rsqrtf(wave_sum(x1 * x1 + x2 * x2) * (1.0f / 128.0f) + EPS); const float* w = qkw + (v < 8 ? 0 : 128);
        const float y1 = x1 * rs * w[2 * lane], y2 = x2 * rs * w[2 * lane + 1];
        if (!lat && v >= 8) { float* o = out + O_GK + (((size_t)(b * 2 + l) * 256 + t) * 2 + (v - 8)) * 128 + 2 * lane; o[0] = y1; o[1] = y2; }
        *(unsigned*)(pr + col) = pkbf(y1 * cs - y2 * sn, y1 * sn + y2 * cs);
    }
    if (lat) {
        const int p = lane & 31, idx = p < 16 ? rr * 16 + p : cc * 16 + (p - 16); const float c2 = tab[TB_COSD + idx], s2 = tab[TB_SIND + idx];
        for (int v = 0; v < 8; ++v) { const int col = (v < 4 ? C_DQ + 128 * v : C_DK + 128 * (v - 4)) + 2 * lane;
            const unsigned raw = *(const unsigned*)(pr + col); const float x1 = bf2f((unsigned short)(raw & 0xffffu)), x2 = bf2f((unsigned short)(raw >> 16));
            *(unsigned*)(pr + col) = pkbf(x1 * c2 - x2 * s2, x1 * s2 + x2 * c2); }
    } else {
        for (int v = 0; v < 2; ++v) { const unsigned raw = *(const unsigned*)(pr + C_GV + 128 * v + 2 * lane);
            float* o = out + O_GV + (((size_t)(b * 2 + l) * 256 + t) * 2 + v) * 128 + 2 * lane; o[0] = bf2f((unsigned short)(raw & 0xffffu)); o[1] = bf2f((unsigned short)(raw >> 16)); }
        for (int v = 0; v < 4; ++v) { const unsigned rk = *(const unsigned*)(pr + C_DK + 128 * v + 2 * lane), rv = *(const unsigned*)(pr + C_DV + 128 * v + 2 * lane);
            const size_t oi = (((size_t)(b * 2 + l) * 256 + t) * 4 + v) * 128 + 2 * lane;
            out[O_DK + oi] = bf2f((unsigned short)(rk & 0xffffu)); out[O_DK + oi + 1] = bf2f((unsigned short)(rk >> 16));
            out[O_DV + oi] = bf2f((unsigned short)(rv & 0xffffu)); out[O_DV + oi + 1] = bf2f((unsigned short)(rv >> 16)); }
    }
}
#ifndef EN_PRO
#define EN_PRO 1
#endif
#ifndef EN_NORM
#define EN_NORM 1
#endif
#ifndef EN_FFNIN
#define EN_FFNIN 1
#endif
#ifndef EN_FFNOUT
#define EN_FFNOUT 1
#endif
#ifndef EN_WIN
#define EN_WIN 1
#endif
#ifndef EN_P
#define EN_P 1
#endif
#ifndef EN_A
#define EN_A 1
#endif
#ifndef EN_A1
#define EN_A1 1
#endif
#ifndef EN_A2
#define EN_A2 1
#endif
#ifndef EN_A3
#define EN_A3 1
#endif
#ifndef EN_WOUT
#define EN_WOUT 1
#endif
#ifndef EN_FIN
#define EN_FIN 1
#endif
struct Args { const float* in[22]; float* out; unsigned char* ws; int ph_lo, ph_hi, pad0, pad1; };
constexpr int NPHASE = 24;
#define LAUNDER(p) asm volatile("" : "+s"(p))
__device__ __forceinline__ int deal_unit(int i, int NL, int NC, int off, int G, int wg) {
    if (NL % G == 0) { const int nr = NL / G; if (i < nr) return i * G + wg; if (i > nr) return -1; const int c = (wg + G - off) % G; return c < NC ? NL + c : -1; }
    const int v = i * G + wg; return v < NL + NC ? v : -1;
}
__global__ void __launch_bounds__(512, 2) fwd_kernel(Args args) {
    extern __shared__ __attribute__((aligned(16))) unsigned char lds_raw[];
    LAS unsigned char* lds = (LAS unsigned char*)lds_raw;
    volatile LAS unsigned* MISC = (volatile LAS unsigned*)(lds + MISC_OFF);
    const int G = gridDim.x, wg = blockIdx.x;
    for (int u = threadIdx.x; u < (LDS_BYTES - 131072) / 4; u += 512) ((LAS unsigned*)(lds + 131072))[u] = 0u;
    __syncthreads();
    XcdBarrier bar = xcd_barrier_post((unsigned*)(args.ws + WS_CTL) + CW_BAR, MISC + 8);
    const int lo = args.ph_lo, hi = args.ph_hi;
#define IN(k) (lo <= (k) && (k) < hi)
#define SEAM(k) do { if (IN(k) && IN((k) + 1)) xcd_barrier(bar); } while (0)
#define PH_BEGIN unsigned char* ws = args.ws; float* out = args.out; const float* const* inp = args.in; LAUNDER(ws); LAUNDER(out); int tid = threadIdx.x; asm volatile("" : "+v"(tid)); \
    const int lane = tid & 63, wave = __builtin_amdgcn_readfirstlane(tid >> 6); (void)lane; (void)wave;

    if (EN_PRO && IN(0)) { PH_BEGIN; (void)out; prologue(inp, ws, lds, G, wg, tid); }
    SEAM(0);
#pragma unroll 1
    for (int l = 0; l < 2; ++l) {
        const int pb = 1 + 11 * l;
#pragma unroll 1
        for (int f = 0; f < 2; ++f) {
            const int fb = pb + 8 * f;
            if (EN_NORM && IN(fb + 0)) { PH_BEGIN; float* X = out + O_X; const bool first = (l == 0 && f == 0);
                const float* mod = (const float*)(ws + WS_TAB) + TB_MOD + (size_t)l * NCOND * NMODC;
                norm_phase(first ? inp[0] : X, first ? inp[1] - (size_t)M_P * DM : X, inp[11] + ((size_t)l * 3 + 2 * f) * DM, mod, 6 * f, (bf16*)(ws + WS_XN), G, wg, tid); }
            SEAM(fb + 0);
            if (EN_FFNIN && IN(fb + 1)) { PH_BEGIN; (void)out; (void)inp; const bf16* WL = (const bf16*)(ws + WS_W + (size_t)l * W_LAYER);
                pg8::Gemm g{(const bf16*)(ws + WS_XN), WL + (W_WI + (size_t)f * 44 * MiB) / 2, MTOK, NFF, DM}; pg8::StaticOrder S; S.init(MTOK, NFF, G, wg); pg8::EpiSwiGLU E{(bf16*)(ws + WS_ACT), DFF};
                pg8::gemm_phase<pg8::EpiSwiGLU, pg8::StaticOrder, true, true>(lds, g, S, E); }
            SEAM(fb + 1);
            if (EN_FFNOUT && IN(fb + 2)) { PH_BEGIN; float* X = out + O_X; const bool first = (l == 0 && f == 0); const bf16* WL = (const bf16*)(ws + WS_W + (size_t)l * W_LAYER);
                const float* mod = (const float*)(ws + WS_TAB) + TB_MOD + (size_t)l * NCOND * NMODC;
                pg8::Gemm g{(const bf16*)(ws + WS_ACT), WL + (W_WO + (size_t)f * 22 * MiB) / 2, MTOK, DM, DFF}; pg8::StaticOrder S; S.init(MTOK, DM, G, wg);
                pg8::EpiResid E{first ? inp[0] : X, first ? inp[1] - (size_t)M_P * DM : X, X, mod + (2 + 6 * f) * DM, 0.5f};
                pg8::gemm_phase<pg8::EpiResid, pg8::StaticOrder, true, true>(lds, g, S, E); }
            SEAM(fb + 2);
            if (f == 1) break;
            if (EN_NORM && IN(pb + 3)) { PH_BEGIN; float* X = out + O_X; const float* mod = (const float*)(ws + WS_TAB) + TB_MOD + (size_t)l * NCOND * NMODC;
                norm_phase(X, X, inp[11] + ((size_t)l * 3 + 1) * DM, mod, 3, (bf16*)(ws + WS_XN), G, wg, tid); }
            SEAM(pb + 3);
            if (EN_WIN && IN(pb + 4)) { PH_BEGIN; (void)out; (void)inp; const bf16* WL = (const bf16*)(ws + WS_W + (size_t)l * W_LAYER);
                pg8::Gemm g{(const bf16*)(ws + WS_XN), WL + W_WIN / 2, MTOK, NIN, DM}; pg8::StaticOrder S; S.init(MTOK, NIN, G, wg); pg8::EpiStoreBf16 E{(bf16*)(ws + WS_ACT), NIN};
                pg8::gemm_phase<pg8::EpiStoreBf16, pg8::StaticOrder, true, true>(lds, g, S, E); }
            SEAM(pb + 4);
            if (EN_P && IN(pb + 5)) { PH_BEGIN; bf16* PROJ = (bf16*)(ws + WS_ACT); const float* tab = (const float*)(ws + WS_TAB);
#pragma unroll 1
                for (int ch = wg; ch < 192; ch += G) {
                    const bool lat = ch < 64; const int cc = lat ? ch : ch - 64, dir = cc & 1, h = (cc >> 1) & 3, b = cc >> 3;
                    att::ChainArgs a; a.P = PROJ + (size_t)(lat ? M_P + b * 4096 : b * 256) * NIN; a.kcol = C_RK + 128 * h; a.vcol = C_RV + 128 * h; a.nchunk = lat ? 32 : 2; a.dir = dir;
                    a.lg2 = tab[TB_SCAL + 16 * l + 2 + dir * 4 + h];
                    a.S0 = lat ? inp[3] + ((((size_t)b * 2 + l) * 2 + dir) * 4 + h) * 16384 : nullptr;
                    a.ST = (bf16*)(ws + WS_ST) + (lat ? (size_t)cc * 32 * 16384 : (size_t)64 * 32 * 16384 + (size_t)cc * 2 * 16384);
                    a.Sfin = lat ? nullptr : out + O_STATE + ((((size_t)b * 2 + l) * 2 + dir) * 4 + h) * 16384;
                    __syncthreads(); att::ret_chain(a, (char*)lds_raw);
                }
                const int w0 = G > 128 ? 64 : 0, gw = (wg - w0) * 8 + wave, NGW = (G - w0) * 8;
                if (wg >= w0) for (int m = gw; m < MTOK; m += NGW) prep_row(m, l, PROJ, tab, inp[18] + l * 256, out, lane);
            }
            SEAM(pb + 5);
            if (EN_A && IN(pb + 6)) { PH_BEGIN; (void)out; bf16* PROJ = (bf16*)(ws + WS_ACT); bf16* MIX = (bf16*)(ws + WS_XN); const float* tab = (const float*)(ws + WS_TAB);
                const bf16* CGK = (const bf16*)(ws + WS_CACHE);
                if (EN_A1)
#pragma unroll 1
                for (int i2 = 0;; ++i2) { const int ps = i2 & 1; const int u = deal_unit(i2 >> 1, 512, 64, 192, G, wg); if (u < 0) break;
                    const bool lat = u < 512; const int v = lat ? u : u - 512;
                    const int qb = lat ? (v & 15) : 0, h = lat ? ((v >> 4) & 3) : (v & 3), b = lat ? (v >> 6) : (v >> 2);
                    const size_t row0 = lat ? (size_t)M_P + (size_t)b * 4096 : (size_t)b * 256;
                    const float lam = tab[TB_SCAL + 16 * l + 0], post = tab[TB_SCAL + 16 * l + 1];
                    {
                        att::KVSrc kv; kv.K1 = PROJ + row0 * NIN + C_DK + 128 * h + 64 * ps; kv.V1 = PROJ + row0 * NIN + C_DV + 128 * h; kv.n1 = lat ? 4096 : 256;
                        kv.K2 = CGK + 2097152 + ((size_t)(b * 2 + l) * 256) * 512 + 128 * h + 64 * ps; kv.V2 = CGK + 4194304 + ((size_t)(b * 2 + l) * 256) * 512 + 128 * h; kv.n2 = lat ? 256 : 0;
                        att::AttnOut ao; ao.Ob = MIX + (row0 + 256 * qb) * DM + 1536 + 128 * h; ao.Of = (float*)(ws + WS_DF) + (row0 + 256 * qb) * 512 + 128 * h;
                        ao.nw = inp[20] + l * 512 + 128 * h; ao.lam = lam; ao.post = post; ao.pass = ps;
                        __syncthreads();
                        att::attn_body<64, 1, 512>(PROJ + (row0 + 256 * qb) * NIN + C_DQ + 128 * h + 64 * ps, kv, ao, (char*)lds_raw);
                    }
                }
                if (EN_A2)
#pragma unroll 1
                for (int i = 0;; ++i) { const int u = deal_unit(i, 1024, 128, 64, G, wg); if (u < 0) break;
                    const bool lat = u < 1024; const int v = lat ? u : u - 1024;
                    const int qb = lat ? (v & 15) : 0, hq = lat ? ((v >> 4) & 7) : (v & 7), b = lat ? (v >> 7) : (v >> 3), kvh = hq >> 2;
                    const size_t row0 = lat ? (size_t)M_P + (size_t)b * 4096 : (size_t)b * 256;
                    att::KVSrc kv; kv.K1 = PROJ + row0 * NIN + C_GK + 128 * kvh; kv.V1 = PROJ + row0 * NIN + C_GV + 128 * kvh; kv.n1 = lat ? 4096 : 256;
                    kv.K2 = CGK + ((size_t)(b * 2 + l) * 256) * 256 + 128 * kvh; kv.V2 = CGK + 1048576 + ((size_t)(b * 2 + l) * 256) * 256 + 128 * kvh; kv.n2 = lat ? 256 : 0;
                    att::AttnOut ao; ao.Ob = MIX + (row0 + 256 * qb) * DM + 512 + 128 * hq; ao.Of = nullptr; ao.nw = nullptr; ao.lam = 0.f; ao.post = 0.f; ao.pass = 0;
                    __syncthreads();
                    att::attn_body<128, 0, 256>(PROJ + (row0 + 256 * qb) * NIN + C_GQ + 128 * hq, kv, ao, (char*)lds_raw);
                }
                if (EN_A3)
#pragma unroll 1
                for (int i = 0;; ++i) { const int u = deal_unit(i, 512, 64, 0, G, wg); if (u < 0) break;
                    const bool lat = u < 512; const int v = lat ? u : u - 512;
                    const int pr = lat ? (v & 15) : 0, h = lat ? ((v >> 4) & 3) : (v & 3), b = lat ? (v >> 6) : (v >> 2);
                    const size_t row0 = (lat ? (size_t)M_P + (size_t)b * 4096 : (size_t)b * 256) + 256 * pr;
                    att::RetCArgs a; a.P = PROJ + row0 * NIN; a.qcol = C_RQ + 128 * h; a.kcol = C_RK + 128 * h; a.vcol = C_RV + 128 * h; a.gcol = C_RG + 128 * h;
                    a.lg2f = tab[TB_SCAL + 16 * l + 2 + h]; a.lg2b = tab[TB_SCAL + 16 * l + 6 + h];
                    const int cf = (b * 4 + h) * 2; const bf16* STB = (const bf16*)(ws + WS_ST);
                    a.STf = STB + (lat ? (size_t)cf * 32 * 16384 : (size_t)64 * 32 * 16384 + (size_t)cf * 2 * 16384) + (size_t)(2 * pr) * 16384;
                    a.STb = STB + (lat ? (size_t)(cf + 1) * 32 * 16384 : (size_t)64 * 32 * 16384 + (size_t)(cf + 1) * 2 * 16384) + (size_t)(2 * pr) * 16384;
                    a.gnw = inp[17] + l * 512 + 128 * h; a.O = MIX + row0 * DM + 128 * h;
                    __syncthreads();
                    att::ret_c(a, (char*)lds_raw);
                }
            }
            SEAM(pb + 6);
            if (EN_WOUT && IN(pb + 7)) { PH_BEGIN; (void)inp; float* X = out + O_X; const bf16* WL = (const bf16*)(ws + WS_W + (size_t)l * W_LAYER);
                const float* mod = (const float*)(ws + WS_TAB) + TB_MOD + (size_t)l * NCOND * NMODC;
                pg8::Gemm g{(const bf16*)(ws + WS_XN), WL + W_WOUT / 2, MTOK, DM, DM}; pg8::StaticOrder S; S.init(MTOK, DM, G, wg);
                pg8::EpiResid E{X, X, X, mod + 5 * DM, 1.0f};
                pg8::gemm_phase<pg8::EpiResid, pg8::StaticOrder, true, true>(lds, g, S, E); }
            SEAM(pb + 7);
        }
    }
    if (EN_FIN && IN(23)) { PH_BEGIN; (void)ws; final_norm(out + O_X, inp[21], G, wg, tid); }
#undef IN
#undef SEAM
#undef PH_BEGIN
}

extern "C" void kernel_launch(void* const* d_in, const int* in_sizes, int n_in, void* d_out, int out_size, void* d_ws, size_t ws_size, hipStream_t stream) {
    static int grid = 0;
    if (grid == 0) {
        if (n_in != 22 || out_size != (int)O_END || ws_size < WS_END) { fprintf(stderr, "kernel_launch: unexpected shapes: n_in %d out %d ws %zu (need %zu)\n", n_in, out_size, ws_size, (size_t)WS_END); grid = -1; return; }
        int dev = 0, cus = 0, per_cu = 0;
        if (hipGetDevice(&dev) != hipSuccess || hipDeviceGetAttribute(&cus, hipDeviceAttributeMultiprocessorCount, dev) != hipSuccess) { grid = -1; return; }
        if (hipFuncSetAttribute((const void*)fwd_kernel, hipFuncAttributeMaxDynamicSharedMemorySize, LDS_BYTES) != hipSuccess) { fprintf(stderr, "kernel_launch: hipFuncSetAttribute failed\n"); grid = -1; return; }
        if (hipOccupancyMaxActiveBlocksPerMultiprocessor(&per_cu, (const void*)fwd_kernel, 512, LDS_BYTES) != hipSuccess || per_cu < 1) { fprintf(stderr, "kernel_launch: occupancy query says %d\n", per_cu); }
        (void)hipGetLastError();
        grid = cus;
    }
    if (grid < 0) return;
    (void)hipMemsetAsync((char*)d_ws + WS_CTL, 0, CTL_ZERO_BYTES, stream);
    Args a{};
    for (int i = 0; i < 22; ++i) a.in[i] = (const float*)d_in[i];
    a.out = (float*)d_out; a.ws = (unsigned char*)d_ws; a.ph_lo = 0; a.ph_hi = NPHASE; a.pad0 = 0; a.pad1 = 0;
    hipLaunchKernelGGL(fwd_kernel, dim3(grid), dim3(512), LDS_BYTES, stream, a);
}
```

```cpp
#include <hip/hip_runtime.h>
#include <hip/hip_bf16.h>
#include <cstdio>
#include <cstdint>
#ifndef PROBE
#define PROBE 0
#endif
#ifndef FFN_MB
#define FFN_MB 4
#endif
__device__ __forceinline__ float qm(float x) { if (FFN_MB >= 7) return x; unsigned u = __float_as_uint(x); constexpr unsigned sh = 23 - FFN_MB; u = (u + ((1u << (sh - 1)) - 1u) + ((u >> sh) & 1u)) & ~((1u << sh) - 1u); return __uint_as_float(u); }
#ifndef DBGT_CLK
#define DBGT_CLK 0
#endif
#ifndef DBGT_PH
#define DBGT_PH -1
#endif
namespace pg8 {
#define PG8_LAS __attribute__((address_space(3)))
typedef unsigned short bf16_t;
typedef short bf16x8 __attribute__((ext_vector_type(8)));
typedef float f32x4 __attribute__((ext_vector_type(4)));
typedef unsigned u32x4 __attribute__((ext_vector_type(4)));
typedef int i32x4 __attribute__((ext_vector_type(4)));
constexpr int BM = 256, BK = 64, HALF = 128, HTB = HALF * BK * 2  , STAGE_BYTES = 8 * HTB, NXCD = 8, WGM = 8;

__host__ __device__ __forceinline__ int lds_byte(int r, int c) { const int st = (r >> 4) * 2 + (c >> 5), rr = r & 15, cc = c & 31, ob = rr * 64 + cc * 2; return st * 1024 + (ob ^ (((ob >> 9) & 1) << 5)); }
__host__ __device__ __forceinline__ void stage_rc(int b, int& R, int& C) { const int st = b / 1024, sb = b % 1024, swz = sb ^ (((sb >> 9) & 1) << 5); R = (st >> 1) * 16 + swz / 64; C = (st & 1) * 32 + (swz % 64) / 2; }
__host__ __device__ __forceinline__ int perm32(int rho) { const int n = rho >> 4, i = rho & 15; return 8 * (i >> 2) + 4 * n + (i & 3); }

struct Unit { int pm, pn; };
struct Gemm { const bf16_t* A; const bf16_t* Bt; int M, N, K; };

struct StaticOrder {
    int nM, nN, nwg, G, c;
    __host__ __device__ void init(int M, int N, int G_, int c_) { nM = M / BM; nN = N / BM; nwg = nM * nN; G = G_; c = c_; }
    __host__ __device__ bool next(int i, Unit& u) const {
        const long L = (long)i * G + c; if (L >= nwg) return false;
        int wgid = (int)L; { const int q = nwg / NXCD, r = nwg % NXCD, xcd = wgid % NXCD, off = wgid / NXCD; wgid = (xcd < r ? xcd * (q + 1) : r * (q + 1) + (xcd - r) * q) + off; }
        const int nig = WGM * nN, gid = wgid / nig, fm = gid * WGM, gsz = (nM - fm) < WGM ? (nM - fm) : WGM;
        u.pm = fm + ((wgid % nig) % gsz); u.pn = (wgid % nig) / gsz; return true;
    }
    __device__ __forceinline__ void a_ready(const Unit&) const {}
    __device__ __forceinline__ void done(const Unit&) const {}
};

__device__ __forceinline__ unsigned cvt_pk_bf16(float lo, float hi) { unsigned r; asm volatile("v_cvt_pk_bf16_f32 %0, %1, %2" : "=v"(r) : "v"(lo), "v"(hi)); return r; }
typedef float f32x2 __attribute__((ext_vector_type(2)));
struct EpiStoreBf16 {
    static constexpr bool PERM = true, AFTER_DRAIN = false;
    bf16_t* O; int ldc;
    __device__ __forceinline__ void operator()(const f32x4 (&acc)[2][2][4][2], const Unit& u, int wr, int wc, int fr, int fq) const {
        const int row0 = u.pm * BM + wr * 64 + fr, col0 = u.pn * BM + wc * 32 + 8 * fq;
#pragma unroll
        for (int ai = 0; ai < 2; ++ai)
#pragma unroll
            for (int m = 0; m < 4; ++m) { bf16_t* rowp = O + (size_t)(row0 + ai * HALF + m * 16) * ldc + col0;
#pragma unroll
                for (int bj = 0; bj < 2; ++bj) { const f32x4 v0 = acc[ai][bj][m][0], v1 = acc[ai][bj][m][1];
                    u32x4 w; w.x = cvt_pk_bf16(v0[0], v0[1]); w.y = cvt_pk_bf16(v0[2], v0[3]); w.z = cvt_pk_bf16(v1[0], v1[1]); w.w = cvt_pk_bf16(v1[2], v1[3]);
                    *(u32x4*)(rowp + bj * HALF) = w; } }
    }
};
__device__ __forceinline__ float silu_f(float g) { return g * __builtin_amdgcn_rcpf(1.0f + __builtin_amdgcn_exp2f(-1.4426950408889634f * g)); }
struct EpiSwiGLU {
    static constexpr bool PERM = true, AFTER_DRAIN = false;
    bf16_t* O; int ldc;
    __device__ __forceinline__ void operator()(const f32x4 (&acc)[2][2][4][2], const Unit& u, int wr, int wc, int fr, int fq) const {
        const int row0 = u.pm * BM + wr * 64 + fr, col0 = u.pn * HALF + wc * 32 + 8 * fq;
#pragma unroll
        for (int ai = 0; ai < 2; ++ai)
#pragma unroll
            for (int m = 0; m < 4; ++m) { bf16_t* rowp = O + (size_t)(row0 + ai * HALF + m * 16) * ldc + col0;
                const f32x4 g0 = acc[ai][0][m][0], g1 = acc[ai][0][m][1], u0 = acc[ai][1][m][0], u1 = acc[ai][1][m][1];
                u32x4 w; w.x = cvt_pk_bf16(silu_f(g0[0]) * u0[0], silu_f(g0[1]) * u0[1]); w.y = cvt_pk_bf16(silu_f(g0[2]) * u0[2], silu_f(g0[3]) * u0[3]);
                w.z = cvt_pk_bf16(silu_f(g1[0]) * u1[0], silu_f(g1[1]) * u1[1]); w.w = cvt_pk_bf16(silu_f(g1[2]) * u1[2], silu_f(g1[3]) * u1[3]);
                *(u32x4*)rowp = w; }
    }
};
struct EpiResid {
    static constexpr bool PERM = false, AFTER_DRAIN = false;
    const float* baseP; const float* baseS; float* out; const float* gate; float coef;
    __device__ __forceinline__ void operator()(const f32x4 (&acc)[2][2][4][2], const Unit& u, int wr, int wc, int fr, int fq) const {
        const int cond = u.pm < 16 ? 0 : 1 + ((u.pm - 16) >> 4);
        const float* g = gate + (size_t)cond * 18432; const float* base = u.pm < 16 ? baseP : baseS;
        const int row0 = u.pm * BM + wr * 64 + fr, col0 = u.pn * BM + wc * 32 + 4 * fq;
        f32x4 gv[2][2];
#pragma unroll
        for (int bj = 0; bj < 2; ++bj)
#pragma unroll
            for (int n = 0; n < 2; ++n) gv[bj][n] = *(const f32x4*)(g + col0 + bj * HALF + n * 16) * coef;
#pragma unroll
        for (int ai = 0; ai < 2; ++ai)
#pragma unroll
            for (int m = 0; m < 4; ++m) { const size_t off = (size_t)(row0 + ai * HALF + m * 16) * 2048 + col0;
#pragma unroll
                for (int bj = 0; bj < 2; ++bj)
#pragma unroll
                    for (int n = 0; n < 2; ++n) { const f32x4 b = *(const f32x4*)(base + off + bj * HALF + n * 16);
                        *(f32x4*)(out + off + bj * HALF + n * 16) = b + gv[bj][n] * acc[ai][bj][m][n]; }
                if (m == 3) asm volatile("" ::: "memory"); }
    }
};

__device__ __forceinline__ float rstd_of(const unsigned long long* rss, int row) { return rsqrtf((float)rss[row] * (1.0f / 16777216.0f) * (1.0f / 2048.0f) + 1e-6f); }
struct EpiStoreBf16N {
    static constexpr bool PERM = true, AFTER_DRAIN = false;
    bf16_t* O; int ldc; const unsigned long long* rss; const float* bias; int ldb;
    __device__ __forceinline__ void operator()(const f32x4 (&acc)[2][2][4][2], const Unit& u, int wr, int wc, int fr, int fq) const {
        const int cond = u.pm < 16 ? 0 : 1 + ((u.pm - 16) >> 4);
        const int row0 = u.pm * BM + wr * 64 + fr, col0 = u.pn * BM + wc * 32 + 8 * fq;
        const float* b = bias + (size_t)cond * ldb + col0;
        f32x4 bv[2][2];
#pragma unroll
        for (int bj = 0; bj < 2; ++bj)
#pragma unroll
            for (int n = 0; n < 2; ++n) bv[bj][n] = *(const f32x4*)(b + bj * HALF + 4 * n);
#pragma unroll
        for (int ai = 0; ai < 2; ++ai)
#pragma unroll
            for (int m = 0; m < 4; ++m) { const int row = row0 + ai * HALF + m * 16; const float rs = rstd_of(rss, row); bf16_t* rowp = O + (size_t)row * ldc + col0;
#pragma unroll
                for (int bj = 0; bj < 2; ++bj) { const f32x4 v0 = acc[ai][bj][m][0] * rs + bv[bj][0], v1 = acc[ai][bj][m][1] * rs + bv[bj][1];
                    u32x4 w; w.x = cvt_pk_bf16(v0[0], v0[1]); w.y = cvt_pk_bf16(v0[2], v0[3]); w.z = cvt_pk_bf16(v1[0], v1[1]); w.w = cvt_pk_bf16(v1[2], v1[3]);
                    *(u32x4*)(rowp + bj * HALF) = w; } }
    }
};
struct EpiSwiGLUN {
    static constexpr bool PERM = true, AFTER_DRAIN = false;
    bf16_t* O; int ldc; const unsigned long long* rss; const float* bias; int ldb;
    __device__ __forceinline__ void operator()(const f32x4 (&acc)[2][2][4][2], const Unit& u, int wr, int wc, int fr, int fq) const {
        const int cond = u.pm < 16 ? 0 : 1 + ((u.pm - 16) >> 4);
        const int row0 = u.pm * BM + wr * 64 + fr, col0 = u.pn * HALF + wc * 32 + 8 * fq;
        const float* b = bias + (size_t)cond * ldb + u.pn * BM + wc * 32 + 8 * fq;
        const f32x4 bg0 = *(const f32x4*)(b), bg1 = *(const f32x4*)(b + 4), bu0 = *(const f32x4*)(b + HALF), bu1 = *(const f32x4*)(b + HALF + 4);
#pragma unroll
        for (int ai = 0; ai < 2; ++ai)
#pragma unroll
            for (int m = 0; m < 4; ++m) { const int row = row0 + ai * HALF + m * 16; const float rs = rstd_of(rss, row); bf16_t* rowp = O + (size_t)row * ldc + col0;
                const f32x4 g0 = acc[ai][0][m][0] * rs + bg0, g1 = acc[ai][0][m][1] * rs + bg1, u0 = acc[ai][1][m][0] * rs + bu0, u1 = acc[ai][1][m][1] * rs + bu1;
                u32x4 w; w.x = cvt_pk_bf16(qm(silu_f(g0[0]) * u0[0]), qm(silu_f(g0[1]) * u0[1])); w.y = cvt_pk_bf16(qm(silu_f(g0[2]) * u0[2]), qm(silu_f(g0[3]) * u0[3]));
                w.z = cvt_pk_bf16(qm(silu_f(g1[0]) * u1[0]), qm(silu_f(g1[1]) * u1[1])); w.w = cvt_pk_bf16(qm(silu_f(g1[2]) * u1[2]), qm(silu_f(g1[3]) * u1[3]));
                *(u32x4*)rowp = w; }
    }
};
struct EpiStoreQ {
    static constexpr bool PERM = true, AFTER_DRAIN = false;
    bf16_t* O; int ldc; const unsigned long long* rss; const float* sa; const float* sw; const float* bias; int ldb; int pm_off;
    __device__ __forceinline__ void operator()(const f32x4 (&acc)[2][2][4][2], const Unit& u, int wr, int wc, int fr, int fq) const {
        const int pmg = u.pm + pm_off, cond = pmg < 16 ? 0 : 1 + ((pmg - 16) >> 4);
        const int row0 = u.pm * BM + wr * 64 + fr, col0 = u.pn * BM + wc * 32 + 8 * fq;
        const float* b = bias + (size_t)cond * ldb + col0; const float* w = sw + col0;
        f32x4 bv[2][2], wv[2][2];
#pragma unroll
        for (int bj = 0; bj < 2; ++bj)
#pragma unroll
            for (int n = 0; n < 2; ++n) { bv[bj][n] = *(const f32x4*)(b + bj * HALF + 4 * n); wv[bj][n] = *(const f32x4*)(w + bj * HALF + 4 * n); }
#pragma unroll
        for (int ai = 0; ai < 2; ++ai)
#pragma unroll
            for (int m = 0; m < 4; ++m) { const int row = row0 + ai * HALF + m * 16; const float rs = rstd_of(rss, row) * sa[row]; bf16_t* rowp = O + (size_t)row * ldc + col0;
#pragma unroll
                for (int bj = 0; bj < 2; ++bj) { const f32x4 v0 = acc[ai][bj][m][0] * rs * wv[bj][0] + bv[bj][0], v1 = acc[ai][bj][m][1] * rs * wv[bj][1] + bv[bj][1];
                    u32x4 w4; w4.x = cvt_pk_bf16(v0[0], v0[1]); w4.y = cvt_pk_bf16(v0[2], v0[3]); w4.z = cvt_pk_bf16(v1[0], v1[1]); w4.w = cvt_pk_bf16(v1[2], v1[3]);
                    *(u32x4*)(rowp + bj * HALF) = w4; } }
    }
};
__device__ __forceinline__ float sat448(float x) { return __builtin_fminf(__builtin_fmaxf(x, -448.0f), 448.0f); }
struct EpiSwiGLUQ {
    static constexpr bool PERM = true, AFTER_DRAIN = false;
    unsigned char* O; int ldc; const unsigned long long* rss; const float* sa; const float* sw; const float* bias; int ldb; const float* act_s;
    __device__ __forceinline__ void operator()(const f32x4 (&acc)[2][2][4][2], const Unit& u, int wr, int wc, int fr, int fq) const {
        const int cond = u.pm < 16 ? 0 : 1 + ((u.pm - 16) >> 4);
        const int row0 = u.pm * BM + wr * 64 + fr, col0 = u.pn * HALF + wc * 32 + 8 * fq, bcol = u.pn * BM + wc * 32 + 8 * fq;
        const float* b = bias + (size_t)cond * ldb + bcol; const float* w = sw + bcol;
        const f32x4 bg0 = *(const f32x4*)(b), bg1 = *(const f32x4*)(b + 4), bu0 = *(const f32x4*)(b + HALF), bu1 = *(const f32x4*)(b + HALF + 4);
        const f32x4 wg0 = *(const f32x4*)(w), wg1 = *(const f32x4*)(w + 4), wu0 = *(const f32x4*)(w + HALF), wu1 = *(const f32x4*)(w + HALF + 4);
        const float as = act_s[0];
#pragma unroll
        for (int ai = 0; ai < 2; ++ai)
#pragma unroll
            for (int m = 0; m < 4; ++m) { const int row = row0 + ai * HALF + m * 16; const float rs = rstd_of(rss, row) * sa[row]; unsigned char* rowp = O + (size_t)row * ldc + col0;
                const f32x4 g0 = acc[ai][0][m][0] * rs * wg0 + bg0, g1 = acc[ai][0][m][1] * rs * wg1 + bg1, u0 = (acc[ai][1][m][0] * rs * wu0 + bu0) * as, u1 = (acc[ai][1][m][1] * rs * wu1 + bu1) * as;
                unsigned w0 = __builtin_amdgcn_cvt_pk_fp8_f32(sat448(silu_f(g0[0]) * u0[0]), sat448(silu_f(g0[1]) * u0[1]), 0, false); w0 = __builtin_amdgcn_cvt_pk_fp8_f32(sat448(silu_f(g0[2]) * u0[2]), sat448(silu_f(g0[3]) * u0[3]), w0, true);
                unsigned w1 = __builtin_amdgcn_cvt_pk_fp8_f32(sat448(silu_f(g1[0]) * u1[0]), sat448(silu_f(g1[1]) * u1[1]), 0, false); w1 = __builtin_amdgcn_cvt_pk_fp8_f32(sat448(silu_f(g1[2]) * u1[2]), sat448(silu_f(g1[3]) * u1[3]), w1, true);
                uint2 wv; wv.x = w0; wv.y = w1; *(uint2*)rowp = wv; }
    }
};
struct EpiResidN {
    static constexpr bool PERM = false, AFTER_DRAIN = false;
    const float* baseP; const float* baseS; float* out; const float* gate; const float* nw; const float* scl; unsigned long long* rss; long xs_delta;   float coef; int do_xs; long sa_delta, sw_delta; int q8; int xs_all = 0; long am_delta = 0;
    __device__ __forceinline__ void operator()(const f32x4 (&acc)[2][2][4][2], const Unit& u, int wr, int wc, int fr, int fq) const {
        const int cond = u.pm < 16 ? 0 : 1 + ((u.pm - 16) >> 4); const int do_xs = (this->do_xs && (xs_all || u.pm < 16)) ? this->do_xs : 0;     bf16_t* xs = (bf16_t*)((char*)rss + xs_delta); const float* sa = (const float*)((char*)rss + sa_delta); const float* swc = (const float*)((char*)rss + sw_delta);
        const float* g = gate + (size_t)cond * 18432; const float* base = u.pm < 16 ? baseP : baseS;
        const int row0 = u.pm * BM + wr * 64 + fr, col0 = u.pn * BM + wc * 32 + 4 * fq;
        f32x4 gv[2][2], av[2][2];
#pragma unroll
        for (int bj = 0; bj < 2; ++bj)
#pragma unroll
            for (int n = 0; n < 2; ++n) { gv[bj][n] = *(const f32x4*)(g + col0 + bj * HALF + n * 16) * coef; if (q8) gv[bj][n] = gv[bj][n] * *(const f32x4*)(swc + col0 + bj * HALF + n * 16);
                av[bj][n] = do_xs ? *(const f32x4*)(nw + col0 + bj * HALF + n * 16) * (*(const f32x4*)(scl + (size_t)cond * 18432 + col0 + bj * HALF + n * 16) + 1.0f) : (f32x4){0.f, 0.f, 0.f, 0.f}; }
#pragma unroll
        for (int ai = 0; ai < 2; ++ai)
#pragma unroll
            for (int m = 0; m < 4; ++m) { const int row = row0 + ai * HALF + m * 16; const size_t off = (size_t)row * 2048 + col0; float ss = 0.f, amx = 0.f; const float sr = q8 == 2 ? sa[0] : q8 ? sa[row] : 1.0f;
#pragma unroll
                for (int bj = 0; bj < 2; ++bj)
#pragma unroll
                    for (int n = 0; n < 2; ++n) { const f32x4 b = *(const f32x4*)(base + off + bj * HALF + n * 16); const f32x4 o = b + gv[bj][n] * (acc[ai][bj][m][n] * sr);
                        *(f32x4*)(out + off + bj * HALF + n * 16) = o;
                        if (do_xs) { f32x4 q = o * av[bj][n]; if (do_xs == 2) { q[0] = qm(q[0]); q[1] = qm(q[1]); q[2] = qm(q[2]); q[3] = qm(q[3]); } ss += (o[0] * o[0] + o[1] * o[1]) + (o[2] * o[2] + o[3] * o[3]); amx = fmaxf(fmaxf(amx, fmaxf(fabsf(q[0]), fabsf(q[1]))), fmaxf(fabsf(q[2]), fabsf(q[3])));
                            uint2 w2; w2.x = cvt_pk_bf16(q[0], q[1]); w2.y = cvt_pk_bf16(q[2], q[3]); *(uint2*)(xs + off + bj * HALF + n * 16) = w2; } }
                if (do_xs) { ss += __shfl_xor(ss, 16); ss += __shfl_xor(ss, 32); if (fq == 0) atomicAdd(rss + row, (unsigned long long)(ss * 16777216.0f));
                    if (xs_all) { amx = fmaxf(amx, __shfl_xor(amx, 16)); amx = fmaxf(amx, __shfl_xor(amx, 32)); if (fq == 0) atomicMax((unsigned*)((char*)rss + am_delta) + row, __float_as_uint(amx)); } }
                if (m == 3) asm volatile("" ::: "memory"); }
    }
};
typedef int i32x8 __attribute__((ext_vector_type(8)));
__device__ __forceinline__ void mfma_f8_128(f32x4& c, const i32x8 a, const i32x8 b) { asm volatile("v_mfma_f32_16x16x128_f8f6f4 %0, %1, %2, %0" : "+v"(c) : "v"(a), "v"(b)); }
template <class Epi, class Sched, bool ALIGN_EPI = false, bool SP2 = false, int I8 = 0>
__device__ __forceinline__ void gemm_phase(PG8_LAS unsigned char* lds, const Gemm g, const Sched& S, const Epi& E) {
    int tid_ = threadIdx.x; asm volatile("" : "+v"(tid_));
    const int tid = tid_, wid = __builtin_amdgcn_readfirstlane(tid >> 6), lane = tid & 63, wr = wid >> 2, wc = wid & 3, fr = lane & 15, fq = lane >> 4;
    const int K = g.K, nt = K / BK;
    unsigned voffA[2], voffB[2];
#pragma unroll
    for (int i = 0; i < 2; ++i) { int R, C; stage_rc(tid * 16 + i * 8192, R, C); const int Rb = Epi::PERM ? ((R & ~31) + perm32(R & 31)) : R;
        voffA[i] = (unsigned)(R * K + C) * 2u; voffB[i] = (unsigned)(Rb * BK + C) * 2u; }
    const size_t kstep = (size_t)(BK * 2);
    const size_t hstep = (size_t)HALF * K * 2;
    const size_t tstep = 2 * hstep;
    const size_t kstepB = (size_t)BM * BK * 2, hstepB = (size_t)HALF * BK * 2;
    const unsigned ldsw = (unsigned)wid * 1024u;
    const int aoff = lds_byte(wr * 64 + fr, fq * 8), boff = lds_byte(wc * 32 + fr, fq * 8);
#define PG8_SA(b, h) (((b) * 2 + (h)) * HTB)
#define PG8_SB(b, h) ((4 + (b) * 2 + (h)) * HTB)
#define PG8_STAGE(bufoff, gbase, voff) do { _Pragma("unroll") for (int _i = 0; _i < 2; ++_i) \
        __builtin_amdgcn_global_load_lds((const unsigned*)((const char*)(gbase) + (voff)[_i]), (PG8_LAS unsigned*)(lds + (bufoff) + ldsw + _i * 8192), 16, 0, 0); } while (0)
#define PG8_LDA(dst, b, h) do { _Pragma("unroll") for (int m = 0; m < 4; ++m) _Pragma("unroll") for (int k = 0; k < 2; ++k) dst[m][k] = *(const PG8_LAS bf16x8*)(lds + PG8_SA(b, h) + aoff + m * 2048 + k * 1024); } while (0)
#define PG8_LDB(dst, b, h) do { _Pragma("unroll") for (int n = 0; n < 2; ++n) _Pragma("unroll") for (int k = 0; k < 2; ++k) dst[n][k] = *(const PG8_LAS bf16x8*)(lds + PG8_SB(b, h) + boff + n * 2048 + k * 1024); } while (0)
#define PG8_MMA(ai, bj, At, Bt) do { __builtin_amdgcn_s_setprio(1); _Pragma("unroll") for (int m = 0; m < 4; ++m) _Pragma("unroll") for (int n = 0; n < 2; ++n) { if constexpr (I8 == 2) { \
        mfma_f8_128(acc[ai][bj][m][n], __builtin_shufflevector(__builtin_bit_cast(i32x4, Bt[n][0]), __builtin_bit_cast(i32x4, Bt[n][1]), 0, 1, 2, 3, 4, 5, 6, 7), \
            __builtin_shufflevector(__builtin_bit_cast(i32x4, At[m][0]), __builtin_bit_cast(i32x4, At[m][1]), 0, 1, 2, 3, 4, 5, 6, 7)); } else _Pragma("unroll") for (int k = 0; k < 2; ++k) { \
        if constexpr (I8 == 1) acc[ai][bj][m][n] = __builtin_bit_cast(f32x4, __builtin_amdgcn_mfma_i32_16x16x64_i8(__builtin_bit_cast(i32x4, Bt[n][k]), __builtin_bit_cast(i32x4, At[m][k]), __builtin_bit_cast(i32x4, acc[ai][bj][m][n]), 0, 0, 0)); \
        else acc[ai][bj][m][n] = __builtin_amdgcn_mfma_f32_16x16x32_bf16(Bt[n][k], At[m][k], acc[ai][bj][m][n], 0, 0, 0); } } __builtin_amdgcn_s_setprio(0); } while (0)
#define PG8_WAIT_V(n) asm volatile("s_waitcnt vmcnt(" #n ")" ::: "memory")
#define PG8_WAIT_L(n) asm volatile("s_waitcnt lgkmcnt(" #n ")" ::: "memory")
#define PG8_BAR __builtin_amdgcn_s_barrier()
#define PG8_SCHED __builtin_amdgcn_sched_barrier(0)
    Unit cur, nxt; int ui = 0;
    if (!S.next(0, cur)) return;
    f32x4 acc[2][2][4][2];
#pragma unroll
    for (int a = 0; a < 2; ++a)
#pragma unroll
        for (int b = 0; b < 2; ++b)
#pragma unroll
            for (int m = 0; m < 4; ++m)
#pragma unroll
                for (int n = 0; n < 2; ++n) acc[a][b][m][n] = (f32x4){0.f, 0.f, 0.f, 0.f};
    bf16x8 At[4][2], B0[2][2], B1[2][2];
    const char* cA = (const char*)g.A + (size_t)cur.pm * tstep; const char* cB = (const char*)g.Bt + (size_t)cur.pn * tstep;
    S.a_ready(cur);
    if constexpr (SP2) {
        PG8_STAGE(PG8_SB(0, 0), cB, voffB); PG8_STAGE(PG8_SB(0, 1), cB + hstepB, voffB); PG8_STAGE(PG8_SA(0, 0), cA, voffA); PG8_STAGE(PG8_SA(0, 1), cA + hstep, voffA);
        if (wr == 1) PG8_BAR;
        PG8_WAIT_V(2); PG8_BAR;
        PG8_STAGE(PG8_SB(1, 0), cB + kstepB, voffB); PG8_STAGE(PG8_SA(1, 0), cA + kstep, voffA); PG8_STAGE(PG8_SB(1, 1), cB + hstepB + kstepB, voffB);
        PG8_WAIT_V(6); PG8_BAR;
    } else {
        PG8_STAGE(PG8_SB(0, 0), cB, voffB); PG8_STAGE(PG8_SA(0, 0), cA, voffA); PG8_STAGE(PG8_SB(0, 1), cB + hstepB, voffB); PG8_STAGE(PG8_SA(0, 1), cA + hstep, voffA);
        if (wr == 1) PG8_BAR;
        PG8_WAIT_V(4); PG8_BAR;
        PG8_STAGE(PG8_SB(1, 0), cB + kstepB, voffB); PG8_STAGE(PG8_SA(1, 0), cA + kstep, voffA); PG8_STAGE(PG8_SB(1, 1), cB + hstepB + kstepB, voffB);
        PG8_WAIT_V(6); PG8_BAR;
    }
    for (;;) {
        const bool has_next = S.next(ui + 1, nxt);
        const char* nA = has_next ? (const char*)g.A + (size_t)nxt.pm * tstep : cA; const char* nB = has_next ? (const char*)g.Bt + (size_t)nxt.pn * tstep : cB;
        for (int t = 0; t < nt; t += 2) {
            const bool last = (t == nt - 2);
            const char* a1 = cA + (size_t)(t + 1) * kstep;
            const char* a2 = last ? nA : cA + (size_t)(t + 2) * kstep; const char* b2 = last ? nB : cB + (size_t)(t + 2) * kstepB;
            const char* a3 = a2 + kstep; const char* b3 = b2 + kstepB;
            if (last && has_next) S.a_ready(nxt);
            if constexpr (SP2) {
            PG8_LDB(B0, 0, 0); PG8_LDB(B1, 0, 1); PG8_SCHED; PG8_LDA(At, 0, 0); PG8_STAGE(PG8_SA(1, 1), a1 + hstep, voffA);
            PG8_WAIT_V(8); PG8_WAIT_L(0); PG8_BAR; PG8_MMA(0, 0, At, B0); PG8_MMA(0, 1, At, B1); PG8_BAR; PG8_SCHED;
            PG8_LDA(At, 0, 1); PG8_STAGE(PG8_SB(0, 0), b2, voffB); PG8_STAGE(PG8_SB(0, 1), b2 + hstepB, voffB); PG8_STAGE(PG8_SA(0, 0), a2, voffA);
            PG8_WAIT_V(8); PG8_WAIT_L(0); PG8_BAR; PG8_MMA(1, 0, At, B0); PG8_MMA(1, 1, At, B1); PG8_BAR; PG8_SCHED;
            PG8_LDB(B0, 1, 0); PG8_LDB(B1, 1, 1); PG8_SCHED; PG8_LDA(At, 1, 0); PG8_STAGE(PG8_SA(0, 1), a2 + hstep, voffA);
            PG8_WAIT_V(8); PG8_WAIT_L(0); PG8_BAR; PG8_MMA(0, 0, At, B0); PG8_MMA(0, 1, At, B1); PG8_BAR; PG8_SCHED;
            PG8_LDA(At, 1, 1); PG8_STAGE(PG8_SB(1, 0), b3, voffB); PG8_STAGE(PG8_SB(1, 1), b3 + hstepB, voffB); PG8_STAGE(PG8_SA(1, 0), a3, voffA);
            PG8_WAIT_V(8); PG8_WAIT_L(0); PG8_BAR; PG8_MMA(1, 0, At, B0); PG8_MMA(1, 1, At, B1); PG8_BAR; PG8_SCHED;
            } else {
            PG8_LDB(B0, 0, 0); PG8_SCHED; PG8_LDA(At, 0, 0); PG8_STAGE(PG8_SA(1, 1), a1 + hstep, voffA);
            PG8_WAIT_L(8); PG8_BAR; PG8_WAIT_L(0); PG8_MMA(0, 0, At, B0); PG8_BAR; PG8_SCHED;
            PG8_LDB(B1, 0, 1); PG8_STAGE(PG8_SB(0, 0), b2, voffB);
            PG8_BAR; PG8_WAIT_L(0); PG8_MMA(0, 1, At, B1); PG8_BAR;
            PG8_LDA(At, 0, 1); PG8_STAGE(PG8_SA(0, 0), a2, voffA);
            PG8_BAR; PG8_WAIT_L(0); PG8_MMA(1, 0, At, B0); PG8_BAR; PG8_SCHED;
            PG8_STAGE(PG8_SB(0, 1), b2 + hstepB, voffB);
            PG8_WAIT_V(6); PG8_BAR; PG8_MMA(1, 1, At, B1); PG8_BAR;
            PG8_LDB(B0, 1, 0); PG8_SCHED; PG8_LDA(At, 1, 0); PG8_STAGE(PG8_SA(0, 1), a2 + hstep, voffA);
            PG8_WAIT_L(8); PG8_BAR; PG8_WAIT_L(0); PG8_MMA(0, 0, At, B0); PG8_BAR; PG8_SCHED;
            PG8_LDB(B1, 1, 1); PG8_STAGE(PG8_SB(1, 0), b3, voffB);
            PG8_BAR; PG8_WAIT_L(0); PG8_MMA(0, 1, At, B1); PG8_BAR;
            PG8_LDA(At, 1, 1); PG8_STAGE(PG8_SA(1, 0), a3, voffA);
            PG8_BAR; PG8_WAIT_L(0); PG8_MMA(1, 0, At, B0); PG8_BAR; PG8_SCHED;
            PG8_STAGE(PG8_SB(1, 1), b3 + hstepB, voffB);
            PG8_WAIT_V(6); PG8_BAR; PG8_MMA(1, 1, At, B1); PG8_BAR;
            }
        }
        if constexpr (ALIGN_EPI) { if (wr == 0) PG8_BAR; }
        if constexpr (I8 == 2) asm volatile("s_nop 15\n\ts_nop 15" ::: "memory");
        if constexpr (I8 == 1) { _Pragma("unroll") for (int a = 0; a < 2; ++a) _Pragma("unroll") for (int b = 0; b < 2; ++b) _Pragma("unroll") for (int m = 0; m < 4; ++m) _Pragma("unroll") for (int n = 0; n < 2; ++n) acc[a][b][m][n] = __builtin_convertvector(__builtin_bit_cast(i32x4, acc[a][b][m][n]), f32x4); }
        if constexpr (!Epi::AFTER_DRAIN) { E(acc, cur, wr, wc, fr, fq); S.done(cur); }
        if (!has_next) break;
#pragma unroll
        for (int a = 0; a < 2; ++a)
#pragma unroll
            for (int b = 0; b < 2; ++b)
#pragma unroll
                for (int m = 0; m < 4; ++m)
#pragma unroll
                    for (int n = 0; n < 2; ++n) acc[a][b][m][n] = (f32x4){0.f, 0.f, 0.f, 0.f};
        cur = nxt; cA = nA; cB = nB; ++ui;
        if constexpr (ALIGN_EPI) { if (wr == 1) PG8_BAR; }
    }
    PG8_WAIT_V(0);
    if constexpr (!ALIGN_EPI) { if (wr == 0) PG8_BAR; }
    PG8_BAR;
    if constexpr (Epi::AFTER_DRAIN) { E.fused(acc, cur, wr, wc, fr, fq, lds, wid, lane); S.done(cur); }
#undef PG8_SA
#undef PG8_SB
#undef PG8_STAGE
#undef PG8_LDA
#undef PG8_LDB
#undef PG8_MMA
#undef PG8_WAIT_V
#undef PG8_WAIT_L
#undef PG8_BAR
#undef PG8_SCHED
}
}
namespace att {
using bf16x8 = __attribute__((ext_vector_type(8))) short;
using s16x4  = __attribute__((ext_vector_type(4))) short;
using f32x16 = __attribute__((ext_vector_type(16))) float;
using u32x4  = __attribute__((ext_vector_type(4))) unsigned;
typedef unsigned short bf16_t;
constexpr int NW = 8, QBLK = 32, KVBLK = 64;
constexpr float THR = 8.f;
constexpr int SHM_V = 64 * 128 * 2, SHM_K = 64 * 128 * 2, SHM_ATTN = 2 * SHM_V + 2 * SHM_K + NW * 64 * 4;
#define KSWZ(row, colB) ((row) * 256 + ((colB) ^ (((row) & 7) << 4)))
#define KSWZ64(row, colB) ((row) * 128 + ((colB) ^ ((((row) >> 1) & 7) << 4)))
#define SBAR() __builtin_amdgcn_sched_barrier(0)
__device__ __forceinline__ int crow(int r, int hi) { return (r & 3) + 8 * (r >> 2) + 4 * hi; }
__device__ __forceinline__ unsigned cvtpk(float lo, float hi) { unsigned r; asm volatile("v_cvt_pk_bf16_f32 %0, %1, %2" : "=v"(r) : "v"(lo), "v"(hi)); return r; }
__device__ __forceinline__ float bf2f(unsigned short b) { return __uint_as_float((unsigned)b << 16); }
__device__ __forceinline__ bf16x8 ld8(const bf16_t* p) { return *reinterpret_cast<const bf16x8*>(p); }

template <int DQK, bool PRE = false> __device__ __forceinline__ void partialSM(f32x16& p0, f32x16& p1, float& m_reg, float& mn, float& alpha) {
  constexpr float SCALE = PRE ? 0.6931471805599453f : ((DQK == 128) ? 0.088388347648318440f : 0.125f);
  constexpr float C = SCALE * 1.4426950408889634f;
  float pmax = p0[0];
#pragma unroll
  for (int r = 1; r < 16; ++r) pmax = fmaxf(pmax, p0[r]);
#pragma unroll
  for (int r = 0; r < 16; ++r) pmax = fmaxf(pmax, p1[r]);
  { auto rr = __builtin_amdgcn_permlane32_swap(__float_as_uint(pmax), __float_as_uint(pmax), false, false);
    pmax = fmaxf(__uint_as_float(rr[0]), __uint_as_float(rr[1])); }
  if (__builtin_expect(__all(pmax - m_reg <= THR / SCALE), 1)) { mn = m_reg; alpha = 1.f; }
  else { mn = fmaxf(m_reg, pmax); alpha = __builtin_amdgcn_exp2f((m_reg - mn) * C); m_reg = mn; }
  float mnC = -mn * C;
#pragma unroll
  for (int r = 0; r < 16; ++r) p0[r] = fmaf(p0[r], C, mnC);
#pragma unroll
  for (int r = 0; r < 16; ++r) p1[r] = fmaf(p1[r], C, mnC);
#pragma unroll
  for (int r = 0; r < 16; ++r) p0[r] = __builtin_amdgcn_exp2f(p0[r]);
}
#define PK4(P, BASE, OUT) do { unsigned a0 = cvtpk(P[BASE + 0], P[BASE + 1]), a1 = cvtpk(P[BASE + 2], P[BASE + 3]);   \
    unsigned b0 = cvtpk(P[BASE + 4], P[BASE + 5]), b1 = cvtpk(P[BASE + 6], P[BASE + 7]);                              \
    auto r0 = __builtin_amdgcn_permlane32_swap(a0, b0, false, false); auto r1 = __builtin_amdgcn_permlane32_swap(a1, b1, false, false); \
    u32x4 w = {r0[0], r1[0], r0[1], r1[1]}; OUT = *reinterpret_cast<bf16x8*>(&w); } while (0)
__device__ __forceinline__ void finishSM(f32x16& p0, f32x16& p1, float alpha, float& l_reg, bf16x8& pa0, bf16x8& pa1, bf16x8& pa2, bf16x8& pa3) {
#pragma unroll
  for (int r = 0; r < 16; ++r) p1[r] = __builtin_amdgcn_exp2f(p1[r]);
  float ps = 0;
#pragma unroll
  for (int r = 0; r < 16; ++r) ps += p0[r];
#pragma unroll
  for (int r = 0; r < 16; ++r) ps += p1[r];
  { auto rr = __builtin_amdgcn_permlane32_swap(__float_as_uint(ps), __float_as_uint(ps), false, false);
    ps = __uint_as_float(rr[0]) + __uint_as_float(rr[1]); }
  l_reg = l_reg * alpha + ps;
  PK4(p0, 0, pa0); PK4(p0, 8, pa1); PK4(p1, 0, pa2); PK4(p1, 8, pa3);
}
template <int DQK> __device__ __forceinline__ void qkt(f32x16& p0, f32x16& p1, const char* Ks, const bf16x8* qr, int r32, int hi) {
  constexpr int ND = DQK / 16;
  p0 = f32x16{}; p1 = f32x16{};
  bf16x8 b0[2], b1[2];
#define QK_RD(d0, s) do { const int cb_ = ((d0) * 16 + hi * 8) * 2; \
    if constexpr (DQK == 128) { b0[s] = *reinterpret_cast<const bf16x8*>(Ks + KSWZ(r32, cb_)); b1[s] = *reinterpret_cast<const bf16x8*>(Ks + KSWZ(32 + r32, cb_)); } \
    else { b0[s] = *reinterpret_cast<const bf16x8*>(Ks + KSWZ64(r32, cb_)); b1[s] = *reinterpret_cast<const bf16x8*>(Ks + KSWZ64(32 + r32, cb_)); } } while (0)
  QK_RD(0, 0); QK_RD(1, 1); SBAR();
#pragma unroll
  for (int d0 = 0; d0 < ND; ++d0) {
    p0 = __builtin_amdgcn_mfma_f32_32x32x16_bf16(b0[d0 & 1], qr[d0], p0, 0, 0, 0);
    p1 = __builtin_amdgcn_mfma_f32_32x32x16_bf16(b1[d0 & 1], qr[d0], p1, 0, 0, 0);
    if (d0 + 2 < ND) { QK_RD(d0 + 2, d0 & 1); }
    SBAR();
  }
#undef QK_RD
}
__device__ __forceinline__ int v_st(int k, int c) { const int kk = (k & ~0xC) | ((k & 4) << 1) | ((k & 8) >> 1); return ((kk >> 3) * 4 + (c >> 5)) * 512 + ((kk & 7) * 32 + (c & 31)) * 2; }
__device__ __forceinline__ int v_rd_base(int lane) { return ((lane & 3) << 3) | (((lane >> 2) & 3) << 6) | (((lane >> 4) & 1) << 5) | (((lane >> 5) & 1) << 8); }
constexpr int v_rd_off(int d0, int ks, int half) { return d0 * 512 + ks * 4096 + half * 2048; }
template <int OFF> __device__ __forceinline__ s16x4 tr_read(int vb) {
  s16x4 r; asm volatile("ds_read_b64_tr_b16 %0, %1 offset:%2" : "=&v"(r) : "v"(vb), "i"(OFF) : "memory"); return r;
}
#define PKF(L, H) (bf16x8){L[0], L[1], L[2], L[3], H[0], H[1], H[2], H[3]}
template <int D0> __device__ __forceinline__ void pv_one(f32x16& od, int vb, bf16x8 pa0, bf16x8 pa1, bf16x8 pa2, bf16x8 pa3) {
  const s16x4 l0 = tr_read<v_rd_off(D0, 0, 0)>(vb), h0 = tr_read<v_rd_off(D0, 0, 1)>(vb), l1 = tr_read<v_rd_off(D0, 1, 0)>(vb), h1 = tr_read<v_rd_off(D0, 1, 1)>(vb);
  const s16x4 l2 = tr_read<v_rd_off(D0, 2, 0)>(vb), h2 = tr_read<v_rd_off(D0, 2, 1)>(vb), l3 = tr_read<v_rd_off(D0, 3, 0)>(vb), h3 = tr_read<v_rd_off(D0, 3, 1)>(vb);
  asm volatile("s_waitcnt lgkmcnt(0)" ::: "memory"); SBAR();
  od = __builtin_amdgcn_mfma_f32_32x32x16_bf16(pa0, PKF(l0, h0), od, 0, 0, 0);
  od = __builtin_amdgcn_mfma_f32_32x32x16_bf16(pa1, PKF(l1, h1), od, 0, 0, 0);
  od = __builtin_amdgcn_mfma_f32_32x32x16_bf16(pa2, PKF(l2, h2), od, 0, 0, 0);
  od = __builtin_amdgcn_mfma_f32_32x32x16_bf16(pa3, PKF(l3, h3), od, 0, 0, 0);
}
#define PV_RD(D0, L, H) do { L[0] = tr_read<v_rd_off(D0, 0, 0)>(vb); H[0] = tr_read<v_rd_off(D0, 0, 1)>(vb); L[1] = tr_read<v_rd_off(D0, 1, 0)>(vb); H[1] = tr_read<v_rd_off(D0, 1, 1)>(vb); \
    L[2] = tr_read<v_rd_off(D0, 2, 0)>(vb); H[2] = tr_read<v_rd_off(D0, 2, 1)>(vb); L[3] = tr_read<v_rd_off(D0, 3, 0)>(vb); H[3] = tr_read<v_rd_off(D0, 3, 1)>(vb); } while (0)
#define PV_MM(OD, L, H) do { OD = __builtin_amdgcn_mfma_f32_32x32x16_bf16(pa0, PKF(L[0], H[0]), OD, 0, 0, 0); OD = __builtin_amdgcn_mfma_f32_32x32x16_bf16(pa1, PKF(L[1], H[1]), OD, 0, 0, 0); \
    OD = __builtin_amdgcn_mfma_f32_32x32x16_bf16(pa2, PKF(L[2], H[2]), OD, 0, 0, 0); OD = __builtin_amdgcn_mfma_f32_32x32x16_bf16(pa3, PKF(L[3], H[3]), OD, 0, 0, 0); } while (0)
__device__ __forceinline__ void pv_d0(f32x16* o, int vb, bf16x8 pa0, bf16x8 pa1, bf16x8 pa2, bf16x8 pa3) {
  s16x4 la[4], ha[4], lb[4], hb[4];
  PV_RD(0, la, ha); PV_RD(1, lb, hb);
  asm volatile("s_waitcnt lgkmcnt(8)" ::: "memory"); SBAR(); PV_MM(o[0], la, ha); SBAR();
  PV_RD(2, la, ha);
  asm volatile("s_waitcnt lgkmcnt(8)" ::: "memory"); SBAR(); PV_MM(o[1], lb, hb); SBAR();
  PV_RD(3, lb, hb);
  asm volatile("s_waitcnt lgkmcnt(8)" ::: "memory"); SBAR(); PV_MM(o[2], la, ha); SBAR();
  asm volatile("s_waitcnt lgkmcnt(0)" ::: "memory"); SBAR(); PV_MM(o[3], lb, hb);
}
#undef PV_RD
#undef PV_MM
__device__ __forceinline__ float half_sum32(float x) {
  x += __shfl_xor(x, 1); x += __shfl_xor(x, 2); x += __shfl_xor(x, 4); x += __shfl_xor(x, 8); x += __shfl_xor(x, 16); return x;
}

struct KVSrc { const bf16_t* K1; const bf16_t* V1; int n1; const bf16_t* K2; const bf16_t* V2; int n2; };
struct AttnOut { bf16_t* Ob; float* Of; const float* nw; float lam, post; int pass; };
template <int DQK, int MODE, int LD2, int SM = 0>
__device__ __forceinline__ void attn_body(const bf16_t* __restrict__ Qb, const KVSrc kv, const AttnOut ao, char* lds) {
  constexpr long ldq = 5120, LD1 = 5120; constexpr int LDO = 2048, LDF = 512;
  int tid_ = threadIdx.x; asm volatile("" : "+v"(tid_));
  const int tid = tid_, wid = tid >> 6, lane = tid & 63, r32 = lane & 31, hi = lane >> 5;
  char* V_lds = lds; char* K_lds = lds + 2 * SHM_V;
  float* ws = (float*)(lds + 2 * SHM_V + 2 * SHM_K) + wid * 64; float* li_l = ws; float* al_l = ws + 32;
  float m_reg = -1e30f, l_reg = 0; f32x16 o[4] = {}; bf16x8 qr[DQK / 16];
  const bf16_t* Qw = Qb + (long)(wid * QBLK + r32) * ldq + hi * 8;
#pragma unroll
  for (int d0 = 0; d0 < DQK / 16; ++d0) qr[d0] = ld8(Qw + d0 * 16);
  const int sr = tid >> 4, sc = (tid & 15) * 8, vst0 = v_st(sr, sc), vst1 = v_st(32 + sr, sc);
  const int kr64 = tid >> 3, kc64 = (tid & 7) * 8;
  const int vb0 = (int)(uintptr_t)V_lds + v_rd_base(lane);
  struct { bf16x8 vs0, vs1, ks0, ks1; } sr_[2];
#define SLOAD(i, k0) do { const int k0_ = (k0); const bool s1_ = k0_ < kv.n1; const bf16_t* kp_ = s1_ ? kv.K1 + (long)k0_ * LD1 : kv.K2 + (long)(k0_ - kv.n1) * LD2; \
    const bf16_t* vp_ = s1_ ? kv.V1 + (long)k0_ * LD1 : kv.V2 + (long)(k0_ - kv.n1) * LD2; const long ld_ = s1_ ? LD1 : (long)LD2; \
    sr_[i].vs0 = ld8(vp_ + (long)sr * ld_ + sc); sr_[i].vs1 = ld8(vp_ + (long)(32 + sr) * ld_ + sc); \
    if constexpr (DQK == 128) { sr_[i].ks0 = ld8(kp_ + (long)sr * ld_ + sc); sr_[i].ks1 = ld8(kp_ + (long)(32 + sr) * ld_ + sc); } \
    else { sr_[i].ks0 = ld8(kp_ + (long)kr64 * ld_ + kc64); } } while (0)
#define SWRITE(b, i) do { *(bf16x8*)(V_lds + (b) * SHM_V + vst0) = sr_[i].vs0; *(bf16x8*)(V_lds + (b) * SHM_V + vst1) = sr_[i].vs1; \
    if constexpr (DQK == 128) { const int kc = sc * 2; *(bf16x8*)(K_lds + (b) * SHM_K + KSWZ(sr, kc)) = sr_[i].ks0; *(bf16x8*)(K_lds + (b) * SHM_K + KSWZ(32 + sr, kc)) = sr_[i].ks1; } \
    else { *(bf16x8*)(K_lds + (b) * SHM_K + KSWZ64(kr64, kc64 * 2)) = sr_[i].ks0; } } while (0)
#define SWAIT() do { if constexpr (DQK == 128) asm volatile("s_waitcnt vmcnt(4)" ::: "memory"); else asm volatile("s_waitcnt vmcnt(3)" ::: "memory"); } while (0)
#define RESC(a) do { if (SM != 1 && __any((a) < 1.f)) { if (hi == 0) al_l[r32] = (a); asm volatile("s_waitcnt lgkmcnt(0)" ::: "memory"); \
    _Pragma("unroll") for (int d = 0; d < 4; ++d) _Pragma("unroll") for (int r = 0; r < 16; ++r) o[d][r] *= al_l[crow(r, hi)]; } } while (0)
  f32x16 pA0, pA1, pB0, pB1; float mnA = 0.f, mnB = 0.f, alA = 1.f, alB = 1.f; bf16x8 pa0, pa1, pa2, pa3; const int NT = (kv.n1 + kv.n2) / KVBLK; (void)mnA; (void)mnB;
#define PSM(P0, P1, MN, AL) do { if constexpr (SM == 1) { _Pragma("unroll") for (int r_ = 0; r_ < 16; ++r_) P0[r_] = __builtin_amdgcn_exp2f(P0[r_]); } else partialSM<DQK, SM == 2>(P0, P1, m_reg, MN, AL); } while (0)
  constexpr int SE = 0, SO = 1;
  SLOAD(SE, 0); asm volatile("s_waitcnt vmcnt(0)" ::: "memory"); SWRITE(0, SE); __syncthreads();
  qkt<DQK>(pA0, pA1, K_lds, qr, r32, hi); PSM(pA0, pA1, mnA, alA);
  SLOAD(SO, KVBLK); if (2 < NT) SLOAD(SE, 2 * KVBLK);
  SWAIT(); SWRITE(1, SO); __syncthreads();
  for (int j = 1; j + 1 < NT; j += 2) {
    SBAR(); qkt<DQK>(pB0, pB1, K_lds + SHM_K, qr, r32, hi);
    finishSM(pA0, pA1, alA, l_reg, pa0, pa1, pa2, pa3); SBAR();
    SLOAD(SO, (j + 2) * KVBLK); SBAR();
    pv_d0(o, vb0, pa0, pa1, pa2, pa3); PSM(pB0, pB1, mnB, alB);
    __syncthreads(); SWAIT(); SWRITE(0, SE);
    RESC(alB); __syncthreads();
    SBAR(); qkt<DQK>(pA0, pA1, K_lds, qr, r32, hi);
    finishSM(pB0, pB1, alB, l_reg, pa0, pa1, pa2, pa3); SBAR();
    if (j + 3 < NT) SLOAD(SE, (j + 3) * KVBLK); SBAR();
    pv_d0(o, vb0 + (int)SHM_V, pa0, pa1, pa2, pa3); PSM(pA0, pA1, mnA, alA);
    __syncthreads(); SWAIT(); SWRITE(1, SO);
    RESC(alA); __syncthreads();
  }
  SBAR(); qkt<DQK>(pB0, pB1, K_lds + SHM_K, qr, r32, hi);
  finishSM(pA0, pA1, alA, l_reg, pa0, pa1, pa2, pa3); SBAR();
  pv_d0(o, vb0, pa0, pa1, pa2, pa3); PSM(pB0, pB1, mnB, alB);
  __syncthreads(); RESC(alB);
  finishSM(pB0, pB1, alB, l_reg, pa0, pa1, pa2, pa3); SBAR();
  pv_d0(o, vb0 + (int)SHM_V, pa0, pa1, pa2, pa3);
  if (hi == 0) li_l[r32] = l_reg; asm volatile("s_waitcnt lgkmcnt(0)" ::: "memory");
  float rli[16];
#pragma unroll
  for (int r = 0; r < 16; ++r) rli[r] = __builtin_amdgcn_rcpf(li_l[crow(r, hi)]);
  bf16_t* stg = (bf16_t*)lds + wid * (QBLK * 128);
#define O_FLUSH(Ow) do { asm volatile("s_waitcnt lgkmcnt(0)" ::: "memory"); _Pragma("unroll") for (int i_ = 0; i_ < 8; ++i_) { const int row_ = i_ * 4 + (lane >> 4), ch_ = lane & 15; \
    const u32x4 v_ = *(const u32x4*)(stg + row_ * 128 + ch_ * 8); *(u32x4*)((Ow) + (long)row_ * LDO + ch_ * 8) = v_; } } while (0)
  if constexpr (MODE == 0) {
    bf16_t* Ow = ao.Ob + (long)(wid * QBLK) * LDO;
    __syncthreads();
#pragma unroll
    for (int r = 0; r < 16; ++r) { const int orow = crow(r, hi);
#pragma unroll
      for (int d0 = 0; d0 < 4; ++d0) { const float v = o[d0][r] * rli[r]; stg[orow * 128 + d0 * 32 + r32] = (bf16_t)(cvtpk(v, v) & 0xffffu); } }
    O_FLUSH(Ow);
  } else {
    float* Fw = ao.Of + (long)(wid * QBLK) * LDF;
    if (ao.pass == 0) {
#pragma unroll
      for (int r = 0; r < 16; ++r) { const int orow = crow(r, hi);
#pragma unroll
        for (int d0 = 0; d0 < 4; ++d0) Fw[(long)orow * LDF + d0 * 32 + r32] = o[d0][r] * rli[r]; }
    } else {
      bf16_t* Ow = ao.Ob + (long)(wid * QBLK) * LDO;
      __syncthreads();
#pragma unroll
      for (int r = 0; r < 16; ++r) { const int orow = crow(r, hi); float v[4]; float ss = 0.f;
#pragma unroll
        for (int d0 = 0; d0 < 4; ++d0) { v[d0] = Fw[(long)orow * LDF + d0 * 32 + r32] - ao.lam * (o[d0][r] * rli[r]); ss += v[d0] * v[d0]; }
        ss = half_sum32(ss); const float rs = rsqrtf(ss * (1.0f / 128.0f) + 1e-6f) * ao.post;
#pragma unroll
        for (int d0 = 0; d0 < 4; ++d0) { const float y = v[d0] * rs * ao.nw[d0 * 32 + r32]; stg[orow * 128 + d0 * 32 + r32] = (bf16_t)(cvtpk(y, y) & 0xffffu); } }
      O_FLUSH(Ow);
    }
  }
#undef O_FLUSH
#undef SLOAD
#undef SWRITE
#undef SWAIT
#undef RESC
#undef PSM
}
struct ChainArgs { const bf16_t* P;   int kcol, vcol; int nchunk; int dir; float lg2;
                   const float* S0;   bf16_t* ST;   float* Sfin;   };
__device__ __forceinline__ void ret_chain(const ChainArgs a, char* lds) {
  int tid_ = threadIdx.x; asm volatile("" : "+v"(tid_));
  const int tid = tid_, wid = tid >> 6, lane = tid & 63, r32 = lane & 31, hi = lane >> 5;
  const int eb = wid >> 1, dh = wid & 1;
  char* V_lds = lds; char* K_lds = lds + 2 * SHM_V;
  const int sr = tid >> 4, sc = (tid & 15) * 8;
  f32x16 acc[2];
#pragma unroll
  for (int j = 0; j < 2; ++j)
#pragma unroll
    for (int r = 0; r < 16; ++r) acc[j][r] = 0.f;
  if (a.S0) {
#pragma unroll
    for (int j = 0; j < 2; ++j)
#pragma unroll
      for (int r = 0; r < 16; ++r) acc[j][r] = a.S0[(size_t)(32 * (2 * dh + j) + r32) * 128 + 32 * eb + crow(r, hi)]; }
  const float gC = __builtin_amdgcn_exp2f(128.f * a.lg2);
  const int vbA = (int)(uintptr_t)V_lds + v_rd_base(lane) + eb * 512, vbB = (int)(uintptr_t)K_lds + v_rd_base(lane) + (2 * dh) * 512;
  bf16x8 kq[4], vq[4];
  { const int c0 = a.dir == 0 ? 0 : a.nchunk - 1; const bf16_t* rowp = a.P + (size_t)(c0 * 128) * 5120;
#pragma unroll
    for (int q = 0; q < 4; ++q) { const int k = 32 * q + sr; kq[q] = ld8(rowp + (size_t)k * 5120 + a.kcol + sc); vq[q] = ld8(rowp + (size_t)k * 5120 + a.vcol + sc); } }
  for (int s = 0; s < a.nchunk; ++s) {
    const int c = a.dir == 0 ? s : a.nchunk - 1 - s;
    bf16_t* st = a.ST + (size_t)c * 16384;
    __syncthreads();
#pragma unroll
    for (int q = 0; q < 4; ++q) { const int k = 32 * q + sr;
      const bf16x8 kv_ = kq[q], vv_ = vq[q];
      const float f = 0.088388347648318440f * __builtin_amdgcn_exp2f((a.dir == 0 ? (float)(127 - k) : (float)k) * a.lg2);
      u32x4 w; w.x = cvtpk(bf2f((unsigned short)kv_[0]) * f, bf2f((unsigned short)kv_[1]) * f); w.y = cvtpk(bf2f((unsigned short)kv_[2]) * f, bf2f((unsigned short)kv_[3]) * f);
      w.z = cvtpk(bf2f((unsigned short)kv_[4]) * f, bf2f((unsigned short)kv_[5]) * f); w.w = cvtpk(bf2f((unsigned short)kv_[6]) * f, bf2f((unsigned short)kv_[7]) * f);
      const int off = (q >> 1) * SHM_V + v_st(32 * (q & 1) + sr, sc);
      *(u32x4*)(K_lds + off) = w; *(bf16x8*)(V_lds + off) = vv_; }
    __syncthreads();
#pragma unroll
    for (int j = 0; j < 2; ++j)
#pragma unroll
      for (int r = 0; r < 16; ++r) { const float v = acc[j][r]; st[(32 * eb + crow(r, hi)) * 128 + 32 * (2 * dh + j) + r32] = (bf16_t)(cvtpk(v, v) & 0xffffu); }
    if (s + 1 < a.nchunk) { const int cn = a.dir == 0 ? s + 1 : a.nchunk - 2 - s; const bf16_t* rowp = a.P + (size_t)(cn * 128) * 5120;
#pragma unroll
      for (int q = 0; q < 4; ++q) { const int k = 32 * q + sr; kq[q] = ld8(rowp + (size_t)k * 5120 + a.kcol + sc); vq[q] = ld8(rowp + (size_t)k * 5120 + a.vcol + sc); } }
#pragma unroll
    for (int j = 0; j < 2; ++j)
#pragma unroll
      for (int r = 0; r < 16; ++r) acc[j][r] *= gC;
#pragma unroll
    for (int tt = 0; tt < 2; ++tt) {
      s16x4 al[4], ah[4], b0l[4], b0h[4], b1l[4], b1h[4];
#define RD4(ks) do { al[ks] = tr_read<v_rd_off(0, ks, 0)>(vbA + tt * SHM_V); ah[ks] = tr_read<v_rd_off(0, ks, 1)>(vbA + tt * SHM_V); \
      b0l[ks] = tr_read<v_rd_off(0, ks, 0)>(vbB + tt * SHM_V); b0h[ks] = tr_read<v_rd_off(0, ks, 1)>(vbB + tt * SHM_V); \
      b1l[ks] = tr_read<v_rd_off(1, ks, 0)>(vbB + tt * SHM_V); b1h[ks] = tr_read<v_rd_off(1, ks, 1)>(vbB + tt * SHM_V); } while (0)
      RD4(0); RD4(1); RD4(2); RD4(3);
#undef RD4
      asm volatile("s_waitcnt lgkmcnt(0)" ::: "memory"); SBAR();
#pragma unroll
      for (int ks = 0; ks < 4; ++ks) {
        acc[0] = __builtin_amdgcn_mfma_f32_32x32x16_bf16(PKF(al[ks], ah[ks]), PKF(b0l[ks], b0h[ks]), acc[0], 0, 0, 0);
        acc[1] = __builtin_amdgcn_mfma_f32_32x32x16_bf16(PKF(al[ks], ah[ks]), PKF(b1l[ks], b1h[ks]), acc[1], 0, 0, 0); }
    }
  }
  if (a.Sfin) {
#pragma unroll
    for (int j = 0; j < 2; ++j)
#pragma unroll
      for (int r = 0; r < 16; ++r) a.Sfin[(size_t)(32 * (2 * dh + j) + r32) * 128 + 32 * eb + crow(r, hi)] = acc[j][r];
  }
}
struct RetCArgs { const bf16_t* P;   int qcol, kcol, vcol, gcol; float lg2f, lg2b; const bf16_t* STf; const bf16_t* STb;
                  const float* gnw; bf16_t* O;   };
__device__ __forceinline__ void ret_c(const RetCArgs a, char* lds) {
  int tid_ = threadIdx.x; asm volatile("" : "+v"(tid_));
  const int tid = tid_, wid = tid >> 6, lane = tid & 63, r32 = lane & 31, hi = lane >> 5;
  char* V_lds = lds; char* K_lds = lds + 2 * SHM_V;
  const int cw = wid >> 2, ipos = 32 * (wid & 3) + r32;
  const int sr = tid >> 4, sc = (tid & 15) * 8;
  const int vb0 = (int)(uintptr_t)V_lds + v_rd_base(lane);
  bf16x8 qr[8];
  const bf16_t* Qw = a.P + (size_t)(wid * 32 + r32) * 5120 + a.qcol + hi * 8;
#pragma unroll
  for (int d0 = 0; d0 < 8; ++d0) qr[d0] = ld8(Qw + d0 * 16);
  f32x16 o[4] = {};
  for (int ch = 0; ch < 2; ++ch) {
    const bf16_t* rowp = a.P + (size_t)(ch * 128) * 5120;
    __syncthreads();
#pragma unroll
    for (int q = 0; q < 4; ++q) { const int k = 32 * q + sr;
      const bf16x8 kv_ = ld8(rowp + (size_t)k * 5120 + a.kcol + sc), vv_ = ld8(rowp + (size_t)k * 5120 + a.vcol + sc);
      *(bf16x8*)(K_lds + (q >> 1) * SHM_K + KSWZ(32 * (q & 1) + sr, sc * 2)) = kv_;
      *(bf16x8*)(V_lds + (q >> 1) * SHM_V + v_st(32 * (q & 1) + sr, sc)) = vv_; }
    __syncthreads();
    if (cw == ch) {
#pragma unroll
      for (int tt = 0; tt < 2; ++tt) {
        f32x16 p0, p1; qkt<128>(p0, p1, K_lds + tt * SHM_K, qr, r32, hi);
        int ip_ = ipos, hi_ = hi; asm volatile("" : "+v"(ip_), "+v"(hi_));
#pragma unroll
        for (int r = 0; r < 16; ++r) {
          const int j0 = 64 * tt + crow(r, hi_), d0_ = ip_ - j0, d1_ = d0_ - 32;
          const float f0 = d0_ > 0 ? __builtin_amdgcn_exp2f((float)d0_ * a.lg2f) : (d0_ < 0 ? __builtin_amdgcn_exp2f((float)(-d0_) * a.lg2b) : 2.0f);
          const float f1 = d1_ > 0 ? __builtin_amdgcn_exp2f((float)d1_ * a.lg2f) : (d1_ < 0 ? __builtin_amdgcn_exp2f((float)(-d1_) * a.lg2b) : 2.0f);
          p0[r] *= f0 * 0.088388347648318440f; p1[r] *= f1 * 0.088388347648318440f; }
        bf16x8 pa0, pa1, pa2, pa3; PK4(p0, 0, pa0); PK4(p0, 8, pa1); PK4(p1, 0, pa2); PK4(p1, 8, pa3);
        pv_d0(o, vb0 + tt * SHM_V, pa0, pa1, pa2, pa3);
      }
    }
  }
#pragma unroll
  for (int dir = 0; dir < 2; ++dir) {
    const float rs = dir == 0 ? __builtin_amdgcn_exp2f((float)(ipos + 1) * a.lg2f) : __builtin_amdgcn_exp2f((float)(128 - ipos) * a.lg2b);
    const bf16_t* S = (dir == 0 ? a.STf : a.STb) + (size_t)cw * 16384 + (size_t)r32 * 128 + hi * 8;
#pragma unroll
    for (int d0 = 0; d0 < 8; ++d0) {
      const bf16x8 q_ = qr[d0]; u32x4 w;
      w.x = cvtpk(bf2f((unsigned short)q_[0]) * rs, bf2f((unsigned short)q_[1]) * rs); w.y = cvtpk(bf2f((unsigned short)q_[2]) * rs, bf2f((unsigned short)q_[3]) * rs);
      w.z = cvtpk(bf2f((unsigned short)q_[4]) * rs, bf2f((unsigned short)q_[5]) * rs); w.w = cvtpk(bf2f((unsigned short)q_[6]) * rs, bf2f((unsigned short)q_[7]) * rs);
      const bf16x8 qs = *reinterpret_cast<bf16x8*>(&w);
#pragma unroll
      for (int eb = 0; eb < 4; ++eb) { const bf16x8 b = ld8(S + (size_t)eb * 32 * 128 + d0 * 16); o[eb] = __builtin_amdgcn_mfma_f32_32x32x16_bf16(qs, b, o[eb], 0, 0, 0); }
    }
  }
#pragma unroll
  for (int r = 0; r < 16; ++r) {
    const int row = wid * 32 + crow(r, hi);
    float s = (o[0][r] + o[1][r]) + (o[2][r] + o[3][r]); s = half_sum32(s); const float mean = s * (1.0f / 128.0f);
    float q = 0.f;
#pragma unroll
    for (int eb = 0; eb < 4; ++eb) { const float d = o[eb][r] - mean; q += d * d; }
    q = half_sum32(q); const float rstd = rsqrtf(q * (1.0f / 128.0f) + 1e-6f);
#pragma unroll
    for (int eb = 0; eb < 4; ++eb) { const int col = eb * 32 + r32;
      const float g = bf2f(a.P[(size_t)row * 5120 + a.gcol + col]);
      const float y = (o[eb][r] - mean) * rstd * a.gnw[col] * (g * __builtin_amdgcn_rcpf(1.0f + __builtin_amdgcn_exp2f(-1.4426950408889634f * g)));
      a.O[(size_t)row * 2048 + col] = (bf16_t)(cvtpk(y, y) & 0xffffu); }
  }
}
#undef KSWZ
#undef KSWZ64
#undef SBAR
#undef PK4
#undef PKF
}
constexpr int DM = 2048, M_P = 4096, M_S = 32768, MTOK = M_P + M_S, DFF = 5632, NFF = 11264, NIN = 5120, NMODC = 18432, NCOND = 9;
constexpr int C_RQ = 0, C_RK = 512, C_RV = 1024, C_RG = 1536, C_GQ = 2048, C_GK = 3072, C_GV = 3328, C_DQ = 3584, C_DK = 4096, C_DV = 4608;
constexpr float EPS = 1e-6f;
constexpr size_t MiB = 1u << 20;
constexpr size_t CTL_ZERO_BYTES = 1 * MiB;
constexpr size_t WS_TAB = 1 * MiB;
constexpr size_t WS_CACHE = 4 * MiB;
constexpr size_t WS_W = 16 * MiB;
constexpr size_t W_LAYER = 160 * MiB, W_WI = 0, W_WO = 88 * MiB, W_WIN = 132 * MiB, W_WOUT = 152 * MiB;
constexpr size_t WS_XN = WS_W + 2 * W_LAYER;
constexpr size_t WS_ACT = WS_XN + 144 * MiB;
constexpr size_t WS_ST = WS_ACT + 396 * MiB;
constexpr size_t WS_DF = WS_ST + 72 * MiB;
constexpr size_t WS_XNB = WS_DF + 72 * MiB;
constexpr size_t WS_SB = WS_XNB + 144 * MiB;
constexpr size_t SB_LAYER = 9 * (11264 + 5120 + 11264), SB_J1 = 9 * 11264, SB_J2 = 9 * (11264 + 5120);
constexpr size_t WS_RS = WS_SB + 2 * MiB;
constexpr size_t WS_CTL = WS_RS + 2 * MiB;
constexpr size_t WS_Q = WS_CTL + CTL_ZERO_BYTES;
constexpr size_t Q_SW = 256 * 1024, Q_SW2 = 512 * 1024, Q_SW4 = 832 * 1024, Q_ACT = 960 * 1024  , W_WINQ = 22 * MiB;
constexpr size_t WS_A8B = WS_Q + 1 * MiB;
constexpr size_t WS_END = WS_A8B + 198 * MiB;
constexpr int TB_MOD = 0, TB_COSG = 2 * 9 * 18432, TB_SING = TB_COSG + 64 * 32, TB_COSD = TB_SING + 64 * 32, TB_SIND = TB_COSD + 64 * 16, TB_SCAL = TB_SIND + 64 * 16;
constexpr int CW_BAR = 4096;
constexpr size_t CTL_RAW2 = 960 * 1024;
constexpr size_t CTL_AMAX = 64 * 1024;
constexpr size_t O_X = 0, O_STATE = 75497472, O_GK = 79691776, O_GV = 81788928, O_DK = 83886080, O_DV = 88080384, O_END = 92274688;
constexpr int LDS_BYTES = 147456, MISC_OFF = 131072 + 320;

typedef att::bf16_t bf16;
#define GAS __attribute__((address_space(1)))
#define LAS __attribute__((address_space(3)))
typedef unsigned v4u __attribute__((ext_vector_type(4)));
typedef float f32x4 __attribute__((ext_vector_type(4)));
typedef short bf16x8 __attribute__((ext_vector_type(8)));
typedef GAS unsigned gu32;
typedef GAS unsigned long long gu64;
#define RLX_AGENT __ATOMIC_RELAXED, __HIP_MEMORY_SCOPE_AGENT
#define LDS_WAIT() asm volatile("s_waitcnt lgkmcnt(0)" ::: "memory")
#define VM_WAIT() asm volatile("s_waitcnt vmcnt(0)" ::: "memory")
__device__ __forceinline__ unsigned long long rt() { return __builtin_amdgcn_s_memrealtime(); }
__device__ __forceinline__ unsigned f2bf(float f) { unsigned u = __builtin_bit_cast(unsigned, f); return (u + 0x7fffu + ((u >> 16) & 1u)) >> 16; }
__device__ __forceinline__ unsigned pk2(float lo, float hi) { return f2bf(lo) | (f2bf(hi) << 16); }
#define XB_TMO      128
#define XB_XCNT(j)  (256  + 64 * (j))
#define XB_XSUB(j)  (1280 + 64 * (j))
#define XB_XGEN(j)  (2304 + 64 * (j))
#define XB_TOP      3328
#define XB_TOPGEN   3392
#define XCD_BAR_WORDS 3456
#define XB_SPIN_CAP (1u << 18)

__device__ __forceinline__ unsigned xb_ld(unsigned* p)              { return __hip_atomic_load(p, __ATOMIC_RELAXED, __HIP_MEMORY_SCOPE_AGENT); }
__device__ __forceinline__ unsigned xb_add(unsigned* p, unsigned v) { return __hip_atomic_fetch_add(p, v, __ATOMIC_RELAXED, __HIP_MEMORY_SCOPE_AGENT); }
__device__ __forceinline__ unsigned xb_xcc_id() { return (unsigned)__builtin_amdgcn_s_getreg((3 << 11) | 20) & 0xFu; }
#define XB_SPIN(cond, bar) do { unsigned _sp = 0; while (cond) { __builtin_amdgcn_s_sleep(1); \
    if ((++_sp & 255u) == 0u) { if (xb_ld(&(bar)[XB_TMO])) break; if (_sp > XB_SPIN_CAP) { atomicAdd(&(bar)[XB_TMO], 1u); break; } } } } while (0)

struct XcdBarrier {
    unsigned* bar; unsigned x;
    volatile LAS unsigned* st;
};

__device__ __forceinline__ XcdBarrier xcd_barrier_post(unsigned* bar, volatile LAS unsigned* st) {
    XcdBarrier b; b.bar = bar; b.x = xb_xcc_id(); b.st = st;
    if (threadIdx.x == 0) (void)xb_add(&bar[XB_XCNT(b.x)], 1u);
    return b;
}
__device__ __forceinline__ void xcd_barrier_complete(unsigned* bar, unsigned x, unsigned& nloc, unsigned& nx) {
    const unsigned G = gridDim.x * gridDim.y * gridDim.z;
    unsigned sum, cnt, mine, sp = 0u;
    for (;;) {
        sum = 0u; cnt = 0u; mine = 0u;
#pragma unroll
        for (unsigned j = 0; j < 16; ++j) { const unsigned c = xb_ld(&bar[XB_XCNT(j)]); sum += c; cnt += (c > 0u) ? 1u : 0u; mine = (j == x) ? c : mine; }
        if (sum == G) break;
        __builtin_amdgcn_s_sleep(1);
        if ((++sp & 255u) == 0u) { if (xb_ld(&bar[XB_TMO])) break; if (sp > XB_SPIN_CAP) { atomicAdd(&bar[XB_TMO], 1u); break; } }
    }
    nloc = mine > 0u ? mine : 1u; nx = cnt > 0u ? cnt : 1u;
}

__device__ __forceinline__ void xcd_barrier(const XcdBarrier& b) {
    asm volatile("s_waitcnt vmcnt(0)" ::: "memory");
    __syncthreads();
    if (threadIdx.x == 0) {
        unsigned* bar = b.bar;
        __builtin_amdgcn_s_waitcnt(0);
        unsigned nloc = b.st[0], nx = b.st[1];
        if (nloc == 0u) { xcd_barrier_complete(bar, b.x, nloc, nx); b.st[0] = nloc; b.st[1] = nx; }
        const unsigned old = xb_add(&bar[XB_XSUB(b.x)], 1u);
        const unsigned gen = old / nloc;
        if (old + 1u == (gen + 1u) * nloc) {
            __builtin_amdgcn_fence(__ATOMIC_RELEASE, "agent");
            asm volatile("s_waitcnt vmcnt(0)" ::: "memory");
            const unsigned og = xb_add(&bar[XB_TOP], 1u);
            const unsigned tg = og / nx;
            if (og + 1u == (tg + 1u) * nx) xb_add(&bar[XB_TOPGEN], 1u);
            else XB_SPIN(xb_ld(&bar[XB_TOPGEN]) == tg, bar);
            __builtin_amdgcn_fence(__ATOMIC_ACQUIRE, "agent");
            xb_add(&bar[XB_XGEN(b.x)], 1u);
            asm volatile("s_waitcnt vmcnt(0)" ::: "memory");
        } else {
            XB_SPIN(xb_ld(&bar[XB_XGEN(b.x)]) == gen, bar);
            __builtin_amdgcn_fence(__ATOMIC_ACQUIRE, "agent");
            asm volatile("s_waitcnt vmcnt(0)" ::: "memory");
        }
    }
    __syncthreads();
}
__device__ __forceinline__ float wave_sum(float v) {
#pragma unroll
    for (int o = 1; o < 64; o <<= 1) v += __shfl_xor(v, o);
    return v;
}
__device__ __forceinline__ unsigned pkbf(float lo, float hi) { return pg8::cvt_pk_bf16(lo, hi); }
__device__ __forceinline__ float bf2f(unsigned short b) { return __uint_as_float((unsigned)b << 16); }
__device__ __forceinline__ void transpose_item(const float* W, int ldn, bf16* WT, int K, int k0, int srccol0, int dstrow0, LAS float* scr, int lane, bool qf = false) {
#pragma unroll 8
    for (int i = 0; i < 32; ++i) { const int kk = 2 * i + (lane >> 5); scr[kk * 33 + (lane & 31)] = W[(size_t)(k0 + kk) * ldn + srccol0 + (lane & 31)]; }
    LDS_WAIT(); asm volatile("" ::: "memory");
    const int c = lane & 7;
#pragma unroll
    for (int j = 0; j < 4; ++j) { const int n = (lane >> 3) + 8 * j; const LAS float* s = scr + (8 * c) * 33 + n;
        v4u o; if (qf) { o.x = pkbf(qm(s[0 * 33]), qm(s[1 * 33])); o.y = pkbf(qm(s[2 * 33]), qm(s[3 * 33])); o.z = pkbf(qm(s[4 * 33]), qm(s[5 * 33])); o.w = pkbf(qm(s[6 * 33]), qm(s[7 * 33])); }
        else { o.x = pkbf(s[0 * 33], s[1 * 33]); o.y = pkbf(s[2 * 33], s[3 * 33]); o.z = pkbf(s[4 * 33], s[5 * 33]); o.w = pkbf(s[6 * 33], s[7 * 33]); }
        const int dr = dstrow0 + n; *(GAS v4u*)(WT + ((size_t)((dr >> 8) * (K >> 6) + (k0 >> 6)) * 256 + (dr & 255)) * 64 + 8 * c) = o; }
    LDS_WAIT(); asm volatile("" ::: "memory");
}
template <class INP> __device__ __forceinline__ void absmax_item(const INP& inp, unsigned char* ws, int t, LAS float* red, int tid) {
    const int col = tid & 127, kq = tid >> 7;
    const float* src; size_t ld; int kb, kn, kind, mat, cb;
    if (t < 352) { kind = 0; mat = t / 88; cb = t % 88; src = inp[12] + (size_t)mat * DM * NFF + 128 * cb + col; ld = NFF; kb = 512 * kq; kn = 512; }
    else if (t < 432) { t -= 352; kind = 1; mat = t / 40; cb = t % 40; src = inp[14] + (size_t)mat * DM * NIN + 128 * cb + col; ld = NIN; kb = 512 * kq; kn = 512; }
    else { t -= 432; kind = 2; mat = t >> 6; cb = (t & 63) >> 2; src = inp[13] + (size_t)mat * DFF * DM + 128 * cb + col; ld = DM; kb = 1408 * (t & 3) + 352 * kq; kn = 352; }
    float mx = 0.f;
    for (int k = kb; k < kb + kn; k += 8) { float w[8];
#pragma unroll
        for (int u = 0; u < 8; ++u) w[u] = src[(size_t)(k + u) * ld];
#pragma unroll
        for (int u = 0; u < 8; ++u) mx = fmaxf(mx, fabsf(w[u])); }
    red[kq * 128 + col] = mx;
    __syncthreads();
    if (tid < 128) { const float m4 = fmaxf(fmaxf(red[tid], red[128 + tid]), fmaxf(red[256 + tid], red[384 + tid])); const int s0 = 128 * cb + tid;
        if (kind == 0) { const int brow = s0 < DFF ? (s0 / 128) * 256 + (s0 % 128) : ((s0 - DFF) / 128) * 256 + 128 + ((s0 - DFF) % 128);
            ((float*)(ws + WS_Q + Q_SW))[(size_t)mat * NFF + brow] = fmaxf(m4, 1e-30f) * (1.0f / 127.0f); }
        else if (kind == 1) ((float*)(ws + WS_Q + Q_SW4))[(size_t)mat * NIN + s0] = fmaxf(m4, 1e-30f) * (1.0f / 127.0f);
        else atomicMax((unsigned*)(ws + WS_CTL + CTL_RAW2) + (size_t)mat * DM + s0, __float_as_uint(m4)); }
    __syncthreads();
}
template <class INP> __device__ __forceinline__ void prologue(const INP& inp, unsigned char* ws, LAS unsigned char* lds, int G, int wg, int tid) {
    const int lane = tid & 63, wave = __builtin_amdgcn_readfirstlane(tid >> 6);
    float* tab = (float*)(ws + WS_TAB);
    {
        LAS float* sc = (LAS float*)lds;
        LAS float* red = sc + NCOND * DM;
        bool have = false;
        for (int it = wg; it < 976; it += G) {
            if (it >= 288) { absmax_item(inp, ws, it - 288, (LAS float*)(lds + 98304), tid); continue; }
            if (!have) { for (int i = tid; i < NCOND * DM; i += 512) { const int cd = i >> 11, k = i & 2047; const float v = cd == 0 ? inp[8][k] : inp[2][(cd - 1) * DM + k];
                              sc[i] = v / (1.0f + __expf(-v)); } have = true; __syncthreads(); }
            const int l = it / 144, cb = it % 144, col = tid & 127, g = tid >> 7;
            const float* W = inp[9] + (size_t)l * DM * NMODC + 128 * cb + col;
            float acc[NCOND];
#pragma unroll
            for (int c = 0; c < NCOND; ++c) acc[c] = 0.f;
            for (int k = 512 * g; k < 512 * g + 512; k += 8) {
                float w[8];
#pragma unroll
                for (int u = 0; u < 8; ++u) w[u] = W[(size_t)(k + u) * NMODC];
#pragma unroll
                for (int c = 0; c < NCOND; ++c) { const f32x4 s0 = *(const LAS f32x4*)(sc + c * DM + k), s1 = *(const LAS f32x4*)(sc + c * DM + k + 4);
                    acc[c] += (s0[0] * w[0] + s0[1] * w[1]) + (s0[2] * w[2] + s0[3] * w[3]) + (s1[0] * w[4] + s1[1] * w[5]) + (s1[2] * w[6] + s1[3] * w[7]); }
            }
#pragma unroll
            for (int c = 0; c < NCOND; ++c) red[(g * NCOND + c) * 128 + col] = acc[c];
            __syncthreads();
            for (int i = tid; i < NCOND * 128; i += 512) { const int c = i >> 7, cc = i & 127;
                const float s = ((red[(0 * NCOND + c) * 128 + cc] + red[(1 * NCOND + c) * 128 + cc]) + red[(2 * NCOND + c) * 128 + cc]) + red[(3 * NCOND + c) * 128 + cc];
                tab[TB_MOD + ((size_t)l * NCOND + c) * NMODC + 128 * cb + cc] = s + inp[10][(size_t)l * NMODC + 128 * cb + cc]; }
            __syncthreads();
        }
        __syncthreads();
    }
    if (wg == 0) {
        for (int i = tid; i < 64 * 32; i += 512) { const int pos = i >> 5, f = i & 31; const double inv = pow(10000.0, -(double)(2 * f) / 64.0), a = (double)pos * inv;
            tab[TB_COSG + i] = (float)cos(a); tab[TB_SING + i] = (float)sin(a); }
        for (int i = tid; i < 64 * 16; i += 512) { const int pos = i >> 4, f = i & 15; const double inv = pow(10000.0, -(double)(2 * f) / 32.0), a = (double)pos * inv;
            tab[TB_COSD + i] = (float)cos(a); tab[TB_SIND + i] = (float)sin(a); }
        if (tid < 2) { const int l = tid; const float* dl = inp[19] + l * 256; double s01 = 0.0, s23 = 0.0;
            for (int i = 0; i < 64; ++i) { s01 += (double)dl[i] * (double)dl[64 + i]; s23 += (double)dl[128 + i] * (double)dl[192 + i]; }
            const double li = 0.8 - 0.6 * exp(-0.3 * (double)l);
            tab[TB_SCAL + 16 * l + 0] = (float)(exp(s01) - exp(s23) + li); tab[TB_SCAL + 16 * l + 1] = (float)(1.0 - li); }
        if (tid >= 128 && tid < 130) { const int l = tid - 128; const float* w = inp[18] + l * 256; float mq = 0.f, mk = 0.f;
            for (int i = 0; i < 128; ++i) { mq = fmaxf(mq, fabsf(w[i])); mk = fmaxf(mk, fabsf(w[128 + i])); }
            tab[TB_SCAL + 16 * l + 10] = (mq * mk * 11.313708f * 1.4426950f < 60.0f) ? 1.0f : 0.0f; }
        if (tid >= 64 && tid < 80) { const int i = tid - 64, l = i >> 3, j = i & 7; const double x = (double)inp[16][l * 8 + j];
            tab[TB_SCAL + 16 * l + 2 + j] = (float)(-log1p(exp(-x)) * 1.4426950408889634); }
    }
    {
        bf16* cb = (bf16*)(ws + WS_CACHE);
        const long gt = (long)wg * 512 + tid, GT = (long)G * 512;
        for (int t = 0; t < 4; ++t) { const float* src = inp[4 + t]; const long n8 = (t < 2 ? 1048576 : 2097152) / 8; bf16* dst = cb + (t == 0 ? 0 : t == 1 ? 1048576 : t == 2 ? 2097152 : 4194304);
            for (long i = gt; i < n8; i += GT) { const f32x4 a = *(const f32x4*)(src + i * 8), b = *(const f32x4*)(src + i * 8 + 4);
                v4u o; o.x = pkbf(a[0], a[1]); o.y = pkbf(a[2], a[3]); o.z = pkbf(b[0], b[1]); o.w = pkbf(b[2], b[3]); *(v4u*)(dst + i * 8) = o; } }
    }
    {
        LAS float* scr = (LAS float*)(lds + wave * 16384);
        const int gw = wg * 8 + wave, NGW = G * 8;
        for (int it = gw; it < 81920; it += NGW) {
            const int l = it / 40960; int r = it % 40960;
            bf16* WL = (bf16*)(ws + WS_W + (size_t)l * W_LAYER);
            if (r < 22528) continue;
            if (false) { const int f = r / 11264, q = r % 11264, kb = q / 352, nb = q % 352, s0 = 32 * nb;
                const int drow = s0 < DFF ? (s0 / 128) * 256 + (s0 % 128) : ((s0 - DFF) / 128) * 256 + 128 + ((s0 - DFF) % 128);
                transpose_item(inp[12] + (size_t)(l * 2 + f) * DM * NFF, NFF, WL + (W_WI + (size_t)f * 44 * MiB) / 2, DM, 64 * kb, s0, drow, scr, lane, true); continue; }
            r -= 22528;
            if (r < 11264) continue;
            if (false) { const int f = r / 5632, q = r % 5632, kb = q / 64, nb = q % 64;
                transpose_item(inp[13] + (size_t)(l * 2 + f) * DFF * DM, DM, WL + (W_WO + (size_t)f * 22 * MiB) / 2, DFF, 64 * kb, 32 * nb, 32 * nb, scr, lane, true); continue; }
            r -= 11264;
            if (r < 5120) { const int kb = r / 160, nb = r % 160;
                transpose_item(inp[14] + (size_t)l * DM * NIN, NIN, WL + W_WIN / 2, DM, 64 * kb, 32 * nb, 32 * nb, scr, lane); continue; }
            r -= 5120;
            { const int kb = r / 64, nb = r % 64;
                transpose_item(inp[15] + (size_t)l * DM * DM, DM, WL + W_WOUT / 2, DM, 64 * kb, 32 * nb, 32 * nb, scr, lane); }
        }
    }
}
template <class INP> __device__ __forceinline__ void prologue_b(const INP& inp, unsigned char* ws, LAS unsigned char* lds, int G, int wg, int tid) {
    const int lane = tid & 63, wave = __builtin_amdgcn_readfirstlane(tid >> 6);
    LAS float* scr = (LAS float*)(lds + wave * 16384);
    const float* swv = (const float*)(ws + WS_Q + Q_SW);
    const int gw = wg * 8 + wave, NGW = G * 8;
    const float* swv4 = (const float*)(ws + WS_Q + Q_SW4);
    if (wg < 4) {
        float sm = 0.f; for (int i = tid; i < NFF; i += 512) sm += swv[(size_t)wg * NFF + i];
#pragma unroll
        for (int o = 1; o < 64; o <<= 1) sm += __shfl_xor(sm, o);
        LAS float* red = (LAS float*)(lds + 131072);
        if (lane == 0) red[wave] = sm;
        __syncthreads();
        if (tid == 0) { float t = 0.f; for (int i = 0; i < 8; ++i) t += red[i];
            const float sg = t * (127.0f / (float)NFF) * (1.0f / 3.6f) * 45.254834f;
            const float h0 = fmaxf(fmaxf(sg * sg, sg), 1e-20f); const float sc = exp2f(1.0f - rintf(log2f(h0)));
            float* qa = (float*)(ws + WS_Q + Q_ACT) + 2 * wg; qa[0] = sc; qa[1] = 1.0f / sc; }
        __syncthreads();
    }
    for (int it = gw; it < 10240; it += NGW) {
        const int l = it / 5120, q = it % 5120, kb = q / 160, nb = q % 160, s0 = 32 * nb, k0 = 64 * kb;
        const float* W = inp[14] + (size_t)l * DM * NIN;
        unsigned char* WQ = ws + WS_W + (size_t)l * W_LAYER + W_WINQ;
#pragma unroll 8
        for (int i = 0; i < 32; ++i) { const int kk = 2 * i + (lane >> 5); scr[kk * 33 + (lane & 31)] = W[(size_t)(k0 + kk) * NIN + s0 + (lane & 31)]; }
        LDS_WAIT(); asm volatile("" ::: "memory");
        const int c = lane & 7;
#pragma unroll
        for (int j = 0; j < 4; ++j) { const int n = (lane >> 3) + 8 * j, dr = s0 + n; const LAS float* sp = scr + (8 * c) * 33 + n;
            const float inv = 1.0f / swv4[(size_t)l * NIN + dr];
            unsigned lo = 0u, hi = 0u;
#pragma unroll
            for (int e = 0; e < 4; ++e) { lo |= ((unsigned)(__float2int_rn(sp[e * 33] * inv)) & 0xffu) << (8 * e); hi |= ((unsigned)(__float2int_rn(sp[(4 + e) * 33] * inv)) & 0xffu) << (8 * e); }
            const int kk = k0 + 8 * c;
            uint2 o; o.x = lo; o.y = hi;
            *(uint2*)(WQ + ((size_t)((dr >> 8) * (DM >> 7) + (kk >> 7)) * 256 + (dr & 255)) * 128 + (kk & 127)) = o; }
        LDS_WAIT(); asm volatile("" ::: "memory");
    }
    const unsigned* raw2 = (const unsigned*)(ws + WS_CTL + CTL_RAW2);
    for (int i = wg * 512 + tid; i < 4 * DM; i += G * 512) ((float*)(ws + WS_Q + Q_SW2))[i] = fmaxf(__uint_as_float(raw2[i]), 1e-30f) * (1.0f / 240.0f);
    for (int it = gw; it < 22528; it += NGW) {
        const int mat = it / 5632, q = it % 5632, kb = q / 64, nb = q % 64, s0 = 32 * nb, k0 = 64 * kb, l = mat >> 1, f = mat & 1;
        const float* W = inp[13] + (size_t)mat * DFF * DM;
        unsigned char* WQ = ws + WS_W + (size_t)l * W_LAYER + W_WO + (size_t)f * 22 * MiB;
#pragma unroll 8
        for (int i = 0; i < 32; ++i) { const int kk = 2 * i + (lane >> 5); scr[kk * 33 + (lane & 31)] = W[(size_t)(k0 + kk) * DM + s0 + (lane & 31)]; }
        LDS_WAIT(); asm volatile("" ::: "memory");
        const int c = lane & 7;
#pragma unroll
        for (int j = 0; j < 4; ++j) { const int n = (lane >> 3) + 8 * j, dr = s0 + n; const LAS float* sp = scr + (8 * c) * 33 + n;
            const float inv = 240.0f / fmaxf(__uint_as_float(raw2[(size_t)mat * DM + dr]), 1e-30f);
            unsigned lo = __builtin_amdgcn_cvt_pk_fp8_f32(sp[0] * inv, sp[33] * inv, 0, false); lo = __builtin_amdgcn_cvt_pk_fp8_f32(sp[2 * 33] * inv, sp[3 * 33] * inv, lo, true);
            unsigned hi = __builtin_amdgcn_cvt_pk_fp8_f32(sp[4 * 33] * inv, sp[5 * 33] * inv, 0, false); hi = __builtin_amdgcn_cvt_pk_fp8_f32(sp[6 * 33] * inv, sp[7 * 33] * inv, hi, true);
            const int kk = k0 + 8 * c;
            uint2 o; o.x = lo; o.y = hi;
            *(uint2*)(WQ + ((size_t)((dr >> 8) * (DFF >> 7) + (kk >> 7)) * 256 + (dr & 255)) * 128 + (kk & 127)) = o; }
        LDS_WAIT(); asm volatile("" ::: "memory");
    }
    for (int it = gw; it < 45056; it += NGW) {
        const int mat = it / 11264, q = it % 11264, kb = q / 352, nb = q % 352, s0 = 32 * nb, k0 = 64 * kb, l = mat >> 1, f = mat & 1;
        const int drow = s0 < DFF ? (s0 / 128) * 256 + (s0 % 128) : ((s0 - DFF) / 128) * 256 + 128 + ((s0 - DFF) % 128);
        const float* W = inp[12] + (size_t)mat * DM * NFF;
        unsigned char* WQ = ws + WS_W + (size_t)l * W_LAYER + W_WI + (size_t)f * 44 * MiB;
#pragma unroll 8
        for (int i = 0; i < 32; ++i) { const int kk = 2 * i + (lane >> 5); scr[kk * 33 + (lane & 31)] = W[(size_t)(k0 + kk) * NFF + s0 + (lane & 31)]; }
        LDS_WAIT(); asm volatile("" ::: "memory");
        const int c = lane & 7;
#pragma unroll
        for (int j = 0; j < 4; ++j) { const int n = (lane >> 3) + 8 * j, dr = drow + n; const LAS float* sp = scr + (8 * c) * 33 + n;
            const float inv = 1.0f / swv[(size_t)mat * NFF + dr];
            unsigned lo = 0u, hi = 0u;
#pragma unroll
            for (int e = 0; e < 4; ++e) { lo |= ((unsigned)(__float2int_rn(sp[e * 33] * inv)) & 0xffu) << (8 * e); hi |= ((unsigned)(__float2int_rn(sp[(4 + e) * 33] * inv)) & 0xffu) << (8 * e); }
            const int kk = k0 + 8 * c;
            uint2 o; o.x = lo; o.y = hi;
            *(uint2*)(WQ + ((size_t)((dr >> 8) * (DM >> 7) + (kk >> 7)) * 256 + (dr & 255)) * 128 + (kk & 127)) = o; }
        LDS_WAIT(); asm volatile("" ::: "memory");
    }
}
__device__ __forceinline__ void quant_act_phase(const bf16* ACT, unsigned char* A8, float* sa, int G, int wg, int tid) {
    const int lane = tid & 63, wave = tid >> 6, gw = wg * 8 + wave, NGW = G * 8;
    for (int m = gw; m < MTOK; m += NGW) {
        const bf16* ar = ACT + (size_t)m * DFF;
        v4u v[11]; float mx = 0.f;
#pragma unroll
        for (int j = 0; j < 11; ++j) v[j] = *(const v4u*)(ar + 512 * j + 8 * lane);
#pragma unroll
        for (int j = 0; j < 11; ++j) { const unsigned w4[4] = {v[j].x, v[j].y, v[j].z, v[j].w};
#pragma unroll
            for (int e = 0; e < 4; ++e) mx = fmaxf(mx, fmaxf(fabsf(__uint_as_float(w4[e] << 16)), fabsf(__uint_as_float(w4[e] & 0xffff0000u)))); }
#pragma unroll
        for (int o = 1; o < 64; o <<= 1) mx = fmaxf(mx, __shfl_xor(mx, o));
        mx = fmaxf(mx, 1e-30f);
        if (lane == 0) sa[m] = mx * (1.0f / 127.0f);
        const float inv = 127.0f / mx; unsigned char* orow = A8 + (size_t)m * DFF;
#pragma unroll
        for (int j = 0; j < 11; ++j) { const unsigned w4[4] = {v[j].x, v[j].y, v[j].z, v[j].w}; unsigned o2[2] = {0u, 0u};
#pragma unroll
            for (int e = 0; e < 4; ++e) { const unsigned lo = (unsigned)__float2int_rn(__uint_as_float(w4[e] << 16) * inv) & 0xffu, hi = (unsigned)__float2int_rn(__uint_as_float(w4[e] & 0xffff0000u) * inv) & 0xffu;
                o2[e >> 1] |= (lo | (hi << 8)) << (16 * (e & 1)); }
            uint2 ov; ov.x = o2[0]; ov.y = o2[1]; *(uint2*)(orow + 512 * j + 8 * lane) = ov; }
    }
}
__device__ __forceinline__ void quant_xs_phase(const bf16* XS, const unsigned* amax, unsigned char* A8, float* sa, int G, int wg, int tid, int m_begin = 0) {
    const int lane = tid & 63, wave = tid >> 6, gw = wg * 8 + wave, NGW = G * 8;
    for (int m0 = m_begin + 2 * gw; m0 < MTOK; m0 += 2 * NGW) {
        v4u v[2][4]; float mx[2];
#pragma unroll
        for (int r = 0; r < 2; ++r) { const bf16* xr = XS + (size_t)(m0 + r) * DM; mx[r] = fmaxf(__uint_as_float(amax[m0 + r]), 1e-30f);
#pragma unroll
            for (int j = 0; j < 4; ++j) v[r][j] = *(const v4u*)(xr + 512 * j + 8 * lane); }
#pragma unroll
        for (int r = 0; r < 2; ++r) { const float inv = 127.0f / mx[r]; unsigned char* orow = A8 + (size_t)(m0 + r) * DM; if (lane == 0) sa[m0 + r] = mx[r] * (1.0f / 127.0f);
#pragma unroll
            for (int j = 0; j < 4; ++j) { const unsigned w4[4] = {v[r][j].x, v[r][j].y, v[r][j].z, v[r][j].w}; unsigned o2[2] = {0u, 0u};
#pragma unroll
                for (int e = 0; e < 4; ++e) { const unsigned lo = (unsigned)__float2int_rn(__uint_as_float(w4[e] << 16) * inv) & 0xffu, hi = (unsigned)__float2int_rn(__uint_as_float(w4[e] & 0xffff0000u) * inv) & 0xffu;
                    o2[e >> 1] |= (lo | (hi << 8)) << (16 * (e & 1)); }
                uint2 ov; ov.x = o2[0]; ov.y = o2[1]; *(uint2*)(orow + 512 * j + 8 * lane) = ov; } }
    }
}
__device__ __forceinline__ void quant_phase(const float* xP, const float* xS, const float* nw, const float* scl0  , unsigned char* A8, float* sa, unsigned long long* rss, int G, int wg, int tid, int m_begin = 0) {
    const int lane = tid & 63, wave = tid >> 6, gw = wg * 8 + wave, NGW = G * 8;
    for (int m = m_begin + gw; m < MTOK; m += NGW) {
        const float* xr = (m < M_P ? xP : xS) + (size_t)m * DM;
        const int cond = m < M_P ? 0 : 1 + ((m - M_P) >> 12);
        const float* scl = scl0 + (size_t)cond * NMODC;
        f32x4 h[8]; float ss = 0.f, mx = 0.f;
#pragma unroll
        for (int j = 0; j < 8; ++j) { const int c = 256 * j + 4 * lane; const f32x4 v = *(const f32x4*)(xr + c); ss += (v[0] * v[0] + v[1] * v[1]) + (v[2] * v[2] + v[3] * v[3]);
            h[j] = v * *(const f32x4*)(nw + c) * (*(const f32x4*)(scl + c) + 1.0f);
            mx = fmaxf(fmaxf(mx, fmaxf(fabsf(h[j][0]), fabsf(h[j][1]))), fmaxf(fabsf(h[j][2]), fabsf(h[j][3]))); }
        ss = wave_sum(ss);
#pragma unroll
        for (int o = 1; o < 64; o <<= 1) mx = fmaxf(mx, __shfl_xor(mx, o));
        mx = fmaxf(mx, 1e-30f);
        if (lane == 0) { rss[m] = (unsigned long long)(ss * 16777216.0f); sa[m] = mx * (1.0f / 127.0f); }
        const float inv = 127.0f / mx; unsigned char* orow = A8 + (size_t)m * DM;
#pragma unroll
        for (int j = 0; j < 8; ++j) { const unsigned w = ((unsigned)__float2int_rn(h[j][0] * inv) & 0xffu) | (((unsigned)__float2int_rn(h[j][1] * inv) & 0xffu) << 8) | (((unsigned)__float2int_rn(h[j][2] * inv) & 0xffu) << 16) | (((unsigned)__float2int_rn(h[j][3] * inv) & 0xffu) << 24);
            *(unsigned*)(orow + 256 * j + 4 * lane) = w; }
    }
}
__device__ __forceinline__ void norm0_phase(const float* xP, const float* xS, const float* nw, const float* mod  , bf16* XN, unsigned long long* rss, int G, int wg, int tid) {
    const int lane = tid & 63, wave = tid >> 6, gw = wg * 8 + wave, NGW = G * 8;
    for (int m = gw; m < MTOK; m += NGW) {
        const float* xr = (m < M_P ? xP : xS) + (size_t)m * DM;
        const int cond = m < M_P ? 0 : 1 + ((m - M_P) >> 12);
        const float* scl = mod + (size_t)cond * NMODC + DM;
        f32x4 v[8]; float ss = 0.f;
#pragma unroll
        for (int j = 0; j < 8; ++j) { v[j] = *(const f32x4*)(xr + 256 * j + 4 * lane); ss += (v[j][0] * v[j][0] + v[j][1] * v[j][1]) + (v[j][2] * v[j][2] + v[j][3] * v[j][3]); }
        ss = wave_sum(ss); if (lane == 0) rss[m] = (unsigned long long)(ss * 16777216.0f);
        bf16* orow = XN + (size_t)m * DM;
#pragma unroll
        for (int j = 0; j < 8; ++j) { const int c = 256 * j + 4 * lane; const f32x4 w = *(const f32x4*)(nw + c), s1 = *(const f32x4*)(scl + c);
            const f32x4 h = v[j] * w * (s1 + 1.0f);
            uint2 o; o.x = pkbf(qm(h[0]), qm(h[1])); o.y = pkbf(qm(h[2]), qm(h[3])); *(uint2*)(orow + c) = o; }
    }
}
__device__ __forceinline__ void bias_phase(unsigned char* ws, LAS unsigned char* lds, int G, int wg, int tid) {
    const int lane = tid & 63, wave = tid >> 6, gw = wg * 8 + wave, NGW = G * 8;
    LAS float* sh = (LAS float*)lds;
    const float* tab = (const float*)(ws + WS_TAB);
    for (int grp = 0; grp < 6; ++grp) {
        const int l = grp / 3, j = grp % 3, N = (j == 1) ? NIN : NFF;
        const bf16* Bt = (const bf16*)(ws + WS_W + (size_t)l * W_LAYER + (j == 0 ? W_WI : j == 1 ? W_WIN : W_WI + 44 * MiB));
        float* sb = (float*)(ws + WS_SB) + (size_t)l * SB_LAYER + (j == 0 ? 0 : j == 1 ? SB_J1 : SB_J2);
        const float* mod = tab + TB_MOD + (size_t)l * NCOND * NMODC + (size_t)(3 * j) * DM;
        __syncthreads();
        for (int i = tid; i < NCOND * DM; i += 512) sh[i] = mod[(size_t)(i >> 11) * NMODC + (i & 2047)];
        __syncthreads();
        if (j != 1) {
            const unsigned char* Bq = (const unsigned char*)Bt; const float* swv = (const float*)(ws + WS_Q + Q_SW) + (size_t)(2 * l + (j >> 1)) * NFF;
            for (int n = gw; n < N; n += NGW) {
                v4u wr2[2];
#pragma unroll
                for (int q = 0; q < 2; ++q) { const int k_ = 16 * (lane + 64 * q); wr2[q] = *(const v4u*)(Bq + ((size_t)((n >> 8) * (DM >> 7) + (k_ >> 7)) * 256 + (n & 255)) * 128 + (k_ & 127)); }
                float wf[2][16];
#pragma unroll
                for (int q = 0; q < 2; ++q) { const unsigned ww[4] = {wr2[q].x, wr2[q].y, wr2[q].z, wr2[q].w};
#pragma unroll
                    for (int e = 0; e < 16; ++e) wf[q][e] = (float)(int)(signed char)((ww[e >> 2] >> (8 * (e & 3))) & 0xffu); }
                const float swn = swv[n];
#pragma unroll 1
                for (int c = 0; c < NCOND; ++c) { float a = 0.f;
#pragma unroll
                    for (int q = 0; q < 2; ++q) { const int k = 16 * (lane + 64 * q);
#pragma unroll
                        for (int e4 = 0; e4 < 4; ++e4) { const f32x4 s0 = *(const LAS f32x4*)(sh + c * DM + k + 4 * e4); a += (s0[0] * wf[q][4 * e4] + s0[1] * wf[q][4 * e4 + 1]) + (s0[2] * wf[q][4 * e4 + 2] + s0[3] * wf[q][4 * e4 + 3]); } }
                    const float t = wave_sum(a); if (lane == 0) sb[(size_t)c * N + n] = t * swn; }
            }
            continue;
        }
        v4u wq[4];
        if (gw < N) {
#pragma unroll
            for (int q = 0; q < 4; ++q) { const int k_ = 8 * (lane + 64 * q); wq[q] = *(const v4u*)(Bt + ((size_t)((gw >> 8) * (DM >> 6) + (k_ >> 6)) * 256 + (gw & 255)) * 64 + (k_ & 63)); } }
        for (int n = gw; n < N; n += NGW) {
            v4u wc_[4];
#pragma unroll
            for (int q = 0; q < 4; ++q) wc_[q] = wq[q];
            if (n + NGW < N) {
#pragma unroll
                for (int q = 0; q < 4; ++q) { const int k_ = 8 * (lane + 64 * q), n_ = n + NGW; wq[q] = *(const v4u*)(Bt + ((size_t)((n_ >> 8) * (DM >> 6) + (k_ >> 6)) * 256 + (n_ & 255)) * 64 + (k_ & 63)); } }
            float wf[4][8];
#pragma unroll
            for (int q = 0; q < 4; ++q) { const v4u w4 = wc_[q];
                wf[q][0] = __uint_as_float(w4.x << 16); wf[q][1] = __uint_as_float(w4.x & 0xffff0000u); wf[q][2] = __uint_as_float(w4.y << 16); wf[q][3] = __uint_as_float(w4.y & 0xffff0000u);
                wf[q][4] = __uint_as_float(w4.z << 16); wf[q][5] = __uint_as_float(w4.z & 0xffff0000u); wf[q][6] = __uint_as_float(w4.w << 16); wf[q][7] = __uint_as_float(w4.w & 0xffff0000u); }
#pragma unroll 1
            for (int c = 0; c < NCOND; ++c) { float a = 0.f;
#pragma unroll
                for (int q = 0; q < 4; ++q) { const int k = 8 * (lane + 64 * q); const f32x4 s0 = *(const LAS f32x4*)(sh + c * DM + k), s1 = *(const LAS f32x4*)(sh + c * DM + k + 4);
                    a += (s0[0] * wf[q][0] + s0[1] * wf[q][1]) + (s0[2] * wf[q][2] + s0[3] * wf[q][3]) + (s1[0] * wf[q][4] + s1[1] * wf[q][5]) + (s1[2] * wf[q][6] + s1[3] * wf[q][7]); }
                const float t = wave_sum(a); if (lane == 0) sb[(size_t)c * N + n] = t; }
        }
    }
    __syncthreads();
}
__device__ __forceinline__ void final_norm(float* x, const float* fw, int G, int wg, int tid) {
    const int lane = tid & 63, wave = tid >> 6, gw = wg * 8 + wave, NGW = G * 8;
    for (int m = gw; m < MTOK; m += NGW) {
        float* xr = x + (size_t)m * DM; f32x4 v[8]; float ss = 0.f;
#pragma unroll
        for (int j = 0; j < 8; ++j) { v[j] = *(const f32x4*)(xr + 256 * j + 4 * lane); ss += (v[j][0] * v[j][0] + v[j][1] * v[j][1]) + (v[j][2] * v[j][2] + v[j][3] * v[j][3]); }
        const float rstd = rsqrtf(wave_sum(ss) * (1.0f / DM) + EPS);
#pragma unroll
        for (int j = 0; j < 8; ++j) { const int c = 256 * j + 4 * lane; *(f32x4*)(xr + c) = (v[j] * rstd) * *(const f32x4*)(fw + c); }
    }
}
struct PrepRegs { unsigned rg[10], rd[8], rv2[2], rv4[4]; };
__device__ __forceinline__ void prep_load(int m, const bf16* PROJ, PrepRegs& R, int lane) {
    const bf16* pr = PROJ + (size_t)m * NIN; const bool lat = m >= M_P;
#pragma unroll
    for (int v = 0; v < 10; ++v) R.rg[v] = *(const unsigned*)(pr + (v < 8 ? C_GQ + 128 * v : C_GK + 128 * (v - 8)) + 2 * lane);
#pragma unroll
    for (int v = 0; v < 8; ++v) R.rd[v] = *(const unsigned*)(pr + (v < 4 ? C_DQ + 128 * v : C_DK + 128 * (v - 4)) + 2 * lane);
#pragma unroll
    for (int v = 0; v < 2; ++v) R.rv2[v] = 0u;
#pragma unroll
    for (int v = 0; v < 4; ++v) R.rv4[v] = 0u;
    if (!lat) {
#pragma unroll
        for (int v = 0; v < 2; ++v) R.rv2[v] = *(const unsigned*)(pr + C_GV + 128 * v + 2 * lane);
#pragma unroll
        for (int v = 0; v < 4; ++v) R.rv4[v] = *(const unsigned*)(pr + C_DV + 128 * v + 2 * lane);
    }
}
__device__ __forceinline__ void prep_finish(int m, int l, const PrepRegs& R, bf16* DST, const float* tab, const float* qkw  , float* out, int lane) {
    bf16* pw = DST + (size_t)m * NIN;
    const bool lat = m >= M_P; const int t = lat ? ((m - M_P) & 4095) : (m & 255), b = lat ? ((m - M_P) >> 12) : (m >> 8);
    const int rr = t >> 6, cc = t & 63;
    const float wq0 = qkw[2 * lane], wq1 = qkw[2 * lane + 1], wk0 = qkw[128 + 2 * lane], wk1 = qkw[128 + 2 * lane + 1];
    float cs = 1.f, sn = 0.f, c2 = 1.f, s2 = 0.f;
    if (lat) { const int idx = lane < 32 ? rr * 32 + lane : cc * 32 + (lane - 32); cs = tab[TB_COSG + idx]; sn = tab[TB_SING + idx];
               const int p = lane & 31, id2 = p < 16 ? rr * 16 + p : cc * 16 + (p - 16); c2 = tab[TB_COSD + id2]; s2 = tab[TB_SIND + id2]; }
#pragma unroll
    for (int v = 0; v < 10; ++v) {
        const int col = (v < 8 ? C_GQ + 128 * v : C_GK + 128 * (v - 8)) + 2 * lane;
        const float x1 = bf2f((unsigned short)(R.rg[v] & 0xffffu)), x2 = bf2f((unsigned short)(R.rg[v] >> 16));
        const float rs = rsqrtf(wave_sum(x1 * x1 + x2 * x2) * (1.0f / 128.0f) + EPS);
        const float y1 = x1 * rs * (v < 8 ? wq0 : wk0), y2 = x2 * rs * (v < 8 ? wq1 : wk1);
        if (!lat && v >= 8) { float* o = out + O_GK + (((size_t)(b * 2 + l) * 256 + t) * 2 + (v - 8)) * 128 + 2 * lane; o[0] = y1; o[1] = y2; }
        const float qs = v < 8 ? 0.12751743f : 1.0f;
        *(unsigned*)(pw + col) = pkbf((y1 * cs - y2 * sn) * qs, (y1 * sn + y2 * cs) * qs);
    }
    if (lat) {
#pragma unroll
        for (int v = 0; v < 8; ++v) { const int col = (v < 4 ? C_DQ + 128 * v : C_DK + 128 * (v - 4)) + 2 * lane;
            const float x1 = bf2f((unsigned short)(R.rd[v] & 0xffffu)), x2 = bf2f((unsigned short)(R.rd[v] >> 16));
            *(unsigned*)(pw + col) = pkbf(x1 * c2 - x2 * s2, x1 * s2 + x2 * c2); }
    } else {
#pragma unroll
        for (int v = 0; v < 2; ++v) { float* o = out + O_GV + (((size_t)(b * 2 + l) * 256 + t) * 2 + v) * 128 + 2 * lane; o[0] = bf2f((unsigned short)(R.rv2[v] & 0xffffu)); o[1] = bf2f((unsigned short)(R.rv2[v] >> 16)); }
#pragma unroll
        for (int v = 0; v < 4; ++v) { const unsigned rk = R.rd[4 + v], rv = R.rv4[v];
            const size_t oi = (((size_t)(b * 2 + l) * 256 + t) * 4 + v) * 128 + 2 * lane;
            out[O_DK + oi] = bf2f((unsigned short)(rk & 0xffffu)); out[O_DK + oi + 1] = bf2f((unsigned short)(rk >> 16));
            out[O_DV + oi] = bf2f((unsigned short)(rv & 0xffffu)); out[O_DV + oi + 1] = bf2f((unsigned short)(rv >> 16)); }
    }
}
#ifndef EN_PRO
#define EN_PRO 1
#endif
#ifndef EN_NORM
#define EN_NORM 1
#endif
#ifndef EN_FFNIN
#define EN_FFNIN 1
#endif
#ifndef EN_FFNOUT
#define EN_FFNOUT 1
#endif
#ifndef EN_WIN
#define EN_WIN 1
#endif
#ifndef EN_P
#define EN_P 1
#endif
#ifndef EN_A
#define EN_A 1
#endif
#ifndef EN_A1
#define EN_A1 1
#endif
#ifndef EN_A2
#define EN_A2 1
#endif
#ifndef EN_A3
#define EN_A3 1
#endif
#ifndef EN_WOUT
#define EN_WOUT 1
#endif
#ifndef EN_FIN
#define EN_FIN 1
#endif
struct Args { const float* in[22]; float* out; unsigned char* ws; int ph_lo, ph_hi, pad0, pad1; };
constexpr int NPHASE = 30;
#define LAUNDER(p) asm volatile("" : "+s"(p))
struct InPtrs { const float* const* p; __device__ __forceinline__ const float* operator[](int i) const { return p[i]; } };
__device__ __forceinline__ int deal_unit(int i, int NL, int NC, int off, int G, int wg) {
    if (NL % G == 0) { const int nr = NL / G; if (i < nr) return i * G + wg; if (i > nr) return -1; const int c = (wg + G - off) % G; return c < NC ? NL + c : -1; }
    const int v = i * G + wg; return v < NL + NC ? v : -1;
}
__global__ void __launch_bounds__(512, 2) fwd_kernel(Args args) {
    extern __shared__ __attribute__((aligned(16))) unsigned char lds_raw[];
    LAS unsigned char* lds = (LAS unsigned char*)lds_raw;
    volatile LAS unsigned* MISC = (volatile LAS unsigned*)(lds + MISC_OFF);
    const int G = gridDim.x, wg = blockIdx.x;
    for (int u = threadIdx.x; u < (LDS_BYTES - 131072) / 4; u += 512) ((LAS unsigned*)(lds + 131072))[u] = 0u;
    __syncthreads();
    XcdBarrier bar = xcd_barrier_post((unsigned*)(args.ws + WS_CTL) + CW_BAR, MISC + 8);
    const int lo = args.ph_lo, hi = args.ph_hi;
#define IN(k) (lo <= (k) && (k) < hi)
#define SEAM(k) do { if (IN(k) && IN((k) + 1)) xcd_barrier(bar); } while (0)
#define PH_BEGIN size_t zoff_ = 0; asm volatile("" : "+s"(zoff_)); unsigned char* ws = args.ws + zoff_; float* out = args.out + zoff_;   \
    const InPtrs inp{args.in}; int tid = threadIdx.x; asm volatile("" : "+v"(tid)); \
    const int lane = tid & 63, wave = __builtin_amdgcn_readfirstlane(tid >> 6); (void)lane; (void)wave;

    if (IN(0)) { PH_BEGIN; (void)out; prologue(inp, ws, lds, G, wg, tid); }
    SEAM(0);
    if (IN(1)) { PH_BEGIN; (void)out; prologue_b(inp, ws, lds, G, wg, tid); }
    SEAM(1);
    if (IN(2)) { PH_BEGIN; (void)out;
        quant_phase(inp[0], inp[1] - (size_t)M_P * DM, inp[11], (const float*)(ws + WS_TAB) + TB_MOD + DM, ws + WS_XNB, (float*)(ws + WS_Q), (unsigned long long*)(ws + WS_RS), G, wg, tid);
        bias_phase(ws, lds, G, wg, tid); }
    SEAM(2);
#pragma unroll 1
    for (int l = 0; l < 2; ++l) {
        const int pb = 3 + 13 * l;
#pragma unroll 1
        for (int f = 0; f < 2; ++f) {
            const int fb = pb + 9 * f;
            if (IN(fb + 0)) { PH_BEGIN; (void)out; (void)inp; const bf16* WL = (const bf16*)(ws + WS_W + (size_t)l * W_LAYER);
                pg8::Gemm g{(const bf16*)(ws + WS_XNB), WL + (W_WI + (size_t)f * 44 * MiB) / 2, MTOK, NFF, DM / 2}; pg8::StaticOrder S; S.init(MTOK, NFF, G, wg);
                pg8::EpiSwiGLUQ E{ws + WS_A8B, DFF, (const unsigned long long*)(ws + WS_RS) + (size_t)(3 * l + 2 * f) * MTOK, (const float*)(ws + WS_Q), (const float*)(ws + WS_Q + Q_SW) + (size_t)(2 * l + f) * NFF,
                                  (const float*)(ws + WS_SB) + (size_t)l * SB_LAYER + (f ? SB_J2 : 0), NFF, (const float*)(ws + WS_Q + Q_ACT) + 2 * (2 * l + f)};
                pg8::gemm_phase<pg8::EpiSwiGLUQ, pg8::StaticOrder, true, true, true>(lds, g, S, E); }
            if (IN(fb + 0) && IN(fb + 2)) xcd_barrier(bar);
            if (IN(fb + 2)) { PH_BEGIN; float* X = out + O_X; const bool first = (l == 0 && f == 0); const unsigned char* WL8 = ws + WS_W + (size_t)l * W_LAYER + W_WO + (size_t)f * 22 * MiB;
                const float* tabf = (const float*)(ws + WS_TAB); const float* mod = tabf + TB_MOD + (size_t)l * NCOND * NMODC;
                pg8::Gemm g{(const bf16*)(ws + WS_A8B), (const bf16*)WL8, MTOK, DM, DFF / 2}; pg8::StaticOrder S; S.init(MTOK, DM, G, wg);
                const int ni = f ? 3 * (l + 1) : 3 * l + 1;
                const size_t rs_off = WS_RS + (size_t)ni * MTOK * 8;
                pg8::EpiResidN E{first ? inp[0] : X, first ? inp[1] - (size_t)M_P * DM : X, X, mod + (2 + 6 * f) * DM,
                                 inp[11] + (size_t)(f ? 3 : 3 * l + 1) * DM, f ? tabf + TB_MOD + (size_t)NCOND * NMODC + DM : mod + (size_t)4 * DM, (unsigned long long*)(ws + rs_off), (long)(f ? WS_ACT : WS_XN) - (long)rs_off, 0.5f, (f && l) ? 0 : 1,
                                 (long)(WS_Q + Q_ACT + (size_t)(2 * (2 * l + f) + 1) * 4) - (long)rs_off, (long)(WS_Q + Q_SW2 + (size_t)(2 * l + f) * DM * 4) - (long)rs_off, 2, 1, (long)(WS_CTL + CTL_AMAX + (size_t)ni * MTOK * 4) - (long)rs_off};
                pg8::gemm_phase<pg8::EpiResidN, pg8::StaticOrder, true, true, 2>(lds, g, S, E); }
            SEAM(fb + 2);
            if (f == 1) {
                if (l == 0 && IN(pb + 12)) { PH_BEGIN; float* X = out + O_X;
                    (void)X; quant_xs_phase((const bf16*)(ws + WS_ACT), (const unsigned*)(ws + WS_CTL + CTL_AMAX) + (size_t)3 * MTOK, ws + WS_XNB, (float*)(ws + WS_Q), G, wg, tid); }
                SEAM(pb + 12);
                break; }
            if (IN(pb + 3)) { PH_BEGIN; float* X = out + O_X;
                (void)X; quant_xs_phase((const bf16*)(ws + WS_XN), (const unsigned*)(ws + WS_CTL + CTL_AMAX) + (size_t)(3 * l + 1) * MTOK, ws + WS_XNB, (float*)(ws + WS_Q), G, wg, tid, M_P); }
            SEAM(pb + 3);
            if (IN(pb + 4)) {
                { PH_BEGIN; (void)out; (void)inp;
                  pg8::Gemm g{(const bf16*)(ws + WS_XNB + (size_t)M_P * DM), (const bf16*)(ws + WS_W + (size_t)l * W_LAYER + W_WINQ), M_S, NIN, DM / 2}; pg8::StaticOrder S; S.init(M_S, NIN, G, wg);
                  pg8::EpiStoreQ E{(bf16*)(ws + WS_ACT) + (size_t)M_P * NIN, NIN, (const unsigned long long*)(ws + WS_RS) + (size_t)(3 * l + 1) * MTOK + M_P, (const float*)(ws + WS_Q) + M_P,
                                   (const float*)(ws + WS_Q + Q_SW4) + (size_t)l * NIN, (const float*)(ws + WS_SB) + (size_t)l * SB_LAYER + SB_J1, NIN, 16};
                  pg8::gemm_phase<pg8::EpiStoreQ, pg8::StaticOrder, true, true, true>(lds, g, S, E); }
                { PH_BEGIN; (void)out; (void)inp; const bf16* WL = (const bf16*)(ws + WS_W + (size_t)l * W_LAYER);
                  pg8::Gemm g{(const bf16*)(ws + WS_XN), WL + W_WIN / 2, M_P, NIN, DM}; pg8::StaticOrder S; S.init(M_P, NIN, G, wg);
                  pg8::EpiStoreBf16N E{(bf16*)(ws + WS_ACT), NIN, (const unsigned long long*)(ws + WS_RS) + (size_t)(3 * l + 1) * MTOK, (const float*)(ws + WS_SB) + (size_t)l * SB_LAYER + SB_J1, NIN};
                  pg8::gemm_phase<pg8::EpiStoreBf16N, pg8::StaticOrder, true, true>(lds, g, S, E); }
            }
            SEAM(pb + 4);
            if (IN(pb + 5)) { PH_BEGIN; bf16* PROJ = (bf16*)(ws + WS_ACT); const float* tab = (const float*)(ws + WS_TAB);
#pragma unroll 1
                for (int ch = wg; ch < 192; ch += G) {
                    const bool lat = ch < 64; const int cc = lat ? ch : ch - 64, dir = cc & 1, h = (cc >> 1) & 3, b = cc >> 3;
                    att::ChainArgs a; a.P = PROJ + (size_t)(lat ? M_P + b * 4096 : b * 256) * NIN; a.kcol = C_RK + 128 * h; a.vcol = C_RV + 128 * h; a.nchunk = lat ? 32 : 2; a.dir = dir;
                    a.lg2 = tab[TB_SCAL + 16 * l + 2 + dir * 4 + h];
                    a.S0 = lat ? inp[3] + ((((size_t)b * 2 + l) * 2 + dir) * 4 + h) * 16384 : nullptr;
                    a.ST = (bf16*)(ws + WS_ST) + (lat ? (size_t)cc * 32 * 16384 : (size_t)64 * 32 * 16384 + (size_t)cc * 2 * 16384);
                    a.Sfin = lat ? nullptr : out + O_STATE + ((((size_t)b * 2 + l) * 2 + dir) * 4 + h) * 16384;
                    __syncthreads(); att::ret_chain(a, (char*)lds_raw);
                }
                const int w0 = G > 128 ? 64 : 0, gw = (wg - w0) * 8 + wave, NGW = (G - w0) * 8;
                if (wg >= w0) for (int m = gw; m < MTOK; m += 2 * NGW) { PrepRegs R0, R1; const int m1 = m + NGW; prep_load(m, PROJ, R0, lane); prep_load(m1 < MTOK ? m1 : m, PROJ, R1, lane);
                    prep_finish(m, l, R0, PROJ, tab, inp[18] + l * 256, out, lane); if (m1 < MTOK) prep_finish(m1, l, R1, PROJ, tab, inp[18] + l * 256, out, lane); }
            }
            SEAM(pb + 5);
            if (IN(pb + 6)) { PH_BEGIN; (void)out; bf16* PROJ = (bf16*)(ws + WS_ACT); bf16* MIX = (bf16*)(ws + WS_XN); const float* tab = (const float*)(ws + WS_TAB);
                const bf16* CGK = (const bf16*)(ws + WS_CACHE);
#pragma unroll 1
                for (int rp = 0; rp < ((PROBE == 13 && l == 0) ? 2 : 1); ++rp)
#pragma unroll 1
                for (int i2 = 0;; ++i2) { const int ps = i2 & 1; const int u = deal_unit(i2 >> 1, 512, 64, 192, G, wg); if (u < 0) break;
                    const bool lat = u < 512; const int v = lat ? u : u - 512;
                    const int qb = lat ? (v & 15) : 0, h = lat ? ((v >> 4) & 3) : (v & 3), b = lat ? (v >> 6) : (v >> 2);
                    const size_t row0 = lat ? (size_t)M_P + (size_t)b * 4096 : (size_t)b * 256;
                    const float lam = tab[TB_SCAL + 16 * l + 0], post = tab[TB_SCAL + 16 * l + 1];
                    {
                        att::KVSrc kv; kv.K1 = PROJ + row0 * NIN + C_DK + 128 * h + 64 * ps; kv.V1 = PROJ + row0 * NIN + C_DV + 128 * h; kv.n1 = lat ? 4096 : 256;
                        kv.K2 = CGK + 2097152 + ((size_t)(b * 2 + l) * 256) * 512 + 128 * h + 64 * ps; kv.V2 = CGK + 4194304 + ((size_t)(b * 2 + l) * 256) * 512 + 128 * h; kv.n2 = lat ? 256 : 0;
                        att::AttnOut ao; ao.Ob = MIX + (row0 + 256 * qb) * DM + 1536 + 128 * h; ao.Of = (float*)(ws + WS_DF) + (row0 + 256 * qb) * 512 + 128 * h;
                        ao.nw = inp[20] + l * 512 + 128 * h; ao.lam = lam; ao.post = post; ao.pass = ps;
                        __syncthreads();
                        att::attn_body<64, 1, 512>(PROJ + (row0 + 256 * qb) * NIN + C_DQ + 128 * h + 64 * ps, kv, ao, (char*)lds_raw);
                    }
                }
                const bool nomax = tab[TB_SCAL + 16 * l + 10] != 0.f;
#pragma unroll 1
                for (int rp = 0; rp < ((PROBE == 14 && l == 0) ? 2 : 1); ++rp)
#pragma unroll 1
                for (int i = 0;; ++i) { const int u = deal_unit(i, 1024, 128, 64, G, wg); if (u < 0) break;
                    const bool lat = u < 1024; const int v = lat ? u : u - 1024;
                    const int qb = lat ? (v & 15) : 0, hq = lat ? ((v >> 4) & 7) : (v & 7), b = lat ? (v >> 7) : (v >> 3), kvh = hq >> 2;
                    const size_t row0 = lat ? (size_t)M_P + (size_t)b * 4096 : (size_t)b * 256;
                    att::KVSrc kv; kv.K1 = PROJ + row0 * NIN + C_GK + 128 * kvh; kv.V1 = PROJ + row0 * NIN + C_GV + 128 * kvh; kv.n1 = lat ? 4096 : 256;
                    kv.K2 = CGK + ((size_t)(b * 2 + l) * 256) * 256 + 128 * kvh; kv.V2 = CGK + 1048576 + ((size_t)(b * 2 + l) * 256) * 256 + 128 * kvh; kv.n2 = lat ? 256 : 0;
                    att::AttnOut ao; ao.Ob = MIX + (row0 + 256 * qb) * DM + 512 + 128 * hq; ao.Of = nullptr; ao.nw = nullptr; ao.lam = 0.f; ao.post = 0.f; ao.pass = 0;
                    __syncthreads();
                    if (nomax) att::attn_body<128, 0, 256, 1>(PROJ + (row0 + 256 * qb) * NIN + C_GQ + 128 * hq, kv, ao, (char*)lds_raw);
                    else att::attn_body<128, 0, 256, 2>(PROJ + (row0 + 256 * qb) * NIN + C_GQ + 128 * hq, kv, ao, (char*)lds_raw);
                }
#pragma unroll 1
                for (int rp = 0; rp < ((PROBE == 15 && l == 0) ? 2 : 1); ++rp)
#pragma unroll 1
                for (int i = 0;; ++i) { const int u = deal_unit(i, 512, 64, 0, G, wg); if (u < 0) break;
                    const bool lat = u < 512; const int v = lat ? u : u - 512;
                    const int pr = lat ? (v & 15) : 0, h = lat ? ((v >> 4) & 3) : (v & 3), b = lat ? (v >> 6) : (v >> 2);
                    const size_t row0 = (lat ? (size_t)M_P + (size_t)b * 4096 : (size_t)b * 256) + 256 * pr;
                    att::RetCArgs a; a.P = PROJ + row0 * NIN; a.qcol = C_RQ + 128 * h; a.kcol = C_RK + 128 * h; a.vcol = C_RV + 128 * h; a.gcol = C_RG + 128 * h;
                    a.lg2f = tab[TB_SCAL + 16 * l + 2 + h]; a.lg2b = tab[TB_SCAL + 16 * l + 6 + h];
                    const int cf = (b * 4 + h) * 2; const bf16* STB = (const bf16*)(ws + WS_ST);
                    a.STf = STB + (lat ? (size_t)cf * 32 * 16384 : (size_t)64 * 32 * 16384 + (size_t)cf * 2 * 16384) + (size_t)(2 * pr) * 16384;
                    a.STb = STB + (lat ? (size_t)(cf + 1) * 32 * 16384 : (size_t)64 * 32 * 16384 + (size_t)(cf + 1) * 2 * 16384) + (size_t)(2 * pr) * 16384;
                    a.gnw = inp[17] + l * 512 + 128 * h; a.O = MIX + row0 * DM + 128 * h;
                    __syncthreads();
                    att::ret_c(a, (char*)lds_raw);
                }
            }
            SEAM(pb + 6);
            if (IN(pb + 7)) { PH_BEGIN; float* X = out + O_X; const bf16* WL = (const bf16*)(ws + WS_W + (size_t)l * W_LAYER);
                const float* mod = (const float*)(ws + WS_TAB) + TB_MOD + (size_t)l * NCOND * NMODC;
                pg8::Gemm g{(const bf16*)(ws + WS_XN), WL + W_WOUT / 2, MTOK, DM, DM}; pg8::StaticOrder S; S.init(MTOK, DM, G, wg);
                const size_t rs_off = WS_RS + (size_t)(3 * l + 2) * MTOK * 8;
                pg8::EpiResidN E{X, X, X, mod + 5 * DM, inp[11] + ((size_t)l * 3 + 2) * DM, mod + 7 * DM, (unsigned long long*)(ws + rs_off), (long)WS_ACT - (long)rs_off, 1.0f, 1, (long)WS_Q - (long)rs_off, (long)WS_Q - (long)rs_off, 0, 1, (long)(WS_CTL + CTL_AMAX + (size_t)(3 * l + 2) * MTOK * 4) - (long)rs_off};
                pg8::gemm_phase<pg8::EpiResidN, pg8::StaticOrder, true, true>(lds, g, S, E); }
            SEAM(pb + 7);
            if (IN(pb + 8)) { PH_BEGIN; float* X = out + O_X;
                (void)X; quant_xs_phase((const bf16*)(ws + WS_ACT), (const unsigned*)(ws + WS_CTL + CTL_AMAX) + (size_t)(3 * l + 2) * MTOK, ws + WS_XNB, (float*)(ws + WS_Q), G, wg, tid); }
            SEAM(pb + 8);
        }
    }
    if (IN(29)) { PH_BEGIN; (void)ws; final_norm(out + O_X, inp[21], G, wg, tid); }
#undef IN
#undef SEAM
#undef PH_BEGIN
}

extern "C" void kernel_launch(void* const* d_in, const int* in_sizes, int n_in, void* d_out, int out_size, void* d_ws, size_t ws_size, hipStream_t stream) {
    static int grid = 0;
    if (grid == 0) {
        if (n_in != 22 || out_size != (int)O_END || ws_size < WS_END) { fprintf(stderr, "kernel_launch: unexpected shapes: n_in %d out %d ws %zu (need %zu)\n", n_in, out_size, ws_size, (size_t)WS_END); grid = -1; return; }
        int dev = 0, cus = 0, per_cu = 0;
        if (hipGetDevice(&dev) != hipSuccess || hipDeviceGetAttribute(&cus, hipDeviceAttributeMultiprocessorCount, dev) != hipSuccess) { grid = -1; return; }
        if (hipFuncSetAttribute((const void*)fwd_kernel, hipFuncAttributeMaxDynamicSharedMemorySize, LDS_BYTES) != hipSuccess) { fprintf(stderr, "kernel_launch: hipFuncSetAttribute failed\n"); grid = -1; return; }
        if (hipOccupancyMaxActiveBlocksPerMultiprocessor(&per_cu, (const void*)fwd_kernel, 512, LDS_BYTES) != hipSuccess || per_cu < 1) { fprintf(stderr, "kernel_launch: occupancy query says %d\n", per_cu); }
        (void)hipGetLastError();
        grid = cus;
    }
    if (grid < 0) return;
    (void)hipMemsetAsync((char*)d_ws + WS_RS, 0, 2 * MiB + CTL_ZERO_BYTES, stream);
    Args a{};
    for (int i = 0; i < 22; ++i) a.in[i] = (const float*)d_in[i];
    a.out = (float*)d_out; a.ws = (unsigned char*)d_ws; a.ph_lo = 0; a.ph_hi = NPHASE; a.pad0 = 0; a.pad1 = 0;
    hipLaunchKernelGGL(fwd_kernel, dim3(grid), dim3(512), LDS_BYTES, stream, a);
}
```

```cpp
#include <hip/hip_runtime.h>
#include <hip/hip_bf16.h>
#include <cstdio>
#include <cstdint>
#ifndef PROBE
#define PROBE 0
#endif
#ifndef FFN_MB
#define FFN_MB 4
#endif
__device__ __forceinline__ float qm(float x) { if (FFN_MB >= 7) return x; unsigned u = __float_as_uint(x); constexpr unsigned sh = 23 - FFN_MB; u = (u + ((1u << (sh - 1)) - 1u) + ((u >> sh) & 1u)) & ~((1u << sh) - 1u); return __uint_as_float(u); }
#ifndef DBGT_CLK
#define DBGT_CLK 0
#endif
#ifndef DBGT_PH
#define DBGT_PH -1
#endif
namespace pg8 {
#define PG8_LAS __attribute__((address_space(3)))
typedef unsigned short bf16_t;
typedef short bf16x8 __attribute__((ext_vector_type(8)));
typedef float f32x4 __attribute__((ext_vector_type(4)));
typedef unsigned u32x4 __attribute__((ext_vector_type(4)));
typedef int i32x4 __attribute__((ext_vector_type(4)));
constexpr int BM = 256, BK = 64, HALF = 128, HTB = HALF * BK * 2  , STAGE_BYTES = 8 * HTB, NXCD = 8, WGM = 8;

__host__ __device__ __forceinline__ int lds_byte(int r, int c) { const int st = (r >> 4) * 2 + (c >> 5), rr = r & 15, cc = c & 31, ob = rr * 64 + cc * 2; return st * 1024 + (ob ^ (((ob >> 9) & 1) << 5)); }
__host__ __device__ __forceinline__ void stage_rc(int b, int& R, int& C) { const int st = b / 1024, sb = b % 1024, swz = sb ^ (((sb >> 9) & 1) << 5); R = (st >> 1) * 16 + swz / 64; C = (st & 1) * 32 + (swz % 64) / 2; }
__host__ __device__ __forceinline__ int perm32(int rho) { const int n = rho >> 4, i = rho & 15; return 8 * (i >> 2) + 4 * n + (i & 3); }

struct Unit { int pm, pn; };
struct Gemm { const bf16_t* A; const bf16_t* Bt; int M, N, K; };

struct StaticOrder {
    int nM, nN, nwg, G, c;
    __host__ __device__ void init(int M, int N, int G_, int c_) { nM = M / BM; nN = N / BM; nwg = nM * nN; G = G_; c = c_; }
    __host__ __device__ bool next(int i, Unit& u) const {
        const long L = (long)i * G + c; if (L >= nwg) return false;
        int wgid = (int)L; { const int q = nwg / NXCD, r = nwg % NXCD, xcd = wgid % NXCD, off = wgid / NXCD; wgid = (xcd < r ? xcd * (q + 1) : r * (q + 1) + (xcd - r) * q) + off; }
        const int nig = WGM * nN, gid = wgid / nig, fm = gid * WGM, gsz = (nM - fm) < WGM ? (nM - fm) : WGM;
        u.pm = fm + ((wgid % nig) % gsz); u.pn = (wgid % nig) / gsz; return true;
    }
    __device__ __forceinline__ void a_ready(const Unit&) const {}
    __device__ __forceinline__ void done(const Unit&) const {}
};

__device__ __forceinline__ unsigned cvt_pk_bf16(float lo, float hi) { unsigned r; asm volatile("v_cvt_pk_bf16_f32 %0, %1, %2" : "=v"(r) : "v"(lo), "v"(hi)); return r; }
typedef float f32x2 __attribute__((ext_vector_type(2)));
struct EpiStoreBf16 {
    static constexpr bool PERM = true, AFTER_DRAIN = false;
    bf16_t* O; int ldc;
    __device__ __forceinline__ void operator()(const f32x4 (&acc)[2][2][4][2], const Unit& u, int wr, int wc, int fr, int fq) const {
        const int row0 = u.pm * BM + wr * 64 + fr, col0 = u.pn * BM + wc * 32 + 8 * fq;
#pragma unroll
        for (int ai = 0; ai < 2; ++ai)
#pragma unroll
            for (int m = 0; m < 4; ++m) { bf16_t* rowp = O + (size_t)(row0 + ai * HALF + m * 16) * ldc + col0;
#pragma unroll
                for (int bj = 0; bj < 2; ++bj) { const f32x4 v0 = acc[ai][bj][m][0], v1 = acc[ai][bj][m][1];
                    u32x4 w; w.x = cvt_pk_bf16(v0[0], v0[1]); w.y = cvt_pk_bf16(v0[2], v0[3]); w.z = cvt_pk_bf16(v1[0], v1[1]); w.w = cvt_pk_bf16(v1[2], v1[3]);
                    *(u32x4*)(rowp + bj * HALF) = w; } }
    }
};
__device__ __forceinline__ float silu_f(float g) { return g * __builtin_amdgcn_rcpf(1.0f + __builtin_amdgcn_exp2f(-1.4426950408889634f * g)); }
struct EpiSwiGLU {
    static constexpr bool PERM = true, AFTER_DRAIN = false;
    bf16_t* O; int ldc;
    __device__ __forceinline__ void operator()(const f32x4 (&acc)[2][2][4][2], const Unit& u, int wr, int wc, int fr, int fq) const {
        const int row0 = u.pm * BM + wr * 64 + fr, col0 = u.pn * HALF + wc * 32 + 8 * fq;
#pragma unroll
        for (int ai = 0; ai < 2; ++ai)
#pragma unroll
            for (int m = 0; m < 4; ++m) { bf16_t* rowp = O + (size_t)(row0 + ai * HALF + m * 16) * ldc + col0;
                const f32x4 g0 = acc[ai][0][m][0], g1 = acc[ai][0][m][1], u0 = acc[ai][1][m][0], u1 = acc[ai][1][m][1];
                u32x4 w; w.x = cvt_pk_bf16(silu_f(g0[0]) * u0[0], silu_f(g0[1]) * u0[1]); w.y = cvt_pk_bf16(silu_f(g0[2]) * u0[2], silu_f(g0[3]) * u0[3]);
                w.z = cvt_pk_bf16(silu_f(g1[0]) * u1[0], silu_f(g1[1]) * u1[1]); w.w = cvt_pk_bf16(silu_f(g1[2]) * u1[2], silu_f(g1[3]) * u1[3]);
                *(u32x4*)rowp = w; }
    }
};
struct EpiResid {
    static constexpr bool PERM = false, AFTER_DRAIN = false;
    const float* baseP; const float* baseS; float* out; const float* gate; float coef;
    __device__ __forceinline__ void operator()(const f32x4 (&acc)[2][2][4][2], const Unit& u, int wr, int wc, int fr, int fq) const {
        const int cond = u.pm < 16 ? 0 : 1 + ((u.pm - 16) >> 4);
        const float* g = gate + (size_t)cond * 18432; const float* base = u.pm < 16 ? baseP : baseS;
        const int row0 = u.pm * BM + wr * 64 + fr, col0 = u.pn * BM + wc * 32 + 4 * fq;
        f32x4 gv[2][2];
#pragma unroll
        for (int bj = 0; bj < 2; ++bj)
#pragma unroll
            for (int n = 0; n < 2; ++n) gv[bj][n] = *(const f32x4*)(g + col0 + bj * HALF + n * 16) * coef;
#pragma unroll
        for (int ai = 0; ai < 2; ++ai)
#pragma unroll
            for (int m = 0; m < 4; ++m) { const size_t off = (size_t)(row0 + ai * HALF + m * 16) * 2048 + col0;
#pragma unroll
                for (int bj = 0; bj < 2; ++bj)
#pragma unroll
                    for (int n = 0; n < 2; ++n) { const f32x4 b = *(const f32x4*)(base + off + bj * HALF + n * 16);
                        *(f32x4*)(out + off + bj * HALF + n * 16) = b + gv[bj][n] * acc[ai][bj][m][n]; }
                if (m == 3) asm volatile("" ::: "memory"); }
    }
};

__device__ __forceinline__ float rstd_of(const unsigned long long* rss, int row) { return rsqrtf((float)rss[row] * (1.0f / 16777216.0f) * (1.0f / 2048.0f) + 1e-6f); }
struct EpiStoreBf16N {
    static constexpr bool PERM = true, AFTER_DRAIN = false;
    bf16_t* O; int ldc; const unsigned long long* rss; const float* bias; int ldb;
    __device__ __forceinline__ void operator()(const f32x4 (&acc)[2][2][4][2], const Unit& u, int wr, int wc, int fr, int fq) const {
        const int cond = u.pm < 16 ? 0 : 1 + ((u.pm - 16) >> 4);
        const int row0 = u.pm * BM + wr * 64 + fr, col0 = u.pn * BM + wc * 32 + 8 * fq;
        const float* b = bias + (size_t)cond * ldb + col0;
        f32x4 bv[2][2];
#pragma unroll
        for (int bj = 0; bj < 2; ++bj)
#pragma unroll
            for (int n = 0; n < 2; ++n) bv[bj][n] = *(const f32x4*)(b + bj * HALF + 4 * n);
#pragma unroll
        for (int ai = 0; ai < 2; ++ai)
#pragma unroll
            for (int m = 0; m < 4; ++m) { const int row = row0 + ai * HALF + m * 16; const float rs = rstd_of(rss, row); bf16_t* rowp = O + (size_t)row * ldc + col0;
#pragma unroll
                for (int bj = 0; bj < 2; ++bj) { const f32x4 v0 = acc[ai][bj][m][0] * rs + bv[bj][0], v1 = acc[ai][bj][m][1] * rs + bv[bj][1];
                    u32x4 w; w.x = cvt_pk_bf16(v0[0], v0[1]); w.y = cvt_pk_bf16(v0[2], v0[3]); w.z = cvt_pk_bf16(v1[0], v1[1]); w.w = cvt_pk_bf16(v1[2], v1[3]);
                    *(u32x4*)(rowp + bj * HALF) = w; } }
    }
};
struct EpiSwiGLUN {
    static constexpr bool PERM = true, AFTER_DRAIN = false;
    bf16_t* O; int ldc; const unsigned long long* rss; const float* bias; int ldb;
    __device__ __forceinline__ void operator()(const f32x4 (&acc)[2][2][4][2], const Unit& u, int wr, int wc, int fr, int fq) const {
        const int cond = u.pm < 16 ? 0 : 1 + ((u.pm - 16) >> 4);
        const int row0 = u.pm * BM + wr * 64 + fr, col0 = u.pn * HALF + wc * 32 + 8 * fq;
        const float* b = bias + (size_t)cond * ldb + u.pn * BM + wc * 32 + 8 * fq;
        const f32x4 bg0 = *(const f32x4*)(b), bg1 = *(const f32x4*)(b + 4), bu0 = *(const f32x4*)(b + HALF), bu1 = *(const f32x4*)(b + HALF + 4);
#pragma unroll
        for (int ai = 0; ai < 2; ++ai)
#pragma unroll
            for (int m = 0; m < 4; ++m) { const int row = row0 + ai * HALF + m * 16; const float rs = rstd_of(rss, row); bf16_t* rowp = O + (size_t)row * ldc + col0;
                const f32x4 g0 = acc[ai][0][m][0] * rs + bg0, g1 = acc[ai][0][m][1] * rs + bg1, u0 = acc[ai][1][m][0] * rs + bu0, u1 = acc[ai][1][m][1] * rs + bu1;
                u32x4 w; w.x = cvt_pk_bf16(qm(silu_f(g0[0]) * u0[0]), qm(silu_f(g0[1]) * u0[1])); w.y = cvt_pk_bf16(qm(silu_f(g0[2]) * u0[2]), qm(silu_f(g0[3]) * u0[3]));
                w.z = cvt_pk_bf16(qm(silu_f(g1[0]) * u1[0]), qm(silu_f(g1[1]) * u1[1])); w.w = cvt_pk_bf16(qm(silu_f(g1[2]) * u1[2]), qm(silu_f(g1[3]) * u1[3]));
                *(u32x4*)rowp = w; }
    }
};
struct EpiStoreQ {
    static constexpr bool PERM = true, AFTER_DRAIN = false;
    bf16_t* O; int ldc; const unsigned long long* rss; const float* sa; const float* sw; const float* bias; int ldb; int pm_off;
    __device__ __forceinline__ void operator()(const f32x4 (&acc)[2][2][4][2], const Unit& u, int wr, int wc, int fr, int fq) const {
        const int pmg = u.pm + pm_off, cond = pmg < 16 ? 0 : 1 + ((pmg - 16) >> 4);
        const int row0 = u.pm * BM + wr * 64 + fr, col0 = u.pn * BM + wc * 32 + 8 * fq;
        const float* b = bias + (size_t)cond * ldb + col0; const float* w = sw + col0;
        f32x4 bv[2][2], wv[2][2];
#pragma unroll
        for (int bj = 0; bj < 2; ++bj)
#pragma unroll
            for (int n = 0; n < 2; ++n) { bv[bj][n] = *(const f32x4*)(b + bj * HALF + 4 * n); wv[bj][n] = *(const f32x4*)(w + bj * HALF + 4 * n); }
#pragma unroll
        for (int ai = 0; ai < 2; ++ai)
#pragma unroll
            for (int m = 0; m < 4; ++m) { const int row = row0 + ai * HALF + m * 16; const float rs = rstd_of(rss, row) * sa[row]; bf16_t* rowp = O + (size_t)row * ldc + col0;
#pragma unroll
                for (int bj = 0; bj < 2; ++bj) { const f32x4 v0 = acc[ai][bj][m][0] * rs * wv[bj][0] + bv[bj][0], v1 = acc[ai][bj][m][1] * rs * wv[bj][1] + bv[bj][1];
                    u32x4 w4; w4.x = cvt_pk_bf16(v0[0], v0[1]); w4.y = cvt_pk_bf16(v0[2], v0[3]); w4.z = cvt_pk_bf16(v1[0], v1[1]); w4.w = cvt_pk_bf16(v1[2], v1[3]);
                    *(u32x4*)(rowp + bj * HALF) = w4; } }
    }
};
__device__ __forceinline__ float sat448(float x) { return __builtin_fminf(__builtin_fmaxf(x, -448.0f), 448.0f); }
struct EpiSwiGLUQ {
    static constexpr bool PERM = true, AFTER_DRAIN = false;
    unsigned char* O; int ldc; const unsigned long long* rss; const float* sa; const float* sw; const float* bias; int ldb; const float* act_s;
    __device__ __forceinline__ void operator()(const f32x4 (&acc)[2][2][4][2], const Unit& u, int wr, int wc, int fr, int fq) const {
        const int cond = u.pm < 16 ? 0 : 1 + ((u.pm - 16) >> 4);
        const int row0 = u.pm * BM + wr * 64 + fr, col0 = u.pn * HALF + wc * 32 + 8 * fq, bcol = u.pn * BM + wc * 32 + 8 * fq;
        const float* b = bias + (size_t)cond * ldb + bcol; const float* w = sw + bcol;
        const f32x4 bg0 = *(const f32x4*)(b), bg1 = *(const f32x4*)(b + 4), bu0 = *(const f32x4*)(b + HALF), bu1 = *(const f32x4*)(b + HALF + 4);
        const f32x4 wg0 = *(const f32x4*)(w), wg1 = *(const f32x4*)(w + 4), wu0 = *(const f32x4*)(w + HALF), wu1 = *(const f32x4*)(w + HALF + 4);
        const float as = act_s[0];
#pragma unroll
        for (int ai = 0; ai < 2; ++ai)
#pragma unroll
            for (int m = 0; m < 4; ++m) { const int row = row0 + ai * HALF + m * 16; const float rs = rstd_of(rss, row) * sa[row]; unsigned char* rowp = O + (size_t)row * ldc + col0;
                const f32x4 g0 = acc[ai][0][m][0] * rs * wg0 + bg0, g1 = acc[ai][0][m][1] * rs * wg1 + bg1, u0 = (acc[ai][1][m][0] * rs * wu0 + bu0) * as, u1 = (acc[ai][1][m][1] * rs * wu1 + bu1) * as;
                unsigned w0 = __builtin_amdgcn_cvt_pk_fp8_f32(sat448(silu_f(g0[0]) * u0[0]), sat448(silu_f(g0[1]) * u0[1]), 0, false); w0 = __builtin_amdgcn_cvt_pk_fp8_f32(sat448(silu_f(g0[2]) * u0[2]), sat448(silu_f(g0[3]) * u0[3]), w0, true);
                unsigned w1 = __builtin_amdgcn_cvt_pk_fp8_f32(sat448(silu_f(g1[0]) * u1[0]), sat448(silu_f(g1[1]) * u1[1]), 0, false); w1 = __builtin_amdgcn_cvt_pk_fp8_f32(sat448(silu_f(g1[2]) * u1[2]), sat448(silu_f(g1[3]) * u1[3]), w1, true);
                uint2 wv; wv.x = w0; wv.y = w1; *(uint2*)rowp = wv; }
    }
};
struct EpiResidN {
    static constexpr bool PERM = false, AFTER_DRAIN = false;
    const float* baseP; const float* baseS; float* out; const float* gate; const float* nw; const float* scl; unsigned long long* rss; long xs_delta;   float coef; int do_xs; long sa_delta, sw_delta; int q8; int xs_all = 0; long am_delta = 0;
    __device__ __forceinline__ void operator()(const f32x4 (&acc)[2][2][4][2], const Unit& u, int wr, int wc, int fr, int fq) const {
        const int cond = u.pm < 16 ? 0 : 1 + ((u.pm - 16) >> 4); const int do_xs = (this->do_xs && (xs_all || u.pm < 16)) ? this->do_xs : 0;     bf16_t* xs = (bf16_t*)((char*)rss + xs_delta); const float* sa = (const float*)((char*)rss + sa_delta); const float* swc = (const float*)((char*)rss + sw_delta);
        const float* g = gate + (size_t)cond * 18432; const float* base = u.pm < 16 ? baseP : baseS;
        const int row0 = u.pm * BM + wr * 64 + fr, col0 = u.pn * BM + wc * 32 + 4 * fq;
        f32x4 gv[2][2], av[2][2];
#pragma unroll
        for (int bj = 0; bj < 2; ++bj)
#pragma unroll
            for (int n = 0; n < 2; ++n) { gv[bj][n] = *(const f32x4*)(g + col0 + bj * HALF + n * 16) * coef; if (q8) gv[bj][n] = gv[bj][n] * *(const f32x4*)(swc + col0 + bj * HALF + n * 16);
                av[bj][n] = do_xs ? *(const f32x4*)(nw + col0 + bj * HALF + n * 16) * (*(const f32x4*)(scl + (size_t)cond * 18432 + col0 + bj * HALF + n * 16) + 1.0f) : (f32x4){0.f, 0.f, 0.f, 0.f}; }
#pragma unroll
        for (int ai = 0; ai < 2; ++ai)
#pragma unroll
            for (int m = 0; m < 4; ++m) { const int row = row0 + ai * HALF + m * 16; const size_t off = (size_t)row * 2048 + col0; float ss = 0.f, amx = 0.f; const float sr = q8 == 2 ? sa[0] : q8 ? sa[row] : 1.0f;
#pragma unroll
                for (int bj = 0; bj < 2; ++bj)
#pragma unroll
                    for (int n = 0; n < 2; ++n) { const f32x4 b = *(const f32x4*)(base + off + bj * HALF + n * 16); const f32x4 o = b + gv[bj][n] * (acc[ai][bj][m][n] * sr);
                        *(f32x4*)(out + off + bj * HALF + n * 16) = o;
                        if (do_xs) { f32x4 q = o * av[bj][n]; if (do_xs == 2) { q[0] = qm(q[0]); q[1] = qm(q[1]); q[2] = qm(q[2]); q[3] = qm(q[3]); } ss += (o[0] * o[0] + o[1] * o[1]) + (o[2] * o[2] + o[3] * o[3]); amx = fmaxf(fmaxf(amx, fmaxf(fabsf(q[0]), fabsf(q[1]))), fmaxf(fabsf(q[2]), fabsf(q[3])));
                            uint2 w2; w2.x = cvt_pk_bf16(q[0], q[1]); w2.y = cvt_pk_bf16(q[2], q[3]); *(uint2*)(xs + off + bj * HALF + n * 16) = w2; } }
                if (do_xs) { ss += __shfl_xor(ss, 16); ss += __shfl_xor(ss, 32); if (fq == 0) atomicAdd(rss + row, (unsigned long long)(ss * 16777216.0f));
                    if (xs_all) { amx = fmaxf(amx, __shfl_xor(amx, 16)); amx = fmaxf(amx, __shfl_xor(amx, 32)); if (fq == 0) atomicMax((unsigned*)((char*)rss + am_delta) + row, __float_as_uint(amx)); } }
                if (m == 3) asm volatile("" ::: "memory"); }
    }
};
typedef int i32x8 __attribute__((ext_vector_type(8)));
__device__ __forceinline__ void mfma_f8_128(f32x4& c, const i32x8 a, const i32x8 b) { asm volatile("v_mfma_f32_16x16x128_f8f6f4 %0, %1, %2, %0" : "+v"(c) : "v"(a), "v"(b)); }
template <class Epi, class Sched, bool ALIGN_EPI = false, bool SP2 = false, int I8 = 0>
__device__ __forceinline__ void gemm_phase(PG8_LAS unsigned char* lds, const Gemm g, const Sched& S, const Epi& E) {
    int tid_ = threadIdx.x; asm volatile("" : "+v"(tid_));
    const int tid = tid_, wid = __builtin_amdgcn_readfirstlane(tid >> 6), lane = tid & 63, wr = wid >> 2, wc = wid & 3, fr = lane & 15, fq = lane >> 4;
    const int K = g.K, nt = K / BK;
    unsigned voffA[2], voffB[2];
#pragma unroll
    for (int i = 0; i < 2; ++i) { int R, C; stage_rc(tid * 16 + i * 8192, R, C); const int Rb = Epi::PERM ? ((R & ~31) + perm32(R & 31)) : R;
        voffA[i] = (unsigned)(R * K + C) * 2u; voffB[i] = (unsigned)(Rb * BK + C) * 2u; }
    const size_t kstep = (size_t)(BK * 2);
    const size_t hstep = (size_t)HALF * K * 2;
    const size_t tstep = 2 * hstep;
    const size_t kstepB = (size_t)BM * BK * 2, hstepB = (size_t)HALF * BK * 2;
    const unsigned ldsw = (unsigned)wid * 1024u;
    const int aoff = lds_byte(wr * 64 + fr, fq * 8), boff = lds_byte(wc * 32 + fr, fq * 8);
#define PG8_SA(b, h) (((b) * 2 + (h)) * HTB)
#define PG8_SB(b, h) ((4 + (b) * 2 + (h)) * HTB)
#define PG8_STAGE(bufoff, gbase, voff) do { _Pragma("unroll") for (int _i = 0; _i < 2; ++_i) \
        __builtin_amdgcn_global_load_lds((const unsigned*)((const char*)(gbase) + (voff)[_i]), (PG8_LAS unsigned*)(lds + (bufoff) + ldsw + _i * 8192), 16, 0, 0); } while (0)
#define PG8_LDA(dst, b, h) do { _Pragma("unroll") for (int m = 0; m < 4; ++m) _Pragma("unroll") for (int k = 0; k < 2; ++k) dst[m][k] = *(const PG8_LAS bf16x8*)(lds + PG8_SA(b, h) + aoff + m * 2048 + k * 1024); } while (0)
#define PG8_LDB(dst, b, h) do { _Pragma("unroll") for (int n = 0; n < 2; ++n) _Pragma("unroll") for (int k = 0; k < 2; ++k) dst[n][k] = *(const PG8_LAS bf16x8*)(lds + PG8_SB(b, h) + boff + n * 2048 + k * 1024); } while (0)
#define PG8_MMA(ai, bj, At, Bt) do { __builtin_amdgcn_s_setprio(1); _Pragma("unroll") for (int m = 0; m < 4; ++m) _Pragma("unroll") for (int n = 0; n < 2; ++n) { if constexpr (I8 == 2) { \
        mfma_f8_128(acc[ai][bj][m][n], __builtin_shufflevector(__builtin_bit_cast(i32x4, Bt[n][0]), __builtin_bit_cast(i32x4, Bt[n][1]), 0, 1, 2, 3, 4, 5, 6, 7), \
            __builtin_shufflevector(__builtin_bit_cast(i32x4, At[m][0]), __builtin_bit_cast(i32x4, At[m][1]), 0, 1, 2, 3, 4, 5, 6, 7)); } else _Pragma("unroll") for (int k = 0; k < 2; ++k) { \
        if constexpr (I8 == 1) acc[ai][bj][m][n] = __builtin_bit_cast(f32x4, __builtin_amdgcn_mfma_i32_16x16x64_i8(__builtin_bit_cast(i32x4, Bt[n][k]), __builtin_bit_cast(i32x4, At[m][k]), __builtin_bit_cast(i32x4, acc[ai][bj][m][n]), 0, 0, 0)); \
        else acc[ai][bj][m][n] = __builtin_amdgcn_mfma_f32_16x16x32_bf16(Bt[n][k], At[m][k], acc[ai][bj][m][n], 0, 0, 0); } } __builtin_amdgcn_s_setprio(0); } while (0)
#define PG8_WAIT_V(n) asm volatile("s_waitcnt vmcnt(" #n ")" ::: "memory")
#define PG8_WAIT_L(n) asm volatile("s_waitcnt lgkmcnt(" #n ")" ::: "memory")
#define PG8_BAR __builtin_amdgcn_s_barrier()
#define PG8_SCHED __builtin_amdgcn_sched_barrier(0)
    Unit cur, nxt; int ui = 0;
    if (!S.next(0, cur)) return;
    f32x4 acc[2][2][4][2];
#pragma unroll
    for (int a = 0; a < 2; ++a)
#pragma unroll
        for (int b = 0; b < 2; ++b)
#pragma unroll
            for (int m = 0; m < 4; ++m)
#pragma unroll
                for (int n = 0; n < 2; ++n) acc[a][b][m][n] = (f32x4){0.f, 0.f, 0.f, 0.f};
    bf16x8 At[4][2], B0[2][2], B1[2][2];
    const char* cA = (const char*)g.A + (size_t)cur.pm * tstep; const char* cB = (const char*)g.Bt + (size_t)cur.pn * tstep;
    S.a_ready(cur);
    if constexpr (SP2) {
        PG8_STAGE(PG8_SB(0, 0), cB, voffB); PG8_STAGE(PG8_SB(0, 1), cB + hstepB, voffB); PG8_STAGE(PG8_SA(0, 0), cA, voffA); PG8_STAGE(PG8_SA(0, 1), cA + hstep, voffA);
        if (wr == 1) PG8_BAR;
        PG8_WAIT_V(2); PG8_BAR;
        PG8_STAGE(PG8_SB(1, 0), cB + kstepB, voffB); PG8_STAGE(PG8_SA(1, 0), cA + kstep, voffA); PG8_STAGE(PG8_SB(1, 1), cB + hstepB + kstepB, voffB);
        PG8_WAIT_V(6); PG8_BAR;
    } else {
        PG8_STAGE(PG8_SB(0, 0), cB, voffB); PG8_STAGE(PG8_SA(0, 0), cA, voffA); PG8_STAGE(PG8_SB(0, 1), cB + hstepB, voffB); PG8_STAGE(PG8_SA(0, 1), cA + hstep, voffA);
        if (wr == 1) PG8_BAR;
        PG8_WAIT_V(4); PG8_BAR;
        PG8_STAGE(PG8_SB(1, 0), cB + kstepB, voffB); PG8_STAGE(PG8_SA(1, 0), cA + kstep, voffA); PG8_STAGE(PG8_SB(1, 1), cB + hstepB + kstepB, voffB);
        PG8_WAIT_V(6); PG8_BAR;
    }
    for (;;) {
        const bool has_next = S.next(ui + 1, nxt);
        const char* nA = has_next ? (const char*)g.A + (size_t)nxt.pm * tstep : cA; const char* nB = has_next ? (const char*)g.Bt + (size_t)nxt.pn * tstep : cB;
        for (int t = 0; t < nt; t += 2) {
            const bool last = (t == nt - 2);
            const char* a1 = cA + (size_t)(t + 1) * kstep;
            const char* a2 = last ? nA : cA + (size_t)(t + 2) * kstep; const char* b2 = last ? nB : cB + (size_t)(t + 2) * kstepB;
            const char* a3 = a2 + kstep; const char* b3 = b2 + kstepB;
            if (last && has_next) S.a_ready(nxt);
            if constexpr (SP2) {
            PG8_LDB(B0, 0, 0); PG8_LDB(B1, 0, 1); PG8_SCHED; PG8_LDA(At, 0, 0); PG8_STAGE(PG8_SA(1, 1), a1 + hstep, voffA);
            PG8_WAIT_V(8); PG8_WAIT_L(0); PG8_BAR; PG8_MMA(0, 0, At, B0); PG8_MMA(0, 1, At, B1); PG8_BAR; PG8_SCHED;
            PG8_LDA(At, 0, 1); PG8_STAGE(PG8_SB(0, 0), b2, voffB); PG8_STAGE(PG8_SB(0, 1), b2 + hstepB, voffB); PG8_STAGE(PG8_SA(0, 0), a2, voffA);
            PG8_WAIT_V(8); PG8_WAIT_L(0); PG8_BAR; PG8_MMA(1, 0, At, B0); PG8_MMA(1, 1, At, B1); PG8_BAR; PG8_SCHED;
            PG8_LDB(B0, 1, 0); PG8_LDB(B1, 1, 1); PG8_SCHED; PG8_LDA(At, 1, 0); PG8_STAGE(PG8_SA(0, 1), a2 + hstep, voffA);
            PG8_WAIT_V(8); PG8_WAIT_L(0); PG8_BAR; PG8_MMA(0, 0, At, B0); PG8_MMA(0, 1, At, B1); PG8_BAR; PG8_SCHED;
            PG8_LDA(At, 1, 1); PG8_STAGE(PG8_SB(1, 0), b3, voffB); PG8_STAGE(PG8_SB(1, 1), b3 + hstepB, voffB); PG8_STAGE(PG8_SA(1, 0), a3, voffA);
            PG8_WAIT_V(8); PG8_WAIT_L(0); PG8_BAR; PG8_MMA(1, 0, At, B0); PG8_MMA(1, 1, At, B1); PG8_BAR; PG8_SCHED;
            } else {
            PG8_LDB(B0, 0, 0); PG8_SCHED; PG8_LDA(At, 0, 0); PG8_STAGE(PG8_SA(1, 1), a1 + hstep, voffA);
            PG8_WAIT_L(8); PG8_BAR; PG8_WAIT_L(0); PG8_MMA(0, 0, At, B0); PG8_BAR; PG8_SCHED;
            PG8_LDB(B1, 0, 1); PG8_STAGE(PG8_SB(0, 0), b2, voffB);
            PG8_BAR; PG8_WAIT_L(0); PG8_MMA(0, 1, At, B1); PG8_BAR;
            PG8_LDA(At, 0, 1); PG8_STAGE(PG8_SA(0, 0), a2, voffA);
            PG8_BAR; PG8_WAIT_L(0); PG8_MMA(1, 0, At, B0); PG8_BAR; PG8_SCHED;
            PG8_STAGE(PG8_SB(0, 1), b2 + hstepB, voffB);
            PG8_WAIT_V(6); PG8_BAR; PG8_MMA(1, 1, At, B1); PG8_BAR;
            PG8_LDB(B0, 1, 0); PG8_SCHED; PG8_LDA(At, 1, 0); PG8_STAGE(PG8_SA(0, 1), a2 + hstep, voffA);
            PG8_WAIT_L(8); PG8_BAR; PG8_WAIT_L(0); PG8_MMA(0, 0, At, B0); PG8_BAR; PG8_SCHED;
            PG8_LDB(B1, 1, 1); PG8_STAGE(PG8_SB(1, 0), b3, voffB);
            PG8_BAR; PG8_WAIT_L(0); PG8_MMA(0, 1, At, B1); PG8_BAR;
            PG8_LDA(At, 1, 1); PG8_STAGE(PG8_SA(1, 0), a3, voffA);
            PG8_BAR; PG8_WAIT_L(0); PG8_MMA(1, 0, At, B0); PG8_BAR; PG8_SCHED;
            PG8_STAGE(PG8_SB(1, 1), b3 + hstepB, voffB);
            PG8_WAIT_V(6); PG8_BAR; PG8_MMA(1, 1, At, B1); PG8_BAR;
            }
        }
        if constexpr (ALIGN_EPI) { if (wr == 0) PG8_BAR; }
        if constexpr (I8 == 2) asm volatile("s_nop 15\n\ts_nop 15" ::: "memory");
        if constexpr (I8 == 1) { _Pragma("unroll") for (int a = 0; a < 2; ++a) _Pragma("unroll") for (int b = 0; b < 2; ++b) _Pragma("unroll") for (int m = 0; m < 4; ++m) _Pragma("unroll") for (int n = 0; n < 2; ++n) acc[a][b][m][n] = __builtin_convertvector(__builtin_bit_cast(i32x4, acc[a][b][m][n]), f32x4); }
        if constexpr (!Epi::AFTER_DRAIN) { E(acc, cur, wr, wc, fr, fq); S.done(cur); }
        if (!has_next) break;
#pragma unroll
        for (int a = 0; a < 2; ++a)
#pragma unroll
            for (int b = 0; b < 2; ++b)
#pragma unroll
                for (int m = 0; m < 4; ++m)
#pragma unroll
                    for (int n = 0; n < 2; ++n) acc[a][b][m][n] = (f32x4){0.f, 0.f, 0.f, 0.f};
        cur = nxt; cA = nA; cB = nB; ++ui;
        if constexpr (ALIGN_EPI) { if (wr == 1) PG8_BAR; }
    }
    PG8_WAIT_V(0);
    if constexpr (!ALIGN_EPI) { if (wr == 0) PG8_BAR; }
    PG8_BAR;
    if constexpr (Epi::AFTER_DRAIN) { E.fused(acc, cur, wr, wc, fr, fq, lds, wid, lane); S.done(cur); }
#undef PG8_SA
#undef PG8_SB
#undef PG8_STAGE
#undef PG8_LDA
#undef PG8_LDB
#undef PG8_MMA
#undef PG8_WAIT_V
#undef PG8_WAIT_L
#undef PG8_BAR
#undef PG8_SCHED
}
}
namespace att {
using bf16x8 = __attribute__((ext_vector_type(8))) short;
using s16x4  = __attribute__((ext_vector_type(4))) short;
using f32x16 = __attribute__((ext_vector_type(16))) float;
using u32x4  = __attribute__((ext_vector_type(4))) unsigned;
typedef unsigned short bf16_t;
constexpr int NW = 8, QBLK = 32, KVBLK = 64;
constexpr float THR = 8.f;
constexpr int SHM_V = 64 * 128 * 2, SHM_K = 64 * 128 * 2, SHM_ATTN = 2 * SHM_V + 2 * SHM_K + NW * 64 * 4;
#define KSWZ(row, colB) ((row) * 256 + ((colB) ^ (((row) & 7) << 4)))
#define KSWZ64(row, colB) ((row) * 128 + ((colB) ^ ((((row) >> 1) & 7) << 4)))
#define SBAR() __builtin_amdgcn_sched_barrier(0)
__device__ __forceinline__ int crow(int r, int hi) { return (r & 3) + 8 * (r >> 2) + 4 * hi; }
__device__ __forceinline__ unsigned cvtpk(float lo, float hi) { unsigned r; asm volatile("v_cvt_pk_bf16_f32 %0, %1, %2" : "=v"(r) : "v"(lo), "v"(hi)); return r; }
__device__ __forceinline__ float bf2f(unsigned short b) { return __uint_as_float((unsigned)b << 16); }
__device__ __forceinline__ bf16x8 ld8(const bf16_t* p) { return *reinterpret_cast<const bf16x8*>(p); }

template <int DQK, bool PRE = false> __device__ __forceinline__ void partialSM(f32x16& p0, f32x16& p1, float& m_reg, float& mn, float& alpha) {
  constexpr float SCALE = PRE ? 0.6931471805599453f : ((DQK == 128) ? 0.088388347648318440f : 0.125f);
  constexpr float C = SCALE * 1.4426950408889634f;
  float pmax = p0[0];
#pragma unroll
  for (int r = 1; r < 16; ++r) pmax = fmaxf(pmax, p0[r]);
#pragma unroll
  for (int r = 0; r < 16; ++r) pmax = fmaxf(pmax, p1[r]);
  { auto rr = __builtin_amdgcn_permlane32_swap(__float_as_uint(pmax), __float_as_uint(pmax), false, false);
    pmax = fmaxf(__uint_as_float(rr[0]), __uint_as_float(rr[1])); }
  if (__builtin_expect(__all(pmax - m_reg <= THR / SCALE), 1)) { mn = m_reg; alpha = 1.f; }
  else { mn = fmaxf(m_reg, pmax); alpha = __builtin_amdgcn_exp2f((m_reg - mn) * C); m_reg = mn; }
  float mnC = -mn * C;
#pragma unroll
  for (int r = 0; r < 16; ++r) p0[r] = fmaf(p0[r], C, mnC);
#pragma unroll
  for (int r = 0; r < 16; ++r) p1[r] = fmaf(p1[r], C, mnC);
#pragma unroll
  for (int r = 0; r < 16; ++r) p0[r] = __builtin_amdgcn_exp2f(p0[r]);
}
#define PK4(P, BASE, OUT) do { unsigned a0 = cvtpk(P[BASE + 0], P[BASE + 1]), a1 = cvtpk(P[BASE + 2], P[BASE + 3]);   \
    unsigned b0 = cvtpk(P[BASE + 4], P[BASE + 5]), b1 = cvtpk(P[BASE + 6], P[BASE + 7]);                              \
    auto r0 = __builtin_amdgcn_permlane32_swap(a0, b0, false, false); auto r1 = __builtin_amdgcn_permlane32_swap(a1, b1, false, false); \
    u32x4 w = {r0[0], r1[0], r0[1], r1[1]}; OUT = *reinterpret_cast<bf16x8*>(&w); } while (0)
__device__ __forceinline__ void finishSM(f32x16& p0, f32x16& p1, float alpha, float& l_reg, bf16x8& pa0, bf16x8& pa1, bf16x8& pa2, bf16x8& pa3) {
#pragma unroll
  for (int r = 0; r < 16; ++r) p1[r] = __builtin_amdgcn_exp2f(p1[r]);
  float ps = 0;
#pragma unroll
  for (int r = 0; r < 16; ++r) ps += p0[r];
#pragma unroll
  for (int r = 0; r < 16; ++r) ps += p1[r];
  { auto rr = __builtin_amdgcn_permlane32_swap(__float_as_uint(ps), __float_as_uint(ps), false, false);
    ps = __uint_as_float(rr[0]) + __uint_as_float(rr[1]); }
  l_reg = l_reg * alpha + ps;
  PK4(p0, 0, pa0); PK4(p0, 8, pa1); PK4(p1, 0, pa2); PK4(p1, 8, pa3);
}
template <int DQK> __device__ __forceinline__ void qkt(f32x16& p0, f32x16& p1, const char* Ks, const bf16x8* qr, int r32, int hi) {
  constexpr int ND = DQK / 16;
  p0 = f32x16{}; p1 = f32x16{};
  bf16x8 b0[2], b1[2];
#define QK_RD(d0, s) do { const int cb_ = ((d0) * 16 + hi * 8) * 2; \
    if constexpr (DQK == 128) { b0[s] = *reinterpret_cast<const bf16x8*>(Ks + KSWZ(r32, cb_)); b1[s] = *reinterpret_cast<const bf16x8*>(Ks + KSWZ(32 + r32, cb_)); } \
    else { b0[s] = *reinterpret_cast<const bf16x8*>(Ks + KSWZ64(r32, cb_)); b1[s] = *reinterpret_cast<const bf16x8*>(Ks + KSWZ64(32 + r32, cb_)); } } while (0)
  QK_RD(0, 0); QK_RD(1, 1); SBAR();
#pragma unroll
  for (int d0 = 0; d0 < ND; ++d0) {
    p0 = __builtin_amdgcn_mfma_f32_32x32x16_bf16(b0[d0 & 1], qr[d0], p0, 0, 0, 0);
    p1 = __builtin_amdgcn_mfma_f32_32x32x16_bf16(b1[d0 & 1], qr[d0], p1, 0, 0, 0);
    if (d0 + 2 < ND) { QK_RD(d0 + 2, d0 & 1); }
    SBAR();
  }
#undef QK_RD
}
__device__ __forceinline__ int v_st(int k, int c) { const int kk = (k & ~0xC) | ((k & 4) << 1) | ((k & 8) >> 1); return ((kk >> 3) * 4 + (c >> 5)) * 512 + ((kk & 7) * 32 + (c & 31)) * 2; }
__device__ __forceinline__ int v_rd_base(int lane) { return ((lane & 3) << 3) | (((lane >> 2) & 3) << 6) | (((lane >> 4) & 1) << 5) | (((lane >> 5) & 1) << 8); }
constexpr int v_rd_off(int d0, int ks, int half) { return d0 * 512 + ks * 4096 + half * 2048; }
template <int OFF> __device__ __forceinline__ s16x4 tr_read(int vb) {
  s16x4 r; asm volatile("ds_read_b64_tr_b16 %0, %1 offset:%2" : "=&v"(r) : "v"(vb), "i"(OFF) : "memory"); return r;
}
#define PKF(L, H) (bf16x8){L[0], L[1], L[2], L[3], H[0], H[1], H[2], H[3]}
template <int D0> __device__ __forceinline__ void pv_one(f32x16& od, int vb, bf16x8 pa0, bf16x8 pa1, bf16x8 pa2, bf16x8 pa3) {
  const s16x4 l0 = tr_read<v_rd_off(D0, 0, 0)>(vb), h0 = tr_read<v_rd_off(D0, 0, 1)>(vb), l1 = tr_read<v_rd_off(D0, 1, 0)>(vb), h1 = tr_read<v_rd_off(D0, 1, 1)>(vb);
  const s16x4 l2 = tr_read<v_rd_off(D0, 2, 0)>(vb), h2 = tr_read<v_rd_off(D0, 2, 1)>(vb), l3 = tr_read<v_rd_off(D0, 3, 0)>(vb), h3 = tr_read<v_rd_off(D0, 3, 1)>(vb);
  asm volatile("s_waitcnt lgkmcnt(0)" ::: "memory"); SBAR();
  od = __builtin_amdgcn_mfma_f32_32x32x16_bf16(pa0, PKF(l0, h0), od, 0, 0, 0);
  od = __builtin_amdgcn_mfma_f32_32x32x16_bf16(pa1, PKF(l1, h1), od, 0, 0, 0);
  od = __builtin_amdgcn_mfma_f32_32x32x16_bf16(pa2, PKF(l2, h2), od, 0, 0, 0);
  od = __builtin_amdgcn_mfma_f32_32x32x16_bf16(pa3, PKF(l3, h3), od, 0, 0, 0);
}
#define PV_RD(D0, L, H) do { L[0] = tr_read<v_rd_off(D0, 0, 0)>(vb); H[0] = tr_read<v_rd_off(D0, 0, 1)>(vb); L[1] = tr_read<v_rd_off(D0, 1, 0)>(vb); H[1] = tr_read<v_rd_off(D0, 1, 1)>(vb); \
    L[2] = tr_read<v_rd_off(D0, 2, 0)>(vb); H[2] = tr_read<v_rd_off(D0, 2, 1)>(vb); L[3] = tr_read<v_rd_off(D0, 3, 0)>(vb); H[3] = tr_read<v_rd_off(D0, 3, 1)>(vb); } while (0)
#define PV_MM(OD, L, H) do { OD = __builtin_amdgcn_mfma_f32_32x32x16_bf16(pa0, PKF(L[0], H[0]), OD, 0, 0, 0); OD = __builtin_amdgcn_mfma_f32_32x32x16_bf16(pa1, PKF(L[1], H[1]), OD, 0, 0, 0); \
    OD = __builtin_amdgcn_mfma_f32_32x32x16_bf16(pa2, PKF(L[2], H[2]), OD, 0, 0, 0); OD = __builtin_amdgcn_mfma_f32_32x32x16_bf16(pa3, PKF(L[3], H[3]), OD, 0, 0, 0); } while (0)
__device__ __forceinline__ void pv_d0(f32x16* o, int vb, bf16x8 pa0, bf16x8 pa1, bf16x8 pa2, bf16x8 pa3) {
  s16x4 la[4], ha[4], lb[4], hb[4];
  PV_RD(0, la, ha); PV_RD(1, lb, hb);
  asm volatile("s_waitcnt lgkmcnt(8)" ::: "memory"); SBAR(); PV_MM(o[0], la, ha); SBAR();
  PV_RD(2, la, ha);
  asm volatile("s_waitcnt lgkmcnt(8)" ::: "memory"); SBAR(); PV_MM(o[1], lb, hb); SBAR();
  PV_RD(3, lb, hb);
  asm volatile("s_waitcnt lgkmcnt(8)" ::: "memory"); SBAR(); PV_MM(o[2], la, ha); SBAR();
  asm volatile("s_waitcnt lgkmcnt(0)" ::: "memory"); SBAR(); PV_MM(o[3], lb, hb);
}
#undef PV_RD
#undef PV_MM
__device__ __forceinline__ float half_sum32(float x) {
  x += __shfl_xor(x, 1); x += __shfl_xor(x, 2); x += __shfl_xor(x, 4); x += __shfl_xor(x, 8); x += __shfl_xor(x, 16); return x;
}

struct KVSrc { const bf16_t* K1; const bf16_t* V1; int n1; const bf16_t* K2; const bf16_t* V2; int n2; };
struct AttnOut { bf16_t* Ob; float* Of; const float* nw; float lam, post; int pass; };
template <int DQK, int MODE, int LD2, int SM = 0>
__device__ __forceinline__ void attn_body(const bf16_t* __restrict__ Qb, const KVSrc kv, const AttnOut ao, char* lds) {
  constexpr long ldq = 5120, LD1 = 5120; constexpr int LDO = 2048, LDF = 512;
  int tid_ = threadIdx.x; asm volatile("" : "+v"(tid_));
  const int tid = tid_, wid = tid >> 6, lane = tid & 63, r32 = lane & 31, hi = lane >> 5;
  char* V_lds = lds; char* K_lds = lds + 2 * SHM_V;
  float* ws = (float*)(lds + 2 * SHM_V + 2 * SHM_K) + wid * 64; float* li_l = ws; float* al_l = ws + 32;
  float m_reg = -1e30f, l_reg = 0; f32x16 o[4] = {}; bf16x8 qr[DQK / 16];
  const bf16_t* Qw = Qb + (long)(wid * QBLK + r32) * ldq + hi * 8;
#pragma unroll
  for (int d0 = 0; d0 < DQK / 16; ++d0) qr[d0] = ld8(Qw + d0 * 16);
  const int sr = tid >> 4, sc = (tid & 15) * 8, vst0 = v_st(sr, sc), vst1 = v_st(32 + sr, sc);
  const int kr64 = tid >> 3, kc64 = (tid & 7) * 8;
  const int vb0 = (int)(uintptr_t)V_lds + v_rd_base(lane);
  struct { bf16x8 vs0, vs1, ks0, ks1; } sr_[2];
#define SLOAD(i, k0) do { const int k0_ = (k0); const bool s1_ = k0_ < kv.n1; const bf16_t* kp_ = s1_ ? kv.K1 + (long)k0_ * LD1 : kv.K2 + (long)(k0_ - kv.n1) * LD2; \
    const bf16_t* vp_ = s1_ ? kv.V1 + (long)k0_ * LD1 : kv.V2 + (long)(k0_ - kv.n1) * LD2; const long ld_ = s1_ ? LD1 : (long)LD2; \
    sr_[i].vs0 = ld8(vp_ + (long)sr * ld_ + sc); sr_[i].vs1 = ld8(vp_ + (long)(32 + sr) * ld_ + sc); \
    if constexpr (DQK == 128) { sr_[i].ks0 = ld8(kp_ + (long)sr * ld_ + sc); sr_[i].ks1 = ld8(kp_ + (long)(32 + sr) * ld_ + sc); } \
    else { sr_[i].ks0 = ld8(kp_ + (long)kr64 * ld_ + kc64); } } while (0)
#define SWRITE(b, i) do { *(bf16x8*)(V_lds + (b) * SHM_V + vst0) = sr_[i].vs0; *(bf16x8*)(V_lds + (b) * SHM_V + vst1) = sr_[i].vs1; \
    if constexpr (DQK == 128) { const int kc = sc * 2; *(bf16x8*)(K_lds + (b) * SHM_K + KSWZ(sr, kc)) = sr_[i].ks0; *(bf16x8*)(K_lds + (b) * SHM_K + KSWZ(32 + sr, kc)) = sr_[i].ks1; } \
    else { *(bf16x8*)(K_lds + (b) * SHM_K + KSWZ64(kr64, kc64 * 2)) = sr_[i].ks0; } } while (0)
#define SWAIT() do { if constexpr (DQK == 128) asm volatile("s_waitcnt vmcnt(4)" ::: "memory"); else asm volatile("s_waitcnt vmcnt(3)" ::: "memory"); } while (0)
#define RESC(a) do { if (SM != 1 && __any((a) < 1.f)) { if (hi == 0) al_l[r32] = (a); asm volatile("s_waitcnt lgkmcnt(0)" ::: "memory"); \
    _Pragma("unroll") for (int d = 0; d < 4; ++d) _Pragma("unroll") for (int r = 0; r < 16; ++r) o[d][r] *= al_l[crow(r, hi)]; } } while (0)
  f32x16 pA0, pA1, pB0, pB1; float mnA = 0.f, mnB = 0.f, alA = 1.f, alB = 1.f; bf16x8 pa0, pa1, pa2, pa3; const int NT = (kv.n1 + kv.n2) / KVBLK; (void)mnA; (void)mnB;
#define PSM(P0, P1, MN, AL) do { if constexpr (SM == 1) { _Pragma("unroll") for (int r_ = 0; r_ < 16; ++r_) P0[r_] = __builtin_amdgcn_exp2f(P0[r_]); } else partialSM<DQK, SM == 2>(P0, P1, m_reg, MN, AL); } while (0)
  constexpr int SE = 0, SO = 1;
  SLOAD(SE, 0); asm volatile("s_waitcnt vmcnt(0)" ::: "memory"); SWRITE(0, SE); __syncthreads();
  qkt<DQK>(pA0, pA1, K_lds, qr, r32, hi); PSM(pA0, pA1, mnA, alA);
  SLOAD(SO, KVBLK); if (2 < NT) SLOAD(SE, 2 * KVBLK);
  SWAIT(); SWRITE(1, SO); __syncthreads();
  for (int j = 1; j + 1 < NT; j += 2) {
    SBAR(); qkt<DQK>(pB0, pB1, K_lds + SHM_K, qr, r32, hi);
    finishSM(pA0, pA1, alA, l_reg, pa0, pa1, pa2, pa3); SBAR();
    SLOAD(SO, (j + 2) * KVBLK); SBAR();
    pv_d0(o, vb0, pa0, pa1, pa2, pa3); PSM(pB0, pB1, mnB, alB);
    __syncthreads(); SWAIT(); SWRITE(0, SE);
    RESC(alB); __syncthreads();
    SBAR(); qkt<DQK>(pA0, pA1, K_lds, qr, r32, hi);
    finishSM(pB0, pB1, alB, l_reg, pa0, pa1, pa2, pa3); SBAR();
    if (j + 3 < NT) SLOAD(SE, (j + 3) * KVBLK); SBAR();
    pv_d0(o, vb0 + (int)SHM_V, pa0, pa1, pa2, pa3); PSM(pA0, pA1, mnA, alA);
    __syncthreads(); SWAIT(); SWRITE(1, SO);
    RESC(alA); __syncthreads();
  }
  SBAR(); qkt<DQK>(pB0, pB1, K_lds + SHM_K, qr, r32, hi);
  finishSM(pA0, pA1, alA, l_reg, pa0, pa1, pa2, pa3); SBAR();
  pv_d0(o, vb0, pa0, pa1, pa2, pa3); PSM(pB0, pB1, mnB, alB);
  __syncthreads(); RESC(alB);
  finishSM(pB0, pB1, alB, l_reg, pa0, pa1, pa2, pa3); SBAR();
  pv_d0(o, vb0 + (int)SHM_V, pa0, pa1, pa2, pa3);
  if (hi == 0) li_l[r32] = l_reg; asm volatile("s_waitcnt lgkmcnt(0)" ::: "memory");
  float rli[16];
#pragma unroll
  for (int r = 0; r < 16; ++r) rli[r] = __builtin_amdgcn_rcpf(li_l[crow(r, hi)]);
  bf16_t* stg = (bf16_t*)lds + wid * (QBLK * 128);
#define O_FLUSH(Ow) do { asm volatile("s_waitcnt lgkmcnt(0)" ::: "memory"); _Pragma("unroll") for (int i_ = 0; i_ < 8; ++i_) { const int row_ = i_ * 4 + (lane >> 4), ch_ = lane & 15; \
    const u32x4 v_ = *(const u32x4*)(stg + row_ * 128 + ch_ * 8); *(u32x4*)((Ow) + (long)row_ * LDO + ch_ * 8) = v_; } } while (0)
  if constexpr (MODE == 0) {
    bf16_t* Ow = ao.Ob + (long)(wid * QBLK) * LDO;
    __syncthreads();
#pragma unroll
    for (int r = 0; r < 16; ++r) { const int orow = crow(r, hi);
#pragma unroll
      for (int d0 = 0; d0 < 4; ++d0) { const float v = o[d0][r] * rli[r]; stg[orow * 128 + d0 * 32 + r32] = (bf16_t)(cvtpk(v, v) & 0xffffu); } }
    O_FLUSH(Ow);
  } else {
    float* Fw = ao.Of + (long)(wid * QBLK) * LDF;
    if (ao.pass == 0) {
#pragma unroll
      for (int r = 0; r < 16; ++r) { const int orow = crow(r, hi);
#pragma unroll
        for (int d0 = 0; d0 < 4; ++d0) Fw[(long)orow * LDF + d0 * 32 + r32] = o[d0][r] * rli[r]; }
    } else {
      bf16_t* Ow = ao.Ob + (long)(wid * QBLK) * LDO;
      __syncthreads();
#pragma unroll
      for (int r = 0; r < 16; ++r) { const int orow = crow(r, hi); float v[4]; float ss = 0.f;
#pragma unroll
        for (int d0 = 0; d0 < 4; ++d0) { v[d0] = Fw[(long)orow * LDF + d0 * 32 + r32] - ao.lam * (o[d0][r] * rli[r]); ss += v[d0] * v[d0]; }
        ss = half_sum32(ss); const float rs = rsqrtf(ss * (1.0f / 128.0f) + 1e-6f) * ao.post;
#pragma unroll
        for (int d0 = 0; d0 < 4; ++d0) { const float y = v[d0] * rs * ao.nw[d0 * 32 + r32]; stg[orow * 128 + d0 * 32 + r32] = (bf16_t)(cvtpk(y, y) & 0xffffu); } }
      O_FLUSH(Ow);
    }
  }
#undef O_FLUSH
#undef SLOAD
#undef SWRITE
#undef SWAIT
#undef RESC
#undef PSM
}
struct ChainArgs { const bf16_t* P;   int kcol, vcol; int nchunk; int dir; float lg2;
                   const float* S0;   bf16_t* ST;   float* Sfin;   };
__device__ __forceinline__ void ret_chain(const ChainArgs a, char* lds) {
  int tid_ = threadIdx.x; asm volatile("" : "+v"(tid_));
  const int tid = tid_, wid = tid >> 6, lane = tid & 63, r32 = lane & 31, hi = lane >> 5;
  const int eb = wid >> 1, dh = wid & 1;
  char* V_lds = lds; char* K_lds = lds + 2 * SHM_V;
  const int sr = tid >> 4, sc = (tid & 15) * 8;
  f32x16 acc[2];
#pragma unroll
  for (int j = 0; j < 2; ++j)
#pragma unroll
    for (int r = 0; r < 16; ++r) acc[j][r] = 0.f;
  if (a.S0) {
#pragma unroll
    for (int j = 0; j < 2; ++j)
#pragma unroll
      for (int r = 0; r < 16; ++r) acc[j][r] = a.S0[(size_t)(32 * (2 * dh + j) + r32) * 128 + 32 * eb + crow(r, hi)]; }
  const float gC = __builtin_amdgcn_exp2f(128.f * a.lg2);
  const int vbA = (int)(uintptr_t)V_lds + v_rd_base(lane) + eb * 512, vbB = (int)(uintptr_t)K_lds + v_rd_base(lane) + (2 * dh) * 512;
  bf16x8 kq[4], vq[4];
  { const int c0 = a.dir == 0 ? 0 : a.nchunk - 1; const bf16_t* rowp = a.P + (size_t)(c0 * 128) * 5120;
#pragma unroll
    for (int q = 0; q < 4; ++q) { const int k = 32 * q + sr; kq[q] = ld8(rowp + (size_t)k * 5120 + a.kcol + sc); vq[q] = ld8(rowp + (size_t)k * 5120 + a.vcol + sc); } }
  for (int s = 0; s < a.nchunk; ++s) {
    const int c = a.dir == 0 ? s : a.nchunk - 1 - s;
    bf16_t* st = a.ST + (size_t)c * 16384;
    __syncthreads();
#pragma unroll
    for (int q = 0; q < 4; ++q) { const int k = 32 * q + sr;
      const bf16x8 kv_ = kq[q], vv_ = vq[q];
      const float f = 0.088388347648318440f * __builtin_amdgcn_exp2f((a.dir == 0 ? (float)(127 - k) : (float)k) * a.lg2);
      u32x4 w; w.x = cvtpk(bf2f((unsigned short)kv_[0]) * f, bf2f((unsigned short)kv_[1]) * f); w.y = cvtpk(bf2f((unsigned short)kv_[2]) * f, bf2f((unsigned short)kv_[3]) * f);
      w.z = cvtpk(bf2f((unsigned short)kv_[4]) * f, bf2f((unsigned short)kv_[5]) * f); w.w = cvtpk(bf2f((unsigned short)kv_[6]) * f, bf2f((unsigned short)kv_[7]) * f);
      const int off = (q >> 1) * SHM_V + v_st(32 * (q & 1) + sr, sc);
      *(u32x4*)(K_lds + off) = w; *(bf16x8*)(V_lds + off) = vv_; }
    __syncthreads();
#pragma unroll
    for (int j = 0; j < 2; ++j)
#pragma unroll
      for (int r = 0; r < 16; ++r) { const float v = acc[j][r]; st[(32 * eb + crow(r, hi)) * 128 + 32 * (2 * dh + j) + r32] = (bf16_t)(cvtpk(v, v) & 0xffffu); }
    if (s + 1 < a.nchunk) { const int cn = a.dir == 0 ? s + 1 : a.nchunk - 2 - s; const bf16_t* rowp = a.P + (size_t)(cn * 128) * 5120;
#pragma unroll
      for (int q = 0; q < 4; ++q) { const int k = 32 * q + sr; kq[q] = ld8(rowp + (size_t)k * 5120 + a.kcol + sc); vq[q] = ld8(rowp + (size_t)k * 5120 + a.vcol + sc); } }
#pragma unroll
    for (int j = 0; j < 2; ++j)
#pragma unroll
      for (int r = 0; r < 16; ++r) acc[j][r] *= gC;
#pragma unroll
    for (int tt = 0; tt < 2; ++tt) {
      s16x4 al[4], ah[4], b0l[4], b0h[4], b1l[4], b1h[4];
#define RD4(ks) do { al[ks] = tr_read<v_rd_off(0, ks, 0)>(vbA + tt * SHM_V); ah[ks] = tr_read<v_rd_off(0, ks, 1)>(vbA + tt * SHM_V); \
      b0l[ks] = tr_read<v_rd_off(0, ks, 0)>(vbB + tt * SHM_V); b0h[ks] = tr_read<v_rd_off(0, ks, 1)>(vbB + tt * SHM_V); \
      b1l[ks] = tr_read<v_rd_off(1, ks, 0)>(vbB + tt * SHM_V); b1h[ks] = tr_read<v_rd_off(1, ks, 1)>(vbB + tt * SHM_V); } while (0)
      RD4(0); RD4(1); RD4(2); RD4(3);
#undef RD4
      asm volatile("s_waitcnt lgkmcnt(0)" ::: "memory"); SBAR();
#pragma unroll
      for (int ks = 0; ks < 4; ++ks) {
        acc[0] = __builtin_amdgcn_mfma_f32_32x32x16_bf16(PKF(al[ks], ah[ks]), PKF(b0l[ks], b0h[ks]), acc[0], 0, 0, 0);
        acc[1] = __builtin_amdgcn_mfma_f32_32x32x16_bf16(PKF(al[ks], ah[ks]), PKF(b1l[ks], b1h[ks]), acc[1], 0, 0, 0); }
    }
  }
  if (a.Sfin) {
#pragma unroll
    for (int j = 0; j < 2; ++j)
#pragma unroll
      for (int r = 0; r < 16; ++r) a.Sfin[(size_t)(32 * (2 * dh + j) + r32) * 128 + 32 * eb + crow(r, hi)] = acc[j][r];
  }
}
struct RetCArgs { const bf16_t* P;   int qcol, kcol, vcol, gcol; float lg2f, lg2b; const bf16_t* STf; const bf16_t* STb;
                  const float* gnw; bf16_t* O;   };
__device__ __forceinline__ void ret_c(const RetCArgs a, char* lds) {
  int tid_ = threadIdx.x; asm volatile("" : "+v"(tid_));
  const int tid = tid_, wid = tid >> 6, lane = tid & 63, r32 = lane & 31, hi = lane >> 5;
  char* V_lds = lds; char* K_lds = lds + 2 * SHM_V;
  const int cw = wid >> 2, ipos = 32 * (wid & 3) + r32;
  const int sr = tid >> 4, sc = (tid & 15) * 8;
  const int vb0 = (int)(uintptr_t)V_lds + v_rd_base(lane);
  bf16x8 qr[8];
  const bf16_t* Qw = a.P + (size_t)(wid * 32 + r32) * 5120 + a.qcol + hi * 8;
#pragma unroll
  for (int d0 = 0; d0 < 8; ++d0) qr[d0] = ld8(Qw + d0 * 16);
  f32x16 o[4] = {};
  for (int ch = 0; ch < 2; ++ch) {
    const bf16_t* rowp = a.P + (size_t)(ch * 128) * 5120;
    __syncthreads();
#pragma unroll
    for (int q = 0; q < 4; ++q) { const int k = 32 * q + sr;
      const bf16x8 kv_ = ld8(rowp + (size_t)k * 5120 + a.kcol + sc), vv_ = ld8(rowp + (size_t)k * 5120 + a.vcol + sc);
      *(bf16x8*)(K_lds + (q >> 1) * SHM_K + KSWZ(32 * (q & 1) + sr, sc * 2)) = kv_;
      *(bf16x8*)(V_lds + (q >> 1) * SHM_V + v_st(32 * (q & 1) + sr, sc)) = vv_; }
    __syncthreads();
    if (cw == ch) {
#pragma unroll
      for (int tt = 0; tt < 2; ++tt) {
        f32x16 p0, p1; qkt<128>(p0, p1, K_lds + tt * SHM_K, qr, r32, hi);
        int ip_ = ipos, hi_ = hi; asm volatile("" : "+v"(ip_), "+v"(hi_));
#pragma unroll
        for (int r = 0; r < 16; ++r) {
          const int j0 = 64 * tt + crow(r, hi_), d0_ = ip_ - j0, d1_ = d0_ - 32;
          const float f0 = d0_ > 0 ? __builtin_amdgcn_exp2f((float)d0_ * a.lg2f) : (d0_ < 0 ? __builtin_amdgcn_exp2f((float)(-d0_) * a.lg2b) : 2.0f);
          const float f1 = d1_ > 0 ? __builtin_amdgcn_exp2f((float)d1_ * a.lg2f) : (d1_ < 0 ? __builtin_amdgcn_exp2f((float)(-d1_) * a.lg2b) : 2.0f);
          p0[r] *= f0 * 0.088388347648318440f; p1[r] *= f1 * 0.088388347648318440f; }
        bf16x8 pa0, pa1, pa2, pa3; PK4(p0, 0, pa0); PK4(p0, 8, pa1); PK4(p1, 0, pa2); PK4(p1, 8, pa3);
        pv_d0(o, vb0 + tt * SHM_V, pa0, pa1, pa2, pa3);
      }
    }
  }
#pragma unroll
  for (int dir = 0; dir < 2; ++dir) {
    const float rs = dir == 0 ? __builtin_amdgcn_exp2f((float)(ipos + 1) * a.lg2f) : __builtin_amdgcn_exp2f((float)(128 - ipos) * a.lg2b);
    const bf16_t* S = (dir == 0 ? a.STf : a.STb) + (size_t)cw * 16384 + (size_t)r32 * 128 + hi * 8;
#pragma unroll
    for (int d0 = 0; d0 < 8; ++d0) {
      const bf16x8 q_ = qr[d0]; u32x4 w;
      w.x = cvtpk(bf2f((unsigned short)q_[0]) * rs, bf2f((unsigned short)q_[1]) * rs); w.y = cvtpk(bf2f((unsigned short)q_[2]) * rs, bf2f((unsigned short)q_[3]) * rs);
      w.z = cvtpk(bf2f((unsigned short)q_[4]) * rs, bf2f((unsigned short)q_[5]) * rs); w.w = cvtpk(bf2f((unsigned short)q_[6]) * rs, bf2f((unsigned short)q_[7]) * rs);
      const bf16x8 qs = *reinterpret_cast<bf16x8*>(&w);
#pragma unroll
      for (int eb = 0; eb < 4; ++eb) { const bf16x8 b = ld8(S + (size_t)eb * 32 * 128 + d0 * 16); o[eb] = __builtin_amdgcn_mfma_f32_32x32x16_bf16(qs, b, o[eb], 0, 0, 0); }
    }
  }
#pragma unroll
  for (int r = 0; r < 16; ++r) {
    const int row = wid * 32 + crow(r, hi);
    float s = (o[0][r] + o[1][r]) + (o[2][r] + o[3][r]); s = half_sum32(s); const float mean = s * (1.0f / 128.0f);
    float q = 0.f;
#pragma unroll
    for (int eb = 0; eb < 4; ++eb) { const float d = o[eb][r] - mean; q += d * d; }
    q = half_sum32(q); const float rstd = rsqrtf(q * (1.0f / 128.0f) + 1e-6f);
#pragma unroll
    for (int eb = 0; eb < 4; ++eb) { const int col = eb * 32 + r32;
      const float g = bf2f(a.P[(size_t)row * 5120 + a.gcol + col]);
      const float y = (o[eb][r] - mean) * rstd * a.gnw[col] * (g * __builtin_amdgcn_rcpf(1.0f + __builtin_amdgcn_exp2f(-1.4426950408889634f * g)));
      a.O[(size_t)row * 2048 + col] = (bf16_t)(cvtpk(y, y) & 0xffffu); }
  }
}
#undef KSWZ
#undef KSWZ64
#undef SBAR
#undef PK4
#undef PKF
}
constexpr int DM = 2048, M_P = 4096, M_S = 32768, MTOK = M_P + M_S, DFF = 5632, NFF = 11264, NIN = 5120, NMODC = 18432, NCOND = 9;
constexpr int C_RQ = 0, C_RK = 512, C_RV = 1024, C_RG = 1536, C_GQ = 2048, C_GK = 3072, C_GV = 3328, C_DQ = 3584, C_DK = 4096, C_DV = 4608;
constexpr float EPS = 1e-6f;
constexpr size_t MiB = 1u << 20;
constexpr size_t WS_CTL = 0, CTL_ZERO_BYTES = 1 * MiB;
constexpr size_t WS_TAB = 1 * MiB;
constexpr size_t WS_CACHE = 4 * MiB;
constexpr size_t WS_W = 16 * MiB;
constexpr size_t W_LAYER = 160 * MiB, W_WI = 0, W_WO = 88 * MiB, W_WIN = 132 * MiB, W_WOUT = 152 * MiB;
constexpr size_t WS_XN = WS_W + 2 * W_LAYER;
constexpr size_t WS_ACT = WS_XN + 144 * MiB;
constexpr size_t WS_ST = WS_ACT + 396 * MiB;
constexpr size_t WS_DF = WS_ST + 72 * MiB;
constexpr size_t WS_XNB = WS_DF + 72 * MiB;
constexpr size_t WS_SB = WS_XNB + 144 * MiB;
constexpr size_t SB_LAYER = 9 * (11264 + 5120 + 11264), SB_J1 = 9 * 11264, SB_J2 = 9 * (11264 + 5120);
constexpr size_t WS_RS = WS_SB + 2 * MiB;
constexpr size_t WS_Q = WS_RS + 2 * MiB;
constexpr size_t Q_SW = 256 * 1024, Q_SW2 = 512 * 1024, Q_SW4 = 832 * 1024, Q_ACT = 960 * 1024  , W_WINQ = 22 * MiB;
constexpr size_t WS_A8B = WS_Q + 1 * MiB;
constexpr size_t WS_END = WS_A8B + 198 * MiB;
constexpr int TB_MOD = 0, TB_COSG = 2 * 9 * 18432, TB_SING = TB_COSG + 64 * 32, TB_COSD = TB_SING + 64 * 32, TB_SIND = TB_COSD + 64 * 16, TB_SCAL = TB_SIND + 64 * 16;
constexpr int CW_BAR = 4096;
constexpr size_t CTL_RAW2 = 960 * 1024;
constexpr size_t CTL_AMAX = 64 * 1024;
constexpr size_t O_X = 0, O_STATE = 75497472, O_GK = 79691776, O_GV = 81788928, O_DK = 83886080, O_DV = 88080384, O_END = 92274688;
constexpr int LDS_BYTES = 147456, MISC_OFF = 131072 + 320;

typedef att::bf16_t bf16;
#define GAS __attribute__((address_space(1)))
#define LAS __attribute__((address_space(3)))
typedef unsigned v4u __attribute__((ext_vector_type(4)));
typedef float f32x4 __attribute__((ext_vector_type(4)));
typedef short bf16x8 __attribute__((ext_vector_type(8)));
typedef GAS unsigned gu32;
typedef GAS unsigned long long gu64;
#define RLX_AGENT __ATOMIC_RELAXED, __HIP_MEMORY_SCOPE_AGENT
#define LDS_WAIT() asm volatile("s_waitcnt lgkmcnt(0)" ::: "memory")
#define VM_WAIT() asm volatile("s_waitcnt vmcnt(0)" ::: "memory")
__device__ __forceinline__ unsigned long long rt() { return __builtin_amdgcn_s_memrealtime(); }
__device__ __forceinline__ unsigned f2bf(float f) { unsigned u = __builtin_bit_cast(unsigned, f); return (u + 0x7fffu + ((u >> 16) & 1u)) >> 16; }
__device__ __forceinline__ unsigned pk2(float lo, float hi) { return f2bf(lo) | (f2bf(hi) << 16); }
#define XB_TMO      128
#define XB_XCNT(j)  (256  + 64 * (j))
#define XB_XSUB(j)  (1280 + 64 * (j))
#define XB_XGEN(j)  (2304 + 64 * (j))
#define XB_TOP      3328
#define XB_TOPGEN   3392
#define XCD_BAR_WORDS 3456
#define XB_SPIN_CAP (1u << 18)

__device__ __forceinline__ unsigned xb_ld(unsigned* p)              { return __hip_atomic_load(p, __ATOMIC_RELAXED, __HIP_MEMORY_SCOPE_AGENT); }
__device__ __forceinline__ unsigned xb_add(unsigned* p, unsigned v) { return __hip_atomic_fetch_add(p, v, __ATOMIC_RELAXED, __HIP_MEMORY_SCOPE_AGENT); }
__device__ __forceinline__ unsigned xb_xcc_id() { return (unsigned)__builtin_amdgcn_s_getreg((3 << 11) | 20) & 0xFu; }
#define XB_SPIN(cond, bar) do { unsigned _sp = 0; while (cond) { __builtin_amdgcn_s_sleep(1); \
    if ((++_sp & 255u) == 0u) { if (xb_ld(&(bar)[XB_TMO])) break; if (_sp > XB_SPIN_CAP) { atomicAdd(&(bar)[XB_TMO], 1u); break; } } } } while (0)

struct XcdBarrier {
    unsigned* bar; unsigned x;
    volatile LAS unsigned* st;
};

__device__ __forceinline__ XcdBarrier xcd_barrier_post(unsigned* bar, volatile LAS unsigned* st) {
    XcdBarrier b; b.bar = bar; b.x = xb_xcc_id(); b.st = st;
    if (threadIdx.x == 0) (void)xb_add(&bar[XB_XCNT(b.x)], 1u);
    return b;
}
__device__ __forceinline__ void xcd_barrier_complete(unsigned* bar, unsigned x, unsigned& nloc, unsigned& nx) {
    const unsigned G = gridDim.x * gridDim.y * gridDim.z;
    unsigned sum, cnt, mine, sp = 0u;
    for (;;) {
        sum = 0u; cnt = 0u; mine = 0u;
#pragma unroll
        for (unsigned j = 0; j < 16; ++j) { const unsigned c = xb_ld(&bar[XB_XCNT(j)]); sum += c; cnt += (c > 0u) ? 1u : 0u; mine = (j == x) ? c : mine; }
        if (sum == G) break;
        __builtin_amdgcn_s_sleep(1);
        if ((++sp & 255u) == 0u) { if (xb_ld(&bar[XB_TMO])) break; if (sp > XB_SPIN_CAP) { atomicAdd(&bar[XB_TMO], 1u); break; } }
    }
    nloc = mine > 0u ? mine : 1u; nx = cnt > 0u ? cnt : 1u;
}

__device__ __forceinline__ void xcd_barrier(const XcdBarrier& b) {
    asm volatile("s_waitcnt vmcnt(0)" ::: "memory");
    __syncthreads();
    if (threadIdx.x == 0) {
        unsigned* bar = b.bar;
        __builtin_amdgcn_s_waitcnt(0);
        unsigned nloc = b.st[0], nx = b.st[1];
        if (nloc == 0u) { xcd_barrier_complete(bar, b.x, nloc, nx); b.st[0] = nloc; b.st[1] = nx; }
        const unsigned old = xb_add(&bar[XB_XSUB(b.x)], 1u);
        const unsigned gen = old / nloc;
        if (old + 1u == (gen + 1u) * nloc) {
            __builtin_amdgcn_fence(__ATOMIC_RELEASE, "agent");
            asm volatile("s_waitcnt vmcnt(0)" ::: "memory");
            const unsigned og = xb_add(&bar[XB_TOP], 1u);
            const unsigned tg = og / nx;
            if (og + 1u == (tg + 1u) * nx) xb_add(&bar[XB_TOPGEN], 1u);
            else XB_SPIN(xb_ld(&bar[XB_TOPGEN]) == tg, bar);
            __builtin_amdgcn_fence(__ATOMIC_ACQUIRE, "agent");
            xb_add(&bar[XB_XGEN(b.x)], 1u);
            asm volatile("s_waitcnt vmcnt(0)" ::: "memory");
        } else {
            XB_SPIN(xb_ld(&bar[XB_XGEN(b.x)]) == gen, bar);
            __builtin_amdgcn_fence(__ATOMIC_ACQUIRE, "agent");
            asm volatile("s_waitcnt vmcnt(0)" ::: "memory");
        }
    }
    __syncthreads();
}
__device__ __forceinline__ float wave_sum(float v) {
#pragma unroll
    for (int o = 1; o < 64; o <<= 1) v += __shfl_xor(v, o);
    return v;
}
__device__ __forceinline__ unsigned pkbf(float lo, float hi) { return pg8::cvt_pk_bf16(lo, hi); }
__device__ __forceinline__ float bf2f(unsigned short b) { return __uint_as_float((unsigned)b << 16); }
__device__ __forceinline__ void transpose_item(const float* W, int ldn, bf16* WT, int K, int k0, int srccol0, int dstrow0, LAS float* scr, int lane, bool qf = false) {
#pragma unroll 8
    for (int i = 0; i < 32; ++i) { const int kk = 2 * i + (lane >> 5); scr[kk * 33 + (lane & 31)] = W[(size_t)(k0 + kk) * ldn + srccol0 + (lane & 31)]; }
    LDS_WAIT(); asm volatile("" ::: "memory");
    const int c = lane & 7;
#pragma unroll
    for (int j = 0; j < 4; ++j) { const int n = (lane >> 3) + 8 * j; const LAS float* s = scr + (8 * c) * 33 + n;
        v4u o; if (qf) { o.x = pkbf(qm(s[0 * 33]), qm(s[1 * 33])); o.y = pkbf(qm(s[2 * 33]), qm(s[3 * 33])); o.z = pkbf(qm(s[4 * 33]), qm(s[5 * 33])); o.w = pkbf(qm(s[6 * 33]), qm(s[7 * 33])); }
        else { o.x = pkbf(s[0 * 33], s[1 * 33]); o.y = pkbf(s[2 * 33], s[3 * 33]); o.z = pkbf(s[4 * 33], s[5 * 33]); o.w = pkbf(s[6 * 33], s[7 * 33]); }
        const int dr = dstrow0 + n; *(GAS v4u*)(WT + ((size_t)((dr >> 8) * (K >> 6) + (k0 >> 6)) * 256 + (dr & 255)) * 64 + 8 * c) = o; }
    LDS_WAIT(); asm volatile("" ::: "memory");
}
template <class INP> __device__ __forceinline__ void absmax_item(const INP& inp, unsigned char* ws, int t, LAS float* red, int tid) {
    const int col = tid & 127, kq = tid >> 7;
    const float* src; size_t ld; int kb, kn, kind, mat, cb;
    if (t < 352) { kind = 0; mat = t / 88; cb = t % 88; src = inp[12] + (size_t)mat * DM * NFF + 128 * cb + col; ld = NFF; kb = 512 * kq; kn = 512; }
    else if (t < 432) { t -= 352; kind = 1; mat = t / 40; cb = t % 40; src = inp[14] + (size_t)mat * DM * NIN + 128 * cb + col; ld = NIN; kb = 512 * kq; kn = 512; }
    else { t -= 432; kind = 2; mat = t >> 6; cb = (t & 63) >> 2; src = inp[13] + (size_t)mat * DFF * DM + 128 * cb + col; ld = DM; kb = 1408 * (t & 3) + 352 * kq; kn = 352; }
    float mx = 0.f;
    for (int k = kb; k < kb + kn; k += 8) { float w[8];
#pragma unroll
        for (int u = 0; u < 8; ++u) w[u] = src[(size_t)(k + u) * ld];
#pragma unroll
        for (int u = 0; u < 8; ++u) mx = fmaxf(mx, fabsf(w[u])); }
    red[kq * 128 + col] = mx;
    __syncthreads();
    if (tid < 128) { const float m4 = fmaxf(fmaxf(red[tid], red[128 + tid]), fmaxf(red[256 + tid], red[384 + tid])); const int s0 = 128 * cb + tid;
        if (kind == 0) { const int brow = s0 < DFF ? (s0 / 128) * 256 + (s0 % 128) : ((s0 - DFF) / 128) * 256 + 128 + ((s0 - DFF) % 128);
            ((float*)(ws + WS_Q + Q_SW))[(size_t)mat * NFF + brow] = fmaxf(m4, 1e-30f) * (1.0f / 127.0f); }
        else if (kind == 1) ((float*)(ws + WS_Q + Q_SW4))[(size_t)mat * NIN + s0] = fmaxf(m4, 1e-30f) * (1.0f / 127.0f);
        else atomicMax((unsigned*)(ws + WS_CTL + CTL_RAW2) + (size_t)mat * DM + s0, __float_as_uint(m4)); }
    __syncthreads();
}
template <class INP> __device__ __forceinline__ void prologue(const INP& inp, unsigned char* ws, LAS unsigned char* lds, int G, int wg, int tid) {
    const int lane = tid & 63, wave = __builtin_amdgcn_readfirstlane(tid >> 6);
    float* tab = (float*)(ws + WS_TAB);
    {
        LAS float* sc = (LAS float*)lds;
        LAS float* red = sc + NCOND * DM;
        bool have = false;
        for (int it = wg; it < 976; it += G) {
            if (it >= 288) { absmax_item(inp, ws, it - 288, (LAS float*)(lds + 98304), tid); continue; }
            if (!have) { for (int i = tid; i < NCOND * DM; i += 512) { const int cd = i >> 11, k = i & 2047; const float v = cd == 0 ? inp[8][k] : inp[2][(cd - 1) * DM + k];
                              sc[i] = v / (1.0f + __expf(-v)); } have = true; __syncthreads(); }
            const int l = it / 144, cb = it % 144, col = tid & 127, g = tid >> 7;
            const float* W = inp[9] + (size_t)l * DM * NMODC + 128 * cb + col;
            float acc[NCOND];
#pragma unroll
            for (int c = 0; c < NCOND; ++c) acc[c] = 0.f;
            for (int k = 512 * g; k < 512 * g + 512; k += 8) {
                float w[8];
#pragma unroll
                for (int u = 0; u < 8; ++u) w[u] = W[(size_t)(k + u) * NMODC];
#pragma unroll
                for (int c = 0; c < NCOND; ++c) { const f32x4 s0 = *(const LAS f32x4*)(sc + c * DM + k), s1 = *(const LAS f32x4*)(sc + c * DM + k + 4);
                    acc[c] += (s0[0] * w[0] + s0[1] * w[1]) + (s0[2] * w[2] + s0[3] * w[3]) + (s1[0] * w[4] + s1[1] * w[5]) + (s1[2] * w[6] + s1[3] * w[7]); }
            }
#pragma unroll
            for (int c = 0; c < NCOND; ++c) red[(g * NCOND + c) * 128 + col] = acc[c];
            __syncthreads();
            for (int i = tid; i < NCOND * 128; i += 512) { const int c = i >> 7, cc = i & 127;
                const float s = ((red[(0 * NCOND + c) * 128 + cc] + red[(1 * NCOND + c) * 128 + cc]) + red[(2 * NCOND + c) * 128 + cc]) + red[(3 * NCOND + c) * 128 + cc];
                tab[TB_MOD + ((size_t)l * NCOND + c) * NMODC + 128 * cb + cc] = s + inp[10][(size_t)l * NMODC + 128 * cb + cc]; }
            __syncthreads();
        }
        __syncthreads();
    }
    if (wg == 0) {
        for (int i = tid; i < 64 * 32; i += 512) { const int pos = i >> 5, f = i & 31; const double inv = pow(10000.0, -(double)(2 * f) / 64.0), a = (double)pos * inv;
            tab[TB_COSG + i] = (float)cos(a); tab[TB_SING + i] = (float)sin(a); }
        for (int i = tid; i < 64 * 16; i += 512) { const int pos = i >> 4, f = i & 15; const double inv = pow(10000.0, -(double)(2 * f) / 32.0), a = (double)pos * inv;
            tab[TB_COSD + i] = (float)cos(a); tab[TB_SIND + i] = (float)sin(a); }
        if (tid < 2) { const int l = tid; const float* dl = inp[19] + l * 256; double s01 = 0.0, s23 = 0.0;
            for (int i = 0; i < 64; ++i) { s01 += (double)dl[i] * (double)dl[64 + i]; s23 += (double)dl[128 + i] * (double)dl[192 + i]; }
            const double li = 0.8 - 0.6 * exp(-0.3 * (double)l);
            tab[TB_SCAL + 16 * l + 0] = (float)(exp(s01) - exp(s23) + li); tab[TB_SCAL + 16 * l + 1] = (float)(1.0 - li); }
        if (tid >= 128 && tid < 130) { const int l = tid - 128; const float* w = inp[18] + l * 256; float mq = 0.f, mk = 0.f;
            for (int i = 0; i < 128; ++i) { mq = fmaxf(mq, fabsf(w[i])); mk = fmaxf(mk, fabsf(w[128 + i])); }
            tab[TB_SCAL + 16 * l + 10] = (mq * mk * 11.313708f * 1.4426950f < 60.0f) ? 1.0f : 0.0f; }
        if (tid >= 64 && tid < 80) { const int i = tid - 64, l = i >> 3, j = i & 7; const double x = (double)inp[16][l * 8 + j];
            tab[TB_SCAL + 16 * l + 2 + j] = (float)(-log1p(exp(-x)) * 1.4426950408889634); }
    }
    {
        bf16* cb = (bf16*)(ws + WS_CACHE);
        const long gt = (long)wg * 512 + tid, GT = (long)G * 512;
        for (int t = 0; t < 4; ++t) { const float* src = inp[4 + t]; const long n8 = (t < 2 ? 1048576 : 2097152) / 8; bf16* dst = cb + (t == 0 ? 0 : t == 1 ? 1048576 : t == 2 ? 2097152 : 4194304);
            for (long i = gt; i < n8; i += GT) { const f32x4 a = *(const f32x4*)(src + i * 8), b = *(const f32x4*)(src + i * 8 + 4);
                v4u o; o.x = pkbf(a[0], a[1]); o.y = pkbf(a[2], a[3]); o.z = pkbf(b[0], b[1]); o.w = pkbf(b[2], b[3]); *(v4u*)(dst + i * 8) = o; } }
    }
    {
        LAS float* scr = (LAS float*)(lds + wave * 16384);
        const int gw = wg * 8 + wave, NGW = G * 8;
        for (int it = gw; it < 81920; it += NGW) {
            const int l = it / 40960; int r = it % 40960;
            bf16* WL = (bf16*)(ws + WS_W + (size_t)l * W_LAYER);
            if (r < 22528) continue;
            if (false) { const int f = r / 11264, q = r % 11264, kb = q / 352, nb = q % 352, s0 = 32 * nb;
                const int drow = s0 < DFF ? (s0 / 128) * 256 + (s0 % 128) : ((s0 - DFF) / 128) * 256 + 128 + ((s0 - DFF) % 128);
                transpose_item(inp[12] + (size_t)(l * 2 + f) * DM * NFF, NFF, WL + (W_WI + (size_t)f * 44 * MiB) / 2, DM, 64 * kb, s0, drow, scr, lane, true); continue; }
            r -= 22528;
            if (r < 11264) continue;
            if (false) { const int f = r / 5632, q = r % 5632, kb = q / 64, nb = q % 64;
                transpose_item(inp[13] + (size_t)(l * 2 + f) * DFF * DM, DM, WL + (W_WO + (size_t)f * 22 * MiB) / 2, DFF, 64 * kb, 32 * nb, 32 * nb, scr, lane, true); continue; }
            r -= 11264;
            if (r < 5120) { const int kb = r / 160, nb = r % 160;
                transpose_item(inp[14] + (size_t)l * DM * NIN, NIN, WL + W_WIN / 2, DM, 64 * kb, 32 * nb, 32 * nb, scr, lane); continue; }
            r -= 5120;
            { const int kb = r / 64, nb = r % 64;
                transpose_item(inp[15] + (size_t)l * DM * DM, DM, WL + W_WOUT / 2, DM, 64 * kb, 32 * nb, 32 * nb, scr, lane); }
        }
    }
}
template <class INP> __device__ __forceinline__ void prologue_b(const INP& inp, unsigned char* ws, LAS unsigned char* lds, int G, int wg, int tid) {
    const int lane = tid & 63, wave = __builtin_amdgcn_readfirstlane(tid >> 6);
    LAS float* scr = (LAS float*)(lds + wave * 16384);
    const float* swv = (const float*)(ws + WS_Q + Q_SW);
    const int gw = wg * 8 + wave, NGW = G * 8;
    const float* swv4 = (const float*)(ws + WS_Q + Q_SW4);
    if (wg < 4) {
        float sm = 0.f; for (int i = tid; i < NFF; i += 512) sm += swv[(size_t)wg * NFF + i];
#pragma unroll
        for (int o = 1; o < 64; o <<= 1) sm += __shfl_xor(sm, o);
        LAS float* red = (LAS float*)(lds + 131072);
        if (lane == 0) red[wave] = sm;
        __syncthreads();
        if (tid == 0) { float t = 0.f; for (int i = 0; i < 8; ++i) t += red[i];
            const float sg = t * (127.0f / (float)NFF) * (1.0f / 3.6f) * 45.254834f;
            const float h0 = fmaxf(fmaxf(sg * sg, sg), 1e-20f); const float sc = exp2f(1.0f - rintf(log2f(h0)));
            float* qa = (float*)(ws + WS_Q + Q_ACT) + 2 * wg; qa[0] = sc; qa[1] = 1.0f / sc; }
        __syncthreads();
    }
    for (int it = gw; it < 10240; it += NGW) {
        const int l = it / 5120, q = it % 5120, kb = q / 160, nb = q % 160, s0 = 32 * nb, k0 = 64 * kb;
        const float* W = inp[14] + (size_t)l * DM * NIN;
        unsigned char* WQ = ws + WS_W + (size_t)l * W_LAYER + W_WINQ;
#pragma unroll 8
        for (int i = 0; i < 32; ++i) { const int kk = 2 * i + (lane >> 5); scr[kk * 33 + (lane & 31)] = W[(size_t)(k0 + kk) * NIN + s0 + (lane & 31)]; }
        LDS_WAIT(); asm volatile("" ::: "memory");
        const int c = lane & 7;
#pragma unroll
        for (int j = 0; j < 4; ++j) { const int n = (lane >> 3) + 8 * j, dr = s0 + n; const LAS float* sp = scr + (8 * c) * 33 + n;
            const float inv = 1.0f / swv4[(size_t)l * NIN + dr];
            unsigned lo = 0u, hi = 0u;
#pragma unroll
            for (int e = 0; e < 4; ++e) { lo |= ((unsigned)(__float2int_rn(sp[e * 33] * inv)) & 0xffu) << (8 * e); hi |= ((unsigned)(__float2int_rn(sp[(4 + e) * 33] * inv)) & 0xffu) << (8 * e); }
            const int kk = k0 + 8 * c;
            uint2 o; o.x = lo; o.y = hi;
            *(uint2*)(WQ + ((size_t)((dr >> 8) * (DM >> 7) + (kk >> 7)) * 256 + (dr & 255)) * 128 + (kk & 127)) = o; }
        LDS_WAIT(); asm volatile("" ::: "memory");
    }
    const unsigned* raw2 = (const unsigned*)(ws + WS_CTL + CTL_RAW2);
    for (int i = wg * 512 + tid; i < 4 * DM; i += G * 512) ((float*)(ws + WS_Q + Q_SW2))[i] = fmaxf(__uint_as_float(raw2[i]), 1e-30f) * (1.0f / 240.0f);
    for (int it = gw; it < 22528; it += NGW) {
        const int mat = it / 5632, q = it % 5632, kb = q / 64, nb = q % 64, s0 = 32 * nb, k0 = 64 * kb, l = mat >> 1, f = mat & 1;
        const float* W = inp[13] + (size_t)mat * DFF * DM;
        unsigned char* WQ = ws + WS_W + (size_t)l * W_LAYER + W_WO + (size_t)f * 22 * MiB;
#pragma unroll 8
        for (int i = 0; i < 32; ++i) { const int kk = 2 * i + (lane >> 5); scr[kk * 33 + (lane & 31)] = W[(size_t)(k0 + kk) * DM + s0 + (lane & 31)]; }
        LDS_WAIT(); asm volatile("" ::: "memory");
        const int c = lane & 7;
#pragma unroll
        for (int j = 0; j < 4; ++j) { const int n = (lane >> 3) + 8 * j, dr = s0 + n; const LAS float* sp = scr + (8 * c) * 33 + n;
            const float inv = 240.0f / fmaxf(__uint_as_float(raw2[(size_t)mat * DM + dr]), 1e-30f);
            unsigned lo = __builtin_amdgcn_cvt_pk_fp8_f32(sp[0] * inv, sp[33] * inv, 0, false); lo = __builtin_amdgcn_cvt_pk_fp8_f32(sp[2 * 33] * inv, sp[3 * 33] * inv, lo, true);
            unsigned hi = __builtin_amdgcn_cvt_pk_fp8_f32(sp[4 * 33] * inv, sp[5 * 33] * inv, 0, false); hi = __builtin_amdgcn_cvt_pk_fp8_f32(sp[6 * 33] * inv, sp[7 * 33] * inv, hi, true);
            const int kk = k0 + 8 * c;
            uint2 o; o.x = lo; o.y = hi;
            *(uint2*)(WQ + ((size_t)((dr >> 8) * (DFF >> 7) + (kk >> 7)) * 256 + (dr & 255)) * 128 + (kk & 127)) = o; }
        LDS_WAIT(); asm volatile("" ::: "memory");
    }
    for (int it = gw; it < 45056; it += NGW) {
        const int mat = it / 11264, q = it % 11264, kb = q / 352, nb = q % 352, s0 = 32 * nb, k0 = 64 * kb, l = mat >> 1, f = mat & 1;
        const int drow = s0 < DFF ? (s0 / 128) * 256 + (s0 % 128) : ((s0 - DFF) / 128) * 256 + 128 + ((s0 - DFF) % 128);
        const float* W = inp[12] + (size_t)mat * DM * NFF;
        unsigned char* WQ = ws + WS_W + (size_t)l * W_LAYER + W_WI + (size_t)f * 44 * MiB;
#pragma unroll 8
        for (int i = 0; i < 32; ++i) { const int kk = 2 * i + (lane >> 5); scr[kk * 33 + (lane & 31)] = W[(size_t)(k0 + kk) * NFF + s0 + (lane & 31)]; }
        LDS_WAIT(); asm volatile("" ::: "memory");
        const int c = lane & 7;
#pragma unroll
        for (int j = 0; j < 4; ++j) { const int n = (lane >> 3) + 8 * j, dr = drow + n; const LAS float* sp = scr + (8 * c) * 33 + n;
            const float inv = 1.0f / swv[(size_t)mat * NFF + dr];
            unsigned lo = 0u, hi = 0u;
#pragma unroll
            for (int e = 0; e < 4; ++e) { lo |= ((unsigned)(__float2int_rn(sp[e * 33] * inv)) & 0xffu) << (8 * e); hi |= ((unsigned)(__float2int_rn(sp[(4 + e) * 33] * inv)) & 0xffu) << (8 * e); }
            const int kk = k0 + 8 * c;
            uint2 o; o.x = lo; o.y = hi;
            *(uint2*)(WQ + ((size_t)((dr >> 8) * (DM >> 7) + (kk >> 7)) * 256 + (dr & 255)) * 128 + (kk & 127)) = o; }
        LDS_WAIT(); asm volatile("" ::: "memory");
    }
}
__device__ __forceinline__ void quant_act_phase(const bf16* ACT, unsigned char* A8, float* sa, int G, int wg, int tid) {
    const int lane = tid & 63, wave = tid >> 6, gw = wg * 8 + wave, NGW = G * 8;
    for (int m = gw; m < MTOK; m += NGW) {
        const bf16* ar = ACT + (size_t)m * DFF;
        v4u v[11]; float mx = 0.f;
#pragma unroll
        for (int j = 0; j < 11; ++j) v[j] = *(const v4u*)(ar + 512 * j + 8 * lane);
#pragma unroll
        for (int j = 0; j < 11; ++j) { const unsigned w4[4] = {v[j].x, v[j].y, v[j].z, v[j].w};
#pragma unroll
            for (int e = 0; e < 4; ++e) mx = fmaxf(mx, fmaxf(fabsf(__uint_as_float(w4[e] << 16)), fabsf(__uint_as_float(w4[e] & 0xffff0000u)))); }
#pragma unroll
        for (int o = 1; o < 64; o <<= 1) mx = fmaxf(mx, __shfl_xor(mx, o));
        mx = fmaxf(mx, 1e-30f);
        if (lane == 0) sa[m] = mx * (1.0f / 127.0f);
        const float inv = 127.0f / mx; unsigned char* orow = A8 + (size_t)m * DFF;
#pragma unroll
        for (int j = 0; j < 11; ++j) { const unsigned w4[4] = {v[j].x, v[j].y, v[j].z, v[j].w}; unsigned o2[2] = {0u, 0u};
#pragma unroll
            for (int e = 0; e < 4; ++e) { const unsigned lo = (unsigned)__float2int_rn(__uint_as_float(w4[e] << 16) * inv) & 0xffu, hi = (unsigned)__float2int_rn(__uint_as_float(w4[e] & 0xffff0000u) * inv) & 0xffu;
                o2[e >> 1] |= (lo | (hi << 8)) << (16 * (e & 1)); }
            uint2 ov; ov.x = o2[0]; ov.y = o2[1]; *(uint2*)(orow + 512 * j + 8 * lane) = ov; }
    }
}
__device__ __forceinline__ void quant_xs_phase(const bf16* XS, const unsigned* amax, unsigned char* A8, float* sa, int G, int wg, int tid, int m_begin = 0) {
    const int lane = tid & 63, wave = tid >> 6, gw = wg * 8 + wave, NGW = G * 8;
    for (int m0 = m_begin + 2 * gw; m0 < MTOK; m0 += 2 * NGW) {
        v4u v[2][4]; float mx[2];
#pragma unroll
        for (int r = 0; r < 2; ++r) { const bf16* xr = XS + (size_t)(m0 + r) * DM; mx[r] = fmaxf(__uint_as_float(amax[m0 + r]), 1e-30f);
#pragma unroll
            for (int j = 0; j < 4; ++j) v[r][j] = *(const v4u*)(xr + 512 * j + 8 * lane); }
#pragma unroll
        for (int r = 0; r < 2; ++r) { const float inv = 127.0f / mx[r]; unsigned char* orow = A8 + (size_t)(m0 + r) * DM; if (lane == 0) sa[m0 + r] = mx[r] * (1.0f / 127.0f);
#pragma unroll
            for (int j = 0; j < 4; ++j) { const unsigned w4[4] = {v[r][j].x, v[r][j].y, v[r][j].z, v[r][j].w}; unsigned o2[2] = {0u, 0u};
#pragma unroll
                for (int e = 0; e < 4; ++e) { const unsigned lo = (unsigned)__float2int_rn(__uint_as_float(w4[e] << 16) * inv) & 0xffu, hi = (unsigned)__float2int_rn(__uint_as_float(w4[e] & 0xffff0000u) * inv) & 0xffu;
                    o2[e >> 1] |= (lo | (hi << 8)) << (16 * (e & 1)); }
                uint2 ov; ov.x = o2[0]; ov.y = o2[1]; *(uint2*)(orow + 512 * j + 8 * lane) = ov; } }
    }
}
__device__ __forceinline__ void quant_phase(const float* xP, const float* xS, const float* nw, const float* scl0  , unsigned char* A8, float* sa, unsigned long long* rss, int G, int wg, int tid, int m_begin = 0) {
    const int lane = tid & 63, wave = tid >> 6, gw = wg * 8 + wave, NGW = G * 8;
    for (int m = m_begin + gw; m < MTOK; m += NGW) {
        const float* xr = (m < M_P ? xP : xS) + (size_t)m * DM;
        const int cond = m < M_P ? 0 : 1 + ((m - M_P) >> 12);
        const float* scl = scl0 + (size_t)cond * NMODC;
        f32x4 h[8]; float ss = 0.f, mx = 0.f;
#pragma unroll
        for (int j = 0; j < 8; ++j) { const int c = 256 * j + 4 * lane; const f32x4 v = *(const f32x4*)(xr + c); ss += (v[0] * v[0] + v[1] * v[1]) + (v[2] * v[2] + v[3] * v[3]);
            h[j] = v * *(const f32x4*)(nw + c) * (*(const f32x4*)(scl + c) + 1.0f);
            mx = fmaxf(fmaxf(mx, fmaxf(fabsf(h[j][0]), fabsf(h[j][1]))), fmaxf(fabsf(h[j][2]), fabsf(h[j][3]))); }
        ss = wave_sum(ss);
#pragma unroll
        for (int o = 1; o < 64; o <<= 1) mx = fmaxf(mx, __shfl_xor(mx, o));
        mx = fmaxf(mx, 1e-30f);
        if (lane == 0) { rss[m] = (unsigned long long)(ss * 16777216.0f); sa[m] = mx * (1.0f / 127.0f); }
        const float inv = 127.0f / mx; unsigned char* orow = A8 + (size_t)m * DM;
#pragma unroll
        for (int j = 0; j < 8; ++j) { const unsigned w = ((unsigned)__float2int_rn(h[j][0] * inv) & 0xffu) | (((unsigned)__float2int_rn(h[j][1] * inv) & 0xffu) << 8) | (((unsigned)__float2int_rn(h[j][2] * inv) & 0xffu) << 16) | (((unsigned)__float2int_rn(h[j][3] * inv) & 0xffu) << 24);
            *(unsigned*)(orow + 256 * j + 4 * lane) = w; }
    }
}
__device__ __forceinline__ void norm0_phase(const float* xP, const float* xS, const float* nw, const float* mod  , bf16* XN, unsigned long long* rss, int G, int wg, int tid) {
    const int lane = tid & 63, wave = tid >> 6, gw = wg * 8 + wave, NGW = G * 8;
    for (int m = gw; m < MTOK; m += NGW) {
        const float* xr = (m < M_P ? xP : xS) + (size_t)m * DM;
        const int cond = m < M_P ? 0 : 1 + ((m - M_P) >> 12);
        const float* scl = mod + (size_t)cond * NMODC + DM;
        f32x4 v[8]; float ss = 0.f;
#pragma unroll
        for (int j = 0; j < 8; ++j) { v[j] = *(const f32x4*)(xr + 256 * j + 4 * lane); ss += (v[j][0] * v[j][0] + v[j][1] * v[j][1]) + (v[j][2] * v[j][2] + v[j][3] * v[j][3]); }
        ss = wave_sum(ss); if (lane == 0) rss[m] = (unsigned long long)(ss * 16777216.0f);
        bf16* orow = XN + (size_t)m * DM;
#pragma unroll
        for (int j = 0; j < 8; ++j) { const int c = 256 * j + 4 * lane; const f32x4 w = *(const f32x4*)(nw + c), s1 = *(const f32x4*)(scl + c);
            const f32x4 h = v[j] * w * (s1 + 1.0f);
            uint2 o; o.x = pkbf(qm(h[0]), qm(h[1])); o.y = pkbf(qm(h[2]), qm(h[3])); *(uint2*)(orow + c) = o; }
    }
}
__device__ __forceinline__ void bias_ffn_mfma(unsigned char* ws, LAS unsigned char* lds, int grp, int sub, int nsub, int tid) {
    typedef int i32x4_t __attribute__((ext_vector_type(4)));
    const int lane = tid & 63, wave = tid >> 6, l = grp >> 1, f = grp & 1;
    const float* mod = (const float*)(ws + WS_TAB) + TB_MOD + (size_t)l * NCOND * NMODC + (size_t)(6 * f) * DM;
    LAS unsigned char* D = lds;
    LAS float* red = (LAS float*)(lds + 65536);
    __syncthreads();
    for (int i = tid; i < 65536 / 16; i += 512) ((LAS v4u*)D)[i] = (v4u){0u, 0u, 0u, 0u};
    for (int c = wave; c < NCOND; c += 8) { float mx = 0.f; for (int k = lane; k < DM; k += 64) mx = fmaxf(mx, fabsf(mod[(size_t)c * NMODC + k]));
#pragma unroll
        for (int o = 1; o < 64; o <<= 1) mx = fmaxf(mx, __shfl_xor(mx, o));
        if (lane == 0) red[c] = fmaxf(mx, 1e-30f) * (1.0f / 127.0f); }
    __syncthreads();
    for (int i = tid; i < NCOND * DM; i += 512) { const int c = i >> 11, k = i & 2047; const float s0 = red[c], s1 = s0 * (1.0f / 127.0f), v = mod[(size_t)c * NMODC + k];
        const float d0 = rintf(v / s0), d1 = rintf((v - d0 * s0) / s1); const int off = ((k >> 6) * 16 + c) * 64 + (k & 63);
        D[off] = (unsigned char)(int)d0; D[32768 + off] = (unsigned char)(int)d1; }
    __syncthreads();
    const unsigned char* Bq = ws + WS_W + (size_t)l * W_LAYER + W_WI + (size_t)f * 44 * MiB;
    const float* swv = (const float*)(ws + WS_Q + Q_SW) + (size_t)(2 * l + f) * NFF;
    float* sb = (float*)(ws + WS_SB) + (size_t)l * SB_LAYER + (f ? SB_J2 : 0);
    const int jr = lane & 15, g = lane >> 4;
    for (int rg = sub * 8 + wave; rg < NFF / 16; rg += nsub * 8) {
        const int n = rg * 16 + jr;
        const unsigned char* wp = Bq + ((size_t)(n >> 8) * (DM >> 7) * 256 + (n & 255)) * 128 + 16 * g;
        i32x4_t a0 = {0, 0, 0, 0}, a1 = {0, 0, 0, 0};
#pragma unroll 4
        for (int kb = 0; kb < 32; ++kb) {
            const i32x4_t w = *(const i32x4_t*)(wp + (size_t)(kb >> 1) * 256 * 128 + (kb & 1) * 64);
            const i32x4_t d0 = *(const LAS i32x4_t*)(D + ((kb * 16 + jr) * 64 + 16 * g)), d1 = *(const LAS i32x4_t*)(D + 32768 + ((kb * 16 + jr) * 64 + 16 * g));
            a0 = __builtin_amdgcn_mfma_i32_16x16x64_i8(w, d0, a0, 0, 0, 0); a1 = __builtin_amdgcn_mfma_i32_16x16x64_i8(w, d1, a1, 0, 0, 0);
        }
        if (jr < NCOND) { const float s0 = red[jr], s1 = s0 * (1.0f / 127.0f);
#pragma unroll
            for (int r = 0; r < 4; ++r) { const int nn = rg * 16 + 4 * g + r; sb[(size_t)jr * NFF + nn] = swv[nn] * (s0 * (float)a0[r] + s1 * (float)a1[r]); } }
    }
    __syncthreads();
}
__device__ __forceinline__ void bias_phase(unsigned char* ws, LAS unsigned char* lds, int G, int wg, int tid) {
    const int lane = tid & 63, wave = tid >> 6, gw = wg * 8 + wave, NGW = G * 8;
    LAS float* sh = (LAS float*)lds;
    const float* tab = (const float*)(ws + WS_TAB);
    const int per = G / 4; const bool mf = per >= 1;
    if (mf && wg < 4 * per) bias_ffn_mfma(ws, lds, wg / per, wg % per, per, tid);
    for (int grp = 0; grp < 6; ++grp) {
        const int l = grp / 3, j = grp % 3, N = (j == 1) ? NIN : NFF;
        if (mf && j != 1) continue;
        const bf16* Bt = (const bf16*)(ws + WS_W + (size_t)l * W_LAYER + (j == 0 ? W_WI : j == 1 ? W_WIN : W_WI + 44 * MiB));
        float* sb = (float*)(ws + WS_SB) + (size_t)l * SB_LAYER + (j == 0 ? 0 : j == 1 ? SB_J1 : SB_J2);
        const float* mod = tab + TB_MOD + (size_t)l * NCOND * NMODC + (size_t)(3 * j) * DM;
        __syncthreads();
        for (int i = tid; i < NCOND * DM; i += 512) sh[i] = mod[(size_t)(i >> 11) * NMODC + (i & 2047)];
        __syncthreads();
        if (j != 1) {
            const unsigned char* Bq = (const unsigned char*)Bt; const float* swv = (const float*)(ws + WS_Q + Q_SW) + (size_t)(2 * l + (j >> 1)) * NFF;
            for (int n = gw; n < N; n += NGW) {
                v4u wr2[2];
#pragma unroll
                for (int q = 0; q < 2; ++q) { const int k_ = 16 * (lane + 64 * q); wr2[q] = *(const v4u*)(Bq + ((size_t)((n >> 8) * (DM >> 7) + (k_ >> 7)) * 256 + (n & 255)) * 128 + (k_ & 127)); }
                float wf[2][16];
#pragma unroll
                for (int q = 0; q < 2; ++q) { const unsigned ww[4] = {wr2[q].x, wr2[q].y, wr2[q].z, wr2[q].w};
#pragma unroll
                    for (int e = 0; e < 16; ++e) wf[q][e] = (float)(int)(signed char)((ww[e >> 2] >> (8 * (e & 3))) & 0xffu); }
                const float swn = swv[n];
#pragma unroll 1
                for (int c = 0; c < NCOND; ++c) { float a = 0.f;
#pragma unroll
                    for (int q = 0; q < 2; ++q) { const int k = 16 * (lane + 64 * q);
#pragma unroll
                        for (int e4 = 0; e4 < 4; ++e4) { const f32x4 s0 = *(const LAS f32x4*)(sh + c * DM + k + 4 * e4); a += (s0[0] * wf[q][4 * e4] + s0[1] * wf[q][4 * e4 + 1]) + (s0[2] * wf[q][4 * e4 + 2] + s0[3] * wf[q][4 * e4 + 3]); } }
                    const float t = wave_sum(a); if (lane == 0) sb[(size_t)c * N + n] = t * swn; }
            }
            continue;
        }
        v4u wq[4];
        if (gw < N) {
#pragma unroll
            for (int q = 0; q < 4; ++q) { const int k_ = 8 * (lane + 64 * q); wq[q] = *(const v4u*)(Bt + ((size_t)((gw >> 8) * (DM >> 6) + (k_ >> 6)) * 256 + (gw & 255)) * 64 + (k_ & 63)); } }
        for (int n = gw; n < N; n += NGW) {
            v4u wc_[4];
#pragma unroll
            for (int q = 0; q < 4; ++q) wc_[q] = wq[q];
            if (n + NGW < N) {
#pragma unroll
                for (int q = 0; q < 4; ++q) { const int k_ = 8 * (lane + 64 * q), n_ = n + NGW; wq[q] = *(const v4u*)(Bt + ((size_t)((n_ >> 8) * (DM >> 6) + (k_ >> 6)) * 256 + (n_ & 255)) * 64 + (k_ & 63)); } }
            float wf[4][8];
#pragma unroll
            for (int q = 0; q < 4; ++q) { const v4u w4 = wc_[q];
                wf[q][0] = __uint_as_float(w4.x << 16); wf[q][1] = __uint_as_float(w4.x & 0xffff0000u); wf[q][2] = __uint_as_float(w4.y << 16); wf[q][3] = __uint_as_float(w4.y & 0xffff0000u);
                wf[q][4] = __uint_as_float(w4.z << 16); wf[q][5] = __uint_as_float(w4.z & 0xffff0000u); wf[q][6] = __uint_as_float(w4.w << 16); wf[q][7] = __uint_as_float(w4.w & 0xffff0000u); }
#pragma unroll 1
            for (int c = 0; c < NCOND; ++c) { float a = 0.f;
#pragma unroll
                for (int q = 0; q < 4; ++q) { const int k = 8 * (lane + 64 * q); const f32x4 s0 = *(const LAS f32x4*)(sh + c * DM + k), s1 = *(const LAS f32x4*)(sh + c * DM + k + 4);
                    a += (s0[0] * wf[q][0] + s0[1] * wf[q][1]) + (s0[2] * wf[q][2] + s0[3] * wf[q][3]) + (s1[0] * wf[q][4] + s1[1] * wf[q][5]) + (s1[2] * wf[q][6] + s1[3] * wf[q][7]); }
                const float t = wave_sum(a); if (lane == 0) sb[(size_t)c * N + n] = t; }
        }
    }
    __syncthreads();
}
__device__ __forceinline__ void final_norm(float* x, const float* fw, int G, int wg, int tid) {
    const int lane = tid & 63, wave = tid >> 6, gw = wg * 8 + wave, NGW = G * 8;
    for (int m = gw; m < MTOK; m += NGW) {
        float* xr = x + (size_t)m * DM; f32x4 v[8]; float ss = 0.f;
#pragma unroll
        for (int j = 0; j < 8; ++j) { v[j] = *(const f32x4*)(xr + 256 * j + 4 * lane); ss += (v[j][0] * v[j][0] + v[j][1] * v[j][1]) + (v[j][2] * v[j][2] + v[j][3] * v[j][3]); }
        const float rstd = rsqrtf(wave_sum(ss) * (1.0f / DM) + EPS);
#pragma unroll
        for (int j = 0; j < 8; ++j) { const int c = 256 * j + 4 * lane; *(f32x4*)(xr + c) = (v[j] * rstd) * *(const f32x4*)(fw + c); }
    }
}
__device__ __forceinline__ void prep_row(int m, int l, bf16* PROJ, bf16* DST, const float* tab, const float* qkw  , float* out, int lane) {
    bf16* pr = PROJ + (size_t)m * NIN; bf16* pw = DST + (size_t)m * NIN;
    const bool lat = m >= M_P; const int t = lat ? ((m - M_P) & 4095) : (m & 255), b = lat ? ((m - M_P) >> 12) : (m >> 8);
    const int rr = t >> 6, cc = t & 63;
    unsigned rg[10], rd[8], rv2[2], rv4[4];
#pragma unroll
    for (int v = 0; v < 10; ++v) rg[v] = *(const unsigned*)(pr + (v < 8 ? C_GQ + 128 * v : C_GK + 128 * (v - 8)) + 2 * lane);
#pragma unroll
    for (int v = 0; v < 8; ++v) rd[v] = *(const unsigned*)(pr + (v < 4 ? C_DQ + 128 * v : C_DK + 128 * (v - 4)) + 2 * lane);
    if (!lat) {
#pragma unroll
        for (int v = 0; v < 2; ++v) rv2[v] = *(const unsigned*)(pr + C_GV + 128 * v + 2 * lane);
#pragma unroll
        for (int v = 0; v < 4; ++v) rv4[v] = *(const unsigned*)(pr + C_DV + 128 * v + 2 * lane);
    }
    const float wq0 = qkw[2 * lane], wq1 = qkw[2 * lane + 1], wk0 = qkw[128 + 2 * lane], wk1 = qkw[128 + 2 * lane + 1];
    float cs = 1.f, sn = 0.f, c2 = 1.f, s2 = 0.f;
    if (lat) { const int idx = lane < 32 ? rr * 32 + lane : cc * 32 + (lane - 32); cs = tab[TB_COSG + idx]; sn = tab[TB_SING + idx];
               const int p = lane & 31, id2 = p < 16 ? rr * 16 + p : cc * 16 + (p - 16); c2 = tab[TB_COSD + id2]; s2 = tab[TB_SIND + id2]; }
#pragma unroll
    for (int v = 0; v < 10; ++v) {
        const int col = (v < 8 ? C_GQ + 128 * v : C_GK + 128 * (v - 8)) + 2 * lane;
        const float x1 = bf2f((unsigned short)(rg[v] & 0xffffu)), x2 = bf2f((unsigned short)(rg[v] >> 16));
        const float rs = rsqrtf(wave_sum(x1 * x1 + x2 * x2) * (1.0f / 128.0f) + EPS);
        const float y1 = x1 * rs * (v < 8 ? wq0 : wk0), y2 = x2 * rs * (v < 8 ? wq1 : wk1);
        if (!lat && v >= 8) { float* o = out + O_GK + (((size_t)(b * 2 + l) * 256 + t) * 2 + (v - 8)) * 128 + 2 * lane; o[0] = y1; o[1] = y2; }
        const float qs = v < 8 ? 0.12751743f : 1.0f;
        *(unsigned*)(pw + col) = pkbf((y1 * cs - y2 * sn) * qs, (y1 * sn + y2 * cs) * qs);
    }
    if (lat) {
#pragma unroll
        for (int v = 0; v < 8; ++v) { const int col = (v < 4 ? C_DQ + 128 * v : C_DK + 128 * (v - 4)) + 2 * lane;
            const float x1 = bf2f((unsigned short)(rd[v] & 0xffffu)), x2 = bf2f((unsigned short)(rd[v] >> 16));
            *(unsigned*)(pw + col) = pkbf(x1 * c2 - x2 * s2, x1 * s2 + x2 * c2); }
    } else {
#pragma unroll
        for (int v = 0; v < 2; ++v) { float* o = out + O_GV + (((size_t)(b * 2 + l) * 256 + t) * 2 + v) * 128 + 2 * lane; o[0] = bf2f((unsigned short)(rv2[v] & 0xffffu)); o[1] = bf2f((unsigned short)(rv2[v] >> 16)); }
#pragma unroll
        for (int v = 0; v < 4; ++v) { const unsigned rk = rd[4 + v], rv = rv4[v];
            const size_t oi = (((size_t)(b * 2 + l) * 256 + t) * 4 + v) * 128 + 2 * lane;
            out[O_DK + oi] = bf2f((unsigned short)(rk & 0xffffu)); out[O_DK + oi + 1] = bf2f((unsigned short)(rk >> 16));
            out[O_DV + oi] = bf2f((unsigned short)(rv & 0xffffu)); out[O_DV + oi + 1] = bf2f((unsigned short)(rv >> 16)); }
    }
}
#ifndef EN_PRO
#define EN_PRO 1
#endif
#ifndef EN_NORM
#define EN_NORM 1
#endif
#ifndef EN_FFNIN
#define EN_FFNIN 1
#endif
#ifndef EN_FFNOUT
#define EN_FFNOUT 1
#endif
#ifndef EN_WIN
#define EN_WIN 1
#endif
#ifndef EN_P
#define EN_P 1
#endif
#ifndef EN_A
#define EN_A 1
#endif
#ifndef EN_A1
#define EN_A1 1
#endif
#ifndef EN_A2
#define EN_A2 1
#endif
#ifndef EN_A3
#define EN_A3 1
#endif
#ifndef EN_WOUT
#define EN_WOUT 1
#endif
#ifndef EN_FIN
#define EN_FIN 1
#endif
struct Args { const float* in[22]; float* out; unsigned char* ws; int ph_lo, ph_hi, pad0, pad1; };
constexpr int NPHASE = 30;
#define LAUNDER(p) asm volatile("" : "+s"(p))
struct InPtrs { const float* const* p; __device__ __forceinline__ const float* operator[](int i) const { return p[i]; } };
__device__ __forceinline__ int deal_unit(int i, int NL, int NC, int off, int G, int wg) {
    if (NL % G == 0) { const int nr = NL / G; if (i < nr) return i * G + wg; if (i > nr) return -1; const int c = (wg + G - off) % G; return c < NC ? NL + c : -1; }
    const int v = i * G + wg; return v < NL + NC ? v : -1;
}
__global__ void __launch_bounds__(512, 2) fwd_kernel(Args args) {
    extern __shared__ __attribute__((aligned(16))) unsigned char lds_raw[];
    LAS unsigned char* lds = (LAS unsigned char*)lds_raw;
    volatile LAS unsigned* MISC = (volatile LAS unsigned*)(lds + MISC_OFF);
    const int G = gridDim.x, wg = blockIdx.x;
    for (int u = threadIdx.x; u < (LDS_BYTES - 131072) / 4; u += 512) ((LAS unsigned*)(lds + 131072))[u] = 0u;
    __syncthreads();
    XcdBarrier bar = xcd_barrier_post((unsigned*)(args.ws + WS_CTL) + CW_BAR, MISC + 8);
    const int lo = args.ph_lo, hi = args.ph_hi;
#define IN(k) (lo <= (k) && (k) < hi)
#define SEAM(k) do { if (IN(k) && IN((k) + 1)) xcd_barrier(bar); } while (0)
#define PH_BEGIN size_t zoff_ = 0; asm volatile("" : "+s"(zoff_)); unsigned char* ws = args.ws + zoff_; float* out = args.out + zoff_;   \
    const InPtrs inp{args.in}; int tid = threadIdx.x; asm volatile("" : "+v"(tid)); \
    const int lane = tid & 63, wave = __builtin_amdgcn_readfirstlane(tid >> 6); (void)lane; (void)wave;

    if (IN(0)) { PH_BEGIN; (void)out; prologue(inp, ws, lds, G, wg, tid); }
    SEAM(0);
    if (IN(1)) { PH_BEGIN; (void)out; prologue_b(inp, ws, lds, G, wg, tid); }
    SEAM(1);
    if (IN(2)) { PH_BEGIN; (void)out;
        quant_phase(inp[0], inp[1] - (size_t)M_P * DM, inp[11], (const float*)(ws + WS_TAB) + TB_MOD + DM, ws + WS_XNB, (float*)(ws + WS_Q), (unsigned long long*)(ws + WS_RS), G, wg, tid);
        bias_phase(ws, lds, G, wg, tid); }
    SEAM(2);
#pragma unroll 1
    for (int l = 0; l < 2; ++l) {
        const int pb = 3 + 13 * l;
#pragma unroll 1
        for (int f = 0; f < 2; ++f) {
            const int fb = pb + 9 * f;
            if (IN(fb + 0)) { PH_BEGIN; (void)out; (void)inp; const bf16* WL = (const bf16*)(ws + WS_W + (size_t)l * W_LAYER);
                pg8::Gemm g{(const bf16*)(ws + WS_XNB), WL + (W_WI + (size_t)f * 44 * MiB) / 2, MTOK, NFF, DM / 2}; pg8::StaticOrder S; S.init(MTOK, NFF, G, wg);
                pg8::EpiSwiGLUQ E{ws + WS_A8B, DFF, (const unsigned long long*)(ws + WS_RS) + (size_t)(3 * l + 2 * f) * MTOK, (const float*)(ws + WS_Q), (const float*)(ws + WS_Q + Q_SW) + (size_t)(2 * l + f) * NFF,
                                  (const float*)(ws + WS_SB) + (size_t)l * SB_LAYER + (f ? SB_J2 : 0), NFF, (const float*)(ws + WS_Q + Q_ACT) + 2 * (2 * l + f)};
                pg8::gemm_phase<pg8::EpiSwiGLUQ, pg8::StaticOrder, true, true, true>(lds, g, S, E); }
            if (IN(fb + 0) && IN(fb + 2)) xcd_barrier(bar);
            if (IN(fb + 2)) { PH_BEGIN; float* X = out + O_X; const bool first = (l == 0 && f == 0); const unsigned char* WL8 = ws + WS_W + (size_t)l * W_LAYER + W_WO + (size_t)f * 22 * MiB;
                const float* tabf = (const float*)(ws + WS_TAB); const float* mod = tabf + TB_MOD + (size_t)l * NCOND * NMODC;
                pg8::Gemm g{(const bf16*)(ws + WS_A8B), (const bf16*)WL8, MTOK, DM, DFF / 2}; pg8::StaticOrder S; S.init(MTOK, DM, G, wg);
                const int ni = f ? 3 * (l + 1) : 3 * l + 1;
                const size_t rs_off = WS_RS + (size_t)ni * MTOK * 8;
                pg8::EpiResidN E{first ? inp[0] : X, first ? inp[1] - (size_t)M_P * DM : X, X, mod + (2 + 6 * f) * DM,
                                 inp[11] + (size_t)(f ? 3 : 3 * l + 1) * DM, f ? tabf + TB_MOD + (size_t)NCOND * NMODC + DM : mod + (size_t)4 * DM, (unsigned long long*)(ws + rs_off), (long)(f ? WS_ACT : WS_XN) - (long)rs_off, 0.5f, (f && l) ? 0 : 1,
                                 (long)(WS_Q + Q_ACT + (size_t)(2 * (2 * l + f) + 1) * 4) - (long)rs_off, (long)(WS_Q + Q_SW2 + (size_t)(2 * l + f) * DM * 4) - (long)rs_off, 2, 1, (long)(WS_CTL + CTL_AMAX + (size_t)ni * MTOK * 4) - (long)rs_off};
                pg8::gemm_phase<pg8::EpiResidN, pg8::StaticOrder, true, true, 2>(lds, g, S, E); }
            SEAM(fb + 2);
            if (f == 1) {
                if (l == 0 && IN(pb + 12)) { PH_BEGIN; float* X = out + O_X;
                    (void)X; quant_xs_phase((const bf16*)(ws + WS_ACT), (const unsigned*)(ws + WS_CTL + CTL_AMAX) + (size_t)3 * MTOK, ws + WS_XNB, (float*)(ws + WS_Q), G, wg, tid); }
                SEAM(pb + 12);
                break; }
            if (IN(pb + 3)) { PH_BEGIN; float* X = out + O_X;
                (void)X; quant_xs_phase((const bf16*)(ws + WS_XN), (const unsigned*)(ws + WS_CTL + CTL_AMAX) + (size_t)(3 * l + 1) * MTOK, ws + WS_XNB, (float*)(ws + WS_Q), G, wg, tid, M_P); }
            SEAM(pb + 3);
            if (IN(pb + 4)) {
                { PH_BEGIN; (void)out; (void)inp;
                  pg8::Gemm g{(const bf16*)(ws + WS_XNB + (size_t)M_P * DM), (const bf16*)(ws + WS_W + (size_t)l * W_LAYER + W_WINQ), M_S, NIN, DM / 2}; pg8::StaticOrder S; S.init(M_S, NIN, G, wg);
                  pg8::EpiStoreQ E{(bf16*)(ws + WS_ACT) + (size_t)M_P * NIN, NIN, (const unsigned long long*)(ws + WS_RS) + (size_t)(3 * l + 1) * MTOK + M_P, (const float*)(ws + WS_Q) + M_P,
                                   (const float*)(ws + WS_Q + Q_SW4) + (size_t)l * NIN, (const float*)(ws + WS_SB) + (size_t)l * SB_LAYER + SB_J1, NIN, 16};
                  pg8::gemm_phase<pg8::EpiStoreQ, pg8::StaticOrder, true, true, true>(lds, g, S, E); }
                { PH_BEGIN; (void)out; (void)inp; const bf16* WL = (const bf16*)(ws + WS_W + (size_t)l * W_LAYER);
                  pg8::Gemm g{(const bf16*)(ws + WS_XN), WL + W_WIN / 2, M_P, NIN, DM}; pg8::StaticOrder S; S.init(M_P, NIN, G, wg);
                  pg8::EpiStoreBf16N E{(bf16*)(ws + WS_ACT), NIN, (const unsigned long long*)(ws + WS_RS) + (size_t)(3 * l + 1) * MTOK, (const float*)(ws + WS_SB) + (size_t)l * SB_LAYER + SB_J1, NIN};
                  pg8::gemm_phase<pg8::EpiStoreBf16N, pg8::StaticOrder, true, true>(lds, g, S, E); }
            }
            SEAM(pb + 4);
            if (IN(pb + 5)) { PH_BEGIN; bf16* PROJ = (bf16*)(ws + WS_ACT); const float* tab = (const float*)(ws + WS_TAB);
#pragma unroll 1
                for (int ch = wg; ch < 192; ch += G) {
                    const bool lat = ch < 64; const int cc = lat ? ch : ch - 64, dir = cc & 1, h = (cc >> 1) & 3, b = cc >> 3;
                    att::ChainArgs a; a.P = PROJ + (size_t)(lat ? M_P + b * 4096 : b * 256) * NIN; a.kcol = C_RK + 128 * h; a.vcol = C_RV + 128 * h; a.nchunk = lat ? 32 : 2; a.dir = dir;
                    a.lg2 = tab[TB_SCAL + 16 * l + 2 + dir * 4 + h];
                    a.S0 = lat ? inp[3] + ((((size_t)b * 2 + l) * 2 + dir) * 4 + h) * 16384 : nullptr;
                    a.ST = (bf16*)(ws + WS_ST) + (lat ? (size_t)cc * 32 * 16384 : (size_t)64 * 32 * 16384 + (size_t)cc * 2 * 16384);
                    a.Sfin = lat ? nullptr : out + O_STATE + ((((size_t)b * 2 + l) * 2 + dir) * 4 + h) * 16384;
                    __syncthreads(); att::ret_chain(a, (char*)lds_raw);
                }
                const int w0 = G > 128 ? 64 : 0, gw = (wg - w0) * 8 + wave, NGW = (G - w0) * 8;
                if (wg >= w0) for (int m = gw; m < MTOK; m += NGW) prep_row(m, l, PROJ, PROJ, tab, inp[18] + l * 256, out, lane);
            }
            SEAM(pb + 5);
            if (IN(pb + 6)) { PH_BEGIN; (void)out; bf16* PROJ = (bf16*)(ws + WS_ACT); bf16* MIX = (bf16*)(ws + WS_XN); const float* tab = (const float*)(ws + WS_TAB);
                const bf16* CGK = (const bf16*)(ws + WS_CACHE);
#pragma unroll 1
                for (int rp = 0; rp < ((PROBE == 13 && l == 0) ? 2 : 1); ++rp)
#pragma unroll 1
                for (int i2 = 0;; ++i2) { const int ps = i2 & 1; const int u = deal_unit(i2 >> 1, 512, 64, 192, G, wg); if (u < 0) break;
                    const bool lat = u < 512; const int v = lat ? u : u - 512;
                    const int qb = lat ? (v & 15) : 0, h = lat ? ((v >> 4) & 3) : (v & 3), b = lat ? (v >> 6) : (v >> 2);
                    const size_t row0 = lat ? (size_t)M_P + (size_t)b * 4096 : (size_t)b * 256;
                    const float lam = tab[TB_SCAL + 16 * l + 0], post = tab[TB_SCAL + 16 * l + 1];
                    {
                        att::KVSrc kv; kv.K1 = PROJ + row0 * NIN + C_DK + 128 * h + 64 * ps; kv.V1 = PROJ + row0 * NIN + C_DV + 128 * h; kv.n1 = lat ? 4096 : 256;
                        kv.K2 = CGK + 2097152 + ((size_t)(b * 2 + l) * 256) * 512 + 128 * h + 64 * ps; kv.V2 = CGK + 4194304 + ((size_t)(b * 2 + l) * 256) * 512 + 128 * h; kv.n2 = lat ? 256 : 0;
                        att::AttnOut ao; ao.Ob = MIX + (row0 + 256 * qb) * DM + 1536 + 128 * h; ao.Of = (float*)(ws + WS_DF) + (row0 + 256 * qb) * 512 + 128 * h;
                        ao.nw = inp[20] + l * 512 + 128 * h; ao.lam = lam; ao.post = post; ao.pass = ps;
                        __syncthreads();
                        att::attn_body<64, 1, 512>(PROJ + (row0 + 256 * qb) * NIN + C_DQ + 128 * h + 64 * ps, kv, ao, (char*)lds_raw);
                    }
                }
                const bool nomax = tab[TB_SCAL + 16 * l + 10] != 0.f;
#pragma unroll 1
                for (int rp = 0; rp < ((PROBE == 14 && l == 0) ? 2 : 1); ++rp)
#pragma unroll 1
                for (int i = 0;; ++i) { const int u = deal_unit(i, 1024, 128, 64, G, wg); if (u < 0) break;
                    const bool lat = u < 1024; const int v = lat ? u : u - 1024;
                    const int qb = lat ? (v & 15) : 0, hq = lat ? ((v >> 4) & 7) : (v & 7), b = lat ? (v >> 7) : (v >> 3), kvh = hq >> 2;
                    const size_t row0 = lat ? (size_t)M_P + (size_t)b * 4096 : (size_t)b * 256;
                    att::KVSrc kv; kv.K1 = PROJ + row0 * NIN + C_GK + 128 * kvh; kv.V1 = PROJ + row0 * NIN + C_GV + 128 * kvh; kv.n1 = lat ? 4096 : 256;
                    kv.K2 = CGK + ((size_t)(b * 2 + l) * 256) * 256 + 128 * kvh; kv.V2 = CGK + 1048576 + ((size_t)(b * 2 + l) * 256) * 256 + 128 * kvh; kv.n2 = lat ? 256 : 0;
                    att::AttnOut ao; ao.Ob = MIX + (row0 + 256 * qb) * DM + 512 + 128 * hq; ao.Of = nullptr; ao.nw = nullptr; ao.lam = 0.f; ao.post = 0.f; ao.pass = 0;
                    __syncthreads();
                    if (nomax) att::attn_body<128, 0, 256, 1>(PROJ + (row0 + 256 * qb) * NIN + C_GQ + 128 * hq, kv, ao, (char*)lds_raw);
                    else att::attn_body<128, 0, 256, 2>(PROJ + (row0 + 256 * qb) * NIN + C_GQ + 128 * hq, kv, ao, (char*)lds_raw);
                }
#pragma unroll 1
                for (int rp = 0; rp < ((PROBE == 15 && l == 0) ? 2 : 1); ++rp)
#pragma unroll 1
                for (int i = 0;; ++i) { const int u = deal_unit(i, 512, 64, 0, G, wg); if (u < 0) break;
                    const bool lat = u < 512; const int v = lat ? u : u - 512;
                    const int pr = lat ? (v & 15) : 0, h = lat ? ((v >> 4) & 3) : (v & 3), b = lat ? (v >> 6) : (v >> 2);
                    const size_t row0 = (lat ? (size_t)M_P + (size_t)b * 4096 : (size_t)b * 256) + 256 * pr;
                    att::RetCArgs a; a.P = PROJ + row0 * NIN; a.qcol = C_RQ + 128 * h; a.kcol = C_RK + 128 * h; a.vcol = C_RV + 128 * h; a.gcol = C_RG + 128 * h;
                    a.lg2f = tab[TB_SCAL + 16 * l + 2 + h]; a.lg2b = tab[TB_SCAL + 16 * l + 6 + h];
                    const int cf = (b * 4 + h) * 2; const bf16* STB = (const bf16*)(ws + WS_ST);
                    a.STf = STB + (lat ? (size_t)cf * 32 * 16384 : (size_t)64 * 32 * 16384 + (size_t)cf * 2 * 16384) + (size_t)(2 * pr) * 16384;
                    a.STb = STB + (lat ? (size_t)(cf + 1) * 32 * 16384 : (size_t)64 * 32 * 16384 + (size_t)(cf + 1) * 2 * 16384) + (size_t)(2 * pr) * 16384;
                    a.gnw = inp[17] + l * 512 + 128 * h; a.O = MIX + row0 * DM + 128 * h;
                    __syncthreads();
                    att::ret_c(a, (char*)lds_raw);
                }
            }
            SEAM(pb + 6);
            if (IN(pb + 7)) { PH_BEGIN; float* X = out + O_X; const bf16* WL = (const bf16*)(ws + WS_W + (size_t)l * W_LAYER);
                const float* mod = (const float*)(ws + WS_TAB) + TB_MOD + (size_t)l * NCOND * NMODC;
                pg8::Gemm g{(const bf16*)(ws + WS_XN), WL + W_WOUT / 2, MTOK, DM, DM}; pg8::StaticOrder S; S.init(MTOK, DM, G, wg);
                const size_t rs_off = WS_RS + (size_t)(3 * l + 2) * MTOK * 8;
                pg8::EpiResidN E{X, X, X, mod + 5 * DM, inp[11] + ((size_t)l * 3 + 2) * DM, mod + 7 * DM, (unsigned long long*)(ws + rs_off), (long)WS_ACT - (long)rs_off, 1.0f, 1, (long)WS_Q - (long)rs_off, (long)WS_Q - (long)rs_off, 0, 1, (long)(WS_CTL + CTL_AMAX + (size_t)(3 * l + 2) * MTOK * 4) - (long)rs_off};
                pg8::gemm_phase<pg8::EpiResidN, pg8::StaticOrder, true, true>(lds, g, S, E); }
            SEAM(pb + 7);
            if (IN(pb + 8)) { PH_BEGIN; float* X = out + O_X;
                (void)X; quant_xs_phase((const bf16*)(ws + WS_ACT), (const unsigned*)(ws + WS_CTL + CTL_AMAX) + (size_t)(3 * l + 2) * MTOK, ws + WS_XNB, (float*)(ws + WS_Q), G, wg, tid); }
            SEAM(pb + 8);
        }
    }
    if (IN(29)) { PH_BEGIN; (void)ws; final_norm(out + O_X, inp[21], G, wg, tid); }
#undef IN
#undef SEAM
#undef PH_BEGIN
}

extern "C" void kernel_launch(void* const* d_in, const int* in_sizes, int n_in, void* d_out, int out_size, void* d_ws, size_t ws_size, hipStream_t stream) {
    static int grid = 0;
    if (grid == 0) {
        if (n_in != 22 || out_size != (int)O_END || ws_size < WS_END) { fprintf(stderr, "kernel_launch: unexpected shapes: n_in %d out %d ws %zu (need %zu)\n", n_in, out_size, ws_size, (size_t)WS_END); grid = -1; return; }
        int dev = 0, cus = 0, per_cu = 0;
        if (hipGetDevice(&dev) != hipSuccess || hipDeviceGetAttribute(&cus, hipDeviceAttributeMultiprocessorCount, dev) != hipSuccess) { grid = -1; return; }
        if (hipFuncSetAttribute((const void*)fwd_kernel, hipFuncAttributeMaxDynamicSharedMemorySize, LDS_BYTES) != hipSuccess) { fprintf(stderr, "kernel_launch: hipFuncSetAttribute failed\n"); grid = -1; return; }
        if (hipOccupancyMaxActiveBlocksPerMultiprocessor(&per_cu, (const void*)fwd_kernel, 512, LDS_BYTES) != hipSuccess || per_cu < 1) { fprintf(stderr, "kernel_launch: occupancy query says %d\n", per_cu); }
        (void)hipGetLastError();
        grid = cus;
    }
    if (grid < 0) return;
    (void)hipMemsetAsync((char*)d_ws + WS_CTL, 0, CTL_ZERO_BYTES, stream);
    (void)hipMemsetAsync((char*)d_ws + WS_RS, 0, 2 * MiB, stream);
    Args a{};
    for (int i = 0; i < 22; ++i) a.in[i] = (const float*)d_in[i];
    a.out = (float*)d_out; a.ws = (unsigned char*)d_ws; a.ph_lo = 0; a.ph_hi = NPHASE; a.pad0 = 0; a.pad1 = 0;
    hipLaunchKernelGGL(fwd_kernel, dim3(grid), dim3(512), LDS_BYTES, stream, a);
}
```

```cpp
#include <hip/hip_runtime.h>
#include <hip/hip_bf16.h>
#include <cstdio>
#include <cstdint>
#ifndef PROBE
#define PROBE 0
#endif
#ifndef FFN_MB
#define FFN_MB 4
#endif
__device__ __forceinline__ float qm(float x) { if (FFN_MB >= 7) return x; unsigned u = __float_as_uint(x); constexpr unsigned sh = 23 - FFN_MB; u = (u + ((1u << (sh - 1)) - 1u) + ((u >> sh) & 1u)) & ~((1u << sh) - 1u); return __uint_as_float(u); }
#ifndef DBGT_CLK
#define DBGT_CLK 0
#endif
#ifndef DBGT_PH
#define DBGT_PH -1
#endif
namespace pg8 {
#define PG8_LAS __attribute__((address_space(3)))
typedef unsigned short bf16_t;
typedef short bf16x8 __attribute__((ext_vector_type(8)));
typedef float f32x4 __attribute__((ext_vector_type(4)));
typedef unsigned u32x4 __attribute__((ext_vector_type(4)));
typedef int i32x4 __attribute__((ext_vector_type(4)));
constexpr int BM = 256, BK = 64, HALF = 128, HTB = HALF * BK * 2  , STAGE_BYTES = 8 * HTB, NXCD = 8, WGM = 4;

__host__ __device__ __forceinline__ int lds_byte(int r, int c) { const int st = (r >> 4) * 2 + (c >> 5), rr = r & 15, cc = c & 31, ob = rr * 64 + cc * 2; return st * 1024 + (ob ^ (((ob >> 9) & 1) << 5)); }
__host__ __device__ __forceinline__ void stage_rc(int b, int& R, int& C) { const int st = b / 1024, sb = b % 1024, swz = sb ^ (((sb >> 9) & 1) << 5); R = (st >> 1) * 16 + swz / 64; C = (st & 1) * 32 + (swz % 64) / 2; }
__host__ __device__ __forceinline__ int perm32(int rho) { const int n = rho >> 4, i = rho & 15; return 8 * (i >> 2) + 4 * n + (i & 3); }

struct Unit { int pm, pn; };
struct Gemm { const bf16_t* A; const bf16_t* Bt; int M, N, K; };

struct StaticOrder {
    int nM, nN, nwg, G, c;
    __host__ __device__ void init(int M, int N, int G_, int c_) { nM = M / BM; nN = N / BM; nwg = nM * nN; G = G_; c = c_; }
    __host__ __device__ bool next(int i, Unit& u) const {
        const long L = (long)i * G + c; if (L >= nwg) return false;
        int wgid = (int)L; { const int q = nwg / NXCD, r = nwg % NXCD, xcd = wgid % NXCD, off = wgid / NXCD; wgid = (xcd < r ? xcd * (q + 1) : r * (q + 1) + (xcd - r) * q) + off; }
        const int nig = WGM * nN, gid = wgid / nig, fm = gid * WGM, gsz = (nM - fm) < WGM ? (nM - fm) : WGM;
        u.pm = fm + ((wgid % nig) % gsz); u.pn = (wgid % nig) / gsz; return true;
    }
    __device__ __forceinline__ void a_ready(const Unit&) const {}
    __device__ __forceinline__ void done(const Unit&) const {}
};

__device__ __forceinline__ unsigned cvt_pk_bf16(float lo, float hi) { unsigned r; asm volatile("v_cvt_pk_bf16_f32 %0, %1, %2" : "=v"(r) : "v"(lo), "v"(hi)); return r; }
typedef float f32x2 __attribute__((ext_vector_type(2)));
struct EpiStoreBf16 {
    static constexpr bool PERM = true, AFTER_DRAIN = false;
    bf16_t* O; int ldc;
    __device__ __forceinline__ void operator()(const f32x4 (&acc)[2][2][4][2], const Unit& u, int wr, int wc, int fr, int fq) const {
        const int row0 = u.pm * BM + wr * 64 + fr, col0 = u.pn * BM + wc * 32 + 8 * fq;
#pragma unroll
        for (int ai = 0; ai < 2; ++ai)
#pragma unroll
            for (int m = 0; m < 4; ++m) { bf16_t* rowp = O + (size_t)(row0 + ai * HALF + m * 16) * ldc + col0;
#pragma unroll
                for (int bj = 0; bj < 2; ++bj) { const f32x4 v0 = acc[ai][bj][m][0], v1 = acc[ai][bj][m][1];
                    u32x4 w; w.x = cvt_pk_bf16(v0[0], v0[1]); w.y = cvt_pk_bf16(v0[2], v0[3]); w.z = cvt_pk_bf16(v1[0], v1[1]); w.w = cvt_pk_bf16(v1[2], v1[3]);
                    *(u32x4*)(rowp + bj * HALF) = w; } }
    }
};
__device__ __forceinline__ float silu_f(float g) { return g * __builtin_amdgcn_rcpf(1.0f + __builtin_amdgcn_exp2f(-1.4426950408889634f * g)); }
struct EpiSwiGLU {
    static constexpr bool PERM = true, AFTER_DRAIN = false;
    bf16_t* O; int ldc;
    __device__ __forceinline__ void operator()(const f32x4 (&acc)[2][2][4][2], const Unit& u, int wr, int wc, int fr, int fq) const {
        const int row0 = u.pm * BM + wr * 64 + fr, col0 = u.pn * HALF + wc * 32 + 8 * fq;
#pragma unroll
        for (int ai = 0; ai < 2; ++ai)
#pragma unroll
            for (int m = 0; m < 4; ++m) { bf16_t* rowp = O + (size_t)(row0 + ai * HALF + m * 16) * ldc + col0;
                const f32x4 g0 = acc[ai][0][m][0], g1 = acc[ai][0][m][1], u0 = acc[ai][1][m][0], u1 = acc[ai][1][m][1];
                u32x4 w; w.x = cvt_pk_bf16(silu_f(g0[0]) * u0[0], silu_f(g0[1]) * u0[1]); w.y = cvt_pk_bf16(silu_f(g0[2]) * u0[2], silu_f(g0[3]) * u0[3]);
                w.z = cvt_pk_bf16(silu_f(g1[0]) * u1[0], silu_f(g1[1]) * u1[1]); w.w = cvt_pk_bf16(silu_f(g1[2]) * u1[2], silu_f(g1[3]) * u1[3]);
                *(u32x4*)rowp = w; }
    }
};
struct EpiResid {
    static constexpr bool PERM = false, AFTER_DRAIN = false;
    const float* baseP; const float* baseS; float* out; const float* gate; float coef;
    __device__ __forceinline__ void operator()(const f32x4 (&acc)[2][2][4][2], const Unit& u, int wr, int wc, int fr, int fq) const {
        const int cond = u.pm < 16 ? 0 : 1 + ((u.pm - 16) >> 4);
        const float* g = gate + (size_t)cond * 18432; const float* base = u.pm < 16 ? baseP : baseS;
        const int row0 = u.pm * BM + wr * 64 + fr, col0 = u.pn * BM + wc * 32 + 4 * fq;
        f32x4 gv[2][2];
#pragma unroll
        for (int bj = 0; bj < 2; ++bj)
#pragma unroll
            for (int n = 0; n < 2; ++n) gv[bj][n] = *(const f32x4*)(g + col0 + bj * HALF + n * 16) * coef;
#pragma unroll
        for (int ai = 0; ai < 2; ++ai)
#pragma unroll
            for (int m = 0; m < 4; ++m) { const size_t off = (size_t)(row0 + ai * HALF + m * 16) * 2048 + col0;
#pragma unroll
                for (int bj = 0; bj < 2; ++bj)
#pragma unroll
                    for (int n = 0; n < 2; ++n) { const f32x4 b = *(const f32x4*)(base + off + bj * HALF + n * 16);
                        *(f32x4*)(out + off + bj * HALF + n * 16) = b + gv[bj][n] * acc[ai][bj][m][n]; }
                if (m == 3) asm volatile("" ::: "memory"); }
    }
};

__device__ __forceinline__ float rstd_of(const unsigned long long* rss, int row) { return rsqrtf((float)rss[row] * (1.0f / 16777216.0f) * (1.0f / 2048.0f) + 1e-6f); }
struct EpiStoreBf16N {
    static constexpr bool PERM = true, AFTER_DRAIN = false;
    bf16_t* O; int ldc; const unsigned long long* rss; const float* bias; int ldb;
    __device__ __forceinline__ void operator()(const f32x4 (&acc)[2][2][4][2], const Unit& u, int wr, int wc, int fr, int fq) const {
        const int cond = u.pm < 16 ? 0 : 1 + ((u.pm - 16) >> 4);
        const int row0 = u.pm * BM + wr * 64 + fr, col0 = u.pn * BM + wc * 32 + 8 * fq;
        const float* b = bias + (size_t)cond * ldb + col0;
        f32x4 bv[2][2];
#pragma unroll
        for (int bj = 0; bj < 2; ++bj)
#pragma unroll
            for (int n = 0; n < 2; ++n) bv[bj][n] = *(const f32x4*)(b + bj * HALF + 4 * n);
#pragma unroll
        for (int ai = 0; ai < 2; ++ai)
#pragma unroll
            for (int m = 0; m < 4; ++m) { const int row = row0 + ai * HALF + m * 16; const float rs = rstd_of(rss, row); bf16_t* rowp = O + (size_t)row * ldc + col0;
#pragma unroll
                for (int bj = 0; bj < 2; ++bj) { const f32x4 v0 = acc[ai][bj][m][0] * rs + bv[bj][0], v1 = acc[ai][bj][m][1] * rs + bv[bj][1];
                    u32x4 w; w.x = cvt_pk_bf16(v0[0], v0[1]); w.y = cvt_pk_bf16(v0[2], v0[3]); w.z = cvt_pk_bf16(v1[0], v1[1]); w.w = cvt_pk_bf16(v1[2], v1[3]);
                    *(u32x4*)(rowp + bj * HALF) = w; } }
    }
};
struct EpiSwiGLUN {
    static constexpr bool PERM = true, AFTER_DRAIN = false;
    bf16_t* O; int ldc; const unsigned long long* rss; const float* bias; int ldb;
    __device__ __forceinline__ void operator()(const f32x4 (&acc)[2][2][4][2], const Unit& u, int wr, int wc, int fr, int fq) const {
        const int cond = u.pm < 16 ? 0 : 1 + ((u.pm - 16) >> 4);
        const int row0 = u.pm * BM + wr * 64 + fr, col0 = u.pn * HALF + wc * 32 + 8 * fq;
        const float* b = bias + (size_t)cond * ldb + u.pn * BM + wc * 32 + 8 * fq;
        const f32x4 bg0 = *(const f32x4*)(b), bg1 = *(const f32x4*)(b + 4), bu0 = *(const f32x4*)(b + HALF), bu1 = *(const f32x4*)(b + HALF + 4);
#pragma unroll
        for (int ai = 0; ai < 2; ++ai)
#pragma unroll
            for (int m = 0; m < 4; ++m) { const int row = row0 + ai * HALF + m * 16; const float rs = rstd_of(rss, row); bf16_t* rowp = O + (size_t)row * ldc + col0;
                const f32x4 g0 = acc[ai][0][m][0] * rs + bg0, g1 = acc[ai][0][m][1] * rs + bg1, u0 = acc[ai][1][m][0] * rs + bu0, u1 = acc[ai][1][m][1] * rs + bu1;
                u32x4 w; w.x = cvt_pk_bf16(qm(silu_f(g0[0]) * u0[0]), qm(silu_f(g0[1]) * u0[1])); w.y = cvt_pk_bf16(qm(silu_f(g0[2]) * u0[2]), qm(silu_f(g0[3]) * u0[3]));
                w.z = cvt_pk_bf16(qm(silu_f(g1[0]) * u1[0]), qm(silu_f(g1[1]) * u1[1])); w.w = cvt_pk_bf16(qm(silu_f(g1[2]) * u1[2]), qm(silu_f(g1[3]) * u1[3]));
                *(u32x4*)rowp = w; }
    }
};
struct EpiStoreQ {
    static constexpr bool PERM = true, AFTER_DRAIN = false;
    bf16_t* O; int ldc; const unsigned long long* rss; const float* sa; const float* sw; const float* bias; int ldb; int pm_off;
    __device__ __forceinline__ void operator()(const f32x4 (&acc)[2][2][4][2], const Unit& u, int wr, int wc, int fr, int fq) const {
        const int pmg = u.pm + pm_off, cond = pmg < 16 ? 0 : 1 + ((pmg - 16) >> 4);
        const int row0 = u.pm * BM + wr * 64 + fr, col0 = u.pn * BM + wc * 32 + 8 * fq;
        const float* b = bias + (size_t)cond * ldb + col0; const float* w = sw + col0;
        f32x4 bv[2][2], wv[2][2];
#pragma unroll
        for (int bj = 0; bj < 2; ++bj)
#pragma unroll
            for (int n = 0; n < 2; ++n) { bv[bj][n] = *(const f32x4*)(b + bj * HALF + 4 * n); wv[bj][n] = *(const f32x4*)(w + bj * HALF + 4 * n); }
#pragma unroll
        for (int ai = 0; ai < 2; ++ai)
#pragma unroll
            for (int m = 0; m < 4; ++m) { const int row = row0 + ai * HALF + m * 16; const float rs = rstd_of(rss, row) * sa[row]; bf16_t* rowp = O + (size_t)row * ldc + col0;
#pragma unroll
                for (int bj = 0; bj < 2; ++bj) { const f32x4 v0 = acc[ai][bj][m][0] * rs * wv[bj][0] + bv[bj][0], v1 = acc[ai][bj][m][1] * rs * wv[bj][1] + bv[bj][1];
                    u32x4 w4; w4.x = cvt_pk_bf16(v0[0], v0[1]); w4.y = cvt_pk_bf16(v0[2], v0[3]); w4.z = cvt_pk_bf16(v1[0], v1[1]); w4.w = cvt_pk_bf16(v1[2], v1[3]);
                    *(u32x4*)(rowp + bj * HALF) = w4; } }
    }
};
__device__ __forceinline__ float sat448(float x) { return __builtin_fminf(__builtin_fmaxf(x, -448.0f), 448.0f); }
struct EpiSwiGLUQ {
    static constexpr bool PERM = true, AFTER_DRAIN = false;
    unsigned char* O; int ldc; const unsigned long long* rss; const float* sa; const float* sw; const float* bias; int ldb; const float* act_s;
    __device__ __forceinline__ void operator()(const f32x4 (&acc)[2][2][4][2], const Unit& u, int wr, int wc, int fr, int fq) const {
        const int cond = u.pm < 16 ? 0 : 1 + ((u.pm - 16) >> 4);
        const int row0 = u.pm * BM + wr * 64 + fr, col0 = u.pn * HALF + wc * 32 + 8 * fq, bcol = u.pn * BM + wc * 32 + 8 * fq;
        const float* b = bias + (size_t)cond * ldb + bcol; const float* w = sw + bcol;
        const f32x4 bg0 = *(const f32x4*)(b), bg1 = *(const f32x4*)(b + 4), bu0 = *(const f32x4*)(b + HALF), bu1 = *(const f32x4*)(b + HALF + 4);
        const f32x4 wg0 = *(const f32x4*)(w), wg1 = *(const f32x4*)(w + 4), wu0 = *(const f32x4*)(w + HALF), wu1 = *(const f32x4*)(w + HALF + 4);
        const float as = act_s[0];
#pragma unroll
        for (int ai = 0; ai < 2; ++ai)
#pragma unroll
            for (int m = 0; m < 4; ++m) { const int row = row0 + ai * HALF + m * 16; const float rs = rstd_of(rss, row) * sa[row]; unsigned char* rowp = O + (size_t)row * ldc + col0;
                const f32x4 g0 = acc[ai][0][m][0] * rs * wg0 + bg0, g1 = acc[ai][0][m][1] * rs * wg1 + bg1, u0 = (acc[ai][1][m][0] * rs * wu0 + bu0) * as, u1 = (acc[ai][1][m][1] * rs * wu1 + bu1) * as;
                unsigned w0 = __builtin_amdgcn_cvt_pk_fp8_f32(sat448(silu_f(g0[0]) * u0[0]), sat448(silu_f(g0[1]) * u0[1]), 0, false); w0 = __builtin_amdgcn_cvt_pk_fp8_f32(sat448(silu_f(g0[2]) * u0[2]), sat448(silu_f(g0[3]) * u0[3]), w0, true);
                unsigned w1 = __builtin_amdgcn_cvt_pk_fp8_f32(sat448(silu_f(g1[0]) * u1[0]), sat448(silu_f(g1[1]) * u1[1]), 0, false); w1 = __builtin_amdgcn_cvt_pk_fp8_f32(sat448(silu_f(g1[2]) * u1[2]), sat448(silu_f(g1[3]) * u1[3]), w1, true);
                uint2 wv; wv.x = w0; wv.y = w1; *(uint2*)rowp = wv; }
    }
};
struct EpiResidN {
    static constexpr bool PERM = false, AFTER_DRAIN = false;
    const float* baseP; const float* baseS; float* out; const float* gate; const float* nw; const float* scl; unsigned long long* rss; long xs_delta;   float coef; int do_xs; long sa_delta, sw_delta; int q8; int xs_all = 0; long am_delta = 0;
    __device__ __forceinline__ void operator()(const f32x4 (&acc)[2][2][4][2], const Unit& u, int wr, int wc, int fr, int fq) const {
        const int cond = u.pm < 16 ? 0 : 1 + ((u.pm - 16) >> 4); const int do_xs = (this->do_xs && (xs_all || u.pm < 16)) ? this->do_xs : 0;     bf16_t* xs = (bf16_t*)((char*)rss + xs_delta); const float* sa = (const float*)((char*)rss + sa_delta); const float* swc = (const float*)((char*)rss + sw_delta);
        const float* g = gate + (size_t)cond * 18432; const float* base = u.pm < 16 ? baseP : baseS;
        const int row0 = u.pm * BM + wr * 64 + fr, col0 = u.pn * BM + wc * 32 + 4 * fq;
        f32x4 gv[2][2], av[2][2];
#pragma unroll
        for (int bj = 0; bj < 2; ++bj)
#pragma unroll
            for (int n = 0; n < 2; ++n) { gv[bj][n] = *(const f32x4*)(g + col0 + bj * HALF + n * 16) * coef; if (q8) gv[bj][n] = gv[bj][n] * *(const f32x4*)(swc + col0 + bj * HALF + n * 16);
                av[bj][n] = do_xs ? *(const f32x4*)(nw + col0 + bj * HALF + n * 16) * (*(const f32x4*)(scl + (size_t)cond * 18432 + col0 + bj * HALF + n * 16) + 1.0f) : (f32x4){0.f, 0.f, 0.f, 0.f}; }
#pragma unroll
        for (int ai = 0; ai < 2; ++ai)
#pragma unroll
            for (int m = 0; m < 4; ++m) { const int row = row0 + ai * HALF + m * 16; const size_t off = (size_t)row * 2048 + col0; float ss = 0.f, amx = 0.f; const float sr = q8 == 2 ? sa[0] : q8 ? sa[row] : 1.0f;
#pragma unroll
                for (int bj = 0; bj < 2; ++bj)
#pragma unroll
                    for (int n = 0; n < 2; ++n) { const f32x4 b = *(const f32x4*)(base + off + bj * HALF + n * 16); const f32x4 o = b + gv[bj][n] * (acc[ai][bj][m][n] * sr);
                        *(f32x4*)(out + off + bj * HALF + n * 16) = o;
                        if (do_xs) { f32x4 q = o * av[bj][n]; if (do_xs == 2) { q[0] = qm(q[0]); q[1] = qm(q[1]); q[2] = qm(q[2]); q[3] = qm(q[3]); } ss += (o[0] * o[0] + o[1] * o[1]) + (o[2] * o[2] + o[3] * o[3]); amx = fmaxf(fmaxf(amx, fmaxf(fabsf(q[0]), fabsf(q[1]))), fmaxf(fabsf(q[2]), fabsf(q[3])));
                            uint2 w2; w2.x = cvt_pk_bf16(q[0], q[1]); w2.y = cvt_pk_bf16(q[2], q[3]); *(uint2*)(xs + off + bj * HALF + n * 16) = w2; } }
                if (do_xs) { ss += __shfl_xor(ss, 16); ss += __shfl_xor(ss, 32); if (fq == 0) atomicAdd(rss + row, (unsigned long long)(ss * 16777216.0f));
                    if (xs_all) { amx = fmaxf(amx, __shfl_xor(amx, 16)); amx = fmaxf(amx, __shfl_xor(amx, 32)); if (fq == 0) atomicMax((unsigned*)((char*)rss + am_delta) + row, __float_as_uint(amx)); } }
                if (m == 3) asm volatile("" ::: "memory"); }
    }
};
typedef int i32x8 __attribute__((ext_vector_type(8)));
__device__ __forceinline__ void mfma_f8_128(f32x4& c, const i32x8 a, const i32x8 b) { asm volatile("v_mfma_f32_16x16x128_f8f6f4 %0, %1, %2, %0" : "+v"(c) : "v"(a), "v"(b)); }
template <class Epi, class Sched, bool ALIGN_EPI = false, bool SP2 = false, int I8 = 0>
__device__ __forceinline__ void gemm_phase(PG8_LAS unsigned char* lds, const Gemm g, const Sched& S, const Epi& E) {
    int tid_ = threadIdx.x; asm volatile("" : "+v"(tid_));
    const int tid = tid_, wid = __builtin_amdgcn_readfirstlane(tid >> 6), lane = tid & 63, wr = wid >> 2, wc = wid & 3, fr = lane & 15, fq = lane >> 4;
    const int K = g.K, nt = K / BK;
    unsigned voffA[2], voffB[2];
#pragma unroll
    for (int i = 0; i < 2; ++i) { int R, C; stage_rc(tid * 16 + i * 8192, R, C); const int Rb = Epi::PERM ? ((R & ~31) + perm32(R & 31)) : R;
        voffA[i] = (unsigned)(R * K + C) * 2u; voffB[i] = (unsigned)(Rb * BK + C) * 2u; }
    const size_t kstep = (size_t)(BK * 2);
    const size_t hstep = (size_t)HALF * K * 2;
    const size_t tstep = 2 * hstep;
    const size_t kstepB = (size_t)BM * BK * 2, hstepB = (size_t)HALF * BK * 2;
    const unsigned ldsw = (unsigned)wid * 1024u;
    const int aoff = lds_byte(wr * 64 + fr, fq * 8), boff = lds_byte(wc * 32 + fr, fq * 8);
#define PG8_SA(b, h) (((b) * 2 + (h)) * HTB)
#define PG8_SB(b, h) ((4 + (b) * 2 + (h)) * HTB)
#define PG8_STAGE(bufoff, gbase, voff) do { _Pragma("unroll") for (int _i = 0; _i < 2; ++_i) \
        __builtin_amdgcn_global_load_lds((const unsigned*)((const char*)(gbase) + (voff)[_i]), (PG8_LAS unsigned*)(lds + (bufoff) + ldsw + _i * 8192), 16, 0, 0); } while (0)
#define PG8_LDA(dst, b, h) do { _Pragma("unroll") for (int m = 0; m < 4; ++m) _Pragma("unroll") for (int k = 0; k < 2; ++k) dst[m][k] = *(const PG8_LAS bf16x8*)(lds + PG8_SA(b, h) + aoff + m * 2048 + k * 1024); } while (0)
#define PG8_LDB(dst, b, h) do { _Pragma("unroll") for (int n = 0; n < 2; ++n) _Pragma("unroll") for (int k = 0; k < 2; ++k) dst[n][k] = *(const PG8_LAS bf16x8*)(lds + PG8_SB(b, h) + boff + n * 2048 + k * 1024); } while (0)
#define PG8_MMA(ai, bj, At, Bt) do { __builtin_amdgcn_s_setprio(1); _Pragma("unroll") for (int m = 0; m < 4; ++m) _Pragma("unroll") for (int n = 0; n < 2; ++n) { if constexpr (I8 == 2) { \
        mfma_f8_128(acc[ai][bj][m][n], __builtin_shufflevector(__builtin_bit_cast(i32x4, Bt[n][0]), __builtin_bit_cast(i32x4, Bt[n][1]), 0, 1, 2, 3, 4, 5, 6, 7), \
            __builtin_shufflevector(__builtin_bit_cast(i32x4, At[m][0]), __builtin_bit_cast(i32x4, At[m][1]), 0, 1, 2, 3, 4, 5, 6, 7)); } else _Pragma("unroll") for (int k = 0; k < 2; ++k) { \
        if constexpr (I8 == 1) acc[ai][bj][m][n] = __builtin_bit_cast(f32x4, __builtin_amdgcn_mfma_i32_16x16x64_i8(__builtin_bit_cast(i32x4, Bt[n][k]), __builtin_bit_cast(i32x4, At[m][k]), __builtin_bit_cast(i32x4, acc[ai][bj][m][n]), 0, 0, 0)); \
        else acc[ai][bj][m][n] = __builtin_amdgcn_mfma_f32_16x16x32_bf16(Bt[n][k], At[m][k], acc[ai][bj][m][n], 0, 0, 0); } } __builtin_amdgcn_s_setprio(0); } while (0)
#define PG8_WAIT_V(n) asm volatile("s_waitcnt vmcnt(" #n ")" ::: "memory")
#define PG8_WAIT_L(n) asm volatile("s_waitcnt lgkmcnt(" #n ")" ::: "memory")
#define PG8_BAR __builtin_amdgcn_s_barrier()
#define PG8_SCHED __builtin_amdgcn_sched_barrier(0)
    Unit cur, nxt; int ui = 0;
    if (!S.next(0, cur)) return;
    f32x4 acc[2][2][4][2];
#pragma unroll
    for (int a = 0; a < 2; ++a)
#pragma unroll
        for (int b = 0; b < 2; ++b)
#pragma unroll
            for (int m = 0; m < 4; ++m)
#pragma unroll
                for (int n = 0; n < 2; ++n) acc[a][b][m][n] = (f32x4){0.f, 0.f, 0.f, 0.f};
    bf16x8 At[4][2], B0[2][2], B1[2][2];
    const char* cA = (const char*)g.A + (size_t)cur.pm * tstep; const char* cB = (const char*)g.Bt + (size_t)cur.pn * tstep;
    S.a_ready(cur);
    if constexpr (SP2) {
        PG8_STAGE(PG8_SB(0, 0), cB, voffB); PG8_STAGE(PG8_SB(0, 1), cB + hstepB, voffB); PG8_STAGE(PG8_SA(0, 0), cA, voffA); PG8_STAGE(PG8_SA(0, 1), cA + hstep, voffA);
        if (wr == 1) PG8_BAR;
        PG8_WAIT_V(2); PG8_BAR;
        PG8_STAGE(PG8_SB(1, 0), cB + kstepB, voffB); PG8_STAGE(PG8_SA(1, 0), cA + kstep, voffA); PG8_STAGE(PG8_SB(1, 1), cB + hstepB + kstepB, voffB);
        PG8_WAIT_V(6); PG8_BAR;
    } else {
        PG8_STAGE(PG8_SB(0, 0), cB, voffB); PG8_STAGE(PG8_SA(0, 0), cA, voffA); PG8_STAGE(PG8_SB(0, 1), cB + hstepB, voffB); PG8_STAGE(PG8_SA(0, 1), cA + hstep, voffA);
        if (wr == 1) PG8_BAR;
        PG8_WAIT_V(4); PG8_BAR;
        PG8_STAGE(PG8_SB(1, 0), cB + kstepB, voffB); PG8_STAGE(PG8_SA(1, 0), cA + kstep, voffA); PG8_STAGE(PG8_SB(1, 1), cB + hstepB + kstepB, voffB);
        PG8_WAIT_V(6); PG8_BAR;
    }
    for (;;) {
        const bool has_next = S.next(ui + 1, nxt);
        const char* nA = has_next ? (const char*)g.A + (size_t)nxt.pm * tstep : cA; const char* nB = has_next ? (const char*)g.Bt + (size_t)nxt.pn * tstep : cB;
        for (int t = 0; t < nt; t += 2) {
            const bool last = (t == nt - 2);
            const char* a1 = cA + (size_t)(t + 1) * kstep;
            const char* a2 = last ? nA : cA + (size_t)(t + 2) * kstep; const char* b2 = last ? nB : cB + (size_t)(t + 2) * kstepB;
            const char* a3 = a2 + kstep; const char* b3 = b2 + kstepB;
            if (last && has_next) S.a_ready(nxt);
            if constexpr (SP2) {
            PG8_LDB(B0, 0, 0); PG8_LDB(B1, 0, 1); PG8_SCHED; PG8_LDA(At, 0, 0); PG8_STAGE(PG8_SA(1, 1), a1 + hstep, voffA);
            PG8_WAIT_V(8); PG8_WAIT_L(0); PG8_BAR; PG8_MMA(0, 0, At, B0); PG8_MMA(0, 1, At, B1); PG8_BAR; PG8_SCHED;
            PG8_LDA(At, 0, 1); PG8_STAGE(PG8_SB(0, 0), b2, voffB); PG8_STAGE(PG8_SB(0, 1), b2 + hstepB, voffB); PG8_STAGE(PG8_SA(0, 0), a2, voffA);
            PG8_WAIT_V(8); PG8_WAIT_L(0); PG8_BAR; PG8_MMA(1, 0, At, B0); PG8_MMA(1, 1, At, B1); PG8_BAR; PG8_SCHED;
            PG8_LDB(B0, 1, 0); PG8_LDB(B1, 1, 1); PG8_SCHED; PG8_LDA(At, 1, 0); PG8_STAGE(PG8_SA(0, 1), a2 + hstep, voffA);
            PG8_WAIT_V(8); PG8_WAIT_L(0); PG8_BAR; PG8_MMA(0, 0, At, B0); PG8_MMA(0, 1, At, B1); PG8_BAR; PG8_SCHED;
            PG8_LDA(At, 1, 1); PG8_STAGE(PG8_SB(1, 0), b3, voffB); PG8_STAGE(PG8_SB(1, 1), b3 + hstepB, voffB); PG8_STAGE(PG8_SA(1, 0), a3, voffA);
            PG8_WAIT_V(8); PG8_WAIT_L(0); PG8_BAR; PG8_MMA(1, 0, At, B0); PG8_MMA(1, 1, At, B1); PG8_BAR; PG8_SCHED;
            } else {
            PG8_LDB(B0, 0, 0); PG8_SCHED; PG8_LDA(At, 0, 0); PG8_STAGE(PG8_SA(1, 1), a1 + hstep, voffA);
            PG8_WAIT_L(8); PG8_BAR; PG8_WAIT_L(0); PG8_MMA(0, 0, At, B0); PG8_BAR; PG8_SCHED;
            PG8_LDB(B1, 0, 1); PG8_STAGE(PG8_SB(0, 0), b2, voffB);
            PG8_BAR; PG8_WAIT_L(0); PG8_MMA(0, 1, At, B1); PG8_BAR;
            PG8_LDA(At, 0, 1); PG8_STAGE(PG8_SA(0, 0), a2, voffA);
            PG8_BAR; PG8_WAIT_L(0); PG8_MMA(1, 0, At, B0); PG8_BAR; PG8_SCHED;
            PG8_STAGE(PG8_SB(0, 1), b2 + hstepB, voffB);
            PG8_WAIT_V(6); PG8_BAR; PG8_MMA(1, 1, At, B1); PG8_BAR;
            PG8_LDB(B0, 1, 0); PG8_SCHED; PG8_LDA(At, 1, 0); PG8_STAGE(PG8_SA(0, 1), a2 + hstep, voffA);
            PG8_WAIT_L(8); PG8_BAR; PG8_WAIT_L(0); PG8_MMA(0, 0, At, B0); PG8_BAR; PG8_SCHED;
            PG8_LDB(B1, 1, 1); PG8_STAGE(PG8_SB(1, 0), b3, voffB);
            PG8_BAR; PG8_WAIT_L(0); PG8_MMA(0, 1, At, B1); PG8_BAR;
            PG8_LDA(At, 1, 1); PG8_STAGE(PG8_SA(1, 0), a3, voffA);
            PG8_BAR; PG8_WAIT_L(0); PG8_MMA(1, 0, At, B0); PG8_BAR; PG8_SCHED;
            PG8_STAGE(PG8_SB(1, 1), b3 + hstepB, voffB);
            PG8_WAIT_V(6); PG8_BAR; PG8_MMA(1, 1, At, B1); PG8_BAR;
            }
        }
        if constexpr (ALIGN_EPI) { if (wr == 0) PG8_BAR; }
        if constexpr (I8 == 2) asm volatile("s_nop 15\n\ts_nop 15" ::: "memory");
        if constexpr (I8 == 1) { _Pragma("unroll") for (int a = 0; a < 2; ++a) _Pragma("unroll") for (int b = 0; b < 2; ++b) _Pragma("unroll") for (int m = 0; m < 4; ++m) _Pragma("unroll") for (int n = 0; n < 2; ++n) acc[a][b][m][n] = __builtin_convertvector(__builtin_bit_cast(i32x4, acc[a][b][m][n]), f32x4); }
        if constexpr (!Epi::AFTER_DRAIN) { E(acc, cur, wr, wc, fr, fq); S.done(cur); }
        if (!has_next) break;
#pragma unroll
        for (int a = 0; a < 2; ++a)
#pragma unroll
            for (int b = 0; b < 2; ++b)
#pragma unroll
                for (int m = 0; m < 4; ++m)
#pragma unroll
                    for (int n = 0; n < 2; ++n) acc[a][b][m][n] = (f32x4){0.f, 0.f, 0.f, 0.f};
        cur = nxt; cA = nA; cB = nB; ++ui;
        if constexpr (ALIGN_EPI) { if (wr == 1) PG8_BAR; }
    }
    PG8_WAIT_V(0);
    if constexpr (!ALIGN_EPI) { if (wr == 0) PG8_BAR; }
    PG8_BAR;
    if constexpr (Epi::AFTER_DRAIN) { E.fused(acc, cur, wr, wc, fr, fq, lds, wid, lane); S.done(cur); }
#undef PG8_SA
#undef PG8_SB
#undef PG8_STAGE
#undef PG8_LDA
#undef PG8_LDB
#undef PG8_MMA
#undef PG8_WAIT_V
#undef PG8_WAIT_L
#undef PG8_BAR
#undef PG8_SCHED
}
}
namespace att {
using bf16x8 = __attribute__((ext_vector_type(8))) short;
using s16x4  = __attribute__((ext_vector_type(4))) short;
using f32x16 = __attribute__((ext_vector_type(16))) float;
using u32x4  = __attribute__((ext_vector_type(4))) unsigned;
typedef unsigned short bf16_t;
constexpr int NW = 8, QBLK = 32, KVBLK = 64;
constexpr float THR = 8.f;
constexpr int SHM_V = 64 * 128 * 2, SHM_K = 64 * 128 * 2, SHM_ATTN = 2 * SHM_V + 2 * SHM_K + NW * 64 * 4;
#define KSWZ(row, colB) ((row) * 256 + ((colB) ^ (((row) & 7) << 4)))
#define KSWZ64(row, colB) ((row) * 128 + ((colB) ^ ((((row) >> 1) & 7) << 4)))
#define SBAR() __builtin_amdgcn_sched_barrier(0)
__device__ __forceinline__ int crow(int r, int hi) { return (r & 3) + 8 * (r >> 2) + 4 * hi; }
__device__ __forceinline__ unsigned cvtpk(float lo, float hi) { unsigned r; asm volatile("v_cvt_pk_bf16_f32 %0, %1, %2" : "=v"(r) : "v"(lo), "v"(hi)); return r; }
__device__ __forceinline__ float bf2f(unsigned short b) { return __uint_as_float((unsigned)b << 16); }
__device__ __forceinline__ bf16x8 ld8(const bf16_t* p) { return *reinterpret_cast<const bf16x8*>(p); }

template <int DQK, bool PRE = false> __device__ __forceinline__ void partialSM(f32x16& p0, f32x16& p1, float& m_reg, float& mn, float& alpha) {
  constexpr float SCALE = PRE ? 0.6931471805599453f : ((DQK == 128) ? 0.088388347648318440f : 0.125f);
  constexpr float C = SCALE * 1.4426950408889634f;
  float pmax = p0[0];
#pragma unroll
  for (int r = 1; r < 16; ++r) pmax = fmaxf(pmax, p0[r]);
#pragma unroll
  for (int r = 0; r < 16; ++r) pmax = fmaxf(pmax, p1[r]);
  { auto rr = __builtin_amdgcn_permlane32_swap(__float_as_uint(pmax), __float_as_uint(pmax), false, false);
    pmax = fmaxf(__uint_as_float(rr[0]), __uint_as_float(rr[1])); }
  if (__builtin_expect(__all(pmax - m_reg <= THR / SCALE), 1)) { mn = m_reg; alpha = 1.f; }
  else { mn = fmaxf(m_reg, pmax); alpha = __builtin_amdgcn_exp2f((m_reg - mn) * C); m_reg = mn; }
  float mnC = -mn * C;
#pragma unroll
  for (int r = 0; r < 16; ++r) p0[r] = fmaf(p0[r], C, mnC);
#pragma unroll
  for (int r = 0; r < 16; ++r) p1[r] = fmaf(p1[r], C, mnC);
#pragma unroll
  for (int r = 0; r < 16; ++r) p0[r] = __builtin_amdgcn_exp2f(p0[r]);
}
#define PK4(P, BASE, OUT) do { unsigned a0 = cvtpk(P[BASE + 0], P[BASE + 1]), a1 = cvtpk(P[BASE + 2], P[BASE + 3]);   \
    unsigned b0 = cvtpk(P[BASE + 4], P[BASE + 5]), b1 = cvtpk(P[BASE + 6], P[BASE + 7]);                              \
    auto r0 = __builtin_amdgcn_permlane32_swap(a0, b0, false, false); auto r1 = __builtin_amdgcn_permlane32_swap(a1, b1, false, false); \
    u32x4 w = {r0[0], r1[0], r0[1], r1[1]}; OUT = *reinterpret_cast<bf16x8*>(&w); } while (0)
__device__ __forceinline__ void finishSM(f32x16& p0, f32x16& p1, float alpha, float& l_reg, bf16x8& pa0, bf16x8& pa1, bf16x8& pa2, bf16x8& pa3) {
#pragma unroll
  for (int r = 0; r < 16; ++r) p1[r] = __builtin_amdgcn_exp2f(p1[r]);
  float ps = 0;
#pragma unroll
  for (int r = 0; r < 16; ++r) ps += p0[r];
#pragma unroll
  for (int r = 0; r < 16; ++r) ps += p1[r];
  { auto rr = __builtin_amdgcn_permlane32_swap(__float_as_uint(ps), __float_as_uint(ps), false, false);
    ps = __uint_as_float(rr[0]) + __uint_as_float(rr[1]); }
  l_reg = l_reg * alpha + ps;
  PK4(p0, 0, pa0); PK4(p0, 8, pa1); PK4(p1, 0, pa2); PK4(p1, 8, pa3);
}
template <int DQK> __device__ __forceinline__ void qkt(f32x16& p0, f32x16& p1, const char* Ks, const bf16x8* qr, int r32, int hi) {
  constexpr int ND = DQK / 16;
  p0 = f32x16{}; p1 = f32x16{};
  bf16x8 b0[2], b1[2];
#define QK_RD(d0, s) do { const int cb_ = ((d0) * 16 + hi * 8) * 2; \
    if constexpr (DQK == 128) { b0[s] = *reinterpret_cast<const bf16x8*>(Ks + KSWZ(r32, cb_)); b1[s] = *reinterpret_cast<const bf16x8*>(Ks + KSWZ(32 + r32, cb_)); } \
    else { b0[s] = *reinterpret_cast<const bf16x8*>(Ks + KSWZ64(r32, cb_)); b1[s] = *reinterpret_cast<const bf16x8*>(Ks + KSWZ64(32 + r32, cb_)); } } while (0)
  QK_RD(0, 0); QK_RD(1, 1); SBAR();
#pragma unroll
  for (int d0 = 0; d0 < ND; ++d0) {
    p0 = __builtin_amdgcn_mfma_f32_32x32x16_bf16(b0[d0 & 1], qr[d0], p0, 0, 0, 0);
    p1 = __builtin_amdgcn_mfma_f32_32x32x16_bf16(b1[d0 & 1], qr[d0], p1, 0, 0, 0);
    if (d0 + 2 < ND) { QK_RD(d0 + 2, d0 & 1); }
    SBAR();
  }
#undef QK_RD
}
__device__ __forceinline__ int v_st(int k, int c) { const int kk = (k & ~0xC) | ((k & 4) << 1) | ((k & 8) >> 1); return ((kk >> 3) * 4 + (c >> 5)) * 512 + ((kk & 7) * 32 + (c & 31)) * 2; }
__device__ __forceinline__ int v_rd_base(int lane) { return ((lane & 3) << 3) | (((lane >> 2) & 3) << 6) | (((lane >> 4) & 1) << 5) | (((lane >> 5) & 1) << 8); }
constexpr int v_rd_off(int d0, int ks, int half) { return d0 * 512 + ks * 4096 + half * 2048; }
template <int OFF> __device__ __forceinline__ s16x4 tr_read(int vb) {
  s16x4 r; asm volatile("ds_read_b64_tr_b16 %0, %1 offset:%2" : "=&v"(r) : "v"(vb), "i"(OFF) : "memory"); return r;
}
#define PKF(L, H) (bf16x8){L[0], L[1], L[2], L[3], H[0], H[1], H[2], H[3]}
template <int D0> __device__ __forceinline__ void pv_one(f32x16& od, int vb, bf16x8 pa0, bf16x8 pa1, bf16x8 pa2, bf16x8 pa3) {
  const s16x4 l0 = tr_read<v_rd_off(D0, 0, 0)>(vb), h0 = tr_read<v_rd_off(D0, 0, 1)>(vb), l1 = tr_read<v_rd_off(D0, 1, 0)>(vb), h1 = tr_read<v_rd_off(D0, 1, 1)>(vb);
  const s16x4 l2 = tr_read<v_rd_off(D0, 2, 0)>(vb), h2 = tr_read<v_rd_off(D0, 2, 1)>(vb), l3 = tr_read<v_rd_off(D0, 3, 0)>(vb), h3 = tr_read<v_rd_off(D0, 3, 1)>(vb);
  asm volatile("s_waitcnt lgkmcnt(0)" ::: "memory"); SBAR();
  od = __builtin_amdgcn_mfma_f32_32x32x16_bf16(pa0, PKF(l0, h0), od, 0, 0, 0);
  od = __builtin_amdgcn_mfma_f32_32x32x16_bf16(pa1, PKF(l1, h1), od, 0, 0, 0);
  od = __builtin_amdgcn_mfma_f32_32x32x16_bf16(pa2, PKF(l2, h2), od, 0, 0, 0);
  od = __builtin_amdgcn_mfma_f32_32x32x16_bf16(pa3, PKF(l3, h3), od, 0, 0, 0);
}
#define PV_RD(D0, L, H) do { L[0] = tr_read<v_rd_off(D0, 0, 0)>(vb); H[0] = tr_read<v_rd_off(D0, 0, 1)>(vb); L[1] = tr_read<v_rd_off(D0, 1, 0)>(vb); H[1] = tr_read<v_rd_off(D0, 1, 1)>(vb); \
    L[2] = tr_read<v_rd_off(D0, 2, 0)>(vb); H[2] = tr_read<v_rd_off(D0, 2, 1)>(vb); L[3] = tr_read<v_rd_off(D0, 3, 0)>(vb); H[3] = tr_read<v_rd_off(D0, 3, 1)>(vb); } while (0)
#define PV_MM(OD, L, H) do { OD = __builtin_amdgcn_mfma_f32_32x32x16_bf16(pa0, PKF(L[0], H[0]), OD, 0, 0, 0); OD = __builtin_amdgcn_mfma_f32_32x32x16_bf16(pa1, PKF(L[1], H[1]), OD, 0, 0, 0); \
    OD = __builtin_amdgcn_mfma_f32_32x32x16_bf16(pa2, PKF(L[2], H[2]), OD, 0, 0, 0); OD = __builtin_amdgcn_mfma_f32_32x32x16_bf16(pa3, PKF(L[3], H[3]), OD, 0, 0, 0); } while (0)
__device__ __forceinline__ void pv_d0(f32x16* o, int vb, bf16x8 pa0, bf16x8 pa1, bf16x8 pa2, bf16x8 pa3) {
  s16x4 la[4], ha[4], lb[4], hb[4];
  PV_RD(0, la, ha); PV_RD(1, lb, hb);
  asm volatile("s_waitcnt lgkmcnt(8)" ::: "memory"); SBAR(); PV_MM(o[0], la, ha); SBAR();
  PV_RD(2, la, ha);
  asm volatile("s_waitcnt lgkmcnt(8)" ::: "memory"); SBAR(); PV_MM(o[1], lb, hb); SBAR();
  PV_RD(3, lb, hb);
  asm volatile("s_waitcnt lgkmcnt(8)" ::: "memory"); SBAR(); PV_MM(o[2], la, ha); SBAR();
  asm volatile("s_waitcnt lgkmcnt(0)" ::: "memory"); SBAR(); PV_MM(o[3], lb, hb);
}
#undef PV_RD
#undef PV_MM
__device__ __forceinline__ float half_sum32(float x) {
  x += __shfl_xor(x, 1); x += __shfl_xor(x, 2); x += __shfl_xor(x, 4); x += __shfl_xor(x, 8); x += __shfl_xor(x, 16); return x;
}

struct KVSrc { const bf16_t* K1; const bf16_t* V1; int n1; const bf16_t* K2; const bf16_t* V2; int n2; };
struct AttnOut { bf16_t* Ob; float* Of; const float* nw; float lam, post; int pass; };
template <int DQK, int MODE, int LD2, int SM = 0>
__device__ __forceinline__ void attn_body(const bf16_t* __restrict__ Qb, const KVSrc kv, const AttnOut ao, char* lds) {
  constexpr long ldq = 5120, LD1 = 5120; constexpr int LDO = 2048, LDF = 512;
  int tid_ = threadIdx.x; asm volatile("" : "+v"(tid_));
  const int tid = tid_, wid = tid >> 6, lane = tid & 63, r32 = lane & 31, hi = lane >> 5;
  char* V_lds = lds; char* K_lds = lds + 2 * SHM_V;
  float* ws = (float*)(lds + 2 * SHM_V + 2 * SHM_K) + wid * 64; float* li_l = ws; float* al_l = ws + 32;
  float m_reg = -1e30f, l_reg = 0; f32x16 o[4] = {}; bf16x8 qr[DQK / 16];
  const bf16_t* Qw = Qb + (long)(wid * QBLK + r32) * ldq + hi * 8;
#pragma unroll
  for (int d0 = 0; d0 < DQK / 16; ++d0) qr[d0] = ld8(Qw + d0 * 16);
  const int sr = tid >> 4, sc = (tid & 15) * 8, vst0 = v_st(sr, sc), vst1 = v_st(32 + sr, sc);
  const int kr64 = tid >> 3, kc64 = (tid & 7) * 8;
  const int vb0 = (int)(uintptr_t)V_lds + v_rd_base(lane);
  struct { bf16x8 vs0, vs1, ks0, ks1; } sr_[2];
#define SLOAD(i, k0) do { const int k0_ = (k0); const bool s1_ = k0_ < kv.n1; const bf16_t* kp_ = s1_ ? kv.K1 + (long)k0_ * LD1 : kv.K2 + (long)(k0_ - kv.n1) * LD2; \
    const bf16_t* vp_ = s1_ ? kv.V1 + (long)k0_ * LD1 : kv.V2 + (long)(k0_ - kv.n1) * LD2; const long ld_ = s1_ ? LD1 : (long)LD2; \
    sr_[i].vs0 = ld8(vp_ + (long)sr * ld_ + sc); sr_[i].vs1 = ld8(vp_ + (long)(32 + sr) * ld_ + sc); \
    if constexpr (DQK == 128) { sr_[i].ks0 = ld8(kp_ + (long)sr * ld_ + sc); sr_[i].ks1 = ld8(kp_ + (long)(32 + sr) * ld_ + sc); } \
    else { sr_[i].ks0 = ld8(kp_ + (long)kr64 * ld_ + kc64); } } while (0)
#define SWRITE(b, i) do { *(bf16x8*)(V_lds + (b) * SHM_V + vst0) = sr_[i].vs0; *(bf16x8*)(V_lds + (b) * SHM_V + vst1) = sr_[i].vs1; \
    if constexpr (DQK == 128) { const int kc = sc * 2; *(bf16x8*)(K_lds + (b) * SHM_K + KSWZ(sr, kc)) = sr_[i].ks0; *(bf16x8*)(K_lds + (b) * SHM_K + KSWZ(32 + sr, kc)) = sr_[i].ks1; } \
    else { *(bf16x8*)(K_lds + (b) * SHM_K + KSWZ64(kr64, kc64 * 2)) = sr_[i].ks0; } } while (0)
#define SWAIT() do { if constexpr (DQK == 128) asm volatile("s_waitcnt vmcnt(4)" ::: "memory"); else asm volatile("s_waitcnt vmcnt(3)" ::: "memory"); } while (0)
#define RESC(a) do { if (SM != 1 && __any((a) < 1.f)) { if (hi == 0) al_l[r32] = (a); asm volatile("s_waitcnt lgkmcnt(0)" ::: "memory"); \
    _Pragma("unroll") for (int d = 0; d < 4; ++d) _Pragma("unroll") for (int r = 0; r < 16; ++r) o[d][r] *= al_l[crow(r, hi)]; } } while (0)
  f32x16 pA0, pA1, pB0, pB1; float mnA = 0.f, mnB = 0.f, alA = 1.f, alB = 1.f; bf16x8 pa0, pa1, pa2, pa3; const int NT = (kv.n1 + kv.n2) / KVBLK; (void)mnA; (void)mnB;
#define PSM(P0, P1, MN, AL) do { if constexpr (SM == 1) { _Pragma("unroll") for (int r_ = 0; r_ < 16; ++r_) P0[r_] = __builtin_amdgcn_exp2f(P0[r_]); } else partialSM<DQK, SM == 2>(P0, P1, m_reg, MN, AL); } while (0)
  constexpr int SE = 0, SO = 1;
  SLOAD(SE, 0); asm volatile("s_waitcnt vmcnt(0)" ::: "memory"); SWRITE(0, SE); __syncthreads();
  qkt<DQK>(pA0, pA1, K_lds, qr, r32, hi); PSM(pA0, pA1, mnA, alA);
  SLOAD(SO, KVBLK); if (2 < NT) SLOAD(SE, 2 * KVBLK);
  SWAIT(); SWRITE(1, SO); __syncthreads();
  for (int j = 1; j + 1 < NT; j += 2) {
    SBAR(); qkt<DQK>(pB0, pB1, K_lds + SHM_K, qr, r32, hi);
    finishSM(pA0, pA1, alA, l_reg, pa0, pa1, pa2, pa3); SBAR();
    SLOAD(SO, (j + 2) * KVBLK); SBAR();
    pv_d0(o, vb0, pa0, pa1, pa2, pa3); PSM(pB0, pB1, mnB, alB);
    __syncthreads(); SWAIT(); SWRITE(0, SE);
    RESC(alB); __syncthreads();
    SBAR(); qkt<DQK>(pA0, pA1, K_lds, qr, r32, hi);
    finishSM(pB0, pB1, alB, l_reg, pa0, pa1, pa2, pa3); SBAR();
    if (j + 3 < NT) SLOAD(SE, (j + 3) * KVBLK); SBAR();
    pv_d0(o, vb0 + (int)SHM_V, pa0, pa1, pa2, pa3); PSM(pA0, pA1, mnA, alA);
    __syncthreads(); SWAIT(); SWRITE(1, SO);
    RESC(alA); __syncthreads();
  }
  SBAR(); qkt<DQK>(pB0, pB1, K_lds + SHM_K, qr, r32, hi);
  finishSM(pA0, pA1, alA, l_reg, pa0, pa1, pa2, pa3); SBAR();
  pv_d0(o, vb0, pa0, pa1, pa2, pa3); PSM(pB0, pB1, mnB, alB);
  __syncthreads(); RESC(alB);
  finishSM(pB0, pB1, alB, l_reg, pa0, pa1, pa2, pa3); SBAR();
  pv_d0(o, vb0 + (int)SHM_V, pa0, pa1, pa2, pa3);
  if (hi == 0) li_l[r32] = l_reg; asm volatile("s_waitcnt lgkmcnt(0)" ::: "memory");
  float rli[16];
#pragma unroll
  for (int r = 0; r < 16; ++r) rli[r] = __builtin_amdgcn_rcpf(li_l[crow(r, hi)]);
  bf16_t* stg = (bf16_t*)lds + wid * (QBLK * 128);
#define O_FLUSH(Ow) do { asm volatile("s_waitcnt lgkmcnt(0)" ::: "memory"); _Pragma("unroll") for (int i_ = 0; i_ < 8; ++i_) { const int row_ = i_ * 4 + (lane >> 4), ch_ = lane & 15; \
    const u32x4 v_ = *(const u32x4*)(stg + row_ * 128 + ch_ * 8); *(u32x4*)((Ow) + (long)row_ * LDO + ch_ * 8) = v_; } } while (0)
  if constexpr (MODE == 0) {
    bf16_t* Ow = ao.Ob + (long)(wid * QBLK) * LDO;
    __syncthreads();
#pragma unroll
    for (int r = 0; r < 16; ++r) { const int orow = crow(r, hi);
#pragma unroll
      for (int d0 = 0; d0 < 4; ++d0) { const float v = o[d0][r] * rli[r]; stg[orow * 128 + d0 * 32 + r32] = (bf16_t)(cvtpk(v, v) & 0xffffu); } }
    O_FLUSH(Ow);
  } else {
    float* Fw = ao.Of + (long)(wid * QBLK) * LDF;
    if (ao.pass == 0) {
#pragma unroll
      for (int r = 0; r < 16; ++r) { const int orow = crow(r, hi);
#pragma unroll
        for (int d0 = 0; d0 < 4; ++d0) Fw[(long)orow * LDF + d0 * 32 + r32] = o[d0][r] * rli[r]; }
    } else {
      bf16_t* Ow = ao.Ob + (long)(wid * QBLK) * LDO;
      __syncthreads();
#pragma unroll
      for (int r = 0; r < 16; ++r) { const int orow = crow(r, hi); float v[4]; float ss = 0.f;
#pragma unroll
        for (int d0 = 0; d0 < 4; ++d0) { v[d0] = Fw[(long)orow * LDF + d0 * 32 + r32] - ao.lam * (o[d0][r] * rli[r]); ss += v[d0] * v[d0]; }
        ss = half_sum32(ss); const float rs = rsqrtf(ss * (1.0f / 128.0f) + 1e-6f) * ao.post;
#pragma unroll
        for (int d0 = 0; d0 < 4; ++d0) { const float y = v[d0] * rs * ao.nw[d0 * 32 + r32]; stg[orow * 128 + d0 * 32 + r32] = (bf16_t)(cvtpk(y, y) & 0xffffu); } }
      O_FLUSH(Ow);
    }
  }
#undef O_FLUSH
#undef SLOAD
#undef SWRITE
#undef SWAIT
#undef RESC
#undef PSM
}
struct ChainArgs { const bf16_t* P;   int kcol, vcol; int nchunk; int dir; float lg2;
                   const float* S0;   bf16_t* ST;   float* Sfin;   };
__device__ __forceinline__ void ret_chain(const ChainArgs a, char* lds) {
  int tid_ = threadIdx.x; asm volatile("" : "+v"(tid_));
  const int tid = tid_, wid = tid >> 6, lane = tid & 63, r32 = lane & 31, hi = lane >> 5;
  const int eb = wid >> 1, dh = wid & 1;
  char* V_lds = lds; char* K_lds = lds + 2 * SHM_V;
  const int sr = tid >> 4, sc = (tid & 15) * 8;
  f32x16 acc[2];
#pragma unroll
  for (int j = 0; j < 2; ++j)
#pragma unroll
    for (int r = 0; r < 16; ++r) acc[j][r] = 0.f;
  if (a.S0) {
#pragma unroll
    for (int j = 0; j < 2; ++j)
#pragma unroll
      for (int r = 0; r < 16; ++r) acc[j][r] = a.S0[(size_t)(32 * (2 * dh + j) + r32) * 128 + 32 * eb + crow(r, hi)]; }
  const float gC = __builtin_amdgcn_exp2f(128.f * a.lg2);
  const int vbA = (int)(uintptr_t)V_lds + v_rd_base(lane) + eb * 512, vbB = (int)(uintptr_t)K_lds + v_rd_base(lane) + (2 * dh) * 512;
  bf16x8 kq[4], vq[4];
  { const int c0 = a.dir == 0 ? 0 : a.nchunk - 1; const bf16_t* rowp = a.P + (size_t)(c0 * 128) * 5120;
#pragma unroll
    for (int q = 0; q < 4; ++q) { const int k = 32 * q + sr; kq[q] = ld8(rowp + (size_t)k * 5120 + a.kcol + sc); vq[q] = ld8(rowp + (size_t)k * 5120 + a.vcol + sc); } }
  for (int s = 0; s < a.nchunk; ++s) {
    const int c = a.dir == 0 ? s : a.nchunk - 1 - s;
    bf16_t* st = a.ST + (size_t)c * 16384;
    __syncthreads();
#pragma unroll
    for (int q = 0; q < 4; ++q) { const int k = 32 * q + sr;
      const bf16x8 kv_ = kq[q], vv_ = vq[q];
      const float f = 0.088388347648318440f * __builtin_amdgcn_exp2f((a.dir == 0 ? (float)(127 - k) : (float)k) * a.lg2);
      u32x4 w; w.x = cvtpk(bf2f((unsigned short)kv_[0]) * f, bf2f((unsigned short)kv_[1]) * f); w.y = cvtpk(bf2f((unsigned short)kv_[2]) * f, bf2f((unsigned short)kv_[3]) * f);
      w.z = cvtpk(bf2f((unsigned short)kv_[4]) * f, bf2f((unsigned short)kv_[5]) * f); w.w = cvtpk(bf2f((unsigned short)kv_[6]) * f, bf2f((unsigned short)kv_[7]) * f);
      const int off = (q >> 1) * SHM_V + v_st(32 * (q & 1) + sr, sc);
      *(u32x4*)(K_lds + off) = w; *(bf16x8*)(V_lds + off) = vv_; }
    __syncthreads();
#pragma unroll
    for (int j = 0; j < 2; ++j)
#pragma unroll
      for (int r = 0; r < 16; ++r) { const float v = acc[j][r]; st[(32 * eb + crow(r, hi)) * 128 + 32 * (2 * dh + j) + r32] = (bf16_t)(cvtpk(v, v) & 0xffffu); }
    if (s + 1 < a.nchunk) { const int cn = a.dir == 0 ? s + 1 : a.nchunk - 2 - s; const bf16_t* rowp = a.P + (size_t)(cn * 128) * 5120;
#pragma unroll
      for (int q = 0; q < 4; ++q) { const int k = 32 * q + sr; kq[q] = ld8(rowp + (size_t)k * 5120 + a.kcol + sc); vq[q] = ld8(rowp + (size_t)k * 5120 + a.vcol + sc); } }
#pragma unroll
    for (int j = 0; j < 2; ++j)
#pragma unroll
      for (int r = 0; r < 16; ++r) acc[j][r] *= gC;
#pragma unroll
    for (int tt = 0; tt < 2; ++tt) {
      s16x4 al[4], ah[4], b0l[4], b0h[4], b1l[4], b1h[4];
#define RD4(ks) do { al[ks] = tr_read<v_rd_off(0, ks, 0)>(vbA + tt * SHM_V); ah[ks] = tr_read<v_rd_off(0, ks, 1)>(vbA + tt * SHM_V); \
      b0l[ks] = tr_read<v_rd_off(0, ks, 0)>(vbB + tt * SHM_V); b0h[ks] = tr_read<v_rd_off(0, ks, 1)>(vbB + tt * SHM_V); \
      b1l[ks] = tr_read<v_rd_off(1, ks, 0)>(vbB + tt * SHM_V); b1h[ks] = tr_read<v_rd_off(1, ks, 1)>(vbB + tt * SHM_V); } while (0)
      RD4(0); RD4(1); RD4(2); RD4(3);
#undef RD4
      asm volatile("s_waitcnt lgkmcnt(0)" ::: "memory"); SBAR();
#pragma unroll
      for (int ks = 0; ks < 4; ++ks) {
        acc[0] = __builtin_amdgcn_mfma_f32_32x32x16_bf16(PKF(al[ks], ah[ks]), PKF(b0l[ks], b0h[ks]), acc[0], 0, 0, 0);
        acc[1] = __builtin_amdgcn_mfma_f32_32x32x16_bf16(PKF(al[ks], ah[ks]), PKF(b1l[ks], b1h[ks]), acc[1], 0, 0, 0); }
    }
  }
  if (a.Sfin) {
#pragma unroll
    for (int j = 0; j < 2; ++j)
#pragma unroll
      for (int r = 0; r < 16; ++r) a.Sfin[(size_t)(32 * (2 * dh + j) + r32) * 128 + 32 * eb + crow(r, hi)] = acc[j][r];
  }
}
struct RetCArgs { const bf16_t* P;   int qcol, kcol, vcol, gcol; float lg2f, lg2b; const bf16_t* STf; const bf16_t* STb;
                  const float* gnw; bf16_t* O;   };
__device__ __forceinline__ void ret_c(const RetCArgs a, char* lds) {
  int tid_ = threadIdx.x; asm volatile("" : "+v"(tid_));
  const int tid = tid_, wid = tid >> 6, lane = tid & 63, r32 = lane & 31, hi = lane >> 5;
  char* V_lds = lds; char* K_lds = lds + 2 * SHM_V;
  const int cw = wid >> 2, ipos = 32 * (wid & 3) + r32;
  const int sr = tid >> 4, sc = (tid & 15) * 8;
  const int vb0 = (int)(uintptr_t)V_lds + v_rd_base(lane);
  bf16x8 qr[8];
  const bf16_t* Qw = a.P + (size_t)(wid * 32 + r32) * 5120 + a.qcol + hi * 8;
#pragma unroll
  for (int d0 = 0; d0 < 8; ++d0) qr[d0] = ld8(Qw + d0 * 16);
  f32x16 o[4] = {};
  for (int ch = 0; ch < 2; ++ch) {
    const bf16_t* rowp = a.P + (size_t)(ch * 128) * 5120;
    __syncthreads();
#pragma unroll
    for (int q = 0; q < 4; ++q) { const int k = 32 * q + sr;
      const bf16x8 kv_ = ld8(rowp + (size_t)k * 5120 + a.kcol + sc), vv_ = ld8(rowp + (size_t)k * 5120 + a.vcol + sc);
      *(bf16x8*)(K_lds + (q >> 1) * SHM_K + KSWZ(32 * (q & 1) + sr, sc * 2)) = kv_;
      *(bf16x8*)(V_lds + (q >> 1) * SHM_V + v_st(32 * (q & 1) + sr, sc)) = vv_; }
    __syncthreads();
    if (cw == ch) {
#pragma unroll
      for (int tt = 0; tt < 2; ++tt) {
        f32x16 p0, p1; qkt<128>(p0, p1, K_lds + tt * SHM_K, qr, r32, hi);
        int ip_ = ipos, hi_ = hi; asm volatile("" : "+v"(ip_), "+v"(hi_));
#pragma unroll
        for (int r = 0; r < 16; ++r) {
          const int j0 = 64 * tt + crow(r, hi_), d0_ = ip_ - j0, d1_ = d0_ - 32;
          const float f0 = d0_ > 0 ? __builtin_amdgcn_exp2f((float)d0_ * a.lg2f) : (d0_ < 0 ? __builtin_amdgcn_exp2f((float)(-d0_) * a.lg2b) : 2.0f);
          const float f1 = d1_ > 0 ? __builtin_amdgcn_exp2f((float)d1_ * a.lg2f) : (d1_ < 0 ? __builtin_amdgcn_exp2f((float)(-d1_) * a.lg2b) : 2.0f);
          p0[r] *= f0 * 0.088388347648318440f; p1[r] *= f1 * 0.088388347648318440f; }
        bf16x8 pa0, pa1, pa2, pa3; PK4(p0, 0, pa0); PK4(p0, 8, pa1); PK4(p1, 0, pa2); PK4(p1, 8, pa3);
        pv_d0(o, vb0 + tt * SHM_V, pa0, pa1, pa2, pa3);
      }
    }
  }
#pragma unroll
  for (int dir = 0; dir < 2; ++dir) {
    const float rs = dir == 0 ? __builtin_amdgcn_exp2f((float)(ipos + 1) * a.lg2f) : __builtin_amdgcn_exp2f((float)(128 - ipos) * a.lg2b);
    const bf16_t* S = (dir == 0 ? a.STf : a.STb) + (size_t)cw * 16384 + (size_t)r32 * 128 + hi * 8;
#pragma unroll
    for (int d0 = 0; d0 < 8; ++d0) {
      const bf16x8 q_ = qr[d0]; u32x4 w;
      w.x = cvtpk(bf2f((unsigned short)q_[0]) * rs, bf2f((unsigned short)q_[1]) * rs); w.y = cvtpk(bf2f((unsigned short)q_[2]) * rs, bf2f((unsigned short)q_[3]) * rs);
      w.z = cvtpk(bf2f((unsigned short)q_[4]) * rs, bf2f((unsigned short)q_[5]) * rs); w.w = cvtpk(bf2f((unsigned short)q_[6]) * rs, bf2f((unsigned short)q_[7]) * rs);
      const bf16x8 qs = *reinterpret_cast<bf16x8*>(&w);
#pragma unroll
      for (int eb = 0; eb < 4; ++eb) { const bf16x8 b = ld8(S + (size_t)eb * 32 * 128 + d0 * 16); o[eb] = __builtin_amdgcn_mfma_f32_32x32x16_bf16(qs, b, o[eb], 0, 0, 0); }
    }
  }
#pragma unroll
  for (int r = 0; r < 16; ++r) {
    const int row = wid * 32 + crow(r, hi);
    float s = (o[0][r] + o[1][r]) + (o[2][r] + o[3][r]); s = half_sum32(s); const float mean = s * (1.0f / 128.0f);
    float q = 0.f;
#pragma unroll
    for (int eb = 0; eb < 4; ++eb) { const float d = o[eb][r] - mean; q += d * d; }
    q = half_sum32(q); const float rstd = rsqrtf(q * (1.0f / 128.0f) + 1e-6f);
#pragma unroll
    for (int eb = 0; eb < 4; ++eb) { const int col = eb * 32 + r32;
      const float g = bf2f(a.P[(size_t)row * 5120 + a.gcol + col]);
      const float y = (o[eb][r] - mean) * rstd * a.gnw[col] * (g * __builtin_amdgcn_rcpf(1.0f + __builtin_amdgcn_exp2f(-1.4426950408889634f * g)));
      a.O[(size_t)row * 2048 + col] = (bf16_t)(cvtpk(y, y) & 0xffffu); }
  }
}
#undef KSWZ
#undef KSWZ64
#undef SBAR
#undef PK4
#undef PKF
}
constexpr int DM = 2048, M_P = 4096, M_S = 32768, MTOK = M_P + M_S, DFF = 5632, NFF = 11264, NIN = 5120, NMODC = 18432, NCOND = 9;
constexpr int C_RQ = 0, C_RK = 512, C_RV = 1024, C_RG = 1536, C_GQ = 2048, C_GK = 3072, C_GV = 3328, C_DQ = 3584, C_DK = 4096, C_DV = 4608;
constexpr float EPS = 1e-6f;
constexpr size_t MiB = 1u << 20;
constexpr size_t WS_CTL = 0, CTL_ZERO_BYTES = 1 * MiB;
constexpr size_t WS_TAB = 1 * MiB;
constexpr size_t WS_CACHE = 4 * MiB;
constexpr size_t WS_W = 16 * MiB;
constexpr size_t W_LAYER = 160 * MiB, W_WI = 0, W_WO = 88 * MiB, W_WIN = 132 * MiB, W_WOUT = 152 * MiB;
constexpr size_t WS_XN = WS_W + 2 * W_LAYER;
constexpr size_t WS_ACT = WS_XN + 144 * MiB;
constexpr size_t WS_ST = WS_ACT + 396 * MiB;
constexpr size_t WS_DF = WS_ST + 72 * MiB;
constexpr size_t WS_XNB = WS_DF + 72 * MiB;
constexpr size_t WS_SB = WS_XNB + 144 * MiB;
constexpr size_t SB_LAYER = 9 * (11264 + 5120 + 11264), SB_J1 = 9 * 11264, SB_J2 = 9 * (11264 + 5120);
constexpr size_t WS_RS = WS_SB + 2 * MiB;
constexpr size_t WS_Q = WS_RS + 2 * MiB;
constexpr size_t Q_SW = 256 * 1024, Q_SW2 = 512 * 1024, Q_SW4 = 832 * 1024, Q_ACT = 960 * 1024  , W_WINQ = 22 * MiB;
constexpr size_t WS_A8B = WS_Q + 1 * MiB;
constexpr size_t WS_END = WS_A8B + 198 * MiB;
constexpr int TB_MOD = 0, TB_COSG = 2 * 9 * 18432, TB_SING = TB_COSG + 64 * 32, TB_COSD = TB_SING + 64 * 32, TB_SIND = TB_COSD + 64 * 16, TB_SCAL = TB_SIND + 64 * 16;
constexpr int CW_BAR = 4096;
constexpr size_t CTL_RAW2 = 960 * 1024;
constexpr size_t CTL_AMAX = 64 * 1024;
constexpr size_t O_X = 0, O_STATE = 75497472, O_GK = 79691776, O_GV = 81788928, O_DK = 83886080, O_DV = 88080384, O_END = 92274688;
constexpr int LDS_BYTES = 147456, MISC_OFF = 131072 + 320;

typedef att::bf16_t bf16;
#define GAS __attribute__((address_space(1)))
#define LAS __attribute__((address_space(3)))
typedef unsigned v4u __attribute__((ext_vector_type(4)));
typedef float f32x4 __attribute__((ext_vector_type(4)));
typedef short bf16x8 __attribute__((ext_vector_type(8)));
typedef GAS unsigned gu32;
typedef GAS unsigned long long gu64;
#define RLX_AGENT __ATOMIC_RELAXED, __HIP_MEMORY_SCOPE_AGENT
#define LDS_WAIT() asm volatile("s_waitcnt lgkmcnt(0)" ::: "memory")
#define VM_WAIT() asm volatile("s_waitcnt vmcnt(0)" ::: "memory")
__device__ __forceinline__ unsigned long long rt() { return __builtin_amdgcn_s_memrealtime(); }
__device__ __forceinline__ unsigned f2bf(float f) { unsigned u = __builtin_bit_cast(unsigned, f); return (u + 0x7fffu + ((u >> 16) & 1u)) >> 16; }
__device__ __forceinline__ unsigned pk2(float lo, float hi) { return f2bf(lo) | (f2bf(hi) << 16); }
#define XB_TMO      128
#define XB_XCNT(j)  (256  + 64 * (j))
#define XB_XSUB(j)  (1280 + 64 * (j))
#define XB_XGEN(j)  (2304 + 64 * (j))
#define XB_TOP      3328
#define XB_TOPGEN   3392
#define XCD_BAR_WORDS 3456
#define XB_SPIN_CAP (1u << 18)

__device__ __forceinline__ unsigned xb_ld(unsigned* p)              { return __hip_atomic_load(p, __ATOMIC_RELAXED, __HIP_MEMORY_SCOPE_AGENT); }
__device__ __forceinline__ unsigned xb_add(unsigned* p, unsigned v) { return __hip_atomic_fetch_add(p, v, __ATOMIC_RELAXED, __HIP_MEMORY_SCOPE_AGENT); }
__device__ __forceinline__ unsigned xb_xcc_id() { return (unsigned)__builtin_amdgcn_s_getreg((3 << 11) | 20) & 0xFu; }
#define XB_SPIN(cond, bar) do { unsigned _sp = 0; while (cond) { __builtin_amdgcn_s_sleep(1); \
    if ((++_sp & 255u) == 0u) { if (xb_ld(&(bar)[XB_TMO])) break; if (_sp > XB_SPIN_CAP) { atomicAdd(&(bar)[XB_TMO], 1u); break; } } } } while (0)

struct XcdBarrier {
    unsigned* bar; unsigned x;
    volatile LAS unsigned* st;
};

__device__ __forceinline__ XcdBarrier xcd_barrier_post(unsigned* bar, volatile LAS unsigned* st) {
    XcdBarrier b; b.bar = bar; b.x = xb_xcc_id(); b.st = st;
    if (threadIdx.x == 0) (void)xb_add(&bar[XB_XCNT(b.x)], 1u);
    return b;
}
__device__ __forceinline__ void xcd_barrier_complete(unsigned* bar, unsigned x, unsigned& nloc, unsigned& nx) {
    const unsigned G = gridDim.x * gridDim.y * gridDim.z;
    unsigned sum, cnt, mine, sp = 0u;
    for (;;) {
        sum = 0u; cnt = 0u; mine = 0u;
#pragma unroll
        for (unsigned j = 0; j < 16; ++j) { const unsigned c = xb_ld(&bar[XB_XCNT(j)]); sum += c; cnt += (c > 0u) ? 1u : 0u; mine = (j == x) ? c : mine; }
        if (sum == G) break;
        __builtin_amdgcn_s_sleep(1);
        if ((++sp & 255u) == 0u) { if (xb_ld(&bar[XB_TMO])) break; if (sp > XB_SPIN_CAP) { atomicAdd(&bar[XB_TMO], 1u); break; } }
    }
    nloc = mine > 0u ? mine : 1u; nx = cnt > 0u ? cnt : 1u;
}

__device__ __forceinline__ void xcd_barrier(const XcdBarrier& b) {
    asm volatile("s_waitcnt vmcnt(0)" ::: "memory");
    __syncthreads();
    if (threadIdx.x == 0) {
        unsigned* bar = b.bar;
        __builtin_amdgcn_s_waitcnt(0);
        unsigned nloc = b.st[0], nx = b.st[1];
        if (nloc == 0u) { xcd_barrier_complete(bar, b.x, nloc, nx); b.st[0] = nloc; b.st[1] = nx; }
        const unsigned old = xb_add(&bar[XB_XSUB(b.x)], 1u);
        const unsigned gen = old / nloc;
        if (old + 1u == (gen + 1u) * nloc) {
            __builtin_amdgcn_fence(__ATOMIC_RELEASE, "agent");
            asm volatile("s_waitcnt vmcnt(0)" ::: "memory");
            const unsigned og = xb_add(&bar[XB_TOP], 1u);
            const unsigned tg = og / nx;
            if (og + 1u == (tg + 1u) * nx) xb_add(&bar[XB_TOPGEN], 1u);
            else XB_SPIN(xb_ld(&bar[XB_TOPGEN]) == tg, bar);
            __builtin_amdgcn_fence(__ATOMIC_ACQUIRE, "agent");
            xb_add(&bar[XB_XGEN(b.x)], 1u);
            asm volatile("s_waitcnt vmcnt(0)" ::: "memory");
        } else {
            XB_SPIN(xb_ld(&bar[XB_XGEN(b.x)]) == gen, bar);
            __builtin_amdgcn_fence(__ATOMIC_ACQUIRE, "agent");
            asm volatile("s_waitcnt vmcnt(0)" ::: "memory");
        }
    }
    __syncthreads();
}
__device__ __forceinline__ float wave_sum(float v) {
#pragma unroll
    for (int o = 1; o < 64; o <<= 1) v += __shfl_xor(v, o);
    return v;
}
__device__ __forceinline__ unsigned pkbf(float lo, float hi) { return pg8::cvt_pk_bf16(lo, hi); }
__device__ __forceinline__ float bf2f(unsigned short b) { return __uint_as_float((unsigned)b << 16); }
__device__ __forceinline__ void transpose_item(const float* W, int ldn, bf16* WT, int K, int k0, int srccol0, int dstrow0, LAS float* scr, int lane, bool qf = false) {
#pragma unroll 8
    for (int i = 0; i < 32; ++i) { const int kk = 2 * i + (lane >> 5); scr[kk * 33 + (lane & 31)] = W[(size_t)(k0 + kk) * ldn + srccol0 + (lane & 31)]; }
    LDS_WAIT(); asm volatile("" ::: "memory");
    const int c = lane & 7;
#pragma unroll
    for (int j = 0; j < 4; ++j) { const int n = (lane >> 3) + 8 * j; const LAS float* s = scr + (8 * c) * 33 + n;
        v4u o; if (qf) { o.x = pkbf(qm(s[0 * 33]), qm(s[1 * 33])); o.y = pkbf(qm(s[2 * 33]), qm(s[3 * 33])); o.z = pkbf(qm(s[4 * 33]), qm(s[5 * 33])); o.w = pkbf(qm(s[6 * 33]), qm(s[7 * 33])); }
        else { o.x = pkbf(s[0 * 33], s[1 * 33]); o.y = pkbf(s[2 * 33], s[3 * 33]); o.z = pkbf(s[4 * 33], s[5 * 33]); o.w = pkbf(s[6 * 33], s[7 * 33]); }
        const int dr = dstrow0 + n; *(GAS v4u*)(WT + ((size_t)((dr >> 8) * (K >> 6) + (k0 >> 6)) * 256 + (dr & 255)) * 64 + 8 * c) = o; }
    LDS_WAIT(); asm volatile("" ::: "memory");
}
template <class INP> __device__ __forceinline__ void absmax_item(const INP& inp, unsigned char* ws, int t, LAS float* red, int tid) {
    const int col = tid & 127, kq = tid >> 7;
    const float* src; size_t ld; int kb, kn, kind, mat, cb;
    if (t < 352) { kind = 0; mat = t / 88; cb = t % 88; src = inp[12] + (size_t)mat * DM * NFF + 128 * cb + col; ld = NFF; kb = 512 * kq; kn = 512; }
    else if (t < 432) { t -= 352; kind = 1; mat = t / 40; cb = t % 40; src = inp[14] + (size_t)mat * DM * NIN + 128 * cb + col; ld = NIN; kb = 512 * kq; kn = 512; }
    else { t -= 432; kind = 2; mat = t >> 6; cb = (t & 63) >> 2; src = inp[13] + (size_t)mat * DFF * DM + 128 * cb + col; ld = DM; kb = 1408 * (t & 3) + 352 * kq; kn = 352; }
    float mx = 0.f;
    for (int k = kb; k < kb + kn; k += 8) { float w[8];
#pragma unroll
        for (int u = 0; u < 8; ++u) w[u] = src[(size_t)(k + u) * ld];
#pragma unroll
        for (int u = 0; u < 8; ++u) mx = fmaxf(mx, fabsf(w[u])); }
    red[kq * 128 + col] = mx;
    __syncthreads();
    if (tid < 128) { const float m4 = fmaxf(fmaxf(red[tid], red[128 + tid]), fmaxf(red[256 + tid], red[384 + tid])); const int s0 = 128 * cb + tid;
        if (kind == 0) { const int brow = s0 < DFF ? (s0 / 128) * 256 + (s0 % 128) : ((s0 - DFF) / 128) * 256 + 128 + ((s0 - DFF) % 128);
            ((float*)(ws + WS_Q + Q_SW))[(size_t)mat * NFF + brow] = fmaxf(m4, 1e-30f) * (1.0f / 127.0f); }
        else if (kind == 1) ((float*)(ws + WS_Q + Q_SW4))[(size_t)mat * NIN + s0] = fmaxf(m4, 1e-30f) * (1.0f / 127.0f);
        else atomicMax((unsigned*)(ws + WS_CTL + CTL_RAW2) + (size_t)mat * DM + s0, __float_as_uint(m4)); }
    __syncthreads();
}
template <class INP> __device__ __forceinline__ void prologue(const INP& inp, unsigned char* ws, LAS unsigned char* lds, int G, int wg, int tid) {
    const int lane = tid & 63, wave = __builtin_amdgcn_readfirstlane(tid >> 6);
    float* tab = (float*)(ws + WS_TAB);
    {
        LAS float* sc = (LAS float*)lds;
        LAS float* red = sc + NCOND * DM;
        bool have = false;
        for (int it = wg; it < 976; it += G) {
            if (it >= 288) { absmax_item(inp, ws, it - 288, (LAS float*)(lds + 98304), tid); continue; }
            if (!have) { for (int i = tid; i < NCOND * DM; i += 512) { const int cd = i >> 11, k = i & 2047; const float v = cd == 0 ? inp[8][k] : inp[2][(cd - 1) * DM + k];
                              sc[i] = v / (1.0f + __expf(-v)); } have = true; __syncthreads(); }
            const int l = it / 144, cb = it % 144, col = tid & 127, g = tid >> 7;
            const float* W = inp[9] + (size_t)l * DM * NMODC + 128 * cb + col;
            float acc[NCOND];
#pragma unroll
            for (int c = 0; c < NCOND; ++c) acc[c] = 0.f;
            for (int k = 512 * g; k < 512 * g + 512; k += 8) {
                float w[8];
#pragma unroll
                for (int u = 0; u < 8; ++u) w[u] = W[(size_t)(k + u) * NMODC];
#pragma unroll
                for (int c = 0; c < NCOND; ++c) { const f32x4 s0 = *(const LAS f32x4*)(sc + c * DM + k), s1 = *(const LAS f32x4*)(sc + c * DM + k + 4);
                    acc[c] += (s0[0] * w[0] + s0[1] * w[1]) + (s0[2] * w[2] + s0[3] * w[3]) + (s1[0] * w[4] + s1[1] * w[5]) + (s1[2] * w[6] + s1[3] * w[7]); }
            }
#pragma unroll
            for (int c = 0; c < NCOND; ++c) red[(g * NCOND + c) * 128 + col] = acc[c];
            __syncthreads();
            for (int i = tid; i < NCOND * 128; i += 512) { const int c = i >> 7, cc = i & 127;
                const float s = ((red[(0 * NCOND + c) * 128 + cc] + red[(1 * NCOND + c) * 128 + cc]) + red[(2 * NCOND + c) * 128 + cc]) + red[(3 * NCOND + c) * 128 + cc];
                tab[TB_MOD + ((size_t)l * NCOND + c) * NMODC + 128 * cb + cc] = s + inp[10][(size_t)l * NMODC + 128 * cb + cc]; }
            __syncthreads();
        }
        __syncthreads();
    }
    if (wg == 0) {
        for (int i = tid; i < 64 * 32; i += 512) { const int pos = i >> 5, f = i & 31; const double inv = pow(10000.0, -(double)(2 * f) / 64.0), a = (double)pos * inv;
            tab[TB_COSG + i] = (float)cos(a); tab[TB_SING + i] = (float)sin(a); }
        for (int i = tid; i < 64 * 16; i += 512) { const int pos = i >> 4, f = i & 15; const double inv = pow(10000.0, -(double)(2 * f) / 32.0), a = (double)pos * inv;
            tab[TB_COSD + i] = (float)cos(a); tab[TB_SIND + i] = (float)sin(a); }
        if (tid < 2) { const int l = tid; const float* dl = inp[19] + l * 256; double s01 = 0.0, s23 = 0.0;
            for (int i = 0; i < 64; ++i) { s01 += (double)dl[i] * (double)dl[64 + i]; s23 += (double)dl[128 + i] * (double)dl[192 + i]; }
            const double li = 0.8 - 0.6 * exp(-0.3 * (double)l);
            tab[TB_SCAL + 16 * l + 0] = (float)(exp(s01) - exp(s23) + li); tab[TB_SCAL + 16 * l + 1] = (float)(1.0 - li); }
        if (tid >= 128 && tid < 130) { const int l = tid - 128; const float* w = inp[18] + l * 256; float mq = 0.f, mk = 0.f;
            for (int i = 0; i < 128; ++i) { mq = fmaxf(mq, fabsf(w[i])); mk = fmaxf(mk, fabsf(w[128 + i])); }
            tab[TB_SCAL + 16 * l + 10] = (mq * mk * 11.313708f * 1.4426950f < 60.0f) ? 1.0f : 0.0f; }
        if (tid >= 64 && tid < 80) { const int i = tid - 64, l = i >> 3, j = i & 7; const double x = (double)inp[16][l * 8 + j];
            tab[TB_SCAL + 16 * l + 2 + j] = (float)(-log1p(exp(-x)) * 1.4426950408889634); }
    }
    {
        bf16* cb = (bf16*)(ws + WS_CACHE);
        const long gt = (long)wg * 512 + tid, GT = (long)G * 512;
        for (int t = 0; t < 4; ++t) { const float* src = inp[4 + t]; const long n8 = (t < 2 ? 1048576 : 2097152) / 8; bf16* dst = cb + (t == 0 ? 0 : t == 1 ? 1048576 : t == 2 ? 2097152 : 4194304);
            for (long i = gt; i < n8; i += GT) { const f32x4 a = *(const f32x4*)(src + i * 8), b = *(const f32x4*)(src + i * 8 + 4);
                v4u o; o.x = pkbf(a[0], a[1]); o.y = pkbf(a[2], a[3]); o.z = pkbf(b[0], b[1]); o.w = pkbf(b[2], b[3]); *(v4u*)(dst + i * 8) = o; } }
    }
    {
        LAS float* scr = (LAS float*)(lds + wave * 16384);
        const int gw = wg * 8 + wave, NGW = G * 8;
        for (int it = gw; it < 81920; it += NGW) {
            const int l = it / 40960; int r = it % 40960;
            bf16* WL = (bf16*)(ws + WS_W + (size_t)l * W_LAYER);
            if (r < 22528) continue;
            if (false) { const int f = r / 11264, q = r % 11264, kb = q / 352, nb = q % 352, s0 = 32 * nb;
                const int drow = s0 < DFF ? (s0 / 128) * 256 + (s0 % 128) : ((s0 - DFF) / 128) * 256 + 128 + ((s0 - DFF) % 128);
                transpose_item(inp[12] + (size_t)(l * 2 + f) * DM * NFF, NFF, WL + (W_WI + (size_t)f * 44 * MiB) / 2, DM, 64 * kb, s0, drow, scr, lane, true); continue; }
            r -= 22528;
            if (r < 11264) continue;
            if (false) { const int f = r / 5632, q = r % 5632, kb = q / 64, nb = q % 64;
                transpose_item(inp[13] + (size_t)(l * 2 + f) * DFF * DM, DM, WL + (W_WO + (size_t)f * 22 * MiB) / 2, DFF, 64 * kb, 32 * nb, 32 * nb, scr, lane, true); continue; }
            r -= 11264;
            if (r < 5120) { const int kb = r / 160, nb = r % 160;
                transpose_item(inp[14] + (size_t)l * DM * NIN, NIN, WL + W_WIN / 2, DM, 64 * kb, 32 * nb, 32 * nb, scr, lane); continue; }
            r -= 5120;
            { const int kb = r / 64, nb = r % 64;
                transpose_item(inp[15] + (size_t)l * DM * DM, DM, WL + W_WOUT / 2, DM, 64 * kb, 32 * nb, 32 * nb, scr, lane); }
        }
    }
}
template <class INP> __device__ __forceinline__ void prologue_b(const INP& inp, unsigned char* ws, LAS unsigned char* lds, int G, int wg, int tid) {
    const int lane = tid & 63, wave = __builtin_amdgcn_readfirstlane(tid >> 6);
    LAS float* scr = (LAS float*)(lds + wave * 16384);
    const float* swv = (const float*)(ws + WS_Q + Q_SW);
    const int gw = wg * 8 + wave, NGW = G * 8;
    const float* swv4 = (const float*)(ws + WS_Q + Q_SW4);
    if (wg < 4) {
        float sm = 0.f; for (int i = tid; i < NFF; i += 512) sm += swv[(size_t)wg * NFF + i];
#pragma unroll
        for (int o = 1; o < 64; o <<= 1) sm += __shfl_xor(sm, o);
        LAS float* red = (LAS float*)(lds + 131072);
        if (lane == 0) red[wave] = sm;
        __syncthreads();
        if (tid == 0) { float t = 0.f; for (int i = 0; i < 8; ++i) t += red[i];
            const float sg = t * (127.0f / (float)NFF) * (1.0f / 3.6f) * 45.254834f;
            const float h0 = fmaxf(fmaxf(sg * sg, sg), 1e-20f); const float sc = exp2f(1.0f - rintf(log2f(h0)));
            float* qa = (float*)(ws + WS_Q + Q_ACT) + 2 * wg; qa[0] = sc; qa[1] = 1.0f / sc; }
        __syncthreads();
    }
    for (int it = gw; it < 10240; it += NGW) {
        const int l = it / 5120, q = it % 5120, kb = q / 160, nb = q % 160, s0 = 32 * nb, k0 = 64 * kb;
        const float* W = inp[14] + (size_t)l * DM * NIN;
        unsigned char* WQ = ws + WS_W + (size_t)l * W_LAYER + W_WINQ;
#pragma unroll 8
        for (int i = 0; i < 32; ++i) { const int kk = 2 * i + (lane >> 5); scr[kk * 33 + (lane & 31)] = W[(size_t)(k0 + kk) * NIN + s0 + (lane & 31)]; }
        LDS_WAIT(); asm volatile("" ::: "memory");
        const int c = lane & 7;
#pragma unroll
        for (int j = 0; j < 4; ++j) { const int n = (lane >> 3) + 8 * j, dr = s0 + n; const LAS float* sp = scr + (8 * c) * 33 + n;
            const float inv = 1.0f / swv4[(size_t)l * NIN + dr];
            unsigned lo = 0u, hi = 0u;
#pragma unroll
            for (int e = 0; e < 4; ++e) { lo |= ((unsigned)(__float2int_rn(sp[e * 33] * inv)) & 0xffu) << (8 * e); hi |= ((unsigned)(__float2int_rn(sp[(4 + e) * 33] * inv)) & 0xffu) << (8 * e); }
            const int kk = k0 + 8 * c;
            uint2 o; o.x = lo; o.y = hi;
            *(uint2*)(WQ + ((size_t)((dr >> 8) * (DM >> 7) + (kk >> 7)) * 256 + (dr & 255)) * 128 + (kk & 127)) = o; }
        LDS_WAIT(); asm volatile("" ::: "memory");
    }
    const unsigned* raw2 = (const unsigned*)(ws + WS_CTL + CTL_RAW2);
    for (int i = wg * 512 + tid; i < 4 * DM; i += G * 512) ((float*)(ws + WS_Q + Q_SW2))[i] = fmaxf(__uint_as_float(raw2[i]), 1e-30f) * (1.0f / 240.0f);
    for (int it = gw; it < 22528; it += NGW) {
        const int mat = it / 5632, q = it % 5632, kb = q / 64, nb = q % 64, s0 = 32 * nb, k0 = 64 * kb, l = mat >> 1, f = mat & 1;
        const float* W = inp[13] + (size_t)mat * DFF * DM;
        unsigned char* WQ = ws + WS_W + (size_t)l * W_LAYER + W_WO + (size_t)f * 22 * MiB;
#pragma unroll 8
        for (int i = 0; i < 32; ++i) { const int kk = 2 * i + (lane >> 5); scr[kk * 33 + (lane & 31)] = W[(size_t)(k0 + kk) * DM + s0 + (lane & 31)]; }
        LDS_WAIT(); asm volatile("" ::: "memory");
        const int c = lane & 7;
#pragma unroll
        for (int j = 0; j < 4; ++j) { const int n = (lane >> 3) + 8 * j, dr = s0 + n; const LAS float* sp = scr + (8 * c) * 33 + n;
            const float inv = 240.0f / fmaxf(__uint_as_float(raw2[(size_t)mat * DM + dr]), 1e-30f);
            unsigned lo = __builtin_amdgcn_cvt_pk_fp8_f32(sp[0] * inv, sp[33] * inv, 0, false); lo = __builtin_amdgcn_cvt_pk_fp8_f32(sp[2 * 33] * inv, sp[3 * 33] * inv, lo, true);
            unsigned hi = __builtin_amdgcn_cvt_pk_fp8_f32(sp[4 * 33] * inv, sp[5 * 33] * inv, 0, false); hi = __builtin_amdgcn_cvt_pk_fp8_f32(sp[6 * 33] * inv, sp[7 * 33] * inv, hi, true);
            const int kk = k0 + 8 * c;
            uint2 o; o.x = lo; o.y = hi;
            *(uint2*)(WQ + ((size_t)((dr >> 8) * (DFF >> 7) + (kk >> 7)) * 256 + (dr & 255)) * 128 + (kk & 127)) = o; }
        LDS_WAIT(); asm volatile("" ::: "memory");
    }
    for (int it = gw; it < 45056; it += NGW) {
        const int mat = it / 11264, q = it % 11264, kb = q / 352, nb = q % 352, s0 = 32 * nb, k0 = 64 * kb, l = mat >> 1, f = mat & 1;
        const int drow = s0 < DFF ? (s0 / 128) * 256 + (s0 % 128) : ((s0 - DFF) / 128) * 256 + 128 + ((s0 - DFF) % 128);
        const float* W = inp[12] + (size_t)mat * DM * NFF;
        unsigned char* WQ = ws + WS_W + (size_t)l * W_LAYER + W_WI + (size_t)f * 44 * MiB;
#pragma unroll 8
        for (int i = 0; i < 32; ++i) { const int kk = 2 * i + (lane >> 5); scr[kk * 33 + (lane & 31)] = W[(size_t)(k0 + kk) * NFF + s0 + (lane & 31)]; }
        LDS_WAIT(); asm volatile("" ::: "memory");
        const int c = lane & 7;
#pragma unroll
        for (int j = 0; j < 4; ++j) { const int n = (lane >> 3) + 8 * j, dr = drow + n; const LAS float* sp = scr + (8 * c) * 33 + n;
            const float inv = 1.0f / swv[(size_t)mat * NFF + dr];
            unsigned lo = 0u, hi = 0u;
#pragma unroll
            for (int e = 0; e < 4; ++e) { lo |= ((unsigned)(__float2int_rn(sp[e * 33] * inv)) & 0xffu) << (8 * e); hi |= ((unsigned)(__float2int_rn(sp[(4 + e) * 33] * inv)) & 0xffu) << (8 * e); }
            const int kk = k0 + 8 * c;
            uint2 o; o.x = lo; o.y = hi;
            *(uint2*)(WQ + ((size_t)((dr >> 8) * (DM >> 7) + (kk >> 7)) * 256 + (dr & 255)) * 128 + (kk & 127)) = o; }
        LDS_WAIT(); asm volatile("" ::: "memory");
    }
}
__device__ __forceinline__ void quant_act_phase(const bf16* ACT, unsigned char* A8, float* sa, int G, int wg, int tid) {
    const int lane = tid & 63, wave = tid >> 6, gw = wg * 8 + wave, NGW = G * 8;
    for (int m = gw; m < MTOK; m += NGW) {
        const bf16* ar = ACT + (size_t)m * DFF;
        v4u v[11]; float mx = 0.f;
#pragma unroll
        for (int j = 0; j < 11; ++j) v[j] = *(const v4u*)(ar + 512 * j + 8 * lane);
#pragma unroll
        for (int j = 0; j < 11; ++j) { const unsigned w4[4] = {v[j].x, v[j].y, v[j].z, v[j].w};
#pragma unroll
            for (int e = 0; e < 4; ++e) mx = fmaxf(mx, fmaxf(fabsf(__uint_as_float(w4[e] << 16)), fabsf(__uint_as_float(w4[e] & 0xffff0000u)))); }
#pragma unroll
        for (int o = 1; o < 64; o <<= 1) mx = fmaxf(mx, __shfl_xor(mx, o));
        mx = fmaxf(mx, 1e-30f);
        if (lane == 0) sa[m] = mx * (1.0f / 127.0f);
        const float inv = 127.0f / mx; unsigned char* orow = A8 + (size_t)m * DFF;
#pragma unroll
        for (int j = 0; j < 11; ++j) { const unsigned w4[4] = {v[j].x, v[j].y, v[j].z, v[j].w}; unsigned o2[2] = {0u, 0u};
#pragma unroll
            for (int e = 0; e < 4; ++e) { const unsigned lo = (unsigned)__float2int_rn(__uint_as_float(w4[e] << 16) * inv) & 0xffu, hi = (unsigned)__float2int_rn(__uint_as_float(w4[e] & 0xffff0000u) * inv) & 0xffu;
                o2[e >> 1] |= (lo | (hi << 8)) << (16 * (e & 1)); }
            uint2 ov; ov.x = o2[0]; ov.y = o2[1]; *(uint2*)(orow + 512 * j + 8 * lane) = ov; }
    }
}
__device__ __forceinline__ void quant_xs_phase(const bf16* XS, const unsigned* amax, unsigned char* A8, float* sa, int G, int wg, int tid, int m_begin = 0) {
    const int lane = tid & 63, wave = tid >> 6, gw = wg * 8 + wave, NGW = G * 8;
    for (int m0 = m_begin + 2 * gw; m0 < MTOK; m0 += 2 * NGW) {
        v4u v[2][4]; float mx[2];
#pragma unroll
        for (int r = 0; r < 2; ++r) { const bf16* xr = XS + (size_t)(m0 + r) * DM; mx[r] = fmaxf(__uint_as_float(amax[m0 + r]), 1e-30f);
#pragma unroll
            for (int j = 0; j < 4; ++j) v[r][j] = *(const v4u*)(xr + 512 * j + 8 * lane); }
#pragma unroll
        for (int r = 0; r < 2; ++r) { const float inv = 127.0f / mx[r]; unsigned char* orow = A8 + (size_t)(m0 + r) * DM; if (lane == 0) sa[m0 + r] = mx[r] * (1.0f / 127.0f);
#pragma unroll
            for (int j = 0; j < 4; ++j) { const unsigned w4[4] = {v[r][j].x, v[r][j].y, v[r][j].z, v[r][j].w}; unsigned o2[2] = {0u, 0u};
#pragma unroll
                for (int e = 0; e < 4; ++e) { const unsigned lo = (unsigned)__float2int_rn(__uint_as_float(w4[e] << 16) * inv) & 0xffu, hi = (unsigned)__float2int_rn(__uint_as_float(w4[e] & 0xffff0000u) * inv) & 0xffu;
                    o2[e >> 1] |= (lo | (hi << 8)) << (16 * (e & 1)); }
                uint2 ov; ov.x = o2[0]; ov.y = o2[1]; *(uint2*)(orow + 512 * j + 8 * lane) = ov; } }
    }
}
__device__ __forceinline__ void quant_phase(const float* xP, const float* xS, const float* nw, const float* scl0  , unsigned char* A8, float* sa, unsigned long long* rss, int G, int wg, int tid, int m_begin = 0) {
    const int lane = tid & 63, wave = tid >> 6, gw = wg * 8 + wave, NGW = G * 8;
    for (int m = m_begin + gw; m < MTOK; m += NGW) {
        const float* xr = (m < M_P ? xP : xS) + (size_t)m * DM;
        const int cond = m < M_P ? 0 : 1 + ((m - M_P) >> 12);
        const float* scl = scl0 + (size_t)cond * NMODC;
        f32x4 h[8]; float ss = 0.f, mx = 0.f;
#pragma unroll
        for (int j = 0; j < 8; ++j) { const int c = 256 * j + 4 * lane; const f32x4 v = *(const f32x4*)(xr + c); ss += (v[0] * v[0] + v[1] * v[1]) + (v[2] * v[2] + v[3] * v[3]);
            h[j] = v * *(const f32x4*)(nw + c) * (*(const f32x4*)(scl + c) + 1.0f);
            mx = fmaxf(fmaxf(mx, fmaxf(fabsf(h[j][0]), fabsf(h[j][1]))), fmaxf(fabsf(h[j][2]), fabsf(h[j][3]))); }
        ss = wave_sum(ss);
#pragma unroll
        for (int o = 1; o < 64; o <<= 1) mx = fmaxf(mx, __shfl_xor(mx, o));
        mx = fmaxf(mx, 1e-30f);
        if (lane == 0) { rss[m] = (unsigned long long)(ss * 16777216.0f); sa[m] = mx * (1.0f / 127.0f); }
        const float inv = 127.0f / mx; unsigned char* orow = A8 + (size_t)m * DM;
#pragma unroll
        for (int j = 0; j < 8; ++j) { const unsigned w = ((unsigned)__float2int_rn(h[j][0] * inv) & 0xffu) | (((unsigned)__float2int_rn(h[j][1] * inv) & 0xffu) << 8) | (((unsigned)__float2int_rn(h[j][2] * inv) & 0xffu) << 16) | (((unsigned)__float2int_rn(h[j][3] * inv) & 0xffu) << 24);
            *(unsigned*)(orow + 256 * j + 4 * lane) = w; }
    }
}
__device__ __forceinline__ void norm0_phase(const float* xP, const float* xS, const float* nw, const float* mod  , bf16* XN, unsigned long long* rss, int G, int wg, int tid) {
    const int lane = tid & 63, wave = tid >> 6, gw = wg * 8 + wave, NGW = G * 8;
    for (int m = gw; m < MTOK; m += NGW) {
        const float* xr = (m < M_P ? xP : xS) + (size_t)m * DM;
        const int cond = m < M_P ? 0 : 1 + ((m - M_P) >> 12);
        const float* scl = mod + (size_t)cond * NMODC + DM;
        f32x4 v[8]; float ss = 0.f;
#pragma unroll
        for (int j = 0; j < 8; ++j) { v[j] = *(const f32x4*)(xr + 256 * j + 4 * lane); ss += (v[j][0] * v[j][0] + v[j][1] * v[j][1]) + (v[j][2] * v[j][2] + v[j][3] * v[j][3]); }
        ss = wave_sum(ss); if (lane == 0) rss[m] = (unsigned long long)(ss * 16777216.0f);
        bf16* orow = XN + (size_t)m * DM;
#pragma unroll
        for (int j = 0; j < 8; ++j) { const int c = 256 * j + 4 * lane; const f32x4 w = *(const f32x4*)(nw + c), s1 = *(const f32x4*)(scl + c);
            const f32x4 h = v[j] * w * (s1 + 1.0f);
            uint2 o; o.x = pkbf(qm(h[0]), qm(h[1])); o.y = pkbf(qm(h[2]), qm(h[3])); *(uint2*)(orow + c) = o; }
    }
}
__device__ __forceinline__ void bias_ffn_mfma(unsigned char* ws, LAS unsigned char* lds, int grp, int sub, int nsub, int tid) {
    typedef int i32x4_t __attribute__((ext_vector_type(4)));
    const int lane = tid & 63, wave = tid >> 6, l = grp >> 1, f = grp & 1;
    const float* mod = (const float*)(ws + WS_TAB) + TB_MOD + (size_t)l * NCOND * NMODC + (size_t)(6 * f) * DM;
    LAS unsigned char* D = lds;
    LAS float* red = (LAS float*)(lds + 65536);
    __syncthreads();
    for (int i = tid; i < 65536 / 16; i += 512) ((LAS v4u*)D)[i] = (v4u){0u, 0u, 0u, 0u};
    for (int c = wave; c < NCOND; c += 8) { float mx = 0.f; for (int k = lane; k < DM; k += 64) mx = fmaxf(mx, fabsf(mod[(size_t)c * NMODC + k]));
#pragma unroll
        for (int o = 1; o < 64; o <<= 1) mx = fmaxf(mx, __shfl_xor(mx, o));
        if (lane == 0) red[c] = fmaxf(mx, 1e-30f) * (1.0f / 127.0f); }
    __syncthreads();
    for (int i = tid; i < NCOND * DM; i += 512) { const int c = i >> 11, k = i & 2047; const float s0 = red[c], s1 = s0 * (1.0f / 127.0f), v = mod[(size_t)c * NMODC + k];
        const float d0 = rintf(v / s0), d1 = rintf((v - d0 * s0) / s1); const int off = ((k >> 6) * 16 + c) * 64 + (k & 63);
        D[off] = (unsigned char)(int)d0; D[32768 + off] = (unsigned char)(int)d1; }
    __syncthreads();
    const unsigned char* Bq = ws + WS_W + (size_t)l * W_LAYER + W_WI + (size_t)f * 44 * MiB;
    const float* swv = (const float*)(ws + WS_Q + Q_SW) + (size_t)(2 * l + f) * NFF;
    float* sb = (float*)(ws + WS_SB) + (size_t)l * SB_LAYER + (f ? SB_J2 : 0);
    const int jr = lane & 15, g = lane >> 4;
    for (int rg = sub * 8 + wave; rg < NFF / 16; rg += nsub * 8) {
        const int n = rg * 16 + jr;
        const unsigned char* wp = Bq + ((size_t)(n >> 8) * (DM >> 7) * 256 + (n & 255)) * 128 + 16 * g;
        i32x4_t a0 = {0, 0, 0, 0}, a1 = {0, 0, 0, 0};
#pragma unroll 4
        for (int kb = 0; kb < 32; ++kb) {
            const i32x4_t w = *(const i32x4_t*)(wp + (size_t)(kb >> 1) * 256 * 128 + (kb & 1) * 64);
            const i32x4_t d0 = *(const LAS i32x4_t*)(D + ((kb * 16 + jr) * 64 + 16 * g)), d1 = *(const LAS i32x4_t*)(D + 32768 + ((kb * 16 + jr) * 64 + 16 * g));
            a0 = __builtin_amdgcn_mfma_i32_16x16x64_i8(w, d0, a0, 0, 0, 0); a1 = __builtin_amdgcn_mfma_i32_16x16x64_i8(w, d1, a1, 0, 0, 0);
        }
        if (jr < NCOND) { const float s0 = red[jr], s1 = s0 * (1.0f / 127.0f);
#pragma unroll
            for (int r = 0; r < 4; ++r) { const int nn = rg * 16 + 4 * g + r; sb[(size_t)jr * NFF + nn] = swv[nn] * (s0 * (float)a0[r] + s1 * (float)a1[r]); } }
    }
    __syncthreads();
}
__device__ __forceinline__ void bias_phase(unsigned char* ws, LAS unsigned char* lds, int G, int wg, int tid) {
    const int lane = tid & 63, wave = tid >> 6, gw = wg * 8 + wave, NGW = G * 8;
    LAS float* sh = (LAS float*)lds;
    const float* tab = (const float*)(ws + WS_TAB);
    const int per = G / 4; const bool mf = per >= 1;
    if (mf && wg < 4 * per) bias_ffn_mfma(ws, lds, wg / per, wg % per, per, tid);
    for (int grp = 0; grp < 6; ++grp) {
        const int l = grp / 3, j = grp % 3, N = (j == 1) ? NIN : NFF;
        if (mf && j != 1) continue;
        const bf16* Bt = (const bf16*)(ws + WS_W + (size_t)l * W_LAYER + (j == 0 ? W_WI : j == 1 ? W_WIN : W_WI + 44 * MiB));
        float* sb = (float*)(ws + WS_SB) + (size_t)l * SB_LAYER + (j == 0 ? 0 : j == 1 ? SB_J1 : SB_J2);
        const float* mod = tab + TB_MOD + (size_t)l * NCOND * NMODC + (size_t)(3 * j) * DM;
        __syncthreads();
        for (int i = tid; i < NCOND * DM; i += 512) sh[i] = mod[(size_t)(i >> 11) * NMODC + (i & 2047)];
        __syncthreads();
        if (j != 1) {
            const unsigned char* Bq = (const unsigned char*)Bt; const float* swv = (const float*)(ws + WS_Q + Q_SW) + (size_t)(2 * l + (j >> 1)) * NFF;
            for (int n = gw; n < N; n += NGW) {
                v4u wr2[2];
#pragma unroll
                for (int q = 0; q < 2; ++q) { const int k_ = 16 * (lane + 64 * q); wr2[q] = *(const v4u*)(Bq + ((size_t)((n >> 8) * (DM >> 7) + (k_ >> 7)) * 256 + (n & 255)) * 128 + (k_ & 127)); }
                float wf[2][16];
#pragma unroll
                for (int q = 0; q < 2; ++q) { const unsigned ww[4] = {wr2[q].x, wr2[q].y, wr2[q].z, wr2[q].w};
#pragma unroll
                    for (int e = 0; e < 16; ++e) wf[q][e] = (float)(int)(signed char)((ww[e >> 2] >> (8 * (e & 3))) & 0xffu); }
                const float swn = swv[n];
#pragma unroll 1
                for (int c = 0; c < NCOND; ++c) { float a = 0.f;
#pragma unroll
                    for (int q = 0; q < 2; ++q) { const int k = 16 * (lane + 64 * q);
#pragma unroll
                        for (int e4 = 0; e4 < 4; ++e4) { const f32x4 s0 = *(const LAS f32x4*)(sh + c * DM + k + 4 * e4); a += (s0[0] * wf[q][4 * e4] + s0[1] * wf[q][4 * e4 + 1]) + (s0[2] * wf[q][4 * e4 + 2] + s0[3] * wf[q][4 * e4 + 3]); } }
                    const float t = wave_sum(a); if (lane == 0) sb[(size_t)c * N + n] = t * swn; }
            }
            continue;
        }
        v4u wq[4];
        if (gw < N) {
#pragma unroll
            for (int q = 0; q < 4; ++q) { const int k_ = 8 * (lane + 64 * q); wq[q] = *(const v4u*)(Bt + ((size_t)((gw >> 8) * (DM >> 6) + (k_ >> 6)) * 256 + (gw & 255)) * 64 + (k_ & 63)); } }
        for (int n = gw; n < N; n += NGW) {
            v4u wc_[4];
#pragma unroll
            for (int q = 0; q < 4; ++q) wc_[q] = wq[q];
            if (n + NGW < N) {
#pragma unroll
                for (int q = 0; q < 4; ++q) { const int k_ = 8 * (lane + 64 * q), n_ = n + NGW; wq[q] = *(const v4u*)(Bt + ((size_t)((n_ >> 8) * (DM >> 6) + (k_ >> 6)) * 256 + (n_ & 255)) * 64 + (k_ & 63)); } }
            float wf[4][8];
#pragma unroll
            for (int q = 0; q < 4; ++q) { const v4u w4 = wc_[q];
                wf[q][0] = __uint_as_float(w4.x << 16); wf[q][1] = __uint_as_float(w4.x & 0xffff0000u); wf[q][2] = __uint_as_float(w4.y << 16); wf[q][3] = __uint_as_float(w4.y & 0xffff0000u);
                wf[q][4] = __uint_as_float(w4.z << 16); wf[q][5] = __uint_as_float(w4.z & 0xffff0000u); wf[q][6] = __uint_as_float(w4.w << 16); wf[q][7] = __uint_as_float(w4.w & 0xffff0000u); }
#pragma unroll 1
            for (int c = 0; c < NCOND; ++c) { float a = 0.f;
#pragma unroll
                for (int q = 0; q < 4; ++q) { const int k = 8 * (lane + 64 * q); const f32x4 s0 = *(const LAS f32x4*)(sh + c * DM + k), s1 = *(const LAS f32x4*)(sh + c * DM + k + 4);
                    a += (s0[0] * wf[q][0] + s0[1] * wf[q][1]) + (s0[2] * wf[q][2] + s0[3] * wf[q][3]) + (s1[0] * wf[q][4] + s1[1] * wf[q][5]) + (s1[2] * wf[q][6] + s1[3] * wf[q][7]); }
                const float t = wave_sum(a); if (lane == 0) sb[(size_t)c * N + n] = t; }
        }
    }
    __syncthreads();
}
__device__ __forceinline__ void final_norm(float* x, const float* fw, int G, int wg, int tid) {
    const int lane = tid & 63, wave = tid >> 6, gw = wg * 8 + wave, NGW = G * 8;
    for (int m = gw; m < MTOK; m += NGW) {
        float* xr = x + (size_t)m * DM; f32x4 v[8]; float ss = 0.f;
#pragma unroll
        for (int j = 0; j < 8; ++j) { v[j] = *(const f32x4*)(xr + 256 * j + 4 * lane); ss += (v[j][0] * v[j][0] + v[j][1] * v[j][1]) + (v[j][2] * v[j][2] + v[j][3] * v[j][3]); }
        const float rstd = rsqrtf(wave_sum(ss) * (1.0f / DM) + EPS);
#pragma unroll
        for (int j = 0; j < 8; ++j) { const int c = 256 * j + 4 * lane; *(f32x4*)(xr + c) = (v[j] * rstd) * *(const f32x4*)(fw + c); }
    }
}
__device__ __forceinline__ void prep_row(int m, int l, bf16* PROJ, bf16* DST, const float* tab, const float* qkw  , float* out, int lane) {
    bf16* pr = PROJ + (size_t)m * NIN; bf16* pw = DST + (size_t)m * NIN;
    const bool lat = m >= M_P; const int t = lat ? ((m - M_P) & 4095) : (m & 255), b = lat ? ((m - M_P) >> 12) : (m >> 8);
    const int rr = t >> 6, cc = t & 63;
    unsigned rg[10], rd[8], rv2[2], rv4[4];
#pragma unroll
    for (int v = 0; v < 10; ++v) rg[v] = *(const unsigned*)(pr + (v < 8 ? C_GQ + 128 * v : C_GK + 128 * (v - 8)) + 2 * lane);
#pragma unroll
    for (int v = 0; v < 8; ++v) rd[v] = *(const unsigned*)(pr + (v < 4 ? C_DQ + 128 * v : C_DK + 128 * (v - 4)) + 2 * lane);
    if (!lat) {
#pragma unroll
        for (int v = 0; v < 2; ++v) rv2[v] = *(const unsigned*)(pr + C_GV + 128 * v + 2 * lane);
#pragma unroll
        for (int v = 0; v < 4; ++v) rv4[v] = *(const unsigned*)(pr + C_DV + 128 * v + 2 * lane);
    }
    const float wq0 = qkw[2 * lane], wq1 = qkw[2 * lane + 1], wk0 = qkw[128 + 2 * lane], wk1 = qkw[128 + 2 * lane + 1];
    float cs = 1.f, sn = 0.f, c2 = 1.f, s2 = 0.f;
    if (lat) { const int idx = lane < 32 ? rr * 32 + lane : cc * 32 + (lane - 32); cs = tab[TB_COSG + idx]; sn = tab[TB_SING + idx];
               const int p = lane & 31, id2 = p < 16 ? rr * 16 + p : cc * 16 + (p - 16); c2 = tab[TB_COSD + id2]; s2 = tab[TB_SIND + id2]; }
#pragma unroll
    for (int v = 0; v < 10; ++v) {
        const int col = (v < 8 ? C_GQ + 128 * v : C_GK + 128 * (v - 8)) + 2 * lane;
        const float x1 = bf2f((unsigned short)(rg[v] & 0xffffu)), x2 = bf2f((unsigned short)(rg[v] >> 16));
        const float rs = rsqrtf(wave_sum(x1 * x1 + x2 * x2) * (1.0f / 128.0f) + EPS);
        const float y1 = x1 * rs * (v < 8 ? wq0 : wk0), y2 = x2 * rs * (v < 8 ? wq1 : wk1);
        if (!lat && v >= 8) { float* o = out + O_GK + (((size_t)(b * 2 + l) * 256 + t) * 2 + (v - 8)) * 128 + 2 * lane; o[0] = y1; o[1] = y2; }
        const float qs = v < 8 ? 0.12751743f : 1.0f;
        *(unsigned*)(pw + col) = pkbf((y1 * cs - y2 * sn) * qs, (y1 * sn + y2 * cs) * qs);
    }
    if (lat) {
#pragma unroll
        for (int v = 0; v < 8; ++v) { const int col = (v < 4 ? C_DQ + 128 * v : C_DK + 128 * (v - 4)) + 2 * lane;
            const float x1 = bf2f((unsigned short)(rd[v] & 0xffffu)), x2 = bf2f((unsigned short)(rd[v] >> 16));
            *(unsigned*)(pw + col) = pkbf(x1 * c2 - x2 * s2, x1 * s2 + x2 * c2); }
    } else {
#pragma unroll
        for (int v = 0; v < 2; ++v) { float* o = out + O_GV + (((size_t)(b * 2 + l) * 256 + t) * 2 + v) * 128 + 2 * lane; o[0] = bf2f((unsigned short)(rv2[v] & 0xffffu)); o[1] = bf2f((unsigned short)(rv2[v] >> 16)); }
#pragma unroll
        for (int v = 0; v < 4; ++v) { const unsigned rk = rd[4 + v], rv = rv4[v];
            const size_t oi = (((size_t)(b * 2 + l) * 256 + t) * 4 + v) * 128 + 2 * lane;
            out[O_DK + oi] = bf2f((unsigned short)(rk & 0xffffu)); out[O_DK + oi + 1] = bf2f((unsigned short)(rk >> 16));
            out[O_DV + oi] = bf2f((unsigned short)(rv & 0xffffu)); out[O_DV + oi + 1] = bf2f((unsigned short)(rv >> 16)); }
    }
}
#ifndef EN_PRO
#define EN_PRO 1
#endif
#ifndef EN_NORM
#define EN_NORM 1
#endif
#ifndef EN_FFNIN
#define EN_FFNIN 1
#endif
#ifndef EN_FFNOUT
#define EN_FFNOUT 1
#endif
#ifndef EN_WIN
#define EN_WIN 1
#endif
#ifndef EN_P
#define EN_P 1
#endif
#ifndef EN_A
#define EN_A 1
#endif
#ifndef EN_A1
#define EN_A1 1
#endif
#ifndef EN_A2
#define EN_A2 1
#endif
#ifndef EN_A3
#define EN_A3 1
#endif
#ifndef EN_WOUT
#define EN_WOUT 1
#endif
#ifndef EN_FIN
#define EN_FIN 1
#endif
struct Args { const float* in[22]; float* out; unsigned char* ws; int ph_lo, ph_hi, pad0, pad1; };
constexpr int NPHASE = 30;
#define LAUNDER(p) asm volatile("" : "+s"(p))
struct InPtrs { const float* const* p; __device__ __forceinline__ const float* operator[](int i) const { return p[i]; } };
__device__ __forceinline__ int deal_unit(int i, int NL, int NC, int off, int G, int wg) {
    if (NL % G == 0) { const int nr = NL / G; if (i < nr) return i * G + wg; if (i > nr) return -1; const int c = (wg + G - off) % G; return c < NC ? NL + c : -1; }
    const int v = i * G + wg; return v < NL + NC ? v : -1;
}
__global__ void __launch_bounds__(512, 2) fwd_kernel(Args args) {
    extern __shared__ __attribute__((aligned(16))) unsigned char lds_raw[];
    LAS unsigned char* lds = (LAS unsigned char*)lds_raw;
    volatile LAS unsigned* MISC = (volatile LAS unsigned*)(lds + MISC_OFF);
    const int G = gridDim.x, wg = blockIdx.x;
    for (int u = threadIdx.x; u < (LDS_BYTES - 131072) / 4; u += 512) ((LAS unsigned*)(lds + 131072))[u] = 0u;
    __syncthreads();
    XcdBarrier bar = xcd_barrier_post((unsigned*)(args.ws + WS_CTL) + CW_BAR, MISC + 8);
    const int lo = args.ph_lo, hi = args.ph_hi;
#define IN(k) (lo <= (k) && (k) < hi)
#define SEAM(k) do { if (IN(k) && IN((k) + 1)) xcd_barrier(bar); } while (0)
#define PH_BEGIN size_t zoff_ = 0; asm volatile("" : "+s"(zoff_)); unsigned char* ws = args.ws + zoff_; float* out = args.out + zoff_;   \
    const InPtrs inp{args.in}; int tid = threadIdx.x; asm volatile("" : "+v"(tid)); \
    const int lane = tid & 63, wave = __builtin_amdgcn_readfirstlane(tid >> 6); (void)lane; (void)wave;

    if (IN(0)) { PH_BEGIN; (void)out; prologue(inp, ws, lds, G, wg, tid); }
    SEAM(0);
    if (IN(1)) { PH_BEGIN; (void)out; prologue_b(inp, ws, lds, G, wg, tid); }
    SEAM(1);
    if (IN(2)) { PH_BEGIN; (void)out;
        quant_phase(inp[0], inp[1] - (size_t)M_P * DM, inp[11], (const float*)(ws + WS_TAB) + TB_MOD + DM, ws + WS_XNB, (float*)(ws + WS_Q), (unsigned long long*)(ws + WS_RS), G, wg, tid);
        bias_phase(ws, lds, G, wg, tid); }
    SEAM(2);
#pragma unroll 1
    for (int l = 0; l < 2; ++l) {
        const int pb = 3 + 13 * l;
#pragma unroll 1
        for (int f = 0; f < 2; ++f) {
            const int fb = pb + 9 * f;
            if (IN(fb + 0)) { PH_BEGIN; (void)out; (void)inp; const bf16* WL = (const bf16*)(ws + WS_W + (size_t)l * W_LAYER);
                pg8::Gemm g{(const bf16*)(ws + WS_XNB), WL + (W_WI + (size_t)f * 44 * MiB) / 2, MTOK, NFF, DM / 2}; pg8::StaticOrder S; S.init(MTOK, NFF, G, wg);
                pg8::EpiSwiGLUQ E{ws + WS_A8B, DFF, (const unsigned long long*)(ws + WS_RS) + (size_t)(3 * l + 2 * f) * MTOK, (const float*)(ws + WS_Q), (const float*)(ws + WS_Q + Q_SW) + (size_t)(2 * l + f) * NFF,
                                  (const float*)(ws + WS_SB) + (size_t)l * SB_LAYER + (f ? SB_J2 : 0), NFF, (const float*)(ws + WS_Q + Q_ACT) + 2 * (2 * l + f)};
                pg8::gemm_phase<pg8::EpiSwiGLUQ, pg8::StaticOrder, true, true, true>(lds, g, S, E); }
            if (IN(fb + 0) && IN(fb + 2)) xcd_barrier(bar);
            if (IN(fb + 2)) { PH_BEGIN; float* X = out + O_X; const bool first = (l == 0 && f == 0); const unsigned char* WL8 = ws + WS_W + (size_t)l * W_LAYER + W_WO + (size_t)f * 22 * MiB;
                const float* tabf = (const float*)(ws + WS_TAB); const float* mod = tabf + TB_MOD + (size_t)l * NCOND * NMODC;
                pg8::Gemm g{(const bf16*)(ws + WS_A8B), (const bf16*)WL8, MTOK, DM, DFF / 2}; pg8::StaticOrder S; S.init(MTOK, DM, G, wg);
                const int ni = f ? 3 * (l + 1) : 3 * l + 1;
                const size_t rs_off = WS_RS + (size_t)ni * MTOK * 8;
                pg8::EpiResidN E{first ? inp[0] : X, first ? inp[1] - (size_t)M_P * DM : X, X, mod + (2 + 6 * f) * DM,
                                 inp[11] + (size_t)(f ? 3 : 3 * l + 1) * DM, f ? tabf + TB_MOD + (size_t)NCOND * NMODC + DM : mod + (size_t)4 * DM, (unsigned long long*)(ws + rs_off), (long)(f ? WS_ACT : WS_XN) - (long)rs_off, 0.5f, (f && l) ? 0 : 1,
                                 (long)(WS_Q + Q_ACT + (size_t)(2 * (2 * l + f) + 1) * 4) - (long)rs_off, (long)(WS_Q + Q_SW2 + (size_t)(2 * l + f) * DM * 4) - (long)rs_off, 2, 1, (long)(WS_CTL + CTL_AMAX + (size_t)ni * MTOK * 4) - (long)rs_off};
                pg8::gemm_phase<pg8::EpiResidN, pg8::StaticOrder, true, true, 2>(lds, g, S, E); }
            SEAM(fb + 2);
            if (f == 1) {
                if (l == 0 && IN(pb + 12)) { PH_BEGIN; float* X = out + O_X;
                    (void)X; quant_xs_phase((const bf16*)(ws + WS_ACT), (const unsigned*)(ws + WS_CTL + CTL_AMAX) + (size_t)3 * MTOK, ws + WS_XNB, (float*)(ws + WS_Q), G, wg, tid); }
                SEAM(pb + 12);
                break; }
            if (IN(pb + 3)) { PH_BEGIN; float* X = out + O_X;
                (void)X; quant_xs_phase((const bf16*)(ws + WS_XN), (const unsigned*)(ws + WS_CTL + CTL_AMAX) + (size_t)(3 * l + 1) * MTOK, ws + WS_XNB, (float*)(ws + WS_Q), G, wg, tid, M_P); }
            SEAM(pb + 3);
            if (IN(pb + 4)) {
                { PH_BEGIN; (void)out; (void)inp;
                  pg8::Gemm g{(const bf16*)(ws + WS_XNB + (size_t)M_P * DM), (const bf16*)(ws + WS_W + (size_t)l * W_LAYER + W_WINQ), M_S, NIN, DM / 2}; pg8::StaticOrder S; S.init(M_S, NIN, G, wg);
                  pg8::EpiStoreQ E{(bf16*)(ws + WS_ACT) + (size_t)M_P * NIN, NIN, (const unsigned long long*)(ws + WS_RS) + (size_t)(3 * l + 1) * MTOK + M_P, (const float*)(ws + WS_Q) + M_P,
                                   (const float*)(ws + WS_Q + Q_SW4) + (size_t)l * NIN, (const float*)(ws + WS_SB) + (size_t)l * SB_LAYER + SB_J1, NIN, 16};
                  pg8::gemm_phase<pg8::EpiStoreQ, pg8::StaticOrder, true, true, true>(lds, g, S, E); }
                { PH_BEGIN; (void)out; (void)inp; const bf16* WL = (const bf16*)(ws + WS_W + (size_t)l * W_LAYER);
                  pg8::Gemm g{(const bf16*)(ws + WS_XN), WL + W_WIN / 2, M_P, NIN, DM}; pg8::StaticOrder S; S.init(M_P, NIN, G, wg);
                  pg8::EpiStoreBf16N E{(bf16*)(ws + WS_ACT), NIN, (const unsigned long long*)(ws + WS_RS) + (size_t)(3 * l + 1) * MTOK, (const float*)(ws + WS_SB) + (size_t)l * SB_LAYER + SB_J1, NIN};
                  pg8::gemm_phase<pg8::EpiStoreBf16N, pg8::StaticOrder, true, true>(lds, g, S, E); }
            }
            SEAM(pb + 4);
            if (IN(pb + 5)) { PH_BEGIN; bf16* PROJ = (bf16*)(ws + WS_ACT); const float* tab = (const float*)(ws + WS_TAB);
#pragma unroll 1
                for (int ch = wg; ch < 192; ch += G) {
                    const bool lat = ch < 64; const int cc = lat ? ch : ch - 64, dir = cc & 1, h = (cc >> 1) & 3, b = cc >> 3;
                    att::ChainArgs a; a.P = PROJ + (size_t)(lat ? M_P + b * 4096 : b * 256) * NIN; a.kcol = C_RK + 128 * h; a.vcol = C_RV + 128 * h; a.nchunk = lat ? 32 : 2; a.dir = dir;
                    a.lg2 = tab[TB_SCAL + 16 * l + 2 + dir * 4 + h];
                    a.S0 = lat ? inp[3] + ((((size_t)b * 2 + l) * 2 + dir) * 4 + h) * 16384 : nullptr;
                    a.ST = (bf16*)(ws + WS_ST) + (lat ? (size_t)cc * 32 * 16384 : (size_t)64 * 32 * 16384 + (size_t)cc * 2 * 16384);
                    a.Sfin = lat ? nullptr : out + O_STATE + ((((size_t)b * 2 + l) * 2 + dir) * 4 + h) * 16384;
                    __syncthreads(); att::ret_chain(a, (char*)lds_raw);
                }
                const int w0 = G > 128 ? 64 : 0, gw = (wg - w0) * 8 + wave, NGW = (G - w0) * 8;
                if (wg >= w0) for (int m = gw; m < MTOK; m += NGW) prep_row(m, l, PROJ, PROJ, tab, inp[18] + l * 256, out, lane);
            }
            SEAM(pb + 5);
            if (IN(pb + 6)) { PH_BEGIN; (void)out; bf16* PROJ = (bf16*)(ws + WS_ACT); bf16* MIX = (bf16*)(ws + WS_XN); const float* tab = (const float*)(ws + WS_TAB);
                const bf16* CGK = (const bf16*)(ws + WS_CACHE);
#pragma unroll 1
                for (int rp = 0; rp < ((PROBE == 13 && l == 0) ? 2 : 1); ++rp)
#pragma unroll 1
                for (int i2 = 0;; ++i2) { const int ps = i2 & 1; const int u = deal_unit(i2 >> 1, 512, 64, 192, G, wg); if (u < 0) break;
                    const bool lat = u < 512; const int v = lat ? u : u - 512;
                    const int qb = lat ? (v & 15) : 0, h = lat ? ((v >> 4) & 3) : (v & 3), b = lat ? (v >> 6) : (v >> 2);
                    const size_t row0 = lat ? (size_t)M_P + (size_t)b * 4096 : (size_t)b * 256;
                    const float lam = tab[TB_SCAL + 16 * l + 0], post = tab[TB_SCAL + 16 * l + 1];
                    {
                        att::KVSrc kv; kv.K1 = PROJ + row0 * NIN + C_DK + 128 * h + 64 * ps; kv.V1 = PROJ + row0 * NIN + C_DV + 128 * h; kv.n1 = lat ? 4096 : 256;
                        kv.K2 = CGK + 2097152 + ((size_t)(b * 2 + l) * 256) * 512 + 128 * h + 64 * ps; kv.V2 = CGK + 4194304 + ((size_t)(b * 2 + l) * 256) * 512 + 128 * h; kv.n2 = lat ? 256 : 0;
                        att::AttnOut ao; ao.Ob = MIX + (row0 + 256 * qb) * DM + 1536 + 128 * h; ao.Of = (float*)(ws + WS_DF) + (row0 + 256 * qb) * 512 + 128 * h;
                        ao.nw = inp[20] + l * 512 + 128 * h; ao.lam = lam; ao.post = post; ao.pass = ps;
                        __syncthreads();
                        att::attn_body<64, 1, 512>(PROJ + (row0 + 256 * qb) * NIN + C_DQ + 128 * h + 64 * ps, kv, ao, (char*)lds_raw);
                    }
                }
                const bool nomax = tab[TB_SCAL + 16 * l + 10] != 0.f;
#pragma unroll 1
                for (int rp = 0; rp < ((PROBE == 14 && l == 0) ? 2 : 1); ++rp)
#pragma unroll 1
                for (int i = 0;; ++i) { const int u = deal_unit(i, 1024, 128, 64, G, wg); if (u < 0) break;
                    const bool lat = u < 1024; const int v = lat ? u : u - 1024;
                    const int qb = lat ? (v & 15) : 0, hq = lat ? ((v >> 4) & 7) : (v & 7), b = lat ? (v >> 7) : (v >> 3), kvh = hq >> 2;
                    const size_t row0 = lat ? (size_t)M_P + (size_t)b * 4096 : (size_t)b * 256;
                    att::KVSrc kv; kv.K1 = PROJ + row0 * NIN + C_GK + 128 * kvh; kv.V1 = PROJ + row0 * NIN + C_GV + 128 * kvh; kv.n1 = lat ? 4096 : 256;
                    kv.K2 = CGK + ((size_t)(b * 2 + l) * 256) * 256 + 128 * kvh; kv.V2 = CGK + 1048576 + ((size_t)(b * 2 + l) * 256) * 256 + 128 * kvh; kv.n2 = lat ? 256 : 0;
                    att::AttnOut ao; ao.Ob = MIX + (row0 + 256 * qb) * DM + 512 + 128 * hq; ao.Of = nullptr; ao.nw = nullptr; ao.lam = 0.f; ao.post = 0.f; ao.pass = 0;
                    __syncthreads();
                    if (nomax) att::attn_body<128, 0, 256, 1>(PROJ + (row0 + 256 * qb) * NIN + C_GQ + 128 * hq, kv, ao, (char*)lds_raw);
                    else att::attn_body<128, 0, 256, 2>(PROJ + (row0 + 256 * qb) * NIN + C_GQ + 128 * hq, kv, ao, (char*)lds_raw);
                }
#pragma unroll 1
                for (int rp = 0; rp < ((PROBE == 15 && l == 0) ? 2 : 1); ++rp)
#pragma unroll 1
                for (int i = 0;; ++i) { const int u = deal_unit(i, 512, 64, 0, G, wg); if (u < 0) break;
                    const bool lat = u < 512; const int v = lat ? u : u - 512;
                    const int pr = lat ? (v & 15) : 0, h = lat ? ((v >> 4) & 3) : (v & 3), b = lat ? (v >> 6) : (v >> 2);
                    const size_t row0 = (lat ? (size_t)M_P + (size_t)b * 4096 : (size_t)b * 256) + 256 * pr;
                    att::RetCArgs a; a.P = PROJ + row0 * NIN; a.qcol = C_RQ + 128 * h; a.kcol = C_RK + 128 * h; a.vcol = C_RV + 128 * h; a.gcol = C_RG + 128 * h;
                    a.lg2f = tab[TB_SCAL + 16 * l + 2 + h]; a.lg2b = tab[TB_SCAL + 16 * l + 6 + h];
                    const int cf = (b * 4 + h) * 2; const bf16* STB = (const bf16*)(ws + WS_ST);
                    a.STf = STB + (lat ? (size_t)cf * 32 * 16384 : (size_t)64 * 32 * 16384 + (size_t)cf * 2 * 16384) + (size_t)(2 * pr) * 16384;
                    a.STb = STB + (lat ? (size_t)(cf + 1) * 32 * 16384 : (size_t)64 * 32 * 16384 + (size_t)(cf + 1) * 2 * 16384) + (size_t)(2 * pr) * 16384;
                    a.gnw = inp[17] + l * 512 + 128 * h; a.O = MIX + row0 * DM + 128 * h;
                    __syncthreads();
                    att::ret_c(a, (char*)lds_raw);
                }
            }
            SEAM(pb + 6);
            if (IN(pb + 7)) { PH_BEGIN; float* X = out + O_X; const bf16* WL = (const bf16*)(ws + WS_W + (size_t)l * W_LAYER);
                const float* mod = (const float*)(ws + WS_TAB) + TB_MOD + (size_t)l * NCOND * NMODC;
                pg8::Gemm g{(const bf16*)(ws + WS_XN), WL + W_WOUT / 2, MTOK, DM, DM}; pg8::StaticOrder S; S.init(MTOK, DM, G, wg);
                const size_t rs_off = WS_RS + (size_t)(3 * l + 2) * MTOK * 8;
                pg8::EpiResidN E{X, X, X, mod + 5 * DM, inp[11] + ((size_t)l * 3 + 2) * DM, mod + 7 * DM, (unsigned long long*)(ws + rs_off), (long)WS_ACT - (long)rs_off, 1.0f, 1, (long)WS_Q - (long)rs_off, (long)WS_Q - (long)rs_off, 0, 1, (long)(WS_CTL + CTL_AMAX + (size_t)(3 * l + 2) * MTOK * 4) - (long)rs_off};
                pg8::gemm_phase<pg8::EpiResidN, pg8::StaticOrder, true, true>(lds, g, S, E); }
            SEAM(pb + 7);
            if (IN(pb + 8)) { PH_BEGIN; float* X = out + O_X;
                (void)X; quant_xs_phase((const bf16*)(ws + WS_ACT), (const unsigned*)(ws + WS_CTL + CTL_AMAX) + (size_t)(3 * l + 2) * MTOK, ws + WS_XNB, (float*)(ws + WS_Q), G, wg, tid); }
            SEAM(pb + 8);
        }
    }
    if (IN(29)) { PH_BEGIN; (void)ws; final_norm(out + O_X, inp[21], G, wg, tid); }
#undef IN
#undef SEAM
#undef PH_BEGIN
}

extern "C" void kernel_launch(void* const* d_in, const int* in_sizes, int n_in, void* d_out, int out_size, void* d_ws, size_t ws_size, hipStream_t stream) {
    static int grid = 0;
    if (grid == 0) {
        if (n_in != 22 || out_size != (int)O_END || ws_size < WS_END) { fprintf(stderr, "kernel_launch: unexpected shapes: n_in %d out %d ws %zu (need %zu)\n", n_in, out_size, ws_size, (size_t)WS_END); grid = -1; return; }
        int dev = 0, cus = 0, per_cu = 0;
        if (hipGetDevice(&dev) != hipSuccess || hipDeviceGetAttribute(&cus, hipDeviceAttributeMultiprocessorCount, dev) != hipSuccess) { grid = -1; return; }
        if (hipFuncSetAttribute((const void*)fwd_kernel, hipFuncAttributeMaxDynamicSharedMemorySize, LDS_BYTES) != hipSuccess) { fprintf(stderr, "kernel_launch: hipFuncSetAttribute failed\n"); grid = -1; return; }
        if (hipOccupancyMaxActiveBlocksPerMultiprocessor(&per_cu, (const void*)fwd_kernel, 512, LDS_BYTES) != hipSuccess || per_cu < 1) { fprintf(stderr, "kernel_launch: occupancy query says %d\n", per_cu); }
        (void)hipGetLastError();
        grid = cus;
    }
    if (grid < 0) return;
    (void)hipMemsetAsync((char*)d_ws + WS_CTL, 0, CTL_ZERO_BYTES, stream);
    (void)hipMemsetAsync((char*)d_ws + WS_RS, 0, 2 * MiB, stream);
    Args a{};
    for (int i = 0; i < 22; ++i) a.in[i] = (const float*)d_in[i];
    a.out = (float*)d_out; a.ws = (unsigned char*)d_ws; a.ph_lo = 0; a.ph_hi = NPHASE; a.pad0 = 0; a.pad1 = 0;
    hipLaunchKernelGGL(fwd_kernel, dim3(grid), dim3(512), LDS_BYTES, stream, a);
}
```

```cpp
#include <hip/hip_runtime.h>
#include <hip/hip_bf16.h>
#include <cstdio>
#include <cstdint>
#ifndef PROBE
#define PROBE 0
#endif
#ifndef FFN_MB
#define FFN_MB 4
#endif
__device__ __forceinline__ float qm(float x) { if (FFN_MB >= 7) return x; unsigned u = __float_as_uint(x); constexpr unsigned sh = 23 - FFN_MB; u = (u + ((1u << (sh - 1)) - 1u) + ((u >> sh) & 1u)) & ~((1u << sh) - 1u); return __uint_as_float(u); }
#ifndef DBGT_CLK
#define DBGT_CLK 0
#endif
#ifndef DBGT_PH
#define DBGT_PH -1
#endif
namespace pg8 {
#define PG8_LAS __attribute__((address_space(3)))
typedef unsigned short bf16_t;
typedef short bf16x8 __attribute__((ext_vector_type(8)));
typedef float f32x4 __attribute__((ext_vector_type(4)));
typedef unsigned u32x4 __attribute__((ext_vector_type(4)));
typedef int i32x4 __attribute__((ext_vector_type(4)));
constexpr int BM = 256, BK = 64, HALF = 128, HTB = HALF * BK * 2  , STAGE_BYTES = 8 * HTB, NXCD = 8, WGM = 4;

__host__ __device__ __forceinline__ int lds_byte(int r, int c) { const int st = (r >> 4) * 2 + (c >> 5), rr = r & 15, cc = c & 31, ob = rr * 64 + cc * 2; return st * 1024 + (ob ^ (((ob >> 9) & 1) << 5)); }
__host__ __device__ __forceinline__ void stage_rc(int b, int& R, int& C) { const int st = b / 1024, sb = b % 1024, swz = sb ^ (((sb >> 9) & 1) << 5); R = (st >> 1) * 16 + swz / 64; C = (st & 1) * 32 + (swz % 64) / 2; }
__host__ __device__ __forceinline__ int perm32(int rho) { const int n = rho >> 4, i = rho & 15; return 8 * (i >> 2) + 4 * n + (i & 3); }

struct Unit { int pm, pn; };
struct Gemm { const bf16_t* A; const bf16_t* Bt; int M, N, K; };

struct StaticOrder {
    int nM, nN, nwg, G, c;
    __host__ __device__ void init(int M, int N, int G_, int c_) { nM = M / BM; nN = N / BM; nwg = nM * nN; G = G_; c = c_; }
    __host__ __device__ bool next(int i, Unit& u) const {
        const long L = (long)i * G + c; if (L >= nwg) return false;
        int wgid = (int)L; { const int q = nwg / NXCD, r = nwg % NXCD, xcd = wgid % NXCD, off = wgid / NXCD; wgid = (xcd < r ? xcd * (q + 1) : r * (q + 1) + (xcd - r) * q) + off; }
        const int nig = WGM * nN, gid = wgid / nig, fm = gid * WGM, gsz = (nM - fm) < WGM ? (nM - fm) : WGM;
        u.pm = fm + ((wgid % nig) % gsz); u.pn = (wgid % nig) / gsz; return true;
    }
    __device__ __forceinline__ void a_ready(const Unit&) const {}
    __device__ __forceinline__ void done(const Unit&) const {}
};

__device__ __forceinline__ unsigned cvt_pk_bf16(float lo, float hi) { unsigned r; asm volatile("v_cvt_pk_bf16_f32 %0, %1, %2" : "=v"(r) : "v"(lo), "v"(hi)); return r; }
typedef float f32x2 __attribute__((ext_vector_type(2)));
struct EpiStoreBf16 {
    static constexpr bool PERM = true, AFTER_DRAIN = false;
    bf16_t* O; int ldc;
    __device__ __forceinline__ void operator()(const f32x4 (&acc)[2][2][4][2], const Unit& u, int wr, int wc, int fr, int fq) const {
        const int row0 = u.pm * BM + wr * 64 + fr, col0 = u.pn * BM + wc * 32 + 8 * fq;
#pragma unroll
        for (int ai = 0; ai < 2; ++ai)
#pragma unroll
            for (int m = 0; m < 4; ++m) { bf16_t* rowp = O + (size_t)(row0 + ai * HALF + m * 16) * ldc + col0;
#pragma unroll
                for (int bj = 0; bj < 2; ++bj) { const f32x4 v0 = acc[ai][bj][m][0], v1 = acc[ai][bj][m][1];
                    u32x4 w; w.x = cvt_pk_bf16(v0[0], v0[1]); w.y = cvt_pk_bf16(v0[2], v0[3]); w.z = cvt_pk_bf16(v1[0], v1[1]); w.w = cvt_pk_bf16(v1[2], v1[3]);
                    *(u32x4*)(rowp + bj * HALF) = w; } }
    }
};
__device__ __forceinline__ float silu_f(float g) { return g * __builtin_amdgcn_rcpf(1.0f + __builtin_amdgcn_exp2f(-1.4426950408889634f * g)); }
struct EpiSwiGLU {
    static constexpr bool PERM = true, AFTER_DRAIN = false;
    bf16_t* O; int ldc;
    __device__ __forceinline__ void operator()(const f32x4 (&acc)[2][2][4][2], const Unit& u, int wr, int wc, int fr, int fq) const {
        const int row0 = u.pm * BM + wr * 64 + fr, col0 = u.pn * HALF + wc * 32 + 8 * fq;
#pragma unroll
        for (int ai = 0; ai < 2; ++ai)
#pragma unroll
            for (int m = 0; m < 4; ++m) { bf16_t* rowp = O + (size_t)(row0 + ai * HALF + m * 16) * ldc + col0;
                const f32x4 g0 = acc[ai][0][m][0], g1 = acc[ai][0][m][1], u0 = acc[ai][1][m][0], u1 = acc[ai][1][m][1];
                u32x4 w; w.x = cvt_pk_bf16(silu_f(g0[0]) * u0[0], silu_f(g0[1]) * u0[1]); w.y = cvt_pk_bf16(silu_f(g0[2]) * u0[2], silu_f(g0[3]) * u0[3]);
                w.z = cvt_pk_bf16(silu_f(g1[0]) * u1[0], silu_f(g1[1]) * u1[1]); w.w = cvt_pk_bf16(silu_f(g1[2]) * u1[2], silu_f(g1[3]) * u1[3]);
                *(u32x4*)rowp = w; }
    }
};
struct EpiResid {
    static constexpr bool PERM = false, AFTER_DRAIN = false;
    const float* baseP; const float* baseS; float* out; const float* gate; float coef;
    __device__ __forceinline__ void operator()(const f32x4 (&acc)[2][2][4][2], const Unit& u, int wr, int wc, int fr, int fq) const {
        const int cond = u.pm < 16 ? 0 : 1 + ((u.pm - 16) >> 4);
        const float* g = gate + (size_t)cond * 18432; const float* base = u.pm < 16 ? baseP : baseS;
        const int row0 = u.pm * BM + wr * 64 + fr, col0 = u.pn * BM + wc * 32 + 4 * fq;
        f32x4 gv[2][2];
#pragma unroll
        for (int bj = 0; bj < 2; ++bj)
#pragma unroll
            for (int n = 0; n < 2; ++n) gv[bj][n] = *(const f32x4*)(g + col0 + bj * HALF + n * 16) * coef;
#pragma unroll
        for (int ai = 0; ai < 2; ++ai)
#pragma unroll
            for (int m = 0; m < 4; ++m) { const size_t off = (size_t)(row0 + ai * HALF + m * 16) * 2048 + col0;
#pragma unroll
                for (int bj = 0; bj < 2; ++bj)
#pragma unroll
                    for (int n = 0; n < 2; ++n) { const f32x4 b = *(const f32x4*)(base + off + bj * HALF + n * 16);
                        *(f32x4*)(out + off + bj * HALF + n * 16) = b + gv[bj][n] * acc[ai][bj][m][n]; }
                if (m == 3) asm volatile("" ::: "memory"); }
    }
};

__device__ __forceinline__ float rstd_of(const unsigned long long* rss, int row) { return rsqrtf((float)rss[row] * (1.0f / 16777216.0f) * (1.0f / 2048.0f) + 1e-6f); }
struct EpiStoreBf16N {
    static constexpr bool PERM = true, AFTER_DRAIN = false;
    bf16_t* O; int ldc; const unsigned long long* rss; const float* bias; int ldb;
    __device__ __forceinline__ void operator()(const f32x4 (&acc)[2][2][4][2], const Unit& u, int wr, int wc, int fr, int fq) const {
        const int cond = u.pm < 16 ? 0 : 1 + ((u.pm - 16) >> 4);
        const int row0 = u.pm * BM + wr * 64 + fr, col0 = u.pn * BM + wc * 32 + 8 * fq;
        const float* b = bias + (size_t)cond * ldb + col0;
        f32x4 bv[2][2];
#pragma unroll
        for (int bj = 0; bj < 2; ++bj)
#pragma unroll
            for (int n = 0; n < 2; ++n) bv[bj][n] = *(const f32x4*)(b + bj * HALF + 4 * n);
#pragma unroll
        for (int ai = 0; ai < 2; ++ai)
#pragma unroll
            for (int m = 0; m < 4; ++m) { const int row = row0 + ai * HALF + m * 16; const float rs = rstd_of(rss, row); bf16_t* rowp = O + (size_t)row * ldc + col0;
#pragma unroll
                for (int bj = 0; bj < 2; ++bj) { const f32x4 v0 = acc[ai][bj][m][0] * rs + bv[bj][0], v1 = acc[ai][bj][m][1] * rs + bv[bj][1];
                    u32x4 w; w.x = cvt_pk_bf16(v0[0], v0[1]); w.y = cvt_pk_bf16(v0[2], v0[3]); w.z = cvt_pk_bf16(v1[0], v1[1]); w.w = cvt_pk_bf16(v1[2], v1[3]);
                    *(u32x4*)(rowp + bj * HALF) = w; } }
    }
};
struct EpiSwiGLUN {
    static constexpr bool PERM = true, AFTER_DRAIN = false;
    bf16_t* O; int ldc; const unsigned long long* rss; const float* bias; int ldb;
    __device__ __forceinline__ void operator()(const f32x4 (&acc)[2][2][4][2], const Unit& u, int wr, int wc, int fr, int fq) const {
        const int cond = u.pm < 16 ? 0 : 1 + ((u.pm - 16) >> 4);
        const int row0 = u.pm * BM + wr * 64 + fr, col0 = u.pn * HALF + wc * 32 + 8 * fq;
        const float* b = bias + (size_t)cond * ldb + u.pn * BM + wc * 32 + 8 * fq;
        const f32x4 bg0 = *(const f32x4*)(b), bg1 = *(const f32x4*)(b + 4), bu0 = *(const f32x4*)(b + HALF), bu1 = *(const f32x4*)(b + HALF + 4);
#pragma unroll
        for (int ai = 0; ai < 2; ++ai)
#pragma unroll
            for (int m = 0; m < 4; ++m) { const int row = row0 + ai * HALF + m * 16; const float rs = rstd_of(rss, row); bf16_t* rowp = O + (size_t)row * ldc + col0;
                const f32x4 g0 = acc[ai][0][m][0] * rs + bg0, g1 = acc[ai][0][m][1] * rs + bg1, u0 = acc[ai][1][m][0] * rs + bu0, u1 = acc[ai][1][m][1] * rs + bu1;
                u32x4 w; w.x = cvt_pk_bf16(qm(silu_f(g0[0]) * u0[0]), qm(silu_f(g0[1]) * u0[1])); w.y = cvt_pk_bf16(qm(silu_f(g0[2]) * u0[2]), qm(silu_f(g0[3]) * u0[3]));
                w.z = cvt_pk_bf16(qm(silu_f(g1[0]) * u1[0]), qm(silu_f(g1[1]) * u1[1])); w.w = cvt_pk_bf16(qm(silu_f(g1[2]) * u1[2]), qm(silu_f(g1[3]) * u1[3]));
                *(u32x4*)rowp = w; }
    }
};
struct EpiStoreQ {
    static constexpr bool PERM = true, AFTER_DRAIN = false;
    bf16_t* O; int ldc; const unsigned long long* rss; const float* sa; const float* sw; const float* bias; int ldb; int pm_off;
    __device__ __forceinline__ void operator()(const f32x4 (&acc)[2][2][4][2], const Unit& u, int wr, int wc, int fr, int fq) const {
        const int pmg = u.pm + pm_off, cond = pmg < 16 ? 0 : 1 + ((pmg - 16) >> 4);
        const int row0 = u.pm * BM + wr * 64 + fr, col0 = u.pn * BM + wc * 32 + 8 * fq;
        const float* b = bias + (size_t)cond * ldb + col0; const float* w = sw + col0;
        f32x4 bv[2][2], wv[2][2];
#pragma unroll
        for (int bj = 0; bj < 2; ++bj)
#pragma unroll
            for (int n = 0; n < 2; ++n) { bv[bj][n] = *(const f32x4*)(b + bj * HALF + 4 * n); wv[bj][n] = *(const f32x4*)(w + bj * HALF + 4 * n); }
#pragma unroll
        for (int ai = 0; ai < 2; ++ai)
#pragma unroll
            for (int m = 0; m < 4; ++m) { const int row = row0 + ai * HALF + m * 16; const float rs = rstd_of(rss, row) * sa[row]; bf16_t* rowp = O + (size_t)row * ldc + col0;
#pragma unroll
                for (int bj = 0; bj < 2; ++bj) { const f32x4 v0 = acc[ai][bj][m][0] * rs * wv[bj][0] + bv[bj][0], v1 = acc[ai][bj][m][1] * rs * wv[bj][1] + bv[bj][1];
                    u32x4 w4; w4.x = cvt_pk_bf16(v0[0], v0[1]); w4.y = cvt_pk_bf16(v0[2], v0[3]); w4.z = cvt_pk_bf16(v1[0], v1[1]); w4.w = cvt_pk_bf16(v1[2], v1[3]);
                    *(u32x4*)(rowp + bj * HALF) = w4; } }
    }
};
__device__ __forceinline__ float sat448(float x) { return __builtin_fminf(__builtin_fmaxf(x, -448.0f), 448.0f); }
struct EpiSwiGLUQ {
    static constexpr bool PERM = true, AFTER_DRAIN = false;
    unsigned char* O; int ldc; const unsigned long long* rss; const float* sa; const float* sw; const float* bias; int ldb; const float* act_s;
    __device__ __forceinline__ void operator()(const f32x4 (&acc)[2][2][4][2], const Unit& u, int wr, int wc, int fr, int fq) const {
        const int cond = u.pm < 16 ? 0 : 1 + ((u.pm - 16) >> 4);
        const int row0 = u.pm * BM + wr * 64 + fr, col0 = u.pn * HALF + wc * 32 + 8 * fq, bcol = u.pn * BM + wc * 32 + 8 * fq;
        const float* b = bias + (size_t)cond * ldb + bcol; const float* w = sw + bcol;
        const f32x4 bg0 = *(const f32x4*)(b), bg1 = *(const f32x4*)(b + 4), bu0 = *(const f32x4*)(b + HALF), bu1 = *(const f32x4*)(b + HALF + 4);
        const f32x4 wg0 = *(const f32x4*)(w), wg1 = *(const f32x4*)(w + 4), wu0 = *(const f32x4*)(w + HALF), wu1 = *(const f32x4*)(w + HALF + 4);
        const float as = act_s[0];
#pragma unroll
        for (int ai = 0; ai < 2; ++ai)
#pragma unroll
            for (int m = 0; m < 4; ++m) { const int row = row0 + ai * HALF + m * 16; const float rs = rstd_of(rss, row) * sa[row]; unsigned char* rowp = O + (size_t)row * ldc + col0;
                const f32x4 g0 = acc[ai][0][m][0] * rs * wg0 + bg0, g1 = acc[ai][0][m][1] * rs * wg1 + bg1, u0 = (acc[ai][1][m][0] * rs * wu0 + bu0) * as, u1 = (acc[ai][1][m][1] * rs * wu1 + bu1) * as;
                unsigned w0 = __builtin_amdgcn_cvt_pk_fp8_f32(sat448(silu_f(g0[0]) * u0[0]), sat448(silu_f(g0[1]) * u0[1]), 0, false); w0 = __builtin_amdgcn_cvt_pk_fp8_f32(sat448(silu_f(g0[2]) * u0[2]), sat448(silu_f(g0[3]) * u0[3]), w0, true);
                unsigned w1 = __builtin_amdgcn_cvt_pk_fp8_f32(sat448(silu_f(g1[0]) * u1[0]), sat448(silu_f(g1[1]) * u1[1]), 0, false); w1 = __builtin_amdgcn_cvt_pk_fp8_f32(sat448(silu_f(g1[2]) * u1[2]), sat448(silu_f(g1[3]) * u1[3]), w1, true);
                uint2 wv; wv.x = w0; wv.y = w1; *(uint2*)rowp = wv; }
    }
};
struct EpiResidN {
    static constexpr bool PERM = false, AFTER_DRAIN = false;
    const float* baseP; const float* baseS; float* out; const float* gate; const float* nw; const float* scl; unsigned long long* rss; long xs_delta;   float coef; int do_xs; long sa_delta, sw_delta; int q8; int xs_all = 0; long am_delta = 0;
    __device__ __forceinline__ void operator()(const f32x4 (&acc)[2][2][4][2], const Unit& u, int wr, int wc, int fr, int fq) const {
        const int cond = u.pm < 16 ? 0 : 1 + ((u.pm - 16) >> 4); const int do_xs = (this->do_xs && (xs_all || u.pm < 16)) ? this->do_xs : 0;     bf16_t* xs = (bf16_t*)((char*)rss + xs_delta); const float* sa = (const float*)((char*)rss + sa_delta); const float* swc = (const float*)((char*)rss + sw_delta);
        const float* g = gate + (size_t)cond * 18432; const float* base = u.pm < 16 ? baseP : baseS;
        const int row0 = u.pm * BM + wr * 64 + fr, col0 = u.pn * BM + wc * 32 + 4 * fq;
        f32x4 gv[2][2], av[2][2];
#pragma unroll
        for (int bj = 0; bj < 2; ++bj)
#pragma unroll
            for (int n = 0; n < 2; ++n) { gv[bj][n] = *(const f32x4*)(g + col0 + bj * HALF + n * 16); av[bj][n] = q8 ? *(const f32x4*)(swc + col0 + bj * HALF + n * 16) : (f32x4){1.f, 1.f, 1.f, 1.f}; }
        f32x4 t0[2][2], t1[2][2];
#pragma unroll
        for (int bj = 0; bj < 2; ++bj)
#pragma unroll
            for (int n = 0; n < 2; ++n) { t0[bj][n] = do_xs ? *(const f32x4*)(nw + col0 + bj * HALF + n * 16) : (f32x4){0.f, 0.f, 0.f, 0.f}; t1[bj][n] = do_xs ? *(const f32x4*)(scl + (size_t)cond * 18432 + col0 + bj * HALF + n * 16) : (f32x4){0.f, 0.f, 0.f, 0.f}; }
#pragma unroll
        for (int bj = 0; bj < 2; ++bj)
#pragma unroll
            for (int n = 0; n < 2; ++n) { gv[bj][n] = gv[bj][n] * coef * av[bj][n]; av[bj][n] = t0[bj][n] * (t1[bj][n] + 1.0f); }
#pragma unroll
        for (int ai2 = 0; ai2 < 4; ++ai2) { const int ai = ai2 >> 1, m0 = (ai2 & 1) * 2;
            f32x4 bb[2][2][2];
#pragma unroll
            for (int mm = 0; mm < 2; ++mm)
#pragma unroll
                for (int bj = 0; bj < 2; ++bj)
#pragma unroll
                    for (int n = 0; n < 2; ++n) bb[mm][bj][n] = *(const f32x4*)(base + (size_t)(row0 + ai * HALF + (m0 + mm) * 16) * 2048 + col0 + bj * HALF + n * 16);
#pragma unroll
            for (int mm = 0; mm < 2; ++mm) { const int m = m0 + mm; const int row = row0 + ai * HALF + m * 16; const size_t off = (size_t)row * 2048 + col0; float ss = 0.f, amx = 0.f; const float sr = q8 == 2 ? sa[0] : q8 ? sa[row] : 1.0f;
#pragma unroll
                for (int bj = 0; bj < 2; ++bj)
#pragma unroll
                    for (int n = 0; n < 2; ++n) { const f32x4 b = bb[mm][bj][n]; const f32x4 o = b + gv[bj][n] * (acc[ai][bj][m][n] * sr);
                        *(f32x4*)(out + off + bj * HALF + n * 16) = o;
                        if (do_xs) { f32x4 q = o * av[bj][n]; if (do_xs == 2) { q[0] = qm(q[0]); q[1] = qm(q[1]); q[2] = qm(q[2]); q[3] = qm(q[3]); } ss += (o[0] * o[0] + o[1] * o[1]) + (o[2] * o[2] + o[3] * o[3]); amx = fmaxf(fmaxf(amx, fmaxf(fabsf(q[0]), fabsf(q[1]))), fmaxf(fabsf(q[2]), fabsf(q[3])));
                            uint2 w2; w2.x = cvt_pk_bf16(q[0], q[1]); w2.y = cvt_pk_bf16(q[2], q[3]); *(uint2*)(xs + off + bj * HALF + n * 16) = w2; } }
                if (do_xs) { ss += __shfl_xor(ss, 16); ss += __shfl_xor(ss, 32); if (fq == 0) atomicAdd(rss + row, (unsigned long long)(ss * 16777216.0f));
                    if (xs_all) { amx = fmaxf(amx, __shfl_xor(amx, 16)); amx = fmaxf(amx, __shfl_xor(amx, 32)); if (fq == 0) atomicMax((unsigned*)((char*)rss + am_delta) + row, __float_as_uint(amx)); } }
                if (mm == 1) asm volatile("" ::: "memory"); } }
    }
};
typedef int i32x8 __attribute__((ext_vector_type(8)));
__device__ __forceinline__ void mfma_f8_128(f32x4& c, const i32x8 a, const i32x8 b) { asm volatile("v_mfma_f32_16x16x128_f8f6f4 %0, %1, %2, %0" : "+v"(c) : "v"(a), "v"(b)); }
template <class Epi, class Sched, bool ALIGN_EPI = false, bool SP2 = false, int I8 = 0>
__device__ __forceinline__ void gemm_phase(PG8_LAS unsigned char* lds, const Gemm g, const Sched& S, const Epi& E) {
    int tid_ = threadIdx.x; asm volatile("" : "+v"(tid_));
    const int tid = tid_, wid = __builtin_amdgcn_readfirstlane(tid >> 6), lane = tid & 63, wr = wid >> 2, wc = wid & 3, fr = lane & 15, fq = lane >> 4;
    const int K = g.K, nt = K / BK;
    unsigned voffA[2], voffB[2];
#pragma unroll
    for (int i = 0; i < 2; ++i) { int R, C; stage_rc(tid * 16 + i * 8192, R, C); const int Rb = Epi::PERM ? ((R & ~31) + perm32(R & 31)) : R;
        voffA[i] = (unsigned)(R * K + C) * 2u; voffB[i] = (unsigned)(Rb * BK + C) * 2u; }
    const size_t kstep = (size_t)(BK * 2);
    const size_t hstep = (size_t)HALF * K * 2;
    const size_t tstep = 2 * hstep;
    const size_t kstepB = (size_t)BM * BK * 2, hstepB = (size_t)HALF * BK * 2;
    const unsigned ldsw = (unsigned)wid * 1024u;
    const int aoff = lds_byte(wr * 64 + fr, fq * 8), boff = lds_byte(wc * 32 + fr, fq * 8);
#define PG8_SA(b, h) (((b) * 2 + (h)) * HTB)
#define PG8_SB(b, h) ((4 + (b) * 2 + (h)) * HTB)
#define PG8_STAGE(bufoff, gbase, voff) do { _Pragma("unroll") for (int _i = 0; _i < 2; ++_i) \
        __builtin_amdgcn_global_load_lds((const unsigned*)((const char*)(gbase) + (voff)[_i]), (PG8_LAS unsigned*)(lds + (bufoff) + ldsw + _i * 8192), 16, 0, 0); } while (0)
#define PG8_LDA(dst, b, h) do { _Pragma("unroll") for (int m = 0; m < 4; ++m) _Pragma("unroll") for (int k = 0; k < 2; ++k) dst[m][k] = *(const PG8_LAS bf16x8*)(lds + PG8_SA(b, h) + aoff + m * 2048 + k * 1024); } while (0)
#define PG8_LDB(dst, b, h) do { _Pragma("unroll") for (int n = 0; n < 2; ++n) _Pragma("unroll") for (int k = 0; k < 2; ++k) dst[n][k] = *(const PG8_LAS bf16x8*)(lds + PG8_SB(b, h) + boff + n * 2048 + k * 1024); } while (0)
#define PG8_MMA(ai, bj, At, Bt) do { __builtin_amdgcn_s_setprio(1); _Pragma("unroll") for (int m = 0; m < 4; ++m) _Pragma("unroll") for (int n = 0; n < 2; ++n) { if constexpr (I8 == 2) { \
        mfma_f8_128(acc[ai][bj][m][n], __builtin_shufflevector(__builtin_bit_cast(i32x4, Bt[n][0]), __builtin_bit_cast(i32x4, Bt[n][1]), 0, 1, 2, 3, 4, 5, 6, 7), \
            __builtin_shufflevector(__builtin_bit_cast(i32x4, At[m][0]), __builtin_bit_cast(i32x4, At[m][1]), 0, 1, 2, 3, 4, 5, 6, 7)); } else _Pragma("unroll") for (int k = 0; k < 2; ++k) { \
        if constexpr (I8 == 1) acc[ai][bj][m][n] = __builtin_bit_cast(f32x4, __builtin_amdgcn_mfma_i32_16x16x64_i8(__builtin_bit_cast(i32x4, Bt[n][k]), __builtin_bit_cast(i32x4, At[m][k]), __builtin_bit_cast(i32x4, acc[ai][bj][m][n]), 0, 0, 0)); \
        else acc[ai][bj][m][n] = __builtin_amdgcn_mfma_f32_16x16x32_bf16(Bt[n][k], At[m][k], acc[ai][bj][m][n], 0, 0, 0); } } __builtin_amdgcn_s_setprio(0); } while (0)
#define PG8_WAIT_V(n) asm volatile("s_waitcnt vmcnt(" #n ")" ::: "memory")
#define PG8_WAIT_L(n) asm volatile("s_waitcnt lgkmcnt(" #n ")" ::: "memory")
#define PG8_BAR __builtin_amdgcn_s_barrier()
#define PG8_SCHED __builtin_amdgcn_sched_barrier(0)
    Unit cur, nxt; int ui = 0;
    if (!S.next(0, cur)) return;
    f32x4 acc[2][2][4][2];
#pragma unroll
    for (int a = 0; a < 2; ++a)
#pragma unroll
        for (int b = 0; b < 2; ++b)
#pragma unroll
            for (int m = 0; m < 4; ++m)
#pragma unroll
                for (int n = 0; n < 2; ++n) acc[a][b][m][n] = (f32x4){0.f, 0.f, 0.f, 0.f};
    bf16x8 At[4][2], B0[2][2], B1[2][2];
    const char* cA = (const char*)g.A + (size_t)cur.pm * tstep; const char* cB = (const char*)g.Bt + (size_t)cur.pn * tstep;
    S.a_ready(cur);
    if constexpr (SP2) {
        PG8_STAGE(PG8_SB(0, 0), cB, voffB); PG8_STAGE(PG8_SB(0, 1), cB + hstepB, voffB); PG8_STAGE(PG8_SA(0, 0), cA, voffA); PG8_STAGE(PG8_SA(0, 1), cA + hstep, voffA);
        if (wr == 1) PG8_BAR;
        PG8_WAIT_V(2); PG8_BAR;
        PG8_STAGE(PG8_SB(1, 0), cB + kstepB, voffB); PG8_STAGE(PG8_SA(1, 0), cA + kstep, voffA); PG8_STAGE(PG8_SB(1, 1), cB + hstepB + kstepB, voffB);
        PG8_WAIT_V(6); PG8_BAR;
    } else {
        PG8_STAGE(PG8_SB(0, 0), cB, voffB); PG8_STAGE(PG8_SA(0, 0), cA, voffA); PG8_STAGE(PG8_SB(0, 1), cB + hstepB, voffB); PG8_STAGE(PG8_SA(0, 1), cA + hstep, voffA);
        if (wr == 1) PG8_BAR;
        PG8_WAIT_V(4); PG8_BAR;
        PG8_STAGE(PG8_SB(1, 0), cB + kstepB, voffB); PG8_STAGE(PG8_SA(1, 0), cA + kstep, voffA); PG8_STAGE(PG8_SB(1, 1), cB + hstepB + kstepB, voffB);
        PG8_WAIT_V(6); PG8_BAR;
    }
    for (;;) {
        const bool has_next = S.next(ui + 1, nxt);
        const char* nA = has_next ? (const char*)g.A + (size_t)nxt.pm * tstep : cA; const char* nB = has_next ? (const char*)g.Bt + (size_t)nxt.pn * tstep : cB;
        for (int t = 0; t < nt; t += 2) {
            const bool last = (t == nt - 2);
            const char* a1 = cA + (size_t)(t + 1) * kstep;
            const char* a2 = last ? nA : cA + (size_t)(t + 2) * kstep; const char* b2 = last ? nB : cB + (size_t)(t + 2) * kstepB;
            const char* a3 = a2 + kstep; const char* b3 = b2 + kstepB;
            if (last && has_next) S.a_ready(nxt);
            if constexpr (SP2) {
            PG8_LDB(B0, 0, 0); PG8_LDB(B1, 0, 1); PG8_SCHED; PG8_LDA(At, 0, 0); PG8_STAGE(PG8_SA(1, 1), a1 + hstep, voffA);
            PG8_WAIT_V(8); PG8_WAIT_L(0); PG8_BAR; PG8_MMA(0, 0, At, B0); PG8_MMA(0, 1, At, B1); PG8_BAR; PG8_SCHED;
            PG8_LDA(At, 0, 1); PG8_STAGE(PG8_SB(0, 0), b2, voffB); PG8_STAGE(PG8_SB(0, 1), b2 + hstepB, voffB); PG8_STAGE(PG8_SA(0, 0), a2, voffA);
            PG8_WAIT_V(8); PG8_WAIT_L(0); PG8_BAR; PG8_MMA(1, 0, At, B0); PG8_MMA(1, 1, At, B1); PG8_BAR; PG8_SCHED;
            PG8_LDB(B0, 1, 0); PG8_LDB(B1, 1, 1); PG8_SCHED; PG8_LDA(At, 1, 0); PG8_STAGE(PG8_SA(0, 1), a2 + hstep, voffA);
            PG8_WAIT_V(8); PG8_WAIT_L(0); PG8_BAR; PG8_MMA(0, 0, At, B0); PG8_MMA(0, 1, At, B1); PG8_BAR; PG8_SCHED;
            PG8_LDA(At, 1, 1); PG8_STAGE(PG8_SB(1, 0), b3, voffB); PG8_STAGE(PG8_SB(1, 1), b3 + hstepB, voffB); PG8_STAGE(PG8_SA(1, 0), a3, voffA);
            PG8_WAIT_V(8); PG8_WAIT_L(0); PG8_BAR; PG8_MMA(1, 0, At, B0); PG8_MMA(1, 1, At, B1); PG8_BAR; PG8_SCHED;
            } else {
            PG8_LDB(B0, 0, 0); PG8_SCHED; PG8_LDA(At, 0, 0); PG8_STAGE(PG8_SA(1, 1), a1 + hstep, voffA);
            PG8_WAIT_L(8); PG8_BAR; PG8_WAIT_L(0); PG8_MMA(0, 0, At, B0); PG8_BAR; PG8_SCHED;
            PG8_LDB(B1, 0, 1); PG8_STAGE(PG8_SB(0, 0), b2, voffB);
            PG8_BAR; PG8_WAIT_L(0); PG8_MMA(0, 1, At, B1); PG8_BAR;
            PG8_LDA(At, 0, 1); PG8_STAGE(PG8_SA(0, 0), a2, voffA);
            PG8_BAR; PG8_WAIT_L(0); PG8_MMA(1, 0, At, B0); PG8_BAR; PG8_SCHED;
            PG8_STAGE(PG8_SB(0, 1), b2 + hstepB, voffB);
            PG8_WAIT_V(6); PG8_BAR; PG8_MMA(1, 1, At, B1); PG8_BAR;
            PG8_LDB(B0, 1, 0); PG8_SCHED; PG8_LDA(At, 1, 0); PG8_STAGE(PG8_SA(0, 1), a2 + hstep, voffA);
            PG8_WAIT_L(8); PG8_BAR; PG8_WAIT_L(0); PG8_MMA(0, 0, At, B0); PG8_BAR; PG8_SCHED;
            PG8_LDB(B1, 1, 1); PG8_STAGE(PG8_SB(1, 0), b3, voffB);
            PG8_BAR; PG8_WAIT_L(0); PG8_MMA(0, 1, At, B1); PG8_BAR;
            PG8_LDA(At, 1, 1); PG8_STAGE(PG8_SA(1, 0), a3, voffA);
            PG8_BAR; PG8_WAIT_L(0); PG8_MMA(1, 0, At, B0); PG8_BAR; PG8_SCHED;
            PG8_STAGE(PG8_SB(1, 1), b3 + hstepB, voffB);
            PG8_WAIT_V(6); PG8_BAR; PG8_MMA(1, 1, At, B1); PG8_BAR;
            }
        }
        if constexpr (ALIGN_EPI) { if (wr == 0) PG8_BAR; }
        if constexpr (I8 == 2) asm volatile("s_nop 15\n\ts_nop 15" ::: "memory");
        if constexpr (I8 == 1) { _Pragma("unroll") for (int a = 0; a < 2; ++a) _Pragma("unroll") for (int b = 0; b < 2; ++b) _Pragma("unroll") for (int m = 0; m < 4; ++m) _Pragma("unroll") for (int n = 0; n < 2; ++n) acc[a][b][m][n] = __builtin_convertvector(__builtin_bit_cast(i32x4, acc[a][b][m][n]), f32x4); }
        if constexpr (!Epi::AFTER_DRAIN) { E(acc, cur, wr, wc, fr, fq); S.done(cur); }
        if (!has_next) break;
#pragma unroll
        for (int a = 0; a < 2; ++a)
#pragma unroll
            for (int b = 0; b < 2; ++b)
#pragma unroll
                for (int m = 0; m < 4; ++m)
#pragma unroll
                    for (int n = 0; n < 2; ++n) acc[a][b][m][n] = (f32x4){0.f, 0.f, 0.f, 0.f};
        cur = nxt; cA = nA; cB = nB; ++ui;
        if constexpr (ALIGN_EPI) { if (wr == 1) PG8_BAR; }
    }
    PG8_WAIT_V(0);
    if constexpr (!ALIGN_EPI) { if (wr == 0) PG8_BAR; }
    PG8_BAR;
    if constexpr (Epi::AFTER_DRAIN) { E.fused(acc, cur, wr, wc, fr, fq, lds, wid, lane); S.done(cur); }
#undef PG8_SA
#undef PG8_SB
#undef PG8_STAGE
#undef PG8_LDA
#undef PG8_LDB
#undef PG8_MMA
#undef PG8_WAIT_V
#undef PG8_WAIT_L
#undef PG8_BAR
#undef PG8_SCHED
}
}
namespace att {
using bf16x8 = __attribute__((ext_vector_type(8))) short;
using s16x4  = __attribute__((ext_vector_type(4))) short;
using f32x16 = __attribute__((ext_vector_type(16))) float;
using u32x4  = __attribute__((ext_vector_type(4))) unsigned;
typedef unsigned short bf16_t;
constexpr int NW = 8, QBLK = 32, KVBLK = 64;
constexpr float THR = 8.f;
constexpr int SHM_V = 64 * 128 * 2, SHM_K = 64 * 128 * 2, SHM_ATTN = 2 * SHM_V + 2 * SHM_K + NW * 64 * 4;
#define KSWZ(row, colB) ((row) * 256 + ((colB) ^ (((row) & 7) << 4)))
#define KSWZ64(row, colB) ((row) * 128 + ((colB) ^ ((((row) >> 1) & 7) << 4)))
#define SBAR() __builtin_amdgcn_sched_barrier(0)
__device__ __forceinline__ int crow(int r, int hi) { return (r & 3) + 8 * (r >> 2) + 4 * hi; }
__device__ __forceinline__ unsigned cvtpk(float lo, float hi) { unsigned r; asm volatile("v_cvt_pk_bf16_f32 %0, %1, %2" : "=v"(r) : "v"(lo), "v"(hi)); return r; }
__device__ __forceinline__ float bf2f(unsigned short b) { return __uint_as_float((unsigned)b << 16); }
__device__ __forceinline__ bf16x8 ld8(const bf16_t* p) { return *reinterpret_cast<const bf16x8*>(p); }

template <int DQK, bool PRE = false> __device__ __forceinline__ void partialSM(f32x16& p0, f32x16& p1, float& m_reg, float& mn, float& alpha) {
  constexpr float SCALE = PRE ? 0.6931471805599453f : ((DQK == 128) ? 0.088388347648318440f : 0.125f);
  constexpr float C = SCALE * 1.4426950408889634f;
  float pmax = p0[0];
#pragma unroll
  for (int r = 1; r < 16; ++r) pmax = fmaxf(pmax, p0[r]);
#pragma unroll
  for (int r = 0; r < 16; ++r) pmax = fmaxf(pmax, p1[r]);
  { auto rr = __builtin_amdgcn_permlane32_swap(__float_as_uint(pmax), __float_as_uint(pmax), false, false);
    pmax = fmaxf(__uint_as_float(rr[0]), __uint_as_float(rr[1])); }
  if (__builtin_expect(__all(pmax - m_reg <= THR / SCALE), 1)) { mn = m_reg; alpha = 1.f; }
  else { mn = fmaxf(m_reg, pmax); alpha = __builtin_amdgcn_exp2f((m_reg - mn) * C); m_reg = mn; }
  float mnC = -mn * C;
#pragma unroll
  for (int r = 0; r < 16; ++r) p0[r] = fmaf(p0[r], C, mnC);
#pragma unroll
  for (int r = 0; r < 16; ++r) p1[r] = fmaf(p1[r], C, mnC);
#pragma unroll
  for (int r = 0; r < 16; ++r) p0[r] = __builtin_amdgcn_exp2f(p0[r]);
}
#define PK4(P, BASE, OUT) do { unsigned a0 = cvtpk(P[BASE + 0], P[BASE + 1]), a1 = cvtpk(P[BASE + 2], P[BASE + 3]);   \
    unsigned b0 = cvtpk(P[BASE + 4], P[BASE + 5]), b1 = cvtpk(P[BASE + 6], P[BASE + 7]);                              \
    auto r0 = __builtin_amdgcn_permlane32_swap(a0, b0, false, false); auto r1 = __builtin_amdgcn_permlane32_swap(a1, b1, false, false); \
    u32x4 w = {r0[0], r1[0], r0[1], r1[1]}; OUT = *reinterpret_cast<bf16x8*>(&w); } while (0)
__device__ __forceinline__ void finishSM(f32x16& p0, f32x16& p1, float alpha, float& l_reg, bf16x8& pa0, bf16x8& pa1, bf16x8& pa2, bf16x8& pa3) {
#pragma unroll
  for (int r = 0; r < 16; ++r) p1[r] = __builtin_amdgcn_exp2f(p1[r]);
  float ps = 0;
#pragma unroll
  for (int r = 0; r < 16; ++r) ps += p0[r];
#pragma unroll
  for (int r = 0; r < 16; ++r) ps += p1[r];
  { auto rr = __builtin_amdgcn_permlane32_swap(__float_as_uint(ps), __float_as_uint(ps), false, false);
    ps = __uint_as_float(rr[0]) + __uint_as_float(rr[1]); }
  l_reg = l_reg * alpha + ps;
  PK4(p0, 0, pa0); PK4(p0, 8, pa1); PK4(p1, 0, pa2); PK4(p1, 8, pa3);
}
template <int DQK> __device__ __forceinline__ void qkt(f32x16& p0, f32x16& p1, const char* Ks, const bf16x8* qr, int r32, int hi) {
  constexpr int ND = DQK / 16;
  p0 = f32x16{}; p1 = f32x16{};
  bf16x8 b0[2], b1[2];
#define QK_RD(d0, s) do { const int cb_ = ((d0) * 16 + hi * 8) * 2; \
    if constexpr (DQK == 128) { b0[s] = *reinterpret_cast<const bf16x8*>(Ks + KSWZ(r32, cb_)); b1[s] = *reinterpret_cast<const bf16x8*>(Ks + KSWZ(32 + r32, cb_)); } \
    else { b0[s] = *reinterpret_cast<const bf16x8*>(Ks + KSWZ64(r32, cb_)); b1[s] = *reinterpret_cast<const bf16x8*>(Ks + KSWZ64(32 + r32, cb_)); } } while (0)
  QK_RD(0, 0); QK_RD(1, 1); SBAR();
#pragma unroll
  for (int d0 = 0; d0 < ND; ++d0) {
    p0 = __builtin_amdgcn_mfma_f32_32x32x16_bf16(b0[d0 & 1], qr[d0], p0, 0, 0, 0);
    p1 = __builtin_amdgcn_mfma_f32_32x32x16_bf16(b1[d0 & 1], qr[d0], p1, 0, 0, 0);
    if (d0 + 2 < ND) { QK_RD(d0 + 2, d0 & 1); }
    SBAR();
  }
#undef QK_RD
}
__device__ __forceinline__ int v_st(int k, int c) { const int kk = (k & ~0xC) | ((k & 4) << 1) | ((k & 8) >> 1); return ((kk >> 3) * 4 + (c >> 5)) * 512 + ((kk & 7) * 32 + (c & 31)) * 2; }
__device__ __forceinline__ int v_rd_base(int lane) { return ((lane & 3) << 3) | (((lane >> 2) & 3) << 6) | (((lane >> 4) & 1) << 5) | (((lane >> 5) & 1) << 8); }
constexpr int v_rd_off(int d0, int ks, int half) { return d0 * 512 + ks * 4096 + half * 2048; }
template <int OFF> __device__ __forceinline__ s16x4 tr_read(int vb) {
  s16x4 r; asm volatile("ds_read_b64_tr_b16 %0, %1 offset:%2" : "=&v"(r) : "v"(vb), "i"(OFF) : "memory"); return r;
}
#define PKF(L, H) (bf16x8){L[0], L[1], L[2], L[3], H[0], H[1], H[2], H[3]}
template <int D0> __device__ __forceinline__ void pv_one(f32x16& od, int vb, bf16x8 pa0, bf16x8 pa1, bf16x8 pa2, bf16x8 pa3) {
  const s16x4 l0 = tr_read<v_rd_off(D0, 0, 0)>(vb), h0 = tr_read<v_rd_off(D0, 0, 1)>(vb), l1 = tr_read<v_rd_off(D0, 1, 0)>(vb), h1 = tr_read<v_rd_off(D0, 1, 1)>(vb);
  const s16x4 l2 = tr_read<v_rd_off(D0, 2, 0)>(vb), h2 = tr_read<v_rd_off(D0, 2, 1)>(vb), l3 = tr_read<v_rd_off(D0, 3, 0)>(vb), h3 = tr_read<v_rd_off(D0, 3, 1)>(vb);
  asm volatile("s_waitcnt lgkmcnt(0)" ::: "memory"); SBAR();
  od = __builtin_amdgcn_mfma_f32_32x32x16_bf16(pa0, PKF(l0, h0), od, 0, 0, 0);
  od = __builtin_amdgcn_mfma_f32_32x32x16_bf16(pa1, PKF(l1, h1), od, 0, 0, 0);
  od = __builtin_amdgcn_mfma_f32_32x32x16_bf16(pa2, PKF(l2, h2), od, 0, 0, 0);
  od = __builtin_amdgcn_mfma_f32_32x32x16_bf16(pa3, PKF(l3, h3), od, 0, 0, 0);
}
#define PV_RD(D0, L, H) do { L[0] = tr_read<v_rd_off(D0, 0, 0)>(vb); H[0] = tr_read<v_rd_off(D0, 0, 1)>(vb); L[1] = tr_read<v_rd_off(D0, 1, 0)>(vb); H[1] = tr_read<v_rd_off(D0, 1, 1)>(vb); \
    L[2] = tr_read<v_rd_off(D0, 2, 0)>(vb); H[2] = tr_read<v_rd_off(D0, 2, 1)>(vb); L[3] = tr_read<v_rd_off(D0, 3, 0)>(vb); H[3] = tr_read<v_rd_off(D0, 3, 1)>(vb); } while (0)
#define PV_MM(OD, L, H) do { OD = __builtin_amdgcn_mfma_f32_32x32x16_bf16(pa0, PKF(L[0], H[0]), OD, 0, 0, 0); OD = __builtin_amdgcn_mfma_f32_32x32x16_bf16(pa1, PKF(L[1], H[1]), OD, 0, 0, 0); \
    OD = __builtin_amdgcn_mfma_f32_32x32x16_bf16(pa2, PKF(L[2], H[2]), OD, 0, 0, 0); OD = __builtin_amdgcn_mfma_f32_32x32x16_bf16(pa3, PKF(L[3], H[3]), OD, 0, 0, 0); } while (0)
__device__ __forceinline__ void pv_d0(f32x16* o, int vb, bf16x8 pa0, bf16x8 pa1, bf16x8 pa2, bf16x8 pa3) {
  s16x4 la[4], ha[4], lb[4], hb[4];
  PV_RD(0, la, ha); PV_RD(1, lb, hb);
  asm volatile("s_waitcnt lgkmcnt(8)" ::: "memory"); SBAR(); PV_MM(o[0], la, ha); SBAR();
  PV_RD(2, la, ha);
  asm volatile("s_waitcnt lgkmcnt(8)" ::: "memory"); SBAR(); PV_MM(o[1], lb, hb); SBAR();
  PV_RD(3, lb, hb);
  asm volatile("s_waitcnt lgkmcnt(8)" ::: "memory"); SBAR(); PV_MM(o[2], la, ha); SBAR();
  asm volatile("s_waitcnt lgkmcnt(0)" ::: "memory"); SBAR(); PV_MM(o[3], lb, hb);
}
#undef PV_RD
#undef PV_MM
__device__ __forceinline__ float half_sum32(float x) {
  x += __shfl_xor(x, 1); x += __shfl_xor(x, 2); x += __shfl_xor(x, 4); x += __shfl_xor(x, 8); x += __shfl_xor(x, 16); return x;
}

struct KVSrc { const bf16_t* K1; const bf16_t* V1; int n1; const bf16_t* K2; const bf16_t* V2; int n2; };
struct AttnOut { bf16_t* Ob; float* Of; const float* nw; float lam, post; int pass; };
template <int DQK, int MODE, int LD2, int SM = 0>
__device__ __forceinline__ void attn_body(const bf16_t* __restrict__ Qb, const KVSrc kv, const AttnOut ao, char* lds) {
  constexpr long ldq = 5120, LD1 = 5120; constexpr int LDO = 2048, LDF = 512;
  int tid_ = threadIdx.x; asm volatile("" : "+v"(tid_));
  const int tid = tid_, wid = tid >> 6, lane = tid & 63, r32 = lane & 31, hi = lane >> 5;
  char* V_lds = lds; char* K_lds = lds + 2 * SHM_V;
  float* ws = (float*)(lds + 2 * SHM_V + 2 * SHM_K) + wid * 64; float* li_l = ws; float* al_l = ws + 32;
  float m_reg = -1e30f, l_reg = 0; f32x16 o[4] = {}; bf16x8 qr[DQK / 16];
  const bf16_t* Qw = Qb + (long)(wid * QBLK + r32) * ldq + hi * 8;
#pragma unroll
  for (int d0 = 0; d0 < DQK / 16; ++d0) qr[d0] = ld8(Qw + d0 * 16);
  const int sr = tid >> 4, sc = (tid & 15) * 8, vst0 = v_st(sr, sc), vst1 = v_st(32 + sr, sc);
  const int kr64 = tid >> 3, kc64 = (tid & 7) * 8;
  const int vb0 = (int)(uintptr_t)V_lds + v_rd_base(lane);
  struct { bf16x8 vs0, vs1, ks0, ks1; } sr_[2];
#define SLOAD(i, k0) do { const int k0_ = (k0); const bool s1_ = k0_ < kv.n1; const bf16_t* kp_ = s1_ ? kv.K1 + (long)k0_ * LD1 : kv.K2 + (long)(k0_ - kv.n1) * LD2; \
    const bf16_t* vp_ = s1_ ? kv.V1 + (long)k0_ * LD1 : kv.V2 + (long)(k0_ - kv.n1) * LD2; const long ld_ = s1_ ? LD1 : (long)LD2; \
    sr_[i].vs0 = ld8(vp_ + (long)sr * ld_ + sc); sr_[i].vs1 = ld8(vp_ + (long)(32 + sr) * ld_ + sc); \
    if constexpr (DQK == 128) { sr_[i].ks0 = ld8(kp_ + (long)sr * ld_ + sc); sr_[i].ks1 = ld8(kp_ + (long)(32 + sr) * ld_ + sc); } \
    else { sr_[i].ks0 = ld8(kp_ + (long)kr64 * ld_ + kc64); } } while (0)
#define SWRITE(b, i) do { *(bf16x8*)(V_lds + (b) * SHM_V + vst0) = sr_[i].vs0; *(bf16x8*)(V_lds + (b) * SHM_V + vst1) = sr_[i].vs1; \
    if constexpr (DQK == 128) { const int kc = sc * 2; *(bf16x8*)(K_lds + (b) * SHM_K + KSWZ(sr, kc)) = sr_[i].ks0; *(bf16x8*)(K_lds + (b) * SHM_K + KSWZ(32 + sr, kc)) = sr_[i].ks1; } \
    else { *(bf16x8*)(K_lds + (b) * SHM_K + KSWZ64(kr64, kc64 * 2)) = sr_[i].ks0; } } while (0)
#define SWAIT() do { if constexpr (DQK == 128) asm volatile("s_waitcnt vmcnt(4)" ::: "memory"); else asm volatile("s_waitcnt vmcnt(3)" ::: "memory"); } while (0)
#define RESC(a) do { if (SM != 1 && __any((a) < 1.f)) { if (hi == 0) al_l[r32] = (a); asm volatile("s_waitcnt lgkmcnt(0)" ::: "memory"); \
    _Pragma("unroll") for (int d = 0; d < 4; ++d) _Pragma("unroll") for (int r = 0; r < 16; ++r) o[d][r] *= al_l[crow(r, hi)]; } } while (0)
  f32x16 pA0, pA1, pB0, pB1; float mnA = 0.f, mnB = 0.f, alA = 1.f, alB = 1.f; bf16x8 pa0, pa1, pa2, pa3; const int NT = (kv.n1 + kv.n2) / KVBLK; (void)mnA; (void)mnB;
#define PSM(P0, P1, MN, AL) do { if constexpr (SM == 1) { _Pragma("unroll") for (int r_ = 0; r_ < 16; ++r_) P0[r_] = __builtin_amdgcn_exp2f(P0[r_]); } else partialSM<DQK, SM == 2>(P0, P1, m_reg, MN, AL); } while (0)
  constexpr int SE = 0, SO = 1;
  SLOAD(SE, 0); asm volatile("s_waitcnt vmcnt(0)" ::: "memory"); SWRITE(0, SE); __syncthreads();
  qkt<DQK>(pA0, pA1, K_lds, qr, r32, hi); PSM(pA0, pA1, mnA, alA);
  SLOAD(SO, KVBLK); if (2 < NT) SLOAD(SE, 2 * KVBLK);
  SWAIT(); SWRITE(1, SO); __syncthreads();
  for (int j = 1; j + 1 < NT; j += 2) {
    SBAR(); qkt<DQK>(pB0, pB1, K_lds + SHM_K, qr, r32, hi);
    finishSM(pA0, pA1, alA, l_reg, pa0, pa1, pa2, pa3); SBAR();
    SLOAD(SO, (j + 2) * KVBLK); SBAR();
    pv_d0(o, vb0, pa0, pa1, pa2, pa3); PSM(pB0, pB1, mnB, alB);
    __syncthreads(); SWAIT(); SWRITE(0, SE);
    RESC(alB); __syncthreads();
    SBAR(); qkt<DQK>(pA0, pA1, K_lds, qr, r32, hi);
    finishSM(pB0, pB1, alB, l_reg, pa0, pa1, pa2, pa3); SBAR();
    if (j + 3 < NT) SLOAD(SE, (j + 3) * KVBLK); SBAR();
    pv_d0(o, vb0 + (int)SHM_V, pa0, pa1, pa2, pa3); PSM(pA0, pA1, mnA, alA);
    __syncthreads(); SWAIT(); SWRITE(1, SO);
    RESC(alA); __syncthreads();
  }
  SBAR(); qkt<DQK>(pB0, pB1, K_lds + SHM_K, qr, r32, hi);
  finishSM(pA0, pA1, alA, l_reg, pa0, pa1, pa2, pa3); SBAR();
  pv_d0(o, vb0, pa0, pa1, pa2, pa3); PSM(pB0, pB1, mnB, alB);
  __syncthreads(); RESC(alB);
  finishSM(pB0, pB1, alB, l_reg, pa0, pa1, pa2, pa3); SBAR();
  pv_d0(o, vb0 + (int)SHM_V, pa0, pa1, pa2, pa3);
  if (hi == 0) li_l[r32] = l_reg; asm volatile("s_waitcnt lgkmcnt(0)" ::: "memory");
  float rli[16];
#pragma unroll
  for (int r = 0; r < 16; ++r) rli[r] = __builtin_amdgcn_rcpf(li_l[crow(r, hi)]);
  bf16_t* stg = (bf16_t*)lds + wid * (QBLK * 128);
#define O_FLUSH(Ow) do { asm volatile("s_waitcnt lgkmcnt(0)" ::: "memory"); _Pragma("unroll") for (int i_ = 0; i_ < 8; ++i_) { const int row_ = i_ * 4 + (lane >> 4), ch_ = lane & 15; \
    const u32x4 v_ = *(const u32x4*)(stg + row_ * 128 + ch_ * 8); *(u32x4*)((Ow) + (long)row_ * LDO + ch_ * 8) = v_; } } while (0)
  if constexpr (MODE == 0) {
    bf16_t* Ow = ao.Ob + (long)(wid * QBLK) * LDO;
    __syncthreads();
#pragma unroll
    for (int r = 0; r < 16; ++r) { const int orow = crow(r, hi);
#pragma unroll
      for (int d0 = 0; d0 < 4; ++d0) { const float v = o[d0][r] * rli[r]; stg[orow * 128 + d0 * 32 + r32] = (bf16_t)(cvtpk(v, v) & 0xffffu); } }
    O_FLUSH(Ow);
  } else {
    float* Fw = ao.Of + (long)(wid * QBLK) * LDF;
    if (ao.pass == 0) {
#pragma unroll
      for (int r = 0; r < 16; ++r) { const int orow = crow(r, hi);
#pragma unroll
        for (int d0 = 0; d0 < 4; ++d0) Fw[(long)orow * LDF + d0 * 32 + r32] = o[d0][r] * rli[r]; }
    } else {
      bf16_t* Ow = ao.Ob + (long)(wid * QBLK) * LDO;
      __syncthreads();
#pragma unroll
      for (int r = 0; r < 16; ++r) { const int orow = crow(r, hi); float v[4]; float ss = 0.f;
#pragma unroll
        for (int d0 = 0; d0 < 4; ++d0) { v[d0] = Fw[(long)orow * LDF + d0 * 32 + r32] - ao.lam * (o[d0][r] * rli[r]); ss += v[d0] * v[d0]; }
        ss = half_sum32(ss); const float rs = rsqrtf(ss * (1.0f / 128.0f) + 1e-6f) * ao.post;
#pragma unroll
        for (int d0 = 0; d0 < 4; ++d0) { const float y = v[d0] * rs * ao.nw[d0 * 32 + r32]; stg[orow * 128 + d0 * 32 + r32] = (bf16_t)(cvtpk(y, y) & 0xffffu); } }
      O_FLUSH(Ow);
    }
  }
#undef O_FLUSH
#undef SLOAD
#undef SWRITE
#undef SWAIT
#undef RESC
#undef PSM
}
struct ChainArgs { const bf16_t* P;   int kcol, vcol; int nchunk; int dir; float lg2;
                   const float* S0;   bf16_t* ST;   float* Sfin;   };
__device__ __forceinline__ void ret_chain(const ChainArgs a, char* lds) {
  int tid_ = threadIdx.x; asm volatile("" : "+v"(tid_));
  const int tid = tid_, wid = tid >> 6, lane = tid & 63, r32 = lane & 31, hi = lane >> 5;
  const int eb = wid >> 1, dh = wid & 1;
  char* V_lds = lds; char* K_lds = lds + 2 * SHM_V;
  const int sr = tid >> 4, sc = (tid & 15) * 8;
  f32x16 acc[2];
#pragma unroll
  for (int j = 0; j < 2; ++j)
#pragma unroll
    for (int r = 0; r < 16; ++r) acc[j][r] = 0.f;
  if (a.S0) {
#pragma unroll
    for (int j = 0; j < 2; ++j)
#pragma unroll
      for (int r = 0; r < 16; ++r) acc[j][r] = a.S0[(size_t)(32 * (2 * dh + j) + r32) * 128 + 32 * eb + crow(r, hi)]; }
  const float gC = __builtin_amdgcn_exp2f(128.f * a.lg2);
  const int vbA = (int)(uintptr_t)V_lds + v_rd_base(lane) + eb * 512, vbB = (int)(uintptr_t)K_lds + v_rd_base(lane) + (2 * dh) * 512;
  bf16x8 kq[4], vq[4];
  { const int c0 = a.dir == 0 ? 0 : a.nchunk - 1; const bf16_t* rowp = a.P + (size_t)(c0 * 128) * 5120;
#pragma unroll
    for (int q = 0; q < 4; ++q) { const int k = 32 * q + sr; kq[q] = ld8(rowp + (size_t)k * 5120 + a.kcol + sc); vq[q] = ld8(rowp + (size_t)k * 5120 + a.vcol + sc); } }
  for (int s = 0; s < a.nchunk; ++s) {
    const int c = a.dir == 0 ? s : a.nchunk - 1 - s;
    bf16_t* st = a.ST + (size_t)c * 16384;
    __syncthreads();
#pragma unroll
    for (int q = 0; q < 4; ++q) { const int k = 32 * q + sr;
      const bf16x8 kv_ = kq[q], vv_ = vq[q];
      const float f = 0.088388347648318440f * __builtin_amdgcn_exp2f((a.dir == 0 ? (float)(127 - k) : (float)k) * a.lg2);
      u32x4 w; w.x = cvtpk(bf2f((unsigned short)kv_[0]) * f, bf2f((unsigned short)kv_[1]) * f); w.y = cvtpk(bf2f((unsigned short)kv_[2]) * f, bf2f((unsigned short)kv_[3]) * f);
      w.z = cvtpk(bf2f((unsigned short)kv_[4]) * f, bf2f((unsigned short)kv_[5]) * f); w.w = cvtpk(bf2f((unsigned short)kv_[6]) * f, bf2f((unsigned short)kv_[7]) * f);
      const int off = (q >> 1) * SHM_V + v_st(32 * (q & 1) + sr, sc);
      *(u32x4*)(K_lds + off) = w; *(bf16x8*)(V_lds + off) = vv_; }
    __syncthreads();
#pragma unroll
    for (int j = 0; j < 2; ++j)
#pragma unroll
      for (int r = 0; r < 16; ++r) { const float v = acc[j][r]; st[(32 * eb + crow(r, hi)) * 128 + 32 * (2 * dh + j) + r32] = (bf16_t)(cvtpk(v, v) & 0xffffu); }
    if (s + 1 < a.nchunk) { const int cn = a.dir == 0 ? s + 1 : a.nchunk - 2 - s; const bf16_t* rowp = a.P + (size_t)(cn * 128) * 5120;
#pragma unroll
      for (int q = 0; q < 4; ++q) { const int k = 32 * q + sr; kq[q] = ld8(rowp + (size_t)k * 5120 + a.kcol + sc); vq[q] = ld8(rowp + (size_t)k * 5120 + a.vcol + sc); } }
#pragma unroll
    for (int j = 0; j < 2; ++j)
#pragma unroll
      for (int r = 0; r < 16; ++r) acc[j][r] *= gC;
#pragma unroll
    for (int tt = 0; tt < 2; ++tt) {
      s16x4 al[4], ah[4], b0l[4], b0h[4], b1l[4], b1h[4];
#define RD4(ks) do { al[ks] = tr_read<v_rd_off(0, ks, 0)>(vbA + tt * SHM_V); ah[ks] = tr_read<v_rd_off(0, ks, 1)>(vbA + tt * SHM_V); \
      b0l[ks] = tr_read<v_rd_off(0, ks, 0)>(vbB + tt * SHM_V); b0h[ks] = tr_read<v_rd_off(0, ks, 1)>(vbB + tt * SHM_V); \
      b1l[ks] = tr_read<v_rd_off(1, ks, 0)>(vbB + tt * SHM_V); b1h[ks] = tr_read<v_rd_off(1, ks, 1)>(vbB + tt * SHM_V); } while (0)
      RD4(0); RD4(1); RD4(2); RD4(3);
#undef RD4
      asm volatile("s_waitcnt lgkmcnt(0)" ::: "memory"); SBAR();
#pragma unroll
      for (int ks = 0; ks < 4; ++ks) {
        acc[0] = __builtin_amdgcn_mfma_f32_32x32x16_bf16(PKF(al[ks], ah[ks]), PKF(b0l[ks], b0h[ks]), acc[0], 0, 0, 0);
        acc[1] = __builtin_amdgcn_mfma_f32_32x32x16_bf16(PKF(al[ks], ah[ks]), PKF(b1l[ks], b1h[ks]), acc[1], 0, 0, 0); }
    }
  }
  if (a.Sfin) {
#pragma unroll
    for (int j = 0; j < 2; ++j)
#pragma unroll
      for (int r = 0; r < 16; ++r) a.Sfin[(size_t)(32 * (2 * dh + j) + r32) * 128 + 32 * eb + crow(r, hi)] = acc[j][r];
  }
}
struct RetCArgs { const bf16_t* P;   int qcol, kcol, vcol, gcol; float lg2f, lg2b; const bf16_t* STf; const bf16_t* STb;
                  const float* gnw; bf16_t* O;   };
__device__ __forceinline__ void ret_c(const RetCArgs a, char* lds) {
  int tid_ = threadIdx.x; asm volatile("" : "+v"(tid_));
  const int tid = tid_, wid = tid >> 6, lane = tid & 63, r32 = lane & 31, hi = lane >> 5;
  char* V_lds = lds; char* K_lds = lds + 2 * SHM_V;
  const int cw = wid >> 2, ipos = 32 * (wid & 3) + r32;
  const int sr = tid >> 4, sc = (tid & 15) * 8;
  const int vb0 = (int)(uintptr_t)V_lds + v_rd_base(lane);
  bf16x8 qr[8];
  const bf16_t* Qw = a.P + (size_t)(wid * 32 + r32) * 5120 + a.qcol + hi * 8;
#pragma unroll
  for (int d0 = 0; d0 < 8; ++d0) qr[d0] = ld8(Qw + d0 * 16);
  f32x16 o[4] = {};
  for (int ch = 0; ch < 2; ++ch) {
    const bf16_t* rowp = a.P + (size_t)(ch * 128) * 5120;
    __syncthreads();
#pragma unroll
    for (int q = 0; q < 4; ++q) { const int k = 32 * q + sr;
      const bf16x8 kv_ = ld8(rowp + (size_t)k * 5120 + a.kcol + sc), vv_ = ld8(rowp + (size_t)k * 5120 + a.vcol + sc);
      *(bf16x8*)(K_lds + (q >> 1) * SHM_K + KSWZ(32 * (q & 1) + sr, sc * 2)) = kv_;
      *(bf16x8*)(V_lds + (q >> 1) * SHM_V + v_st(32 * (q & 1) + sr, sc)) = vv_; }
    __syncthreads();
    if (cw == ch) {
#pragma unroll
      for (int tt = 0; tt < 2; ++tt) {
        f32x16 p0, p1; qkt<128>(p0, p1, K_lds + tt * SHM_K, qr, r32, hi);
        int ip_ = ipos, hi_ = hi; asm volatile("" : "+v"(ip_), "+v"(hi_));
#pragma unroll
        for (int r = 0; r < 16; ++r) {
          const int j0 = 64 * tt + crow(r, hi_), d0_ = ip_ - j0, d1_ = d0_ - 32;
          const float f0 = d0_ > 0 ? __builtin_amdgcn_exp2f((float)d0_ * a.lg2f) : (d0_ < 0 ? __builtin_amdgcn_exp2f((float)(-d0_) * a.lg2b) : 2.0f);
          const float f1 = d1_ > 0 ? __builtin_amdgcn_exp2f((float)d1_ * a.lg2f) : (d1_ < 0 ? __builtin_amdgcn_exp2f((float)(-d1_) * a.lg2b) : 2.0f);
          p0[r] *= f0 * 0.088388347648318440f; p1[r] *= f1 * 0.088388347648318440f; }
        bf16x8 pa0, pa1, pa2, pa3; PK4(p0, 0, pa0); PK4(p0, 8, pa1); PK4(p1, 0, pa2); PK4(p1, 8, pa3);
        pv_d0(o, vb0 + tt * SHM_V, pa0, pa1, pa2, pa3);
      }
    }
  }
#pragma unroll
  for (int dir = 0; dir < 2; ++dir) {
    const float rs = dir == 0 ? __builtin_amdgcn_exp2f((float)(ipos + 1) * a.lg2f) : __builtin_amdgcn_exp2f((float)(128 - ipos) * a.lg2b);
    const bf16_t* S = (dir == 0 ? a.STf : a.STb) + (size_t)cw * 16384 + (size_t)r32 * 128 + hi * 8;
#pragma unroll
    for (int d0 = 0; d0 < 8; ++d0) {
      const bf16x8 q_ = qr[d0]; u32x4 w;
      w.x = cvtpk(bf2f((unsigned short)q_[0]) * rs, bf2f((unsigned short)q_[1]) * rs); w.y = cvtpk(bf2f((unsigned short)q_[2]) * rs, bf2f((unsigned short)q_[3]) * rs);
      w.z = cvtpk(bf2f((unsigned short)q_[4]) * rs, bf2f((unsigned short)q_[5]) * rs); w.w = cvtpk(bf2f((unsigned short)q_[6]) * rs, bf2f((unsigned short)q_[7]) * rs);
      const bf16x8 qs = *reinterpret_cast<bf16x8*>(&w);
#pragma unroll
      for (int eb = 0; eb < 4; ++eb) { const bf16x8 b = ld8(S + (size_t)eb * 32 * 128 + d0 * 16); o[eb] = __builtin_amdgcn_mfma_f32_32x32x16_bf16(qs, b, o[eb], 0, 0, 0); }
    }
  }
#pragma unroll
  for (int r = 0; r < 16; ++r) {
    const int row = wid * 32 + crow(r, hi);
    float s = (o[0][r] + o[1][r]) + (o[2][r] + o[3][r]); s = half_sum32(s); const float mean = s * (1.0f / 128.0f);
    float q = 0.f;
#pragma unroll
    for (int eb = 0; eb < 4; ++eb) { const float d = o[eb][r] - mean; q += d * d; }
    q = half_sum32(q); const float rstd = rsqrtf(q * (1.0f / 128.0f) + 1e-6f);
#pragma unroll
    for (int eb = 0; eb < 4; ++eb) { const int col = eb * 32 + r32;
      const float g = bf2f(a.P[(size_t)row * 5120 + a.gcol + col]);
      const float y = (o[eb][r] - mean) * rstd * a.gnw[col] * (g * __builtin_amdgcn_rcpf(1.0f + __builtin_amdgcn_exp2f(-1.4426950408889634f * g)));
      a.O[(size_t)row * 2048 + col] = (bf16_t)(cvtpk(y, y) & 0xffffu); }
  }
}
#undef KSWZ
#undef KSWZ64
#undef SBAR
#undef PK4
#undef PKF
}
constexpr int DM = 2048, M_P = 4096, M_S = 32768, MTOK = M_P + M_S, DFF = 5632, NFF = 11264, NIN = 5120, NMODC = 18432, NCOND = 9;
constexpr int C_RQ = 0, C_RK = 512, C_RV = 1024, C_RG = 1536, C_GQ = 2048, C_GK = 3072, C_GV = 3328, C_DQ = 3584, C_DK = 4096, C_DV = 4608;
constexpr float EPS = 1e-6f;
constexpr size_t MiB = 1u << 20;
constexpr size_t WS_CTL = 0, CTL_ZERO_BYTES = 1 * MiB;
constexpr size_t WS_TAB = 1 * MiB;
constexpr size_t WS_CACHE = 4 * MiB;
constexpr size_t WS_W = 16 * MiB;
constexpr size_t W_LAYER = 160 * MiB, W_WI = 0, W_WO = 88 * MiB, W_WIN = 132 * MiB, W_WOUT = 152 * MiB;
constexpr size_t WS_XN = WS_W + 2 * W_LAYER;
constexpr size_t WS_ACT = WS_XN + 144 * MiB;
constexpr size_t WS_ST = WS_ACT + 396 * MiB;
constexpr size_t WS_DF = WS_ST + 72 * MiB;
constexpr size_t WS_XNB = WS_DF + 72 * MiB;
constexpr size_t WS_SB = WS_XNB + 144 * MiB;
constexpr size_t SB_LAYER = 9 * (11264 + 5120 + 11264), SB_J1 = 9 * 11264, SB_J2 = 9 * (11264 + 5120);
constexpr size_t WS_RS = WS_SB + 2 * MiB;
constexpr size_t WS_Q = WS_RS + 2 * MiB;
constexpr size_t Q_SW = 256 * 1024, Q_SW2 = 512 * 1024, Q_SW4 = 832 * 1024, Q_ACT = 960 * 1024  , W_WINQ = 22 * MiB;
constexpr size_t WS_A8B = WS_Q + 1 * MiB;
constexpr size_t WS_END = WS_A8B + 198 * MiB;
constexpr int TB_MOD = 0, TB_COSG = 2 * 9 * 18432, TB_SING = TB_COSG + 64 * 32, TB_COSD = TB_SING + 64 * 32, TB_SIND = TB_COSD + 64 * 16, TB_SCAL = TB_SIND + 64 * 16;
constexpr int CW_BAR = 4096;
constexpr size_t CTL_RAW2 = 960 * 1024;
constexpr size_t CTL_AMAX = 64 * 1024;
constexpr size_t O_X = 0, O_STATE = 75497472, O_GK = 79691776, O_GV = 81788928, O_DK = 83886080, O_DV = 88080384, O_END = 92274688;
constexpr int LDS_BYTES = 147456, MISC_OFF = 131072 + 320;

typedef att::bf16_t bf16;
#define GAS __attribute__((address_space(1)))
#define LAS __attribute__((address_space(3)))
typedef unsigned v4u __attribute__((ext_vector_type(4)));
typedef float f32x4 __attribute__((ext_vector_type(4)));
typedef short bf16x8 __attribute__((ext_vector_type(8)));
typedef GAS unsigned gu32;
typedef GAS unsigned long long gu64;
#define RLX_AGENT __ATOMIC_RELAXED, __HIP_MEMORY_SCOPE_AGENT
#define LDS_WAIT() asm volatile("s_waitcnt lgkmcnt(0)" ::: "memory")
#define VM_WAIT() asm volatile("s_waitcnt vmcnt(0)" ::: "memory")
__device__ __forceinline__ unsigned long long rt() { return __builtin_amdgcn_s_memrealtime(); }
__device__ __forceinline__ unsigned f2bf(float f) { unsigned u = __builtin_bit_cast(unsigned, f); return (u + 0x7fffu + ((u >> 16) & 1u)) >> 16; }
__device__ __forceinline__ unsigned pk2(float lo, float hi) { return f2bf(lo) | (f2bf(hi) << 16); }
#define XB_TMO      128
#define XB_XCNT(j)  (256  + 64 * (j))
#define XB_XSUB(j)  (1280 + 64 * (j))
#define XB_XGEN(j)  (2304 + 64 * (j))
#define XB_TOP      3328
#define XB_TOPGEN   3392
#define XCD_BAR_WORDS 3456
#define XB_SPIN_CAP (1u << 18)

__device__ __forceinline__ unsigned xb_ld(unsigned* p)              { return __hip_atomic_load(p, __ATOMIC_RELAXED, __HIP_MEMORY_SCOPE_AGENT); }
__device__ __forceinline__ unsigned xb_add(unsigned* p, unsigned v) { return __hip_atomic_fetch_add(p, v, __ATOMIC_RELAXED, __HIP_MEMORY_SCOPE_AGENT); }
__device__ __forceinline__ unsigned xb_xcc_id() { return (unsigned)__builtin_amdgcn_s_getreg((3 << 11) | 20) & 0xFu; }
#define XB_SPIN(cond, bar) do { unsigned _sp = 0; while (cond) { __builtin_amdgcn_s_sleep(1); \
    if ((++_sp & 255u) == 0u) { if (xb_ld(&(bar)[XB_TMO])) break; if (_sp > XB_SPIN_CAP) { atomicAdd(&(bar)[XB_TMO], 1u); break; } } } } while (0)

struct XcdBarrier {
    unsigned* bar; unsigned x;
    volatile LAS unsigned* st;
};

__device__ __forceinline__ XcdBarrier xcd_barrier_post(unsigned* bar, volatile LAS unsigned* st) {
    XcdBarrier b; b.bar = bar; b.x = xb_xcc_id(); b.st = st;
    if (threadIdx.x == 0) (void)xb_add(&bar[XB_XCNT(b.x)], 1u);
    return b;
}
__device__ __forceinline__ void xcd_barrier_complete(unsigned* bar, unsigned x, unsigned& nloc, unsigned& nx) {
    const unsigned G = gridDim.x * gridDim.y * gridDim.z;
    unsigned sum, cnt, mine, sp = 0u;
    for (;;) {
        sum = 0u; cnt = 0u; mine = 0u;
#pragma unroll
        for (unsigned j = 0; j < 16; ++j) { const unsigned c = xb_ld(&bar[XB_XCNT(j)]); sum += c; cnt += (c > 0u) ? 1u : 0u; mine = (j == x) ? c : mine; }
        if (sum == G) break;
        __builtin_amdgcn_s_sleep(1);
        if ((++sp & 255u) == 0u) { if (xb_ld(&bar[XB_TMO])) break; if (sp > XB_SPIN_CAP) { atomicAdd(&bar[XB_TMO], 1u); break; } }
    }
    nloc = mine > 0u ? mine : 1u; nx = cnt > 0u ? cnt : 1u;
}

__device__ __forceinline__ void xcd_barrier(const XcdBarrier& b) {
    asm volatile("s_waitcnt vmcnt(0)" ::: "memory");
    __syncthreads();
    if (threadIdx.x == 0) {
        unsigned* bar = b.bar;
        __builtin_amdgcn_s_waitcnt(0);
        unsigned nloc = b.st[0], nx = b.st[1];
        if (nloc == 0u) { xcd_barrier_complete(bar, b.x, nloc, nx); b.st[0] = nloc; b.st[1] = nx; }
        const unsigned old = xb_add(&bar[XB_XSUB(b.x)], 1u);
        const unsigned gen = old / nloc;
        if (old + 1u == (gen + 1u) * nloc) {
            __builtin_amdgcn_fence(__ATOMIC_RELEASE, "agent");
            asm volatile("s_waitcnt vmcnt(0)" ::: "memory");
            const unsigned og = xb_add(&bar[XB_TOP], 1u);
            const unsigned tg = og / nx;
            if (og + 1u == (tg + 1u) * nx) xb_add(&bar[XB_TOPGEN], 1u);
            else XB_SPIN(xb_ld(&bar[XB_TOPGEN]) == tg, bar);
            __builtin_amdgcn_fence(__ATOMIC_ACQUIRE, "agent");
            xb_add(&bar[XB_XGEN(b.x)], 1u);
            asm volatile("s_waitcnt vmcnt(0)" ::: "memory");
        } else {
            XB_SPIN(xb_ld(&bar[XB_XGEN(b.x)]) == gen, bar);
            __builtin_amdgcn_fence(__ATOMIC_ACQUIRE, "agent");
            asm volatile("s_waitcnt vmcnt(0)" ::: "memory");
        }
    }
    __syncthreads();
}
__device__ __forceinline__ float wave_sum(float v) {
#pragma unroll
    for (int o = 1; o < 64; o <<= 1) v += __shfl_xor(v, o);
    return v;
}
__device__ __forceinline__ unsigned pkbf(float lo, float hi) { return pg8::cvt_pk_bf16(lo, hi); }
__device__ __forceinline__ float bf2f(unsigned short b) { return __uint_as_float((unsigned)b << 16); }
__device__ __forceinline__ void transpose_item(const float* W, int ldn, bf16* WT, int K, int k0, int srccol0, int dstrow0, LAS float* scr, int lane, bool qf = false) {
#pragma unroll 8
    for (int i = 0; i < 32; ++i) { const int kk = 2 * i + (lane >> 5); scr[kk * 33 + (lane & 31)] = W[(size_t)(k0 + kk) * ldn + srccol0 + (lane & 31)]; }
    LDS_WAIT(); asm volatile("" ::: "memory");
    const int c = lane & 7;
#pragma unroll
    for (int j = 0; j < 4; ++j) { const int n = (lane >> 3) + 8 * j; const LAS float* s = scr + (8 * c) * 33 + n;
        v4u o; if (qf) { o.x = pkbf(qm(s[0 * 33]), qm(s[1 * 33])); o.y = pkbf(qm(s[2 * 33]), qm(s[3 * 33])); o.z = pkbf(qm(s[4 * 33]), qm(s[5 * 33])); o.w = pkbf(qm(s[6 * 33]), qm(s[7 * 33])); }
        else { o.x = pkbf(s[0 * 33], s[1 * 33]); o.y = pkbf(s[2 * 33], s[3 * 33]); o.z = pkbf(s[4 * 33], s[5 * 33]); o.w = pkbf(s[6 * 33], s[7 * 33]); }
        const int dr = dstrow0 + n; *(GAS v4u*)(WT + ((size_t)((dr >> 8) * (K >> 6) + (k0 >> 6)) * 256 + (dr & 255)) * 64 + 8 * c) = o; }
    LDS_WAIT(); asm volatile("" ::: "memory");
}
template <class INP> __device__ __forceinline__ void absmax_item(const INP& inp, unsigned char* ws, int t, LAS float* red, int tid) {
    const int col = tid & 127, kq = tid >> 7;
    const float* src; size_t ld; int kb, kn, kind, mat, cb;
    if (t < 352) { kind = 0; mat = t / 88; cb = t % 88; src = inp[12] + (size_t)mat * DM * NFF + 128 * cb + col; ld = NFF; kb = 512 * kq; kn = 512; }
    else if (t < 432) { t -= 352; kind = 1; mat = t / 40; cb = t % 40; src = inp[14] + (size_t)mat * DM * NIN + 128 * cb + col; ld = NIN; kb = 512 * kq; kn = 512; }
    else { t -= 432; kind = 2; mat = t >> 6; cb = (t & 63) >> 2; src = inp[13] + (size_t)mat * DFF * DM + 128 * cb + col; ld = DM; kb = 1408 * (t & 3) + 352 * kq; kn = 352; }
    float mx = 0.f;
    for (int k = kb; k < kb + kn; k += 8) { float w[8];
#pragma unroll
        for (int u = 0; u < 8; ++u) w[u] = src[(size_t)(k + u) * ld];
#pragma unroll
        for (int u = 0; u < 8; ++u) mx = fmaxf(mx, fabsf(w[u])); }
    red[kq * 128 + col] = mx;
    __syncthreads();
    if (tid < 128) { const float m4 = fmaxf(fmaxf(red[tid], red[128 + tid]), fmaxf(red[256 + tid], red[384 + tid])); const int s0 = 128 * cb + tid;
        if (kind == 0) { const int brow = s0 < DFF ? (s0 / 128) * 256 + (s0 % 128) : ((s0 - DFF) / 128) * 256 + 128 + ((s0 - DFF) % 128);
            ((float*)(ws + WS_Q + Q_SW))[(size_t)mat * NFF + brow] = fmaxf(m4, 1e-30f) * (1.0f / 127.0f); }
        else if (kind == 1) ((float*)(ws + WS_Q + Q_SW4))[(size_t)mat * NIN + s0] = fmaxf(m4, 1e-30f) * (1.0f / 127.0f);
        else atomicMax((unsigned*)(ws + WS_CTL + CTL_RAW2) + (size_t)mat * DM + s0, __float_as_uint(m4)); }
    __syncthreads();
}
template <class INP> __device__ __forceinline__ void prologue(const INP& inp, unsigned char* ws, LAS unsigned char* lds, int G, int wg, int tid) {
    const int lane = tid & 63, wave = __builtin_amdgcn_readfirstlane(tid >> 6);
    float* tab = (float*)(ws + WS_TAB);
    {
        LAS float* sc = (LAS float*)lds;
        LAS float* red = sc + NCOND * DM;
        bool have = false;
        for (int it = wg; it < 976; it += G) {
            if (it >= 288) { absmax_item(inp, ws, it - 288, (LAS float*)(lds + 98304), tid); continue; }
            if (!have) { for (int i = tid; i < NCOND * DM; i += 512) { const int cd = i >> 11, k = i & 2047; const float v = cd == 0 ? inp[8][k] : inp[2][(cd - 1) * DM + k];
                              sc[i] = v / (1.0f + __expf(-v)); } have = true; __syncthreads(); }
            const int l = it / 144, cb = it % 144, col = tid & 127, g = tid >> 7;
            const float* W = inp[9] + (size_t)l * DM * NMODC + 128 * cb + col;
            float acc[NCOND];
#pragma unroll
            for (int c = 0; c < NCOND; ++c) acc[c] = 0.f;
            for (int k = 512 * g; k < 512 * g + 512; k += 8) {
                float w[8];
#pragma unroll
                for (int u = 0; u < 8; ++u) w[u] = W[(size_t)(k + u) * NMODC];
#pragma unroll
                for (int c = 0; c < NCOND; ++c) { const f32x4 s0 = *(const LAS f32x4*)(sc + c * DM + k), s1 = *(const LAS f32x4*)(sc + c * DM + k + 4);
                    acc[c] += (s0[0] * w[0] + s0[1] * w[1]) + (s0[2] * w[2] + s0[3] * w[3]) + (s1[0] * w[4] + s1[1] * w[5]) + (s1[2] * w[6] + s1[3] * w[7]); }
            }
#pragma unroll
            for (int c = 0; c < NCOND; ++c) red[(g * NCOND + c) * 128 + col] = acc[c];
            __syncthreads();
            for (int i = tid; i < NCOND * 128; i += 512) { const int c = i >> 7, cc = i & 127;
                const float s = ((red[(0 * NCOND + c) * 128 + cc] + red[(1 * NCOND + c) * 128 + cc]) + red[(2 * NCOND + c) * 128 + cc]) + red[(3 * NCOND + c) * 128 + cc];
                tab[TB_MOD + ((size_t)l * NCOND + c) * NMODC + 128 * cb + cc] = s + inp[10][(size_t)l * NMODC + 128 * cb + cc]; }
            __syncthreads();
        }
        __syncthreads();
    }
    if (wg == 0) {
        for (int i = tid; i < 64 * 32; i += 512) { const int pos = i >> 5, f = i & 31; const double inv = pow(10000.0, -(double)(2 * f) / 64.0), a = (double)pos * inv;
            tab[TB_COSG + i] = (float)cos(a); tab[TB_SING + i] = (float)sin(a); }
        for (int i = tid; i < 64 * 16; i += 512) { const int pos = i >> 4, f = i & 15; const double inv = pow(10000.0, -(double)(2 * f) / 32.0), a = (double)pos * inv;
            tab[TB_COSD + i] = (float)cos(a); tab[TB_SIND + i] = (float)sin(a); }
        if (tid < 2) { const int l = tid; const float* dl = inp[19] + l * 256; double s01 = 0.0, s23 = 0.0;
            for (int i = 0; i < 64; ++i) { s01 += (double)dl[i] * (double)dl[64 + i]; s23 += (double)dl[128 + i] * (double)dl[192 + i]; }
            const double li = 0.8 - 0.6 * exp(-0.3 * (double)l);
            tab[TB_SCAL + 16 * l + 0] = (float)(exp(s01) - exp(s23) + li); tab[TB_SCAL + 16 * l + 1] = (float)(1.0 - li); }
        if (tid >= 128 && tid < 130) { const int l = tid - 128; const float* w = inp[18] + l * 256; float mq = 0.f, mk = 0.f;
            for (int i = 0; i < 128; ++i) { mq = fmaxf(mq, fabsf(w[i])); mk = fmaxf(mk, fabsf(w[128 + i])); }
            tab[TB_SCAL + 16 * l + 10] = (mq * mk * 11.313708f * 1.4426950f < 60.0f) ? 1.0f : 0.0f; }
        if (tid >= 64 && tid < 80) { const int i = tid - 64, l = i >> 3, j = i & 7; const double x = (double)inp[16][l * 8 + j];
            tab[TB_SCAL + 16 * l + 2 + j] = (float)(-log1p(exp(-x)) * 1.4426950408889634); }
    }
    {
        bf16* cb = (bf16*)(ws + WS_CACHE);
        const long gt = (long)wg * 512 + tid, GT = (long)G * 512;
        for (int t = 0; t < 4; ++t) { const float* src = inp[4 + t]; const long n8 = (t < 2 ? 1048576 : 2097152) / 8; bf16* dst = cb + (t == 0 ? 0 : t == 1 ? 1048576 : t == 2 ? 2097152 : 4194304);
            for (long i = gt; i < n8; i += GT) { const f32x4 a = *(const f32x4*)(src + i * 8), b = *(const f32x4*)(src + i * 8 + 4);
                v4u o; o.x = pkbf(a[0], a[1]); o.y = pkbf(a[2], a[3]); o.z = pkbf(b[0], b[1]); o.w = pkbf(b[2], b[3]); *(v4u*)(dst + i * 8) = o; } }
    }
    {
        LAS float* scr = (LAS float*)(lds + wave * 16384);
        const int gw = wg * 8 + wave, NGW = G * 8;
        for (int it = gw; it < 81920; it += NGW) {
            const int l = it / 40960; int r = it % 40960;
            bf16* WL = (bf16*)(ws + WS_W + (size_t)l * W_LAYER);
            if (r < 22528) continue;
            if (false) { const int f = r / 11264, q = r % 11264, kb = q / 352, nb = q % 352, s0 = 32 * nb;
                const int drow = s0 < DFF ? (s0 / 128) * 256 + (s0 % 128) : ((s0 - DFF) / 128) * 256 + 128 + ((s0 - DFF) % 128);
                transpose_item(inp[12] + (size_t)(l * 2 + f) * DM * NFF, NFF, WL + (W_WI + (size_t)f * 44 * MiB) / 2, DM, 64 * kb, s0, drow, scr, lane, true); continue; }
            r -= 22528;
            if (r < 11264) continue;
            if (false) { const int f = r / 5632, q = r % 5632, kb = q / 64, nb = q % 64;
                transpose_item(inp[13] + (size_t)(l * 2 + f) * DFF * DM, DM, WL + (W_WO + (size_t)f * 22 * MiB) / 2, DFF, 64 * kb, 32 * nb, 32 * nb, scr, lane, true); continue; }
            r -= 11264;
            if (r < 5120) { const int kb = r / 160, nb = r % 160;
                transpose_item(inp[14] + (size_t)l * DM * NIN, NIN, WL + W_WIN / 2, DM, 64 * kb, 32 * nb, 32 * nb, scr, lane); continue; }
            r -= 5120;
            { const int kb = r / 64, nb = r % 64;
                transpose_item(inp[15] + (size_t)l * DM * DM, DM, WL + W_WOUT / 2, DM, 64 * kb, 32 * nb, 32 * nb, scr, lane); }
        }
    }
}
template <class INP> __device__ __forceinline__ void prologue_b(const INP& inp, unsigned char* ws, LAS unsigned char* lds, int G, int wg, int tid) {
    const int lane = tid & 63, wave = __builtin_amdgcn_readfirstlane(tid >> 6);
    LAS float* scr = (LAS float*)(lds + wave * 16384);
    const float* swv = (const float*)(ws + WS_Q + Q_SW);
    const int gw = wg * 8 + wave, NGW = G * 8;
    const float* swv4 = (const float*)(ws + WS_Q + Q_SW4);
    if (wg < 4) {
        float sm = 0.f; for (int i = tid; i < NFF; i += 512) sm += swv[(size_t)wg * NFF + i];
#pragma unroll
        for (int o = 1; o < 64; o <<= 1) sm += __shfl_xor(sm, o);
        LAS float* red = (LAS float*)(lds + 131072);
        if (lane == 0) red[wave] = sm;
        __syncthreads();
        if (tid == 0) { float t = 0.f; for (int i = 0; i < 8; ++i) t += red[i];
            const float sg = t * (127.0f / (float)NFF) * (1.0f / 3.6f) * 45.254834f;
            const float h0 = fmaxf(fmaxf(sg * sg, sg), 1e-20f); const float sc = exp2f(1.0f - rintf(log2f(h0)));
            float* qa = (float*)(ws + WS_Q + Q_ACT) + 2 * wg; qa[0] = sc; qa[1] = 1.0f / sc; }
        __syncthreads();
    }
    for (int it = gw; it < 10240; it += NGW) {
        const int l = it / 5120, q = it % 5120, kb = q / 160, nb = q % 160, s0 = 32 * nb, k0 = 64 * kb;
        const float* W = inp[14] + (size_t)l * DM * NIN;
        unsigned char* WQ = ws + WS_W + (size_t)l * W_LAYER + W_WINQ;
#pragma unroll 8
        for (int i = 0; i < 32; ++i) { const int kk = 2 * i + (lane >> 5); scr[kk * 33 + (lane & 31)] = W[(size_t)(k0 + kk) * NIN + s0 + (lane & 31)]; }
        LDS_WAIT(); asm volatile("" ::: "memory");
        const int c = lane & 7;
#pragma unroll
        for (int j = 0; j < 4; ++j) { const int n = (lane >> 3) + 8 * j, dr = s0 + n; const LAS float* sp = scr + (8 * c) * 33 + n;
            const float inv = 1.0f / swv4[(size_t)l * NIN + dr];
            unsigned lo = 0u, hi = 0u;
#pragma unroll
            for (int e = 0; e < 4; ++e) { lo |= ((unsigned)(__float2int_rn(sp[e * 33] * inv)) & 0xffu) << (8 * e); hi |= ((unsigned)(__float2int_rn(sp[(4 + e) * 33] * inv)) & 0xffu) << (8 * e); }
            const int kk = k0 + 8 * c;
            uint2 o; o.x = lo; o.y = hi;
            *(uint2*)(WQ + ((size_t)((dr >> 8) * (DM >> 7) + (kk >> 7)) * 256 + (dr & 255)) * 128 + (kk & 127)) = o; }
        LDS_WAIT(); asm volatile("" ::: "memory");
    }
    const unsigned* raw2 = (const unsigned*)(ws + WS_CTL + CTL_RAW2);
    for (int i = wg * 512 + tid; i < 4 * DM; i += G * 512) ((float*)(ws + WS_Q + Q_SW2))[i] = fmaxf(__uint_as_float(raw2[i]), 1e-30f) * (1.0f / 240.0f);
    for (int it = gw; it < 22528; it += NGW) {
        const int mat = it / 5632, q = it % 5632, kb = q / 64, nb = q % 64, s0 = 32 * nb, k0 = 64 * kb, l = mat >> 1, f = mat & 1;
        const float* W = inp[13] + (size_t)mat * DFF * DM;
        unsigned char* WQ = ws + WS_W + (size_t)l * W_LAYER + W_WO + (size_t)f * 22 * MiB;
#pragma unroll 8
        for (int i = 0; i < 32; ++i) { const int kk = 2 * i + (lane >> 5); scr[kk * 33 + (lane & 31)] = W[(size_t)(k0 + kk) * DM + s0 + (lane & 31)]; }
        LDS_WAIT(); asm volatile("" ::: "memory");
        const int c = lane & 7;
#pragma unroll
        for (int j = 0; j < 4; ++j) { const int n = (lane >> 3) + 8 * j, dr = s0 + n; const LAS float* sp = scr + (8 * c) * 33 + n;
            const float inv = 240.0f / fmaxf(__uint_as_float(raw2[(size_t)mat * DM + dr]), 1e-30f);
            unsigned lo = __builtin_amdgcn_cvt_pk_fp8_f32(sp[0] * inv, sp[33] * inv, 0, false); lo = __builtin_amdgcn_cvt_pk_fp8_f32(sp[2 * 33] * inv, sp[3 * 33] * inv, lo, true);
            unsigned hi = __builtin_amdgcn_cvt_pk_fp8_f32(sp[4 * 33] * inv, sp[5 * 33] * inv, 0, false); hi = __builtin_amdgcn_cvt_pk_fp8_f32(sp[6 * 33] * inv, sp[7 * 33] * inv, hi, true);
            const int kk = k0 + 8 * c;
            uint2 o; o.x = lo; o.y = hi;
            *(uint2*)(WQ + ((size_t)((dr >> 8) * (DFF >> 7) + (kk >> 7)) * 256 + (dr & 255)) * 128 + (kk & 127)) = o; }
        LDS_WAIT(); asm volatile("" ::: "memory");
    }
    for (int it = gw; it < 45056; it += NGW) {
        const int mat = it / 11264, q = it % 11264, kb = q / 352, nb = q % 352, s0 = 32 * nb, k0 = 64 * kb, l = mat >> 1, f = mat & 1;
        const int drow = s0 < DFF ? (s0 / 128) * 256 + (s0 % 128) : ((s0 - DFF) / 128) * 256 + 128 + ((s0 - DFF) % 128);
        const float* W = inp[12] + (size_t)mat * DM * NFF;
        unsigned char* WQ = ws + WS_W + (size_t)l * W_LAYER + W_WI + (size_t)f * 44 * MiB;
#pragma unroll 8
        for (int i = 0; i < 32; ++i) { const int kk = 2 * i + (lane >> 5); scr[kk * 33 + (lane & 31)] = W[(size_t)(k0 + kk) * NFF + s0 + (lane & 31)]; }
        LDS_WAIT(); asm volatile("" ::: "memory");
        const int c = lane & 7;
#pragma unroll
        for (int j = 0; j < 4; ++j) { const int n = (lane >> 3) + 8 * j, dr = drow + n; const LAS float* sp = scr + (8 * c) * 33 + n;
            const float inv = 1.0f / swv[(size_t)mat * NFF + dr];
            unsigned lo = 0u, hi = 0u;
#pragma unroll
            for (int e = 0; e < 4; ++e) { lo |= ((unsigned)(__float2int_rn(sp[e * 33] * inv)) & 0xffu) << (8 * e); hi |= ((unsigned)(__float2int_rn(sp[(4 + e) * 33] * inv)) & 0xffu) << (8 * e); }
            const int kk = k0 + 8 * c;
            uint2 o; o.x = lo; o.y = hi;
            *(uint2*)(WQ + ((size_t)((dr >> 8) * (DM >> 7) + (kk >> 7)) * 256 + (dr & 255)) * 128 + (kk & 127)) = o; }
        LDS_WAIT(); asm volatile("" ::: "memory");
    }
}
__device__ __forceinline__ void quant_act_phase(const bf16* ACT, unsigned char* A8, float* sa, int G, int wg, int tid) {
    const int lane = tid & 63, wave = tid >> 6, gw = wg * 8 + wave, NGW = G * 8;
    for (int m = gw; m < MTOK; m += NGW) {
        const bf16* ar = ACT + (size_t)m * DFF;
        v4u v[11]; float mx = 0.f;
#pragma unroll
        for (int j = 0; j < 11; ++j) v[j] = *(const v4u*)(ar + 512 * j + 8 * lane);
#pragma unroll
        for (int j = 0; j < 11; ++j) { const unsigned w4[4] = {v[j].x, v[j].y, v[j].z, v[j].w};
#pragma unroll
            for (int e = 0; e < 4; ++e) mx = fmaxf(mx, fmaxf(fabsf(__uint_as_float(w4[e] << 16)), fabsf(__uint_as_float(w4[e] & 0xffff0000u)))); }
#pragma unroll
        for (int o = 1; o < 64; o <<= 1) mx = fmaxf(mx, __shfl_xor(mx, o));
        mx = fmaxf(mx, 1e-30f);
        if (lane == 0) sa[m] = mx * (1.0f / 127.0f);
        const float inv = 127.0f / mx; unsigned char* orow = A8 + (size_t)m * DFF;
#pragma unroll
        for (int j = 0; j < 11; ++j) { const unsigned w4[4] = {v[j].x, v[j].y, v[j].z, v[j].w}; unsigned o2[2] = {0u, 0u};
#pragma unroll
            for (int e = 0; e < 4; ++e) { const unsigned lo = (unsigned)__float2int_rn(__uint_as_float(w4[e] << 16) * inv) & 0xffu, hi = (unsigned)__float2int_rn(__uint_as_float(w4[e] & 0xffff0000u) * inv) & 0xffu;
                o2[e >> 1] |= (lo | (hi << 8)) << (16 * (e & 1)); }
            uint2 ov; ov.x = o2[0]; ov.y = o2[1]; *(uint2*)(orow + 512 * j + 8 * lane) = ov; }
    }
}
__device__ __forceinline__ void quant_xs_phase(const bf16* XS, const unsigned* amax, unsigned char* A8, float* sa, int G, int wg, int tid, int m_begin = 0) {
    const int lane = tid & 63, wave = tid >> 6, gw = wg * 8 + wave, NGW = G * 8;
    for (int m0 = m_begin + 2 * gw; m0 < MTOK; m0 += 2 * NGW) {
        v4u v[2][4]; float mx[2];
#pragma unroll
        for (int r = 0; r < 2; ++r) { const bf16* xr = XS + (size_t)(m0 + r) * DM; mx[r] = fmaxf(__uint_as_float(amax[m0 + r]), 1e-30f);
#pragma unroll
            for (int j = 0; j < 4; ++j) v[r][j] = *(const v4u*)(xr + 512 * j + 8 * lane); }
#pragma unroll
        for (int r = 0; r < 2; ++r) { const float inv = 127.0f / mx[r]; unsigned char* orow = A8 + (size_t)(m0 + r) * DM; if (lane == 0) sa[m0 + r] = mx[r] * (1.0f / 127.0f);
#pragma unroll
            for (int j = 0; j < 4; ++j) { const unsigned w4[4] = {v[r][j].x, v[r][j].y, v[r][j].z, v[r][j].w}; unsigned o2[2] = {0u, 0u};
#pragma unroll
                for (int e = 0; e < 4; ++e) { const unsigned lo = (unsigned)__float2int_rn(__uint_as_float(w4[e] << 16) * inv) & 0xffu, hi = (unsigned)__float2int_rn(__uint_as_float(w4[e] & 0xffff0000u) * inv) & 0xffu;
                    o2[e >> 1] |= (lo | (hi << 8)) << (16 * (e & 1)); }
                uint2 ov; ov.x = o2[0]; ov.y = o2[1]; *(uint2*)(orow + 512 * j + 8 * lane) = ov; } }
    }
}
__device__ __forceinline__ void quant_phase(const float* xP, const float* xS, const float* nw, const float* scl0  , unsigned char* A8, float* sa, unsigned long long* rss, int G, int wg, int tid, int m_begin = 0) {
    const int lane = tid & 63, wave = tid >> 6, gw = wg * 8 + wave, NGW = G * 8;
    for (int m = m_begin + gw; m < MTOK; m += NGW) {
        const float* xr = (m < M_P ? xP : xS) + (size_t)m * DM;
        const int cond = m < M_P ? 0 : 1 + ((m - M_P) >> 12);
        const float* scl = scl0 + (size_t)cond * NMODC;
        f32x4 h[8]; float ss = 0.f, mx = 0.f;
#pragma unroll
        for (int j = 0; j < 8; ++j) { const int c = 256 * j + 4 * lane; const f32x4 v = *(const f32x4*)(xr + c); ss += (v[0] * v[0] + v[1] * v[1]) + (v[2] * v[2] + v[3] * v[3]);
            h[j] = v * *(const f32x4*)(nw + c) * (*(const f32x4*)(scl + c) + 1.0f);
            mx = fmaxf(fmaxf(mx, fmaxf(fabsf(h[j][0]), fabsf(h[j][1]))), fmaxf(fabsf(h[j][2]), fabsf(h[j][3]))); }
        ss = wave_sum(ss);
#pragma unroll
        for (int o = 1; o < 64; o <<= 1) mx = fmaxf(mx, __shfl_xor(mx, o));
        mx = fmaxf(mx, 1e-30f);
        if (lane == 0) { rss[m] = (unsigned long long)(ss * 16777216.0f); sa[m] = mx * (1.0f / 127.0f); }
        const float inv = 127.0f / mx; unsigned char* orow = A8 + (size_t)m * DM;
#pragma unroll
        for (int j = 0; j < 8; ++j) { const unsigned w = ((unsigned)__float2int_rn(h[j][0] * inv) & 0xffu) | (((unsigned)__float2int_rn(h[j][1] * inv) & 0xffu) << 8) | (((unsigned)__float2int_rn(h[j][2] * inv) & 0xffu) << 16) | (((unsigned)__float2int_rn(h[j][3] * inv) & 0xffu) << 24);
            *(unsigned*)(orow + 256 * j + 4 * lane) = w; }
    }
}
__device__ __forceinline__ void norm0_phase(const float* xP, const float* xS, const float* nw, const float* mod  , bf16* XN, unsigned long long* rss, int G, int wg, int tid) {
    const int lane = tid & 63, wave = tid >> 6, gw = wg * 8 + wave, NGW = G * 8;
    for (int m = gw; m < MTOK; m += NGW) {
        const float* xr = (m < M_P ? xP : xS) + (size_t)m * DM;
        const int cond = m < M_P ? 0 : 1 + ((m - M_P) >> 12);
        const float* scl = mod + (size_t)cond * NMODC + DM;
        f32x4 v[8]; float ss = 0.f;
#pragma unroll
        for (int j = 0; j < 8; ++j) { v[j] = *(const f32x4*)(xr + 256 * j + 4 * lane); ss += (v[j][0] * v[j][0] + v[j][1] * v[j][1]) + (v[j][2] * v[j][2] + v[j][3] * v[j][3]); }
        ss = wave_sum(ss); if (lane == 0) rss[m] = (unsigned long long)(ss * 16777216.0f);
        bf16* orow = XN + (size_t)m * DM;
#pragma unroll
        for (int j = 0; j < 8; ++j) { const int c = 256 * j + 4 * lane; const f32x4 w = *(const f32x4*)(nw + c), s1 = *(const f32x4*)(scl + c);
            const f32x4 h = v[j] * w * (s1 + 1.0f);
            uint2 o; o.x = pkbf(qm(h[0]), qm(h[1])); o.y = pkbf(qm(h[2]), qm(h[3])); *(uint2*)(orow + c) = o; }
    }
}
__device__ __forceinline__ void bias_ffn_mfma(unsigned char* ws, LAS unsigned char* lds, int grp, int sub, int nsub, int tid) {
    typedef int i32x4_t __attribute__((ext_vector_type(4)));
    const int lane = tid & 63, wave = tid >> 6, l = grp >> 1, f = grp & 1;
    const float* mod = (const float*)(ws + WS_TAB) + TB_MOD + (size_t)l * NCOND * NMODC + (size_t)(6 * f) * DM;
    LAS unsigned char* D = lds;
    LAS float* red = (LAS float*)(lds + 65536);
    __syncthreads();
    for (int i = tid; i < 65536 / 16; i += 512) ((LAS v4u*)D)[i] = (v4u){0u, 0u, 0u, 0u};
    for (int c = wave; c < NCOND; c += 8) { float mx = 0.f; for (int k = lane; k < DM; k += 64) mx = fmaxf(mx, fabsf(mod[(size_t)c * NMODC + k]));
#pragma unroll
        for (int o = 1; o < 64; o <<= 1) mx = fmaxf(mx, __shfl_xor(mx, o));
        if (lane == 0) red[c] = fmaxf(mx, 1e-30f) * (1.0f / 127.0f); }
    __syncthreads();
    for (int i = tid; i < NCOND * DM; i += 512) { const int c = i >> 11, k = i & 2047; const float s0 = red[c], s1 = s0 * (1.0f / 127.0f), v = mod[(size_t)c * NMODC + k];
        const float d0 = rintf(v / s0), d1 = rintf((v - d0 * s0) / s1); const int off = ((k >> 6) * 16 + c) * 64 + (k & 63);
        D[off] = (unsigned char)(int)d0; D[32768 + off] = (unsigned char)(int)d1; }
    __syncthreads();
    const unsigned char* Bq = ws + WS_W + (size_t)l * W_LAYER + W_WI + (size_t)f * 44 * MiB;
    const float* swv = (const float*)(ws + WS_Q + Q_SW) + (size_t)(2 * l + f) * NFF;
    float* sb = (float*)(ws + WS_SB) + (size_t)l * SB_LAYER + (f ? SB_J2 : 0);
    const int jr = lane & 15, g = lane >> 4;
    for (int rg = sub * 8 + wave; rg < NFF / 16; rg += nsub * 8) {
        const int n = rg * 16 + jr;
        const unsigned char* wp = Bq + ((size_t)(n >> 8) * (DM >> 7) * 256 + (n & 255)) * 128 + 16 * g;
        i32x4_t a0 = {0, 0, 0, 0}, a1 = {0, 0, 0, 0};
#pragma unroll 4
        for (int kb = 0; kb < 32; ++kb) {
            const i32x4_t w = *(const i32x4_t*)(wp + (size_t)(kb >> 1) * 256 * 128 + (kb & 1) * 64);
            const i32x4_t d0 = *(const LAS i32x4_t*)(D + ((kb * 16 + jr) * 64 + 16 * g)), d1 = *(const LAS i32x4_t*)(D + 32768 + ((kb * 16 + jr) * 64 + 16 * g));
            a0 = __builtin_amdgcn_mfma_i32_16x16x64_i8(w, d0, a0, 0, 0, 0); a1 = __builtin_amdgcn_mfma_i32_16x16x64_i8(w, d1, a1, 0, 0, 0);
        }
        if (jr < NCOND) { const float s0 = red[jr], s1 = s0 * (1.0f / 127.0f);
#pragma unroll
            for (int r = 0; r < 4; ++r) { const int nn = rg * 16 + 4 * g + r; sb[(size_t)jr * NFF + nn] = swv[nn] * (s0 * (float)a0[r] + s1 * (float)a1[r]); } }
    }
    __syncthreads();
}
__device__ __forceinline__ void bias_phase(unsigned char* ws, LAS unsigned char* lds, int G, int wg, int tid) {
    const int lane = tid & 63, wave = tid >> 6, gw = wg * 8 + wave, NGW = G * 8;
    LAS float* sh = (LAS float*)lds;
    const float* tab = (const float*)(ws + WS_TAB);
    const int per = G / 4; const bool mf = per >= 1;
    if (mf && wg < 4 * per) bias_ffn_mfma(ws, lds, wg / per, wg % per, per, tid);
    for (int grp = 0; grp < 6; ++grp) {
        const int l = grp / 3, j = grp % 3, N = (j == 1) ? NIN : NFF;
        if (mf && j != 1) continue;
        const bf16* Bt = (const bf16*)(ws + WS_W + (size_t)l * W_LAYER + (j == 0 ? W_WI : j == 1 ? W_WIN : W_WI + 44 * MiB));
        float* sb = (float*)(ws + WS_SB) + (size_t)l * SB_LAYER + (j == 0 ? 0 : j == 1 ? SB_J1 : SB_J2);
        const float* mod = tab + TB_MOD + (size_t)l * NCOND * NMODC + (size_t)(3 * j) * DM;
        __syncthreads();
        for (int i = tid; i < NCOND * DM; i += 512) sh[i] = mod[(size_t)(i >> 11) * NMODC + (i & 2047)];
        __syncthreads();
        if (j != 1) {
            const unsigned char* Bq = (const unsigned char*)Bt; const float* swv = (const float*)(ws + WS_Q + Q_SW) + (size_t)(2 * l + (j >> 1)) * NFF;
            for (int n = gw; n < N; n += NGW) {
                v4u wr2[2];
#pragma unroll
                for (int q = 0; q < 2; ++q) { const int k_ = 16 * (lane + 64 * q); wr2[q] = *(const v4u*)(Bq + ((size_t)((n >> 8) * (DM >> 7) + (k_ >> 7)) * 256 + (n & 255)) * 128 + (k_ & 127)); }
                float wf[2][16];
#pragma unroll
                for (int q = 0; q < 2; ++q) { const unsigned ww[4] = {wr2[q].x, wr2[q].y, wr2[q].z, wr2[q].w};
#pragma unroll
                    for (int e = 0; e < 16; ++e) wf[q][e] = (float)(int)(signed char)((ww[e >> 2] >> (8 * (e & 3))) & 0xffu); }
                const float swn = swv[n];
#pragma unroll 1
                for (int c = 0; c < NCOND; ++c) { float a = 0.f;
#pragma unroll
                    for (int q = 0; q < 2; ++q) { const int k = 16 * (lane + 64 * q);
#pragma unroll
                        for (int e4 = 0; e4 < 4; ++e4) { const f32x4 s0 = *(const LAS f32x4*)(sh + c * DM + k + 4 * e4); a += (s0[0] * wf[q][4 * e4] + s0[1] * wf[q][4 * e4 + 1]) + (s0[2] * wf[q][4 * e4 + 2] + s0[3] * wf[q][4 * e4 + 3]); } }
                    const float t = wave_sum(a); if (lane == 0) sb[(size_t)c * N + n] = t * swn; }
            }
            continue;
        }
        v4u wq[4];
        if (gw < N) {
#pragma unroll
            for (int q = 0; q < 4; ++q) { const int k_ = 8 * (lane + 64 * q); wq[q] = *(const v4u*)(Bt + ((size_t)((gw >> 8) * (DM >> 6) + (k_ >> 6)) * 256 + (gw & 255)) * 64 + (k_ & 63)); } }
        for (int n = gw; n < N; n += NGW) {
            v4u wc_[4];
#pragma unroll
            for (int q = 0; q < 4; ++q) wc_[q] = wq[q];
            if (n + NGW < N) {
#pragma unroll
                for (int q = 0; q < 4; ++q) { const int k_ = 8 * (lane + 64 * q), n_ = n + NGW; wq[q] = *(const v4u*)(Bt + ((size_t)((n_ >> 8) * (DM >> 6) + (k_ >> 6)) * 256 + (n_ & 255)) * 64 + (k_ & 63)); } }
            float wf[4][8];
#pragma unroll
            for (int q = 0; q < 4; ++q) { const v4u w4 = wc_[q];
                wf[q][0] = __uint_as_float(w4.x << 16); wf[q][1] = __uint_as_float(w4.x & 0xffff0000u); wf[q][2] = __uint_as_float(w4.y << 16); wf[q][3] = __uint_as_float(w4.y & 0xffff0000u);
                wf[q][4] = __uint_as_float(w4.z << 16); wf[q][5] = __uint_as_float(w4.z & 0xffff0000u); wf[q][6] = __uint_as_float(w4.w << 16); wf[q][7] = __uint_as_float(w4.w & 0xffff0000u); }
#pragma unroll 1
            for (int c = 0; c < NCOND; ++c) { float a = 0.f;
#pragma unroll
                for (int q = 0; q < 4; ++q) { const int k = 8 * (lane + 64 * q); const f32x4 s0 = *(const LAS f32x4*)(sh + c * DM + k), s1 = *(const LAS f32x4*)(sh + c * DM + k + 4);
                    a += (s0[0] * wf[q][0] + s0[1] * wf[q][1]) + (s0[2] * wf[q][2] + s0[3] * wf[q][3]) + (s1[0] * wf[q][4] + s1[1] * wf[q][5]) + (s1[2] * wf[q][6] + s1[3] * wf[q][7]); }
                const float t = wave_sum(a); if (lane == 0) sb[(size_t)c * N + n] = t; }
        }
    }
    __syncthreads();
}
__device__ __forceinline__ void final_norm(float* x, const float* fw, int G, int wg, int tid) {
    const int lane = tid & 63, wave = tid >> 6, gw = wg * 8 + wave, NGW = G * 8;
    for (int m = gw; m < MTOK; m += NGW) {
        float* xr = x + (size_t)m * DM; f32x4 v[8]; float ss = 0.f;
#pragma unroll
        for (int j = 0; j < 8; ++j) { v[j] = *(const f32x4*)(xr + 256 * j + 4 * lane); ss += (v[j][0] * v[j][0] + v[j][1] * v[j][1]) + (v[j][2] * v[j][2] + v[j][3] * v[j][3]); }
        const float rstd = rsqrtf(wave_sum(ss) * (1.0f / DM) + EPS);
#pragma unroll
        for (int j = 0; j < 8; ++j) { const int c = 256 * j + 4 * lane; *(f32x4*)(xr + c) = (v[j] * rstd) * *(const f32x4*)(fw + c); }
    }
}
__device__ __forceinline__ void prep_row(int m, int l, bf16* PROJ, bf16* DST, const float* tab, const float* qkw  , float* out, int lane) {
    bf16* pr = PROJ + (size_t)m * NIN; bf16* pw = DST + (size_t)m * NIN;
    const bool lat = m >= M_P; const int t = lat ? ((m - M_P) & 4095) : (m & 255), b = lat ? ((m - M_P) >> 12) : (m >> 8);
    const int rr = t >> 6, cc = t & 63;
    unsigned rg[10], rd[8], rv2[2], rv4[4];
#pragma unroll
    for (int v = 0; v < 10; ++v) rg[v] = *(const unsigned*)(pr + (v < 8 ? C_GQ + 128 * v : C_GK + 128 * (v - 8)) + 2 * lane);
#pragma unroll
    for (int v = 0; v < 8; ++v) rd[v] = *(const unsigned*)(pr + (v < 4 ? C_DQ + 128 * v : C_DK + 128 * (v - 4)) + 2 * lane);
    if (!lat) {
#pragma unroll
        for (int v = 0; v < 2; ++v) rv2[v] = *(const unsigned*)(pr + C_GV + 128 * v + 2 * lane);
#pragma unroll
        for (int v = 0; v < 4; ++v) rv4[v] = *(const unsigned*)(pr + C_DV + 128 * v + 2 * lane);
    }
    const float wq0 = qkw[2 * lane], wq1 = qkw[2 * lane + 1], wk0 = qkw[128 + 2 * lane], wk1 = qkw[128 + 2 * lane + 1];
    float cs = 1.f, sn = 0.f, c2 = 1.f, s2 = 0.f;
    if (lat) { const int idx = lane < 32 ? rr * 32 + lane : cc * 32 + (lane - 32); cs = tab[TB_COSG + idx]; sn = tab[TB_SING + idx];
               const int p = lane & 31, id2 = p < 16 ? rr * 16 + p : cc * 16 + (p - 16); c2 = tab[TB_COSD + id2]; s2 = tab[TB_SIND + id2]; }
#pragma unroll
    for (int v = 0; v < 10; ++v) {
        const int col = (v < 8 ? C_GQ + 128 * v : C_GK + 128 * (v - 8)) + 2 * lane;
        const float x1 = bf2f((unsigned short)(rg[v] & 0xffffu)), x2 = bf2f((unsigned short)(rg[v] >> 16));
        const float rs = rsqrtf(wave_sum(x1 * x1 + x2 * x2) * (1.0f / 128.0f) + EPS);
        const float y1 = x1 * rs * (v < 8 ? wq0 : wk0), y2 = x2 * rs * (v < 8 ? wq1 : wk1);
        if (!lat && v >= 8) { float* o = out + O_GK + (((size_t)(b * 2 + l) * 256 + t) * 2 + (v - 8)) * 128 + 2 * lane; o[0] = y1; o[1] = y2; }
        const float qs = v < 8 ? 0.12751743f : 1.0f;
        *(unsigned*)(pw + col) = pkbf((y1 * cs - y2 * sn) * qs, (y1 * sn + y2 * cs) * qs);
    }
    if (lat) {
#pragma unroll
        for (int v = 0; v < 8; ++v) { const int col = (v < 4 ? C_DQ + 128 * v : C_DK + 128 * (v - 4)) + 2 * lane;
            const float x1 = bf2f((unsigned short)(rd[v] & 0xffffu)), x2 = bf2f((unsigned short)(rd[v] >> 16));
            *(unsigned*)(pw + col) = pkbf(x1 * c2 - x2 * s2, x1 * s2 + x2 * c2); }
    } else {
#pragma unroll
        for (int v = 0; v < 2; ++v) { float* o = out + O_GV + (((size_t)(b * 2 + l) * 256 + t) * 2 + v) * 128 + 2 * lane; o[0] = bf2f((unsigned short)(rv2[v] & 0xffffu)); o[1] = bf2f((unsigned short)(rv2[v] >> 16)); }
#pragma unroll
        for (int v = 0; v < 4; ++v) { const unsigned rk = rd[4 + v], rv = rv4[v];
            const size_t oi = (((size_t)(b * 2 + l) * 256 + t) * 4 + v) * 128 + 2 * lane;
            out[O_DK + oi] = bf2f((unsigned short)(rk & 0xffffu)); out[O_DK + oi + 1] = bf2f((unsigned short)(rk >> 16));
            out[O_DV + oi] = bf2f((unsigned short)(rv & 0xffffu)); out[O_DV + oi + 1] = bf2f((unsigned short)(rv >> 16)); }
    }
}
#ifndef EN_PRO
#define EN_PRO 1
#endif
#ifndef EN_NORM
#define EN_NORM 1
#endif
#ifndef EN_FFNIN
#define EN_FFNIN 1
#endif
#ifndef EN_FFNOUT
#define EN_FFNOUT 1
#endif
#ifndef EN_WIN
#define EN_WIN 1
#endif
#ifndef EN_P
#define EN_P 1
#endif
#ifndef EN_A
#define EN_A 1
#endif
#ifndef EN_A1
#define EN_A1 1
#endif
#ifndef EN_A2
#define EN_A2 1
#endif
#ifndef EN_A3
#define EN_A3 1
#endif
#ifndef EN_WOUT
#define EN_WOUT 1
#endif
#ifndef EN_FIN
#define EN_FIN 1
#endif
struct Args { const float* in[22]; float* out; unsigned char* ws; int ph_lo, ph_hi, pad0, pad1; };
constexpr int NPHASE = 30;
#define LAUNDER(p) asm volatile("" : "+s"(p))
struct InPtrs { const float* const* p; __device__ __forceinline__ const float* operator[](int i) const { return p[i]; } };
__device__ __forceinline__ int deal_unit(int i, int NL, int NC, int off, int G, int wg) {
    if (NL % G == 0) { const int nr = NL / G; if (i < nr) return i * G + wg; if (i > nr) return -1; const int c = (wg + G - off) % G; return c < NC ? NL + c : -1; }
    const int v = i * G + wg; return v < NL + NC ? v : -1;
}
__global__ void __launch_bounds__(512, 2) fwd_kernel(Args args) {
    extern __shared__ __attribute__((aligned(16))) unsigned char lds_raw[];
    LAS unsigned char* lds = (LAS unsigned char*)lds_raw;
    volatile LAS unsigned* MISC = (volatile LAS unsigned*)(lds + MISC_OFF);
    const int G = gridDim.x, wg = blockIdx.x;
    for (int u = threadIdx.x; u < (LDS_BYTES - 131072) / 4; u += 512) ((LAS unsigned*)(lds + 131072))[u] = 0u;
    __syncthreads();
    XcdBarrier bar = xcd_barrier_post((unsigned*)(args.ws + WS_CTL) + CW_BAR, MISC + 8);
    const int lo = args.ph_lo, hi = args.ph_hi;
#define IN(k) (lo <= (k) && (k) < hi)
#define SEAM(k) do { if (IN(k) && IN((k) + 1)) xcd_barrier(bar); } while (0)
#define PH_BEGIN size_t zoff_ = 0; asm volatile("" : "+s"(zoff_)); unsigned char* ws = args.ws + zoff_; float* out = args.out + zoff_;   \
    const InPtrs inp{args.in}; int tid = threadIdx.x; asm volatile("" : "+v"(tid)); \
    const int lane = tid & 63, wave = __builtin_amdgcn_readfirstlane(tid >> 6); (void)lane; (void)wave;

    if (IN(0)) { PH_BEGIN; (void)out; prologue(inp, ws, lds, G, wg, tid); }
    SEAM(0);
    if (IN(1)) { PH_BEGIN; (void)out; prologue_b(inp, ws, lds, G, wg, tid); }
    SEAM(1);
    if (IN(2)) { PH_BEGIN; (void)out;
        quant_phase(inp[0], inp[1] - (size_t)M_P * DM, inp[11], (const float*)(ws + WS_TAB) + TB_MOD + DM, ws + WS_XNB, (float*)(ws + WS_Q), (unsigned long long*)(ws + WS_RS), G, wg, tid);
        bias_phase(ws, lds, G, wg, tid); }
    SEAM(2);
#pragma unroll 1
    for (int l = 0; l < 2; ++l) {
        const int pb = 3 + 13 * l;
#pragma unroll 1
        for (int f = 0; f < 2; ++f) {
            const int fb = pb + 9 * f;
            if (IN(fb + 0)) { PH_BEGIN; (void)out; (void)inp; const bf16* WL = (const bf16*)(ws + WS_W + (size_t)l * W_LAYER);
                pg8::Gemm g{(const bf16*)(ws + WS_XNB), WL + (W_WI + (size_t)f * 44 * MiB) / 2, MTOK, NFF, DM / 2}; pg8::StaticOrder S; S.init(MTOK, NFF, G, wg);
                pg8::EpiSwiGLUQ E{ws + WS_A8B, DFF, (const unsigned long long*)(ws + WS_RS) + (size_t)(3 * l + 2 * f) * MTOK, (const float*)(ws + WS_Q), (const float*)(ws + WS_Q + Q_SW) + (size_t)(2 * l + f) * NFF,
                                  (const float*)(ws + WS_SB) + (size_t)l * SB_LAYER + (f ? SB_J2 : 0), NFF, (const float*)(ws + WS_Q + Q_ACT) + 2 * (2 * l + f)};
                pg8::gemm_phase<pg8::EpiSwiGLUQ, pg8::StaticOrder, true, true, true>(lds, g, S, E); }
            if (IN(fb + 0) && IN(fb + 2)) xcd_barrier(bar);
            if (IN(fb + 2)) { PH_BEGIN; float* X = out + O_X; const bool first = (l == 0 && f == 0); const unsigned char* WL8 = ws + WS_W + (size_t)l * W_LAYER + W_WO + (size_t)f * 22 * MiB;
                const float* tabf = (const float*)(ws + WS_TAB); const float* mod = tabf + TB_MOD + (size_t)l * NCOND * NMODC;
                pg8::Gemm g{(const bf16*)(ws + WS_A8B), (const bf16*)WL8, MTOK, DM, DFF / 2}; pg8::StaticOrder S; S.init(MTOK, DM, G, wg);
                const int ni = f ? 3 * (l + 1) : 3 * l + 1;
                const size_t rs_off = WS_RS + (size_t)ni * MTOK * 8;
                pg8::EpiResidN E{first ? inp[0] : X, first ? inp[1] - (size_t)M_P * DM : X, X, mod + (2 + 6 * f) * DM,
                                 inp[11] + (size_t)(f ? 3 : 3 * l + 1) * DM, f ? tabf + TB_MOD + (size_t)NCOND * NMODC + DM : mod + (size_t)4 * DM, (unsigned long long*)(ws + rs_off), (long)(f ? WS_ACT : WS_XN) - (long)rs_off, 0.5f, (f && l) ? 0 : 1,
                                 (long)(WS_Q + Q_ACT + (size_t)(2 * (2 * l + f) + 1) * 4) - (long)rs_off, (long)(WS_Q + Q_SW2 + (size_t)(2 * l + f) * DM * 4) - (long)rs_off, 2, 1, (long)(WS_CTL + CTL_AMAX + (size_t)ni * MTOK * 4) - (long)rs_off};
                pg8::gemm_phase<pg8::EpiResidN, pg8::StaticOrder, true, true, 2>(lds, g, S, E); }
            SEAM(fb + 2);
            if (f == 1) {
                if (l == 0 && IN(pb + 12)) { PH_BEGIN; float* X = out + O_X;
                    (void)X; quant_xs_phase((const bf16*)(ws + WS_ACT), (const unsigned*)(ws + WS_CTL + CTL_AMAX) + (size_t)3 * MTOK, ws + WS_XNB, (float*)(ws + WS_Q), G, wg, tid); }
                SEAM(pb + 12);
                break; }
            if (IN(pb + 3)) { PH_BEGIN; float* X = out + O_X;
                (void)X; quant_xs_phase((const bf16*)(ws + WS_XN), (const unsigned*)(ws + WS_CTL + CTL_AMAX) + (size_t)(3 * l + 1) * MTOK, ws + WS_XNB, (float*)(ws + WS_Q), G, wg, tid, M_P); }
            SEAM(pb + 3);
            if (IN(pb + 4)) {
                { PH_BEGIN; (void)out; (void)inp;
                  pg8::Gemm g{(const bf16*)(ws + WS_XNB + (size_t)M_P * DM), (const bf16*)(ws + WS_W + (size_t)l * W_LAYER + W_WINQ), M_S, NIN, DM / 2}; pg8::StaticOrder S; S.init(M_S, NIN, G, wg);
                  pg8::EpiStoreQ E{(bf16*)(ws + WS_ACT) + (size_t)M_P * NIN, NIN, (const unsigned long long*)(ws + WS_RS) + (size_t)(3 * l + 1) * MTOK + M_P, (const float*)(ws + WS_Q) + M_P,
                                   (const float*)(ws + WS_Q + Q_SW4) + (size_t)l * NIN, (const float*)(ws + WS_SB) + (size_t)l * SB_LAYER + SB_J1, NIN, 16};
                  pg8::gemm_phase<pg8::EpiStoreQ, pg8::StaticOrder, true, true, true>(lds, g, S, E); }
                { PH_BEGIN; (void)out; (void)inp; const bf16* WL = (const bf16*)(ws + WS_W + (size_t)l * W_LAYER);
                  pg8::Gemm g{(const bf16*)(ws + WS_XN), WL + W_WIN / 2, M_P, NIN, DM}; pg8::StaticOrder S; S.init(M_P, NIN, G, wg);
                  pg8::EpiStoreBf16N E{(bf16*)(ws + WS_ACT), NIN, (const unsigned long long*)(ws + WS_RS) + (size_t)(3 * l + 1) * MTOK, (const float*)(ws + WS_SB) + (size_t)l * SB_LAYER + SB_J1, NIN};
                  pg8::gemm_phase<pg8::EpiStoreBf16N, pg8::StaticOrder, true, true>(lds, g, S, E); }
            }
            SEAM(pb + 4);
            if (IN(pb + 5)) { PH_BEGIN; bf16* PROJ = (bf16*)(ws + WS_ACT); const float* tab = (const float*)(ws + WS_TAB);
#pragma unroll 1
                for (int ch = wg; ch < 192; ch += G) {
                    const bool lat = ch < 64; const int cc = lat ? ch : ch - 64, dir = cc & 1, h = (cc >> 1) & 3, b = cc >> 3;
                    att::ChainArgs a; a.P = PROJ + (size_t)(lat ? M_P + b * 4096 : b * 256) * NIN; a.kcol = C_RK + 128 * h; a.vcol = C_RV + 128 * h; a.nchunk = lat ? 32 : 2; a.dir = dir;
                    a.lg2 = tab[TB_SCAL + 16 * l + 2 + dir * 4 + h];
                    a.S0 = lat ? inp[3] + ((((size_t)b * 2 + l) * 2 + dir) * 4 + h) * 16384 : nullptr;
                    a.ST = (bf16*)(ws + WS_ST) + (lat ? (size_t)cc * 32 * 16384 : (size_t)64 * 32 * 16384 + (size_t)cc * 2 * 16384);
                    a.Sfin = lat ? nullptr : out + O_STATE + ((((size_t)b * 2 + l) * 2 + dir) * 4 + h) * 16384;
                    __syncthreads(); att::ret_chain(a, (char*)lds_raw);
                }
                const int w0 = G > 128 ? 64 : 0, gw = (wg - w0) * 8 + wave, NGW = (G - w0) * 8;
                if (wg >= w0) for (int m = gw; m < MTOK; m += NGW) prep_row(m, l, PROJ, PROJ, tab, inp[18] + l * 256, out, lane);
            }
            SEAM(pb + 5);
            if (IN(pb + 6)) { PH_BEGIN; (void)out; bf16* PROJ = (bf16*)(ws + WS_ACT); bf16* MIX = (bf16*)(ws + WS_XN); const float* tab = (const float*)(ws + WS_TAB);
                const bf16* CGK = (const bf16*)(ws + WS_CACHE);
#pragma unroll 1
                for (int rp = 0; rp < ((PROBE == 13 && l == 0) ? 2 : 1); ++rp)
#pragma unroll 1
                for (int i2 = 0;; ++i2) { const int ps = i2 & 1; const int u = deal_unit(i2 >> 1, 512, 64, 192, G, wg); if (u < 0) break;
                    const bool lat = u < 512; const int v = lat ? u : u - 512;
                    const int qb = lat ? (v & 15) : 0, h = lat ? ((v >> 4) & 3) : (v & 3), b = lat ? (v >> 6) : (v >> 2);
                    const size_t row0 = lat ? (size_t)M_P + (size_t)b * 4096 : (size_t)b * 256;
                    const float lam = tab[TB_SCAL + 16 * l + 0], post = tab[TB_SCAL + 16 * l + 1];
                    {
                        att::KVSrc kv; kv.K1 = PROJ + row0 * NIN + C_DK + 128 * h + 64 * ps; kv.V1 = PROJ + row0 * NIN + C_DV + 128 * h; kv.n1 = lat ? 4096 : 256;
                        kv.K2 = CGK + 2097152 + ((size_t)(b * 2 + l) * 256) * 512 + 128 * h + 64 * ps; kv.V2 = CGK + 4194304 + ((size_t)(b * 2 + l) * 256) * 512 + 128 * h; kv.n2 = lat ? 256 : 0;
                        att::AttnOut ao; ao.Ob = MIX + (row0 + 256 * qb) * DM + 1536 + 128 * h; ao.Of = (float*)(ws + WS_DF) + (row0 + 256 * qb) * 512 + 128 * h;
                        ao.nw = inp[20] + l * 512 + 128 * h; ao.lam = lam; ao.post = post; ao.pass = ps;
                        __syncthreads();
                        att::attn_body<64, 1, 512>(PROJ + (row0 + 256 * qb) * NIN + C_DQ + 128 * h + 64 * ps, kv, ao, (char*)lds_raw);
                    }
                }
                const bool nomax = tab[TB_SCAL + 16 * l + 10] != 0.f;
#pragma unroll 1
                for (int rp = 0; rp < ((PROBE == 14 && l == 0) ? 2 : 1); ++rp)
#pragma unroll 1
                for (int i = 0;; ++i) { const int u = deal_unit(i, 1024, 128, 64, G, wg); if (u < 0) break;
                    const bool lat = u < 1024; const int v = lat ? u : u - 1024;
                    const int qb = lat ? (v & 15) : 0, hq = lat ? ((v >> 4) & 7) : (v & 7), b = lat ? (v >> 7) : (v >> 3), kvh = hq >> 2;
                    const size_t row0 = lat ? (size_t)M_P + (size_t)b * 4096 : (size_t)b * 256;
                    att::KVSrc kv; kv.K1 = PROJ + row0 * NIN + C_GK + 128 * kvh; kv.V1 = PROJ + row0 * NIN + C_GV + 128 * kvh; kv.n1 = lat ? 4096 : 256;
                    kv.K2 = CGK + ((size_t)(b * 2 + l) * 256) * 256 + 128 * kvh; kv.V2 = CGK + 1048576 + ((size_t)(b * 2 + l) * 256) * 256 + 128 * kvh; kv.n2 = lat ? 256 : 0;
                    att::AttnOut ao; ao.Ob = MIX + (row0 + 256 * qb) * DM + 512 + 128 * hq; ao.Of = nullptr; ao.nw = nullptr; ao.lam = 0.f; ao.post = 0.f; ao.pass = 0;
                    __syncthreads();
                    if (nomax) att::attn_body<128, 0, 256, 1>(PROJ + (row0 + 256 * qb) * NIN + C_GQ + 128 * hq, kv, ao, (char*)lds_raw);
                    else att::attn_body<128, 0, 256, 2>(PROJ + (row0 + 256 * qb) * NIN + C_GQ + 128 * hq, kv, ao, (char*)lds_raw);
                }
#pragma unroll 1
                for (int rp = 0; rp < ((PROBE == 15 && l == 0) ? 2 : 1); ++rp)
#pragma unroll 1
                for (int i = 0;; ++i) { const int u = deal_unit(i, 512, 64, 0, G, wg); if (u < 0) break;
                    const bool lat = u < 512; const int v = lat ? u : u - 512;
                    const int pr = lat ? (v & 15) : 0, h = lat ? ((v >> 4) & 3) : (v & 3), b = lat ? (v >> 6) : (v >> 2);
                    const size_t row0 = (lat ? (size_t)M_P + (size_t)b * 4096 : (size_t)b * 256) + 256 * pr;
                    att::RetCArgs a; a.P = PROJ + row0 * NIN; a.qcol = C_RQ + 128 * h; a.kcol = C_RK + 128 * h; a.vcol = C_RV + 128 * h; a.gcol = C_RG + 128 * h;
                    a.lg2f = tab[TB_SCAL + 16 * l + 2 + h]; a.lg2b = tab[TB_SCAL + 16 * l + 6 + h];
                    const int cf = (b * 4 + h) * 2; const bf16* STB = (const bf16*)(ws + WS_ST);
                    a.STf = STB + (lat ? (size_t)cf * 32 * 16384 : (size_t)64 * 32 * 16384 + (size_t)cf * 2 * 16384) + (size_t)(2 * pr) * 16384;
                    a.STb = STB + (lat ? (size_t)(cf + 1) * 32 * 16384 : (size_t)64 * 32 * 16384 + (size_t)(cf + 1) * 2 * 16384) + (size_t)(2 * pr) * 16384;
                    a.gnw = inp[17] + l * 512 + 128 * h; a.O = MIX + row0 * DM + 128 * h;
                    __syncthreads();
                    att::ret_c(a, (char*)lds_raw);
                }
            }
            SEAM(pb + 6);
            if (IN(pb + 7)) { PH_BEGIN; float* X = out + O_X; const bf16* WL = (const bf16*)(ws + WS_W + (size_t)l * W_LAYER);
                const float* mod = (const float*)(ws + WS_TAB) + TB_MOD + (size_t)l * NCOND * NMODC;
                pg8::Gemm g{(const bf16*)(ws + WS_XN), WL + W_WOUT / 2, MTOK, DM, DM}; pg8::StaticOrder S; S.init(MTOK, DM, G, wg);
                const size_t rs_off = WS_RS + (size_t)(3 * l + 2) * MTOK * 8;
                pg8::EpiResidN E{X, X, X, mod + 5 * DM, inp[11] + ((size_t)l * 3 + 2) * DM, mod + 7 * DM, (unsigned long long*)(ws + rs_off), (long)WS_ACT - (long)rs_off, 1.0f, 1, (long)WS_Q - (long)rs_off, (long)WS_Q - (long)rs_off, 0, 1, (long)(WS_CTL + CTL_AMAX + (size_t)(3 * l + 2) * MTOK * 4) - (long)rs_off};
                pg8::gemm_phase<pg8::EpiResidN, pg8::StaticOrder, true, true>(lds, g, S, E); }
            SEAM(pb + 7);
            if (IN(pb + 8)) { PH_BEGIN; float* X = out + O_X;
                (void)X; quant_xs_phase((const bf16*)(ws + WS_ACT), (const unsigned*)(ws + WS_CTL + CTL_AMAX) + (size_t)(3 * l + 2) * MTOK, ws + WS_XNB, (float*)(ws + WS_Q), G, wg, tid); }
            SEAM(pb + 8);
        }
    }
    if (IN(29)) { PH_BEGIN; (void)ws; final_norm(out + O_X, inp[21], G, wg, tid); }
#undef IN
#undef SEAM
#undef PH_BEGIN
}

extern "C" void kernel_launch(void* const* d_in, const int* in_sizes, int n_in, void* d_out, int out_size, void* d_ws, size_t ws_size, hipStream_t stream) {
    static int grid = 0;
    if (grid == 0) {
        if (n_in != 22 || out_size != (int)O_END || ws_size < WS_END) { fprintf(stderr, "kernel_launch: unexpected shapes: n_in %d out %d ws %zu (need %zu)\n", n_in, out_size, ws_size, (size_t)WS_END); grid = -1; return; }
        int dev = 0, cus = 0, per_cu = 0;
        if (hipGetDevice(&dev) != hipSuccess || hipDeviceGetAttribute(&cus, hipDeviceAttributeMultiprocessorCount, dev) != hipSuccess) { grid = -1; return; }
        if (hipFuncSetAttribute((const void*)fwd_kernel, hipFuncAttributeMaxDynamicSharedMemorySize, LDS_BYTES) != hipSuccess) { fprintf(stderr, "kernel_launch: hipFuncSetAttribute failed\n"); grid = -1; return; }
        if (hipOccupancyMaxActiveBlocksPerMultiprocessor(&per_cu, (const void*)fwd_kernel, 512, LDS_BYTES) != hipSuccess || per_cu < 1) { fprintf(stderr, "kernel_launch: occupancy query says %d\n", per_cu); }
        (void)hipGetLastError();
        grid = cus;
    }
    if (grid < 0) return;
    (void)hipMemsetAsync((char*)d_ws + WS_CTL, 0, CTL_ZERO_BYTES, stream);
    (void)hipMemsetAsync((char*)d_ws + WS_RS, 0, 2 * MiB, stream);
    Args a{};
    for (int i = 0; i < 22; ++i) a.in[i] = (const float*)d_in[i];
    a.out = (float*)d_out; a.ws = (unsigned char*)d_ws; a.ph_lo = 0; a.ph_hi = NPHASE; a.pad0 = 0; a.pad1 = 0;
    hipLaunchKernelGGL(fwd_kernel, dim3(grid), dim3(512), LDS_BYTES, stream, a);
}
```

```cpp
#include <hip/hip_runtime.h>
#include <hip/hip_bf16.h>
#include <cstdio>
#include <cstdint>
#ifndef PROBE
#define PROBE 0
#endif
#ifndef FFN_MB
#define FFN_MB 4
#endif
__device__ __forceinline__ float qm(float x) { if (FFN_MB >= 7) return x; unsigned u = __float_as_uint(x); constexpr unsigned sh = 23 - FFN_MB; u = (u + ((1u << (sh - 1)) - 1u) + ((u >> sh) & 1u)) & ~((1u << sh) - 1u); return __uint_as_float(u); }
#ifndef DBGT_CLK
#define DBGT_CLK 0
#endif
#ifndef DBGT_PH
#define DBGT_PH -1
#endif
namespace pg8 {
#define PG8_LAS __attribute__((address_space(3)))
typedef unsigned short bf16_t;
typedef short bf16x8 __attribute__((ext_vector_type(8)));
typedef float f32x4 __attribute__((ext_vector_type(4)));
typedef unsigned u32x4 __attribute__((ext_vector_type(4)));
typedef int i32x4 __attribute__((ext_vector_type(4)));
constexpr int BM = 256, BK = 64, HALF = 128, HTB = HALF * BK * 2  , STAGE_BYTES = 8 * HTB, NXCD = 8, WGM = 4;

__host__ __device__ __forceinline__ int lds_byte(int r, int c) { const int st = (r >> 4) * 2 + (c >> 5), rr = r & 15, cc = c & 31, ob = rr * 64 + cc * 2; return st * 1024 + (ob ^ (((ob >> 9) & 1) << 5)); }
__host__ __device__ __forceinline__ void stage_rc(int b, int& R, int& C) { const int st = b / 1024, sb = b % 1024, swz = sb ^ (((sb >> 9) & 1) << 5); R = (st >> 1) * 16 + swz / 64; C = (st & 1) * 32 + (swz % 64) / 2; }
__host__ __device__ __forceinline__ int perm32(int rho) { const int n = rho >> 4, i = rho & 15; return 8 * (i >> 2) + 4 * n + (i & 3); }

struct Unit { int pm, pn; };
struct Gemm { const bf16_t* A; const bf16_t* Bt; int M, N, K; };

struct StaticOrder {
    int nM, nN, nwg, G, c;
    __host__ __device__ void init(int M, int N, int G_, int c_) { nM = M / BM; nN = N / BM; nwg = nM * nN; G = G_; c = c_; }
    __host__ __device__ bool next(int i, Unit& u) const {
        const long L = (long)i * G + c; if (L >= nwg) return false;
        int wgid = (int)L; { const int q = nwg / NXCD, r = nwg % NXCD, xcd = wgid % NXCD, off = wgid / NXCD; wgid = (xcd < r ? xcd * (q + 1) : r * (q + 1) + (xcd - r) * q) + off; }
        const int nig = WGM * nN, gid = wgid / nig, fm = gid * WGM, gsz = (nM - fm) < WGM ? (nM - fm) : WGM;
        u.pm = fm + ((wgid % nig) % gsz); u.pn = (wgid % nig) / gsz; return true;
    }
    __device__ __forceinline__ void a_ready(const Unit&) const {}
    __device__ __forceinline__ void done(const Unit&) const {}
};

__device__ __forceinline__ unsigned cvt_pk_bf16(float lo, float hi) { unsigned r; asm volatile("v_cvt_pk_bf16_f32 %0, %1, %2" : "=v"(r) : "v"(lo), "v"(hi)); return r; }
typedef float f32x2 __attribute__((ext_vector_type(2)));
struct EpiStoreBf16 {
    static constexpr bool PERM = true, AFTER_DRAIN = false;
    bf16_t* O; int ldc;
    __device__ __forceinline__ void operator()(const f32x4 (&acc)[2][2][4][2], const Unit& u, int wr, int wc, int fr, int fq) const {
        const int row0 = u.pm * BM + wr * 64 + fr, col0 = u.pn * BM + wc * 32 + 8 * fq;
#pragma unroll
        for (int ai = 0; ai < 2; ++ai)
#pragma unroll
            for (int m = 0; m < 4; ++m) { bf16_t* rowp = O + (size_t)(row0 + ai * HALF + m * 16) * ldc + col0;
#pragma unroll
                for (int bj = 0; bj < 2; ++bj) { const f32x4 v0 = acc[ai][bj][m][0], v1 = acc[ai][bj][m][1];
                    u32x4 w; w.x = cvt_pk_bf16(v0[0], v0[1]); w.y = cvt_pk_bf16(v0[2], v0[3]); w.z = cvt_pk_bf16(v1[0], v1[1]); w.w = cvt_pk_bf16(v1[2], v1[3]);
                    *(u32x4*)(rowp + bj * HALF) = w; } }
    }
};
__device__ __forceinline__ float silu_f(float g) { return g * __builtin_amdgcn_rcpf(1.0f + __builtin_amdgcn_exp2f(-1.4426950408889634f * g)); }
struct EpiSwiGLU {
    static constexpr bool PERM = true, AFTER_DRAIN = false;
    bf16_t* O; int ldc;
    __device__ __forceinline__ void operator()(const f32x4 (&acc)[2][2][4][2], const Unit& u, int wr, int wc, int fr, int fq) const {
        const int row0 = u.pm * BM + wr * 64 + fr, col0 = u.pn * HALF + wc * 32 + 8 * fq;
#pragma unroll
        for (int ai = 0; ai < 2; ++ai)
#pragma unroll
            for (int m = 0; m < 4; ++m) { bf16_t* rowp = O + (size_t)(row0 + ai * HALF + m * 16) * ldc + col0;
                const f32x4 g0 = acc[ai][0][m][0], g1 = acc[ai][0][m][1], u0 = acc[ai][1][m][0], u1 = acc[ai][1][m][1];
                u32x4 w; w.x = cvt_pk_bf16(silu_f(g0[0]) * u0[0], silu_f(g0[1]) * u0[1]); w.y = cvt_pk_bf16(silu_f(g0[2]) * u0[2], silu_f(g0[3]) * u0[3]);
                w.z = cvt_pk_bf16(silu_f(g1[0]) * u1[0], silu_f(g1[1]) * u1[1]); w.w = cvt_pk_bf16(silu_f(g1[2]) * u1[2], silu_f(g1[3]) * u1[3]);
                *(u32x4*)rowp = w; }
    }
};
struct EpiResid {
    static constexpr bool PERM = false, AFTER_DRAIN = false;
    const float* baseP; const float* baseS; float* out; const float* gate; float coef;
    __device__ __forceinline__ void operator()(const f32x4 (&acc)[2][2][4][2], const Unit& u, int wr, int wc, int fr, int fq) const {
        const int cond = u.pm < 16 ? 0 : 1 + ((u.pm - 16) >> 4);
        const float* g = gate + (size_t)cond * 18432; const float* base = u.pm < 16 ? baseP : baseS;
        const int row0 = u.pm * BM + wr * 64 + fr, col0 = u.pn * BM + wc * 32 + 4 * fq;
        f32x4 gv[2][2];
#pragma unroll
        for (int bj = 0; bj < 2; ++bj)
#pragma unroll
            for (int n = 0; n < 2; ++n) gv[bj][n] = *(const f32x4*)(g + col0 + bj * HALF + n * 16) * coef;
#pragma unroll
        for (int ai = 0; ai < 2; ++ai)
#pragma unroll
            for (int m = 0; m < 4; ++m) { const size_t off = (size_t)(row0 + ai * HALF + m * 16) * 2048 + col0;
#pragma unroll
                for (int bj = 0; bj < 2; ++bj)
#pragma unroll
                    for (int n = 0; n < 2; ++n) { const f32x4 b = *(const f32x4*)(base + off + bj * HALF + n * 16);
                        *(f32x4*)(out + off + bj * HALF + n * 16) = b + gv[bj][n] * acc[ai][bj][m][n]; }
                if (m == 3) asm volatile("" ::: "memory"); }
    }
};

__device__ __forceinline__ float rstd_of(const unsigned long long* rss, int row) { return rsqrtf((float)rss[row] * (1.0f / 16777216.0f) * (1.0f / 2048.0f) + 1e-6f); }
struct EpiStoreBf16N {
    static constexpr bool PERM = true, AFTER_DRAIN = false;
    bf16_t* O; int ldc; const unsigned long long* rss; const float* bias; int ldb;
    __device__ __forceinline__ void operator()(const f32x4 (&acc)[2][2][4][2], const Unit& u, int wr, int wc, int fr, int fq) const {
        const int cond = u.pm < 16 ? 0 : 1 + ((u.pm - 16) >> 4);
        const int row0 = u.pm * BM + wr * 64 + fr, col0 = u.pn * BM + wc * 32 + 8 * fq;
        const float* b = bias + (size_t)cond * ldb + col0;
        f32x4 bv[2][2];
#pragma unroll
        for (int bj = 0; bj < 2; ++bj)
#pragma unroll
            for (int n = 0; n < 2; ++n) bv[bj][n] = *(const f32x4*)(b + bj * HALF + 4 * n);
#pragma unroll
        for (int ai = 0; ai < 2; ++ai)
#pragma unroll
            for (int m = 0; m < 4; ++m) { const int row = row0 + ai * HALF + m * 16; const float rs = rstd_of(rss, row); bf16_t* rowp = O + (size_t)row * ldc + col0;
#pragma unroll
                for (int bj = 0; bj < 2; ++bj) { const f32x4 v0 = acc[ai][bj][m][0] * rs + bv[bj][0], v1 = acc[ai][bj][m][1] * rs + bv[bj][1];
                    u32x4 w; w.x = cvt_pk_bf16(v0[0], v0[1]); w.y = cvt_pk_bf16(v0[2], v0[3]); w.z = cvt_pk_bf16(v1[0], v1[1]); w.w = cvt_pk_bf16(v1[2], v1[3]);
                    *(u32x4*)(rowp + bj * HALF) = w; } }
    }
};
struct EpiSwiGLUN {
    static constexpr bool PERM = true, AFTER_DRAIN = false;
    bf16_t* O; int ldc; const unsigned long long* rss; const float* bias; int ldb;
    __device__ __forceinline__ void operator()(const f32x4 (&acc)[2][2][4][2], const Unit& u, int wr, int wc, int fr, int fq) const {
        const int cond = u.pm < 16 ? 0 : 1 + ((u.pm - 16) >> 4);
        const int row0 = u.pm * BM + wr * 64 + fr, col0 = u.pn * HALF + wc * 32 + 8 * fq;
        const float* b = bias + (size_t)cond * ldb + u.pn * BM + wc * 32 + 8 * fq;
        const f32x4 bg0 = *(const f32x4*)(b), bg1 = *(const f32x4*)(b + 4), bu0 = *(const f32x4*)(b + HALF), bu1 = *(const f32x4*)(b + HALF + 4);
#pragma unroll
        for (int ai = 0; ai < 2; ++ai)
#pragma unroll
            for (int m = 0; m < 4; ++m) { const int row = row0 + ai * HALF + m * 16; const float rs = rstd_of(rss, row); bf16_t* rowp = O + (size_t)row * ldc + col0;
                const f32x4 g0 = acc[ai][0][m][0] * rs + bg0, g1 = acc[ai][0][m][1] * rs + bg1, u0 = acc[ai][1][m][0] * rs + bu0, u1 = acc[ai][1][m][1] * rs + bu1;
                u32x4 w; w.x = cvt_pk_bf16(qm(silu_f(g0[0]) * u0[0]), qm(silu_f(g0[1]) * u0[1])); w.y = cvt_pk_bf16(qm(silu_f(g0[2]) * u0[2]), qm(silu_f(g0[3]) * u0[3]));
                w.z = cvt_pk_bf16(qm(silu_f(g1[0]) * u1[0]), qm(silu_f(g1[1]) * u1[1])); w.w = cvt_pk_bf16(qm(silu_f(g1[2]) * u1[2]), qm(silu_f(g1[3]) * u1[3]));
                *(u32x4*)rowp = w; }
    }
};
struct EpiStoreQ {
    static constexpr bool PERM = true, AFTER_DRAIN = false;
    bf16_t* O; int ldc; const unsigned long long* rss; const float* sa; const float* sw; const float* bias; int ldb; int pm_off;
    __device__ __forceinline__ void operator()(const f32x4 (&acc)[2][2][4][2], const Unit& u, int wr, int wc, int fr, int fq) const {
        const int pmg = u.pm + pm_off, cond = pmg < 16 ? 0 : 1 + ((pmg - 16) >> 4);
        const int row0 = u.pm * BM + wr * 64 + fr, col0 = u.pn * BM + wc * 32 + 8 * fq;
        const float* b = bias + (size_t)cond * ldb + col0; const float* w = sw + col0;
        f32x4 bv[2][2], wv[2][2];
#pragma unroll
        for (int bj = 0; bj < 2; ++bj)
#pragma unroll
            for (int n = 0; n < 2; ++n) { bv[bj][n] = *(const f32x4*)(b + bj * HALF + 4 * n); wv[bj][n] = *(const f32x4*)(w + bj * HALF + 4 * n); }
#pragma unroll
        for (int ai = 0; ai < 2; ++ai)
#pragma unroll
            for (int m = 0; m < 4; ++m) { const int row = row0 + ai * HALF + m * 16; const float rs = rstd_of(rss, row) * sa[row]; bf16_t* rowp = O + (size_t)row * ldc + col0;
#pragma unroll
                for (int bj = 0; bj < 2; ++bj) { const f32x4 v0 = acc[ai][bj][m][0] * rs * wv[bj][0] + bv[bj][0], v1 = acc[ai][bj][m][1] * rs * wv[bj][1] + bv[bj][1];
                    u32x4 w4; w4.x = cvt_pk_bf16(v0[0], v0[1]); w4.y = cvt_pk_bf16(v0[2], v0[3]); w4.z = cvt_pk_bf16(v1[0], v1[1]); w4.w = cvt_pk_bf16(v1[2], v1[3]);
                    *(u32x4*)(rowp + bj * HALF) = w4; } }
    }
};
__device__ __forceinline__ float sat448(float x) { return __builtin_fminf(__builtin_fmaxf(x, -448.0f), 448.0f); }
__device__ __forceinline__ f32x4 swiglu4(const f32x4 g, const f32x4 u) {
    const f32x4 t = g * -1.4426950408889634f; f32x4 e;
#pragma unroll
    for (int i = 0; i < 4; ++i) e[i] = __builtin_amdgcn_exp2f(t[i]);
    const f32x4 d = e + 1.0f; f32x4 r;
#pragma unroll
    for (int i = 0; i < 4; ++i) r[i] = __builtin_amdgcn_rcpf(d[i]);
    return (g * u) * r;
}
struct EpiSwiGLUQ {
    static constexpr bool PERM = true, AFTER_DRAIN = false;
    unsigned char* O; int ldc; const unsigned long long* rss; const float* sa; const float* sw; const float* bias; int ldb; const float* act_s;
    __device__ __forceinline__ void operator()(const f32x4 (&acc)[2][2][4][2], const Unit& u, int wr, int wc, int fr, int fq) const {
        const int cond = u.pm < 16 ? 0 : 1 + ((u.pm - 16) >> 4);
        const int row0 = u.pm * BM + wr * 64 + fr, col0 = u.pn * HALF + wc * 32 + 8 * fq, bcol = u.pn * BM + wc * 32 + 8 * fq;
        const float* b = bias + (size_t)cond * ldb + bcol; const float* w = sw + bcol;
        const f32x4 bg0 = *(const f32x4*)(b), bg1 = *(const f32x4*)(b + 4), bu0 = *(const f32x4*)(b + HALF), bu1 = *(const f32x4*)(b + HALF + 4);
        const f32x4 wg0 = *(const f32x4*)(w), wg1 = *(const f32x4*)(w + 4), wu0 = *(const f32x4*)(w + HALF), wu1 = *(const f32x4*)(w + HALF + 4);
        const float as = act_s[0];
#pragma unroll
        for (int ai = 0; ai < 2; ++ai)
#pragma unroll
            for (int m = 0; m < 4; ++m) { const int row = row0 + ai * HALF + m * 16; const float rs = rstd_of(rss, row) * sa[row]; unsigned char* rowp = O + (size_t)row * ldc + col0;
                const f32x4 g0 = acc[ai][0][m][0] * rs * wg0 + bg0, g1 = acc[ai][0][m][1] * rs * wg1 + bg1, u0 = (acc[ai][1][m][0] * rs * wu0 + bu0) * as, u1 = (acc[ai][1][m][1] * rs * wu1 + bu1) * as;
                const f32x4 h0 = swiglu4(g0, u0), h1 = swiglu4(g1, u1);
                unsigned w0 = __builtin_amdgcn_cvt_pk_fp8_f32(sat448(h0[0]), sat448(h0[1]), 0, false); w0 = __builtin_amdgcn_cvt_pk_fp8_f32(sat448(h0[2]), sat448(h0[3]), w0, true);
                unsigned w1 = __builtin_amdgcn_cvt_pk_fp8_f32(sat448(h1[0]), sat448(h1[1]), 0, false); w1 = __builtin_amdgcn_cvt_pk_fp8_f32(sat448(h1[2]), sat448(h1[3]), w1, true);
                uint2 wv; wv.x = w0; wv.y = w1; *(uint2*)rowp = wv; }
    }
};
struct EpiResidN {
    static constexpr bool PERM = false, AFTER_DRAIN = false;
    const float* baseP; const float* baseS; float* out; const float* gate; const float* nw; const float* scl; unsigned long long* rss; long xs_delta;   float coef; int do_xs; long sa_delta, sw_delta; int q8; int xs_all = 0; long am_delta = 0;
    __device__ __forceinline__ void operator()(const f32x4 (&acc)[2][2][4][2], const Unit& u, int wr, int wc, int fr, int fq) const {
        const int cond = u.pm < 16 ? 0 : 1 + ((u.pm - 16) >> 4); const int do_xs = (this->do_xs && (xs_all || u.pm < 16)) ? this->do_xs : 0;     bf16_t* xs = (bf16_t*)((char*)rss + xs_delta); const float* sa = (const float*)((char*)rss + sa_delta); const float* swc = (const float*)((char*)rss + sw_delta);
        const float* g = gate + (size_t)cond * 18432; const float* base = u.pm < 16 ? baseP : baseS;
        const int row0 = u.pm * BM + wr * 64 + fr, col0 = u.pn * BM + wc * 32 + 4 * fq;
        f32x4 gv[2][2], av[2][2];
#pragma unroll
        for (int bj = 0; bj < 2; ++bj)
#pragma unroll
            for (int n = 0; n < 2; ++n) { gv[bj][n] = *(const f32x4*)(g + col0 + bj * HALF + n * 16); av[bj][n] = q8 ? *(const f32x4*)(swc + col0 + bj * HALF + n * 16) : (f32x4){1.f, 1.f, 1.f, 1.f}; }
        f32x4 t0[2][2], t1[2][2];
#pragma unroll
        for (int bj = 0; bj < 2; ++bj)
#pragma unroll
            for (int n = 0; n < 2; ++n) { t0[bj][n] = do_xs ? *(const f32x4*)(nw + col0 + bj * HALF + n * 16) : (f32x4){0.f, 0.f, 0.f, 0.f}; t1[bj][n] = do_xs ? *(const f32x4*)(scl + (size_t)cond * 18432 + col0 + bj * HALF + n * 16) : (f32x4){0.f, 0.f, 0.f, 0.f}; }
#pragma unroll
        for (int bj = 0; bj < 2; ++bj)
#pragma unroll
            for (int n = 0; n < 2; ++n) { gv[bj][n] = gv[bj][n] * coef * av[bj][n]; av[bj][n] = t0[bj][n] * (t1[bj][n] + 1.0f); }
#pragma unroll
        for (int ai2 = 0; ai2 < 4; ++ai2) { const int ai = ai2 >> 1, m0 = (ai2 & 1) * 2;
            f32x4 bb[2][2][2];
#pragma unroll
            for (int mm = 0; mm < 2; ++mm)
#pragma unroll
                for (int bj = 0; bj < 2; ++bj)
#pragma unroll
                    for (int n = 0; n < 2; ++n) bb[mm][bj][n] = *(const f32x4*)(base + (size_t)(row0 + ai * HALF + (m0 + mm) * 16) * 2048 + col0 + bj * HALF + n * 16);
#pragma unroll
            for (int mm = 0; mm < 2; ++mm) { const int m = m0 + mm; const int row = row0 + ai * HALF + m * 16; const size_t off = (size_t)row * 2048 + col0; float ss = 0.f, amx = 0.f; const float sr = q8 == 2 ? sa[0] : q8 ? sa[row] : 1.0f;
#pragma unroll
                for (int bj = 0; bj < 2; ++bj)
#pragma unroll
                    for (int n = 0; n < 2; ++n) { const f32x4 b = bb[mm][bj][n]; const f32x4 o = b + gv[bj][n] * (acc[ai][bj][m][n] * sr);
                        *(f32x4*)(out + off + bj * HALF + n * 16) = o;
                        if (do_xs) { f32x4 q = o * av[bj][n]; if (do_xs == 2) { q[0] = qm(q[0]); q[1] = qm(q[1]); q[2] = qm(q[2]); q[3] = qm(q[3]); } ss += (o[0] * o[0] + o[1] * o[1]) + (o[2] * o[2] + o[3] * o[3]); amx = fmaxf(fmaxf(amx, fmaxf(fabsf(q[0]), fabsf(q[1]))), fmaxf(fabsf(q[2]), fabsf(q[3])));
                            uint2 w2; w2.x = cvt_pk_bf16(q[0], q[1]); w2.y = cvt_pk_bf16(q[2], q[3]); *(uint2*)(xs + off + bj * HALF + n * 16) = w2; } }
                if (do_xs) { ss += __shfl_xor(ss, 16); ss += __shfl_xor(ss, 32); if (fq == 0) atomicAdd(rss + row, (unsigned long long)(ss * 16777216.0f));
                    if (xs_all) { amx = fmaxf(amx, __shfl_xor(amx, 16)); amx = fmaxf(amx, __shfl_xor(amx, 32)); if (fq == 0) atomicMax((unsigned*)((char*)rss + am_delta) + row, __float_as_uint(amx)); } }
                if (mm == 1) asm volatile("" ::: "memory"); } }
    }
};
typedef int i32x8 __attribute__((ext_vector_type(8)));
__device__ __forceinline__ void mfma_f8_128(f32x4& c, const i32x8 a, const i32x8 b) { asm volatile("v_mfma_f32_16x16x128_f8f6f4 %0, %1, %2, %0" : "+v"(c) : "v"(a), "v"(b)); }
template <class Epi, class Sched, bool ALIGN_EPI = false, bool SP2 = false, int I8 = 0>
__device__ __forceinline__ void gemm_phase(PG8_LAS unsigned char* lds, const Gemm g, const Sched& S, const Epi& E) {
    int tid_ = threadIdx.x; asm volatile("" : "+v"(tid_));
    const int tid = tid_, wid = __builtin_amdgcn_readfirstlane(tid >> 6), lane = tid & 63, wr = wid >> 2, wc = wid & 3, fr = lane & 15, fq = lane >> 4;
    const int K = g.K, nt = K / BK;
    unsigned voffA[2], voffB[2];
#pragma unroll
    for (int i = 0; i < 2; ++i) { int R, C; stage_rc(tid * 16 + i * 8192, R, C); const int Rb = Epi::PERM ? ((R & ~31) + perm32(R & 31)) : R;
        voffA[i] = (unsigned)(R * K + C) * 2u; voffB[i] = (unsigned)(Rb * BK + C) * 2u; }
    const size_t kstep = (size_t)(BK * 2);
    const size_t hstep = (size_t)HALF * K * 2;
    const size_t tstep = 2 * hstep;
    const size_t kstepB = (size_t)BM * BK * 2, hstepB = (size_t)HALF * BK * 2;
    const unsigned ldsw = (unsigned)wid * 1024u;
    const int aoff = lds_byte(wr * 64 + fr, fq * 8), boff = lds_byte(wc * 32 + fr, fq * 8);
#define PG8_SA(b, h) (((b) * 2 + (h)) * HTB)
#define PG8_SB(b, h) ((4 + (b) * 2 + (h)) * HTB)
#define PG8_STAGE(bufoff, gbase, voff) do { _Pragma("unroll") for (int _i = 0; _i < 2; ++_i) \
        __builtin_amdgcn_global_load_lds((const unsigned*)((const char*)(gbase) + (voff)[_i]), (PG8_LAS unsigned*)(lds + (bufoff) + ldsw + _i * 8192), 16, 0, 0); } while (0)
#define PG8_LDA(dst, b, h) do { _Pragma("unroll") for (int m = 0; m < 4; ++m) _Pragma("unroll") for (int k = 0; k < 2; ++k) dst[m][k] = *(const PG8_LAS bf16x8*)(lds + PG8_SA(b, h) + aoff + m * 2048 + k * 1024); } while (0)
#define PG8_LDB(dst, b, h) do { _Pragma("unroll") for (int n = 0; n < 2; ++n) _Pragma("unroll") for (int k = 0; k < 2; ++k) dst[n][k] = *(const PG8_LAS bf16x8*)(lds + PG8_SB(b, h) + boff + n * 2048 + k * 1024); } while (0)
#define PG8_MMA(ai, bj, At, Bt) do { __builtin_amdgcn_s_setprio(1); _Pragma("unroll") for (int m = 0; m < 4; ++m) _Pragma("unroll") for (int n = 0; n < 2; ++n) { if constexpr (I8 == 2) { \
        mfma_f8_128(acc[ai][bj][m][n], __builtin_shufflevector(__builtin_bit_cast(i32x4, Bt[n][0]), __builtin_bit_cast(i32x4, Bt[n][1]), 0, 1, 2, 3, 4, 5, 6, 7), \
            __builtin_shufflevector(__builtin_bit_cast(i32x4, At[m][0]), __builtin_bit_cast(i32x4, At[m][1]), 0, 1, 2, 3, 4, 5, 6, 7)); } else _Pragma("unroll") for (int k = 0; k < 2; ++k) { \
        if constexpr (I8 == 1) acc[ai][bj][m][n] = __builtin_bit_cast(f32x4, __builtin_amdgcn_mfma_i32_16x16x64_i8(__builtin_bit_cast(i32x4, Bt[n][k]), __builtin_bit_cast(i32x4, At[m][k]), __builtin_bit_cast(i32x4, acc[ai][bj][m][n]), 0, 0, 0)); \
        else acc[ai][bj][m][n] = __builtin_amdgcn_mfma_f32_16x16x32_bf16(Bt[n][k], At[m][k], acc[ai][bj][m][n], 0, 0, 0); } } __builtin_amdgcn_s_setprio(0); } while (0)
#define PG8_WAIT_V(n) asm volatile("s_waitcnt vmcnt(" #n ")" ::: "memory")
#define PG8_WAIT_L(n) asm volatile("s_waitcnt lgkmcnt(" #n ")" ::: "memory")
#define PG8_BAR __builtin_amdgcn_s_barrier()
#define PG8_SCHED __builtin_amdgcn_sched_barrier(0)
    Unit cur, nxt; int ui = 0;
    if (!S.next(0, cur)) return;
    f32x4 acc[2][2][4][2];
#pragma unroll
    for (int a = 0; a < 2; ++a)
#pragma unroll
        for (int b = 0; b < 2; ++b)
#pragma unroll
            for (int m = 0; m < 4; ++m)
#pragma unroll
                for (int n = 0; n < 2; ++n) acc[a][b][m][n] = (f32x4){0.f, 0.f, 0.f, 0.f};
    bf16x8 At[4][2], B0[2][2], B1[2][2];
    const char* cA = (const char*)g.A + (size_t)cur.pm * tstep; const char* cB = (const char*)g.Bt + (size_t)cur.pn * tstep;
    S.a_ready(cur);
    if constexpr (SP2) {
        PG8_STAGE(PG8_SB(0, 0), cB, voffB); PG8_STAGE(PG8_SB(0, 1), cB + hstepB, voffB); PG8_STAGE(PG8_SA(0, 0), cA, voffA); PG8_STAGE(PG8_SA(0, 1), cA + hstep, voffA);
        if (wr == 1) PG8_BAR;
        PG8_WAIT_V(2); PG8_BAR;
        PG8_STAGE(PG8_SB(1, 0), cB + kstepB, voffB); PG8_STAGE(PG8_SA(1, 0), cA + kstep, voffA); PG8_STAGE(PG8_SB(1, 1), cB + hstepB + kstepB, voffB);
        PG8_WAIT_V(6); PG8_BAR;
    } else {
        PG8_STAGE(PG8_SB(0, 0), cB, voffB); PG8_STAGE(PG8_SA(0, 0), cA, voffA); PG8_STAGE(PG8_SB(0, 1), cB + hstepB, voffB); PG8_STAGE(PG8_SA(0, 1), cA + hstep, voffA);
        if (wr == 1) PG8_BAR;
        PG8_WAIT_V(4); PG8_BAR;
        PG8_STAGE(PG8_SB(1, 0), cB + kstepB, voffB); PG8_STAGE(PG8_SA(1, 0), cA + kstep, voffA); PG8_STAGE(PG8_SB(1, 1), cB + hstepB + kstepB, voffB);
        PG8_WAIT_V(6); PG8_BAR;
    }
    for (;;) {
        const bool has_next = S.next(ui + 1, nxt);
        const char* nA = has_next ? (const char*)g.A + (size_t)nxt.pm * tstep : cA; const char* nB = has_next ? (const char*)g.Bt + (size_t)nxt.pn * tstep : cB;
        for (int t = 0; t < nt; t += 2) {
            const bool last = (t == nt - 2);
            const char* a1 = cA + (size_t)(t + 1) * kstep;
            const char* a2 = last ? nA : cA + (size_t)(t + 2) * kstep; const char* b2 = last ? nB : cB + (size_t)(t + 2) * kstepB;
            const char* a3 = a2 + kstep; const char* b3 = b2 + kstepB;
            if (last && has_next) S.a_ready(nxt);
            if constexpr (SP2) {
            PG8_LDB(B0, 0, 0); PG8_LDB(B1, 0, 1); PG8_SCHED; PG8_LDA(At, 0, 0); PG8_STAGE(PG8_SA(1, 1), a1 + hstep, voffA);
            PG8_WAIT_V(8); PG8_WAIT_L(0); PG8_BAR; PG8_MMA(0, 0, At, B0); PG8_MMA(0, 1, At, B1); PG8_BAR; PG8_SCHED;
            PG8_LDA(At, 0, 1); PG8_STAGE(PG8_SB(0, 0), b2, voffB); PG8_STAGE(PG8_SB(0, 1), b2 + hstepB, voffB); PG8_STAGE(PG8_SA(0, 0), a2, voffA);
            PG8_WAIT_V(8); PG8_WAIT_L(0); PG8_BAR; PG8_MMA(1, 0, At, B0); PG8_MMA(1, 1, At, B1); PG8_BAR; PG8_SCHED;
            PG8_LDB(B0, 1, 0); PG8_LDB(B1, 1, 1); PG8_SCHED; PG8_LDA(At, 1, 0); PG8_STAGE(PG8_SA(0, 1), a2 + hstep, voffA);
            PG8_WAIT_V(8); PG8_WAIT_L(0); PG8_BAR; PG8_MMA(0, 0, At, B0); PG8_MMA(0, 1, At, B1); PG8_BAR; PG8_SCHED;
            PG8_LDA(At, 1, 1); PG8_STAGE(PG8_SB(1, 0), b3, voffB); PG8_STAGE(PG8_SB(1, 1), b3 + hstepB, voffB); PG8_STAGE(PG8_SA(1, 0), a3, voffA);
            PG8_WAIT_V(8); PG8_WAIT_L(0); PG8_BAR; PG8_MMA(1, 0, At, B0); PG8_MMA(1, 1, At, B1); PG8_BAR; PG8_SCHED;
            } else {
            PG8_LDB(B0, 0, 0); PG8_SCHED; PG8_LDA(At, 0, 0); PG8_STAGE(PG8_SA(1, 1), a1 + hstep, voffA);
            PG8_WAIT_L(8); PG8_BAR; PG8_WAIT_L(0); PG8_MMA(0, 0, At, B0); PG8_BAR; PG8_SCHED;
            PG8_LDB(B1, 0, 1); PG8_STAGE(PG8_SB(0, 0), b2, voffB);
            PG8_BAR; PG8_WAIT_L(0); PG8_MMA(0, 1, At, B1); PG8_BAR;
            PG8_LDA(At, 0, 1); PG8_STAGE(PG8_SA(0, 0), a2, voffA);
            PG8_BAR; PG8_WAIT_L(0); PG8_MMA(1, 0, At, B0); PG8_BAR; PG8_SCHED;
            PG8_STAGE(PG8_SB(0, 1), b2 + hstepB, voffB);
            PG8_WAIT_V(6); PG8_BAR; PG8_MMA(1, 1, At, B1); PG8_BAR;
            PG8_LDB(B0, 1, 0); PG8_SCHED; PG8_LDA(At, 1, 0); PG8_STAGE(PG8_SA(0, 1), a2 + hstep, voffA);
            PG8_WAIT_L(8); PG8_BAR; PG8_WAIT_L(0); PG8_MMA(0, 0, At, B0); PG8_BAR; PG8_SCHED;
            PG8_LDB(B1, 1, 1); PG8_STAGE(PG8_SB(1, 0), b3, voffB);
            PG8_BAR; PG8_WAIT_L(0); PG8_MMA(0, 1, At, B1); PG8_BAR;
            PG8_LDA(At, 1, 1); PG8_STAGE(PG8_SA(1, 0), a3, voffA);
            PG8_BAR; PG8_WAIT_L(0); PG8_MMA(1, 0, At, B0); PG8_BAR; PG8_SCHED;
            PG8_STAGE(PG8_SB(1, 1), b3 + hstepB, voffB);
            PG8_WAIT_V(6); PG8_BAR; PG8_MMA(1, 1, At, B1); PG8_BAR;
            }
        }
        if constexpr (ALIGN_EPI) { if (wr == 0) PG8_BAR; }
        if constexpr (I8 == 2) asm volatile("s_nop 15\n\ts_nop 15" ::: "memory");
        if constexpr (I8 == 1) { _Pragma("unroll") for (int a = 0; a < 2; ++a) _Pragma("unroll") for (int b = 0; b < 2; ++b) _Pragma("unroll") for (int m = 0; m < 4; ++m) _Pragma("unroll") for (int n = 0; n < 2; ++n) acc[a][b][m][n] = __builtin_convertvector(__builtin_bit_cast(i32x4, acc[a][b][m][n]), f32x4); }
        if constexpr (!Epi::AFTER_DRAIN) { E(acc, cur, wr, wc, fr, fq); S.done(cur); }
        if (!has_next) break;
#pragma unroll
        for (int a = 0; a < 2; ++a)
#pragma unroll
            for (int b = 0; b < 2; ++b)
#pragma unroll
                for (int m = 0; m < 4; ++m)
#pragma unroll
                    for (int n = 0; n < 2; ++n) acc[a][b][m][n] = (f32x4){0.f, 0.f, 0.f, 0.f};
        cur = nxt; cA = nA; cB = nB; ++ui;
        if constexpr (ALIGN_EPI) { if (wr == 1) PG8_BAR; }
    }
    PG8_WAIT_V(0);
    if constexpr (!ALIGN_EPI) { if (wr == 0) PG8_BAR; }
    PG8_BAR;
    if constexpr (Epi::AFTER_DRAIN) { E.fused(acc, cur, wr, wc, fr, fq, lds, wid, lane); S.done(cur); }
#undef PG8_SA
#undef PG8_SB
#undef PG8_STAGE
#undef PG8_LDA
#undef PG8_LDB
#undef PG8_MMA
#undef PG8_WAIT_V
#undef PG8_WAIT_L
#undef PG8_BAR
#undef PG8_SCHED
}
}
namespace att {
using bf16x8 = __attribute__((ext_vector_type(8))) short;
using s16x4  = __attribute__((ext_vector_type(4))) short;
using f32x16 = __attribute__((ext_vector_type(16))) float;
using u32x4  = __attribute__((ext_vector_type(4))) unsigned;
typedef unsigned short bf16_t;
constexpr int NW = 8, QBLK = 32, KVBLK = 64;
constexpr float THR = 8.f;
constexpr int SHM_V = 64 * 128 * 2, SHM_K = 64 * 128 * 2, SHM_ATTN = 2 * SHM_V + 2 * SHM_K + NW * 64 * 4;
#define KSWZ(row, colB) ((row) * 256 + ((colB) ^ (((row) & 7) << 4)))
#define KSWZ64(row, colB) ((row) * 128 + ((colB) ^ ((((row) >> 1) & 7) << 4)))
#define SBAR() __builtin_amdgcn_sched_barrier(0)
__device__ __forceinline__ int crow(int r, int hi) { return (r & 3) + 8 * (r >> 2) + 4 * hi; }
__device__ __forceinline__ unsigned cvtpk(float lo, float hi) { unsigned r; asm volatile("v_cvt_pk_bf16_f32 %0, %1, %2" : "=v"(r) : "v"(lo), "v"(hi)); return r; }
__device__ __forceinline__ float bf2f(unsigned short b) { return __uint_as_float((unsigned)b << 16); }
__device__ __forceinline__ bf16x8 ld8(const bf16_t* p) { return *reinterpret_cast<const bf16x8*>(p); }

template <int DQK, bool PRE = false> __device__ __forceinline__ void partialSM(f32x16& p0, f32x16& p1, float& m_reg, float& mn, float& alpha) {
  constexpr float SCALE = PRE ? 0.6931471805599453f : ((DQK == 128) ? 0.088388347648318440f : 0.125f);
  constexpr float C = SCALE * 1.4426950408889634f;
  float pmax = p0[0];
#pragma unroll
  for (int r = 1; r < 16; ++r) pmax = fmaxf(pmax, p0[r]);
#pragma unroll
  for (int r = 0; r < 16; ++r) pmax = fmaxf(pmax, p1[r]);
  { auto rr = __builtin_amdgcn_permlane32_swap(__float_as_uint(pmax), __float_as_uint(pmax), false, false);
    pmax = fmaxf(__uint_as_float(rr[0]), __uint_as_float(rr[1])); }
  if (__builtin_expect(__all(pmax - m_reg <= THR / SCALE), 1)) { mn = m_reg; alpha = 1.f; }
  else { mn = fmaxf(m_reg, pmax); alpha = __builtin_amdgcn_exp2f((m_reg - mn) * C); m_reg = mn; }
  float mnC = -mn * C;
#pragma unroll
  for (int r = 0; r < 16; ++r) p0[r] = fmaf(p0[r], C, mnC);
#pragma unroll
  for (int r = 0; r < 16; ++r) p1[r] = fmaf(p1[r], C, mnC);
#pragma unroll
  for (int r = 0; r < 16; ++r) p0[r] = __builtin_amdgcn_exp2f(p0[r]);
}
#define PK4(P, BASE, OUT) do { unsigned a0 = cvtpk(P[BASE + 0], P[BASE + 1]), a1 = cvtpk(P[BASE + 2], P[BASE + 3]);   \
    unsigned b0 = cvtpk(P[BASE + 4], P[BASE + 5]), b1 = cvtpk(P[BASE + 6], P[BASE + 7]);                              \
    auto r0 = __builtin_amdgcn_permlane32_swap(a0, b0, false, false); auto r1 = __builtin_amdgcn_permlane32_swap(a1, b1, false, false); \
    u32x4 w = {r0[0], r1[0], r0[1], r1[1]}; OUT = *reinterpret_cast<bf16x8*>(&w); } while (0)
__device__ __forceinline__ void finishSM(f32x16& p0, f32x16& p1, float alpha, float& l_reg, bf16x8& pa0, bf16x8& pa1, bf16x8& pa2, bf16x8& pa3) {
#pragma unroll
  for (int r = 0; r < 16; ++r) p1[r] = __builtin_amdgcn_exp2f(p1[r]);
  float ps = 0;
#pragma unroll
  for (int r = 0; r < 16; ++r) ps += p0[r];
#pragma unroll
  for (int r = 0; r < 16; ++r) ps += p1[r];
  { auto rr = __builtin_amdgcn_permlane32_swap(__float_as_uint(ps), __float_as_uint(ps), false, false);
    ps = __uint_as_float(rr[0]) + __uint_as_float(rr[1]); }
  l_reg = l_reg * alpha + ps;
  PK4(p0, 0, pa0); PK4(p0, 8, pa1); PK4(p1, 0, pa2); PK4(p1, 8, pa3);
}
template <int DQK> __device__ __forceinline__ void qkt(f32x16& p0, f32x16& p1, const char* Ks, const bf16x8* qr, int r32, int hi) {
  constexpr int ND = DQK / 16;
  p0 = f32x16{}; p1 = f32x16{};
  bf16x8 b0[2], b1[2];
#define QK_RD(d0, s) do { const int cb_ = ((d0) * 16 + hi * 8) * 2; \
    if constexpr (DQK == 128) { b0[s] = *reinterpret_cast<const bf16x8*>(Ks + KSWZ(r32, cb_)); b1[s] = *reinterpret_cast<const bf16x8*>(Ks + KSWZ(32 + r32, cb_)); } \
    else { b0[s] = *reinterpret_cast<const bf16x8*>(Ks + KSWZ64(r32, cb_)); b1[s] = *reinterpret_cast<const bf16x8*>(Ks + KSWZ64(32 + r32, cb_)); } } while (0)
  QK_RD(0, 0); QK_RD(1, 1); SBAR();
#pragma unroll
  for (int d0 = 0; d0 < ND; ++d0) {
    p0 = __builtin_amdgcn_mfma_f32_32x32x16_bf16(b0[d0 & 1], qr[d0], p0, 0, 0, 0);
    p1 = __builtin_amdgcn_mfma_f32_32x32x16_bf16(b1[d0 & 1], qr[d0], p1, 0, 0, 0);
    if (d0 + 2 < ND) { QK_RD(d0 + 2, d0 & 1); }
    SBAR();
  }
#undef QK_RD
}
__device__ __forceinline__ int v_st(int k, int c) { const int kk = (k & ~0xC) | ((k & 4) << 1) | ((k & 8) >> 1); return ((kk >> 3) * 4 + (c >> 5)) * 512 + ((kk & 7) * 32 + (c & 31)) * 2; }
__device__ __forceinline__ int v_rd_base(int lane) { return ((lane & 3) << 3) | (((lane >> 2) & 3) << 6) | (((lane >> 4) & 1) << 5) | (((lane >> 5) & 1) << 8); }
constexpr int v_rd_off(int d0, int ks, int half) { return d0 * 512 + ks * 4096 + half * 2048; }
template <int OFF> __device__ __forceinline__ s16x4 tr_read(int vb) {
  s16x4 r; asm volatile("ds_read_b64_tr_b16 %0, %1 offset:%2" : "=&v"(r) : "v"(vb), "i"(OFF) : "memory"); return r;
}
#define PKF(L, H) (bf16x8){L[0], L[1], L[2], L[3], H[0], H[1], H[2], H[3]}
template <int D0> __device__ __forceinline__ void pv_one(f32x16& od, int vb, bf16x8 pa0, bf16x8 pa1, bf16x8 pa2, bf16x8 pa3) {
  const s16x4 l0 = tr_read<v_rd_off(D0, 0, 0)>(vb), h0 = tr_read<v_rd_off(D0, 0, 1)>(vb), l1 = tr_read<v_rd_off(D0, 1, 0)>(vb), h1 = tr_read<v_rd_off(D0, 1, 1)>(vb);
  const s16x4 l2 = tr_read<v_rd_off(D0, 2, 0)>(vb), h2 = tr_read<v_rd_off(D0, 2, 1)>(vb), l3 = tr_read<v_rd_off(D0, 3, 0)>(vb), h3 = tr_read<v_rd_off(D0, 3, 1)>(vb);
  asm volatile("s_waitcnt lgkmcnt(0)" ::: "memory"); SBAR();
  od = __builtin_amdgcn_mfma_f32_32x32x16_bf16(pa0, PKF(l0, h0), od, 0, 0, 0);
  od = __builtin_amdgcn_mfma_f32_32x32x16_bf16(pa1, PKF(l1, h1), od, 0, 0, 0);
  od = __builtin_amdgcn_mfma_f32_32x32x16_bf16(pa2, PKF(l2, h2), od, 0, 0, 0);
  od = __builtin_amdgcn_mfma_f32_32x32x16_bf16(pa3, PKF(l3, h3), od, 0, 0, 0);
}
#define PV_RD(D0, L, H) do { L[0] = tr_read<v_rd_off(D0, 0, 0)>(vb); H[0] = tr_read<v_rd_off(D0, 0, 1)>(vb); L[1] = tr_read<v_rd_off(D0, 1, 0)>(vb); H[1] = tr_read<v_rd_off(D0, 1, 1)>(vb); \
    L[2] = tr_read<v_rd_off(D0, 2, 0)>(vb); H[2] = tr_read<v_rd_off(D0, 2, 1)>(vb); L[3] = tr_read<v_rd_off(D0, 3, 0)>(vb); H[3] = tr_read<v_rd_off(D0, 3, 1)>(vb); } while (0)
#define PV_MM(OD, L, H) do { OD = __builtin_amdgcn_mfma_f32_32x32x16_bf16(pa0, PKF(L[0], H[0]), OD, 0, 0, 0); OD = __builtin_amdgcn_mfma_f32_32x32x16_bf16(pa1, PKF(L[1], H[1]), OD, 0, 0, 0); \
    OD = __builtin_amdgcn_mfma_f32_32x32x16_bf16(pa2, PKF(L[2], H[2]), OD, 0, 0, 0); OD = __builtin_amdgcn_mfma_f32_32x32x16_bf16(pa3, PKF(L[3], H[3]), OD, 0, 0, 0); } while (0)
__device__ __forceinline__ void pv_d0(f32x16* o, int vb, bf16x8 pa0, bf16x8 pa1, bf16x8 pa2, bf16x8 pa3) {
  s16x4 la[4], ha[4], lb[4], hb[4];
  PV_RD(0, la, ha); PV_RD(1, lb, hb);
  asm volatile("s_waitcnt lgkmcnt(8)" ::: "memory"); SBAR(); PV_MM(o[0], la, ha); SBAR();
  PV_RD(2, la, ha);
  asm volatile("s_waitcnt lgkmcnt(8)" ::: "memory"); SBAR(); PV_MM(o[1], lb, hb); SBAR();
  PV_RD(3, lb, hb);
  asm volatile("s_waitcnt lgkmcnt(8)" ::: "memory"); SBAR(); PV_MM(o[2], la, ha); SBAR();
  asm volatile("s_waitcnt lgkmcnt(0)" ::: "memory"); SBAR(); PV_MM(o[3], lb, hb);
}
#undef PV_RD
#undef PV_MM
__device__ __forceinline__ float half_sum32(float x) {
  x += __shfl_xor(x, 1); x += __shfl_xor(x, 2); x += __shfl_xor(x, 4); x += __shfl_xor(x, 8); x += __shfl_xor(x, 16); return x;
}

struct KVSrc { const bf16_t* K1; const bf16_t* V1; int n1; const bf16_t* K2; const bf16_t* V2; int n2; };
struct AttnOut { bf16_t* Ob; float* Of; const float* nw; float lam, post; int pass; };
template <int DQK, int MODE, int LD2, int SM = 0>
__device__ __forceinline__ void attn_body(const bf16_t* __restrict__ Qb, const KVSrc kv, const AttnOut ao, char* lds) {
  constexpr long ldq = 5120, LD1 = 5120; constexpr int LDO = 2048, LDF = 512;
  int tid_ = threadIdx.x; asm volatile("" : "+v"(tid_));
  const int tid = tid_, wid = tid >> 6, lane = tid & 63, r32 = lane & 31, hi = lane >> 5;
  char* V_lds = lds; char* K_lds = lds + 2 * SHM_V;
  float* ws = (float*)(lds + 2 * SHM_V + 2 * SHM_K) + wid * 64; float* li_l = ws; float* al_l = ws + 32;
  float m_reg = -1e30f, l_reg = 0; f32x16 o[4] = {}; bf16x8 qr[DQK / 16];
  const bf16_t* Qw = Qb + (long)(wid * QBLK + r32) * ldq + hi * 8;
#pragma unroll
  for (int d0 = 0; d0 < DQK / 16; ++d0) qr[d0] = ld8(Qw + d0 * 16);
  const int sr = tid >> 4, sc = (tid & 15) * 8, vst0 = v_st(sr, sc), vst1 = v_st(32 + sr, sc);
  const int kr64 = tid >> 3, kc64 = (tid & 7) * 8;
  const int vb0 = (int)(uintptr_t)V_lds + v_rd_base(lane);
  struct { bf16x8 vs0, vs1, ks0, ks1; } sr_[2];
#define SLOAD(i, k0) do { const int k0_ = (k0); const bool s1_ = k0_ < kv.n1; const bf16_t* kp_ = s1_ ? kv.K1 + (long)k0_ * LD1 : kv.K2 + (long)(k0_ - kv.n1) * LD2; \
    const bf16_t* vp_ = s1_ ? kv.V1 + (long)k0_ * LD1 : kv.V2 + (long)(k0_ - kv.n1) * LD2; const long ld_ = s1_ ? LD1 : (long)LD2; \
    sr_[i].vs0 = ld8(vp_ + (long)sr * ld_ + sc); sr_[i].vs1 = ld8(vp_ + (long)(32 + sr) * ld_ + sc); \
    if constexpr (DQK == 128) { sr_[i].ks0 = ld8(kp_ + (long)sr * ld_ + sc); sr_[i].ks1 = ld8(kp_ + (long)(32 + sr) * ld_ + sc); } \
    else { sr_[i].ks0 = ld8(kp_ + (long)kr64 * ld_ + kc64); } } while (0)
#define SWRITE(b, i) do { *(bf16x8*)(V_lds + (b) * SHM_V + vst0) = sr_[i].vs0; *(bf16x8*)(V_lds + (b) * SHM_V + vst1) = sr_[i].vs1; \
    if constexpr (DQK == 128) { const int kc = sc * 2; *(bf16x8*)(K_lds + (b) * SHM_K + KSWZ(sr, kc)) = sr_[i].ks0; *(bf16x8*)(K_lds + (b) * SHM_K + KSWZ(32 + sr, kc)) = sr_[i].ks1; } \
    else { *(bf16x8*)(K_lds + (b) * SHM_K + KSWZ64(kr64, kc64 * 2)) = sr_[i].ks0; } } while (0)
#define SWAIT() do { if constexpr (DQK == 128) asm volatile("s_waitcnt vmcnt(4)" ::: "memory"); else asm volatile("s_waitcnt vmcnt(3)" ::: "memory"); } while (0)
#define RESC(a) do { if (SM != 1 && __any((a) < 1.f)) { if (hi == 0) al_l[r32] = (a); asm volatile("s_waitcnt lgkmcnt(0)" ::: "memory"); \
    _Pragma("unroll") for (int d = 0; d < 4; ++d) _Pragma("unroll") for (int r = 0; r < 16; ++r) o[d][r] *= al_l[crow(r, hi)]; } } while (0)
  f32x16 pA0, pA1, pB0, pB1; float mnA = 0.f, mnB = 0.f, alA = 1.f, alB = 1.f; bf16x8 pa0, pa1, pa2, pa3; const int NT = (kv.n1 + kv.n2) / KVBLK; (void)mnA; (void)mnB;
#define PSM(P0, P1, MN, AL) do { if constexpr (SM == 1) { _Pragma("unroll") for (int r_ = 0; r_ < 16; ++r_) P0[r_] = __builtin_amdgcn_exp2f(P0[r_]); } else partialSM<DQK, SM == 2>(P0, P1, m_reg, MN, AL); } while (0)
  constexpr int SE = 0, SO = 1;
  SLOAD(SE, 0); asm volatile("s_waitcnt vmcnt(0)" ::: "memory"); SWRITE(0, SE); __syncthreads();
  qkt<DQK>(pA0, pA1, K_lds, qr, r32, hi); PSM(pA0, pA1, mnA, alA);
  SLOAD(SO, KVBLK); if (2 < NT) SLOAD(SE, 2 * KVBLK);
  SWAIT(); SWRITE(1, SO); __syncthreads();
  for (int j = 1; j + 1 < NT; j += 2) {
    SBAR(); qkt<DQK>(pB0, pB1, K_lds + SHM_K, qr, r32, hi);
    finishSM(pA0, pA1, alA, l_reg, pa0, pa1, pa2, pa3); SBAR();
    SLOAD(SO, (j + 2) * KVBLK); SBAR();
    pv_d0(o, vb0, pa0, pa1, pa2, pa3); PSM(pB0, pB1, mnB, alB);
    __syncthreads(); SWAIT(); SWRITE(0, SE);
    RESC(alB); __syncthreads();
    SBAR(); qkt<DQK>(pA0, pA1, K_lds, qr, r32, hi);
    finishSM(pB0, pB1, alB, l_reg, pa0, pa1, pa2, pa3); SBAR();
    if (j + 3 < NT) SLOAD(SE, (j + 3) * KVBLK); SBAR();
    pv_d0(o, vb0 + (int)SHM_V, pa0, pa1, pa2, pa3); PSM(pA0, pA1, mnA, alA);
    __syncthreads(); SWAIT(); SWRITE(1, SO);
    RESC(alA); __syncthreads();
  }
  SBAR(); qkt<DQK>(pB0, pB1, K_lds + SHM_K, qr, r32, hi);
  finishSM(pA0, pA1, alA, l_reg, pa0, pa1, pa2, pa3); SBAR();
  pv_d0(o, vb0, pa0, pa1, pa2, pa3); PSM(pB0, pB1, mnB, alB);
  __syncthreads(); RESC(alB);
  finishSM(pB0, pB1, alB, l_reg, pa0, pa1, pa2, pa3); SBAR();
  pv_d0(o, vb0 + (int)SHM_V, pa0, pa1, pa2, pa3);
  if (hi == 0) li_l[r32] = l_reg; asm volatile("s_waitcnt lgkmcnt(0)" ::: "memory");
  float rli[16];
#pragma unroll
  for (int r = 0; r < 16; ++r) rli[r] = __builtin_amdgcn_rcpf(li_l[crow(r, hi)]);
  bf16_t* stg = (bf16_t*)lds + wid * (QBLK * 128);
#define O_FLUSH(Ow) do { asm volatile("s_waitcnt lgkmcnt(0)" ::: "memory"); _Pragma("unroll") for (int i_ = 0; i_ < 8; ++i_) { const int row_ = i_ * 4 + (lane >> 4), ch_ = lane & 15; \
    const u32x4 v_ = *(const u32x4*)(stg + row_ * 128 + ch_ * 8); *(u32x4*)((Ow) + (long)row_ * LDO + ch_ * 8) = v_; } } while (0)
  if constexpr (MODE == 0) {
    bf16_t* Ow = ao.Ob + (long)(wid * QBLK) * LDO;
    __syncthreads();
#pragma unroll
    for (int r = 0; r < 16; ++r) { const int orow = crow(r, hi);
#pragma unroll
      for (int d0 = 0; d0 < 4; ++d0) { const float v = o[d0][r] * rli[r]; stg[orow * 128 + d0 * 32 + r32] = (bf16_t)(cvtpk(v, v) & 0xffffu); } }
    O_FLUSH(Ow);
  } else {
    float* Fw = ao.Of + (long)(wid * QBLK) * LDF;
    if (ao.pass == 0) {
#pragma unroll
      for (int r = 0; r < 16; ++r) { const int orow = crow(r, hi);
#pragma unroll
        for (int d0 = 0; d0 < 4; ++d0) Fw[(long)orow * LDF + d0 * 32 + r32] = o[d0][r] * rli[r]; }
    } else {
      bf16_t* Ow = ao.Ob + (long)(wid * QBLK) * LDO;
      __syncthreads();
#pragma unroll
      for (int r = 0; r < 16; ++r) { const int orow = crow(r, hi); float v[4]; float ss = 0.f;
#pragma unroll
        for (int d0 = 0; d0 < 4; ++d0) { v[d0] = Fw[(long)orow * LDF + d0 * 32 + r32] - ao.lam * (o[d0][r] * rli[r]); ss += v[d0] * v[d0]; }
        ss = half_sum32(ss); const float rs = rsqrtf(ss * (1.0f / 128.0f) + 1e-6f) * ao.post;
#pragma unroll
        for (int d0 = 0; d0 < 4; ++d0) { const float y = v[d0] * rs * ao.nw[d0 * 32 + r32]; stg[orow * 128 + d0 * 32 + r32] = (bf16_t)(cvtpk(y, y) & 0xffffu); } }
      O_FLUSH(Ow);
    }
  }
#undef O_FLUSH
#undef SLOAD
#undef SWRITE
#undef SWAIT
#undef RESC
#undef PSM
}
struct ChainArgs { const bf16_t* P;   int kcol, vcol; int nchunk; int dir; float lg2;
                   const float* S0;   bf16_t* ST;   float* Sfin;   };
__device__ __forceinline__ void ret_chain(const ChainArgs a, char* lds) {
  int tid_ = threadIdx.x; asm volatile("" : "+v"(tid_));
  const int tid = tid_, wid = tid >> 6, lane = tid & 63, r32 = lane & 31, hi = lane >> 5;
  const int eb = wid >> 1, dh = wid & 1;
  char* V_lds = lds; char* K_lds = lds + 2 * SHM_V;
  const int sr = tid >> 4, sc = (tid & 15) * 8;
  f32x16 acc[2];
#pragma unroll
  for (int j = 0; j < 2; ++j)
#pragma unroll
    for (int r = 0; r < 16; ++r) acc[j][r] = 0.f;
  if (a.S0) {
#pragma unroll
    for (int j = 0; j < 2; ++j)
#pragma unroll
      for (int r = 0; r < 16; ++r) acc[j][r] = a.S0[(size_t)(32 * (2 * dh + j) + r32) * 128 + 32 * eb + crow(r, hi)]; }
  const float gC = __builtin_amdgcn_exp2f(128.f * a.lg2);
  const int vbA = (int)(uintptr_t)V_lds + v_rd_base(lane) + eb * 512, vbB = (int)(uintptr_t)K_lds + v_rd_base(lane) + (2 * dh) * 512;
  bf16x8 kq[4], vq[4];
  { const int c0 = a.dir == 0 ? 0 : a.nchunk - 1; const bf16_t* rowp = a.P + (size_t)(c0 * 128) * 5120;
#pragma unroll
    for (int q = 0; q < 4; ++q) { const int k = 32 * q + sr; kq[q] = ld8(rowp + (size_t)k * 5120 + a.kcol + sc); vq[q] = ld8(rowp + (size_t)k * 5120 + a.vcol + sc); } }
  for (int s = 0; s < a.nchunk; ++s) {
    const int c = a.dir == 0 ? s : a.nchunk - 1 - s;
    bf16_t* st = a.ST + (size_t)c * 16384;
    __syncthreads();
#pragma unroll
    for (int q = 0; q < 4; ++q) { const int k = 32 * q + sr;
      const bf16x8 kv_ = kq[q], vv_ = vq[q];
      const float f = 0.088388347648318440f * __builtin_amdgcn_exp2f((a.dir == 0 ? (float)(127 - k) : (float)k) * a.lg2);
      u32x4 w; w.x = cvtpk(bf2f((unsigned short)kv_[0]) * f, bf2f((unsigned short)kv_[1]) * f); w.y = cvtpk(bf2f((unsigned short)kv_[2]) * f, bf2f((unsigned short)kv_[3]) * f);
      w.z = cvtpk(bf2f((unsigned short)kv_[4]) * f, bf2f((unsigned short)kv_[5]) * f); w.w = cvtpk(bf2f((unsigned short)kv_[6]) * f, bf2f((unsigned short)kv_[7]) * f);
      const int off = (q >> 1) * SHM_V + v_st(32 * (q & 1) + sr, sc);
      *(u32x4*)(K_lds + off) = w; *(bf16x8*)(V_lds + off) = vv_; }
    __syncthreads();
#pragma unroll
    for (int j = 0; j < 2; ++j)
#pragma unroll
      for (int r = 0; r < 16; ++r) { const float v = acc[j][r]; st[(32 * eb + crow(r, hi)) * 128 + 32 * (2 * dh + j) + r32] = (bf16_t)(cvtpk(v, v) & 0xffffu); }
    if (s + 1 < a.nchunk) { const int cn = a.dir == 0 ? s + 1 : a.nchunk - 2 - s; const bf16_t* rowp = a.P + (size_t)(cn * 128) * 5120;
#pragma unroll
      for (int q = 0; q < 4; ++q) { const int k = 32 * q + sr; kq[q] = ld8(rowp + (size_t)k * 5120 + a.kcol + sc); vq[q] = ld8(rowp + (size_t)k * 5120 + a.vcol + sc); } }
#pragma unroll
    for (int j = 0; j < 2; ++j)
#pragma unroll
      for (int r = 0; r < 16; ++r) acc[j][r] *= gC;
#pragma unroll
    for (int tt = 0; tt < 2; ++tt) {
      s16x4 al[4], ah[4], b0l[4], b0h[4], b1l[4], b1h[4];
#define RD4(ks) do { al[ks] = tr_read<v_rd_off(0, ks, 0)>(vbA + tt * SHM_V); ah[ks] = tr_read<v_rd_off(0, ks, 1)>(vbA + tt * SHM_V); \
      b0l[ks] = tr_read<v_rd_off(0, ks, 0)>(vbB + tt * SHM_V); b0h[ks] = tr_read<v_rd_off(0, ks, 1)>(vbB + tt * SHM_V); \
      b1l[ks] = tr_read<v_rd_off(1, ks, 0)>(vbB + tt * SHM_V); b1h[ks] = tr_read<v_rd_off(1, ks, 1)>(vbB + tt * SHM_V); } while (0)
      RD4(0); RD4(1); RD4(2); RD4(3);
#undef RD4
      asm volatile("s_waitcnt lgkmcnt(0)" ::: "memory"); SBAR();
#pragma unroll
      for (int ks = 0; ks < 4; ++ks) {
        acc[0] = __builtin_amdgcn_mfma_f32_32x32x16_bf16(PKF(al[ks], ah[ks]), PKF(b0l[ks], b0h[ks]), acc[0], 0, 0, 0);
        acc[1] = __builtin_amdgcn_mfma_f32_32x32x16_bf16(PKF(al[ks], ah[ks]), PKF(b1l[ks], b1h[ks]), acc[1], 0, 0, 0); }
    }
  }
  if (a.Sfin) {
#pragma unroll
    for (int j = 0; j < 2; ++j)
#pragma unroll
      for (int r = 0; r < 16; ++r) a.Sfin[(size_t)(32 * (2 * dh + j) + r32) * 128 + 32 * eb + crow(r, hi)] = acc[j][r];
  }
}
struct RetCArgs { const bf16_t* P;   int qcol, kcol, vcol, gcol; float lg2f, lg2b; const bf16_t* STf; const bf16_t* STb;
                  const float* gnw; bf16_t* O;   };
__device__ __forceinline__ void ret_c(const RetCArgs a, char* lds) {
  int tid_ = threadIdx.x; asm volatile("" : "+v"(tid_));
  const int tid = tid_, wid = tid >> 6, lane = tid & 63, r32 = lane & 31, hi = lane >> 5;
  char* V_lds = lds; char* K_lds = lds + 2 * SHM_V;
  const int cw = wid >> 2, ipos = 32 * (wid & 3) + r32;
  const int sr = tid >> 4, sc = (tid & 15) * 8;
  const int vb0 = (int)(uintptr_t)V_lds + v_rd_base(lane);
  bf16x8 qr[8];
  const bf16_t* Qw = a.P + (size_t)(wid * 32 + r32) * 5120 + a.qcol + hi * 8;
#pragma unroll
  for (int d0 = 0; d0 < 8; ++d0) qr[d0] = ld8(Qw + d0 * 16);
  f32x16 o[4] = {};
  for (int ch = 0; ch < 2; ++ch) {
    const bf16_t* rowp = a.P + (size_t)(ch * 128) * 5120;
    __syncthreads();
#pragma unroll
    for (int q = 0; q < 4; ++q) { const int k = 32 * q + sr;
      const bf16x8 kv_ = ld8(rowp + (size_t)k * 5120 + a.kcol + sc), vv_ = ld8(rowp + (size_t)k * 5120 + a.vcol + sc);
      *(bf16x8*)(K_lds + (q >> 1) * SHM_K + KSWZ(32 * (q & 1) + sr, sc * 2)) = kv_;
      *(bf16x8*)(V_lds + (q >> 1) * SHM_V + v_st(32 * (q & 1) + sr, sc)) = vv_; }
    __syncthreads();
    if (cw == ch) {
#pragma unroll
      for (int tt = 0; tt < 2; ++tt) {
        f32x16 p0, p1; qkt<128>(p0, p1, K_lds + tt * SHM_K, qr, r32, hi);
        int ip_ = ipos, hi_ = hi; asm volatile("" : "+v"(ip_), "+v"(hi_));
#pragma unroll
        for (int r = 0; r < 16; ++r) {
          const int j0 = 64 * tt + crow(r, hi_), d0_ = ip_ - j0, d1_ = d0_ - 32;
          const float f0 = d0_ > 0 ? __builtin_amdgcn_exp2f((float)d0_ * a.lg2f) : (d0_ < 0 ? __builtin_amdgcn_exp2f((float)(-d0_) * a.lg2b) : 2.0f);
          const float f1 = d1_ > 0 ? __builtin_amdgcn_exp2f((float)d1_ * a.lg2f) : (d1_ < 0 ? __builtin_amdgcn_exp2f((float)(-d1_) * a.lg2b) : 2.0f);
          p0[r] *= f0 * 0.088388347648318440f; p1[r] *= f1 * 0.088388347648318440f; }
        bf16x8 pa0, pa1, pa2, pa3; PK4(p0, 0, pa0); PK4(p0, 8, pa1); PK4(p1, 0, pa2); PK4(p1, 8, pa3);
        pv_d0(o, vb0 + tt * SHM_V, pa0, pa1, pa2, pa3);
      }
    }
  }
#pragma unroll
  for (int dir = 0; dir < 2; ++dir) {
    const float rs = dir == 0 ? __builtin_amdgcn_exp2f((float)(ipos + 1) * a.lg2f) : __builtin_amdgcn_exp2f((float)(128 - ipos) * a.lg2b);
    const bf16_t* S = (dir == 0 ? a.STf : a.STb) + (size_t)cw * 16384 + (size_t)r32 * 128 + hi * 8;
#pragma unroll
    for (int d0 = 0; d0 < 8; ++d0) {
      const bf16x8 q_ = qr[d0]; u32x4 w;
      w.x = cvtpk(bf2f((unsigned short)q_[0]) * rs, bf2f((unsigned short)q_[1]) * rs); w.y = cvtpk(bf2f((unsigned short)q_[2]) * rs, bf2f((unsigned short)q_[3]) * rs);
      w.z = cvtpk(bf2f((unsigned short)q_[4]) * rs, bf2f((unsigned short)q_[5]) * rs); w.w = cvtpk(bf2f((unsigned short)q_[6]) * rs, bf2f((unsigned short)q_[7]) * rs);
      const bf16x8 qs = *reinterpret_cast<bf16x8*>(&w);
#pragma unroll
      for (int eb = 0; eb < 4; ++eb) { const bf16x8 b = ld8(S + (size_t)eb * 32 * 128 + d0 * 16); o[eb] = __builtin_amdgcn_mfma_f32_32x32x16_bf16(qs, b, o[eb], 0, 0, 0); }
    }
  }
#pragma unroll
  for (int r = 0; r < 16; ++r) {
    const int row = wid * 32 + crow(r, hi);
    float s = (o[0][r] + o[1][r]) + (o[2][r] + o[3][r]); s = half_sum32(s); const float mean = s * (1.0f / 128.0f);
    float q = 0.f;
#pragma unroll
    for (int eb = 0; eb < 4; ++eb) { const float d = o[eb][r] - mean; q += d * d; }
    q = half_sum32(q); const float rstd = rsqrtf(q * (1.0f / 128.0f) + 1e-6f);
#pragma unroll
    for (int eb = 0; eb < 4; ++eb) { const int col = eb * 32 + r32;
      const float g = bf2f(a.P[(size_t)row * 5120 + a.gcol + col]);
      const float y = (o[eb][r] - mean) * rstd * a.gnw[col] * (g * __builtin_amdgcn_rcpf(1.0f + __builtin_amdgcn_exp2f(-1.4426950408889634f * g)));
      a.O[(size_t)row * 2048 + col] = (bf16_t)(cvtpk(y, y) & 0xffffu); }
  }
}
#undef KSWZ
#undef KSWZ64
#undef SBAR
#undef PK4
#undef PKF
}
constexpr int DM = 2048, M_P = 4096, M_S = 32768, MTOK = M_P + M_S, DFF = 5632, NFF = 11264, NIN = 5120, NMODC = 18432, NCOND = 9;
constexpr int C_RQ = 0, C_RK = 512, C_RV = 1024, C_RG = 1536, C_GQ = 2048, C_GK = 3072, C_GV = 3328, C_DQ = 3584, C_DK = 4096, C_DV = 4608;
constexpr float EPS = 1e-6f;
constexpr size_t MiB = 1u << 20;
constexpr size_t WS_CTL = 0, CTL_ZERO_BYTES = 1 * MiB;
constexpr size_t WS_TAB = 1 * MiB;
constexpr size_t WS_CACHE = 4 * MiB;
constexpr size_t WS_W = 16 * MiB;
constexpr size_t W_LAYER = 160 * MiB, W_WI = 0, W_WO = 88 * MiB, W_WIN = 132 * MiB, W_WOUT = 152 * MiB;
constexpr size_t WS_XN = WS_W + 2 * W_LAYER;
constexpr size_t WS_ACT = WS_XN + 144 * MiB;
constexpr size_t WS_ST = WS_ACT + 396 * MiB;
constexpr size_t WS_DF = WS_ST + 72 * MiB;
constexpr size_t WS_XNB = WS_DF + 72 * MiB;
constexpr size_t WS_SB = WS_XNB + 144 * MiB;
constexpr size_t SB_LAYER = 9 * (11264 + 5120 + 11264), SB_J1 = 9 * 11264, SB_J2 = 9 * (11264 + 5120);
constexpr size_t WS_RS = WS_SB + 2 * MiB;
constexpr size_t WS_Q = WS_RS + 2 * MiB;
constexpr size_t Q_SW = 256 * 1024, Q_SW2 = 512 * 1024, Q_SW4 = 832 * 1024, Q_ACT = 960 * 1024  , W_WINQ = 22 * MiB;
constexpr size_t WS_A8B = WS_Q + 1 * MiB;
constexpr size_t WS_END = WS_A8B + 198 * MiB;
constexpr int TB_MOD = 0, TB_COSG = 2 * 9 * 18432, TB_SING = TB_COSG + 64 * 32, TB_COSD = TB_SING + 64 * 32, TB_SIND = TB_COSD + 64 * 16, TB_SCAL = TB_SIND + 64 * 16;
constexpr int CW_BAR = 4096;
constexpr size_t CTL_RAW2 = 960 * 1024;
constexpr size_t CTL_AMAX = 64 * 1024;
constexpr size_t O_X = 0, O_STATE = 75497472, O_GK = 79691776, O_GV = 81788928, O_DK = 83886080, O_DV = 88080384, O_END = 92274688;
constexpr int LDS_BYTES = 147456, MISC_OFF = 131072 + 320;

typedef att::bf16_t bf16;
#define GAS __attribute__((address_space(1)))
#define LAS __attribute__((address_space(3)))
typedef unsigned v4u __attribute__((ext_vector_type(4)));
typedef float f32x4 __attribute__((ext_vector_type(4)));
typedef short bf16x8 __attribute__((ext_vector_type(8)));
typedef GAS unsigned gu32;
typedef GAS unsigned long long gu64;
#define RLX_AGENT __ATOMIC_RELAXED, __HIP_MEMORY_SCOPE_AGENT
#define LDS_WAIT() asm volatile("s_waitcnt lgkmcnt(0)" ::: "memory")
#define VM_WAIT() asm volatile("s_waitcnt vmcnt(0)" ::: "memory")
__device__ __forceinline__ unsigned long long rt() { return __builtin_amdgcn_s_memrealtime(); }
__device__ __forceinline__ unsigned f2bf(float f) { unsigned u = __builtin_bit_cast(unsigned, f); return (u + 0x7fffu + ((u >> 16) & 1u)) >> 16; }
__device__ __forceinline__ unsigned pk2(float lo, float hi) { return f2bf(lo) | (f2bf(hi) << 16); }
#define XB_TMO      128
#define XB_XCNT(j)  (256  + 64 * (j))
#define XB_XSUB(j)  (1280 + 64 * (j))
#define XB_XGEN(j)  (2304 + 64 * (j))
#define XB_TOP      3328
#define XB_TOPGEN   3392
#define XCD_BAR_WORDS 3456
#define XB_SPIN_CAP (1u << 18)

__device__ __forceinline__ unsigned xb_ld(unsigned* p)              { return __hip_atomic_load(p, __ATOMIC_RELAXED, __HIP_MEMORY_SCOPE_AGENT); }
__device__ __forceinline__ unsigned xb_add(unsigned* p, unsigned v) { return __hip_atomic_fetch_add(p, v, __ATOMIC_RELAXED, __HIP_MEMORY_SCOPE_AGENT); }
__device__ __forceinline__ unsigned xb_xcc_id() { return (unsigned)__builtin_amdgcn_s_getreg((3 << 11) | 20) & 0xFu; }
#define XB_SPIN(cond, bar) do { unsigned _sp = 0; while (cond) { __builtin_amdgcn_s_sleep(1); \
    if ((++_sp & 255u) == 0u) { if (xb_ld(&(bar)[XB_TMO])) break; if (_sp > XB_SPIN_CAP) { atomicAdd(&(bar)[XB_TMO], 1u); break; } } } } while (0)

struct XcdBarrier {
    unsigned* bar; unsigned x;
    volatile LAS unsigned* st;
};

__device__ __forceinline__ XcdBarrier xcd_barrier_post(unsigned* bar, volatile LAS unsigned* st) {
    XcdBarrier b; b.bar = bar; b.x = xb_xcc_id(); b.st = st;
    if (threadIdx.x == 0) (void)xb_add(&bar[XB_XCNT(b.x)], 1u);
    return b;
}
__device__ __forceinline__ void xcd_barrier_complete(unsigned* bar, unsigned x, unsigned& nloc, unsigned& nx) {
    const unsigned G = gridDim.x * gridDim.y * gridDim.z;
    unsigned sum, cnt, mine, sp = 0u;
    for (;;) {
        sum = 0u; cnt = 0u; mine = 0u;
#pragma unroll
        for (unsigned j = 0; j < 16; ++j) { const unsigned c = xb_ld(&bar[XB_XCNT(j)]); sum += c; cnt += (c > 0u) ? 1u : 0u; mine = (j == x) ? c : mine; }
        if (sum == G) break;
        __builtin_amdgcn_s_sleep(1);
        if ((++sp & 255u) == 0u) { if (xb_ld(&bar[XB_TMO])) break; if (sp > XB_SPIN_CAP) { atomicAdd(&bar[XB_TMO], 1u); break; } }
    }
    nloc = mine > 0u ? mine : 1u; nx = cnt > 0u ? cnt : 1u;
}

__device__ __forceinline__ void xcd_barrier(const XcdBarrier& b) {
    asm volatile("s_waitcnt vmcnt(0)" ::: "memory");
    __syncthreads();
    if (threadIdx.x == 0) {
        unsigned* bar = b.bar;
        __builtin_amdgcn_s_waitcnt(0);
        unsigned nloc = b.st[0], nx = b.st[1];
        if (nloc == 0u) { xcd_barrier_complete(bar, b.x, nloc, nx); b.st[0] = nloc; b.st[1] = nx; }
        const unsigned old = xb_add(&bar[XB_XSUB(b.x)], 1u);
        const unsigned gen = old / nloc;
        if (old + 1u == (gen + 1u) * nloc) {
            __builtin_amdgcn_fence(__ATOMIC_RELEASE, "agent");
            asm volatile("s_waitcnt vmcnt(0)" ::: "memory");
            const unsigned og = xb_add(&bar[XB_TOP], 1u);
            const unsigned tg = og / nx;
            if (og + 1u == (tg + 1u) * nx) xb_add(&bar[XB_TOPGEN], 1u);
            else XB_SPIN(xb_ld(&bar[XB_TOPGEN]) == tg, bar);
            __builtin_amdgcn_fence(__ATOMIC_ACQUIRE, "agent");
            xb_add(&bar[XB_XGEN(b.x)], 1u);
            asm volatile("s_waitcnt vmcnt(0)" ::: "memory");
        } else {
            XB_SPIN(xb_ld(&bar[XB_XGEN(b.x)]) == gen, bar);
            __builtin_amdgcn_fence(__ATOMIC_ACQUIRE, "agent");
            asm volatile("s_waitcnt vmcnt(0)" ::: "memory");
        }
    }
    __syncthreads();
}
__device__ __forceinline__ float wave_sum(float v) {
#pragma unroll
    for (int o = 1; o < 64; o <<= 1) v += __shfl_xor(v, o);
    return v;
}
__device__ __forceinline__ unsigned pkbf(float lo, float hi) { return pg8::cvt_pk_bf16(lo, hi); }
__device__ __forceinline__ float bf2f(unsigned short b) { return __uint_as_float((unsigned)b << 16); }
__device__ __forceinline__ void transpose_item(const float* W, int ldn, bf16* WT, int K, int k0, int srccol0, int dstrow0, LAS float* scr, int lane, bool qf = false) {
#pragma unroll 8
    for (int i = 0; i < 32; ++i) { const int kk = 2 * i + (lane >> 5); scr[kk * 33 + (lane & 31)] = W[(size_t)(k0 + kk) * ldn + srccol0 + (lane & 31)]; }
    LDS_WAIT(); asm volatile("" ::: "memory");
    const int c = lane & 7;
#pragma unroll
    for (int j = 0; j < 4; ++j) { const int n = (lane >> 3) + 8 * j; const LAS float* s = scr + (8 * c) * 33 + n;
        v4u o; if (qf) { o.x = pkbf(qm(s[0 * 33]), qm(s[1 * 33])); o.y = pkbf(qm(s[2 * 33]), qm(s[3 * 33])); o.z = pkbf(qm(s[4 * 33]), qm(s[5 * 33])); o.w = pkbf(qm(s[6 * 33]), qm(s[7 * 33])); }
        else { o.x = pkbf(s[0 * 33], s[1 * 33]); o.y = pkbf(s[2 * 33], s[3 * 33]); o.z = pkbf(s[4 * 33], s[5 * 33]); o.w = pkbf(s[6 * 33], s[7 * 33]); }
        const int dr = dstrow0 + n; *(GAS v4u*)(WT + ((size_t)((dr >> 8) * (K >> 6) + (k0 >> 6)) * 256 + (dr & 255)) * 64 + 8 * c) = o; }
    LDS_WAIT(); asm volatile("" ::: "memory");
}
template <class INP> __device__ __forceinline__ void absmax_item(const INP& inp, unsigned char* ws, int t, LAS float* red, int tid) {
    const int col = tid & 127, kq = tid >> 7;
    const float* src; size_t ld; int kb, kn, kind, mat, cb;
    if (t < 352) { kind = 0; mat = t / 88; cb = t % 88; src = inp[12] + (size_t)mat * DM * NFF + 128 * cb + col; ld = NFF; kb = 512 * kq; kn = 512; }
    else if (t < 432) { t -= 352; kind = 1; mat = t / 40; cb = t % 40; src = inp[14] + (size_t)mat * DM * NIN + 128 * cb + col; ld = NIN; kb = 512 * kq; kn = 512; }
    else { t -= 432; kind = 2; mat = t >> 6; cb = (t & 63) >> 2; src = inp[13] + (size_t)mat * DFF * DM + 128 * cb + col; ld = DM; kb = 1408 * (t & 3) + 352 * kq; kn = 352; }
    float mx = 0.f;
    for (int k = kb; k < kb + kn; k += 8) { float w[8];
#pragma unroll
        for (int u = 0; u < 8; ++u) w[u] = src[(size_t)(k + u) * ld];
#pragma unroll
        for (int u = 0; u < 8; ++u) mx = fmaxf(mx, fabsf(w[u])); }
    red[kq * 128 + col] = mx;
    __syncthreads();
    if (tid < 128) { const float m4 = fmaxf(fmaxf(red[tid], red[128 + tid]), fmaxf(red[256 + tid], red[384 + tid])); const int s0 = 128 * cb + tid;
        if (kind == 0) { const int brow = s0 < DFF ? (s0 / 128) * 256 + (s0 % 128) : ((s0 - DFF) / 128) * 256 + 128 + ((s0 - DFF) % 128);
            ((float*)(ws + WS_Q + Q_SW))[(size_t)mat * NFF + brow] = fmaxf(m4, 1e-30f) * (1.0f / 127.0f); }
        else if (kind == 1) ((float*)(ws + WS_Q + Q_SW4))[(size_t)mat * NIN + s0] = fmaxf(m4, 1e-30f) * (1.0f / 127.0f);
        else atomicMax((unsigned*)(ws + WS_CTL + CTL_RAW2) + (size_t)mat * DM + s0, __float_as_uint(m4)); }
    __syncthreads();
}
template <class INP> __device__ __forceinline__ void prologue(const INP& inp, unsigned char* ws, LAS unsigned char* lds, int G, int wg, int tid) {
    const int lane = tid & 63, wave = __builtin_amdgcn_readfirstlane(tid >> 6);
    float* tab = (float*)(ws + WS_TAB);
    {
        LAS float* sc = (LAS float*)lds;
        LAS float* red = sc + NCOND * DM;
        bool have = false;
        for (int it = wg; it < 976; it += G) {
            if (it >= 288) { absmax_item(inp, ws, it - 288, (LAS float*)(lds + 98304), tid); continue; }
            if (!have) { for (int i = tid; i < NCOND * DM; i += 512) { const int cd = i >> 11, k = i & 2047; const float v = cd == 0 ? inp[8][k] : inp[2][(cd - 1) * DM + k];
                              sc[i] = v / (1.0f + __expf(-v)); } have = true; __syncthreads(); }
            const int l = it / 144, cb = it % 144, col = tid & 127, g = tid >> 7;
            const float* W = inp[9] + (size_t)l * DM * NMODC + 128 * cb + col;
            float acc[NCOND];
#pragma unroll
            for (int c = 0; c < NCOND; ++c) acc[c] = 0.f;
            for (int k = 512 * g; k < 512 * g + 512; k += 8) {
                float w[8];
#pragma unroll
                for (int u = 0; u < 8; ++u) w[u] = W[(size_t)(k + u) * NMODC];
#pragma unroll
                for (int c = 0; c < NCOND; ++c) { const f32x4 s0 = *(const LAS f32x4*)(sc + c * DM + k), s1 = *(const LAS f32x4*)(sc + c * DM + k + 4);
                    acc[c] += (s0[0] * w[0] + s0[1] * w[1]) + (s0[2] * w[2] + s0[3] * w[3]) + (s1[0] * w[4] + s1[1] * w[5]) + (s1[2] * w[6] + s1[3] * w[7]); }
            }
#pragma unroll
            for (int c = 0; c < NCOND; ++c) red[(g * NCOND + c) * 128 + col] = acc[c];
            __syncthreads();
            for (int i = tid; i < NCOND * 128; i += 512) { const int c = i >> 7, cc = i & 127;
                const float s = ((red[(0 * NCOND + c) * 128 + cc] + red[(1 * NCOND + c) * 128 + cc]) + red[(2 * NCOND + c) * 128 + cc]) + red[(3 * NCOND + c) * 128 + cc];
                tab[TB_MOD + ((size_t)l * NCOND + c) * NMODC + 128 * cb + cc] = s + inp[10][(size_t)l * NMODC + 128 * cb + cc]; }
            __syncthreads();
        }
        __syncthreads();
    }
    if (wg == 0) {
        for (int i = tid; i < 64 * 32; i += 512) { const int pos = i >> 5, f = i & 31; const double inv = pow(10000.0, -(double)(2 * f) / 64.0), a = (double)pos * inv;
            tab[TB_COSG + i] = (float)cos(a); tab[TB_SING + i] = (float)sin(a); }
        for (int i = tid; i < 64 * 16; i += 512) { const int pos = i >> 4, f = i & 15; const double inv = pow(10000.0, -(double)(2 * f) / 32.0), a = (double)pos * inv;
            tab[TB_COSD + i] = (float)cos(a); tab[TB_SIND + i] = (float)sin(a); }
        if (tid < 2) { const int l = tid; const float* dl = inp[19] + l * 256; double s01 = 0.0, s23 = 0.0;
            for (int i = 0; i < 64; ++i) { s01 += (double)dl[i] * (double)dl[64 + i]; s23 += (double)dl[128 + i] * (double)dl[192 + i]; }
            const double li = 0.8 - 0.6 * exp(-0.3 * (double)l);
            tab[TB_SCAL + 16 * l + 0] = (float)(exp(s01) - exp(s23) + li); tab[TB_SCAL + 16 * l + 1] = (float)(1.0 - li); }
        if (tid >= 128 && tid < 130) { const int l = tid - 128; const float* w = inp[18] + l * 256; float mq = 0.f, mk = 0.f;
            for (int i = 0; i < 128; ++i) { mq = fmaxf(mq, fabsf(w[i])); mk = fmaxf(mk, fabsf(w[128 + i])); }
            tab[TB_SCAL + 16 * l + 10] = (mq * mk * 11.313708f * 1.4426950f < 60.0f) ? 1.0f : 0.0f; }
        if (tid >= 64 && tid < 80) { const int i = tid - 64, l = i >> 3, j = i & 7; const double x = (double)inp[16][l * 8 + j];
            tab[TB_SCAL + 16 * l + 2 + j] = (float)(-log1p(exp(-x)) * 1.4426950408889634); }
    }
    {
        bf16* cb = (bf16*)(ws + WS_CACHE);
        const long gt = (long)wg * 512 + tid, GT = (long)G * 512;
        for (int t = 0; t < 4; ++t) { const float* src = inp[4 + t]; const long n8 = (t < 2 ? 1048576 : 2097152) / 8; bf16* dst = cb + (t == 0 ? 0 : t == 1 ? 1048576 : t == 2 ? 2097152 : 4194304);
            for (long i = gt; i < n8; i += GT) { const f32x4 a = *(const f32x4*)(src + i * 8), b = *(const f32x4*)(src + i * 8 + 4);
                v4u o; o.x = pkbf(a[0], a[1]); o.y = pkbf(a[2], a[3]); o.z = pkbf(b[0], b[1]); o.w = pkbf(b[2], b[3]); *(v4u*)(dst + i * 8) = o; } }
    }
    {
        LAS float* scr = (LAS float*)(lds + wave * 16384);
        const int gw = wg * 8 + wave, NGW = G * 8;
        for (int it = gw; it < 81920; it += NGW) {
            const int l = it / 40960; int r = it % 40960;
            bf16* WL = (bf16*)(ws + WS_W + (size_t)l * W_LAYER);
            if (r < 22528) continue;
            if (false) { const int f = r / 11264, q = r % 11264, kb = q / 352, nb = q % 352, s0 = 32 * nb;
                const int drow = s0 < DFF ? (s0 / 128) * 256 + (s0 % 128) : ((s0 - DFF) / 128) * 256 + 128 + ((s0 - DFF) % 128);
                transpose_item(inp[12] + (size_t)(l * 2 + f) * DM * NFF, NFF, WL + (W_WI + (size_t)f * 44 * MiB) / 2, DM, 64 * kb, s0, drow, scr, lane, true); continue; }
            r -= 22528;
            if (r < 11264) continue;
            if (false) { const int f = r / 5632, q = r % 5632, kb = q / 64, nb = q % 64;
                transpose_item(inp[13] + (size_t)(l * 2 + f) * DFF * DM, DM, WL + (W_WO + (size_t)f * 22 * MiB) / 2, DFF, 64 * kb, 32 * nb, 32 * nb, scr, lane, true); continue; }
            r -= 11264;
            if (r < 5120) { const int kb = r / 160, nb = r % 160;
                transpose_item(inp[14] + (size_t)l * DM * NIN, NIN, WL + W_WIN / 2, DM, 64 * kb, 32 * nb, 32 * nb, scr, lane); continue; }
            r -= 5120;
            { const int kb = r / 64, nb = r % 64;
                transpose_item(inp[15] + (size_t)l * DM * DM, DM, WL + W_WOUT / 2, DM, 64 * kb, 32 * nb, 32 * nb, scr, lane); }
        }
    }
}
template <class INP> __device__ __forceinline__ void prologue_b(const INP& inp, unsigned char* ws, LAS unsigned char* lds, int G, int wg, int tid) {
    const int lane = tid & 63, wave = __builtin_amdgcn_readfirstlane(tid >> 6);
    LAS float* scr = (LAS float*)(lds + wave * 16384);
    const float* swv = (const float*)(ws + WS_Q + Q_SW);
    const int gw = wg * 8 + wave, NGW = G * 8;
    const float* swv4 = (const float*)(ws + WS_Q + Q_SW4);
    if (wg < 4) {
        float sm = 0.f; for (int i = tid; i < NFF; i += 512) sm += swv[(size_t)wg * NFF + i];
#pragma unroll
        for (int o = 1; o < 64; o <<= 1) sm += __shfl_xor(sm, o);
        LAS float* red = (LAS float*)(lds + 131072);
        if (lane == 0) red[wave] = sm;
        __syncthreads();
        if (tid == 0) { float t = 0.f; for (int i = 0; i < 8; ++i) t += red[i];
            const float sg = t * (127.0f / (float)NFF) * (1.0f / 3.6f) * 45.254834f;
            const float h0 = fmaxf(fmaxf(sg * sg, sg), 1e-20f); const float sc = exp2f(1.0f - rintf(log2f(h0)));
            float* qa = (float*)(ws + WS_Q + Q_ACT) + 2 * wg; qa[0] = sc; qa[1] = 1.0f / sc; }
        __syncthreads();
    }
    for (int it = gw; it < 10240; it += NGW) {
        const int l = it / 5120, q = it % 5120, kb = q / 160, nb = q % 160, s0 = 32 * nb, k0 = 64 * kb;
        const float* W = inp[14] + (size_t)l * DM * NIN;
        unsigned char* WQ = ws + WS_W + (size_t)l * W_LAYER + W_WINQ;
#pragma unroll 8
        for (int i = 0; i < 32; ++i) { const int kk = 2 * i + (lane >> 5); scr[kk * 33 + (lane & 31)] = W[(size_t)(k0 + kk) * NIN + s0 + (lane & 31)]; }
        LDS_WAIT(); asm volatile("" ::: "memory");
        const int c = lane & 7;
#pragma unroll
        for (int j = 0; j < 4; ++j) { const int n = (lane >> 3) + 8 * j, dr = s0 + n; const LAS float* sp = scr + (8 * c) * 33 + n;
            const float inv = 1.0f / swv4[(size_t)l * NIN + dr];
            unsigned lo = 0u, hi = 0u;
#pragma unroll
            for (int e = 0; e < 4; ++e) { lo |= ((unsigned)(__float2int_rn(sp[e * 33] * inv)) & 0xffu) << (8 * e); hi |= ((unsigned)(__float2int_rn(sp[(4 + e) * 33] * inv)) & 0xffu) << (8 * e); }
            const int kk = k0 + 8 * c;
            uint2 o; o.x = lo; o.y = hi;
            *(uint2*)(WQ + ((size_t)((dr >> 8) * (DM >> 7) + (kk >> 7)) * 256 + (dr & 255)) * 128 + (kk & 127)) = o; }
        LDS_WAIT(); asm volatile("" ::: "memory");
    }
    const unsigned* raw2 = (const unsigned*)(ws + WS_CTL + CTL_RAW2);
    for (int i = wg * 512 + tid; i < 4 * DM; i += G * 512) ((float*)(ws + WS_Q + Q_SW2))[i] = fmaxf(__uint_as_float(raw2[i]), 1e-30f) * (1.0f / 240.0f);
    for (int it = gw; it < 22528; it += NGW) {
        const int mat = it / 5632, q = it % 5632, kb = q / 64, nb = q % 64, s0 = 32 * nb, k0 = 64 * kb, l = mat >> 1, f = mat & 1;
        const float* W = inp[13] + (size_t)mat * DFF * DM;
        unsigned char* WQ = ws + WS_W + (size_t)l * W_LAYER + W_WO + (size_t)f * 22 * MiB;
#pragma unroll 8
        for (int i = 0; i < 32; ++i) { const int kk = 2 * i + (lane >> 5); scr[kk * 33 + (lane & 31)] = W[(size_t)(k0 + kk) * DM + s0 + (lane & 31)]; }
        LDS_WAIT(); asm volatile("" ::: "memory");
        const int c = lane & 7;
#pragma unroll
        for (int j = 0; j < 4; ++j) { const int n = (lane >> 3) + 8 * j, dr = s0 + n; const LAS float* sp = scr + (8 * c) * 33 + n;
            const float inv = 240.0f / fmaxf(__uint_as_float(raw2[(size_t)mat * DM + dr]), 1e-30f);
            unsigned lo = __builtin_amdgcn_cvt_pk_fp8_f32(sp[0] * inv, sp[33] * inv, 0, false); lo = __builtin_amdgcn_cvt_pk_fp8_f32(sp[2 * 33] * inv, sp[3 * 33] * inv, lo, true);
            unsigned hi = __builtin_amdgcn_cvt_pk_fp8_f32(sp[4 * 33] * inv, sp[5 * 33] * inv, 0, false); hi = __builtin_amdgcn_cvt_pk_fp8_f32(sp[6 * 33] * inv, sp[7 * 33] * inv, hi, true);
            const int kk = k0 + 8 * c;
            uint2 o; o.x = lo; o.y = hi;
            *(uint2*)(WQ + ((size_t)((dr >> 8) * (DFF >> 7) + (kk >> 7)) * 256 + (dr & 255)) * 128 + (kk & 127)) = o; }
        LDS_WAIT(); asm volatile("" ::: "memory");
    }
    for (int it = gw; it < 45056; it += NGW) {
        const int mat = it / 11264, q = it % 11264, kb = q / 352, nb = q % 352, s0 = 32 * nb, k0 = 64 * kb, l = mat >> 1, f = mat & 1;
        const int drow = s0 < DFF ? (s0 / 128) * 256 + (s0 % 128) : ((s0 - DFF) / 128) * 256 + 128 + ((s0 - DFF) % 128);
        const float* W = inp[12] + (size_t)mat * DM * NFF;
        unsigned char* WQ = ws + WS_W + (size_t)l * W_LAYER + W_WI + (size_t)f * 44 * MiB;
#pragma unroll 8
        for (int i = 0; i < 32; ++i) { const int kk = 2 * i + (lane >> 5); scr[kk * 33 + (lane & 31)] = W[(size_t)(k0 + kk) * NFF + s0 + (lane & 31)]; }
        LDS_WAIT(); asm volatile("" ::: "memory");
        const int c = lane & 7;
#pragma unroll
        for (int j = 0; j < 4; ++j) { const int n = (lane >> 3) + 8 * j, dr = drow + n; const LAS float* sp = scr + (8 * c) * 33 + n;
            const float inv = 1.0f / swv[(size_t)mat * NFF + dr];
            unsigned lo = 0u, hi = 0u;
#pragma unroll
            for (int e = 0; e < 4; ++e) { lo |= ((unsigned)(__float2int_rn(sp[e * 33] * inv)) & 0xffu) << (8 * e); hi |= ((unsigned)(__float2int_rn(sp[(4 + e) * 33] * inv)) & 0xffu) << (8 * e); }
            const int kk = k0 + 8 * c;
            uint2 o; o.x = lo; o.y = hi;
            *(uint2*)(WQ + ((size_t)((dr >> 8) * (DM >> 7) + (kk >> 7)) * 256 + (dr & 255)) * 128 + (kk & 127)) = o; }
        LDS_WAIT(); asm volatile("" ::: "memory");
    }
}
__device__ __forceinline__ void quant_act_phase(const bf16* ACT, unsigned char* A8, float* sa, int G, int wg, int tid) {
    const int lane = tid & 63, wave = tid >> 6, gw = wg * 8 + wave, NGW = G * 8;
    for (int m = gw; m < MTOK; m += NGW) {
        const bf16* ar = ACT + (size_t)m * DFF;
        v4u v[11]; float mx = 0.f;
#pragma unroll
        for (int j = 0; j < 11; ++j) v[j] = *(const v4u*)(ar + 512 * j + 8 * lane);
#pragma unroll
        for (int j = 0; j < 11; ++j) { const unsigned w4[4] = {v[j].x, v[j].y, v[j].z, v[j].w};
#pragma unroll
            for (int e = 0; e < 4; ++e) mx = fmaxf(mx, fmaxf(fabsf(__uint_as_float(w4[e] << 16)), fabsf(__uint_as_float(w4[e] & 0xffff0000u)))); }
#pragma unroll
        for (int o = 1; o < 64; o <<= 1) mx = fmaxf(mx, __shfl_xor(mx, o));
        mx = fmaxf(mx, 1e-30f);
        if (lane == 0) sa[m] = mx * (1.0f / 127.0f);
        const float inv = 127.0f / mx; unsigned char* orow = A8 + (size_t)m * DFF;
#pragma unroll
        for (int j = 0; j < 11; ++j) { const unsigned w4[4] = {v[j].x, v[j].y, v[j].z, v[j].w}; unsigned o2[2] = {0u, 0u};
#pragma unroll
            for (int e = 0; e < 4; ++e) { const unsigned lo = (unsigned)__float2int_rn(__uint_as_float(w4[e] << 16) * inv) & 0xffu, hi = (unsigned)__float2int_rn(__uint_as_float(w4[e] & 0xffff0000u) * inv) & 0xffu;
                o2[e >> 1] |= (lo | (hi << 8)) << (16 * (e & 1)); }
            uint2 ov; ov.x = o2[0]; ov.y = o2[1]; *(uint2*)(orow + 512 * j + 8 * lane) = ov; }
    }
}
__device__ __forceinline__ void quant_xs_phase(const bf16* XS, const unsigned* amax, unsigned char* A8, float* sa, int G, int wg, int tid, int m_begin = 0) {
    const int lane = tid & 63, wave = tid >> 6, gw = wg * 8 + wave, NGW = G * 8;
    for (int m0 = m_begin + 2 * gw; m0 < MTOK; m0 += 2 * NGW) {
        v4u v[2][4]; float mx[2];
#pragma unroll
        for (int r = 0; r < 2; ++r) { const bf16* xr = XS + (size_t)(m0 + r) * DM; mx[r] = fmaxf(__uint_as_float(amax[m0 + r]), 1e-30f);
#pragma unroll
            for (int j = 0; j < 4; ++j) v[r][j] = *(const v4u*)(xr + 512 * j + 8 * lane); }
#pragma unroll
        for (int r = 0; r < 2; ++r) { const float inv = 127.0f / mx[r]; unsigned char* orow = A8 + (size_t)(m0 + r) * DM; if (lane == 0) sa[m0 + r] = mx[r] * (1.0f / 127.0f);
#pragma unroll
            for (int j = 0; j < 4; ++j) { const unsigned w4[4] = {v[r][j].x, v[r][j].y, v[r][j].z, v[r][j].w}; unsigned o2[2] = {0u, 0u};
#pragma unroll
                for (int e = 0; e < 4; ++e) { const unsigned lo = (unsigned)__float2int_rn(__uint_as_float(w4[e] << 16) * inv) & 0xffu, hi = (unsigned)__float2int_rn(__uint_as_float(w4[e] & 0xffff0000u) * inv) & 0xffu;
                    o2[e >> 1] |= (lo | (hi << 8)) << (16 * (e & 1)); }
                uint2 ov; ov.x = o2[0]; ov.y = o2[1]; *(uint2*)(orow + 512 * j + 8 * lane) = ov; } }
    }
}
__device__ __forceinline__ void quant_phase(const float* xP, const float* xS, const float* nw, const float* scl0  , unsigned char* A8, float* sa, unsigned long long* rss, int G, int wg, int tid, int m_begin = 0) {
    const int lane = tid & 63, wave = tid >> 6, gw = wg * 8 + wave, NGW = G * 8;
    for (int m = m_begin + gw; m < MTOK; m += NGW) {
        const float* xr = (m < M_P ? xP : xS) + (size_t)m * DM;
        const int cond = m < M_P ? 0 : 1 + ((m - M_P) >> 12);
        const float* scl = scl0 + (size_t)cond * NMODC;
        f32x4 h[8]; float ss = 0.f, mx = 0.f;
#pragma unroll
        for (int j = 0; j < 8; ++j) { const int c = 256 * j + 4 * lane; const f32x4 v = *(const f32x4*)(xr + c); ss += (v[0] * v[0] + v[1] * v[1]) + (v[2] * v[2] + v[3] * v[3]);
            h[j] = v * *(const f32x4*)(nw + c) * (*(const f32x4*)(scl + c) + 1.0f);
            mx = fmaxf(fmaxf(mx, fmaxf(fabsf(h[j][0]), fabsf(h[j][1]))), fmaxf(fabsf(h[j][2]), fabsf(h[j][3]))); }
        ss = wave_sum(ss);
#pragma unroll
        for (int o = 1; o < 64; o <<= 1) mx = fmaxf(mx, __shfl_xor(mx, o));
        mx = fmaxf(mx, 1e-30f);
        if (lane == 0) { rss[m] = (unsigned long long)(ss * 16777216.0f); sa[m] = mx * (1.0f / 127.0f); }
        const float inv = 127.0f / mx; unsigned char* orow = A8 + (size_t)m * DM;
#pragma unroll
        for (int j = 0; j < 8; ++j) { const unsigned w = ((unsigned)__float2int_rn(h[j][0] * inv) & 0xffu) | (((unsigned)__float2int_rn(h[j][1] * inv) & 0xffu) << 8) | (((unsigned)__float2int_rn(h[j][2] * inv) & 0xffu) << 16) | (((unsigned)__float2int_rn(h[j][3] * inv) & 0xffu) << 24);
            *(unsigned*)(orow + 256 * j + 4 * lane) = w; }
    }
}
__device__ __forceinline__ void norm0_phase(const float* xP, const float* xS, const float* nw, const float* mod  , bf16* XN, unsigned long long* rss, int G, int wg, int tid) {
    const int lane = tid & 63, wave = tid >> 6, gw = wg * 8 + wave, NGW = G * 8;
    for (int m = gw; m < MTOK; m += NGW) {
        const float* xr = (m < M_P ? xP : xS) + (size_t)m * DM;
        const int cond = m < M_P ? 0 : 1 + ((m - M_P) >> 12);
        const float* scl = mod + (size_t)cond * NMODC + DM;
        f32x4 v[8]; float ss = 0.f;
#pragma unroll
        for (int j = 0; j < 8; ++j) { v[j] = *(const f32x4*)(xr + 256 * j + 4 * lane); ss += (v[j][0] * v[j][0] + v[j][1] * v[j][1]) + (v[j][2] * v[j][2] + v[j][3] * v[j][3]); }
        ss = wave_sum(ss); if (lane == 0) rss[m] = (unsigned long long)(ss * 16777216.0f);
        bf16* orow = XN + (size_t)m * DM;
#pragma unroll
        for (int j = 0; j < 8; ++j) { const int c = 256 * j + 4 * lane; const f32x4 w = *(const f32x4*)(nw + c), s1 = *(const f32x4*)(scl + c);
            const f32x4 h = v[j] * w * (s1 + 1.0f);
            uint2 o; o.x = pkbf(qm(h[0]), qm(h[1])); o.y = pkbf(qm(h[2]), qm(h[3])); *(uint2*)(orow + c) = o; }
    }
}
__device__ __forceinline__ void bias_ffn_mfma(unsigned char* ws, LAS unsigned char* lds, int grp, int sub, int nsub, int tid) {
    typedef int i32x4_t __attribute__((ext_vector_type(4)));
    const int lane = tid & 63, wave = tid >> 6, l = grp >> 1, f = grp & 1;
    const float* mod = (const float*)(ws + WS_TAB) + TB_MOD + (size_t)l * NCOND * NMODC + (size_t)(6 * f) * DM;
    LAS unsigned char* D = lds;
    LAS float* red = (LAS float*)(lds + 65536);
    __syncthreads();
    for (int i = tid; i < 65536 / 16; i += 512) ((LAS v4u*)D)[i] = (v4u){0u, 0u, 0u, 0u};
    for (int c = wave; c < NCOND; c += 8) { float mx = 0.f; for (int k = lane; k < DM; k += 64) mx = fmaxf(mx, fabsf(mod[(size_t)c * NMODC + k]));
#pragma unroll
        for (int o = 1; o < 64; o <<= 1) mx = fmaxf(mx, __shfl_xor(mx, o));
        if (lane == 0) red[c] = fmaxf(mx, 1e-30f) * (1.0f / 127.0f); }
    __syncthreads();
    for (int i = tid; i < NCOND * DM; i += 512) { const int c = i >> 11, k = i & 2047; const float s0 = red[c], s1 = s0 * (1.0f / 127.0f), v = mod[(size_t)c * NMODC + k];
        const float d0 = rintf(v / s0), d1 = rintf((v - d0 * s0) / s1); const int off = ((k >> 6) * 16 + c) * 64 + (k & 63);
        D[off] = (unsigned char)(int)d0; D[32768 + off] = (unsigned char)(int)d1; }
    __syncthreads();
    const unsigned char* Bq = ws + WS_W + (size_t)l * W_LAYER + W_WI + (size_t)f * 44 * MiB;
    const float* swv = (const float*)(ws + WS_Q + Q_SW) + (size_t)(2 * l + f) * NFF;
    float* sb = (float*)(ws + WS_SB) + (size_t)l * SB_LAYER + (f ? SB_J2 : 0);
    const int jr = lane & 15, g = lane >> 4;
    for (int rg = sub * 8 + wave; rg < NFF / 16; rg += nsub * 8) {
        const int n = rg * 16 + jr;
        const unsigned char* wp = Bq + ((size_t)(n >> 8) * (DM >> 7) * 256 + (n & 255)) * 128 + 16 * g;
        i32x4_t a0 = {0, 0, 0, 0}, a1 = {0, 0, 0, 0};
#pragma unroll 4
        for (int kb = 0; kb < 32; ++kb) {
            const i32x4_t w = *(const i32x4_t*)(wp + (size_t)(kb >> 1) * 256 * 128 + (kb & 1) * 64);
            const i32x4_t d0 = *(const LAS i32x4_t*)(D + ((kb * 16 + jr) * 64 + 16 * g)), d1 = *(const LAS i32x4_t*)(D + 32768 + ((kb * 16 + jr) * 64 + 16 * g));
            a0 = __builtin_amdgcn_mfma_i32_16x16x64_i8(w, d0, a0, 0, 0, 0); a1 = __builtin_amdgcn_mfma_i32_16x16x64_i8(w, d1, a1, 0, 0, 0);
        }
        if (jr < NCOND) { const float s0 = red[jr], s1 = s0 * (1.0f / 127.0f);
#pragma unroll
            for (int r = 0; r < 4; ++r) { const int nn = rg * 16 + 4 * g + r; sb[(size_t)jr * NFF + nn] = swv[nn] * (s0 * (float)a0[r] + s1 * (float)a1[r]); } }
    }
    __syncthreads();
}
__device__ __forceinline__ void bias_phase(unsigned char* ws, LAS unsigned char* lds, int G, int wg, int tid) {
    const int lane = tid & 63, wave = tid >> 6, gw = wg * 8 + wave, NGW = G * 8;
    LAS float* sh = (LAS float*)lds;
    const float* tab = (const float*)(ws + WS_TAB);
    const int per = G / 4; const bool mf = per >= 1;
    if (mf && wg < 4 * per) bias_ffn_mfma(ws, lds, wg / per, wg % per, per, tid);
    for (int grp = 0; grp < 6; ++grp) {
        const int l = grp / 3, j = grp % 3, N = (j == 1) ? NIN : NFF;
        if (mf && j != 1) continue;
        const bf16* Bt = (const bf16*)(ws + WS_W + (size_t)l * W_LAYER + (j == 0 ? W_WI : j == 1 ? W_WIN : W_WI + 44 * MiB));
        float* sb = (float*)(ws + WS_SB) + (size_t)l * SB_LAYER + (j == 0 ? 0 : j == 1 ? SB_J1 : SB_J2);
        const float* mod = tab + TB_MOD + (size_t)l * NCOND * NMODC + (size_t)(3 * j) * DM;
        __syncthreads();
        for (int i = tid; i < NCOND * DM; i += 512) sh[i] = mod[(size_t)(i >> 11) * NMODC + (i & 2047)];
        __syncthreads();
        if (j != 1) {
            const unsigned char* Bq = (const unsigned char*)Bt; const float* swv = (const float*)(ws + WS_Q + Q_SW) + (size_t)(2 * l + (j >> 1)) * NFF;
            for (int n = gw; n < N; n += NGW) {
                v4u wr2[2];
#pragma unroll
                for (int q = 0; q < 2; ++q) { const int k_ = 16 * (lane + 64 * q); wr2[q] = *(const v4u*)(Bq + ((size_t)((n >> 8) * (DM >> 7) + (k_ >> 7)) * 256 + (n & 255)) * 128 + (k_ & 127)); }
                float wf[2][16];
#pragma unroll
                for (int q = 0; q < 2; ++q) { const unsigned ww[4] = {wr2[q].x, wr2[q].y, wr2[q].z, wr2[q].w};
#pragma unroll
                    for (int e = 0; e < 16; ++e) wf[q][e] = (float)(int)(signed char)((ww[e >> 2] >> (8 * (e & 3))) & 0xffu); }
                const float swn = swv[n];
#pragma unroll 1
                for (int c = 0; c < NCOND; ++c) { float a = 0.f;
#pragma unroll
                    for (int q = 0; q < 2; ++q) { const int k = 16 * (lane + 64 * q);
#pragma unroll
                        for (int e4 = 0; e4 < 4; ++e4) { const f32x4 s0 = *(const LAS f32x4*)(sh + c * DM + k + 4 * e4); a += (s0[0] * wf[q][4 * e4] + s0[1] * wf[q][4 * e4 + 1]) + (s0[2] * wf[q][4 * e4 + 2] + s0[3] * wf[q][4 * e4 + 3]); } }
                    const float t = wave_sum(a); if (lane == 0) sb[(size_t)c * N + n] = t * swn; }
            }
            continue;
        }
        v4u wq[4];
        if (gw < N) {
#pragma unroll
            for (int q = 0; q < 4; ++q) { const int k_ = 8 * (lane + 64 * q); wq[q] = *(const v4u*)(Bt + ((size_t)((gw >> 8) * (DM >> 6) + (k_ >> 6)) * 256 + (gw & 255)) * 64 + (k_ & 63)); } }
        for (int n = gw; n < N; n += NGW) {
            v4u wc_[4];
#pragma unroll
            for (int q = 0; q < 4; ++q) wc_[q] = wq[q];
            if (n + NGW < N) {
#pragma unroll
                for (int q = 0; q < 4; ++q) { const int k_ = 8 * (lane + 64 * q), n_ = n + NGW; wq[q] = *(const v4u*)(Bt + ((size_t)((n_ >> 8) * (DM >> 6) + (k_ >> 6)) * 256 + (n_ & 255)) * 64 + (k_ & 63)); } }
            float wf[4][8];
#pragma unroll
            for (int q = 0; q < 4; ++q) { const v4u w4 = wc_[q];
                wf[q][0] = __uint_as_float(w4.x << 16); wf[q][1] = __uint_as_float(w4.x & 0xffff0000u); wf[q][2] = __uint_as_float(w4.y << 16); wf[q][3] = __uint_as_float(w4.y & 0xffff0000u);
                wf[q][4] = __uint_as_float(w4.z << 16); wf[q][5] = __uint_as_float(w4.z & 0xffff0000u); wf[q][6] = __uint_as_float(w4.w << 16); wf[q][7] = __uint_as_float(w4.w & 0xffff0000u); }
#pragma unroll 1
            for (int c = 0; c < NCOND; ++c) { float a = 0.f;
#pragma unroll
                for (int q = 0; q < 4; ++q) { const int k = 8 * (lane + 64 * q); const f32x4 s0 = *(const LAS f32x4*)(sh + c * DM + k), s1 = *(const LAS f32x4*)(sh + c * DM + k + 4);
                    a += (s0[0] * wf[q][0] + s0[1] * wf[q][1]) + (s0[2] * wf[q][2] + s0[3] * wf[q][3]) + (s1[0] * wf[q][4] + s1[1] * wf[q][5]) + (s1[2] * wf[q][6] + s1[3] * wf[q][7]); }
                const float t = wave_sum(a); if (lane == 0) sb[(size_t)c * N + n] = t; }
        }
    }
    __syncthreads();
}
__device__ __forceinline__ void final_norm(float* x, const float* fw, int G, int wg, int tid) {
    const int lane = tid & 63, wave = tid >> 6, gw = wg * 8 + wave, NGW = G * 8;
    for (int m = gw; m < MTOK; m += NGW) {
        float* xr = x + (size_t)m * DM; f32x4 v[8]; float ss = 0.f;
#pragma unroll
        for (int j = 0; j < 8; ++j) { v[j] = *(const f32x4*)(xr + 256 * j + 4 * lane); ss += (v[j][0] * v[j][0] + v[j][1] * v[j][1]) + (v[j][2] * v[j][2] + v[j][3] * v[j][3]); }
        const float rstd = rsqrtf(wave_sum(ss) * (1.0f / DM) + EPS);
#pragma unroll
        for (int j = 0; j < 8; ++j) { const int c = 256 * j + 4 * lane; *(f32x4*)(xr + c) = (v[j] * rstd) * *(const f32x4*)(fw + c); }
    }
}
__device__ __forceinline__ void prep_row(int m, int l, bf16* PROJ, bf16* DST, const float* tab, const float* qkw  , float* out, int lane) {
    bf16* pr = PROJ + (size_t)m * NIN; bf16* pw = DST + (size_t)m * NIN;
    const bool lat = m >= M_P; const int t = lat ? ((m - M_P) & 4095) : (m & 255), b = lat ? ((m - M_P) >> 12) : (m >> 8);
    const int rr = t >> 6, cc = t & 63;
    unsigned rg[10], rd[8], rv2[2], rv4[4];
#pragma unroll
    for (int v = 0; v < 10; ++v) rg[v] = *(const unsigned*)(pr + (v < 8 ? C_GQ + 128 * v : C_GK + 128 * (v - 8)) + 2 * lane);
#pragma unroll
    for (int v = 0; v < 8; ++v) rd[v] = *(const unsigned*)(pr + (v < 4 ? C_DQ + 128 * v : C_DK + 128 * (v - 4)) + 2 * lane);
    if (!lat) {
#pragma unroll
        for (int v = 0; v < 2; ++v) rv2[v] = *(const unsigned*)(pr + C_GV + 128 * v + 2 * lane);
#pragma unroll
        for (int v = 0; v < 4; ++v) rv4[v] = *(const unsigned*)(pr + C_DV + 128 * v + 2 * lane);
    }
    const float wq0 = qkw[2 * lane], wq1 = qkw[2 * lane + 1], wk0 = qkw[128 + 2 * lane], wk1 = qkw[128 + 2 * lane + 1];
    float cs = 1.f, sn = 0.f, c2 = 1.f, s2 = 0.f;
    if (lat) { const int idx = lane < 32 ? rr * 32 + lane : cc * 32 + (lane - 32); cs = tab[TB_COSG + idx]; sn = tab[TB_SING + idx];
               const int p = lane & 31, id2 = p < 16 ? rr * 16 + p : cc * 16 + (p - 16); c2 = tab[TB_COSD + id2]; s2 = tab[TB_SIND + id2]; }
#pragma unroll
    for (int v = 0; v < 10; ++v) {
        const int col = (v < 8 ? C_GQ + 128 * v : C_GK + 128 * (v - 8)) + 2 * lane;
        const float x1 = bf2f((unsigned short)(rg[v] & 0xffffu)), x2 = bf2f((unsigned short)(rg[v] >> 16));
        const float rs = rsqrtf(wave_sum(x1 * x1 + x2 * x2) * (1.0f / 128.0f) + EPS);
        const float y1 = x1 * rs * (v < 8 ? wq0 : wk0), y2 = x2 * rs * (v < 8 ? wq1 : wk1);
        if (!lat && v >= 8) { float* o = out + O_GK + (((size_t)(b * 2 + l) * 256 + t) * 2 + (v - 8)) * 128 + 2 * lane; o[0] = y1; o[1] = y2; }
        const float qs = v < 8 ? 0.12751743f : 1.0f;
        *(unsigned*)(pw + col) = pkbf((y1 * cs - y2 * sn) * qs, (y1 * sn + y2 * cs) * qs);
    }
    if (lat) {
#pragma unroll
        for (int v = 0; v < 8; ++v) { const int col = (v < 4 ? C_DQ + 128 * v : C_DK + 128 * (v - 4)) + 2 * lane;
            const float x1 = bf2f((unsigned short)(rd[v] & 0xffffu)), x2 = bf2f((unsigned short)(rd[v] >> 16));
            *(unsigned*)(pw + col) = pkbf(x1 * c2 - x2 * s2, x1 * s2 + x2 * c2); }
    } else {
#pragma unroll
        for (int v = 0; v < 2; ++v) { float* o = out + O_GV + (((size_t)(b * 2 + l) * 256 + t) * 2 + v) * 128 + 2 * lane; o[0] = bf2f((unsigned short)(rv2[v] & 0xffffu)); o[1] = bf2f((unsigned short)(rv2[v] >> 16)); }
#pragma unroll
        for (int v = 0; v < 4; ++v) { const unsigned rk = rd[4 + v], rv = rv4[v];
            const size_t oi = (((size_t)(b * 2 + l) * 256 + t) * 4 + v) * 128 + 2 * lane;
            out[O_DK + oi] = bf2f((unsigned short)(rk & 0xffffu)); out[O_DK + oi + 1] = bf2f((unsigned short)(rk >> 16));
            out[O_DV + oi] = bf2f((unsigned short)(rv & 0xffffu)); out[O_DV + oi + 1] = bf2f((unsigned short)(rv >> 16)); }
    }
}
#ifndef EN_PRO
#define EN_PRO 1
#endif
#ifndef EN_NORM
#define EN_NORM 1
#endif
#ifndef EN_FFNIN
#define EN_FFNIN 1
#endif
#ifndef EN_FFNOUT
#define EN_FFNOUT 1
#endif
#ifndef EN_WIN
#define EN_WIN 1
#endif
#ifndef EN_P
#define EN_P 1
#endif
#ifndef EN_A
#define EN_A 1
#endif
#ifndef EN_A1
#define EN_A1 1
#endif
#ifndef EN_A2
#define EN_A2 1
#endif
#ifndef EN_A3
#define EN_A3 1
#endif
#ifndef EN_WOUT
#define EN_WOUT 1
#endif
#ifndef EN_FIN
#define EN_FIN 1
#endif
struct Args { const float* in[22]; float* out; unsigned char* ws; int ph_lo, ph_hi, pad0, pad1; };
constexpr int NPHASE = 30;
#define LAUNDER(p) asm volatile("" : "+s"(p))
struct InPtrs { const float* const* p; __device__ __forceinline__ const float* operator[](int i) const { return p[i]; } };
__device__ __forceinline__ int deal_unit(int i, int NL, int NC, int off, int G, int wg) {
    if (NL % G == 0) { const int nr = NL / G; if (i < nr) return i * G + wg; if (i > nr) return -1; const int c = (wg + G - off) % G; return c < NC ? NL + c : -1; }
    const int v = i * G + wg; return v < NL + NC ? v : -1;
}
__global__ void __launch_bounds__(512, 2) fwd_kernel(Args args) {
    extern __shared__ __attribute__((aligned(16))) unsigned char lds_raw[];
    LAS unsigned char* lds = (LAS unsigned char*)lds_raw;
    volatile LAS unsigned* MISC = (volatile LAS unsigned*)(lds + MISC_OFF);
    const int G = gridDim.x, wg = blockIdx.x;
    for (int u = threadIdx.x; u < (LDS_BYTES - 131072) / 4; u += 512) ((LAS unsigned*)(lds + 131072))[u] = 0u;
    __syncthreads();
    XcdBarrier bar = xcd_barrier_post((unsigned*)(args.ws + WS_CTL) + CW_BAR, MISC + 8);
    const int lo = args.ph_lo, hi = args.ph_hi;
#define IN(k) (lo <= (k) && (k) < hi)
#define SEAM(k) do { if (IN(k) && IN((k) + 1)) xcd_barrier(bar); } while (0)
#define PH_BEGIN size_t zoff_ = 0; asm volatile("" : "+s"(zoff_)); unsigned char* ws = args.ws + zoff_; float* out = args.out + zoff_;   \
    const InPtrs inp{args.in}; int tid = threadIdx.x; asm volatile("" : "+v"(tid)); \
    const int lane = tid & 63, wave = __builtin_amdgcn_readfirstlane(tid >> 6); (void)lane; (void)wave;

    if (IN(0)) { PH_BEGIN; (void)out; prologue(inp, ws, lds, G, wg, tid); }
    SEAM(0);
    if (IN(1)) { PH_BEGIN; (void)out; prologue_b(inp, ws, lds, G, wg, tid); }
    SEAM(1);
    if (IN(2)) { PH_BEGIN; (void)out;
        quant_phase(inp[0], inp[1] - (size_t)M_P * DM, inp[11], (const float*)(ws + WS_TAB) + TB_MOD + DM, ws + WS_XNB, (float*)(ws + WS_Q), (unsigned long long*)(ws + WS_RS), G, wg, tid);
        bias_phase(ws, lds, G, wg, tid); }
    SEAM(2);
#pragma unroll 1
    for (int l = 0; l < 2; ++l) {
        const int pb = 3 + 13 * l;
#pragma unroll 1
        for (int f = 0; f < 2; ++f) {
            const int fb = pb + 9 * f;
            if (IN(fb + 0)) { PH_BEGIN; (void)out; (void)inp; const bf16* WL = (const bf16*)(ws + WS_W + (size_t)l * W_LAYER);
                pg8::Gemm g{(const bf16*)(ws + WS_XNB), WL + (W_WI + (size_t)f * 44 * MiB) / 2, MTOK, NFF, DM / 2}; pg8::StaticOrder S; S.init(MTOK, NFF, G, wg);
                pg8::EpiSwiGLUQ E{ws + WS_A8B, DFF, (const unsigned long long*)(ws + WS_RS) + (size_t)(3 * l + 2 * f) * MTOK, (const float*)(ws + WS_Q), (const float*)(ws + WS_Q + Q_SW) + (size_t)(2 * l + f) * NFF,
                                  (const float*)(ws + WS_SB) + (size_t)l * SB_LAYER + (f ? SB_J2 : 0), NFF, (const float*)(ws + WS_Q + Q_ACT) + 2 * (2 * l + f)};
                pg8::gemm_phase<pg8::EpiSwiGLUQ, pg8::StaticOrder, true, true, true>(lds, g, S, E); }
            if (IN(fb + 0) && IN(fb + 2)) xcd_barrier(bar);
            if (IN(fb + 2)) { PH_BEGIN; float* X = out + O_X; const bool first = (l == 0 && f == 0); const unsigned char* WL8 = ws + WS_W + (size_t)l * W_LAYER + W_WO + (size_t)f * 22 * MiB;
                const float* tabf = (const float*)(ws + WS_TAB); const float* mod = tabf + TB_MOD + (size_t)l * NCOND * NMODC;
                pg8::Gemm g{(const bf16*)(ws + WS_A8B), (const bf16*)WL8, MTOK, DM, DFF / 2}; pg8::StaticOrder S; S.init(MTOK, DM, G, wg);
                const int ni = f ? 3 * (l + 1) : 3 * l + 1;
                const size_t rs_off = WS_RS + (size_t)ni * MTOK * 8;
                pg8::EpiResidN E{first ? inp[0] : X, first ? inp[1] - (size_t)M_P * DM : X, X, mod + (2 + 6 * f) * DM,
                                 inp[11] + (size_t)(f ? 3 : 3 * l + 1) * DM, f ? tabf + TB_MOD + (size_t)NCOND * NMODC + DM : mod + (size_t)4 * DM, (unsigned long long*)(ws + rs_off), (long)(f ? WS_ACT : WS_XN) - (long)rs_off, 0.5f, (f && l) ? 0 : 1,
                                 (long)(WS_Q + Q_ACT + (size_t)(2 * (2 * l + f) + 1) * 4) - (long)rs_off, (long)(WS_Q + Q_SW2 + (size_t)(2 * l + f) * DM * 4) - (long)rs_off, 2, 1, (long)(WS_CTL + CTL_AMAX + (size_t)ni * MTOK * 4) - (long)rs_off};
                pg8::gemm_phase<pg8::EpiResidN, pg8::StaticOrder, true, true, 2>(lds, g, S, E); }
            SEAM(fb + 2);
            if (f == 1) {
                if (l == 0 && IN(pb + 12)) { PH_BEGIN; float* X = out + O_X;
                    (void)X; quant_xs_phase((const bf16*)(ws + WS_ACT), (const unsigned*)(ws + WS_CTL + CTL_AMAX) + (size_t)3 * MTOK, ws + WS_XNB, (float*)(ws + WS_Q), G, wg, tid); }
                SEAM(pb + 12);
                break; }
            if (IN(pb + 3)) { PH_BEGIN; float* X = out + O_X;
                (void)X; quant_xs_phase((const bf16*)(ws + WS_XN), (const unsigned*)(ws + WS_CTL + CTL_AMAX) + (size_t)(3 * l + 1) * MTOK, ws + WS_XNB, (float*)(ws + WS_Q), G, wg, tid, M_P); }
            SEAM(pb + 3);
            if (IN(pb + 4)) {
                { PH_BEGIN; (void)out; (void)inp;
                  pg8::Gemm g{(const bf16*)(ws + WS_XNB + (size_t)M_P * DM), (const bf16*)(ws + WS_W + (size_t)l * W_LAYER + W_WINQ), M_S, NIN, DM / 2}; pg8::StaticOrder S; S.init(M_S, NIN, G, wg);
                  pg8::EpiStoreQ E{(bf16*)(ws + WS_ACT) + (size_t)M_P * NIN, NIN, (const unsigned long long*)(ws + WS_RS) + (size_t)(3 * l + 1) * MTOK + M_P, (const float*)(ws + WS_Q) + M_P,
                                   (const float*)(ws + WS_Q + Q_SW4) + (size_t)l * NIN, (const float*)(ws + WS_SB) + (size_t)l * SB_LAYER + SB_J1, NIN, 16};
                  pg8::gemm_phase<pg8::EpiStoreQ, pg8::StaticOrder, true, true, true>(lds, g, S, E); }
                { PH_BEGIN; (void)out; (void)inp; const bf16* WL = (const bf16*)(ws + WS_W + (size_t)l * W_LAYER);
                  pg8::Gemm g{(const bf16*)(ws + WS_XN), WL + W_WIN / 2, M_P, NIN, DM}; pg8::StaticOrder S; S.init(M_P, NIN, G, wg);
                  pg8::EpiStoreBf16N E{(bf16*)(ws + WS_ACT), NIN, (const unsigned long long*)(ws + WS_RS) + (size_t)(3 * l + 1) * MTOK, (const float*)(ws + WS_SB) + (size_t)l * SB_LAYER + SB_J1, NIN};
                  pg8::gemm_phase<pg8::EpiStoreBf16N, pg8::StaticOrder, true, true>(lds, g, S, E); }
            }
            SEAM(pb + 4);
            if (IN(pb + 5)) { PH_BEGIN; bf16* PROJ = (bf16*)(ws + WS_ACT); const float* tab = (const float*)(ws + WS_TAB);
#pragma unroll 1
                for (int ch = wg; ch < 192; ch += G) {
                    const bool lat = ch < 64; const int cc = lat ? ch : ch - 64, dir = cc & 1, h = (cc >> 1) & 3, b = cc >> 3;
                    att::ChainArgs a; a.P = PROJ + (size_t)(lat ? M_P + b * 4096 : b * 256) * NIN; a.kcol = C_RK + 128 * h; a.vcol = C_RV + 128 * h; a.nchunk = lat ? 32 : 2; a.dir = dir;
                    a.lg2 = tab[TB_SCAL + 16 * l + 2 + dir * 4 + h];
                    a.S0 = lat ? inp[3] + ((((size_t)b * 2 + l) * 2 + dir) * 4 + h) * 16384 : nullptr;
                    a.ST = (bf16*)(ws + WS_ST) + (lat ? (size_t)cc * 32 * 16384 : (size_t)64 * 32 * 16384 + (size_t)cc * 2 * 16384);
                    a.Sfin = lat ? nullptr : out + O_STATE + ((((size_t)b * 2 + l) * 2 + dir) * 4 + h) * 16384;
                    __syncthreads(); att::ret_chain(a, (char*)lds_raw);
                }
                const int w0 = G > 128 ? 64 : 0, gw = (wg - w0) * 8 + wave, NGW = (G - w0) * 8;
                if (wg >= w0) for (int m = gw; m < MTOK; m += NGW) prep_row(m, l, PROJ, PROJ, tab, inp[18] + l * 256, out, lane);
            }
            SEAM(pb + 5);
            if (IN(pb + 6)) { PH_BEGIN; (void)out; bf16* PROJ = (bf16*)(ws + WS_ACT); bf16* MIX = (bf16*)(ws + WS_XN); const float* tab = (const float*)(ws + WS_TAB);
                const bf16* CGK = (const bf16*)(ws + WS_CACHE);
#pragma unroll 1
                for (int rp = 0; rp < ((PROBE == 13 && l == 0) ? 2 : 1); ++rp)
#pragma unroll 1
                for (int i2 = 0;; ++i2) { const int ps = i2 & 1; const int u = deal_unit(i2 >> 1, 512, 64, 192, G, wg); if (u < 0) break;
                    const bool lat = u < 512; const int v = lat ? u : u - 512;
                    const int qb = lat ? (v & 15) : 0, h = lat ? ((v >> 4) & 3) : (v & 3), b = lat ? (v >> 6) : (v >> 2);
                    const size_t row0 = lat ? (size_t)M_P + (size_t)b * 4096 : (size_t)b * 256;
                    const float lam = tab[TB_SCAL + 16 * l + 0], post = tab[TB_SCAL + 16 * l + 1];
                    {
                        att::KVSrc kv; kv.K1 = PROJ + row0 * NIN + C_DK + 128 * h + 64 * ps; kv.V1 = PROJ + row0 * NIN + C_DV + 128 * h; kv.n1 = lat ? 4096 : 256;
                        kv.K2 = CGK + 2097152 + ((size_t)(b * 2 + l) * 256) * 512 + 128 * h + 64 * ps; kv.V2 = CGK + 4194304 + ((size_t)(b * 2 + l) * 256) * 512 + 128 * h; kv.n2 = lat ? 256 : 0;
                        att::AttnOut ao; ao.Ob = MIX + (row0 + 256 * qb) * DM + 1536 + 128 * h; ao.Of = (float*)(ws + WS_DF) + (row0 + 256 * qb) * 512 + 128 * h;
                        ao.nw = inp[20] + l * 512 + 128 * h; ao.lam = lam; ao.post = post; ao.pass = ps;
                        __syncthreads();
                        att::attn_body<64, 1, 512>(PROJ + (row0 + 256 * qb) * NIN + C_DQ + 128 * h + 64 * ps, kv, ao, (char*)lds_raw);
                    }
                }
                const bool nomax = tab[TB_SCAL + 16 * l + 10] != 0.f;
#pragma unroll 1
                for (int rp = 0; rp < ((PROBE == 14 && l == 0) ? 2 : 1); ++rp)
#pragma unroll 1
                for (int i = 0;; ++i) { const int u = deal_unit(i, 1024, 128, 64, G, wg); if (u < 0) break;
                    const bool lat = u < 1024; const int v = lat ? u : u - 1024;
                    const int qb = lat ? (v & 15) : 0, hq = lat ? ((v >> 4) & 7) : (v & 7), b = lat ? (v >> 7) : (v >> 3), kvh = hq >> 2;
                    const size_t row0 = lat ? (size_t)M_P + (size_t)b * 4096 : (size_t)b * 256;
                    att::KVSrc kv; kv.K1 = PROJ + row0 * NIN + C_GK + 128 * kvh; kv.V1 = PROJ + row0 * NIN + C_GV + 128 * kvh; kv.n1 = lat ? 4096 : 256;
                    kv.K2 = CGK + ((size_t)(b * 2 + l) * 256) * 256 + 128 * kvh; kv.V2 = CGK + 1048576 + ((size_t)(b * 2 + l) * 256) * 256 + 128 * kvh; kv.n2 = lat ? 256 : 0;
                    att::AttnOut ao; ao.Ob = MIX + (row0 + 256 * qb) * DM + 512 + 128 * hq; ao.Of = nullptr; ao.nw = nullptr; ao.lam = 0.f; ao.post = 0.f; ao.pass = 0;
                    __syncthreads();
                    if (nomax) att::attn_body<128, 0, 256, 1>(PROJ + (row0 + 256 * qb) * NIN + C_GQ + 128 * hq, kv, ao, (char*)lds_raw);
                    else att::attn_body<128, 0, 256, 2>(PROJ + (row0 + 256 * qb) * NIN + C_GQ + 128 * hq, kv, ao, (char*)lds_raw);
                }
#pragma unroll 1
                for (int rp = 0; rp < ((PROBE == 15 && l == 0) ? 2 : 1); ++rp)
#pragma unroll 1
                for (int i = 0;; ++i) { const int u = deal_unit(i, 512, 64, 0, G, wg); if (u < 0) break;
                    const bool lat = u < 512; const int v = lat ? u : u - 512;
                    const int pr = lat ? (v & 15) : 0, h = lat ? ((v >> 4) & 3) : (v & 3), b = lat ? (v >> 6) : (v >> 2);
                    const size_t row0 = (lat ? (size_t)M_P + (size_t)b * 4096 : (size_t)b * 256) + 256 * pr;
                    att::RetCArgs a; a.P = PROJ + row0 * NIN; a.qcol = C_RQ + 128 * h; a.kcol = C_RK + 128 * h; a.vcol = C_RV + 128 * h; a.gcol = C_RG + 128 * h;
                    a.lg2f = tab[TB_SCAL + 16 * l + 2 + h]; a.lg2b = tab[TB_SCAL + 16 * l + 6 + h];
                    const int cf = (b * 4 + h) * 2; const bf16* STB = (const bf16*)(ws + WS_ST);
                    a.STf = STB + (lat ? (size_t)cf * 32 * 16384 : (size_t)64 * 32 * 16384 + (size_t)cf * 2 * 16384) + (size_t)(2 * pr) * 16384;
                    a.STb = STB + (lat ? (size_t)(cf + 1) * 32 * 16384 : (size_t)64 * 32 * 16384 + (size_t)(cf + 1) * 2 * 16384) + (size_t)(2 * pr) * 16384;
                    a.gnw = inp[17] + l * 512 + 128 * h; a.O = MIX + row0 * DM + 128 * h;
                    __syncthreads();
                    att::ret_c(a, (char*)lds_raw);
                }
            }
            SEAM(pb + 6);
            if (IN(pb + 7)) { PH_BEGIN; float* X = out + O_X; const bf16* WL = (const bf16*)(ws + WS_W + (size_t)l * W_LAYER);
                const float* mod = (const float*)(ws + WS_TAB) + TB_MOD + (size_t)l * NCOND * NMODC;
                pg8::Gemm g{(const bf16*)(ws + WS_XN), WL + W_WOUT / 2, MTOK, DM, DM}; pg8::StaticOrder S; S.init(MTOK, DM, G, wg);
                const size_t rs_off = WS_RS + (size_t)(3 * l + 2) * MTOK * 8;
                pg8::EpiResidN E{X, X, X, mod + 5 * DM, inp[11] + ((size_t)l * 3 + 2) * DM, mod + 7 * DM, (unsigned long long*)(ws + rs_off), (long)WS_ACT - (long)rs_off, 1.0f, 1, (long)WS_Q - (long)rs_off, (long)WS_Q - (long)rs_off, 0, 1, (long)(WS_CTL + CTL_AMAX + (size_t)(3 * l + 2) * MTOK * 4) - (long)rs_off};
                pg8::gemm_phase<pg8::EpiResidN, pg8::StaticOrder, true, true>(lds, g, S, E); }
            SEAM(pb + 7);
            if (IN(pb + 8)) { PH_BEGIN; float* X = out + O_X;
                (void)X; quant_xs_phase((const bf16*)(ws + WS_ACT), (const unsigned*)(ws + WS_CTL + CTL_AMAX) + (size_t)(3 * l + 2) * MTOK, ws + WS_XNB, (float*)(ws + WS_Q), G, wg, tid); }
            SEAM(pb + 8);
        }
    }
    if (IN(29)) { PH_BEGIN; (void)ws; final_norm(out + O_X, inp[21], G, wg, tid); }
#undef IN
#undef SEAM
#undef PH_BEGIN
}

extern "C" void kernel_launch(void* const* d_in, const int* in_sizes, int n_in, void* d_out, int out_size, void* d_ws, size_t ws_size, hipStream_t stream) {
    static int grid = 0;
    if (grid == 0) {
        if (n_in != 22 || out_size != (int)O_END || ws_size < WS_END) { fprintf(stderr, "kernel_launch: unexpected shapes: n_in %d out %d ws %zu (need %zu)\n", n_in, out_size, ws_size, (size_t)WS_END); grid = -1; return; }
        int dev = 0, cus = 0, per_cu = 0;
        if (hipGetDevice(&dev) != hipSuccess || hipDeviceGetAttribute(&cus, hipDeviceAttributeMultiprocessorCount, dev) != hipSuccess) { grid = -1; return; }
        if (hipFuncSetAttribute((const void*)fwd_kernel, hipFuncAttributeMaxDynamicSharedMemorySize, LDS_BYTES) != hipSuccess) { fprintf(stderr, "kernel_launch: hipFuncSetAttribute failed\n"); grid = -1; return; }
        if (hipOccupancyMaxActiveBlocksPerMultiprocessor(&per_cu, (const void*)fwd_kernel, 512, LDS_BYTES) != hipSuccess || per_cu < 1) { fprintf(stderr, "kernel_launch: occupancy query says %d\n", per_cu); }
        (void)hipGetLastError();
        grid = cus;
    }
    if (grid < 0) return;
    (void)hipMemsetAsync((char*)d_ws + WS_CTL, 0, CTL_ZERO_BYTES, stream);
    (void)hipMemsetAsync((char*)d_ws + WS_RS, 0, 2 * MiB, stream);
    Args a{};
    for (int i = 0; i < 22; ++i) a.in[i] = (const float*)d_in[i];
    a.out = (float*)d_out; a.ws = (unsigned char*)d_ws; a.ph_lo = 0; a.ph_hi = NPHASE; a.pad0 = 0; a.pad1 = 0;
    hipLaunchKernelGGL(fwd_kernel, dim3(grid), dim3(512), LDS_BYTES, stream, a);
}
```

```cpp
#include <hip/hip_runtime.h>
#include <hip/hip_bf16.h>
#include <cstdio>
#include <cstdint>
#ifndef PROBE
#define PROBE 0
#endif
#ifndef FFN_MB
#define FFN_MB 4
#endif
__device__ __forceinline__ float qm(float x) { if (FFN_MB >= 7) return x; unsigned u = __float_as_uint(x); constexpr unsigned sh = 23 - FFN_MB; u = (u + ((1u << (sh - 1)) - 1u) + ((u >> sh) & 1u)) & ~((1u << sh) - 1u); return __uint_as_float(u); }
#ifndef DBGT_CLK
#define DBGT_CLK 0
#endif
#ifndef DBGT_PH
#define DBGT_PH -1
#endif
namespace pg8 {
#define PG8_LAS __attribute__((address_space(3)))
typedef unsigned short bf16_t;
typedef short bf16x8 __attribute__((ext_vector_type(8)));
typedef float f32x4 __attribute__((ext_vector_type(4)));
typedef unsigned u32x4 __attribute__((ext_vector_type(4)));
typedef int i32x4 __attribute__((ext_vector_type(4)));
constexpr int BM = 256, BK = 64, HALF = 128, HTB = HALF * BK * 2  , STAGE_BYTES = 8 * HTB, NXCD = 8, WGM = 4;

__host__ __device__ __forceinline__ int lds_byte(int r, int c) { const int st = (r >> 4) * 2 + (c >> 5), rr = r & 15, cc = c & 31, ob = rr * 64 + cc * 2; return st * 1024 + (ob ^ (((ob >> 9) & 1) << 5)); }
__host__ __device__ __forceinline__ void stage_rc(int b, int& R, int& C) { const int st = b / 1024, sb = b % 1024, swz = sb ^ (((sb >> 9) & 1) << 5); R = (st >> 1) * 16 + swz / 64; C = (st & 1) * 32 + (swz % 64) / 2; }
__host__ __device__ __forceinline__ int perm32(int rho) { const int n = rho >> 4, i = rho & 15; return 8 * (i >> 2) + 4 * n + (i & 3); }

struct Unit { int pm, pn; };
struct Gemm { const bf16_t* A; const bf16_t* Bt; int M, N, K; };

struct StaticOrder {
    int nM, nN, nwg, G, c;
    __host__ __device__ void init(int M, int N, int G_, int c_) { nM = M / BM; nN = N / BM; nwg = nM * nN; G = G_; c = c_; }
    __host__ __device__ bool next(int i, Unit& u) const {
        const long L = (long)i * G + c; if (L >= nwg) return false;
        int wgid = (int)L; { const int q = nwg / NXCD, r = nwg % NXCD, xcd = wgid % NXCD, off = wgid / NXCD; wgid = (xcd < r ? xcd * (q + 1) : r * (q + 1) + (xcd - r) * q) + off; }
        const int nig = WGM * nN, gid = wgid / nig, fm = gid * WGM, gsz = (nM - fm) < WGM ? (nM - fm) : WGM;
        u.pm = fm + ((wgid % nig) % gsz); u.pn = (wgid % nig) / gsz; return true;
    }
    __device__ __forceinline__ void a_ready(const Unit&) const {}
    __device__ __forceinline__ void done(const Unit&) const {}
};

__device__ __forceinline__ unsigned cvt_pk_bf16(float lo, float hi) { unsigned r; asm volatile("v_cvt_pk_bf16_f32 %0, %1, %2" : "=v"(r) : "v"(lo), "v"(hi)); return r; }
typedef float f32x2 __attribute__((ext_vector_type(2)));
struct EpiStoreBf16 {
    static constexpr bool PERM = true, AFTER_DRAIN = false;
    bf16_t* O; int ldc;
    __device__ __forceinline__ void operator()(const f32x4 (&acc)[2][2][4][2], const Unit& u, int wr, int wc, int fr, int fq) const {
        const int row0 = u.pm * BM + wr * 64 + fr, col0 = u.pn * BM + wc * 32 + 8 * fq;
#pragma unroll
        for (int ai = 0; ai < 2; ++ai)
#pragma unroll
            for (int m = 0; m < 4; ++m) { bf16_t* rowp = O + (size_t)(row0 + ai * HALF + m * 16) * ldc + col0;
#pragma unroll
                for (int bj = 0; bj < 2; ++bj) { const f32x4 v0 = acc[ai][bj][m][0], v1 = acc[ai][bj][m][1];
                    u32x4 w; w.x = cvt_pk_bf16(v0[0], v0[1]); w.y = cvt_pk_bf16(v0[2], v0[3]); w.z = cvt_pk_bf16(v1[0], v1[1]); w.w = cvt_pk_bf16(v1[2], v1[3]);
                    *(u32x4*)(rowp + bj * HALF) = w; } }
    }
};
__device__ __forceinline__ float silu_f(float g) { return g * __builtin_amdgcn_rcpf(1.0f + __builtin_amdgcn_exp2f(-1.4426950408889634f * g)); }
struct EpiSwiGLU {
    static constexpr bool PERM = true, AFTER_DRAIN = false;
    bf16_t* O; int ldc;
    __device__ __forceinline__ void operator()(const f32x4 (&acc)[2][2][4][2], const Unit& u, int wr, int wc, int fr, int fq) const {
        const int row0 = u.pm * BM + wr * 64 + fr, col0 = u.pn * HALF + wc * 32 + 8 * fq;
#pragma unroll
        for (int ai = 0; ai < 2; ++ai)
#pragma unroll
            for (int m = 0; m < 4; ++m) { bf16_t* rowp = O + (size_t)(row0 + ai * HALF + m * 16) * ldc + col0;
                const f32x4 g0 = acc[ai][0][m][0], g1 = acc[ai][0][m][1], u0 = acc[ai][1][m][0], u1 = acc[ai][1][m][1];
                u32x4 w; w.x = cvt_pk_bf16(silu_f(g0[0]) * u0[0], silu_f(g0[1]) * u0[1]); w.y = cvt_pk_bf16(silu_f(g0[2]) * u0[2], silu_f(g0[3]) * u0[3]);
                w.z = cvt_pk_bf16(silu_f(g1[0]) * u1[0], silu_f(g1[1]) * u1[1]); w.w = cvt_pk_bf16(silu_f(g1[2]) * u1[2], silu_f(g1[3]) * u1[3]);
                *(u32x4*)rowp = w; }
    }
};
struct EpiResid {
    static constexpr bool PERM = false, AFTER_DRAIN = false;
    const float* baseP; const float* baseS; float* out; const float* gate; float coef;
    __device__ __forceinline__ void operator()(const f32x4 (&acc)[2][2][4][2], const Unit& u, int wr, int wc, int fr, int fq) const {
        const int cond = u.pm < 16 ? 0 : 1 + ((u.pm - 16) >> 4);
        const float* g = gate + (size_t)cond * 18432; const float* base = u.pm < 16 ? baseP : baseS;
        const int row0 = u.pm * BM + wr * 64 + fr, col0 = u.pn * BM + wc * 32 + 4 * fq;
        f32x4 gv[2][2];
#pragma unroll
        for (int bj = 0; bj < 2; ++bj)
#pragma unroll
            for (int n = 0; n < 2; ++n) gv[bj][n] = *(const f32x4*)(g + col0 + bj * HALF + n * 16) * coef;
#pragma unroll
        for (int ai = 0; ai < 2; ++ai)
#pragma unroll
            for (int m = 0; m < 4; ++m) { const size_t off = (size_t)(row0 + ai * HALF + m * 16) * 2048 + col0;
#pragma unroll
                for (int bj = 0; bj < 2; ++bj)
#pragma unroll
                    for (int n = 0; n < 2; ++n) { const f32x4 b = *(const f32x4*)(base + off + bj * HALF + n * 16);
                        *(f32x4*)(out + off + bj * HALF + n * 16) = b + gv[bj][n] * acc[ai][bj][m][n]; }
                if (m == 3) asm volatile("" ::: "memory"); }
    }
};

__device__ __forceinline__ float rstd_of(const unsigned long long* rss, int row) { return rsqrtf((float)rss[row] * (1.0f / 16777216.0f) * (1.0f / 2048.0f) + 1e-6f); }
struct EpiStoreBf16N {
    static constexpr bool PERM = true, AFTER_DRAIN = false;
    bf16_t* O; int ldc; const unsigned long long* rss; const float* bias; int ldb;
    __device__ __forceinline__ void operator()(const f32x4 (&acc)[2][2][4][2], const Unit& u, int wr, int wc, int fr, int fq) const {
        const int cond = u.pm < 16 ? 0 : 1 + ((u.pm - 16) >> 4);
        const int row0 = u.pm * BM + wr * 64 + fr, col0 = u.pn * BM + wc * 32 + 8 * fq;
        const float* b = bias + (size_t)cond * ldb + col0;
        f32x4 bv[2][2];
#pragma unroll
        for (int bj = 0; bj < 2; ++bj)
#pragma unroll
            for (int n = 0; n < 2; ++n) bv[bj][n] = *(const f32x4*)(b + bj * HALF + 4 * n);
#pragma unroll
        for (int ai = 0; ai < 2; ++ai)
#pragma unroll
            for (int m = 0; m < 4; ++m) { const int row = row0 + ai * HALF + m * 16; const float rs = rstd_of(rss, row); bf16_t* rowp = O + (size_t)row * ldc + col0;
#pragma unroll
                for (int bj = 0; bj < 2; ++bj) { const f32x4 v0 = acc[ai][bj][m][0] * rs + bv[bj][0], v1 = acc[ai][bj][m][1] * rs + bv[bj][1];
                    u32x4 w; w.x = cvt_pk_bf16(v0[0], v0[1]); w.y = cvt_pk_bf16(v0[2], v0[3]); w.z = cvt_pk_bf16(v1[0], v1[1]); w.w = cvt_pk_bf16(v1[2], v1[3]);
                    *(u32x4*)(rowp + bj * HALF) = w; } }
    }
};
struct EpiSwiGLUN {
    static constexpr bool PERM = true, AFTER_DRAIN = false;
    bf16_t* O; int ldc; const unsigned long long* rss; const float* bias; int ldb;
    __device__ __forceinline__ void operator()(const f32x4 (&acc)[2][2][4][2], const Unit& u, int wr, int wc, int fr, int fq) const {
        const int cond = u.pm < 16 ? 0 : 1 + ((u.pm - 16) >> 4);
        const int row0 = u.pm * BM + wr * 64 + fr, col0 = u.pn * HALF + wc * 32 + 8 * fq;
        const float* b = bias + (size_t)cond * ldb + u.pn * BM + wc * 32 + 8 * fq;
        const f32x4 bg0 = *(const f32x4*)(b), bg1 = *(const f32x4*)(b + 4), bu0 = *(const f32x4*)(b + HALF), bu1 = *(const f32x4*)(b + HALF + 4);
#pragma unroll
        for (int ai = 0; ai < 2; ++ai)
#pragma unroll
            for (int m = 0; m < 4; ++m) { const int row = row0 + ai * HALF + m * 16; const float rs = rstd_of(rss, row); bf16_t* rowp = O + (size_t)row * ldc + col0;
                const f32x4 g0 = acc[ai][0][m][0] * rs + bg0, g1 = acc[ai][0][m][1] * rs + bg1, u0 = acc[ai][1][m][0] * rs + bu0, u1 = acc[ai][1][m][1] * rs + bu1;
                u32x4 w; w.x = cvt_pk_bf16(qm(silu_f(g0[0]) * u0[0]), qm(silu_f(g0[1]) * u0[1])); w.y = cvt_pk_bf16(qm(silu_f(g0[2]) * u0[2]), qm(silu_f(g0[3]) * u0[3]));
                w.z = cvt_pk_bf16(qm(silu_f(g1[0]) * u1[0]), qm(silu_f(g1[1]) * u1[1])); w.w = cvt_pk_bf16(qm(silu_f(g1[2]) * u1[2]), qm(silu_f(g1[3]) * u1[3]));
                *(u32x4*)rowp = w; }
    }
};
struct EpiStoreQ {
    static constexpr bool PERM = true, AFTER_DRAIN = false;
    bf16_t* O; int ldc; const unsigned long long* rss; const float* sa; const float* sw; const float* bias; int ldb; int pm_off;
    __device__ __forceinline__ void operator()(const f32x4 (&acc)[2][2][4][2], const Unit& u, int wr, int wc, int fr, int fq) const {
        const int pmg = u.pm + pm_off, cond = pmg < 16 ? 0 : 1 + ((pmg - 16) >> 4);
        const int row0 = u.pm * BM + wr * 64 + fr, col0 = u.pn * BM + wc * 32 + 8 * fq;
        const float* b = bias + (size_t)cond * ldb + col0; const float* w = sw + col0;
        f32x4 bv[2][2], wv[2][2];
#pragma unroll
        for (int bj = 0; bj < 2; ++bj)
#pragma unroll
            for (int n = 0; n < 2; ++n) { bv[bj][n] = *(const f32x4*)(b + bj * HALF + 4 * n); wv[bj][n] = *(const f32x4*)(w + bj * HALF + 4 * n); }
#pragma unroll
        for (int ai = 0; ai < 2; ++ai)
#pragma unroll
            for (int m = 0; m < 4; ++m) { const int row = row0 + ai * HALF + m * 16; const float rs = rstd_of(rss, row) * sa[row]; bf16_t* rowp = O + (size_t)row * ldc + col0;
#pragma unroll
                for (int bj = 0; bj < 2; ++bj) { const f32x4 v0 = acc[ai][bj][m][0] * rs * wv[bj][0] + bv[bj][0], v1 = acc[ai][bj][m][1] * rs * wv[bj][1] + bv[bj][1];
                    u32x4 w4; w4.x = cvt_pk_bf16(v0[0], v0[1]); w4.y = cvt_pk_bf16(v0[2], v0[3]); w4.z = cvt_pk_bf16(v1[0], v1[1]); w4.w = cvt_pk_bf16(v1[2], v1[3]);
                    *(u32x4*)(rowp + bj * HALF) = w4; } }
    }
};
__device__ __forceinline__ float sat448(float x) { return __builtin_fminf(__builtin_fmaxf(x, -448.0f), 448.0f); }
__device__ __forceinline__ f32x4 swiglu4(const f32x4 g, const f32x4 u) {
    const f32x4 t = g * -1.4426950408889634f; f32x4 e;
#pragma unroll
    for (int i = 0; i < 4; ++i) e[i] = __builtin_amdgcn_exp2f(t[i]);
    const f32x4 d = e + 1.0f; f32x4 r;
#pragma unroll
    for (int i = 0; i < 4; ++i) r[i] = __builtin_amdgcn_rcpf(d[i]);
    return (g * u) * r;
}
struct EpiSwiGLUQ {
    static constexpr bool PERM = true, AFTER_DRAIN = false;
    unsigned char* O; int ldc; const unsigned long long* rss; const float* sa; const float* sw; const float* bias; int ldb; const float* act_s;
    __device__ __forceinline__ void operator()(const f32x4 (&acc)[2][2][4][2], const Unit& u, int wr, int wc, int fr, int fq) const {
        const int cond = u.pm < 16 ? 0 : 1 + ((u.pm - 16) >> 4);
        const int row0 = u.pm * BM + wr * 64 + fr, col0 = u.pn * HALF + wc * 32 + 8 * fq, bcol = u.pn * BM + wc * 32 + 8 * fq;
        const float* b = bias + (size_t)cond * ldb + bcol; const float* w = sw + bcol;
        const f32x4 bg0 = *(const f32x4*)(b), bg1 = *(const f32x4*)(b + 4), bu0 = *(const f32x4*)(b + HALF), bu1 = *(const f32x4*)(b + HALF + 4);
        const f32x4 wg0 = *(const f32x4*)(w), wg1 = *(const f32x4*)(w + 4), wu0 = *(const f32x4*)(w + HALF), wu1 = *(const f32x4*)(w + HALF + 4);
        const float as = act_s[0];
#pragma unroll
        for (int ai = 0; ai < 2; ++ai)
#pragma unroll
            for (int m = 0; m < 4; ++m) { const int row = row0 + ai * HALF + m * 16; const float rs = rstd_of(rss, row) * sa[row]; unsigned char* rowp = O + (size_t)row * ldc + col0;
                const f32x4 g0 = acc[ai][0][m][0] * rs * wg0 + bg0, g1 = acc[ai][0][m][1] * rs * wg1 + bg1, u0 = (acc[ai][1][m][0] * rs * wu0 + bu0) * as, u1 = (acc[ai][1][m][1] * rs * wu1 + bu1) * as;
                const f32x4 h0 = swiglu4(g0, u0), h1 = swiglu4(g1, u1);
                unsigned w0 = __builtin_amdgcn_cvt_pk_fp8_f32(sat448(h0[0]), sat448(h0[1]), 0, false); w0 = __builtin_amdgcn_cvt_pk_fp8_f32(sat448(h0[2]), sat448(h0[3]), w0, true);
                unsigned w1 = __builtin_amdgcn_cvt_pk_fp8_f32(sat448(h1[0]), sat448(h1[1]), 0, false); w1 = __builtin_amdgcn_cvt_pk_fp8_f32(sat448(h1[2]), sat448(h1[3]), w1, true);
                uint2 wv; wv.x = w0; wv.y = w1; *(uint2*)rowp = wv; }
    }
};
struct EpiResidN {
    static constexpr bool PERM = false, AFTER_DRAIN = false;
    const float* baseP; const float* baseS; float* out; const float* gate; const float* nw; const float* scl; unsigned long long* rss; long xs_delta;   float coef; int do_xs; long sa_delta, sw_delta; int q8; int xs_all = 0; long am_delta = 0;
    __device__ __forceinline__ void operator()(const f32x4 (&acc)[2][2][4][2], const Unit& u, int wr, int wc, int fr, int fq) const {
        const int cond = u.pm < 16 ? 0 : 1 + ((u.pm - 16) >> 4); const int do_xs = (this->do_xs && (xs_all || u.pm < 16)) ? this->do_xs : 0;     bf16_t* xs = (bf16_t*)((char*)rss + xs_delta); const float* sa = (const float*)((char*)rss + sa_delta); const float* swc = (const float*)((char*)rss + sw_delta);
        const float* g = gate + (size_t)cond * 18432; const float* base = u.pm < 16 ? baseP : baseS;
        const int row0 = u.pm * BM + wr * 64 + fr, col0 = u.pn * BM + wc * 32 + 4 * fq;
        f32x4 gv[2][2], av[2][2];
#pragma unroll
        for (int bj = 0; bj < 2; ++bj)
#pragma unroll
            for (int n = 0; n < 2; ++n) { gv[bj][n] = *(const f32x4*)(g + col0 + bj * HALF + n * 16); av[bj][n] = q8 ? *(const f32x4*)(swc + col0 + bj * HALF + n * 16) : (f32x4){1.f, 1.f, 1.f, 1.f}; }
        f32x4 t0[2][2], t1[2][2];
#pragma unroll
        for (int bj = 0; bj < 2; ++bj)
#pragma unroll
            for (int n = 0; n < 2; ++n) { t0[bj][n] = do_xs ? *(const f32x4*)(nw + col0 + bj * HALF + n * 16) : (f32x4){0.f, 0.f, 0.f, 0.f}; t1[bj][n] = do_xs ? *(const f32x4*)(scl + (size_t)cond * 18432 + col0 + bj * HALF + n * 16) : (f32x4){0.f, 0.f, 0.f, 0.f}; }
#pragma unroll
        for (int bj = 0; bj < 2; ++bj)
#pragma unroll
            for (int n = 0; n < 2; ++n) { gv[bj][n] = gv[bj][n] * coef * av[bj][n]; av[bj][n] = t0[bj][n] * (t1[bj][n] + 1.0f); }
#pragma unroll
        for (int ai2 = 0; ai2 < 4; ++ai2) { const int ai = ai2 >> 1, m0 = (ai2 & 1) * 2;
            f32x4 bb[2][2][2];
#pragma unroll
            for (int mm = 0; mm < 2; ++mm)
#pragma unroll
                for (int bj = 0; bj < 2; ++bj)
#pragma unroll
                    for (int n = 0; n < 2; ++n) bb[mm][bj][n] = *(const f32x4*)(base + (size_t)(row0 + ai * HALF + (m0 + mm) * 16) * 2048 + col0 + bj * HALF + n * 16);
#pragma unroll
            for (int mm = 0; mm < 2; ++mm) { const int m = m0 + mm; const int row = row0 + ai * HALF + m * 16; const size_t off = (size_t)row * 2048 + col0; float ss = 0.f, amx = 0.f; const float sr = q8 == 2 ? sa[0] : q8 ? sa[row] : 1.0f;
#pragma unroll
                for (int bj = 0; bj < 2; ++bj)
#pragma unroll
                    for (int n = 0; n < 2; ++n) { const f32x4 b = bb[mm][bj][n]; const f32x4 o = b + gv[bj][n] * (acc[ai][bj][m][n] * sr);
                        *(f32x4*)(out + off + bj * HALF + n * 16) = o;
                        if (do_xs) { f32x4 q = o * av[bj][n]; if (do_xs == 2) { q[0] = qm(q[0]); q[1] = qm(q[1]); q[2] = qm(q[2]); q[3] = qm(q[3]); } ss += (o[0] * o[0] + o[1] * o[1]) + (o[2] * o[2] + o[3] * o[3]); amx = fmaxf(fmaxf(amx, fmaxf(fabsf(q[0]), fabsf(q[1]))), fmaxf(fabsf(q[2]), fabsf(q[3])));
                            uint2 w2; w2.x = cvt_pk_bf16(q[0], q[1]); w2.y = cvt_pk_bf16(q[2], q[3]); *(uint2*)(xs + off + bj * HALF + n * 16) = w2; } }
                if (do_xs) { ss += __shfl_xor(ss, 16); ss += __shfl_xor(ss, 32); if (fq == 0) atomicAdd(rss + row, (unsigned long long)(ss * 16777216.0f));
                    if (xs_all) { amx = fmaxf(amx, __shfl_xor(amx, 16)); amx = fmaxf(amx, __shfl_xor(amx, 32)); if (fq == 0) atomicMax((unsigned*)((char*)rss + am_delta) + row, __float_as_uint(amx)); } }
                if (mm == 1) asm volatile("" ::: "memory"); } }
    }
};
typedef int i32x8 __attribute__((ext_vector_type(8)));
__device__ __forceinline__ void mfma_f8_128(f32x4& c, const i32x8 a, const i32x8 b) { asm volatile("v_mfma_f32_16x16x128_f8f6f4 %0, %1, %2, %0" : "+v"(c) : "v"(a), "v"(b)); }
template <class Epi, class Sched, bool ALIGN_EPI = false, bool SP2 = false, int I8 = 0>
__device__ __forceinline__ void gemm_phase(PG8_LAS unsigned char* lds, const Gemm g, const Sched& S, const Epi& E) {
    int tid_ = threadIdx.x; asm volatile("" : "+v"(tid_));
    const int tid = tid_, wid = __builtin_amdgcn_readfirstlane(tid >> 6), lane = tid & 63, wr = wid >> 2, wc = wid & 3, fr = lane & 15, fq = lane >> 4;
    const int K = g.K, nt = K / BK;
    unsigned voffA[2], voffB[2];
#pragma unroll
    for (int i = 0; i < 2; ++i) { int R, C; stage_rc(tid * 16 + i * 8192, R, C); const int Rb = Epi::PERM ? ((R & ~31) + perm32(R & 31)) : R;
        voffA[i] = (unsigned)(R * K + C) * 2u; voffB[i] = (unsigned)(Rb * BK + C) * 2u; }
    const size_t kstep = (size_t)(BK * 2);
    const size_t hstep = (size_t)HALF * K * 2;
    const size_t tstep = 2 * hstep;
    const size_t kstepB = (size_t)BM * BK * 2, hstepB = (size_t)HALF * BK * 2;
    const unsigned ldsw = (unsigned)wid * 1024u;
    const int aoff = lds_byte(wr * 64 + fr, fq * 8), boff = lds_byte(wc * 32 + fr, fq * 8);
#define PG8_SA(b, h) (((b) * 2 + (h)) * HTB)
#define PG8_SB(b, h) ((4 + (b) * 2 + (h)) * HTB)
#define PG8_STAGE(bufoff, gbase, voff) do { _Pragma("unroll") for (int _i = 0; _i < 2; ++_i) \
        __builtin_amdgcn_global_load_lds((const unsigned*)((const char*)(gbase) + (voff)[_i]), (PG8_LAS unsigned*)(lds + (bufoff) + ldsw + _i * 8192), 16, 0, 0); } while (0)
#define PG8_LDA(dst, b, h) do { _Pragma("unroll") for (int m = 0; m < 4; ++m) _Pragma("unroll") for (int k = 0; k < 2; ++k) dst[m][k] = *(const PG8_LAS bf16x8*)(lds + PG8_SA(b, h) + aoff + m * 2048 + k * 1024); } while (0)
#define PG8_LDB(dst, b, h) do { _Pragma("unroll") for (int n = 0; n < 2; ++n) _Pragma("unroll") for (int k = 0; k < 2; ++k) dst[n][k] = *(const PG8_LAS bf16x8*)(lds + PG8_SB(b, h) + boff + n * 2048 + k * 1024); } while (0)
#define PG8_MMA(ai, bj, At, Bt) do { __builtin_amdgcn_s_setprio(1); _Pragma("unroll") for (int m = 0; m < 4; ++m) _Pragma("unroll") for (int n = 0; n < 2; ++n) { if constexpr (I8 == 2) { \
        mfma_f8_128(acc[ai][bj][m][n], __builtin_shufflevector(__builtin_bit_cast(i32x4, Bt[n][0]), __builtin_bit_cast(i32x4, Bt[n][1]), 0, 1, 2, 3, 4, 5, 6, 7), \
            __builtin_shufflevector(__builtin_bit_cast(i32x4, At[m][0]), __builtin_bit_cast(i32x4, At[m][1]), 0, 1, 2, 3, 4, 5, 6, 7)); } else _Pragma("unroll") for (int k = 0; k < 2; ++k) { \
        if constexpr (I8 == 1) acc[ai][bj][m][n] = __builtin_bit_cast(f32x4, __builtin_amdgcn_mfma_i32_16x16x64_i8(__builtin_bit_cast(i32x4, Bt[n][k]), __builtin_bit_cast(i32x4, At[m][k]), __builtin_bit_cast(i32x4, acc[ai][bj][m][n]), 0, 0, 0)); \
        else acc[ai][bj][m][n] = __builtin_amdgcn_mfma_f32_16x16x32_bf16(Bt[n][k], At[m][k], acc[ai][bj][m][n], 0, 0, 0); } } __builtin_amdgcn_s_setprio(0); } while (0)
#define PG8_WAIT_V(n) asm volatile("s_waitcnt vmcnt(" #n ")" ::: "memory")
#define PG8_WAIT_L(n) asm volatile("s_waitcnt lgkmcnt(" #n ")" ::: "memory")
#define PG8_BAR __builtin_amdgcn_s_barrier()
#define PG8_SCHED __builtin_amdgcn_sched_barrier(0)
    Unit cur, nxt; int ui = 0;
    if (!S.next(0, cur)) return;
    f32x4 acc[2][2][4][2];
#pragma unroll
    for (int a = 0; a < 2; ++a)
#pragma unroll
        for (int b = 0; b < 2; ++b)
#pragma unroll
            for (int m = 0; m < 4; ++m)
#pragma unroll
                for (int n = 0; n < 2; ++n) acc[a][b][m][n] = (f32x4){0.f, 0.f, 0.f, 0.f};
    bf16x8 At[4][2], B0[2][2], B1[2][2];
    const char* cA = (const char*)g.A + (size_t)cur.pm * tstep; const char* cB = (const char*)g.Bt + (size_t)cur.pn * tstep;
    S.a_ready(cur);
    if constexpr (SP2) {
        PG8_STAGE(PG8_SB(0, 0), cB, voffB); PG8_STAGE(PG8_SB(0, 1), cB + hstepB, voffB); PG8_STAGE(PG8_SA(0, 0), cA, voffA); PG8_STAGE(PG8_SA(0, 1), cA + hstep, voffA);
        if (wr == 1) PG8_BAR;
        PG8_WAIT_V(2); PG8_BAR;
        PG8_STAGE(PG8_SB(1, 0), cB + kstepB, voffB); PG8_STAGE(PG8_SA(1, 0), cA + kstep, voffA); PG8_STAGE(PG8_SB(1, 1), cB + hstepB + kstepB, voffB);
        PG8_WAIT_V(6); PG8_BAR;
    } else {
        PG8_STAGE(PG8_SB(0, 0), cB, voffB); PG8_STAGE(PG8_SA(0, 0), cA, voffA); PG8_STAGE(PG8_SB(0, 1), cB + hstepB, voffB); PG8_STAGE(PG8_SA(0, 1), cA + hstep, voffA);
        if (wr == 1) PG8_BAR;
        PG8_WAIT_V(4); PG8_BAR;
        PG8_STAGE(PG8_SB(1, 0), cB + kstepB, voffB); PG8_STAGE(PG8_SA(1, 0), cA + kstep, voffA); PG8_STAGE(PG8_SB(1, 1), cB + hstepB + kstepB, voffB);
        PG8_WAIT_V(6); PG8_BAR;
    }
    for (;;) {
        const bool has_next = S.next(ui + 1, nxt);
        const char* nA = has_next ? (const char*)g.A + (size_t)nxt.pm * tstep : cA; const char* nB = has_next ? (const char*)g.Bt + (size_t)nxt.pn * tstep : cB;
        for (int t = 0; t < nt; t += 2) {
            const bool last = (t == nt - 2);
            const char* a1 = cA + (size_t)(t + 1) * kstep;
            const char* a2 = last ? nA : cA + (size_t)(t + 2) * kstep; const char* b2 = last ? nB : cB + (size_t)(t + 2) * kstepB;
            const char* a3 = a2 + kstep; const char* b3 = b2 + kstepB;
            if (last && has_next) S.a_ready(nxt);
            if constexpr (SP2) {
            PG8_LDB(B0, 0, 0); PG8_LDB(B1, 0, 1); PG8_SCHED; PG8_LDA(At, 0, 0); PG8_STAGE(PG8_SA(1, 1), a1 + hstep, voffA);
            PG8_WAIT_V(8); PG8_WAIT_L(0); PG8_BAR; PG8_MMA(0, 0, At, B0); PG8_MMA(0, 1, At, B1); PG8_BAR; PG8_SCHED;
            PG8_LDA(At, 0, 1); PG8_STAGE(PG8_SB(0, 0), b2, voffB); PG8_STAGE(PG8_SB(0, 1), b2 + hstepB, voffB); PG8_STAGE(PG8_SA(0, 0), a2, voffA);
            PG8_WAIT_V(8); PG8_WAIT_L(0); PG8_BAR; PG8_MMA(1, 0, At, B0); PG8_MMA(1, 1, At, B1); PG8_BAR; PG8_SCHED;
            PG8_LDB(B0, 1, 0); PG8_LDB(B1, 1, 1); PG8_SCHED; PG8_LDA(At, 1, 0); PG8_STAGE(PG8_SA(0, 1), a2 + hstep, voffA);
            PG8_WAIT_V(8); PG8_WAIT_L(0); PG8_BAR; PG8_MMA(0, 0, At, B0); PG8_MMA(0, 1, At, B1); PG8_BAR; PG8_SCHED;
            PG8_LDA(At, 1, 1); PG8_STAGE(PG8_SB(1, 0), b3, voffB); PG8_STAGE(PG8_SB(1, 1), b3 + hstepB, voffB); PG8_STAGE(PG8_SA(1, 0), a3, voffA);
            PG8_WAIT_V(8); PG8_WAIT_L(0); PG8_BAR; PG8_MMA(1, 0, At, B0); PG8_MMA(1, 1, At, B1); PG8_BAR; PG8_SCHED;
            } else {
            PG8_LDB(B0, 0, 0); PG8_SCHED; PG8_LDA(At, 0, 0); PG8_STAGE(PG8_SA(1, 1), a1 + hstep, voffA);
            PG8_WAIT_L(8); PG8_BAR; PG8_WAIT_L(0); PG8_MMA(0, 0, At, B0); PG8_BAR; PG8_SCHED;
            PG8_LDB(B1, 0, 1); PG8_STAGE(PG8_SB(0, 0), b2, voffB);
            PG8_BAR; PG8_WAIT_L(0); PG8_MMA(0, 1, At, B1); PG8_BAR;
            PG8_LDA(At, 0, 1); PG8_STAGE(PG8_SA(0, 0), a2, voffA);
            PG8_BAR; PG8_WAIT_L(0); PG8_MMA(1, 0, At, B0); PG8_BAR; PG8_SCHED;
            PG8_STAGE(PG8_SB(0, 1), b2 + hstepB, voffB);
            PG8_WAIT_V(6); PG8_BAR; PG8_MMA(1, 1, At, B1); PG8_BAR;
            PG8_LDB(B0, 1, 0); PG8_SCHED; PG8_LDA(At, 1, 0); PG8_STAGE(PG8_SA(0, 1), a2 + hstep, voffA);
            PG8_WAIT_L(8); PG8_BAR; PG8_WAIT_L(0); PG8_MMA(0, 0, At, B0); PG8_BAR; PG8_SCHED;
            PG8_LDB(B1, 1, 1); PG8_STAGE(PG8_SB(1, 0), b3, voffB);
            PG8_BAR; PG8_WAIT_L(0); PG8_MMA(0, 1, At, B1); PG8_BAR;
            PG8_LDA(At, 1, 1); PG8_STAGE(PG8_SA(1, 0), a3, voffA);
            PG8_BAR; PG8_WAIT_L(0); PG8_MMA(1, 0, At, B0); PG8_BAR; PG8_SCHED;
            PG8_STAGE(PG8_SB(1, 1), b3 + hstepB, voffB);
            PG8_WAIT_V(6); PG8_BAR; PG8_MMA(1, 1, At, B1); PG8_BAR;
            }
        }
        if constexpr (ALIGN_EPI) { if (wr == 0) PG8_BAR; }
        if constexpr (I8 == 2) asm volatile("s_nop 15\n\ts_nop 15" ::: "memory");
        if constexpr (I8 == 1) { _Pragma("unroll") for (int a = 0; a < 2; ++a) _Pragma("unroll") for (int b = 0; b < 2; ++b) _Pragma("unroll") for (int m = 0; m < 4; ++m) _Pragma("unroll") for (int n = 0; n < 2; ++n) acc[a][b][m][n] = __builtin_convertvector(__builtin_bit_cast(i32x4, acc[a][b][m][n]), f32x4); }
        if constexpr (!Epi::AFTER_DRAIN) { E(acc, cur, wr, wc, fr, fq); S.done(cur); }
        if (!has_next) break;
#pragma unroll
        for (int a = 0; a < 2; ++a)
#pragma unroll
            for (int b = 0; b < 2; ++b)
#pragma unroll
                for (int m = 0; m < 4; ++m)
#pragma unroll
                    for (int n = 0; n < 2; ++n) acc[a][b][m][n] = (f32x4){0.f, 0.f, 0.f, 0.f};
        cur = nxt; cA = nA; cB = nB; ++ui;
        if constexpr (ALIGN_EPI) { if (wr == 1) PG8_BAR; }
    }
    PG8_WAIT_V(0);
    if constexpr (!ALIGN_EPI) { if (wr == 0) PG8_BAR; }
    PG8_BAR;
    if constexpr (Epi::AFTER_DRAIN) { E.fused(acc, cur, wr, wc, fr, fq, lds, wid, lane); S.done(cur); }
#undef PG8_SA
#undef PG8_SB
#undef PG8_STAGE
#undef PG8_LDA
#undef PG8_LDB
#undef PG8_MMA
#undef PG8_WAIT_V
#undef PG8_WAIT_L
#undef PG8_BAR
#undef PG8_SCHED
}
}
namespace att {
using bf16x8 = __attribute__((ext_vector_type(8))) short;
using s16x4  = __attribute__((ext_vector_type(4))) short;
using f32x16 = __attribute__((ext_vector_type(16))) float;
using u32x4  = __attribute__((ext_vector_type(4))) unsigned;
typedef unsigned short bf16_t;
constexpr int NW = 8, QBLK = 32, KVBLK = 64;
constexpr float THR = 8.f;
constexpr int SHM_V = 64 * 128 * 2, SHM_K = 64 * 128 * 2, SHM_ATTN = 2 * SHM_V + 2 * SHM_K + NW * 64 * 4;
#define KSWZ(row, colB) ((row) * 256 + ((colB) ^ (((row) & 7) << 4)))
#define KSWZ64(row, colB) ((row) * 128 + ((colB) ^ ((((row) >> 1) & 7) << 4)))
#define SBAR() __builtin_amdgcn_sched_barrier(0)
__device__ __forceinline__ int crow(int r, int hi) { return (r & 3) + 8 * (r >> 2) + 4 * hi; }
__device__ __forceinline__ unsigned cvtpk(float lo, float hi) { unsigned r; asm volatile("v_cvt_pk_bf16_f32 %0, %1, %2" : "=v"(r) : "v"(lo), "v"(hi)); return r; }
__device__ __forceinline__ float bf2f(unsigned short b) { return __uint_as_float((unsigned)b << 16); }
__device__ __forceinline__ bf16x8 ld8(const bf16_t* p) { return *reinterpret_cast<const bf16x8*>(p); }

template <int DQK, bool PRE = false> __device__ __forceinline__ void partialSM(f32x16& p0, f32x16& p1, float& m_reg, float& mn, float& alpha) {
  constexpr float SCALE = PRE ? 0.6931471805599453f : ((DQK == 128) ? 0.088388347648318440f : 0.125f);
  constexpr float C = SCALE * 1.4426950408889634f;
  float pmax = p0[0];
#pragma unroll
  for (int r = 1; r < 16; ++r) pmax = fmaxf(pmax, p0[r]);
#pragma unroll
  for (int r = 0; r < 16; ++r) pmax = fmaxf(pmax, p1[r]);
  { auto rr = __builtin_amdgcn_permlane32_swap(__float_as_uint(pmax), __float_as_uint(pmax), false, false);
    pmax = fmaxf(__uint_as_float(rr[0]), __uint_as_float(rr[1])); }
  if (__builtin_expect(__all(pmax - m_reg <= THR / SCALE), 1)) { mn = m_reg; alpha = 1.f; }
  else { mn = fmaxf(m_reg, pmax); alpha = __builtin_amdgcn_exp2f((m_reg - mn) * C); m_reg = mn; }
  float mnC = -mn * C;
#pragma unroll
  for (int r = 0; r < 16; ++r) p0[r] = fmaf(p0[r], C, mnC);
#pragma unroll
  for (int r = 0; r < 16; ++r) p1[r] = fmaf(p1[r], C, mnC);
#pragma unroll
  for (int r = 0; r < 16; ++r) p0[r] = __builtin_amdgcn_exp2f(p0[r]);
}
#define PK4(P, BASE, OUT) do { unsigned a0 = cvtpk(P[BASE + 0], P[BASE + 1]), a1 = cvtpk(P[BASE + 2], P[BASE + 3]);   \
    unsigned b0 = cvtpk(P[BASE + 4], P[BASE + 5]), b1 = cvtpk(P[BASE + 6], P[BASE + 7]);                              \
    auto r0 = __builtin_amdgcn_permlane32_swap(a0, b0, false, false); auto r1 = __builtin_amdgcn_permlane32_swap(a1, b1, false, false); \
    u32x4 w = {r0[0], r1[0], r0[1], r1[1]}; OUT = *reinterpret_cast<bf16x8*>(&w); } while (0)
__device__ __forceinline__ void finishSM(f32x16& p0, f32x16& p1, float alpha, float& l_reg, bf16x8& pa0, bf16x8& pa1, bf16x8& pa2, bf16x8& pa3) {
#pragma unroll
  for (int r = 0; r < 16; ++r) p1[r] = __builtin_amdgcn_exp2f(p1[r]);
  float ps = 0;
#pragma unroll
  for (int r = 0; r < 16; ++r) ps += p0[r];
#pragma unroll
  for (int r = 0; r < 16; ++r) ps += p1[r];
  { auto rr = __builtin_amdgcn_permlane32_swap(__float_as_uint(ps), __float_as_uint(ps), false, false);
    ps = __uint_as_float(rr[0]) + __uint_as_float(rr[1]); }
  l_reg = l_reg * alpha + ps;
  PK4(p0, 0, pa0); PK4(p0, 8, pa1); PK4(p1, 0, pa2); PK4(p1, 8, pa3);
}
template <int DQK> __device__ __forceinline__ void qkt(f32x16& p0, f32x16& p1, const char* Ks, const bf16x8* qr, int r32, int hi) {
  constexpr int ND = DQK / 16;
  p0 = f32x16{}; p1 = f32x16{};
  bf16x8 b0[2], b1[2];
#define QK_RD(d0, s) do { const int cb_ = ((d0) * 16 + hi * 8) * 2; \
    if constexpr (DQK == 128) { b0[s] = *reinterpret_cast<const bf16x8*>(Ks + KSWZ(r32, cb_)); b1[s] = *reinterpret_cast<const bf16x8*>(Ks + KSWZ(32 + r32, cb_)); } \
    else { b0[s] = *reinterpret_cast<const bf16x8*>(Ks + KSWZ64(r32, cb_)); b1[s] = *reinterpret_cast<const bf16x8*>(Ks + KSWZ64(32 + r32, cb_)); } } while (0)
  QK_RD(0, 0); QK_RD(1, 1); SBAR();
#pragma unroll
  for (int d0 = 0; d0 < ND; ++d0) {
    p0 = __builtin_amdgcn_mfma_f32_32x32x16_bf16(b0[d0 & 1], qr[d0], p0, 0, 0, 0);
    p1 = __builtin_amdgcn_mfma_f32_32x32x16_bf16(b1[d0 & 1], qr[d0], p1, 0, 0, 0);
    if (d0 + 2 < ND) { QK_RD(d0 + 2, d0 & 1); }
    SBAR();
  }
#undef QK_RD
}
__device__ __forceinline__ int v_st(int k, int c) { const int kk = (k & ~0xC) | ((k & 4) << 1) | ((k & 8) >> 1); return ((kk >> 3) * 4 + (c >> 5)) * 512 + ((kk & 7) * 32 + (c & 31)) * 2; }
__device__ __forceinline__ int v_rd_base(int lane) { return ((lane & 3) << 3) | (((lane >> 2) & 3) << 6) | (((lane >> 4) & 1) << 5) | (((lane >> 5) & 1) << 8); }
constexpr int v_rd_off(int d0, int ks, int half) { return d0 * 512 + ks * 4096 + half * 2048; }
template <int OFF> __device__ __forceinline__ s16x4 tr_read(int vb) {
  s16x4 r; asm volatile("ds_read_b64_tr_b16 %0, %1 offset:%2" : "=&v"(r) : "v"(vb), "i"(OFF) : "memory"); return r;
}
#define PKF(L, H) (bf16x8){L[0], L[1], L[2], L[3], H[0], H[1], H[2], H[3]}
template <int D0> __device__ __forceinline__ void pv_one(f32x16& od, int vb, bf16x8 pa0, bf16x8 pa1, bf16x8 pa2, bf16x8 pa3) {
  const s16x4 l0 = tr_read<v_rd_off(D0, 0, 0)>(vb), h0 = tr_read<v_rd_off(D0, 0, 1)>(vb), l1 = tr_read<v_rd_off(D0, 1, 0)>(vb), h1 = tr_read<v_rd_off(D0, 1, 1)>(vb);
  const s16x4 l2 = tr_read<v_rd_off(D0, 2, 0)>(vb), h2 = tr_read<v_rd_off(D0, 2, 1)>(vb), l3 = tr_read<v_rd_off(D0, 3, 0)>(vb), h3 = tr_read<v_rd_off(D0, 3, 1)>(vb);
  asm volatile("s_waitcnt lgkmcnt(0)" ::: "memory"); SBAR();
  od = __builtin_amdgcn_mfma_f32_32x32x16_bf16(pa0, PKF(l0, h0), od, 0, 0, 0);
  od = __builtin_amdgcn_mfma_f32_32x32x16_bf16(pa1, PKF(l1, h1), od, 0, 0, 0);
  od = __builtin_amdgcn_mfma_f32_32x32x16_bf16(pa2, PKF(l2, h2), od, 0, 0, 0);
  od = __builtin_amdgcn_mfma_f32_32x32x16_bf16(pa3, PKF(l3, h3), od, 0, 0, 0);
}
#define PV_RD(D0, L, H) do { L[0] = tr_read<v_rd_off(D0, 0, 0)>(vb); H[0] = tr_read<v_rd_off(D0, 0, 1)>(vb); L[1] = tr_read<v_rd_off(D0, 1, 0)>(vb); H[1] = tr_read<v_rd_off(D0, 1, 1)>(vb); \
    L[2] = tr_read<v_rd_off(D0, 2, 0)>(vb); H[2] = tr_read<v_rd_off(D0, 2, 1)>(vb); L[3] = tr_read<v_rd_off(D0, 3, 0)>(vb); H[3] = tr_read<v_rd_off(D0, 3, 1)>(vb); } while (0)
#define PV_MM(OD, L, H) do { OD = __builtin_amdgcn_mfma_f32_32x32x16_bf16(pa0, PKF(L[0], H[0]), OD, 0, 0, 0); OD = __builtin_amdgcn_mfma_f32_32x32x16_bf16(pa1, PKF(L[1], H[1]), OD, 0, 0, 0); \
    OD = __builtin_amdgcn_mfma_f32_32x32x16_bf16(pa2, PKF(L[2], H[2]), OD, 0, 0, 0); OD = __builtin_amdgcn_mfma_f32_32x32x16_bf16(pa3, PKF(L[3], H[3]), OD, 0, 0, 0); } while (0)
__device__ __forceinline__ void pv_d0(f32x16* o, int vb, bf16x8 pa0, bf16x8 pa1, bf16x8 pa2, bf16x8 pa3) {
  s16x4 la[4], ha[4], lb[4], hb[4];
  PV_RD(0, la, ha); PV_RD(1, lb, hb);
  asm volatile("s_waitcnt lgkmcnt(8)" ::: "memory"); SBAR(); PV_MM(o[0], la, ha); SBAR();
  PV_RD(2, la, ha);
  asm volatile("s_waitcnt lgkmcnt(8)" ::: "memory"); SBAR(); PV_MM(o[1], lb, hb); SBAR();
  PV_RD(3, lb, hb);
  asm volatile("s_waitcnt lgkmcnt(8)" ::: "memory"); SBAR(); PV_MM(o[2], la, ha); SBAR();
  asm volatile("s_waitcnt lgkmcnt(0)" ::: "memory"); SBAR(); PV_MM(o[3], lb, hb);
}
#undef PV_RD
#undef PV_MM
__device__ __forceinline__ float half_sum32(float x) {
  x += __shfl_xor(x, 1); x += __shfl_xor(x, 2); x += __shfl_xor(x, 4); x += __shfl_xor(x, 8); x += __shfl_xor(x, 16); return x;
}

struct KVSrc { const bf16_t* K1; const bf16_t* V1; int n1; const bf16_t* K2; const bf16_t* V2; int n2; };
struct AttnOut { bf16_t* Ob; float* Of; const float* nw; float lam, post; int pass; };
template <int DQK, int MODE, int LD2, int SM = 0>
__device__ __forceinline__ void attn_body(const bf16_t* __restrict__ Qb, const KVSrc kv, const AttnOut ao, char* lds) {
  constexpr long ldq = 5120, LD1 = 5120; constexpr int LDO = 2048, LDF = 512;
  int tid_ = threadIdx.x; asm volatile("" : "+v"(tid_));
  const int tid = tid_, wid = tid >> 6, lane = tid & 63, r32 = lane & 31, hi = lane >> 5;
  char* V_lds = lds; char* K_lds = lds + 2 * SHM_V;
  float* ws = (float*)(lds + 2 * SHM_V + 2 * SHM_K) + wid * 64; float* li_l = ws; float* al_l = ws + 32;
  float m_reg = -1e30f, l_reg = 0; f32x16 o[4] = {}; bf16x8 qr[DQK / 16];
  const bf16_t* Qw = Qb + (long)(wid * QBLK + r32) * ldq + hi * 8;
#pragma unroll
  for (int d0 = 0; d0 < DQK / 16; ++d0) qr[d0] = ld8(Qw + d0 * 16);
  const int sr = tid >> 4, sc = (tid & 15) * 8, vst0 = v_st(sr, sc), vst1 = v_st(32 + sr, sc);
  const int kr64 = tid >> 3, kc64 = (tid & 7) * 8;
  const int vb0 = (int)(uintptr_t)V_lds + v_rd_base(lane);
  struct { bf16x8 vs0, vs1, ks0, ks1; } sr_[2];
#define SLOAD(i, k0) do { const int k0_ = (k0); const bool s1_ = k0_ < kv.n1; const bf16_t* kp_ = s1_ ? kv.K1 + (long)k0_ * LD1 : kv.K2 + (long)(k0_ - kv.n1) * LD2; \
    const bf16_t* vp_ = s1_ ? kv.V1 + (long)k0_ * LD1 : kv.V2 + (long)(k0_ - kv.n1) * LD2; const long ld_ = s1_ ? LD1 : (long)LD2; \
    sr_[i].vs0 = ld8(vp_ + (long)sr * ld_ + sc); sr_[i].vs1 = ld8(vp_ + (long)(32 + sr) * ld_ + sc); \
    if constexpr (DQK == 128) { sr_[i].ks0 = ld8(kp_ + (long)sr * ld_ + sc); sr_[i].ks1 = ld8(kp_ + (long)(32 + sr) * ld_ + sc); } \
    else { sr_[i].ks0 = ld8(kp_ + (long)kr64 * ld_ + kc64); } } while (0)
#define SWRITE(b, i) do { *(bf16x8*)(V_lds + (b) * SHM_V + vst0) = sr_[i].vs0; *(bf16x8*)(V_lds + (b) * SHM_V + vst1) = sr_[i].vs1; \
    if constexpr (DQK == 128) { const int kc = sc * 2; *(bf16x8*)(K_lds + (b) * SHM_K + KSWZ(sr, kc)) = sr_[i].ks0; *(bf16x8*)(K_lds + (b) * SHM_K + KSWZ(32 + sr, kc)) = sr_[i].ks1; } \
    else { *(bf16x8*)(K_lds + (b) * SHM_K + KSWZ64(kr64, kc64 * 2)) = sr_[i].ks0; } } while (0)
#define SWAIT() do { if constexpr (DQK == 128) asm volatile("s_waitcnt vmcnt(4)" ::: "memory"); else asm volatile("s_waitcnt vmcnt(3)" ::: "memory"); } while (0)
#define RESC(a) do { if (SM != 1 && __any((a) < 1.f)) { if (hi == 0) al_l[r32] = (a); asm volatile("s_waitcnt lgkmcnt(0)" ::: "memory"); \
    _Pragma("unroll") for (int d = 0; d < 4; ++d) _Pragma("unroll") for (int r = 0; r < 16; ++r) o[d][r] *= al_l[crow(r, hi)]; } } while (0)
  f32x16 pA0, pA1, pB0, pB1; float mnA = 0.f, mnB = 0.f, alA = 1.f, alB = 1.f; bf16x8 pa0, pa1, pa2, pa3; const int NT = (kv.n1 + kv.n2) / KVBLK; (void)mnA; (void)mnB;
#define PSM(P0, P1, MN, AL) do { if constexpr (SM == 1) { _Pragma("unroll") for (int r_ = 0; r_ < 16; ++r_) P0[r_] = __builtin_amdgcn_exp2f(P0[r_]); } else partialSM<DQK, SM == 2>(P0, P1, m_reg, MN, AL); } while (0)
  constexpr int SE = 0, SO = 1;
  SLOAD(SE, 0); SLOAD(SO, KVBLK); SWAIT(); SWRITE(0, SE); __syncthreads();
  qkt<DQK>(pA0, pA1, K_lds, qr, r32, hi); PSM(pA0, pA1, mnA, alA);
  if (2 < NT) SLOAD(SE, 2 * KVBLK);
  SWAIT(); SWRITE(1, SO); __syncthreads();
  for (int j = 1; j + 1 < NT; j += 2) {
    SBAR(); qkt<DQK>(pB0, pB1, K_lds + SHM_K, qr, r32, hi);
    finishSM(pA0, pA1, alA, l_reg, pa0, pa1, pa2, pa3); SBAR();
    SLOAD(SO, (j + 2) * KVBLK); SBAR();
    pv_d0(o, vb0, pa0, pa1, pa2, pa3); PSM(pB0, pB1, mnB, alB);
    __syncthreads(); SWAIT(); SWRITE(0, SE);
    RESC(alB); __syncthreads();
    SBAR(); qkt<DQK>(pA0, pA1, K_lds, qr, r32, hi);
    finishSM(pB0, pB1, alB, l_reg, pa0, pa1, pa2, pa3); SBAR();
    if (j + 3 < NT) SLOAD(SE, (j + 3) * KVBLK); SBAR();
    pv_d0(o, vb0 + (int)SHM_V, pa0, pa1, pa2, pa3); PSM(pA0, pA1, mnA, alA);
    __syncthreads(); SWAIT(); SWRITE(1, SO);
    RESC(alA); __syncthreads();
  }
  SBAR(); qkt<DQK>(pB0, pB1, K_lds + SHM_K, qr, r32, hi);
  finishSM(pA0, pA1, alA, l_reg, pa0, pa1, pa2, pa3); SBAR();
  pv_d0(o, vb0, pa0, pa1, pa2, pa3); PSM(pB0, pB1, mnB, alB);
  __syncthreads(); RESC(alB);
  finishSM(pB0, pB1, alB, l_reg, pa0, pa1, pa2, pa3); SBAR();
  pv_d0(o, vb0 + (int)SHM_V, pa0, pa1, pa2, pa3);
  if (hi == 0) li_l[r32] = l_reg; asm volatile("s_waitcnt lgkmcnt(0)" ::: "memory");
  float rli[16];
#pragma unroll
  for (int r = 0; r < 16; ++r) rli[r] = __builtin_amdgcn_rcpf(li_l[crow(r, hi)]);
  bf16_t* stg = (bf16_t*)lds + wid * (QBLK * 128);
#define O_FLUSH(Ow) do { asm volatile("s_waitcnt lgkmcnt(0)" ::: "memory"); _Pragma("unroll") for (int i_ = 0; i_ < 8; ++i_) { const int row_ = i_ * 4 + (lane >> 4), ch_ = lane & 15; \
    const u32x4 v_ = *(const u32x4*)(stg + row_ * 128 + ch_ * 8); *(u32x4*)((Ow) + (long)row_ * LDO + ch_ * 8) = v_; } } while (0)
  if constexpr (MODE == 0) {
    bf16_t* Ow = ao.Ob + (long)(wid * QBLK) * LDO;
    __syncthreads();
#pragma unroll
    for (int r = 0; r < 16; ++r) { const int orow = crow(r, hi);
#pragma unroll
      for (int d0 = 0; d0 < 4; ++d0) { const float v = o[d0][r] * rli[r]; stg[orow * 128 + d0 * 32 + r32] = (bf16_t)(cvtpk(v, v) & 0xffffu); } }
    O_FLUSH(Ow);
  } else {
    float* Fw = ao.Of + (long)(wid * QBLK) * LDF;
    if (ao.pass == 0) {
#pragma unroll
      for (int r = 0; r < 16; ++r) { const int orow = crow(r, hi);
#pragma unroll
        for (int d0 = 0; d0 < 4; ++d0) Fw[(long)orow * LDF + d0 * 32 + r32] = o[d0][r] * rli[r]; }
    } else {
      bf16_t* Ow = ao.Ob + (long)(wid * QBLK) * LDO;
      __syncthreads();
#pragma unroll
      for (int r = 0; r < 16; ++r) { const int orow = crow(r, hi); float v[4]; float ss = 0.f;
#pragma unroll
        for (int d0 = 0; d0 < 4; ++d0) { v[d0] = Fw[(long)orow * LDF + d0 * 32 + r32] - ao.lam * (o[d0][r] * rli[r]); ss += v[d0] * v[d0]; }
        ss = half_sum32(ss); const float rs = rsqrtf(ss * (1.0f / 128.0f) + 1e-6f) * ao.post;
#pragma unroll
        for (int d0 = 0; d0 < 4; ++d0) { const float y = v[d0] * rs * ao.nw[d0 * 32 + r32]; stg[orow * 128 + d0 * 32 + r32] = (bf16_t)(cvtpk(y, y) & 0xffffu); } }
      O_FLUSH(Ow);
    }
  }
#undef O_FLUSH
#undef SLOAD
#undef SWRITE
#undef SWAIT
#undef RESC
#undef PSM
}
struct ChainArgs { const bf16_t* P;   int kcol, vcol; int nchunk; int dir; float lg2;
                   const float* S0;   bf16_t* ST;   float* Sfin;   };
__device__ __forceinline__ void ret_chain(const ChainArgs a, char* lds) {
  int tid_ = threadIdx.x; asm volatile("" : "+v"(tid_));
  const int tid = tid_, wid = tid >> 6, lane = tid & 63, r32 = lane & 31, hi = lane >> 5;
  const int eb = wid >> 1, dh = wid & 1;
  char* V_lds = lds; char* K_lds = lds + 2 * SHM_V;
  const int sr = tid >> 4, sc = (tid & 15) * 8;
  f32x16 acc[2];
#pragma unroll
  for (int j = 0; j < 2; ++j)
#pragma unroll
    for (int r = 0; r < 16; ++r) acc[j][r] = 0.f;
  if (a.S0) {
#pragma unroll
    for (int j = 0; j < 2; ++j)
#pragma unroll
      for (int r = 0; r < 16; ++r) acc[j][r] = a.S0[(size_t)(32 * (2 * dh + j) + r32) * 128 + 32 * eb + crow(r, hi)]; }
  const float gC = __builtin_amdgcn_exp2f(128.f * a.lg2);
  const int vbA = (int)(uintptr_t)V_lds + v_rd_base(lane) + eb * 512, vbB = (int)(uintptr_t)K_lds + v_rd_base(lane) + (2 * dh) * 512;
  bf16x8 kq[4], vq[4];
  { const int c0 = a.dir == 0 ? 0 : a.nchunk - 1; const bf16_t* rowp = a.P + (size_t)(c0 * 128) * 5120;
#pragma unroll
    for (int q = 0; q < 4; ++q) { const int k = 32 * q + sr; kq[q] = ld8(rowp + (size_t)k * 5120 + a.kcol + sc); vq[q] = ld8(rowp + (size_t)k * 5120 + a.vcol + sc); } }
  for (int s = 0; s < a.nchunk; ++s) {
    const int c = a.dir == 0 ? s : a.nchunk - 1 - s;
    bf16_t* st = a.ST + (size_t)c * 16384;
    __syncthreads();
#pragma unroll
    for (int q = 0; q < 4; ++q) { const int k = 32 * q + sr;
      const bf16x8 kv_ = kq[q], vv_ = vq[q];
      const float f = 0.088388347648318440f * __builtin_amdgcn_exp2f((a.dir == 0 ? (float)(127 - k) : (float)k) * a.lg2);
      u32x4 w; w.x = cvtpk(bf2f((unsigned short)kv_[0]) * f, bf2f((unsigned short)kv_[1]) * f); w.y = cvtpk(bf2f((unsigned short)kv_[2]) * f, bf2f((unsigned short)kv_[3]) * f);
      w.z = cvtpk(bf2f((unsigned short)kv_[4]) * f, bf2f((unsigned short)kv_[5]) * f); w.w = cvtpk(bf2f((unsigned short)kv_[6]) * f, bf2f((unsigned short)kv_[7]) * f);
      const int off = (q >> 1) * SHM_V + v_st(32 * (q & 1) + sr, sc);
      *(u32x4*)(K_lds + off) = w; *(bf16x8*)(V_lds + off) = vv_; }
    __syncthreads();
#pragma unroll
    for (int j = 0; j < 2; ++j)
#pragma unroll
      for (int r = 0; r < 16; ++r) { const float v = acc[j][r]; st[(32 * eb + crow(r, hi)) * 128 + 32 * (2 * dh + j) + r32] = (bf16_t)(cvtpk(v, v) & 0xffffu); }
    if (s + 1 < a.nchunk) { const int cn = a.dir == 0 ? s + 1 : a.nchunk - 2 - s; const bf16_t* rowp = a.P + (size_t)(cn * 128) * 5120;
#pragma unroll
      for (int q = 0; q < 4; ++q) { const int k = 32 * q + sr; kq[q] = ld8(rowp + (size_t)k * 5120 + a.kcol + sc); vq[q] = ld8(rowp + (size_t)k * 5120 + a.vcol + sc); } }
#pragma unroll
    for (int j = 0; j < 2; ++j)
#pragma unroll
      for (int r = 0; r < 16; ++r) acc[j][r] *= gC;
#pragma unroll
    for (int tt = 0; tt < 2; ++tt) {
      s16x4 al[4], ah[4], b0l[4], b0h[4], b1l[4], b1h[4];
#define RD4(ks) do { al[ks] = tr_read<v_rd_off(0, ks, 0)>(vbA + tt * SHM_V); ah[ks] = tr_read<v_rd_off(0, ks, 1)>(vbA + tt * SHM_V); \
      b0l[ks] = tr_read<v_rd_off(0, ks, 0)>(vbB + tt * SHM_V); b0h[ks] = tr_read<v_rd_off(0, ks, 1)>(vbB + tt * SHM_V); \
      b1l[ks] = tr_read<v_rd_off(1, ks, 0)>(vbB + tt * SHM_V); b1h[ks] = tr_read<v_rd_off(1, ks, 1)>(vbB + tt * SHM_V); } while (0)
      RD4(0); RD4(1); RD4(2); RD4(3);
#undef RD4
      asm volatile("s_waitcnt lgkmcnt(0)" ::: "memory"); SBAR();
#pragma unroll
      for (int ks = 0; ks < 4; ++ks) {
        acc[0] = __builtin_amdgcn_mfma_f32_32x32x16_bf16(PKF(al[ks], ah[ks]), PKF(b0l[ks], b0h[ks]), acc[0], 0, 0, 0);
        acc[1] = __builtin_amdgcn_mfma_f32_32x32x16_bf16(PKF(al[ks], ah[ks]), PKF(b1l[ks], b1h[ks]), acc[1], 0, 0, 0); }
    }
  }
  if (a.Sfin) {
#pragma unroll
    for (int j = 0; j < 2; ++j)
#pragma unroll
      for (int r = 0; r < 16; ++r) a.Sfin[(size_t)(32 * (2 * dh + j) + r32) * 128 + 32 * eb + crow(r, hi)] = acc[j][r];
  }
}
struct RetCArgs { const bf16_t* P;   int qcol, kcol, vcol, gcol; float lg2f, lg2b; const bf16_t* STf; const bf16_t* STb;
                  const float* gnw; bf16_t* O;   };
__device__ __forceinline__ void ret_c(const RetCArgs a, char* lds) {
  int tid_ = threadIdx.x; asm volatile("" : "+v"(tid_));
  const int tid = tid_, wid = tid >> 6, lane = tid & 63, r32 = lane & 31, hi = lane >> 5;
  char* V_lds = lds; char* K_lds = lds + 2 * SHM_V;
  const int cw = wid >> 2, ipos = 32 * (wid & 3) + r32;
  const int sr = tid >> 4, sc = (tid & 15) * 8;
  const int vb0 = (int)(uintptr_t)V_lds + v_rd_base(lane);
  bf16x8 qr[8];
  const bf16_t* Qw = a.P + (size_t)(wid * 32 + r32) * 5120 + a.qcol + hi * 8;
#pragma unroll
  for (int d0 = 0; d0 < 8; ++d0) qr[d0] = ld8(Qw + d0 * 16);
  f32x16 o[4] = {};
  for (int ch = 0; ch < 2; ++ch) {
    const bf16_t* rowp = a.P + (size_t)(ch * 128) * 5120;
    __syncthreads();
#pragma unroll
    for (int q = 0; q < 4; ++q) { const int k = 32 * q + sr;
      const bf16x8 kv_ = ld8(rowp + (size_t)k * 5120 + a.kcol + sc), vv_ = ld8(rowp + (size_t)k * 5120 + a.vcol + sc);
      *(bf16x8*)(K_lds + (q >> 1) * SHM_K + KSWZ(32 * (q & 1) + sr, sc * 2)) = kv_;
      *(bf16x8*)(V_lds + (q >> 1) * SHM_V + v_st(32 * (q & 1) + sr, sc)) = vv_; }
    __syncthreads();
    if (cw == ch) {
#pragma unroll
      for (int tt = 0; tt < 2; ++tt) {
        f32x16 p0, p1; qkt<128>(p0, p1, K_lds + tt * SHM_K, qr, r32, hi);
        int ip_ = ipos, hi_ = hi; asm volatile("" : "+v"(ip_), "+v"(hi_));
#pragma unroll
        for (int r = 0; r < 16; ++r) {
          const int j0 = 64 * tt + crow(r, hi_), d0_ = ip_ - j0, d1_ = d0_ - 32;
          const float f0 = d0_ > 0 ? __builtin_amdgcn_exp2f((float)d0_ * a.lg2f) : (d0_ < 0 ? __builtin_amdgcn_exp2f((float)(-d0_) * a.lg2b) : 2.0f);
          const float f1 = d1_ > 0 ? __builtin_amdgcn_exp2f((float)d1_ * a.lg2f) : (d1_ < 0 ? __builtin_amdgcn_exp2f((float)(-d1_) * a.lg2b) : 2.0f);
          p0[r] *= f0 * 0.088388347648318440f; p1[r] *= f1 * 0.088388347648318440f; }
        bf16x8 pa0, pa1, pa2, pa3; PK4(p0, 0, pa0); PK4(p0, 8, pa1); PK4(p1, 0, pa2); PK4(p1, 8, pa3);
        pv_d0(o, vb0 + tt * SHM_V, pa0, pa1, pa2, pa3);
      }
    }
  }
#pragma unroll
  for (int dir = 0; dir < 2; ++dir) {
    const float rs = dir == 0 ? __builtin_amdgcn_exp2f((float)(ipos + 1) * a.lg2f) : __builtin_amdgcn_exp2f((float)(128 - ipos) * a.lg2b);
    const bf16_t* S = (dir == 0 ? a.STf : a.STb) + (size_t)cw * 16384 + (size_t)r32 * 128 + hi * 8;
#pragma unroll
    for (int d0 = 0; d0 < 8; ++d0) {
      const bf16x8 q_ = qr[d0]; u32x4 w;
      w.x = cvtpk(bf2f((unsigned short)q_[0]) * rs, bf2f((unsigned short)q_[1]) * rs); w.y = cvtpk(bf2f((unsigned short)q_[2]) * rs, bf2f((unsigned short)q_[3]) * rs);
      w.z = cvtpk(bf2f((unsigned short)q_[4]) * rs, bf2f((unsigned short)q_[5]) * rs); w.w = cvtpk(bf2f((unsigned short)q_[6]) * rs, bf2f((unsigned short)q_[7]) * rs);
      const bf16x8 qs = *reinterpret_cast<bf16x8*>(&w);
#pragma unroll
      for (int eb = 0; eb < 4; ++eb) { const bf16x8 b = ld8(S + (size_t)eb * 32 * 128 + d0 * 16); o[eb] = __builtin_amdgcn_mfma_f32_32x32x16_bf16(qs, b, o[eb], 0, 0, 0); }
    }
  }
#pragma unroll
  for (int r = 0; r < 16; ++r) {
    const int row = wid * 32 + crow(r, hi);
    float s = (o[0][r] + o[1][r]) + (o[2][r] + o[3][r]); s = half_sum32(s); const float mean = s * (1.0f / 128.0f);
    float q = 0.f;
#pragma unroll
    for (int eb = 0; eb < 4; ++eb) { const float d = o[eb][r] - mean; q += d * d; }
    q = half_sum32(q); const float rstd = rsqrtf(q * (1.0f / 128.0f) + 1e-6f);
#pragma unroll
    for (int eb = 0; eb < 4; ++eb) { const int col = eb * 32 + r32;
      const float g = bf2f(a.P[(size_t)row * 5120 + a.gcol + col]);
      const float y = (o[eb][r] - mean) * rstd * a.gnw[col] * (g * __builtin_amdgcn_rcpf(1.0f + __builtin_amdgcn_exp2f(-1.4426950408889634f * g)));
      a.O[(size_t)row * 2048 + col] = (bf16_t)(cvtpk(y, y) & 0xffffu); }
  }
}
#undef KSWZ
#undef KSWZ64
#undef SBAR
#undef PK4
#undef PKF
}
constexpr int DM = 2048, M_P = 4096, M_S = 32768, MTOK = M_P + M_S, DFF = 5632, NFF = 11264, NIN = 5120, NMODC = 18432, NCOND = 9;
constexpr int C_RQ = 0, C_RK = 512, C_RV = 1024, C_RG = 1536, C_GQ = 2048, C_GK = 3072, C_GV = 3328, C_DQ = 3584, C_DK = 4096, C_DV = 4608;
constexpr float EPS = 1e-6f;
constexpr size_t MiB = 1u << 20;
constexpr size_t WS_CTL = 0, CTL_ZERO_BYTES = 1 * MiB;
constexpr size_t WS_TAB = 1 * MiB;
constexpr size_t WS_CACHE = 4 * MiB;
constexpr size_t WS_W = 16 * MiB;
constexpr size_t W_LAYER = 160 * MiB, W_WI = 0, W_WO = 88 * MiB, W_WIN = 132 * MiB, W_WOUT = 152 * MiB;
constexpr size_t WS_XN = WS_W + 2 * W_LAYER;
constexpr size_t WS_ACT = WS_XN + 144 * MiB;
constexpr size_t WS_ST = WS_ACT + 396 * MiB;
constexpr size_t WS_DF = WS_ST + 72 * MiB;
constexpr size_t WS_XNB = WS_DF + 72 * MiB;
constexpr size_t WS_SB = WS_XNB + 144 * MiB;
constexpr size_t SB_LAYER = 9 * (11264 + 5120 + 11264), SB_J1 = 9 * 11264, SB_J2 = 9 * (11264 + 5120);
constexpr size_t WS_RS = WS_SB + 2 * MiB;
constexpr size_t WS_Q = WS_RS + 2 * MiB;
constexpr size_t Q_SW = 256 * 1024, Q_SW2 = 512 * 1024, Q_SW4 = 832 * 1024, Q_ACT = 960 * 1024  , W_WINQ = 22 * MiB;
constexpr size_t WS_A8B = WS_Q + 1 * MiB;
constexpr size_t WS_END = WS_A8B + 198 * MiB;
constexpr int TB_MOD = 0, TB_COSG = 2 * 9 * 18432, TB_SING = TB_COSG + 64 * 32, TB_COSD = TB_SING + 64 * 32, TB_SIND = TB_COSD + 64 * 16, TB_SCAL = TB_SIND + 64 * 16;
constexpr int CW_BAR = 4096;
constexpr size_t CTL_RAW2 = 960 * 1024;
constexpr size_t CTL_AMAX = 64 * 1024;
constexpr size_t O_X = 0, O_STATE = 75497472, O_GK = 79691776, O_GV = 81788928, O_DK = 83886080, O_DV = 88080384, O_END = 92274688;
constexpr int LDS_BYTES = 147456, MISC_OFF = 131072 + 320;

typedef att::bf16_t bf16;
#define GAS __attribute__((address_space(1)))
#define LAS __attribute__((address_space(3)))
typedef unsigned v4u __attribute__((ext_vector_type(4)));
typedef float f32x4 __attribute__((ext_vector_type(4)));
typedef short bf16x8 __attribute__((ext_vector_type(8)));
typedef GAS unsigned gu32;
typedef GAS unsigned long long gu64;
#define RLX_AGENT __ATOMIC_RELAXED, __HIP_MEMORY_SCOPE_AGENT
#define LDS_WAIT() asm volatile("s_waitcnt lgkmcnt(0)" ::: "memory")
#define VM_WAIT() asm volatile("s_waitcnt vmcnt(0)" ::: "memory")
__device__ __forceinline__ unsigned long long rt() { return __builtin_amdgcn_s_memrealtime(); }
__device__ __forceinline__ unsigned f2bf(float f) { unsigned u = __builtin_bit_cast(unsigned, f); return (u + 0x7fffu + ((u >> 16) & 1u)) >> 16; }
__device__ __forceinline__ unsigned pk2(float lo, float hi) { return f2bf(lo) | (f2bf(hi) << 16); }
#define XB_TMO      128
#define XB_XCNT(j)  (256  + 64 * (j))
#define XB_XSUB(j)  (1280 + 64 * (j))
#define XB_XGEN(j)  (2304 + 64 * (j))
#define XB_TOP      3328
#define XB_TOPGEN   3392
#define XCD_BAR_WORDS 3456
#define XB_SPIN_CAP (1u << 18)

__device__ __forceinline__ unsigned xb_ld(unsigned* p)              { return __hip_atomic_load(p, __ATOMIC_RELAXED, __HIP_MEMORY_SCOPE_AGENT); }
__device__ __forceinline__ unsigned xb_add(unsigned* p, unsigned v) { return __hip_atomic_fetch_add(p, v, __ATOMIC_RELAXED, __HIP_MEMORY_SCOPE_AGENT); }
__device__ __forceinline__ unsigned xb_xcc_id() { return (unsigned)__builtin_amdgcn_s_getreg((3 << 11) | 20) & 0xFu; }
#define XB_SPIN(cond, bar) do { unsigned _sp = 0; while (cond) { __builtin_amdgcn_s_sleep(1); \
    if ((++_sp & 255u) == 0u) { if (xb_ld(&(bar)[XB_TMO])) break; if (_sp > XB_SPIN_CAP) { atomicAdd(&(bar)[XB_TMO], 1u); break; } } } } while (0)

struct XcdBarrier {
    unsigned* bar; unsigned x;
    volatile LAS unsigned* st;
};

__device__ __forceinline__ XcdBarrier xcd_barrier_post(unsigned* bar, volatile LAS unsigned* st) {
    XcdBarrier b; b.bar = bar; b.x = xb_xcc_id(); b.st = st;
    if (threadIdx.x == 0) (void)xb_add(&bar[XB_XCNT(b.x)], 1u);
    return b;
}
__device__ __forceinline__ void xcd_barrier_complete(unsigned* bar, unsigned x, unsigned& nloc, unsigned& nx) {
    const unsigned G = gridDim.x * gridDim.y * gridDim.z;
    unsigned sum, cnt, mine, sp = 0u;
    for (;;) {
        sum = 0u; cnt = 0u; mine = 0u;
#pragma unroll
        for (unsigned j = 0; j < 16; ++j) { const unsigned c = xb_ld(&bar[XB_XCNT(j)]); sum += c; cnt += (c > 0u) ? 1u : 0u; mine = (j == x) ? c : mine; }
        if (sum == G) break;
        __builtin_amdgcn_s_sleep(1);
        if ((++sp & 255u) == 0u) { if (xb_ld(&bar[XB_TMO])) break; if (sp > XB_SPIN_CAP) { atomicAdd(&bar[XB_TMO], 1u); break; } }
    }
    nloc = mine > 0u ? mine : 1u; nx = cnt > 0u ? cnt : 1u;
}

__device__ __forceinline__ void xcd_barrier(const XcdBarrier& b) {
    asm volatile("s_waitcnt vmcnt(0)" ::: "memory");
    __syncthreads();
    if (threadIdx.x == 0) {
        unsigned* bar = b.bar;
        __builtin_amdgcn_s_waitcnt(0);
        unsigned nloc = b.st[0], nx = b.st[1];
        if (nloc == 0u) { xcd_barrier_complete(bar, b.x, nloc, nx); b.st[0] = nloc; b.st[1] = nx; }
        const unsigned old = xb_add(&bar[XB_XSUB(b.x)], 1u);
        const unsigned gen = old / nloc;
        if (old + 1u == (gen + 1u) * nloc) {
            __builtin_amdgcn_fence(__ATOMIC_RELEASE, "agent");
            asm volatile("s_waitcnt vmcnt(0)" ::: "memory");
            const unsigned og = xb_add(&bar[XB_TOP], 1u);
            const unsigned tg = og / nx;
            if (og + 1u == (tg + 1u) * nx) xb_add(&bar[XB_TOPGEN], 1u);
            else XB_SPIN(xb_ld(&bar[XB_TOPGEN]) == tg, bar);
            __builtin_amdgcn_fence(__ATOMIC_ACQUIRE, "agent");
            xb_add(&bar[XB_XGEN(b.x)], 1u);
            asm volatile("s_waitcnt vmcnt(0)" ::: "memory");
        } else {
            XB_SPIN(xb_ld(&bar[XB_XGEN(b.x)]) == gen, bar);
            __builtin_amdgcn_fence(__ATOMIC_ACQUIRE, "agent");
            asm volatile("s_waitcnt vmcnt(0)" ::: "memory");
        }
    }
    __syncthreads();
}
__device__ __forceinline__ float wave_sum(float v) {
#pragma unroll
    for (int o = 1; o < 64; o <<= 1) v += __shfl_xor(v, o);
    return v;
}
__device__ __forceinline__ unsigned pkbf(float lo, float hi) { return pg8::cvt_pk_bf16(lo, hi); }
__device__ __forceinline__ float bf2f(unsigned short b) { return __uint_as_float((unsigned)b << 16); }
__device__ __forceinline__ void transpose_item(const float* W, int ldn, bf16* WT, int K, int k0, int srccol0, int dstrow0, LAS float* scr, int lane, bool qf = false) {
#pragma unroll 8
    for (int i = 0; i < 32; ++i) { const int kk = 2 * i + (lane >> 5); scr[kk * 33 + (lane & 31)] = W[(size_t)(k0 + kk) * ldn + srccol0 + (lane & 31)]; }
    LDS_WAIT(); asm volatile("" ::: "memory");
    const int c = lane & 7;
#pragma unroll
    for (int j = 0; j < 4; ++j) { const int n = (lane >> 3) + 8 * j; const LAS float* s = scr + (8 * c) * 33 + n;
        v4u o; if (qf) { o.x = pkbf(qm(s[0 * 33]), qm(s[1 * 33])); o.y = pkbf(qm(s[2 * 33]), qm(s[3 * 33])); o.z = pkbf(qm(s[4 * 33]), qm(s[5 * 33])); o.w = pkbf(qm(s[6 * 33]), qm(s[7 * 33])); }
        else { o.x = pkbf(s[0 * 33], s[1 * 33]); o.y = pkbf(s[2 * 33], s[3 * 33]); o.z = pkbf(s[4 * 33], s[5 * 33]); o.w = pkbf(s[6 * 33], s[7 * 33]); }
        const int dr = dstrow0 + n; *(GAS v4u*)(WT + ((size_t)((dr >> 8) * (K >> 6) + (k0 >> 6)) * 256 + (dr & 255)) * 64 + 8 * c) = o; }
    LDS_WAIT(); asm volatile("" ::: "memory");
}
template <class INP> __device__ __forceinline__ void absmax_item(const INP& inp, unsigned char* ws, int t, LAS float* red, int tid) {
    const int col = tid & 127, kq = tid >> 7;
    const float* src; size_t ld; int kb, kn, kind, mat, cb;
    if (t < 352) { kind = 0; mat = t / 88; cb = t % 88; src = inp[12] + (size_t)mat * DM * NFF + 128 * cb + col; ld = NFF; kb = 512 * kq; kn = 512; }
    else if (t < 432) { t -= 352; kind = 1; mat = t / 40; cb = t % 40; src = inp[14] + (size_t)mat * DM * NIN + 128 * cb + col; ld = NIN; kb = 512 * kq; kn = 512; }
    else { t -= 432; kind = 2; mat = t >> 6; cb = (t & 63) >> 2; src = inp[13] + (size_t)mat * DFF * DM + 128 * cb + col; ld = DM; kb = 1408 * (t & 3) + 352 * kq; kn = 352; }
    float mx = 0.f;
    for (int k = kb; k < kb + kn; k += 8) { float w[8];
#pragma unroll
        for (int u = 0; u < 8; ++u) w[u] = src[(size_t)(k + u) * ld];
#pragma unroll
        for (int u = 0; u < 8; ++u) mx = fmaxf(mx, fabsf(w[u])); }
    red[kq * 128 + col] = mx;
    __syncthreads();
    if (tid < 128) { const float m4 = fmaxf(fmaxf(red[tid], red[128 + tid]), fmaxf(red[256 + tid], red[384 + tid])); const int s0 = 128 * cb + tid;
        if (kind == 0) { const int brow = s0 < DFF ? (s0 / 128) * 256 + (s0 % 128) : ((s0 - DFF) / 128) * 256 + 128 + ((s0 - DFF) % 128);
            ((float*)(ws + WS_Q + Q_SW))[(size_t)mat * NFF + brow] = fmaxf(m4, 1e-30f) * (1.0f / 127.0f); }
        else if (kind == 1) ((float*)(ws + WS_Q + Q_SW4))[(size_t)mat * NIN + s0] = fmaxf(m4, 1e-30f) * (1.0f / 127.0f);
        else atomicMax((unsigned*)(ws + WS_CTL + CTL_RAW2) + (size_t)mat * DM + s0, __float_as_uint(m4)); }
    __syncthreads();
}
template <class INP> __device__ __forceinline__ void prologue(const INP& inp, unsigned char* ws, LAS unsigned char* lds, int G, int wg, int tid) {
    const int lane = tid & 63, wave = __builtin_amdgcn_readfirstlane(tid >> 6);
    float* tab = (float*)(ws + WS_TAB);
    {
        LAS float* sc = (LAS float*)lds;
        LAS float* red = sc + NCOND * DM;
        bool have = false;
        for (int it = wg; it < 976; it += G) {
            if (it >= 288) { absmax_item(inp, ws, it - 288, (LAS float*)(lds + 98304), tid); continue; }
            if (!have) { for (int i = tid; i < NCOND * DM; i += 512) { const int cd = i >> 11, k = i & 2047; const float v = cd == 0 ? inp[8][k] : inp[2][(cd - 1) * DM + k];
                              sc[i] = v / (1.0f + __expf(-v)); } have = true; __syncthreads(); }
            const int l = it / 144, cb = it % 144, col = tid & 127, g = tid >> 7;
            const float* W = inp[9] + (size_t)l * DM * NMODC + 128 * cb + col;
            float acc[NCOND];
#pragma unroll
            for (int c = 0; c < NCOND; ++c) acc[c] = 0.f;
            for (int k = 512 * g; k < 512 * g + 512; k += 8) {
                float w[8];
#pragma unroll
                for (int u = 0; u < 8; ++u) w[u] = W[(size_t)(k + u) * NMODC];
#pragma unroll
                for (int c = 0; c < NCOND; ++c) { const f32x4 s0 = *(const LAS f32x4*)(sc + c * DM + k), s1 = *(const LAS f32x4*)(sc + c * DM + k + 4);
                    acc[c] += (s0[0] * w[0] + s0[1] * w[1]) + (s0[2] * w[2] + s0[3] * w[3]) + (s1[0] * w[4] + s1[1] * w[5]) + (s1[2] * w[6] + s1[3] * w[7]); }
            }
#pragma unroll
            for (int c = 0; c < NCOND; ++c) red[(g * NCOND + c) * 128 + col] = acc[c];
            __syncthreads();
            for (int i = tid; i < NCOND * 128; i += 512) { const int c = i >> 7, cc = i & 127;
                const float s = ((red[(0 * NCOND + c) * 128 + cc] + red[(1 * NCOND + c) * 128 + cc]) + red[(2 * NCOND + c) * 128 + cc]) + red[(3 * NCOND + c) * 128 + cc];
                tab[TB_MOD + ((size_t)l * NCOND + c) * NMODC + 128 * cb + cc] = s + inp[10][(size_t)l * NMODC + 128 * cb + cc]; }
            __syncthreads();
        }
        __syncthreads();
    }
    if (wg == 0) {
        for (int i = tid; i < 64 * 32; i += 512) { const int pos = i >> 5, f = i & 31; const double inv = pow(10000.0, -(double)(2 * f) / 64.0), a = (double)pos * inv;
            tab[TB_COSG + i] = (float)cos(a); tab[TB_SING + i] = (float)sin(a); }
        for (int i = tid; i < 64 * 16; i += 512) { const int pos = i >> 4, f = i & 15; const double inv = pow(10000.0, -(double)(2 * f) / 32.0), a = (double)pos * inv;
            tab[TB_COSD + i] = (float)cos(a); tab[TB_SIND + i] = (float)sin(a); }
        if (tid < 2) { const int l = tid; const float* dl = inp[19] + l * 256; double s01 = 0.0, s23 = 0.0;
            for (int i = 0; i < 64; ++i) { s01 += (double)dl[i] * (double)dl[64 + i]; s23 += (double)dl[128 + i] * (double)dl[192 + i]; }
            const double li = 0.8 - 0.6 * exp(-0.3 * (double)l);
            tab[TB_SCAL + 16 * l + 0] = (float)(exp(s01) - exp(s23) + li); tab[TB_SCAL + 16 * l + 1] = (float)(1.0 - li); }
        if (tid >= 128 && tid < 130) { const int l = tid - 128; const float* w = inp[18] + l * 256; float mq = 0.f, mk = 0.f;
            for (int i = 0; i < 128; ++i) { mq = fmaxf(mq, fabsf(w[i])); mk = fmaxf(mk, fabsf(w[128 + i])); }
            tab[TB_SCAL + 16 * l + 10] = (mq * mk * 11.313708f * 1.4426950f < 60.0f) ? 1.0f : 0.0f; }
        if (tid >= 64 && tid < 80) { const int i = tid - 64, l = i >> 3, j = i & 7; const double x = (double)inp[16][l * 8 + j];
            tab[TB_SCAL + 16 * l + 2 + j] = (float)(-log1p(exp(-x)) * 1.4426950408889634); }
    }
    {
        bf16* cb = (bf16*)(ws + WS_CACHE);
        const long gt = (long)wg * 512 + tid, GT = (long)G * 512;
        for (int t = 0; t < 4; ++t) { const float* src = inp[4 + t]; const long n8 = (t < 2 ? 1048576 : 2097152) / 8; bf16* dst = cb + (t == 0 ? 0 : t == 1 ? 1048576 : t == 2 ? 2097152 : 4194304);
            for (long i = gt; i < n8; i += GT) { const f32x4 a = *(const f32x4*)(src + i * 8), b = *(const f32x4*)(src + i * 8 + 4);
                v4u o; o.x = pkbf(a[0], a[1]); o.y = pkbf(a[2], a[3]); o.z = pkbf(b[0], b[1]); o.w = pkbf(b[2], b[3]); *(v4u*)(dst + i * 8) = o; } }
    }
    {
        LAS float* scr = (LAS float*)(lds + wave * 16384);
        const int gw = wg * 8 + wave, NGW = G * 8;
        for (int it = gw; it < 81920; it += NGW) {
            const int l = it / 40960; int r = it % 40960;
            bf16* WL = (bf16*)(ws + WS_W + (size_t)l * W_LAYER);
            if (r < 22528) continue;
            if (false) { const int f = r / 11264, q = r % 11264, kb = q / 352, nb = q % 352, s0 = 32 * nb;
                const int drow = s0 < DFF ? (s0 / 128) * 256 + (s0 % 128) : ((s0 - DFF) / 128) * 256 + 128 + ((s0 - DFF) % 128);
                transpose_item(inp[12] + (size_t)(l * 2 + f) * DM * NFF, NFF, WL + (W_WI + (size_t)f * 44 * MiB) / 2, DM, 64 * kb, s0, drow, scr, lane, true); continue; }
            r -= 22528;
            if (r < 11264) continue;
            if (false) { const int f = r / 5632, q = r % 5632, kb = q / 64, nb = q % 64;
                transpose_item(inp[13] + (size_t)(l * 2 + f) * DFF * DM, DM, WL + (W_WO + (size_t)f * 22 * MiB) / 2, DFF, 64 * kb, 32 * nb, 32 * nb, scr, lane, true); continue; }
            r -= 11264;
            if (r < 5120) { const int kb = r / 160, nb = r % 160;
                transpose_item(inp[14] + (size_t)l * DM * NIN, NIN, WL + W_WIN / 2, DM, 64 * kb, 32 * nb, 32 * nb, scr, lane); continue; }
            r -= 5120;
            { const int kb = r / 64, nb = r % 64;
                transpose_item(inp[15] + (size_t)l * DM * DM, DM, WL + W_WOUT / 2, DM, 64 * kb, 32 * nb, 32 * nb, scr, lane); }
        }
    }
}
template <class INP> __device__ __forceinline__ void prologue_b(const INP& inp, unsigned char* ws, LAS unsigned char* lds, int G, int wg, int tid) {
    const int lane = tid & 63, wave = __builtin_amdgcn_readfirstlane(tid >> 6);
    LAS float* scr = (LAS float*)(lds + wave * 16384);
    const float* swv = (const float*)(ws + WS_Q + Q_SW);
    const int gw = wg * 8 + wave, NGW = G * 8;
    const float* swv4 = (const float*)(ws + WS_Q + Q_SW4);
    if (wg < 4) {
        float sm = 0.f; for (int i = tid; i < NFF; i += 512) sm += swv[(size_t)wg * NFF + i];
#pragma unroll
        for (int o = 1; o < 64; o <<= 1) sm += __shfl_xor(sm, o);
        LAS float* red = (LAS float*)(lds + 131072);
        if (lane == 0) red[wave] = sm;
        __syncthreads();
        if (tid == 0) { float t = 0.f; for (int i = 0; i < 8; ++i) t += red[i];
            const float sg = t * (127.0f / (float)NFF) * (1.0f / 3.6f) * 45.254834f;
            const float h0 = fmaxf(fmaxf(sg * sg, sg), 1e-20f); const float sc = exp2f(1.0f - rintf(log2f(h0)));
            float* qa = (float*)(ws + WS_Q + Q_ACT) + 2 * wg; qa[0] = sc; qa[1] = 1.0f / sc; }
        __syncthreads();
    }
    for (int it = gw; it < 10240; it += NGW) {
        const int l = it / 5120, q = it % 5120, kb = q / 160, nb = q % 160, s0 = 32 * nb, k0 = 64 * kb;
        const float* W = inp[14] + (size_t)l * DM * NIN;
        unsigned char* WQ = ws + WS_W + (size_t)l * W_LAYER + W_WINQ;
#pragma unroll 8
        for (int i = 0; i < 32; ++i) { const int kk = 2 * i + (lane >> 5); scr[kk * 33 + (lane & 31)] = W[(size_t)(k0 + kk) * NIN + s0 + (lane & 31)]; }
        LDS_WAIT(); asm volatile("" ::: "memory");
        const int c = lane & 7;
#pragma unroll
        for (int j = 0; j < 4; ++j) { const int n = (lane >> 3) + 8 * j, dr = s0 + n; const LAS float* sp = scr + (8 * c) * 33 + n;
            const float inv = 1.0f / swv4[(size_t)l * NIN + dr];
            unsigned lo = 0u, hi = 0u;
#pragma unroll
            for (int e = 0; e < 4; ++e) { lo |= ((unsigned)(__float2int_rn(sp[e * 33] * inv)) & 0xffu) << (8 * e); hi |= ((unsigned)(__float2int_rn(sp[(4 + e) * 33] * inv)) & 0xffu) << (8 * e); }
            const int kk = k0 + 8 * c;
            uint2 o; o.x = lo; o.y = hi;
            *(uint2*)(WQ + ((size_t)((dr >> 8) * (DM >> 7) + (kk >> 7)) * 256 + (dr & 255)) * 128 + (kk & 127)) = o; }
        LDS_WAIT(); asm volatile("" ::: "memory");
    }
    const unsigned* raw2 = (const unsigned*)(ws + WS_CTL + CTL_RAW2);
    for (int i = wg * 512 + tid; i < 4 * DM; i += G * 512) ((float*)(ws + WS_Q + Q_SW2))[i] = fmaxf(__uint_as_float(raw2[i]), 1e-30f) * (1.0f / 240.0f);
    for (int it = gw; it < 22528; it += NGW) {
        const int mat = it / 5632, q = it % 5632, kb = q / 64, nb = q % 64, s0 = 32 * nb, k0 = 64 * kb, l = mat >> 1, f = mat & 1;
        const float* W = inp[13] + (size_t)mat * DFF * DM;
        unsigned char* WQ = ws + WS_W + (size_t)l * W_LAYER + W_WO + (size_t)f * 22 * MiB;
#pragma unroll 8
        for (int i = 0; i < 32; ++i) { const int kk = 2 * i + (lane >> 5); scr[kk * 33 + (lane & 31)] = W[(size_t)(k0 + kk) * DM + s0 + (lane & 31)]; }
        LDS_WAIT(); asm volatile("" ::: "memory");
        const int c = lane & 7;
#pragma unroll
        for (int j = 0; j < 4; ++j) { const int n = (lane >> 3) + 8 * j, dr = s0 + n; const LAS float* sp = scr + (8 * c) * 33 + n;
            const float inv = 240.0f / fmaxf(__uint_as_float(raw2[(size_t)mat * DM + dr]), 1e-30f);
            unsigned lo = __builtin_amdgcn_cvt_pk_fp8_f32(sp[0] * inv, sp[33] * inv, 0, false); lo = __builtin_amdgcn_cvt_pk_fp8_f32(sp[2 * 33] * inv, sp[3 * 33] * inv, lo, true);
            unsigned hi = __builtin_amdgcn_cvt_pk_fp8_f32(sp[4 * 33] * inv, sp[5 * 33] * inv, 0, false); hi = __builtin_amdgcn_cvt_pk_fp8_f32(sp[6 * 33] * inv, sp[7 * 33] * inv, hi, true);
            const int kk = k0 + 8 * c;
            uint2 o; o.x = lo; o.y = hi;
            *(uint2*)(WQ + ((size_t)((dr >> 8) * (DFF >> 7) + (kk >> 7)) * 256 + (dr & 255)) * 128 + (kk & 127)) = o; }
        LDS_WAIT(); asm volatile("" ::: "memory");
    }
    for (int it = gw; it < 45056; it += NGW) {
        const int mat = it / 11264, q = it % 11264, kb = q / 352, nb = q % 352, s0 = 32 * nb, k0 = 64 * kb, l = mat >> 1, f = mat & 1;
        const int drow = s0 < DFF ? (s0 / 128) * 256 + (s0 % 128) : ((s0 - DFF) / 128) * 256 + 128 + ((s0 - DFF) % 128);
        const float* W = inp[12] + (size_t)mat * DM * NFF;
        unsigned char* WQ = ws + WS_W + (size_t)l * W_LAYER + W_WI + (size_t)f * 44 * MiB;
#pragma unroll 8
        for (int i = 0; i < 32; ++i) { const int kk = 2 * i + (lane >> 5); scr[kk * 33 + (lane & 31)] = W[(size_t)(k0 + kk) * NFF + s0 + (lane & 31)]; }
        LDS_WAIT(); asm volatile("" ::: "memory");
        const int c = lane & 7;
#pragma unroll
        for (int j = 0; j < 4; ++j) { const int n = (lane >> 3) + 8 * j, dr = drow + n; const LAS float* sp = scr + (8 * c) * 33 + n;
            const float inv = 1.0f / swv[(size_t)mat * NFF + dr];
            unsigned lo = 0u, hi = 0u;
#pragma unroll
            for (int e = 0; e < 4; ++e) { lo |= ((unsigned)(__float2int_rn(sp[e * 33] * inv)) & 0xffu) << (8 * e); hi |= ((unsigned)(__float2int_rn(sp[(4 + e) * 33] * inv)) & 0xffu) << (8 * e); }
            const int kk = k0 + 8 * c;
            uint2 o; o.x = lo; o.y = hi;
            *(uint2*)(WQ + ((size_t)((dr >> 8) * (DM >> 7) + (kk >> 7)) * 256 + (dr & 255)) * 128 + (kk & 127)) = o; }
        LDS_WAIT(); asm volatile("" ::: "memory");
    }
}
__device__ __forceinline__ void quant_act_phase(const bf16* ACT, unsigned char* A8, float* sa, int G, int wg, int tid) {
    const int lane = tid & 63, wave = tid >> 6, gw = wg * 8 + wave, NGW = G * 8;
    for (int m = gw; m < MTOK; m += NGW) {
        const bf16* ar = ACT + (size_t)m * DFF;
        v4u v[11]; float mx = 0.f;
#pragma unroll
        for (int j = 0; j < 11; ++j) v[j] = *(const v4u*)(ar + 512 * j + 8 * lane);
#pragma unroll
        for (int j = 0; j < 11; ++j) { const unsigned w4[4] = {v[j].x, v[j].y, v[j].z, v[j].w};
#pragma unroll
            for (int e = 0; e < 4; ++e) mx = fmaxf(mx, fmaxf(fabsf(__uint_as_float(w4[e] << 16)), fabsf(__uint_as_float(w4[e] & 0xffff0000u)))); }
#pragma unroll
        for (int o = 1; o < 64; o <<= 1) mx = fmaxf(mx, __shfl_xor(mx, o));
        mx = fmaxf(mx, 1e-30f);
        if (lane == 0) sa[m] = mx * (1.0f / 127.0f);
        const float inv = 127.0f / mx; unsigned char* orow = A8 + (size_t)m * DFF;
#pragma unroll
        for (int j = 0; j < 11; ++j) { const unsigned w4[4] = {v[j].x, v[j].y, v[j].z, v[j].w}; unsigned o2[2] = {0u, 0u};
#pragma unroll
            for (int e = 0; e < 4; ++e) { const unsigned lo = (unsigned)__float2int_rn(__uint_as_float(w4[e] << 16) * inv) & 0xffu, hi = (unsigned)__float2int_rn(__uint_as_float(w4[e] & 0xffff0000u) * inv) & 0xffu;
                o2[e >> 1] |= (lo | (hi << 8)) << (16 * (e & 1)); }
            uint2 ov; ov.x = o2[0]; ov.y = o2[1]; *(uint2*)(orow + 512 * j + 8 * lane) = ov; }
    }
}
__device__ __forceinline__ void quant_xs_phase(const bf16* XS, const unsigned* amax, unsigned char* A8, float* sa, int G, int wg, int tid, int m_begin = 0) {
    const int lane = tid & 63, wave = tid >> 6, gw = wg * 8 + wave, NGW = G * 8;
    for (int m0 = m_begin + 2 * gw; m0 < MTOK; m0 += 2 * NGW) {
        v4u v[2][4]; float mx[2];
#pragma unroll
        for (int r = 0; r < 2; ++r) { const bf16* xr = XS + (size_t)(m0 + r) * DM; mx[r] = fmaxf(__uint_as_float(amax[m0 + r]), 1e-30f);
#pragma unroll
            for (int j = 0; j < 4; ++j) v[r][j] = *(const v4u*)(xr + 512 * j + 8 * lane); }
#pragma unroll
        for (int r = 0; r < 2; ++r) { const float inv = 127.0f / mx[r]; unsigned char* orow = A8 + (size_t)(m0 + r) * DM; if (lane == 0) sa[m0 + r] = mx[r] * (1.0f / 127.0f);
#pragma unroll
            for (int j = 0; j < 4; ++j) { const unsigned w4[4] = {v[r][j].x, v[r][j].y, v[r][j].z, v[r][j].w}; unsigned o2[2] = {0u, 0u};
#pragma unroll
                for (int e = 0; e < 4; ++e) { const unsigned lo = (unsigned)__float2int_rn(__uint_as_float(w4[e] << 16) * inv) & 0xffu, hi = (unsigned)__float2int_rn(__uint_as_float(w4[e] & 0xffff0000u) * inv) & 0xffu;
                    o2[e >> 1] |= (lo | (hi << 8)) << (16 * (e & 1)); }
                uint2 ov; ov.x = o2[0]; ov.y = o2[1]; *(uint2*)(orow + 512 * j + 8 * lane) = ov; } }
    }
}
__device__ __forceinline__ void quant_phase(const float* xP, const float* xS, const float* nw, const float* scl0  , unsigned char* A8, float* sa, unsigned long long* rss, int G, int wg, int tid, int m_begin = 0) {
    const int lane = tid & 63, wave = tid >> 6, gw = wg * 8 + wave, NGW = G * 8;
    for (int m = m_begin + gw; m < MTOK; m += NGW) {
        const float* xr = (m < M_P ? xP : xS) + (size_t)m * DM;
        const int cond = m < M_P ? 0 : 1 + ((m - M_P) >> 12);
        const float* scl = scl0 + (size_t)cond * NMODC;
        f32x4 h[8]; float ss = 0.f, mx = 0.f;
#pragma unroll
        for (int j = 0; j < 8; ++j) { const int c = 256 * j + 4 * lane; const f32x4 v = *(const f32x4*)(xr + c); ss += (v[0] * v[0] + v[1] * v[1]) + (v[2] * v[2] + v[3] * v[3]);
            h[j] = v * *(const f32x4*)(nw + c) * (*(const f32x4*)(scl + c) + 1.0f);
            mx = fmaxf(fmaxf(mx, fmaxf(fabsf(h[j][0]), fabsf(h[j][1]))), fmaxf(fabsf(h[j][2]), fabsf(h[j][3]))); }
        ss = wave_sum(ss);
#pragma unroll
        for (int o = 1; o < 64; o <<= 1) mx = fmaxf(mx, __shfl_xor(mx, o));
        mx = fmaxf(mx, 1e-30f);
        if (lane == 0) { rss[m] = (unsigned long long)(ss * 16777216.0f); sa[m] = mx * (1.0f / 127.0f); }
        const float inv = 127.0f / mx; unsigned char* orow = A8 + (size_t)m * DM;
#pragma unroll
        for (int j = 0; j < 8; ++j) { const unsigned w = ((unsigned)__float2int_rn(h[j][0] * inv) & 0xffu) | (((unsigned)__float2int_rn(h[j][1] * inv) & 0xffu) << 8) | (((unsigned)__float2int_rn(h[j][2] * inv) & 0xffu) << 16) | (((unsigned)__float2int_rn(h[j][3] * inv) & 0xffu) << 24);
            *(unsigned*)(orow + 256 * j + 4 * lane) = w; }
    }
}
__device__ __forceinline__ void norm0_phase(const float* xP, const float* xS, const float* nw, const float* mod  , bf16* XN, unsigned long long* rss, int G, int wg, int tid) {
    const int lane = tid & 63, wave = tid >> 6, gw = wg * 8 + wave, NGW = G * 8;
    for (int m = gw; m < MTOK; m += NGW) {
        const float* xr = (m < M_P ? xP : xS) + (size_t)m * DM;
        const int cond = m < M_P ? 0 : 1 + ((m - M_P) >> 12);
        const float* scl = mod + (size_t)cond * NMODC + DM;
        f32x4 v[8]; float ss = 0.f;
#pragma unroll
        for (int j = 0; j < 8; ++j) { v[j] = *(const f32x4*)(xr + 256 * j + 4 * lane); ss += (v[j][0] * v[j][0] + v[j][1] * v[j][1]) + (v[j][2] * v[j][2] + v[j][3] * v[j][3]); }
        ss = wave_sum(ss); if (lane == 0) rss[m] = (unsigned long long)(ss * 16777216.0f);
        bf16* orow = XN + (size_t)m * DM;
#pragma unroll
        for (int j = 0; j < 8; ++j) { const int c = 256 * j + 4 * lane; const f32x4 w = *(const f32x4*)(nw + c), s1 = *(const f32x4*)(scl + c);
            const f32x4 h = v[j] * w * (s1 + 1.0f);
            uint2 o; o.x = pkbf(qm(h[0]), qm(h[1])); o.y = pkbf(qm(h[2]), qm(h[3])); *(uint2*)(orow + c) = o; }
    }
}
__device__ __forceinline__ void bias_ffn_mfma(unsigned char* ws, LAS unsigned char* lds, int grp, int sub, int nsub, int tid) {
    typedef int i32x4_t __attribute__((ext_vector_type(4)));
    const int lane = tid & 63, wave = tid >> 6, l = grp >> 1, f = grp & 1;
    const float* mod = (const float*)(ws + WS_TAB) + TB_MOD + (size_t)l * NCOND * NMODC + (size_t)(6 * f) * DM;
    LAS unsigned char* D = lds;
    LAS float* red = (LAS float*)(lds + 65536);
    __syncthreads();
    for (int i = tid; i < 65536 / 16; i += 512) ((LAS v4u*)D)[i] = (v4u){0u, 0u, 0u, 0u};
    for (int c = wave; c < NCOND; c += 8) { float mx = 0.f; for (int k = lane; k < DM; k += 64) mx = fmaxf(mx, fabsf(mod[(size_t)c * NMODC + k]));
#pragma unroll
        for (int o = 1; o < 64; o <<= 1) mx = fmaxf(mx, __shfl_xor(mx, o));
        if (lane == 0) red[c] = fmaxf(mx, 1e-30f) * (1.0f / 127.0f); }
    __syncthreads();
    for (int i = tid; i < NCOND * DM; i += 512) { const int c = i >> 11, k = i & 2047; const float s0 = red[c], s1 = s0 * (1.0f / 127.0f), v = mod[(size_t)c * NMODC + k];
        const float d0 = rintf(v / s0), d1 = rintf((v - d0 * s0) / s1); const int off = ((k >> 6) * 16 + c) * 64 + (k & 63);
        D[off] = (unsigned char)(int)d0; D[32768 + off] = (unsigned char)(int)d1; }
    __syncthreads();
    const unsigned char* Bq = ws + WS_W + (size_t)l * W_LAYER + W_WI + (size_t)f * 44 * MiB;
    const float* swv = (const float*)(ws + WS_Q + Q_SW) + (size_t)(2 * l + f) * NFF;
    float* sb = (float*)(ws + WS_SB) + (size_t)l * SB_LAYER + (f ? SB_J2 : 0);
    const int jr = lane & 15, g = lane >> 4;
    for (int rg = sub * 8 + wave; rg < NFF / 16; rg += nsub * 8) {
        const int n = rg * 16 + jr;
        const unsigned char* wp = Bq + ((size_t)(n >> 8) * (DM >> 7) * 256 + (n & 255)) * 128 + 16 * g;
        i32x4_t a0 = {0, 0, 0, 0}, a1 = {0, 0, 0, 0};
#pragma unroll 4
        for (int kb = 0; kb < 32; ++kb) {
            const i32x4_t w = *(const i32x4_t*)(wp + (size_t)(kb >> 1) * 256 * 128 + (kb & 1) * 64);
            const i32x4_t d0 = *(const LAS i32x4_t*)(D + ((kb * 16 + jr) * 64 + 16 * g)), d1 = *(const LAS i32x4_t*)(D + 32768 + ((kb * 16 + jr) * 64 + 16 * g));
            a0 = __builtin_amdgcn_mfma_i32_16x16x64_i8(w, d0, a0, 0, 0, 0); a1 = __builtin_amdgcn_mfma_i32_16x16x64_i8(w, d1, a1, 0, 0, 0);
        }
        if (jr < NCOND) { const float s0 = red[jr], s1 = s0 * (1.0f / 127.0f);
#pragma unroll
            for (int r = 0; r < 4; ++r) { const int nn = rg * 16 + 4 * g + r; sb[(size_t)jr * NFF + nn] = swv[nn] * (s0 * (float)a0[r] + s1 * (float)a1[r]); } }
    }
    __syncthreads();
}
__device__ __forceinline__ void bias_phase(unsigned char* ws, LAS unsigned char* lds, int G, int wg, int tid) {
    const int lane = tid & 63, wave = tid >> 6, gw = wg * 8 + wave, NGW = G * 8;
    LAS float* sh = (LAS float*)lds;
    const float* tab = (const float*)(ws + WS_TAB);
    const int per = G / 4; const bool mf = per >= 1;
    if (mf && wg < 4 * per) bias_ffn_mfma(ws, lds, wg / per, wg % per, per, tid);
    for (int grp = 0; grp < 6; ++grp) {
        const int l = grp / 3, j = grp % 3, N = (j == 1) ? NIN : NFF;
        if (mf && j != 1) continue;
        const bf16* Bt = (const bf16*)(ws + WS_W + (size_t)l * W_LAYER + (j == 0 ? W_WI : j == 1 ? W_WIN : W_WI + 44 * MiB));
        float* sb = (float*)(ws + WS_SB) + (size_t)l * SB_LAYER + (j == 0 ? 0 : j == 1 ? SB_J1 : SB_J2);
        const float* mod = tab + TB_MOD + (size_t)l * NCOND * NMODC + (size_t)(3 * j) * DM;
        __syncthreads();
        for (int i = tid; i < NCOND * DM; i += 512) sh[i] = mod[(size_t)(i >> 11) * NMODC + (i & 2047)];
        __syncthreads();
        if (j != 1) {
            const unsigned char* Bq = (const unsigned char*)Bt; const float* swv = (const float*)(ws + WS_Q + Q_SW) + (size_t)(2 * l + (j >> 1)) * NFF;
            for (int n = gw; n < N; n += NGW) {
                v4u wr2[2];
#pragma unroll
                for (int q = 0; q < 2; ++q) { const int k_ = 16 * (lane + 64 * q); wr2[q] = *(const v4u*)(Bq + ((size_t)((n >> 8) * (DM >> 7) + (k_ >> 7)) * 256 + (n & 255)) * 128 + (k_ & 127)); }
                float wf[2][16];
#pragma unroll
                for (int q = 0; q < 2; ++q) { const unsigned ww[4] = {wr2[q].x, wr2[q].y, wr2[q].z, wr2[q].w};
#pragma unroll
                    for (int e = 0; e < 16; ++e) wf[q][e] = (float)(int)(signed char)((ww[e >> 2] >> (8 * (e & 3))) & 0xffu); }
                const float swn = swv[n];
#pragma unroll 1
                for (int c = 0; c < NCOND; ++c) { float a = 0.f;
#pragma unroll
                    for (int q = 0; q < 2; ++q) { const int k = 16 * (lane + 64 * q);
#pragma unroll
                        for (int e4 = 0; e4 < 4; ++e4) { const f32x4 s0 = *(const LAS f32x4*)(sh + c * DM + k + 4 * e4); a += (s0[0] * wf[q][4 * e4] + s0[1] * wf[q][4 * e4 + 1]) + (s0[2] * wf[q][4 * e4 + 2] + s0[3] * wf[q][4 * e4 + 3]); } }
                    const float t = wave_sum(a); if (lane == 0) sb[(size_t)c * N + n] = t * swn; }
            }
            continue;
        }
        v4u wq[4];
        if (gw < N) {
#pragma unroll
            for (int q = 0; q < 4; ++q) { const int k_ = 8 * (lane + 64 * q); wq[q] = *(const v4u*)(Bt + ((size_t)((gw >> 8) * (DM >> 6) + (k_ >> 6)) * 256 + (gw & 255)) * 64 + (k_ & 63)); } }
        for (int n = gw; n < N; n += NGW) {
            v4u wc_[4];
#pragma unroll
            for (int q = 0; q < 4; ++q) wc_[q] = wq[q];
            if (n + NGW < N) {
#pragma unroll
                for (int q = 0; q < 4; ++q) { const int k_ = 8 * (lane + 64 * q), n_ = n + NGW; wq[q] = *(const v4u*)(Bt + ((size_t)((n_ >> 8) * (DM >> 6) + (k_ >> 6)) * 256 + (n_ & 255)) * 64 + (k_ & 63)); } }
            float wf[4][8];
#pragma unroll
            for (int q = 0; q < 4; ++q) { const v4u w4 = wc_[q];
                wf[q][0] = __uint_as_float(w4.x << 16); wf[q][1] = __uint_as_float(w4.x & 0xffff0000u); wf[q][2] = __uint_as_float(w4.y << 16); wf[q][3] = __uint_as_float(w4.y & 0xffff0000u);
                wf[q][4] = __uint_as_float(w4.z << 16); wf[q][5] = __uint_as_float(w4.z & 0xffff0000u); wf[q][6] = __uint_as_float(w4.w << 16); wf[q][7] = __uint_as_float(w4.w & 0xffff0000u); }
#pragma unroll 1
            for (int c = 0; c < NCOND; ++c) { float a = 0.f;
#pragma unroll
                for (int q = 0; q < 4; ++q) { const int k = 8 * (lane + 64 * q); const f32x4 s0 = *(const LAS f32x4*)(sh + c * DM + k), s1 = *(const LAS f32x4*)(sh + c * DM + k + 4);
                    a += (s0[0] * wf[q][0] + s0[1] * wf[q][1]) + (s0[2] * wf[q][2] + s0[3] * wf[q][3]) + (s1[0] * wf[q][4] + s1[1] * wf[q][5]) + (s1[2] * wf[q][6] + s1[3] * wf[q][7]); }
                const float t = wave_sum(a); if (lane == 0) sb[(size_t)c * N + n] = t; }
        }
    }
    __syncthreads();
}
__device__ __forceinline__ void final_norm(float* x, const float* fw, int G, int wg, int tid) {
    const int lane = tid & 63, wave = tid >> 6, gw = wg * 8 + wave, NGW = G * 8;
    for (int m = gw; m < MTOK; m += NGW) {
        float* xr = x + (size_t)m * DM; f32x4 v[8]; float ss = 0.f;
#pragma unroll
        for (int j = 0; j < 8; ++j) { v[j] = *(const f32x4*)(xr + 256 * j + 4 * lane); ss += (v[j][0] * v[j][0] + v[j][1] * v[j][1]) + (v[j][2] * v[j][2] + v[j][3] * v[j][3]); }
        const float rstd = rsqrtf(wave_sum(ss) * (1.0f / DM) + EPS);
#pragma unroll
        for (int j = 0; j < 8; ++j) { const int c = 256 * j + 4 * lane; *(f32x4*)(xr + c) = (v[j] * rstd) * *(const f32x4*)(fw + c); }
    }
}
__device__ __forceinline__ void prep_row(int m, int l, bf16* PROJ, bf16* DST, const float* tab, const float* qkw  , float* out, int lane) {
    bf16* pr = PROJ + (size_t)m * NIN; bf16* pw = DST + (size_t)m * NIN;
    const bool lat = m >= M_P; const int t = lat ? ((m - M_P) & 4095) : (m & 255), b = lat ? ((m - M_P) >> 12) : (m >> 8);
    const int rr = t >> 6, cc = t & 63;
    unsigned rg[10], rd[8], rv2[2], rv4[4];
#pragma unroll
    for (int v = 0; v < 10; ++v) rg[v] = *(const unsigned*)(pr + (v < 8 ? C_GQ + 128 * v : C_GK + 128 * (v - 8)) + 2 * lane);
#pragma unroll
    for (int v = 0; v < 8; ++v) rd[v] = *(const unsigned*)(pr + (v < 4 ? C_DQ + 128 * v : C_DK + 128 * (v - 4)) + 2 * lane);
    if (!lat) {
#pragma unroll
        for (int v = 0; v < 2; ++v) rv2[v] = *(const unsigned*)(pr + C_GV + 128 * v + 2 * lane);
#pragma unroll
        for (int v = 0; v < 4; ++v) rv4[v] = *(const unsigned*)(pr + C_DV + 128 * v + 2 * lane);
    }
    const float wq0 = qkw[2 * lane], wq1 = qkw[2 * lane + 1], wk0 = qkw[128 + 2 * lane], wk1 = qkw[128 + 2 * lane + 1];
    float cs = 1.f, sn = 0.f, c2 = 1.f, s2 = 0.f;
    if (lat) { const int idx = lane < 32 ? rr * 32 + lane : cc * 32 + (lane - 32); cs = tab[TB_COSG + idx]; sn = tab[TB_SING + idx];
               const int p = lane & 31, id2 = p < 16 ? rr * 16 + p : cc * 16 + (p - 16); c2 = tab[TB_COSD + id2]; s2 = tab[TB_SIND + id2]; }
#pragma unroll
    for (int v = 0; v < 10; ++v) {
        const int col = (v < 8 ? C_GQ + 128 * v : C_GK + 128 * (v - 8)) + 2 * lane;
        const float x1 = bf2f((unsigned short)(rg[v] & 0xffffu)), x2 = bf2f((unsigned short)(rg[v] >> 16));
        const float rs = rsqrtf(wave_sum(x1 * x1 + x2 * x2) * (1.0f / 128.0f) + EPS);
        const float y1 = x1 * rs * (v < 8 ? wq0 : wk0), y2 = x2 * rs * (v < 8 ? wq1 : wk1);
        if (!lat && v >= 8) { float* o = out + O_GK + (((size_t)(b * 2 + l) * 256 + t) * 2 + (v - 8)) * 128 + 2 * lane; o[0] = y1; o[1] = y2; }
        const float qs = v < 8 ? 0.12751743f : 1.0f;
        *(unsigned*)(pw + col) = pkbf((y1 * cs - y2 * sn) * qs, (y1 * sn + y2 * cs) * qs);
    }
    if (lat) {
#pragma unroll
        for (int v = 0; v < 8; ++v) { const int col = (v < 4 ? C_DQ + 128 * v : C_DK + 128 * (v - 4)) + 2 * lane;
            const float x1 = bf2f((unsigned short)(rd[v] & 0xffffu)), x2 = bf2f((unsigned short)(rd[v] >> 16));
            *(unsigned*)(pw + col) = pkbf(x1 * c2 - x2 * s2, x1 * s2 + x2 * c2); }
    } else {
#pragma unroll
        for (int v = 0; v < 2; ++v) { float* o = out + O_GV + (((size_t)(b * 2 + l) * 256 + t) * 2 + v) * 128 + 2 * lane; o[0] = bf2f((unsigned short)(rv2[v] & 0xffffu)); o[1] = bf2f((unsigned short)(rv2[v] >> 16)); }
#pragma unroll
        for (int v = 0; v < 4; ++v) { const unsigned rk = rd[4 + v], rv = rv4[v];
            const size_t oi = (((size_t)(b * 2 + l) * 256 + t) * 4 + v) * 128 + 2 * lane;
            out[O_DK + oi] = bf2f((unsigned short)(rk & 0xffffu)); out[O_DK + oi + 1] = bf2f((unsigned short)(rk >> 16));
            out[O_DV + oi] = bf2f((unsigned short)(rv & 0xffffu)); out[O_DV + oi + 1] = bf2f((unsigned short)(rv >> 16)); }
    }
}
#ifndef EN_PRO
#define EN_PRO 1
#endif
#ifndef EN_NORM
#define EN_NORM 1
#endif
#ifndef EN_FFNIN
#define EN_FFNIN 1
#endif
#ifndef EN_FFNOUT
#define EN_FFNOUT 1
#endif
#ifndef EN_WIN
#define EN_WIN 1
#endif
#ifndef EN_P
#define EN_P 1
#endif
#ifndef EN_A
#define EN_A 1
#endif
#ifndef EN_A1
#define EN_A1 1
#endif
#ifndef EN_A2
#define EN_A2 1
#endif
#ifndef EN_A3
#define EN_A3 1
#endif
#ifndef EN_WOUT
#define EN_WOUT 1
#endif
#ifndef EN_FIN
#define EN_FIN 1
#endif
struct Args { const float* in[22]; float* out; unsigned char* ws; int ph_lo, ph_hi, pad0, pad1; };
constexpr int NPHASE = 30;
#define LAUNDER(p) asm volatile("" : "+s"(p))
struct InPtrs { const float* const* p; __device__ __forceinline__ const float* operator[](int i) const { return p[i]; } };
__device__ __forceinline__ int deal_unit(int i, int NL, int NC, int off, int G, int wg) {
    if (NL % G == 0) { const int nr = NL / G; if (i < nr) return i * G + wg; if (i > nr) return -1; const int c = (wg + G - off) % G; return c < NC ? NL + c : -1; }
    const int v = i * G + wg; return v < NL + NC ? v : -1;
}
__global__ void __launch_bounds__(512, 2) fwd_kernel(Args args) {
    extern __shared__ __attribute__((aligned(16))) unsigned char lds_raw[];
    LAS unsigned char* lds = (LAS unsigned char*)lds_raw;
    volatile LAS unsigned* MISC = (volatile LAS unsigned*)(lds + MISC_OFF);
    const int G = gridDim.x, wg = blockIdx.x;
    for (int u = threadIdx.x; u < (LDS_BYTES - 131072) / 4; u += 512) ((LAS unsigned*)(lds + 131072))[u] = 0u;
    __syncthreads();
    XcdBarrier bar = xcd_barrier_post((unsigned*)(args.ws + WS_CTL) + CW_BAR, MISC + 8);
    const int lo = args.ph_lo, hi = args.ph_hi;
#define IN(k) (lo <= (k) && (k) < hi)
#define SEAM(k) do { if (IN(k) && IN((k) + 1)) xcd_barrier(bar); } while (0)
#define PH_BEGIN size_t zoff_ = 0; asm volatile("" : "+s"(zoff_)); unsigned char* ws = args.ws + zoff_; float* out = args.out + zoff_;   \
    const InPtrs inp{args.in}; int tid = threadIdx.x; asm volatile("" : "+v"(tid)); \
    const int lane = tid & 63, wave = __builtin_amdgcn_readfirstlane(tid >> 6); (void)lane; (void)wave;

    if (IN(0)) { PH_BEGIN; (void)out; prologue(inp, ws, lds, G, wg, tid); }
    SEAM(0);
    if (IN(1)) { PH_BEGIN; (void)out; prologue_b(inp, ws, lds, G, wg, tid); }
    SEAM(1);
    if (IN(2)) { PH_BEGIN; (void)out;
        quant_phase(inp[0], inp[1] - (size_t)M_P * DM, inp[11], (const float*)(ws + WS_TAB) + TB_MOD + DM, ws + WS_XNB, (float*)(ws + WS_Q), (unsigned long long*)(ws + WS_RS), G, wg, tid);
        bias_phase(ws, lds, G, wg, tid); }
    SEAM(2);
#pragma unroll 1
    for (int l = 0; l < 2; ++l) {
        const int pb = 3 + 13 * l;
#pragma unroll 1
        for (int f = 0; f < 2; ++f) {
            const int fb = pb + 9 * f;
            if (IN(fb + 0)) { PH_BEGIN; (void)out; (void)inp; const bf16* WL = (const bf16*)(ws + WS_W + (size_t)l * W_LAYER);
                pg8::Gemm g{(const bf16*)(ws + WS_XNB), WL + (W_WI + (size_t)f * 44 * MiB) / 2, MTOK, NFF, DM / 2}; pg8::StaticOrder S; S.init(MTOK, NFF, G, wg);
                pg8::EpiSwiGLUQ E{ws + WS_A8B, DFF, (const unsigned long long*)(ws + WS_RS) + (size_t)(3 * l + 2 * f) * MTOK, (const float*)(ws + WS_Q), (const float*)(ws + WS_Q + Q_SW) + (size_t)(2 * l + f) * NFF,
                                  (const float*)(ws + WS_SB) + (size_t)l * SB_LAYER + (f ? SB_J2 : 0), NFF, (const float*)(ws + WS_Q + Q_ACT) + 2 * (2 * l + f)};
                pg8::gemm_phase<pg8::EpiSwiGLUQ, pg8::StaticOrder, true, true, true>(lds, g, S, E); }
            if (IN(fb + 0) && IN(fb + 2)) xcd_barrier(bar);
            if (IN(fb + 2)) { PH_BEGIN; float* X = out + O_X; const bool first = (l == 0 && f == 0); const unsigned char* WL8 = ws + WS_W + (size_t)l * W_LAYER + W_WO + (size_t)f * 22 * MiB;
                const float* tabf = (const float*)(ws + WS_TAB); const float* mod = tabf + TB_MOD + (size_t)l * NCOND * NMODC;
                pg8::Gemm g{(const bf16*)(ws + WS_A8B), (const bf16*)WL8, MTOK, DM, DFF / 2}; pg8::StaticOrder S; S.init(MTOK, DM, G, wg);
                const int ni = f ? 3 * (l + 1) : 3 * l + 1;
                const size_t rs_off = WS_RS + (size_t)ni * MTOK * 8;
                pg8::EpiResidN E{first ? inp[0] : X, first ? inp[1] - (size_t)M_P * DM : X, X, mod + (2 + 6 * f) * DM,
                                 inp[11] + (size_t)(f ? 3 : 3 * l + 1) * DM, f ? tabf + TB_MOD + (size_t)NCOND * NMODC + DM : mod + (size_t)4 * DM, (unsigned long long*)(ws + rs_off), (long)(f ? WS_ACT : WS_XN) - (long)rs_off, 0.5f, (f && l) ? 0 : 1,
                                 (long)(WS_Q + Q_ACT + (size_t)(2 * (2 * l + f) + 1) * 4) - (long)rs_off, (long)(WS_Q + Q_SW2 + (size_t)(2 * l + f) * DM * 4) - (long)rs_off, 2, 1, (long)(WS_CTL + CTL_AMAX + (size_t)ni * MTOK * 4) - (long)rs_off};
                pg8::gemm_phase<pg8::EpiResidN, pg8::StaticOrder, true, true, 2>(lds, g, S, E); }
            SEAM(fb + 2);
            if (f == 1) {
                if (l == 0 && IN(pb + 12)) { PH_BEGIN; float* X = out + O_X;
                    (void)X; quant_xs_phase((const bf16*)(ws + WS_ACT), (const unsigned*)(ws + WS_CTL + CTL_AMAX) + (size_t)3 * MTOK, ws + WS_XNB, (float*)(ws + WS_Q), G, wg, tid); }
                SEAM(pb + 12);
                break; }
            if (IN(pb + 3)) { PH_BEGIN; float* X = out + O_X;
                (void)X; quant_xs_phase((const bf16*)(ws + WS_XN), (const unsigned*)(ws + WS_CTL + CTL_AMAX) + (size_t)(3 * l + 1) * MTOK, ws + WS_XNB, (float*)(ws + WS_Q), G, wg, tid, M_P); }
            SEAM(pb + 3);
            if (IN(pb + 4)) {
                { PH_BEGIN; (void)out; (void)inp;
                  pg8::Gemm g{(const bf16*)(ws + WS_XNB + (size_t)M_P * DM), (const bf16*)(ws + WS_W + (size_t)l * W_LAYER + W_WINQ), M_S, NIN, DM / 2}; pg8::StaticOrder S; S.init(M_S, NIN, G, wg);
                  pg8::EpiStoreQ E{(bf16*)(ws + WS_ACT) + (size_t)M_P * NIN, NIN, (const unsigned long long*)(ws + WS_RS) + (size_t)(3 * l + 1) * MTOK + M_P, (const float*)(ws + WS_Q) + M_P,
                                   (const float*)(ws + WS_Q + Q_SW4) + (size_t)l * NIN, (const float*)(ws + WS_SB) + (size_t)l * SB_LAYER + SB_J1, NIN, 16};
                  pg8::gemm_phase<pg8::EpiStoreQ, pg8::StaticOrder, true, true, true>(lds, g, S, E); }
                { PH_BEGIN; (void)out; (void)inp; const bf16* WL = (const bf16*)(ws + WS_W + (size_t)l * W_LAYER);
                  pg8::Gemm g{(const bf16*)(ws + WS_XN), WL + W_WIN / 2, M_P, NIN, DM}; pg8::StaticOrder S; S.init(M_P, NIN, G, wg);
                  pg8::EpiStoreBf16N E{(bf16*)(ws + WS_ACT), NIN, (const unsigned long long*)(ws + WS_RS) + (size_t)(3 * l + 1) * MTOK, (const float*)(ws + WS_SB) + (size_t)l * SB_LAYER + SB_J1, NIN};
                  pg8::gemm_phase<pg8::EpiStoreBf16N, pg8::StaticOrder, true, true>(lds, g, S, E); }
            }
            SEAM(pb + 4);
            if (IN(pb + 5)) { PH_BEGIN; bf16* PROJ = (bf16*)(ws + WS_ACT); const float* tab = (const float*)(ws + WS_TAB);
#pragma unroll 1
                for (int ch = wg; ch < 192; ch += G) {
                    const bool lat = ch < 64; const int cc = lat ? ch : ch - 64, dir = cc & 1, h = (cc >> 1) & 3, b = cc >> 3;
                    att::ChainArgs a; a.P = PROJ + (size_t)(lat ? M_P + b * 4096 : b * 256) * NIN; a.kcol = C_RK + 128 * h; a.vcol = C_RV + 128 * h; a.nchunk = lat ? 32 : 2; a.dir = dir;
                    a.lg2 = tab[TB_SCAL + 16 * l + 2 + dir * 4 + h];
                    a.S0 = lat ? inp[3] + ((((size_t)b * 2 + l) * 2 + dir) * 4 + h) * 16384 : nullptr;
                    a.ST = (bf16*)(ws + WS_ST) + (lat ? (size_t)cc * 32 * 16384 : (size_t)64 * 32 * 16384 + (size_t)cc * 2 * 16384);
                    a.Sfin = lat ? nullptr : out + O_STATE + ((((size_t)b * 2 + l) * 2 + dir) * 4 + h) * 16384;
                    __syncthreads(); att::ret_chain(a, (char*)lds_raw);
                }
                const int w0 = G > 128 ? 64 : 0, gw = (wg - w0) * 8 + wave, NGW = (G - w0) * 8;
                if (wg >= w0) for (int m = gw; m < MTOK; m += NGW) prep_row(m, l, PROJ, PROJ, tab, inp[18] + l * 256, out, lane);
            }
            SEAM(pb + 5);
            if (IN(pb + 6)) { PH_BEGIN; (void)out; bf16* PROJ = (bf16*)(ws + WS_ACT); bf16* MIX = (bf16*)(ws + WS_XN); const float* tab = (const float*)(ws + WS_TAB);
                const bf16* CGK = (const bf16*)(ws + WS_CACHE);
#pragma unroll 1
                for (int rp = 0; rp < ((PROBE == 13 && l == 0) ? 2 : 1); ++rp)
#pragma unroll 1
                for (int i2 = 0;; ++i2) { const int ps = i2 & 1; const int u = deal_unit(i2 >> 1, 512, 64, 192, G, wg); if (u < 0) break;
                    const bool lat = u < 512; const int v = lat ? u : u - 512;
                    const int qb = lat ? (v & 15) : 0, h = lat ? ((v >> 4) & 3) : (v & 3), b = lat ? (v >> 6) : (v >> 2);
                    const size_t row0 = lat ? (size_t)M_P + (size_t)b * 4096 : (size_t)b * 256;
                    const float lam = tab[TB_SCAL + 16 * l + 0], post = tab[TB_SCAL + 16 * l + 1];
                    {
                        att::KVSrc kv; kv.K1 = PROJ + row0 * NIN + C_DK + 128 * h + 64 * ps; kv.V1 = PROJ + row0 * NIN + C_DV + 128 * h; kv.n1 = lat ? 4096 : 256;
                        kv.K2 = CGK + 2097152 + ((size_t)(b * 2 + l) * 256) * 512 + 128 * h + 64 * ps; kv.V2 = CGK + 4194304 + ((size_t)(b * 2 + l) * 256) * 512 + 128 * h; kv.n2 = lat ? 256 : 0;
                        att::AttnOut ao; ao.Ob = MIX + (row0 + 256 * qb) * DM + 1536 + 128 * h; ao.Of = (float*)(ws + WS_DF) + (row0 + 256 * qb) * 512 + 128 * h;
                        ao.nw = inp[20] + l * 512 + 128 * h; ao.lam = lam; ao.post = post; ao.pass = ps;
                        __syncthreads();
                        att::attn_body<64, 1, 512>(PROJ + (row0 + 256 * qb) * NIN + C_DQ + 128 * h + 64 * ps, kv, ao, (char*)lds_raw);
                    }
                }
                const bool nomax = tab[TB_SCAL + 16 * l + 10] != 0.f;
#pragma unroll 1
                for (int rp = 0; rp < ((PROBE == 14 && l == 0) ? 2 : 1); ++rp)
#pragma unroll 1
                for (int i = 0;; ++i) { const int u = deal_unit(i, 1024, 128, 64, G, wg); if (u < 0) break;
                    const bool lat = u < 1024; const int v = lat ? u : u - 1024;
                    const int qb = lat ? (v & 15) : 0, hq = lat ? ((v >> 4) & 7) : (v & 7), b = lat ? (v >> 7) : (v >> 3), kvh = hq >> 2;
                    const size_t row0 = lat ? (size_t)M_P + (size_t)b * 4096 : (size_t)b * 256;
                    att::KVSrc kv; kv.K1 = PROJ + row0 * NIN + C_GK + 128 * kvh; kv.V1 = PROJ + row0 * NIN + C_GV + 128 * kvh; kv.n1 = lat ? 4096 : 256;
                    kv.K2 = CGK + ((size_t)(b * 2 + l) * 256) * 256 + 128 * kvh; kv.V2 = CGK + 1048576 + ((size_t)(b * 2 + l) * 256) * 256 + 128 * kvh; kv.n2 = lat ? 256 : 0;
                    att::AttnOut ao; ao.Ob = MIX + (row0 + 256 * qb) * DM + 512 + 128 * hq; ao.Of = nullptr; ao.nw = nullptr; ao.lam = 0.f; ao.post = 0.f; ao.pass = 0;
                    __syncthreads();
                    if (nomax) att::attn_body<128, 0, 256, 1>(PROJ + (row0 + 256 * qb) * NIN + C_GQ + 128 * hq, kv, ao, (char*)lds_raw);
                    else att::attn_body<128, 0, 256, 2>(PROJ + (row0 + 256 * qb) * NIN + C_GQ + 128 * hq, kv, ao, (char*)lds_raw);
                }
#pragma unroll 1
                for (int rp = 0; rp < ((PROBE == 15 && l == 0) ? 2 : 1); ++rp)
#pragma unroll 1
                for (int i = 0;; ++i) { const int u = deal_unit(i, 512, 64, 0, G, wg); if (u < 0) break;
                    const bool lat = u < 512; const int v = lat ? u : u - 512;
                    const int pr = lat ? (v & 15) : 0, h = lat ? ((v >> 4) & 3) : (v & 3), b = lat ? (v >> 6) : (v >> 2);
                    const size_t row0 = (lat ? (size_t)M_P + (size_t)b * 4096 : (size_t)b * 256) + 256 * pr;
                    att::RetCArgs a; a.P = PROJ + row0 * NIN; a.qcol = C_RQ + 128 * h; a.kcol = C_RK + 128 * h; a.vcol = C_RV + 128 * h; a.gcol = C_RG + 128 * h;
                    a.lg2f = tab[TB_SCAL + 16 * l + 2 + h]; a.lg2b = tab[TB_SCAL + 16 * l + 6 + h];
                    const int cf = (b * 4 + h) * 2; const bf16* STB = (const bf16*)(ws + WS_ST);
                    a.STf = STB + (lat ? (size_t)cf * 32 * 16384 : (size_t)64 * 32 * 16384 + (size_t)cf * 2 * 16384) + (size_t)(2 * pr) * 16384;
                    a.STb = STB + (lat ? (size_t)(cf + 1) * 32 * 16384 : (size_t)64 * 32 * 16384 + (size_t)(cf + 1) * 2 * 16384) + (size_t)(2 * pr) * 16384;
                    a.gnw = inp[17] + l * 512 + 128 * h; a.O = MIX + row0 * DM + 128 * h;
                    __syncthreads();
                    att::ret_c(a, (char*)lds_raw);
                }
            }
            SEAM(pb + 6);
            if (IN(pb + 7)) { PH_BEGIN; float* X = out + O_X; const bf16* WL = (const bf16*)(ws + WS_W + (size_t)l * W_LAYER);
                const float* mod = (const float*)(ws + WS_TAB) + TB_MOD + (size_t)l * NCOND * NMODC;
                pg8::Gemm g{(const bf16*)(ws + WS_XN), WL + W_WOUT / 2, MTOK, DM, DM}; pg8::StaticOrder S; S.init(MTOK, DM, G, wg);
                const size_t rs_off = WS_RS + (size_t)(3 * l + 2) * MTOK * 8;
                pg8::EpiResidN E{X, X, X, mod + 5 * DM, inp[11] + ((size_t)l * 3 + 2) * DM, mod + 7 * DM, (unsigned long long*)(ws + rs_off), (long)WS_ACT - (long)rs_off, 1.0f, 1, (long)WS_Q - (long)rs_off, (long)WS_Q - (long)rs_off, 0, 1, (long)(WS_CTL + CTL_AMAX + (size_t)(3 * l + 2) * MTOK * 4) - (long)rs_off};
                pg8::gemm_phase<pg8::EpiResidN, pg8::StaticOrder, true, true>(lds, g, S, E); }
            SEAM(pb + 7);
            if (IN(pb + 8)) { PH_BEGIN; float* X = out + O_X;
                (void)X; quant_xs_phase((const bf16*)(ws + WS_ACT), (const unsigned*)(ws + WS_CTL + CTL_AMAX) + (size_t)(3 * l + 2) * MTOK, ws + WS_XNB, (float*)(ws + WS_Q), G, wg, tid); }
            SEAM(pb + 8);
        }
    }
    if (IN(29)) { PH_BEGIN; (void)ws; final_norm(out + O_X, inp[21], G, wg, tid); }
#undef IN
#undef SEAM
#undef PH_BEGIN
}

extern "C" void kernel_launch(void* const* d_in, const int* in_sizes, int n_in, void* d_out, int out_size, void* d_ws, size_t ws_size, hipStream_t stream) {
    static int grid = 0;
    if (grid == 0) {
        if (n_in != 22 || out_size != (int)O_END || ws_size < WS_END) { fprintf(stderr, "kernel_launch: unexpected shapes: n_in %d out %d ws %zu (need %zu)\n", n_in, out_size, ws_size, (size_t)WS_END); grid = -1; return; }
        int dev = 0, cus = 0, per_cu = 0;
        if (hipGetDevice(&dev) != hipSuccess || hipDeviceGetAttribute(&cus, hipDeviceAttributeMultiprocessorCount, dev) != hipSuccess) { grid = -1; return; }
        if (hipFuncSetAttribute((const void*)fwd_kernel, hipFuncAttributeMaxDynamicSharedMemorySize, LDS_BYTES) != hipSuccess) { fprintf(stderr, "kernel_launch: hipFuncSetAttribute failed\n"); grid = -1; return; }
        if (hipOccupancyMaxActiveBlocksPerMultiprocessor(&per_cu, (const void*)fwd_kernel, 512, LDS_BYTES) != hipSuccess || per_cu < 1) { fprintf(stderr, "kernel_launch: occupancy query says %d\n", per_cu); }
        (void)hipGetLastError();
        grid = cus;
    }
    if (grid < 0) return;
    (void)hipMemsetAsync((char*)d_ws + WS_CTL, 0, CTL_ZERO_BYTES, stream);
    (void)hipMemsetAsync((char*)d_ws + WS_RS, 0, 2 * MiB, stream);
    Args a{};
    for (int i = 0; i < 22; ++i) a.in[i] = (const float*)d_in[i];
    a.out = (float*)d_out; a.ws = (unsigned char*)d_ws; a.ph_lo = 0; a.ph_hi = NPHASE; a.pad0 = 0; a.pad1 = 0;
    hipLaunchKernelGGL(fwd_kernel, dim3(grid), dim3(512), LDS_BYTES, stream, a);
}
```

```cpp
#include <hip/hip_runtime.h>
#include <hip/hip_bf16.h>
#include <cstdio>
#include <cstdint>
#ifndef PROBE
#define PROBE 0
#endif
#ifndef FFN_MB
#define FFN_MB 4
#endif
__device__ __forceinline__ float qm(float x) { if (FFN_MB >= 7) return x; unsigned u = __float_as_uint(x); constexpr unsigned sh = 23 - FFN_MB; u = (u + ((1u << (sh - 1)) - 1u) + ((u >> sh) & 1u)) & ~((1u << sh) - 1u); return __uint_as_float(u); }
#ifndef DBGT_CLK
#define DBGT_CLK 0
#endif
#ifndef DBGT_PH
#define DBGT_PH -1
#endif
namespace pg8 {
#define PG8_LAS __attribute__((address_space(3)))
typedef unsigned short bf16_t;
typedef short bf16x8 __attribute__((ext_vector_type(8)));
typedef float f32x4 __attribute__((ext_vector_type(4)));
typedef unsigned u32x4 __attribute__((ext_vector_type(4)));
typedef int i32x4 __attribute__((ext_vector_type(4)));
constexpr int BM = 256, BK = 64, HALF = 128, HTB = HALF * BK * 2  , STAGE_BYTES = 8 * HTB, NXCD = 8, WGM = 4;

__host__ __device__ __forceinline__ int lds_byte(int r, int c) { const int st = (r >> 4) * 2 + (c >> 5), rr = r & 15, cc = c & 31, ob = rr * 64 + cc * 2; return st * 1024 + (ob ^ (((ob >> 9) & 1) << 5)); }
__host__ __device__ __forceinline__ void stage_rc(int b, int& R, int& C) { const int st = b / 1024, sb = b % 1024, swz = sb ^ (((sb >> 9) & 1) << 5); R = (st >> 1) * 16 + swz / 64; C = (st & 1) * 32 + (swz % 64) / 2; }
__host__ __device__ __forceinline__ int perm32(int rho) { const int n = rho >> 4, i = rho & 15; return 8 * (i >> 2) + 4 * n + (i & 3); }

struct Unit { int pm, pn; };
struct Gemm { const bf16_t* A; const bf16_t* Bt; int M, N, K; };

struct StaticOrder {
    int nM, nN, nwg, G, c;
    __host__ __device__ void init(int M, int N, int G_, int c_) { nM = M / BM; nN = N / BM; nwg = nM * nN; G = G_; c = c_; }
    __host__ __device__ bool next(int i, Unit& u) const {
        const long L = (long)i * G + c; if (L >= nwg) return false;
        int wgid = (int)L; { const int q = nwg / NXCD, r = nwg % NXCD, xcd = wgid % NXCD, off = wgid / NXCD; wgid = (xcd < r ? xcd * (q + 1) : r * (q + 1) + (xcd - r) * q) + off; }
        const int nig = WGM * nN, gid = wgid / nig, fm = gid * WGM, gsz = (nM - fm) < WGM ? (nM - fm) : WGM;
        u.pm = fm + ((wgid % nig) % gsz); u.pn = (wgid % nig) / gsz; return true;
    }
    __device__ __forceinline__ void a_ready(const Unit&) const {}
    __device__ __forceinline__ void done(const Unit&) const {}
};

__device__ __forceinline__ unsigned cvt_pk_bf16(float lo, float hi) { unsigned r; asm volatile("v_cvt_pk_bf16_f32 %0, %1, %2" : "=v"(r) : "v"(lo), "v"(hi)); return r; }
typedef float f32x2 __attribute__((ext_vector_type(2)));
struct EpiStoreBf16 {
    static constexpr bool PERM = true, AFTER_DRAIN = false;
    bf16_t* O; int ldc;
    __device__ __forceinline__ void operator()(const f32x4 (&acc)[2][2][4][2], const Unit& u, int wr, int wc, int fr, int fq) const {
        const int row0 = u.pm * BM + wr * 64 + fr, col0 = u.pn * BM + wc * 32 + 8 * fq;
#pragma unroll
        for (int ai = 0; ai < 2; ++ai)
#pragma unroll
            for (int m = 0; m < 4; ++m) { bf16_t* rowp = O + (size_t)(row0 + ai * HALF + m * 16) * ldc + col0;
#pragma unroll
                for (int bj = 0; bj < 2; ++bj) { const f32x4 v0 = acc[ai][bj][m][0], v1 = acc[ai][bj][m][1];
                    u32x4 w; w.x = cvt_pk_bf16(v0[0], v0[1]); w.y = cvt_pk_bf16(v0[2], v0[3]); w.z = cvt_pk_bf16(v1[0], v1[1]); w.w = cvt_pk_bf16(v1[2], v1[3]);
                    *(u32x4*)(rowp + bj * HALF) = w; } }
    }
};
__device__ __forceinline__ float silu_f(float g) { return g * __builtin_amdgcn_rcpf(1.0f + __builtin_amdgcn_exp2f(-1.4426950408889634f * g)); }
struct EpiSwiGLU {
    static constexpr bool PERM = true, AFTER_DRAIN = false;
    bf16_t* O; int ldc;
    __device__ __forceinline__ void operator()(const f32x4 (&acc)[2][2][4][2], const Unit& u, int wr, int wc, int fr, int fq) const {
        const int row0 = u.pm * BM + wr * 64 + fr, col0 = u.pn * HALF + wc * 32 + 8 * fq;
#pragma unroll
        for (int ai = 0; ai < 2; ++ai)
#pragma unroll
            for (int m = 0; m < 4; ++m) { bf16_t* rowp = O + (size_t)(row0 + ai * HALF + m * 16) * ldc + col0;
                const f32x4 g0 = acc[ai][0][m][0], g1 = acc[ai][0][m][1], u0 = acc[ai][1][m][0], u1 = acc[ai][1][m][1];
                u32x4 w; w.x = cvt_pk_bf16(silu_f(g0[0]) * u0[0], silu_f(g0[1]) * u0[1]); w.y = cvt_pk_bf16(silu_f(g0[2]) * u0[2], silu_f(g0[3]) * u0[3]);
                w.z = cvt_pk_bf16(silu_f(g1[0]) * u1[0], silu_f(g1[1]) * u1[1]); w.w = cvt_pk_bf16(silu_f(g1[2]) * u1[2], silu_f(g1[3]) * u1[3]);
                *(u32x4*)rowp = w; }
    }
};
struct EpiResid {
    static constexpr bool PERM = false, AFTER_DRAIN = false;
    const float* baseP; const float* baseS; float* out; const float* gate; float coef;
    __device__ __forceinline__ void operator()(const f32x4 (&acc)[2][2][4][2], const Unit& u, int wr, int wc, int fr, int fq) const {
        const int cond = u.pm < 16 ? 0 : 1 + ((u.pm - 16) >> 4);
        const float* g = gate + (size_t)cond * 18432; const float* base = u.pm < 16 ? baseP : baseS;
        const int row0 = u.pm * BM + wr * 64 + fr, col0 = u.pn * BM + wc * 32 + 4 * fq;
        f32x4 gv[2][2];
#pragma unroll
        for (int bj = 0; bj < 2; ++bj)
#pragma unroll
            for (int n = 0; n < 2; ++n) gv[bj][n] = *(const f32x4*)(g + col0 + bj * HALF + n * 16) * coef;
#pragma unroll
        for (int ai = 0; ai < 2; ++ai)
#pragma unroll
            for (int m = 0; m < 4; ++m) { const size_t off = (size_t)(row0 + ai * HALF + m * 16) * 2048 + col0;
#pragma unroll
                for (int bj = 0; bj < 2; ++bj)
#pragma unroll
                    for (int n = 0; n < 2; ++n) { const f32x4 b = *(const f32x4*)(base + off + bj * HALF + n * 16);
                        *(f32x4*)(out + off + bj * HALF + n * 16) = b + gv[bj][n] * acc[ai][bj][m][n]; }
                if (m == 3) asm volatile("" ::: "memory"); }
    }
};

__device__ __forceinline__ float rstd_of(const unsigned long long* rss, int row) { return rsqrtf((float)rss[row] * (1.0f / 16777216.0f) * (1.0f / 2048.0f) + 1e-6f); }
struct EpiStoreBf16N {
    static constexpr bool PERM = true, AFTER_DRAIN = false;
    bf16_t* O; int ldc; const unsigned long long* rss; const float* bias; int ldb;
    __device__ __forceinline__ void operator()(const f32x4 (&acc)[2][2][4][2], const Unit& u, int wr, int wc, int fr, int fq) const {
        const int cond = u.pm < 16 ? 0 : 1 + ((u.pm - 16) >> 4);
        const int row0 = u.pm * BM + wr * 64 + fr, col0 = u.pn * BM + wc * 32 + 8 * fq;
        const float* b = bias + (size_t)cond * ldb + col0;
        f32x4 bv[2][2];
#pragma unroll
        for (int bj = 0; bj < 2; ++bj)
#pragma unroll
            for (int n = 0; n < 2; ++n) bv[bj][n] = *(const f32x4*)(b + bj * HALF + 4 * n);
#pragma unroll
        for (int ai = 0; ai < 2; ++ai)
#pragma unroll
            for (int m = 0; m < 4; ++m) { const int row = row0 + ai * HALF + m * 16; const float rs = rstd_of(rss, row); bf16_t* rowp = O + (size_t)row * ldc + col0;
#pragma unroll
                for (int bj = 0; bj < 2; ++bj) { const f32x4 v0 = acc[ai][bj][m][0] * rs + bv[bj][0], v1 = acc[ai][bj][m][1] * rs + bv[bj][1];
                    u32x4 w; w.x = cvt_pk_bf16(v0[0], v0[1]); w.y = cvt_pk_bf16(v0[2], v0[3]); w.z = cvt_pk_bf16(v1[0], v1[1]); w.w = cvt_pk_bf16(v1[2], v1[3]);
                    *(u32x4*)(rowp + bj * HALF) = w; } }
    }
};
struct EpiSwiGLUN {
    static constexpr bool PERM = true, AFTER_DRAIN = false;
    bf16_t* O; int ldc; const unsigned long long* rss; const float* bias; int ldb;
    __device__ __forceinline__ void operator()(const f32x4 (&acc)[2][2][4][2], const Unit& u, int wr, int wc, int fr, int fq) const {
        const int cond = u.pm < 16 ? 0 : 1 + ((u.pm - 16) >> 4);
        const int row0 = u.pm * BM + wr * 64 + fr, col0 = u.pn * HALF + wc * 32 + 8 * fq;
        const float* b = bias + (size_t)cond * ldb + u.pn * BM + wc * 32 + 8 * fq;
        const f32x4 bg0 = *(const f32x4*)(b), bg1 = *(const f32x4*)(b + 4), bu0 = *(const f32x4*)(b + HALF), bu1 = *(const f32x4*)(b + HALF + 4);
#pragma unroll
        for (int ai = 0; ai < 2; ++ai)
#pragma unroll
            for (int m = 0; m < 4; ++m) { const int row = row0 + ai * HALF + m * 16; const float rs = rstd_of(rss, row); bf16_t* rowp = O + (size_t)row * ldc + col0;
                const f32x4 g0 = acc[ai][0][m][0] * rs + bg0, g1 = acc[ai][0][m][1] * rs + bg1, u0 = acc[ai][1][m][0] * rs + bu0, u1 = acc[ai][1][m][1] * rs + bu1;
                u32x4 w; w.x = cvt_pk_bf16(qm(silu_f(g0[0]) * u0[0]), qm(silu_f(g0[1]) * u0[1])); w.y = cvt_pk_bf16(qm(silu_f(g0[2]) * u0[2]), qm(silu_f(g0[3]) * u0[3]));
                w.z = cvt_pk_bf16(qm(silu_f(g1[0]) * u1[0]), qm(silu_f(g1[1]) * u1[1])); w.w = cvt_pk_bf16(qm(silu_f(g1[2]) * u1[2]), qm(silu_f(g1[3]) * u1[3]));
                *(u32x4*)rowp = w; }
    }
};
struct EpiStoreQ {
    static constexpr bool PERM = true, AFTER_DRAIN = false;
    bf16_t* O; int ldc; const unsigned long long* rss; const float* sa; const float* sw; const float* bias; int ldb; int pm_off;
    __device__ __forceinline__ void operator()(const f32x4 (&acc)[2][2][4][2], const Unit& u, int wr, int wc, int fr, int fq) const {
        const int pmg = u.pm + pm_off, cond = pmg < 16 ? 0 : 1 + ((pmg - 16) >> 4);
        const int row0 = u.pm * BM + wr * 64 + fr, col0 = u.pn * BM + wc * 32 + 8 * fq;
        const float* b = bias + (size_t)cond * ldb + col0; const float* w = sw + col0;
        f32x4 bv[2][2], wv[2][2];
#pragma unroll
        for (int bj = 0; bj < 2; ++bj)
#pragma unroll
            for (int n = 0; n < 2; ++n) { bv[bj][n] = *(const f32x4*)(b + bj * HALF + 4 * n); wv[bj][n] = *(const f32x4*)(w + bj * HALF + 4 * n); }
#pragma unroll
        for (int ai = 0; ai < 2; ++ai)
#pragma unroll
            for (int m = 0; m < 4; ++m) { const int row = row0 + ai * HALF + m * 16; const float rs = rstd_of(rss, row) * sa[row]; bf16_t* rowp = O + (size_t)row * ldc + col0;
#pragma unroll
                for (int bj = 0; bj < 2; ++bj) { const f32x4 v0 = acc[ai][bj][m][0] * rs * wv[bj][0] + bv[bj][0], v1 = acc[ai][bj][m][1] * rs * wv[bj][1] + bv[bj][1];
                    u32x4 w4; w4.x = cvt_pk_bf16(v0[0], v0[1]); w4.y = cvt_pk_bf16(v0[2], v0[3]); w4.z = cvt_pk_bf16(v1[0], v1[1]); w4.w = cvt_pk_bf16(v1[2], v1[3]);
                    *(u32x4*)(rowp + bj * HALF) = w4; } }
    }
};
__device__ __forceinline__ float sat448(float x) { return __builtin_fminf(__builtin_fmaxf(x, -448.0f), 448.0f); }
__device__ __forceinline__ f32x4 swiglu4(const f32x4 g, const f32x4 u) {
    const f32x4 t = g * -1.4426950408889634f; f32x4 e;
#pragma unroll
    for (int i = 0; i < 4; ++i) e[i] = __builtin_amdgcn_exp2f(t[i]);
    const f32x4 d = e + 1.0f; f32x4 r;
#pragma unroll
    for (int i = 0; i < 4; ++i) r[i] = __builtin_amdgcn_rcpf(d[i]);
    return (g * u) * r;
}
struct EpiSwiGLUQ {
    static constexpr bool PERM = true, AFTER_DRAIN = false;
    unsigned char* O; int ldc; const unsigned long long* rss; const float* sa; const float* sw; const float* bias; int ldb; const float* act_s;
    __device__ __forceinline__ void operator()(const f32x4 (&acc)[2][2][4][2], const Unit& u, int wr, int wc, int fr, int fq) const {
        const int cond = u.pm < 16 ? 0 : 1 + ((u.pm - 16) >> 4);
        const int row0 = u.pm * BM + wr * 64 + fr, col0 = u.pn * HALF + wc * 32 + 8 * fq, bcol = u.pn * BM + wc * 32 + 8 * fq;
        const float* b = bias + (size_t)cond * ldb + bcol; const float* w = sw + bcol;
        const f32x4 bg0 = *(const f32x4*)(b), bg1 = *(const f32x4*)(b + 4), bu0 = *(const f32x4*)(b + HALF), bu1 = *(const f32x4*)(b + HALF + 4);
        const f32x4 wg0 = *(const f32x4*)(w), wg1 = *(const f32x4*)(w + 4), wu0 = *(const f32x4*)(w + HALF), wu1 = *(const f32x4*)(w + HALF + 4);
        const float as = act_s[0];
#pragma unroll
        for (int ai = 0; ai < 2; ++ai)
#pragma unroll
            for (int m = 0; m < 4; ++m) { const int row = row0 + ai * HALF + m * 16; const float rs = rstd_of(rss, row) * sa[row]; unsigned char* rowp = O + (size_t)row * ldc + col0;
                const f32x4 g0 = acc[ai][0][m][0] * rs * wg0 + bg0, g1 = acc[ai][0][m][1] * rs * wg1 + bg1, u0 = (acc[ai][1][m][0] * rs * wu0 + bu0) * as, u1 = (acc[ai][1][m][1] * rs * wu1 + bu1) * as;
                const f32x4 h0 = swiglu4(g0, u0), h1 = swiglu4(g1, u1);
                unsigned w0 = __builtin_amdgcn_cvt_pk_fp8_f32(sat448(h0[0]), sat448(h0[1]), 0, false); w0 = __builtin_amdgcn_cvt_pk_fp8_f32(sat448(h0[2]), sat448(h0[3]), w0, true);
                unsigned w1 = __builtin_amdgcn_cvt_pk_fp8_f32(sat448(h1[0]), sat448(h1[1]), 0, false); w1 = __builtin_amdgcn_cvt_pk_fp8_f32(sat448(h1[2]), sat448(h1[3]), w1, true);
                uint2 wv; wv.x = w0; wv.y = w1; *(uint2*)rowp = wv; }
    }
};
struct EpiResidN {
    static constexpr bool PERM = false, AFTER_DRAIN = false;
    const float* baseP; const float* baseS; float* out; const float* gate; const float* nw; const float* scl; unsigned long long* rss; long xs_delta;   float coef; int do_xs; long sa_delta, sw_delta; int q8; int xs_all = 0; long am_delta = 0;
    __device__ __forceinline__ void operator()(const f32x4 (&acc)[2][2][4][2], const Unit& u, int wr, int wc, int fr, int fq) const {
        const int cond = u.pm < 16 ? 0 : 1 + ((u.pm - 16) >> 4); const int do_xs = (this->do_xs && (xs_all || u.pm < 16)) ? this->do_xs : 0;     bf16_t* xs = (bf16_t*)((char*)rss + xs_delta); const float* sa = (const float*)((char*)rss + sa_delta); const float* swc = (const float*)((char*)rss + sw_delta);
        const float* g = gate + (size_t)cond * 18432; const float* base = u.pm < 16 ? baseP : baseS;
        const int row0 = u.pm * BM + wr * 64 + fr, col0 = u.pn * BM + wc * 32 + 4 * fq;
        f32x4 gv[2][2], av[2][2];
#pragma unroll
        for (int bj = 0; bj < 2; ++bj)
#pragma unroll
            for (int n = 0; n < 2; ++n) { gv[bj][n] = *(const f32x4*)(g + col0 + bj * HALF + n * 16); av[bj][n] = q8 ? *(const f32x4*)(swc + col0 + bj * HALF + n * 16) : (f32x4){1.f, 1.f, 1.f, 1.f}; }
        f32x4 t0[2][2], t1[2][2];
#pragma unroll
        for (int bj = 0; bj < 2; ++bj)
#pragma unroll
            for (int n = 0; n < 2; ++n) { t0[bj][n] = do_xs ? *(const f32x4*)(nw + col0 + bj * HALF + n * 16) : (f32x4){0.f, 0.f, 0.f, 0.f}; t1[bj][n] = do_xs ? *(const f32x4*)(scl + (size_t)cond * 18432 + col0 + bj * HALF + n * 16) : (f32x4){0.f, 0.f, 0.f, 0.f}; }
#pragma unroll
        for (int bj = 0; bj < 2; ++bj)
#pragma unroll
            for (int n = 0; n < 2; ++n) { gv[bj][n] = gv[bj][n] * coef * av[bj][n]; av[bj][n] = t0[bj][n] * (t1[bj][n] + 1.0f); }
#pragma unroll
        for (int ai2 = 0; ai2 < 4; ++ai2) { const int ai = ai2 >> 1, m0 = (ai2 & 1) * 2;
            f32x4 bb[2][2][2];
#pragma unroll
            for (int mm = 0; mm < 2; ++mm)
#pragma unroll
                for (int bj = 0; bj < 2; ++bj)
#pragma unroll
                    for (int n = 0; n < 2; ++n) bb[mm][bj][n] = *(const f32x4*)(base + (size_t)(row0 + ai * HALF + (m0 + mm) * 16) * 2048 + col0 + bj * HALF + n * 16);
#pragma unroll
            for (int mm = 0; mm < 2; ++mm) { const int m = m0 + mm; const int row = row0 + ai * HALF + m * 16; const size_t off = (size_t)row * 2048 + col0; float ss = 0.f, amx = 0.f; const float sr = q8 == 2 ? sa[0] : q8 ? sa[row] : 1.0f;
#pragma unroll
                for (int bj = 0; bj < 2; ++bj)
#pragma unroll
                    for (int n = 0; n < 2; ++n) { const f32x4 b = bb[mm][bj][n]; const f32x4 o = b + gv[bj][n] * (acc[ai][bj][m][n] * sr);
                        *(f32x4*)(out + off + bj * HALF + n * 16) = o;
                        if (do_xs) { f32x4 q = o * av[bj][n]; if (do_xs == 2) { q[0] = qm(q[0]); q[1] = qm(q[1]); q[2] = qm(q[2]); q[3] = qm(q[3]); } ss += (o[0] * o[0] + o[1] * o[1]) + (o[2] * o[2] + o[3] * o[3]); amx = fmaxf(fmaxf(amx, fmaxf(fabsf(q[0]), fabsf(q[1]))), fmaxf(fabsf(q[2]), fabsf(q[3])));
                            uint2 w2; w2.x = cvt_pk_bf16(q[0], q[1]); w2.y = cvt_pk_bf16(q[2], q[3]); *(uint2*)(xs + off + bj * HALF + n * 16) = w2; } }
                if (do_xs) { ss += __shfl_xor(ss, 16); ss += __shfl_xor(ss, 32); if (fq == 0) atomicAdd(rss + row, (unsigned long long)(ss * 16777216.0f));
                    if (xs_all) { amx = fmaxf(amx, __shfl_xor(amx, 16)); amx = fmaxf(amx, __shfl_xor(amx, 32)); if (fq == 0) atomicMax((unsigned*)((char*)rss + am_delta) + row, __float_as_uint(amx)); } }
                if (mm == 1) asm volatile("" ::: "memory"); } }
    }
};
typedef int i32x8 __attribute__((ext_vector_type(8)));
__device__ __forceinline__ void mfma_f8_128(f32x4& c, const i32x8 a, const i32x8 b) { asm volatile("v_mfma_f32_16x16x128_f8f6f4 %0, %1, %2, %0" : "+v"(c) : "v"(a), "v"(b)); }
template <class Epi, class Sched, bool ALIGN_EPI = false, bool SP2 = false, int I8 = 0>
__device__ __forceinline__ void gemm_phase(PG8_LAS unsigned char* lds, const Gemm g, const Sched& S, const Epi& E) {
    int tid_ = threadIdx.x; asm volatile("" : "+v"(tid_));
    const int tid = tid_, wid = __builtin_amdgcn_readfirstlane(tid >> 6), lane = tid & 63, wr = wid >> 2, wc = wid & 3, fr = lane & 15, fq = lane >> 4;
    const int K = g.K, nt = K / BK;
    unsigned voffA[2], voffB[2];
#pragma unroll
    for (int i = 0; i < 2; ++i) { int R, C; stage_rc(tid * 16 + i * 8192, R, C); const int Rb = Epi::PERM ? ((R & ~31) + perm32(R & 31)) : R;
        voffA[i] = (unsigned)(R * K + C) * 2u; voffB[i] = (unsigned)(Rb * BK + C) * 2u; }
    const size_t kstep = (size_t)(BK * 2);
    const size_t hstep = (size_t)HALF * K * 2;
    const size_t tstep = 2 * hstep;
    const size_t kstepB = (size_t)BM * BK * 2, hstepB = (size_t)HALF * BK * 2;
    const unsigned ldsw = (unsigned)wid * 1024u;
    const int aoff = lds_byte(wr * 64 + fr, fq * 8), boff = lds_byte(wc * 32 + fr, fq * 8);
#define PG8_SA(b, h) (((b) * 2 + (h)) * HTB)
#define PG8_SB(b, h) ((4 + (b) * 2 + (h)) * HTB)
#define PG8_STAGE(bufoff, gbase, voff) do { _Pragma("unroll") for (int _i = 0; _i < 2; ++_i) \
        __builtin_amdgcn_global_load_lds((const unsigned*)((const char*)(gbase) + (voff)[_i]), (PG8_LAS unsigned*)(lds + (bufoff) + ldsw + _i * 8192), 16, 0, 0); } while (0)
#define PG8_LDA(dst, b, h) do { _Pragma("unroll") for (int m = 0; m < 4; ++m) _Pragma("unroll") for (int k = 0; k < 2; ++k) dst[m][k] = *(const PG8_LAS bf16x8*)(lds + PG8_SA(b, h) + aoff + m * 2048 + k * 1024); } while (0)
#define PG8_LDB(dst, b, h) do { _Pragma("unroll") for (int n = 0; n < 2; ++n) _Pragma("unroll") for (int k = 0; k < 2; ++k) dst[n][k] = *(const PG8_LAS bf16x8*)(lds + PG8_SB(b, h) + boff + n * 2048 + k * 1024); } while (0)
#define PG8_MMA(ai, bj, At, Bt) do { __builtin_amdgcn_s_setprio(1); _Pragma("unroll") for (int m = 0; m < 4; ++m) _Pragma("unroll") for (int n = 0; n < 2; ++n) { if constexpr (I8 == 2) { \
        mfma_f8_128(acc[ai][bj][m][n], __builtin_shufflevector(__builtin_bit_cast(i32x4, Bt[n][0]), __builtin_bit_cast(i32x4, Bt[n][1]), 0, 1, 2, 3, 4, 5, 6, 7), \
            __builtin_shufflevector(__builtin_bit_cast(i32x4, At[m][0]), __builtin_bit_cast(i32x4, At[m][1]), 0, 1, 2, 3, 4, 5, 6, 7)); } else _Pragma("unroll") for (int k = 0; k < 2; ++k) { \
        if constexpr (I8 == 1) acc[ai][bj][m][n] = __builtin_bit_cast(f32x4, __builtin_amdgcn_mfma_i32_16x16x64_i8(__builtin_bit_cast(i32x4, Bt[n][k]), __builtin_bit_cast(i32x4, At[m][k]), __builtin_bit_cast(i32x4, acc[ai][bj][m][n]), 0, 0, 0)); \
        else acc[ai][bj][m][n] = __builtin_amdgcn_mfma_f32_16x16x32_bf16(Bt[n][k], At[m][k], acc[ai][bj][m][n], 0, 0, 0); } } __builtin_amdgcn_s_setprio(0); } while (0)
#define PG8_WAIT_V(n) asm volatile("s_waitcnt vmcnt(" #n ")" ::: "memory")
#define PG8_WAIT_L(n) asm volatile("s_waitcnt lgkmcnt(" #n ")" ::: "memory")
#define PG8_BAR __builtin_amdgcn_s_barrier()
#define PG8_SCHED __builtin_amdgcn_sched_barrier(0)
    Unit cur, nxt; int ui = 0;
    if (!S.next(0, cur)) return;
    f32x4 acc[2][2][4][2];
#pragma unroll
    for (int a = 0; a < 2; ++a)
#pragma unroll
        for (int b = 0; b < 2; ++b)
#pragma unroll
            for (int m = 0; m < 4; ++m)
#pragma unroll
                for (int n = 0; n < 2; ++n) acc[a][b][m][n] = (f32x4){0.f, 0.f, 0.f, 0.f};
    bf16x8 At[4][2], B0[2][2], B1[2][2];
    const char* cA = (const char*)g.A + (size_t)cur.pm * tstep; const char* cB = (const char*)g.Bt + (size_t)cur.pn * tstep;
    S.a_ready(cur);
    if constexpr (SP2) {
        PG8_STAGE(PG8_SB(0, 0), cB, voffB); PG8_STAGE(PG8_SB(0, 1), cB + hstepB, voffB); PG8_STAGE(PG8_SA(0, 0), cA, voffA); PG8_STAGE(PG8_SA(0, 1), cA + hstep, voffA);
        if (wr == 1) PG8_BAR;
        PG8_WAIT_V(2); PG8_BAR;
        PG8_STAGE(PG8_SB(1, 0), cB + kstepB, voffB); PG8_STAGE(PG8_SA(1, 0), cA + kstep, voffA); PG8_STAGE(PG8_SB(1, 1), cB + hstepB + kstepB, voffB);
        PG8_WAIT_V(6); PG8_BAR;
    } else {
        PG8_STAGE(PG8_SB(0, 0), cB, voffB); PG8_STAGE(PG8_SA(0, 0), cA, voffA); PG8_STAGE(PG8_SB(0, 1), cB + hstepB, voffB); PG8_STAGE(PG8_SA(0, 1), cA + hstep, voffA);
        if (wr == 1) PG8_BAR;
        PG8_WAIT_V(4); PG8_BAR;
        PG8_STAGE(PG8_SB(1, 0), cB + kstepB, voffB); PG8_STAGE(PG8_SA(1, 0), cA + kstep, voffA); PG8_STAGE(PG8_SB(1, 1), cB + hstepB + kstepB, voffB);
        PG8_WAIT_V(6); PG8_BAR;
    }
    for (;;) {
        const bool has_next = S.next(ui + 1, nxt);
        const char* nA = has_next ? (const char*)g.A + (size_t)nxt.pm * tstep : cA; const char* nB = has_next ? (const char*)g.Bt + (size_t)nxt.pn * tstep : cB;
        for (int t = 0; t < nt; t += 2) {
            const bool last = (t == nt - 2);
            const char* a1 = cA + (size_t)(t + 1) * kstep;
            const char* a2 = last ? nA : cA + (size_t)(t + 2) * kstep; const char* b2 = last ? nB : cB + (size_t)(t + 2) * kstepB;
            const char* a3 = a2 + kstep; const char* b3 = b2 + kstepB;
            if (last && has_next) S.a_ready(nxt);
            if constexpr (SP2) {
            PG8_LDB(B0, 0, 0); PG8_LDB(B1, 0, 1); PG8_SCHED; PG8_LDA(At, 0, 0); PG8_STAGE(PG8_SA(1, 1), a1 + hstep, voffA);
            PG8_WAIT_V(8); PG8_WAIT_L(0); PG8_BAR; PG8_MMA(0, 0, At, B0); PG8_MMA(0, 1, At, B1); PG8_BAR; PG8_SCHED;
            PG8_LDA(At, 0, 1); PG8_STAGE(PG8_SB(0, 0), b2, voffB); PG8_STAGE(PG8_SB(0, 1), b2 + hstepB, voffB); PG8_STAGE(PG8_SA(0, 0), a2, voffA);
            PG8_WAIT_V(8); PG8_WAIT_L(0); PG8_BAR; PG8_MMA(1, 0, At, B0); PG8_MMA(1, 1, At, B1); PG8_BAR; PG8_SCHED;
            PG8_LDB(B0, 1, 0); PG8_LDB(B1, 1, 1); PG8_SCHED; PG8_LDA(At, 1, 0); PG8_STAGE(PG8_SA(0, 1), a2 + hstep, voffA);
            PG8_WAIT_V(8); PG8_WAIT_L(0); PG8_BAR; PG8_MMA(0, 0, At, B0); PG8_MMA(0, 1, At, B1); PG8_BAR; PG8_SCHED;
            PG8_LDA(At, 1, 1); PG8_STAGE(PG8_SB(1, 0), b3, voffB); PG8_STAGE(PG8_SB(1, 1), b3 + hstepB, voffB); PG8_STAGE(PG8_SA(1, 0), a3, voffA);
            PG8_WAIT_V(8); PG8_WAIT_L(0); PG8_BAR; PG8_MMA(1, 0, At, B0); PG8_MMA(1, 1, At, B1); PG8_BAR; PG8_SCHED;
            } else {
            PG8_LDB(B0, 0, 0); PG8_SCHED; PG8_LDA(At, 0, 0); PG8_STAGE(PG8_SA(1, 1), a1 + hstep, voffA);
            PG8_WAIT_L(8); PG8_BAR; PG8_WAIT_L(0); PG8_MMA(0, 0, At, B0); PG8_BAR; PG8_SCHED;
            PG8_LDB(B1, 0, 1); PG8_STAGE(PG8_SB(0, 0), b2, voffB);
            PG8_BAR; PG8_WAIT_L(0); PG8_MMA(0, 1, At, B1); PG8_BAR;
            PG8_LDA(At, 0, 1); PG8_STAGE(PG8_SA(0, 0), a2, voffA);
            PG8_BAR; PG8_WAIT_L(0); PG8_MMA(1, 0, At, B0); PG8_BAR; PG8_SCHED;
            PG8_STAGE(PG8_SB(0, 1), b2 + hstepB, voffB);
            PG8_WAIT_V(6); PG8_BAR; PG8_MMA(1, 1, At, B1); PG8_BAR;
            PG8_LDB(B0, 1, 0); PG8_SCHED; PG8_LDA(At, 1, 0); PG8_STAGE(PG8_SA(0, 1), a2 + hstep, voffA);
            PG8_WAIT_L(8); PG8_BAR; PG8_WAIT_L(0); PG8_MMA(0, 0, At, B0); PG8_BAR; PG8_SCHED;
            PG8_LDB(B1, 1, 1); PG8_STAGE(PG8_SB(1, 0), b3, voffB);
            PG8_BAR; PG8_WAIT_L(0); PG8_MMA(0, 1, At, B1); PG8_BAR;
            PG8_LDA(At, 1, 1); PG8_STAGE(PG8_SA(1, 0), a3, voffA);
            PG8_BAR; PG8_WAIT_L(0); PG8_MMA(1, 0, At, B0); PG8_BAR; PG8_SCHED;
            PG8_STAGE(PG8_SB(1, 1), b3 + hstepB, voffB);
            PG8_WAIT_V(6); PG8_BAR; PG8_MMA(1, 1, At, B1); PG8_BAR;
            }
        }
        if constexpr (ALIGN_EPI) { if (wr == 0) PG8_BAR; }
        if constexpr (I8 == 2) asm volatile("s_nop 15\n\ts_nop 15" ::: "memory");
        if constexpr (I8 == 1) { _Pragma("unroll") for (int a = 0; a < 2; ++a) _Pragma("unroll") for (int b = 0; b < 2; ++b) _Pragma("unroll") for (int m = 0; m < 4; ++m) _Pragma("unroll") for (int n = 0; n < 2; ++n) acc[a][b][m][n] = __builtin_convertvector(__builtin_bit_cast(i32x4, acc[a][b][m][n]), f32x4); }
        if constexpr (!Epi::AFTER_DRAIN) { E(acc, cur, wr, wc, fr, fq); S.done(cur); }
        if (!has_next) break;
#pragma unroll
        for (int a = 0; a < 2; ++a)
#pragma unroll
            for (int b = 0; b < 2; ++b)
#pragma unroll
                for (int m = 0; m < 4; ++m)
#pragma unroll
                    for (int n = 0; n < 2; ++n) acc[a][b][m][n] = (f32x4){0.f, 0.f, 0.f, 0.f};
        cur = nxt; cA = nA; cB = nB; ++ui;
        if constexpr (ALIGN_EPI) { if (wr == 1) PG8_BAR; }
    }
    PG8_WAIT_V(0);
    if constexpr (!ALIGN_EPI) { if (wr == 0) PG8_BAR; }
    PG8_BAR;
    if constexpr (Epi::AFTER_DRAIN) { E.fused(acc, cur, wr, wc, fr, fq, lds, wid, lane); S.done(cur); }
#undef PG8_SA
#undef PG8_SB
#undef PG8_STAGE
#undef PG8_LDA
#undef PG8_LDB
#undef PG8_MMA
#undef PG8_WAIT_V
#undef PG8_WAIT_L
#undef PG8_BAR
#undef PG8_SCHED
}
}
namespace att {
using bf16x8 = __attribute__((ext_vector_type(8))) short;
using s16x4  = __attribute__((ext_vector_type(4))) short;
using f32x16 = __attribute__((ext_vector_type(16))) float;
using u32x4  = __attribute__((ext_vector_type(4))) unsigned;
typedef unsigned short bf16_t;
constexpr int NW = 8, QBLK = 32, KVBLK = 64;
constexpr float THR = 8.f;
constexpr int SHM_V = 64 * 128 * 2, SHM_K = 64 * 128 * 2, SHM_ATTN = 2 * SHM_V + 2 * SHM_K + NW * 64 * 4;
#define KSWZ(row, colB) ((row) * 256 + ((colB) ^ (((row) & 7) << 4)))
#define KSWZ64(row, colB) ((row) * 128 + ((colB) ^ ((((row) >> 1) & 7) << 4)))
#define SBAR() __builtin_amdgcn_sched_barrier(0)
__device__ __forceinline__ int crow(int r, int hi) { return (r & 3) + 8 * (r >> 2) + 4 * hi; }
__device__ __forceinline__ unsigned cvtpk(float lo, float hi) { unsigned r; asm volatile("v_cvt_pk_bf16_f32 %0, %1, %2" : "=v"(r) : "v"(lo), "v"(hi)); return r; }
__device__ __forceinline__ float bf2f(unsigned short b) { return __uint_as_float((unsigned)b << 16); }
__device__ __forceinline__ bf16x8 ld8(const bf16_t* p) { return *reinterpret_cast<const bf16x8*>(p); }

template <int DQK, bool PRE = false> __device__ __forceinline__ void partialSM(f32x16& p0, f32x16& p1, float& m_reg, float& mn, float& alpha) {
  constexpr float SCALE = PRE ? 0.6931471805599453f : ((DQK == 128) ? 0.088388347648318440f : 0.125f);
  constexpr float C = SCALE * 1.4426950408889634f;
  float pmax = p0[0];
#pragma unroll
  for (int r = 1; r < 16; ++r) pmax = fmaxf(pmax, p0[r]);
#pragma unroll
  for (int r = 0; r < 16; ++r) pmax = fmaxf(pmax, p1[r]);
  { auto rr = __builtin_amdgcn_permlane32_swap(__float_as_uint(pmax), __float_as_uint(pmax), false, false);
    pmax = fmaxf(__uint_as_float(rr[0]), __uint_as_float(rr[1])); }
  if (__builtin_expect(__all(pmax - m_reg <= THR / SCALE), 1)) { mn = m_reg; alpha = 1.f; }
  else { mn = fmaxf(m_reg, pmax); alpha = __builtin_amdgcn_exp2f((m_reg - mn) * C); m_reg = mn; }
  float mnC = -mn * C;
#pragma unroll
  for (int r = 0; r < 16; ++r) p0[r] = fmaf(p0[r], C, mnC);
#pragma unroll
  for (int r = 0; r < 16; ++r) p1[r] = fmaf(p1[r], C, mnC);
#pragma unroll
  for (int r = 0; r < 16; ++r) p0[r] = __builtin_amdgcn_exp2f(p0[r]);
}
#define PK4(P, BASE, OUT) do { unsigned a0 = cvtpk(P[BASE + 0], P[BASE + 1]), a1 = cvtpk(P[BASE + 2], P[BASE + 3]);   \
    unsigned b0 = cvtpk(P[BASE + 4], P[BASE + 5]), b1 = cvtpk(P[BASE + 6], P[BASE + 7]);                              \
    auto r0 = __builtin_amdgcn_permlane32_swap(a0, b0, false, false); auto r1 = __builtin_amdgcn_permlane32_swap(a1, b1, false, false); \
    u32x4 w = {r0[0], r1[0], r0[1], r1[1]}; OUT = *reinterpret_cast<bf16x8*>(&w); } while (0)
__device__ __forceinline__ void finishSM(f32x16& p0, f32x16& p1, float alpha, float& l_reg, bf16x8& pa0, bf16x8& pa1, bf16x8& pa2, bf16x8& pa3) {
#pragma unroll
  for (int r = 0; r < 16; ++r) p1[r] = __builtin_amdgcn_exp2f(p1[r]);
  float ps = 0;
#pragma unroll
  for (int r = 0; r < 16; ++r) ps += p0[r];
#pragma unroll
  for (int r = 0; r < 16; ++r) ps += p1[r];
  { auto rr = __builtin_amdgcn_permlane32_swap(__float_as_uint(ps), __float_as_uint(ps), false, false);
    ps = __uint_as_float(rr[0]) + __uint_as_float(rr[1]); }
  l_reg = l_reg * alpha + ps;
  PK4(p0, 0, pa0); PK4(p0, 8, pa1); PK4(p1, 0, pa2); PK4(p1, 8, pa3);
}
template <int DQK> __device__ __forceinline__ void qkt(f32x16& p0, f32x16& p1, const char* Ks, const bf16x8* qr, int r32, int hi) {
  constexpr int ND = DQK / 16;
  p0 = f32x16{}; p1 = f32x16{};
  bf16x8 b0[2], b1[2];
#define QK_RD(d0, s) do { const int cb_ = ((d0) * 16 + hi * 8) * 2; \
    if constexpr (DQK == 128) { b0[s] = *reinterpret_cast<const bf16x8*>(Ks + KSWZ(r32, cb_)); b1[s] = *reinterpret_cast<const bf16x8*>(Ks + KSWZ(32 + r32, cb_)); } \
    else { b0[s] = *reinterpret_cast<const bf16x8*>(Ks + KSWZ64(r32, cb_)); b1[s] = *reinterpret_cast<const bf16x8*>(Ks + KSWZ64(32 + r32, cb_)); } } while (0)
  QK_RD(0, 0); QK_RD(1, 1); SBAR();
#pragma unroll
  for (int d0 = 0; d0 < ND; ++d0) {
    p0 = __builtin_amdgcn_mfma_f32_32x32x16_bf16(b0[d0 & 1], qr[d0], p0, 0, 0, 0);
    p1 = __builtin_amdgcn_mfma_f32_32x32x16_bf16(b1[d0 & 1], qr[d0], p1, 0, 0, 0);
    if (d0 + 2 < ND) { QK_RD(d0 + 2, d0 & 1); }
    SBAR();
  }
#undef QK_RD
}
__device__ __forceinline__ int v_st(int k, int c) { const int kk = (k & ~0xC) | ((k & 4) << 1) | ((k & 8) >> 1); return ((kk >> 3) * 4 + (c >> 5)) * 512 + ((kk & 7) * 32 + (c & 31)) * 2; }
__device__ __forceinline__ int v_rd_base(int lane) { return ((lane & 3) << 3) | (((lane >> 2) & 3) << 6) | (((lane >> 4) & 1) << 5) | (((lane >> 5) & 1) << 8); }
constexpr int v_rd_off(int d0, int ks, int half) { return d0 * 512 + ks * 4096 + half * 2048; }
template <int OFF> __device__ __forceinline__ s16x4 tr_read(int vb) {
  s16x4 r; asm volatile("ds_read_b64_tr_b16 %0, %1 offset:%2" : "=&v"(r) : "v"(vb), "i"(OFF) : "memory"); return r;
}
#define PKF(L, H) (bf16x8){L[0], L[1], L[2], L[3], H[0], H[1], H[2], H[3]}
template <int D0> __device__ __forceinline__ void pv_one(f32x16& od, int vb, bf16x8 pa0, bf16x8 pa1, bf16x8 pa2, bf16x8 pa3) {
  const s16x4 l0 = tr_read<v_rd_off(D0, 0, 0)>(vb), h0 = tr_read<v_rd_off(D0, 0, 1)>(vb), l1 = tr_read<v_rd_off(D0, 1, 0)>(vb), h1 = tr_read<v_rd_off(D0, 1, 1)>(vb);
  const s16x4 l2 = tr_read<v_rd_off(D0, 2, 0)>(vb), h2 = tr_read<v_rd_off(D0, 2, 1)>(vb), l3 = tr_read<v_rd_off(D0, 3, 0)>(vb), h3 = tr_read<v_rd_off(D0, 3, 1)>(vb);
  asm volatile("s_waitcnt lgkmcnt(0)" ::: "memory"); SBAR();
  od = __builtin_amdgcn_mfma_f32_32x32x16_bf16(pa0, PKF(l0, h0), od, 0, 0, 0);
  od = __builtin_amdgcn_mfma_f32_32x32x16_bf16(pa1, PKF(l1, h1), od, 0, 0, 0);
  od = __builtin_amdgcn_mfma_f32_32x32x16_bf16(pa2, PKF(l2, h2), od, 0, 0, 0);
  od = __builtin_amdgcn_mfma_f32_32x32x16_bf16(pa3, PKF(l3, h3), od, 0, 0, 0);
}
#define PV_RD(D0, L, H) do { L[0] = tr_read<v_rd_off(D0, 0, 0)>(vb); H[0] = tr_read<v_rd_off(D0, 0, 1)>(vb); L[1] = tr_read<v_rd_off(D0, 1, 0)>(vb); H[1] = tr_read<v_rd_off(D0, 1, 1)>(vb); \
    L[2] = tr_read<v_rd_off(D0, 2, 0)>(vb); H[2] = tr_read<v_rd_off(D0, 2, 1)>(vb); L[3] = tr_read<v_rd_off(D0, 3, 0)>(vb); H[3] = tr_read<v_rd_off(D0, 3, 1)>(vb); } while (0)
#define PV_MM(OD, L, H) do { OD = __builtin_amdgcn_mfma_f32_32x32x16_bf16(pa0, PKF(L[0], H[0]), OD, 0, 0, 0); OD = __builtin_amdgcn_mfma_f32_32x32x16_bf16(pa1, PKF(L[1], H[1]), OD, 0, 0, 0); \
    OD = __builtin_amdgcn_mfma_f32_32x32x16_bf16(pa2, PKF(L[2], H[2]), OD, 0, 0, 0); OD = __builtin_amdgcn_mfma_f32_32x32x16_bf16(pa3, PKF(L[3], H[3]), OD, 0, 0, 0); } while (0)
__device__ __forceinline__ void pv_d0(f32x16* o, int vb, bf16x8 pa0, bf16x8 pa1, bf16x8 pa2, bf16x8 pa3) {
  s16x4 la[4], ha[4], lb[4], hb[4];
  PV_RD(0, la, ha); PV_RD(1, lb, hb);
  asm volatile("s_waitcnt lgkmcnt(8)" ::: "memory"); SBAR(); PV_MM(o[0], la, ha); SBAR();
  PV_RD(2, la, ha);
  asm volatile("s_waitcnt lgkmcnt(8)" ::: "memory"); SBAR(); PV_MM(o[1], lb, hb); SBAR();
  PV_RD(3, lb, hb);
  asm volatile("s_waitcnt lgkmcnt(8)" ::: "memory"); SBAR(); PV_MM(o[2], la, ha); SBAR();
  asm volatile("s_waitcnt lgkmcnt(0)" ::: "memory"); SBAR(); PV_MM(o[3], lb, hb);
}
#undef PV_RD
#undef PV_MM
__device__ __forceinline__ float half_sum32(float x) {
  x += __shfl_xor(x, 1); x += __shfl_xor(x, 2); x += __shfl_xor(x, 4); x += __shfl_xor(x, 8); x += __shfl_xor(x, 16); return x;
}

struct KVSrc { const bf16_t* K1; const bf16_t* V1; int n1; const bf16_t* K2; const bf16_t* V2; int n2; };
struct AttnOut { bf16_t* Ob; float* Of; const float* nw; float lam, post; int pass; };
template <int DQK, int MODE, int LD2, int SM = 0>
__device__ __forceinline__ void attn_body(const bf16_t* __restrict__ Qb, const KVSrc kv, const AttnOut ao, char* lds) {
  constexpr long ldq = 5120, LD1 = 5120; constexpr int LDO = 2048, LDF = 512;
  int tid_ = threadIdx.x; asm volatile("" : "+v"(tid_));
  const int tid = tid_, wid = tid >> 6, lane = tid & 63, r32 = lane & 31, hi = lane >> 5;
  char* V_lds = lds; char* K_lds = lds + 2 * SHM_V;
  float* ws = (float*)(lds + 2 * SHM_V + 2 * SHM_K) + wid * 64; float* li_l = ws; float* al_l = ws + 32;
  float m_reg = -1e30f, l_reg = 0; f32x16 o[4] = {}; bf16x8 qr[DQK / 16];
  const bf16_t* Qw = Qb + (long)(wid * QBLK + r32) * ldq + hi * 8;
#pragma unroll
  for (int d0 = 0; d0 < DQK / 16; ++d0) qr[d0] = ld8(Qw + d0 * 16);
  const int sr = tid >> 4, sc = (tid & 15) * 8, vst0 = v_st(sr, sc), vst1 = v_st(32 + sr, sc);
  const int kr64 = tid >> 3, kc64 = (tid & 7) * 8;
  const int vb0 = (int)(uintptr_t)V_lds + v_rd_base(lane);
  struct { bf16x8 vs0, vs1, ks0, ks1; } sr_[2];
#define SLOAD(i, k0) do { const int k0_ = (k0); const bool s1_ = k0_ < kv.n1; const bf16_t* kp_ = s1_ ? kv.K1 + (long)k0_ * LD1 : kv.K2 + (long)(k0_ - kv.n1) * LD2; \
    const bf16_t* vp_ = s1_ ? kv.V1 + (long)k0_ * LD1 : kv.V2 + (long)(k0_ - kv.n1) * LD2; const long ld_ = s1_ ? LD1 : (long)LD2; \
    sr_[i].vs0 = ld8(vp_ + (long)sr * ld_ + sc); sr_[i].vs1 = ld8(vp_ + (long)(32 + sr) * ld_ + sc); \
    if constexpr (DQK == 128) { sr_[i].ks0 = ld8(kp_ + (long)sr * ld_ + sc); sr_[i].ks1 = ld8(kp_ + (long)(32 + sr) * ld_ + sc); } \
    else { sr_[i].ks0 = ld8(kp_ + (long)kr64 * ld_ + kc64); } } while (0)
#define SWRITE(b, i) do { *(bf16x8*)(V_lds + (b) * SHM_V + vst0) = sr_[i].vs0; *(bf16x8*)(V_lds + (b) * SHM_V + vst1) = sr_[i].vs1; \
    if constexpr (DQK == 128) { const int kc = sc * 2; *(bf16x8*)(K_lds + (b) * SHM_K + KSWZ(sr, kc)) = sr_[i].ks0; *(bf16x8*)(K_lds + (b) * SHM_K + KSWZ(32 + sr, kc)) = sr_[i].ks1; } \
    else { *(bf16x8*)(K_lds + (b) * SHM_K + KSWZ64(kr64, kc64 * 2)) = sr_[i].ks0; } } while (0)
#define SWAIT() do { if constexpr (DQK == 128) asm volatile("s_waitcnt vmcnt(4)" ::: "memory"); else asm volatile("s_waitcnt vmcnt(3)" ::: "memory"); } while (0)
#define RESC(a) do { if (SM != 1 && __any((a) < 1.f)) { if (hi == 0) al_l[r32] = (a); asm volatile("s_waitcnt lgkmcnt(0)" ::: "memory"); \
    _Pragma("unroll") for (int d = 0; d < 4; ++d) _Pragma("unroll") for (int r = 0; r < 16; ++r) o[d][r] *= al_l[crow(r, hi)]; } } while (0)
  f32x16 pA0, pA1, pB0, pB1; float mnA = 0.f, mnB = 0.f, alA = 1.f, alB = 1.f; bf16x8 pa0, pa1, pa2, pa3; const int NT = (kv.n1 + kv.n2) / KVBLK; (void)mnA; (void)mnB;
#define PSM(P0, P1, MN, AL) do { if constexpr (SM == 1) { _Pragma("unroll") for (int r_ = 0; r_ < 16; ++r_) P0[r_] = __builtin_amdgcn_exp2f(P0[r_]); } else partialSM<DQK, SM == 2>(P0, P1, m_reg, MN, AL); } while (0)
  constexpr int SE = 0, SO = 1;
  SLOAD(SE, 0); SLOAD(SO, KVBLK); SWAIT(); SWRITE(0, SE); __syncthreads();
  qkt<DQK>(pA0, pA1, K_lds, qr, r32, hi); PSM(pA0, pA1, mnA, alA);
  if (2 < NT) SLOAD(SE, 2 * KVBLK);
  SWAIT(); SWRITE(1, SO); __syncthreads();
  for (int j = 1; j + 1 < NT; j += 2) {
    SBAR(); qkt<DQK>(pB0, pB1, K_lds + SHM_K, qr, r32, hi);
    finishSM(pA0, pA1, alA, l_reg, pa0, pa1, pa2, pa3); SBAR();
    SLOAD(SO, (j + 2) * KVBLK); SBAR();
    pv_d0(o, vb0, pa0, pa1, pa2, pa3); PSM(pB0, pB1, mnB, alB);
    __syncthreads(); SWAIT(); SWRITE(0, SE);
    RESC(alB); __syncthreads();
    SBAR(); qkt<DQK>(pA0, pA1, K_lds, qr, r32, hi);
    finishSM(pB0, pB1, alB, l_reg, pa0, pa1, pa2, pa3); SBAR();
    if (j + 3 < NT) SLOAD(SE, (j + 3) * KVBLK); SBAR();
    pv_d0(o, vb0 + (int)SHM_V, pa0, pa1, pa2, pa3); PSM(pA0, pA1, mnA, alA);
    __syncthreads(); SWAIT(); SWRITE(1, SO);
    RESC(alA); __syncthreads();
  }
  SBAR(); qkt<DQK>(pB0, pB1, K_lds + SHM_K, qr, r32, hi);
  finishSM(pA0, pA1, alA, l_reg, pa0, pa1, pa2, pa3); SBAR();
  pv_d0(o, vb0, pa0, pa1, pa2, pa3); PSM(pB0, pB1, mnB, alB);
  __syncthreads(); RESC(alB);
  finishSM(pB0, pB1, alB, l_reg, pa0, pa1, pa2, pa3); SBAR();
  pv_d0(o, vb0 + (int)SHM_V, pa0, pa1, pa2, pa3);
  if (hi == 0) li_l[r32] = l_reg; asm volatile("s_waitcnt lgkmcnt(0)" ::: "memory");
  float rli[16];
#pragma unroll
  for (int r = 0; r < 16; ++r) rli[r] = __builtin_amdgcn_rcpf(li_l[crow(r, hi)]);
  bf16_t* stg = (bf16_t*)lds + wid * (QBLK * 128);
#define O_FLUSH(Ow) do { asm volatile("s_waitcnt lgkmcnt(0)" ::: "memory"); _Pragma("unroll") for (int i_ = 0; i_ < 8; ++i_) { const int row_ = i_ * 4 + (lane >> 4), ch_ = lane & 15; \
    const u32x4 v_ = *(const u32x4*)(stg + row_ * 128 + ch_ * 8); *(u32x4*)((Ow) + (long)row_ * LDO + ch_ * 8) = v_; } } while (0)
  if constexpr (MODE == 0) {
    bf16_t* Ow = ao.Ob + (long)(wid * QBLK) * LDO;
    __syncthreads();
#pragma unroll
    for (int r = 0; r < 16; ++r) { const int orow = crow(r, hi);
#pragma unroll
      for (int d0 = 0; d0 < 4; ++d0) { const float v = o[d0][r] * rli[r]; stg[orow * 128 + d0 * 32 + r32] = (bf16_t)(cvtpk(v, v) & 0xffffu); } }
    O_FLUSH(Ow);
  } else {
    float* Fw = ao.Of + (long)(wid * QBLK) * LDF;
    if (ao.pass == 0) {
#pragma unroll
      for (int r = 0; r < 16; ++r) { const int orow = crow(r, hi);
#pragma unroll
        for (int d0 = 0; d0 < 4; ++d0) Fw[(long)orow * LDF + d0 * 32 + r32] = o[d0][r] * rli[r]; }
    } else {
      bf16_t* Ow = ao.Ob + (long)(wid * QBLK) * LDO;
      __syncthreads();
#pragma unroll
      for (int r = 0; r < 16; ++r) { const int orow = crow(r, hi); float v[4]; float ss = 0.f;
#pragma unroll
        for (int d0 = 0; d0 < 4; ++d0) { v[d0] = Fw[(long)orow * LDF + d0 * 32 + r32] - ao.lam * (o[d0][r] * rli[r]); ss += v[d0] * v[d0]; }
        ss = half_sum32(ss); const float rs = rsqrtf(ss * (1.0f / 128.0f) + 1e-6f) * ao.post;
#pragma unroll
        for (int d0 = 0; d0 < 4; ++d0) { const float y = v[d0] * rs * ao.nw[d0 * 32 + r32]; stg[orow * 128 + d0 * 32 + r32] = (bf16_t)(cvtpk(y, y) & 0xffffu); } }
      O_FLUSH(Ow);
    }
  }
#undef O_FLUSH
#undef SLOAD
#undef SWRITE
#undef SWAIT
#undef RESC
#undef PSM
}
struct ChainArgs { const bf16_t* P;   int kcol, vcol; int nchunk; int dir; float lg2;
                   const float* S0;   bf16_t* ST;   float* Sfin;   };
__device__ __forceinline__ void ret_chain(const ChainArgs a, char* lds) {
  int tid_ = threadIdx.x; asm volatile("" : "+v"(tid_));
  const int tid = tid_, wid = tid >> 6, lane = tid & 63, r32 = lane & 31, hi = lane >> 5;
  const int eb = wid >> 1, dh = wid & 1;
  char* V_lds = lds; char* K_lds = lds + 2 * SHM_V;
  const int sr = tid >> 4, sc = (tid & 15) * 8;
  f32x16 acc[2];
#pragma unroll
  for (int j = 0; j < 2; ++j)
#pragma unroll
    for (int r = 0; r < 16; ++r) acc[j][r] = 0.f;
  if (a.S0) {
#pragma unroll
    for (int j = 0; j < 2; ++j)
#pragma unroll
      for (int r = 0; r < 16; ++r) acc[j][r] = a.S0[(size_t)(32 * (2 * dh + j) + r32) * 128 + 32 * eb + crow(r, hi)]; }
  const float gC = __builtin_amdgcn_exp2f(128.f * a.lg2);
  const int vbA = (int)(uintptr_t)V_lds + v_rd_base(lane) + eb * 512, vbB = (int)(uintptr_t)K_lds + v_rd_base(lane) + (2 * dh) * 512;
  bf16x8 kq[4], vq[4];
  { const int c0 = a.dir == 0 ? 0 : a.nchunk - 1; const bf16_t* rowp = a.P + (size_t)(c0 * 128) * 5120;
#pragma unroll
    for (int q = 0; q < 4; ++q) { const int k = 32 * q + sr; kq[q] = ld8(rowp + (size_t)k * 5120 + a.kcol + sc); vq[q] = ld8(rowp + (size_t)k * 5120 + a.vcol + sc); } }
  for (int s = 0; s < a.nchunk; ++s) {
    const int c = a.dir == 0 ? s : a.nchunk - 1 - s;
    bf16_t* st = a.ST + (size_t)c * 16384;
    __syncthreads();
#pragma unroll
    for (int q = 0; q < 4; ++q) { const int k = 32 * q + sr;
      const bf16x8 kv_ = kq[q], vv_ = vq[q];
      const float f = 0.088388347648318440f * __builtin_amdgcn_exp2f((a.dir == 0 ? (float)(127 - k) : (float)k) * a.lg2);
      u32x4 w; w.x = cvtpk(bf2f((unsigned short)kv_[0]) * f, bf2f((unsigned short)kv_[1]) * f); w.y = cvtpk(bf2f((unsigned short)kv_[2]) * f, bf2f((unsigned short)kv_[3]) * f);
      w.z = cvtpk(bf2f((unsigned short)kv_[4]) * f, bf2f((unsigned short)kv_[5]) * f); w.w = cvtpk(bf2f((unsigned short)kv_[6]) * f, bf2f((unsigned short)kv_[7]) * f);
      const int off = (q >> 1) * SHM_V + v_st(32 * (q & 1) + sr, sc);
      *(u32x4*)(K_lds + off) = w; *(bf16x8*)(V_lds + off) = vv_; }
    __syncthreads();
#pragma unroll
    for (int j = 0; j < 2; ++j)
#pragma unroll
      for (int r = 0; r < 16; ++r) { const float v = acc[j][r]; st[(32 * eb + crow(r, hi)) * 128 + 32 * (2 * dh + j) + r32] = (bf16_t)(cvtpk(v, v) & 0xffffu); }
    if (s + 1 < a.nchunk) { const int cn = a.dir == 0 ? s + 1 : a.nchunk - 2 - s; const bf16_t* rowp = a.P + (size_t)(cn * 128) * 5120;
#pragma unroll
      for (int q = 0; q < 4; ++q) { const int k = 32 * q + sr; kq[q] = ld8(rowp + (size_t)k * 5120 + a.kcol + sc); vq[q] = ld8(rowp + (size_t)k * 5120 + a.vcol + sc); } }
#pragma unroll
    for (int j = 0; j < 2; ++j)
#pragma unroll
      for (int r = 0; r < 16; ++r) acc[j][r] *= gC;
#pragma unroll
    for (int tt = 0; tt < 2; ++tt) {
      s16x4 al[4], ah[4], b0l[4], b0h[4], b1l[4], b1h[4];
#define RD4(ks) do { al[ks] = tr_read<v_rd_off(0, ks, 0)>(vbA + tt * SHM_V); ah[ks] = tr_read<v_rd_off(0, ks, 1)>(vbA + tt * SHM_V); \
      b0l[ks] = tr_read<v_rd_off(0, ks, 0)>(vbB + tt * SHM_V); b0h[ks] = tr_read<v_rd_off(0, ks, 1)>(vbB + tt * SHM_V); \
      b1l[ks] = tr_read<v_rd_off(1, ks, 0)>(vbB + tt * SHM_V); b1h[ks] = tr_read<v_rd_off(1, ks, 1)>(vbB + tt * SHM_V); } while (0)
      RD4(0); RD4(1); RD4(2); RD4(3);
#undef RD4
      asm volatile("s_waitcnt lgkmcnt(0)" ::: "memory"); SBAR();
#pragma unroll
      for (int ks = 0; ks < 4; ++ks) {
        acc[0] = __builtin_amdgcn_mfma_f32_32x32x16_bf16(PKF(al[ks], ah[ks]), PKF(b0l[ks], b0h[ks]), acc[0], 0, 0, 0);
        acc[1] = __builtin_amdgcn_mfma_f32_32x32x16_bf16(PKF(al[ks], ah[ks]), PKF(b1l[ks], b1h[ks]), acc[1], 0, 0, 0); }
    }
  }
  if (a.Sfin) {
#pragma unroll
    for (int j = 0; j < 2; ++j)
#pragma unroll
      for (int r = 0; r < 16; ++r) a.Sfin[(size_t)(32 * (2 * dh + j) + r32) * 128 + 32 * eb + crow(r, hi)] = acc[j][r];
  }
}
struct RetCArgs { const bf16_t* P;   int qcol, kcol, vcol, gcol; float lg2f, lg2b; const bf16_t* STf; const bf16_t* STb;
                  const float* gnw; bf16_t* O;   };
__device__ __forceinline__ void ret_c(const RetCArgs a, char* lds) {
  int tid_ = threadIdx.x; asm volatile("" : "+v"(tid_));
  const int tid = tid_, wid = tid >> 6, lane = tid & 63, r32 = lane & 31, hi = lane >> 5;
  char* V_lds = lds; char* K_lds = lds + 2 * SHM_V;
  const int cw = wid >> 2, ipos = 32 * (wid & 3) + r32;
  const int sr = tid >> 4, sc = (tid & 15) * 8;
  const int vb0 = (int)(uintptr_t)V_lds + v_rd_base(lane);
  bf16x8 qr[8];
  const bf16_t* Qw = a.P + (size_t)(wid * 32 + r32) * 5120 + a.qcol + hi * 8;
#pragma unroll
  for (int d0 = 0; d0 < 8; ++d0) qr[d0] = ld8(Qw + d0 * 16);
  f32x16 o[4] = {};
  bf16x8 kvs[2][4], vvs[2][4];
#pragma unroll
  for (int ch = 0; ch < 2; ++ch) { const bf16_t* rowp = a.P + (size_t)(ch * 128) * 5120;
#pragma unroll
    for (int q = 0; q < 4; ++q) { const int k = 32 * q + sr; kvs[ch][q] = ld8(rowp + (size_t)k * 5120 + a.kcol + sc); vvs[ch][q] = ld8(rowp + (size_t)k * 5120 + a.vcol + sc); } }
#pragma unroll
  for (int ch = 0; ch < 2; ++ch) {
    __syncthreads();
#pragma unroll
    for (int q = 0; q < 4; ++q) {
      *(bf16x8*)(K_lds + (q >> 1) * SHM_K + KSWZ(32 * (q & 1) + sr, sc * 2)) = kvs[ch][q];
      *(bf16x8*)(V_lds + (q >> 1) * SHM_V + v_st(32 * (q & 1) + sr, sc)) = vvs[ch][q]; }
    __syncthreads();
    if (cw == ch) {
#pragma unroll
      for (int tt = 0; tt < 2; ++tt) {
        f32x16 p0, p1; qkt<128>(p0, p1, K_lds + tt * SHM_K, qr, r32, hi);
        int ip_ = ipos, hi_ = hi; asm volatile("" : "+v"(ip_), "+v"(hi_));
#pragma unroll
        for (int r = 0; r < 16; ++r) {
          const int j0 = 64 * tt + crow(r, hi_), d0_ = ip_ - j0, d1_ = d0_ - 32;
          const float f0 = d0_ > 0 ? __builtin_amdgcn_exp2f((float)d0_ * a.lg2f) : (d0_ < 0 ? __builtin_amdgcn_exp2f((float)(-d0_) * a.lg2b) : 2.0f);
          const float f1 = d1_ > 0 ? __builtin_amdgcn_exp2f((float)d1_ * a.lg2f) : (d1_ < 0 ? __builtin_amdgcn_exp2f((float)(-d1_) * a.lg2b) : 2.0f);
          p0[r] *= f0 * 0.088388347648318440f; p1[r] *= f1 * 0.088388347648318440f; }
        bf16x8 pa0, pa1, pa2, pa3; PK4(p0, 0, pa0); PK4(p0, 8, pa1); PK4(p1, 0, pa2); PK4(p1, 8, pa3);
        pv_d0(o, vb0 + tt * SHM_V, pa0, pa1, pa2, pa3);
      }
    }
  }
#pragma unroll
  for (int dir = 0; dir < 2; ++dir) {
    const float rs = dir == 0 ? __builtin_amdgcn_exp2f((float)(ipos + 1) * a.lg2f) : __builtin_amdgcn_exp2f((float)(128 - ipos) * a.lg2b);
    const bf16_t* S = (dir == 0 ? a.STf : a.STb) + (size_t)cw * 16384 + (size_t)r32 * 128 + hi * 8;
#pragma unroll
    for (int d0 = 0; d0 < 8; ++d0) {
      const bf16x8 q_ = qr[d0]; u32x4 w;
      w.x = cvtpk(bf2f((unsigned short)q_[0]) * rs, bf2f((unsigned short)q_[1]) * rs); w.y = cvtpk(bf2f((unsigned short)q_[2]) * rs, bf2f((unsigned short)q_[3]) * rs);
      w.z = cvtpk(bf2f((unsigned short)q_[4]) * rs, bf2f((unsigned short)q_[5]) * rs); w.w = cvtpk(bf2f((unsigned short)q_[6]) * rs, bf2f((unsigned short)q_[7]) * rs);
      const bf16x8 qs = *reinterpret_cast<bf16x8*>(&w);
#pragma unroll
      for (int eb = 0; eb < 4; ++eb) { const bf16x8 b = ld8(S + (size_t)eb * 32 * 128 + d0 * 16); o[eb] = __builtin_amdgcn_mfma_f32_32x32x16_bf16(qs, b, o[eb], 0, 0, 0); }
    }
  }
  unsigned short gq[16][4]; float gw4[4];
#pragma unroll
  for (int eb = 0; eb < 4; ++eb) gw4[eb] = a.gnw[eb * 32 + r32];
#pragma unroll
  for (int r = 0; r < 16; ++r)
#pragma unroll
    for (int eb = 0; eb < 4; ++eb) gq[r][eb] = a.P[(size_t)(wid * 32 + crow(r, hi)) * 5120 + a.gcol + eb * 32 + r32];
#pragma unroll
  for (int r = 0; r < 16; ++r) {
    const int row = wid * 32 + crow(r, hi);
    float s = (o[0][r] + o[1][r]) + (o[2][r] + o[3][r]); s = half_sum32(s); const float mean = s * (1.0f / 128.0f);
    float q = 0.f;
#pragma unroll
    for (int eb = 0; eb < 4; ++eb) { const float d = o[eb][r] - mean; q += d * d; }
    q = half_sum32(q); const float rstd = rsqrtf(q * (1.0f / 128.0f) + 1e-6f);
#pragma unroll
    for (int eb = 0; eb < 4; ++eb) { const int col = eb * 32 + r32;
      const float g = bf2f(gq[r][eb]);
      const float y = (o[eb][r] - mean) * rstd * gw4[eb] * (g * __builtin_amdgcn_rcpf(1.0f + __builtin_amdgcn_exp2f(-1.4426950408889634f * g)));
      a.O[(size_t)row * 2048 + col] = (bf16_t)(cvtpk(y, y) & 0xffffu); }
  }
}
#undef KSWZ
#undef KSWZ64
#undef SBAR
#undef PK4
#undef PKF
}
constexpr int DM = 2048, M_P = 4096, M_S = 32768, MTOK = M_P + M_S, DFF = 5632, NFF = 11264, NIN = 5120, NMODC = 18432, NCOND = 9;
constexpr int C_RQ = 0, C_RK = 512, C_RV = 1024, C_RG = 1536, C_GQ = 2048, C_GK = 3072, C_GV = 3328, C_DQ = 3584, C_DK = 4096, C_DV = 4608;
constexpr float EPS = 1e-6f;
constexpr size_t MiB = 1u << 20;
constexpr size_t WS_CTL = 0, CTL_ZERO_BYTES = 1 * MiB;
constexpr size_t WS_TAB = 1 * MiB;
constexpr size_t WS_CACHE = 4 * MiB;
constexpr size_t WS_W = 16 * MiB;
constexpr size_t W_LAYER = 160 * MiB, W_WI = 0, W_WO = 88 * MiB, W_WIN = 132 * MiB, W_WOUT = 152 * MiB;
constexpr size_t WS_XN = WS_W + 2 * W_LAYER;
constexpr size_t WS_ACT = WS_XN + 144 * MiB;
constexpr size_t WS_ST = WS_ACT + 396 * MiB;
constexpr size_t WS_DF = WS_ST + 72 * MiB;
constexpr size_t WS_XNB = WS_DF + 72 * MiB;
constexpr size_t WS_SB = WS_XNB + 144 * MiB;
constexpr size_t SB_LAYER = 9 * (11264 + 5120 + 11264), SB_J1 = 9 * 11264, SB_J2 = 9 * (11264 + 5120);
constexpr size_t WS_RS = WS_SB + 2 * MiB;
constexpr size_t WS_Q = WS_RS + 2 * MiB;
constexpr size_t Q_SW = 256 * 1024, Q_SW2 = 512 * 1024, Q_SW4 = 832 * 1024, Q_ACT = 960 * 1024  , W_WINQ = 22 * MiB;
constexpr size_t WS_A8B = WS_Q + 1 * MiB;
constexpr size_t WS_END = WS_A8B + 198 * MiB;
constexpr int TB_MOD = 0, TB_COSG = 2 * 9 * 18432, TB_SING = TB_COSG + 64 * 32, TB_COSD = TB_SING + 64 * 32, TB_SIND = TB_COSD + 64 * 16, TB_SCAL = TB_SIND + 64 * 16;
constexpr int CW_BAR = 4096;
constexpr size_t CTL_RAW2 = 960 * 1024;
constexpr size_t CTL_AMAX = 64 * 1024;
constexpr size_t O_X = 0, O_STATE = 75497472, O_GK = 79691776, O_GV = 81788928, O_DK = 83886080, O_DV = 88080384, O_END = 92274688;
constexpr int LDS_BYTES = 147456, MISC_OFF = 131072 + 320;

typedef att::bf16_t bf16;
#define GAS __attribute__((address_space(1)))
#define LAS __attribute__((address_space(3)))
typedef unsigned v4u __attribute__((ext_vector_type(4)));
typedef float f32x4 __attribute__((ext_vector_type(4)));
typedef short bf16x8 __attribute__((ext_vector_type(8)));
typedef GAS unsigned gu32;
typedef GAS unsigned long long gu64;
#define RLX_AGENT __ATOMIC_RELAXED, __HIP_MEMORY_SCOPE_AGENT
#define LDS_WAIT() asm volatile("s_waitcnt lgkmcnt(0)" ::: "memory")
#define VM_WAIT() asm volatile("s_waitcnt vmcnt(0)" ::: "memory")
__device__ __forceinline__ unsigned long long rt() { return __builtin_amdgcn_s_memrealtime(); }
__device__ __forceinline__ unsigned f2bf(float f) { unsigned u = __builtin_bit_cast(unsigned, f); return (u + 0x7fffu + ((u >> 16) & 1u)) >> 16; }
__device__ __forceinline__ unsigned pk2(float lo, float hi) { return f2bf(lo) | (f2bf(hi) << 16); }
#define XB_TMO      128
#define XB_XCNT(j)  (256  + 64 * (j))
#define XB_XSUB(j)  (1280 + 64 * (j))
#define XB_XGEN(j)  (2304 + 64 * (j))
#define XB_TOP      3328
#define XB_TOPGEN   3392
#define XCD_BAR_WORDS 3456
#define XB_SPIN_CAP (1u << 18)

__device__ __forceinline__ unsigned xb_ld(unsigned* p)              { return __hip_atomic_load(p, __ATOMIC_RELAXED, __HIP_MEMORY_SCOPE_AGENT); }
__device__ __forceinline__ unsigned xb_add(unsigned* p, unsigned v) { return __hip_atomic_fetch_add(p, v, __ATOMIC_RELAXED, __HIP_MEMORY_SCOPE_AGENT); }
__device__ __forceinline__ unsigned xb_xcc_id() { return (unsigned)__builtin_amdgcn_s_getreg((3 << 11) | 20) & 0xFu; }
#define XB_SPIN(cond, bar) do { unsigned _sp = 0; while (cond) { __builtin_amdgcn_s_sleep(1); \
    if ((++_sp & 255u) == 0u) { if (xb_ld(&(bar)[XB_TMO])) break; if (_sp > XB_SPIN_CAP) { atomicAdd(&(bar)[XB_TMO], 1u); break; } } } } while (0)

struct XcdBarrier {
    unsigned* bar; unsigned x;
    volatile LAS unsigned* st;
};

__device__ __forceinline__ XcdBarrier xcd_barrier_post(unsigned* bar, volatile LAS unsigned* st) {
    XcdBarrier b; b.bar = bar; b.x = xb_xcc_id(); b.st = st;
    if (threadIdx.x == 0) (void)xb_add(&bar[XB_XCNT(b.x)], 1u);
    return b;
}
__device__ __forceinline__ void xcd_barrier_complete(unsigned* bar, unsigned x, unsigned& nloc, unsigned& nx) {
    const unsigned G = gridDim.x * gridDim.y * gridDim.z;
    unsigned sum, cnt, mine, sp = 0u;
    for (;;) {
        sum = 0u; cnt = 0u; mine = 0u;
#pragma unroll
        for (unsigned j = 0; j < 16; ++j) { const unsigned c = xb_ld(&bar[XB_XCNT(j)]); sum += c; cnt += (c > 0u) ? 1u : 0u; mine = (j == x) ? c : mine; }
        if (sum == G) break;
        __builtin_amdgcn_s_sleep(1);
        if ((++sp & 255u) == 0u) { if (xb_ld(&bar[XB_TMO])) break; if (sp > XB_SPIN_CAP) { atomicAdd(&bar[XB_TMO], 1u); break; } }
    }
    nloc = mine > 0u ? mine : 1u; nx = cnt > 0u ? cnt : 1u;
}

__device__ __forceinline__ void xcd_barrier(const XcdBarrier& b) {
    asm volatile("s_waitcnt vmcnt(0)" ::: "memory");
    __syncthreads();
    if (threadIdx.x == 0) {
        unsigned* bar = b.bar;
        __builtin_amdgcn_s_waitcnt(0);
        unsigned nloc = b.st[0], nx = b.st[1];
        if (nloc == 0u) { xcd_barrier_complete(bar, b.x, nloc, nx); b.st[0] = nloc; b.st[1] = nx; }
        const unsigned old = xb_add(&bar[XB_XSUB(b.x)], 1u);
        const unsigned gen = old / nloc;
        if (old + 1u == (gen + 1u) * nloc) {
            __builtin_amdgcn_fence(__ATOMIC_RELEASE, "agent");
            asm volatile("s_waitcnt vmcnt(0)" ::: "memory");
            const unsigned og = xb_add(&bar[XB_TOP], 1u);
            const unsigned tg = og / nx;
            if (og + 1u == (tg + 1u) * nx) xb_add(&bar[XB_TOPGEN], 1u);
            else XB_SPIN(xb_ld(&bar[XB_TOPGEN]) == tg, bar);
            __builtin_amdgcn_fence(__ATOMIC_ACQUIRE, "agent");
            xb_add(&bar[XB_XGEN(b.x)], 1u);
            asm volatile("s_waitcnt vmcnt(0)" ::: "memory");
        } else {
            XB_SPIN(xb_ld(&bar[XB_XGEN(b.x)]) == gen, bar);
            __builtin_amdgcn_fence(__ATOMIC_ACQUIRE, "agent");
            asm volatile("s_waitcnt vmcnt(0)" ::: "memory");
        }
    }
    __syncthreads();
}
__device__ __forceinline__ float wave_sum(float v) {
#pragma unroll
    for (int o = 1; o < 64; o <<= 1) v += __shfl_xor(v, o);
    return v;
}
__device__ __forceinline__ unsigned pkbf(float lo, float hi) { return pg8::cvt_pk_bf16(lo, hi); }
__device__ __forceinline__ float bf2f(unsigned short b) { return __uint_as_float((unsigned)b << 16); }
__device__ __forceinline__ void transpose_item(const float* W, int ldn, bf16* WT, int K, int k0, int srccol0, int dstrow0, LAS float* scr, int lane, bool qf = false) {
#pragma unroll 8
    for (int i = 0; i < 32; ++i) { const int kk = 2 * i + (lane >> 5); scr[kk * 33 + (lane & 31)] = W[(size_t)(k0 + kk) * ldn + srccol0 + (lane & 31)]; }
    LDS_WAIT(); asm volatile("" ::: "memory");
    const int c = lane & 7;
#pragma unroll
    for (int j = 0; j < 4; ++j) { const int n = (lane >> 3) + 8 * j; const LAS float* s = scr + (8 * c) * 33 + n;
        v4u o; if (qf) { o.x = pkbf(qm(s[0 * 33]), qm(s[1 * 33])); o.y = pkbf(qm(s[2 * 33]), qm(s[3 * 33])); o.z = pkbf(qm(s[4 * 33]), qm(s[5 * 33])); o.w = pkbf(qm(s[6 * 33]), qm(s[7 * 33])); }
        else { o.x = pkbf(s[0 * 33], s[1 * 33]); o.y = pkbf(s[2 * 33], s[3 * 33]); o.z = pkbf(s[4 * 33], s[5 * 33]); o.w = pkbf(s[6 * 33], s[7 * 33]); }
        const int dr = dstrow0 + n; *(GAS v4u*)(WT + ((size_t)((dr >> 8) * (K >> 6) + (k0 >> 6)) * 256 + (dr & 255)) * 64 + 8 * c) = o; }
    LDS_WAIT(); asm volatile("" ::: "memory");
}
template <class INP> __device__ __forceinline__ void absmax_item(const INP& inp, unsigned char* ws, int t, LAS float* red, int tid) {
    const int col = tid & 127, kq = tid >> 7;
    const float* src; size_t ld; int kb, kn, kind, mat, cb;
    if (t < 352) { kind = 0; mat = t / 88; cb = t % 88; src = inp[12] + (size_t)mat * DM * NFF + 128 * cb + col; ld = NFF; kb = 512 * kq; kn = 512; }
    else if (t < 432) { t -= 352; kind = 1; mat = t / 40; cb = t % 40; src = inp[14] + (size_t)mat * DM * NIN + 128 * cb + col; ld = NIN; kb = 512 * kq; kn = 512; }
    else { t -= 432; kind = 2; mat = t >> 6; cb = (t & 63) >> 2; src = inp[13] + (size_t)mat * DFF * DM + 128 * cb + col; ld = DM; kb = 1408 * (t & 3) + 352 * kq; kn = 352; }
    float mx = 0.f;
    for (int k = kb; k < kb + kn; k += 8) { float w[8];
#pragma unroll
        for (int u = 0; u < 8; ++u) w[u] = src[(size_t)(k + u) * ld];
#pragma unroll
        for (int u = 0; u < 8; ++u) mx = fmaxf(mx, fabsf(w[u])); }
    red[kq * 128 + col] = mx;
    __syncthreads();
    if (tid < 128) { const float m4 = fmaxf(fmaxf(red[tid], red[128 + tid]), fmaxf(red[256 + tid], red[384 + tid])); const int s0 = 128 * cb + tid;
        if (kind == 0) { const int brow = s0 < DFF ? (s0 / 128) * 256 + (s0 % 128) : ((s0 - DFF) / 128) * 256 + 128 + ((s0 - DFF) % 128);
            ((float*)(ws + WS_Q + Q_SW))[(size_t)mat * NFF + brow] = fmaxf(m4, 1e-30f) * (1.0f / 127.0f); }
        else if (kind == 1) ((float*)(ws + WS_Q + Q_SW4))[(size_t)mat * NIN + s0] = fmaxf(m4, 1e-30f) * (1.0f / 127.0f);
        else atomicMax((unsigned*)(ws + WS_CTL + CTL_RAW2) + (size_t)mat * DM + s0, __float_as_uint(m4)); }
    __syncthreads();
}
template <class INP> __device__ __forceinline__ void prologue(const INP& inp, unsigned char* ws, LAS unsigned char* lds, int G, int wg, int tid) {
    const int lane = tid & 63, wave = __builtin_amdgcn_readfirstlane(tid >> 6);
    float* tab = (float*)(ws + WS_TAB);
    {
        LAS float* sc = (LAS float*)lds;
        LAS float* red = sc + NCOND * DM;
        bool have = false;
        for (int it = wg; it < 976; it += G) {
            if (it >= 288) { absmax_item(inp, ws, it - 288, (LAS float*)(lds + 98304), tid); continue; }
            if (!have) { for (int i = tid; i < NCOND * DM; i += 512) { const int cd = i >> 11, k = i & 2047; const float v = cd == 0 ? inp[8][k] : inp[2][(cd - 1) * DM + k];
                              sc[i] = v / (1.0f + __expf(-v)); } have = true; __syncthreads(); }
            const int l = it / 144, cb = it % 144, col = tid & 127, g = tid >> 7;
            const float* W = inp[9] + (size_t)l * DM * NMODC + 128 * cb + col;
            float acc[NCOND];
#pragma unroll
            for (int c = 0; c < NCOND; ++c) acc[c] = 0.f;
            for (int k = 512 * g; k < 512 * g + 512; k += 8) {
                float w[8];
#pragma unroll
                for (int u = 0; u < 8; ++u) w[u] = W[(size_t)(k + u) * NMODC];
#pragma unroll
                for (int c = 0; c < NCOND; ++c) { const f32x4 s0 = *(const LAS f32x4*)(sc + c * DM + k), s1 = *(const LAS f32x4*)(sc + c * DM + k + 4);
                    acc[c] += (s0[0] * w[0] + s0[1] * w[1]) + (s0[2] * w[2] + s0[3] * w[3]) + (s1[0] * w[4] + s1[1] * w[5]) + (s1[2] * w[6] + s1[3] * w[7]); }
            }
#pragma unroll
            for (int c = 0; c < NCOND; ++c) red[(g * NCOND + c) * 128 + col] = acc[c];
            __syncthreads();
            for (int i = tid; i < NCOND * 128; i += 512) { const int c = i >> 7, cc = i & 127;
                const float s = ((red[(0 * NCOND + c) * 128 + cc] + red[(1 * NCOND + c) * 128 + cc]) + red[(2 * NCOND + c) * 128 + cc]) + red[(3 * NCOND + c) * 128 + cc];
                tab[TB_MOD + ((size_t)l * NCOND + c) * NMODC + 128 * cb + cc] = s + inp[10][(size_t)l * NMODC + 128 * cb + cc]; }
            __syncthreads();
        }
        __syncthreads();
    }
    if (wg == 0) {
        for (int i = tid; i < 64 * 32; i += 512) { const int pos = i >> 5, f = i & 31; const double inv = pow(10000.0, -(double)(2 * f) / 64.0), a = (double)pos * inv;
            tab[TB_COSG + i] = (float)cos(a); tab[TB_SING + i] = (float)sin(a); }
        for (int i = tid; i < 64 * 16; i += 512) { const int pos = i >> 4, f = i & 15; const double inv = pow(10000.0, -(double)(2 * f) / 32.0), a = (double)pos * inv;
            tab[TB_COSD + i] = (float)cos(a); tab[TB_SIND + i] = (float)sin(a); }
        if (tid < 2) { const int l = tid; const float* dl = inp[19] + l * 256; double s01 = 0.0, s23 = 0.0;
            for (int i = 0; i < 64; ++i) { s01 += (double)dl[i] * (double)dl[64 + i]; s23 += (double)dl[128 + i] * (double)dl[192 + i]; }
            const double li = 0.8 - 0.6 * exp(-0.3 * (double)l);
            tab[TB_SCAL + 16 * l + 0] = (float)(exp(s01) - exp(s23) + li); tab[TB_SCAL + 16 * l + 1] = (float)(1.0 - li); }
        if (tid >= 128 && tid < 130) { const int l = tid - 128; const float* w = inp[18] + l * 256; float mq = 0.f, mk = 0.f;
            for (int i = 0; i < 128; ++i) { mq = fmaxf(mq, fabsf(w[i])); mk = fmaxf(mk, fabsf(w[128 + i])); }
            tab[TB_SCAL + 16 * l + 10] = (mq * mk * 11.313708f * 1.4426950f < 60.0f) ? 1.0f : 0.0f; }
        if (tid >= 64 && tid < 80) { const int i = tid - 64, l = i >> 3, j = i & 7; const double x = (double)inp[16][l * 8 + j];
            tab[TB_SCAL + 16 * l + 2 + j] = (float)(-log1p(exp(-x)) * 1.4426950408889634); }
    }
    {
        bf16* cb = (bf16*)(ws + WS_CACHE);
        const long gt = (long)wg * 512 + tid, GT = (long)G * 512;
        for (int t = 0; t < 4; ++t) { const float* src = inp[4 + t]; const long n8 = (t < 2 ? 1048576 : 2097152) / 8; bf16* dst = cb + (t == 0 ? 0 : t == 1 ? 1048576 : t == 2 ? 2097152 : 4194304);
            for (long i = gt; i < n8; i += GT) { const f32x4 a = *(const f32x4*)(src + i * 8), b = *(const f32x4*)(src + i * 8 + 4);
                v4u o; o.x = pkbf(a[0], a[1]); o.y = pkbf(a[2], a[3]); o.z = pkbf(b[0], b[1]); o.w = pkbf(b[2], b[3]); *(v4u*)(dst + i * 8) = o; } }
    }
    {
        LAS float* scr = (LAS float*)(lds + wave * 16384);
        const int gw = wg * 8 + wave, NGW = G * 8;
        for (int it = gw; it < 81920; it += NGW) {
            const int l = it / 40960; int r = it % 40960;
            bf16* WL = (bf16*)(ws + WS_W + (size_t)l * W_LAYER);
            if (r < 22528) continue;
            if (false) { const int f = r / 11264, q = r % 11264, kb = q / 352, nb = q % 352, s0 = 32 * nb;
                const int drow = s0 < DFF ? (s0 / 128) * 256 + (s0 % 128) : ((s0 - DFF) / 128) * 256 + 128 + ((s0 - DFF) % 128);
                transpose_item(inp[12] + (size_t)(l * 2 + f) * DM * NFF, NFF, WL + (W_WI + (size_t)f * 44 * MiB) / 2, DM, 64 * kb, s0, drow, scr, lane, true); continue; }
            r -= 22528;
            if (r < 11264) continue;
            if (false) { const int f = r / 5632, q = r % 5632, kb = q / 64, nb = q % 64;
                transpose_item(inp[13] + (size_t)(l * 2 + f) * DFF * DM, DM, WL + (W_WO + (size_t)f * 22 * MiB) / 2, DFF, 64 * kb, 32 * nb, 32 * nb, scr, lane, true); continue; }
            r -= 11264;
            if (r < 5120) { const int kb = r / 160, nb = r % 160;
                transpose_item(inp[14] + (size_t)l * DM * NIN, NIN, WL + W_WIN / 2, DM, 64 * kb, 32 * nb, 32 * nb, scr, lane); continue; }
            r -= 5120;
            { const int kb = r / 64, nb = r % 64;
                transpose_item(inp[15] + (size_t)l * DM * DM, DM, WL + W_WOUT / 2, DM, 64 * kb, 32 * nb, 32 * nb, scr, lane); }
        }
    }
}
template <class INP> __device__ __forceinline__ void prologue_b(const INP& inp, unsigned char* ws, LAS unsigned char* lds, int G, int wg, int tid) {
    const int lane = tid & 63, wave = __builtin_amdgcn_readfirstlane(tid >> 6);
    LAS float* scr = (LAS float*)(lds + wave * 16384);
    const float* swv = (const float*)(ws + WS_Q + Q_SW);
    const int gw = wg * 8 + wave, NGW = G * 8;
    const float* swv4 = (const float*)(ws + WS_Q + Q_SW4);
    if (wg < 4) {
        float sm = 0.f; for (int i = tid; i < NFF; i += 512) sm += swv[(size_t)wg * NFF + i];
#pragma unroll
        for (int o = 1; o < 64; o <<= 1) sm += __shfl_xor(sm, o);
        LAS float* red = (LAS float*)(lds + 131072);
        if (lane == 0) red[wave] = sm;
        __syncthreads();
        if (tid == 0) { float t = 0.f; for (int i = 0; i < 8; ++i) t += red[i];
            const float sg = t * (127.0f / (float)NFF) * (1.0f / 3.6f) * 45.254834f;
            const float h0 = fmaxf(fmaxf(sg * sg, sg), 1e-20f); const float sc = exp2f(1.0f - rintf(log2f(h0)));
            float* qa = (float*)(ws + WS_Q + Q_ACT) + 2 * wg; qa[0] = sc; qa[1] = 1.0f / sc; }
        __syncthreads();
    }
    for (int it = gw; it < 10240; it += NGW) {
        const int l = it / 5120, q = it % 5120, kb = q / 160, nb = q % 160, s0 = 32 * nb, k0 = 64 * kb;
        const float* W = inp[14] + (size_t)l * DM * NIN;
        unsigned char* WQ = ws + WS_W + (size_t)l * W_LAYER + W_WINQ;
#pragma unroll 8
        for (int i = 0; i < 32; ++i) { const int kk = 2 * i + (lane >> 5); scr[kk * 33 + (lane & 31)] = W[(size_t)(k0 + kk) * NIN + s0 + (lane & 31)]; }
        LDS_WAIT(); asm volatile("" ::: "memory");
        const int c = lane & 7;
#pragma unroll
        for (int j = 0; j < 4; ++j) { const int n = (lane >> 3) + 8 * j, dr = s0 + n; const LAS float* sp = scr + (8 * c) * 33 + n;
            const float inv = 1.0f / swv4[(size_t)l * NIN + dr];
            unsigned lo = 0u, hi = 0u;
#pragma unroll
            for (int e = 0; e < 4; ++e) { lo |= ((unsigned)(__float2int_rn(sp[e * 33] * inv)) & 0xffu) << (8 * e); hi |= ((unsigned)(__float2int_rn(sp[(4 + e) * 33] * inv)) & 0xffu) << (8 * e); }
            const int kk = k0 + 8 * c;
            uint2 o; o.x = lo; o.y = hi;
            *(uint2*)(WQ + ((size_t)((dr >> 8) * (DM >> 7) + (kk >> 7)) * 256 + (dr & 255)) * 128 + (kk & 127)) = o; }
        LDS_WAIT(); asm volatile("" ::: "memory");
    }
    const unsigned* raw2 = (const unsigned*)(ws + WS_CTL + CTL_RAW2);
    for (int i = wg * 512 + tid; i < 4 * DM; i += G * 512) ((float*)(ws + WS_Q + Q_SW2))[i] = fmaxf(__uint_as_float(raw2[i]), 1e-30f) * (1.0f / 240.0f);
    for (int it = gw; it < 22528; it += NGW) {
        const int mat = it / 5632, q = it % 5632, kb = q / 64, nb = q % 64, s0 = 32 * nb, k0 = 64 * kb, l = mat >> 1, f = mat & 1;
        const float* W = inp[13] + (size_t)mat * DFF * DM;
        unsigned char* WQ = ws + WS_W + (size_t)l * W_LAYER + W_WO + (size_t)f * 22 * MiB;
#pragma unroll 8
        for (int i = 0; i < 32; ++i) { const int kk = 2 * i + (lane >> 5); scr[kk * 33 + (lane & 31)] = W[(size_t)(k0 + kk) * DM + s0 + (lane & 31)]; }
        LDS_WAIT(); asm volatile("" ::: "memory");
        const int c = lane & 7;
#pragma unroll
        for (int j = 0; j < 4; ++j) { const int n = (lane >> 3) + 8 * j, dr = s0 + n; const LAS float* sp = scr + (8 * c) * 33 + n;
            const float inv = 240.0f / fmaxf(__uint_as_float(raw2[(size_t)mat * DM + dr]), 1e-30f);
            unsigned lo = __builtin_amdgcn_cvt_pk_fp8_f32(sp[0] * inv, sp[33] * inv, 0, false); lo = __builtin_amdgcn_cvt_pk_fp8_f32(sp[2 * 33] * inv, sp[3 * 33] * inv, lo, true);
            unsigned hi = __builtin_amdgcn_cvt_pk_fp8_f32(sp[4 * 33] * inv, sp[5 * 33] * inv, 0, false); hi = __builtin_amdgcn_cvt_pk_fp8_f32(sp[6 * 33] * inv, sp[7 * 33] * inv, hi, true);
            const int kk = k0 + 8 * c;
            uint2 o; o.x = lo; o.y = hi;
            *(uint2*)(WQ + ((size_t)((dr >> 8) * (DFF >> 7) + (kk >> 7)) * 256 + (dr & 255)) * 128 + (kk & 127)) = o; }
        LDS_WAIT(); asm volatile("" ::: "memory");
    }
    for (int it = gw; it < 45056; it += NGW) {
        const int mat = it / 11264, q = it % 11264, kb = q / 352, nb = q % 352, s0 = 32 * nb, k0 = 64 * kb, l = mat >> 1, f = mat & 1;
        const int drow = s0 < DFF ? (s0 / 128) * 256 + (s0 % 128) : ((s0 - DFF) / 128) * 256 + 128 + ((s0 - DFF) % 128);
        const float* W = inp[12] + (size_t)mat * DM * NFF;
        unsigned char* WQ = ws + WS_W + (size_t)l * W_LAYER + W_WI + (size_t)f * 44 * MiB;
#pragma unroll 8
        for (int i = 0; i < 32; ++i) { const int kk = 2 * i + (lane >> 5); scr[kk * 33 + (lane & 31)] = W[(size_t)(k0 + kk) * NFF + s0 + (lane & 31)]; }
        LDS_WAIT(); asm volatile("" ::: "memory");
        const int c = lane & 7;
#pragma unroll
        for (int j = 0; j < 4; ++j) { const int n = (lane >> 3) + 8 * j, dr = drow + n; const LAS float* sp = scr + (8 * c) * 33 + n;
            const float inv = 1.0f / swv[(size_t)mat * NFF + dr];
            unsigned lo = 0u, hi = 0u;
#pragma unroll
            for (int e = 0; e < 4; ++e) { lo |= ((unsigned)(__float2int_rn(sp[e * 33] * inv)) & 0xffu) << (8 * e); hi |= ((unsigned)(__float2int_rn(sp[(4 + e) * 33] * inv)) & 0xffu) << (8 * e); }
            const int kk = k0 + 8 * c;
            uint2 o; o.x = lo; o.y = hi;
            *(uint2*)(WQ + ((size_t)((dr >> 8) * (DM >> 7) + (kk >> 7)) * 256 + (dr & 255)) * 128 + (kk & 127)) = o; }
        LDS_WAIT(); asm volatile("" ::: "memory");
    }
}
__device__ __forceinline__ void quant_act_phase(const bf16* ACT, unsigned char* A8, float* sa, int G, int wg, int tid) {
    const int lane = tid & 63, wave = tid >> 6, gw = wg * 8 + wave, NGW = G * 8;
    for (int m = gw; m < MTOK; m += NGW) {
        const bf16* ar = ACT + (size_t)m * DFF;
        v4u v[11]; float mx = 0.f;
#pragma unroll
        for (int j = 0; j < 11; ++j) v[j] = *(const v4u*)(ar + 512 * j + 8 * lane);
#pragma unroll
        for (int j = 0; j < 11; ++j) { const unsigned w4[4] = {v[j].x, v[j].y, v[j].z, v[j].w};
#pragma unroll
            for (int e = 0; e < 4; ++e) mx = fmaxf(mx, fmaxf(fabsf(__uint_as_float(w4[e] << 16)), fabsf(__uint_as_float(w4[e] & 0xffff0000u)))); }
#pragma unroll
        for (int o = 1; o < 64; o <<= 1) mx = fmaxf(mx, __shfl_xor(mx, o));
        mx = fmaxf(mx, 1e-30f);
        if (lane == 0) sa[m] = mx * (1.0f / 127.0f);
        const float inv = 127.0f / mx; unsigned char* orow = A8 + (size_t)m * DFF;
#pragma unroll
        for (int j = 0; j < 11; ++j) { const unsigned w4[4] = {v[j].x, v[j].y, v[j].z, v[j].w}; unsigned o2[2] = {0u, 0u};
#pragma unroll
            for (int e = 0; e < 4; ++e) { const unsigned lo = (unsigned)__float2int_rn(__uint_as_float(w4[e] << 16) * inv) & 0xffu, hi = (unsigned)__float2int_rn(__uint_as_float(w4[e] & 0xffff0000u) * inv) & 0xffu;
                o2[e >> 1] |= (lo | (hi << 8)) << (16 * (e & 1)); }
            uint2 ov; ov.x = o2[0]; ov.y = o2[1]; *(uint2*)(orow + 512 * j + 8 * lane) = ov; }
    }
}
__device__ __forceinline__ void quant_xs_phase(const bf16* XS, const unsigned* amax, unsigned char* A8, float* sa, int G, int wg, int tid, int m_begin = 0) {
    const int lane = tid & 63, wave = tid >> 6, gw = wg * 8 + wave, NGW = G * 8;
    for (int m0 = m_begin + 2 * gw; m0 < MTOK; m0 += 2 * NGW) {
        v4u v[2][4]; float mx[2];
#pragma unroll
        for (int r = 0; r < 2; ++r) { const bf16* xr = XS + (size_t)(m0 + r) * DM; mx[r] = fmaxf(__uint_as_float(amax[m0 + r]), 1e-30f);
#pragma unroll
            for (int j = 0; j < 4; ++j) v[r][j] = *(const v4u*)(xr + 512 * j + 8 * lane); }
#pragma unroll
        for (int r = 0; r < 2; ++r) { const float inv = 127.0f / mx[r]; unsigned char* orow = A8 + (size_t)(m0 + r) * DM; if (lane == 0) sa[m0 + r] = mx[r] * (1.0f / 127.0f);
#pragma unroll
            for (int j = 0; j < 4; ++j) { const unsigned w4[4] = {v[r][j].x, v[r][j].y, v[r][j].z, v[r][j].w}; unsigned o2[2] = {0u, 0u};
#pragma unroll
                for (int e = 0; e < 4; ++e) { const unsigned lo = (unsigned)__float2int_rn(__uint_as_float(w4[e] << 16) * inv) & 0xffu, hi = (unsigned)__float2int_rn(__uint_as_float(w4[e] & 0xffff0000u) * inv) & 0xffu;
                    o2[e >> 1] |= (lo | (hi << 8)) << (16 * (e & 1)); }
                uint2 ov; ov.x = o2[0]; ov.y = o2[1]; *(uint2*)(orow + 512 * j + 8 * lane) = ov; } }
    }
}
__device__ __forceinline__ void quant_phase(const float* xP, const float* xS, const float* nw, const float* scl0  , unsigned char* A8, float* sa, unsigned long long* rss, int G, int wg, int tid, int m_begin = 0) {
    const int lane = tid & 63, wave = tid >> 6, gw = wg * 8 + wave, NGW = G * 8;
    for (int m = m_begin + gw; m < MTOK; m += NGW) {
        const float* xr = (m < M_P ? xP : xS) + (size_t)m * DM;
        const int cond = m < M_P ? 0 : 1 + ((m - M_P) >> 12);
        const float* scl = scl0 + (size_t)cond * NMODC;
        f32x4 h[8]; float ss = 0.f, mx = 0.f;
#pragma unroll
        for (int j = 0; j < 8; ++j) { const int c = 256 * j + 4 * lane; const f32x4 v = *(const f32x4*)(xr + c); ss += (v[0] * v[0] + v[1] * v[1]) + (v[2] * v[2] + v[3] * v[3]);
            h[j] = v * *(const f32x4*)(nw + c) * (*(const f32x4*)(scl + c) + 1.0f);
            mx = fmaxf(fmaxf(mx, fmaxf(fabsf(h[j][0]), fabsf(h[j][1]))), fmaxf(fabsf(h[j][2]), fabsf(h[j][3]))); }
        ss = wave_sum(ss);
#pragma unroll
        for (int o = 1; o < 64; o <<= 1) mx = fmaxf(mx, __shfl_xor(mx, o));
        mx = fmaxf(mx, 1e-30f);
        if (lane == 0) { rss[m] = (unsigned long long)(ss * 16777216.0f); sa[m] = mx * (1.0f / 127.0f); }
        const float inv = 127.0f / mx; unsigned char* orow = A8 + (size_t)m * DM;
#pragma unroll
        for (int j = 0; j < 8; ++j) { const unsigned w = ((unsigned)__float2int_rn(h[j][0] * inv) & 0xffu) | (((unsigned)__float2int_rn(h[j][1] * inv) & 0xffu) << 8) | (((unsigned)__float2int_rn(h[j][2] * inv) & 0xffu) << 16) | (((unsigned)__float2int_rn(h[j][3] * inv) & 0xffu) << 24);
            *(unsigned*)(orow + 256 * j + 4 * lane) = w; }
    }
}
__device__ __forceinline__ void norm0_phase(const float* xP, const float* xS, const float* nw, const float* mod  , bf16* XN, unsigned long long* rss, int G, int wg, int tid) {
    const int lane = tid & 63, wave = tid >> 6, gw = wg * 8 + wave, NGW = G * 8;
    for (int m = gw; m < MTOK; m += NGW) {
        const float* xr = (m < M_P ? xP : xS) + (size_t)m * DM;
        const int cond = m < M_P ? 0 : 1 + ((m - M_P) >> 12);
        const float* scl = mod + (size_t)cond * NMODC + DM;
        f32x4 v[8]; float ss = 0.f;
#pragma unroll
        for (int j = 0; j < 8; ++j) { v[j] = *(const f32x4*)(xr + 256 * j + 4 * lane); ss += (v[j][0] * v[j][0] + v[j][1] * v[j][1]) + (v[j][2] * v[j][2] + v[j][3] * v[j][3]); }
        ss = wave_sum(ss); if (lane == 0) rss[m] = (unsigned long long)(ss * 16777216.0f);
        bf16* orow = XN + (size_t)m * DM;
#pragma unroll
        for (int j = 0; j < 8; ++j) { const int c = 256 * j + 4 * lane; const f32x4 w = *(const f32x4*)(nw + c), s1 = *(const f32x4*)(scl + c);
            const f32x4 h = v[j] * w * (s1 + 1.0f);
            uint2 o; o.x = pkbf(qm(h[0]), qm(h[1])); o.y = pkbf(qm(h[2]), qm(h[3])); *(uint2*)(orow + c) = o; }
    }
}
__device__ __forceinline__ void bias_ffn_mfma(unsigned char* ws, LAS unsigned char* lds, int grp, int sub, int nsub, int tid) {
    typedef int i32x4_t __attribute__((ext_vector_type(4)));
    const int lane = tid & 63, wave = tid >> 6, l = grp >> 1, f = grp & 1;
    const float* mod = (const float*)(ws + WS_TAB) + TB_MOD + (size_t)l * NCOND * NMODC + (size_t)(6 * f) * DM;
    LAS unsigned char* D = lds;
    LAS float* red = (LAS float*)(lds + 65536);
    __syncthreads();
    for (int i = tid; i < 65536 / 16; i += 512) ((LAS v4u*)D)[i] = (v4u){0u, 0u, 0u, 0u};
    for (int c = wave; c < NCOND; c += 8) { float mx = 0.f; for (int k = lane; k < DM; k += 64) mx = fmaxf(mx, fabsf(mod[(size_t)c * NMODC + k]));
#pragma unroll
        for (int o = 1; o < 64; o <<= 1) mx = fmaxf(mx, __shfl_xor(mx, o));
        if (lane == 0) red[c] = fmaxf(mx, 1e-30f) * (1.0f / 127.0f); }
    __syncthreads();
    for (int i = tid; i < NCOND * DM; i += 512) { const int c = i >> 11, k = i & 2047; const float s0 = red[c], s1 = s0 * (1.0f / 127.0f), v = mod[(size_t)c * NMODC + k];
        const float d0 = rintf(v / s0), d1 = rintf((v - d0 * s0) / s1); const int off = ((k >> 6) * 16 + c) * 64 + (k & 63);
        D[off] = (unsigned char)(int)d0; D[32768 + off] = (unsigned char)(int)d1; }
    __syncthreads();
    const unsigned char* Bq = ws + WS_W + (size_t)l * W_LAYER + W_WI + (size_t)f * 44 * MiB;
    const float* swv = (const float*)(ws + WS_Q + Q_SW) + (size_t)(2 * l + f) * NFF;
    float* sb = (float*)(ws + WS_SB) + (size_t)l * SB_LAYER + (f ? SB_J2 : 0);
    const int jr = lane & 15, g = lane >> 4;
    for (int rg = sub * 8 + wave; rg < NFF / 16; rg += nsub * 8) {
        const int n = rg * 16 + jr;
        const unsigned char* wp = Bq + ((size_t)(n >> 8) * (DM >> 7) * 256 + (n & 255)) * 128 + 16 * g;
        i32x4_t a0 = {0, 0, 0, 0}, a1 = {0, 0, 0, 0};
#pragma unroll 4
        for (int kb = 0; kb < 32; ++kb) {
            const i32x4_t w = *(const i32x4_t*)(wp + (size_t)(kb >> 1) * 256 * 128 + (kb & 1) * 64);
            const i32x4_t d0 = *(const LAS i32x4_t*)(D + ((kb * 16 + jr) * 64 + 16 * g)), d1 = *(const LAS i32x4_t*)(D + 32768 + ((kb * 16 + jr) * 64 + 16 * g));
            a0 = __builtin_amdgcn_mfma_i32_16x16x64_i8(w, d0, a0, 0, 0, 0); a1 = __builtin_amdgcn_mfma_i32_16x16x64_i8(w, d1, a1, 0, 0, 0);
        }
        if (jr < NCOND) { const float s0 = red[jr], s1 = s0 * (1.0f / 127.0f);
#pragma unroll
            for (int r = 0; r < 4; ++r) { const int nn = rg * 16 + 4 * g + r; sb[(size_t)jr * NFF + nn] = swv[nn] * (s0 * (float)a0[r] + s1 * (float)a1[r]); } }
    }
    __syncthreads();
}
__device__ __forceinline__ void bias_phase(unsigned char* ws, LAS unsigned char* lds, int G, int wg, int tid) {
    const int lane = tid & 63, wave = tid >> 6, gw = wg * 8 + wave, NGW = G * 8;
    LAS float* sh = (LAS float*)lds;
    const float* tab = (const float*)(ws + WS_TAB);
    const int per = G / 4; const bool mf = per >= 1;
    if (mf && wg < 4 * per) bias_ffn_mfma(ws, lds, wg / per, wg % per, per, tid);
    for (int grp = 0; grp < 6; ++grp) {
        const int l = grp / 3, j = grp % 3, N = (j == 1) ? NIN : NFF;
        if (mf && j != 1) continue;
        const bf16* Bt = (const bf16*)(ws + WS_W + (size_t)l * W_LAYER + (j == 0 ? W_WI : j == 1 ? W_WIN : W_WI + 44 * MiB));
        float* sb = (float*)(ws + WS_SB) + (size_t)l * SB_LAYER + (j == 0 ? 0 : j == 1 ? SB_J1 : SB_J2);
        const float* mod = tab + TB_MOD + (size_t)l * NCOND * NMODC + (size_t)(3 * j) * DM;
        __syncthreads();
        for (int i = tid; i < NCOND * DM; i += 512) sh[i] = mod[(size_t)(i >> 11) * NMODC + (i & 2047)];
        __syncthreads();
        if (j != 1) {
            const unsigned char* Bq = (const unsigned char*)Bt; const float* swv = (const float*)(ws + WS_Q + Q_SW) + (size_t)(2 * l + (j >> 1)) * NFF;
            for (int n = gw; n < N; n += NGW) {
                v4u wr2[2];
#pragma unroll
                for (int q = 0; q < 2; ++q) { const int k_ = 16 * (lane + 64 * q); wr2[q] = *(const v4u*)(Bq + ((size_t)((n >> 8) * (DM >> 7) + (k_ >> 7)) * 256 + (n & 255)) * 128 + (k_ & 127)); }
                float wf[2][16];
#pragma unroll
                for (int q = 0; q < 2; ++q) { const unsigned ww[4] = {wr2[q].x, wr2[q].y, wr2[q].z, wr2[q].w};
#pragma unroll
                    for (int e = 0; e < 16; ++e) wf[q][e] = (float)(int)(signed char)((ww[e >> 2] >> (8 * (e & 3))) & 0xffu); }
                const float swn = swv[n];
#pragma unroll 1
                for (int c = 0; c < NCOND; ++c) { float a = 0.f;
#pragma unroll
                    for (int q = 0; q < 2; ++q) { const int k = 16 * (lane + 64 * q);
#pragma unroll
                        for (int e4 = 0; e4 < 4; ++e4) { const f32x4 s0 = *(const LAS f32x4*)(sh + c * DM + k + 4 * e4); a += (s0[0] * wf[q][4 * e4] + s0[1] * wf[q][4 * e4 + 1]) + (s0[2] * wf[q][4 * e4 + 2] + s0[3] * wf[q][4 * e4 + 3]); } }
                    const float t = wave_sum(a); if (lane == 0) sb[(size_t)c * N + n] = t * swn; }
            }
            continue;
        }
        v4u wq[4];
        if (gw < N) {
#pragma unroll
            for (int q = 0; q < 4; ++q) { const int k_ = 8 * (lane + 64 * q); wq[q] = *(const v4u*)(Bt + ((size_t)((gw >> 8) * (DM >> 6) + (k_ >> 6)) * 256 + (gw & 255)) * 64 + (k_ & 63)); } }
        for (int n = gw; n < N; n += NGW) {
            v4u wc_[4];
#pragma unroll
            for (int q = 0; q < 4; ++q) wc_[q] = wq[q];
            if (n + NGW < N) {
#pragma unroll
                for (int q = 0; q < 4; ++q) { const int k_ = 8 * (lane + 64 * q), n_ = n + NGW; wq[q] = *(const v4u*)(Bt + ((size_t)((n_ >> 8) * (DM >> 6) + (k_ >> 6)) * 256 + (n_ & 255)) * 64 + (k_ & 63)); } }
            float wf[4][8];
#pragma unroll
            for (int q = 0; q < 4; ++q) { const v4u w4 = wc_[q];
                wf[q][0] = __uint_as_float(w4.x << 16); wf[q][1] = __uint_as_float(w4.x & 0xffff0000u); wf[q][2] = __uint_as_float(w4.y << 16); wf[q][3] = __uint_as_float(w4.y & 0xffff0000u);
                wf[q][4] = __uint_as_float(w4.z << 16); wf[q][5] = __uint_as_float(w4.z & 0xffff0000u); wf[q][6] = __uint_as_float(w4.w << 16); wf[q][7] = __uint_as_float(w4.w & 0xffff0000u); }
#pragma unroll 1
            for (int c = 0; c < NCOND; ++c) { float a = 0.f;
#pragma unroll
                for (int q = 0; q < 4; ++q) { const int k = 8 * (lane + 64 * q); const f32x4 s0 = *(const LAS f32x4*)(sh + c * DM + k), s1 = *(const LAS f32x4*)(sh + c * DM + k + 4);
                    a += (s0[0] * wf[q][0] + s0[1] * wf[q][1]) + (s0[2] * wf[q][2] + s0[3] * wf[q][3]) + (s1[0] * wf[q][4] + s1[1] * wf[q][5]) + (s1[2] * wf[q][6] + s1[3] * wf[q][7]); }
                const float t = wave_sum(a); if (lane == 0) sb[(size_t)c * N + n] = t; }
        }
    }
    __syncthreads();
}
__device__ __forceinline__ void final_norm(float* x, const float* fw, int G, int wg, int tid) {
    const int lane = tid & 63, wave = tid >> 6, gw = wg * 8 + wave, NGW = G * 8;
    for (int m = gw; m < MTOK; m += NGW) {
        float* xr = x + (size_t)m * DM; f32x4 v[8]; float ss = 0.f;
#pragma unroll
        for (int j = 0; j < 8; ++j) { v[j] = *(const f32x4*)(xr + 256 * j + 4 * lane); ss += (v[j][0] * v[j][0] + v[j][1] * v[j][1]) + (v[j][2] * v[j][2] + v[j][3] * v[j][3]); }
        const float rstd = rsqrtf(wave_sum(ss) * (1.0f / DM) + EPS);
#pragma unroll
        for (int j = 0; j < 8; ++j) { const int c = 256 * j + 4 * lane; *(f32x4*)(xr + c) = (v[j] * rstd) * *(const f32x4*)(fw + c); }
    }
}
__device__ __forceinline__ void prep_row(int m, int l, bf16* PROJ, bf16* DST, const float* tab, const float* qkw  , float* out, int lane) {
    bf16* pr = PROJ + (size_t)m * NIN; bf16* pw = DST + (size_t)m * NIN;
    const bool lat = m >= M_P; const int t = lat ? ((m - M_P) & 4095) : (m & 255), b = lat ? ((m - M_P) >> 12) : (m >> 8);
    const int rr = t >> 6, cc = t & 63;
    unsigned rg[10], rd[8], rv2[2], rv4[4];
#pragma unroll
    for (int v = 0; v < 10; ++v) rg[v] = *(const unsigned*)(pr + (v < 8 ? C_GQ + 128 * v : C_GK + 128 * (v - 8)) + 2 * lane);
#pragma unroll
    for (int v = 0; v < 8; ++v) rd[v] = *(const unsigned*)(pr + (v < 4 ? C_DQ + 128 * v : C_DK + 128 * (v - 4)) + 2 * lane);
    if (!lat) {
#pragma unroll
        for (int v = 0; v < 2; ++v) rv2[v] = *(const unsigned*)(pr + C_GV + 128 * v + 2 * lane);
#pragma unroll
        for (int v = 0; v < 4; ++v) rv4[v] = *(const unsigned*)(pr + C_DV + 128 * v + 2 * lane);
    }
    const float wq0 = qkw[2 * lane], wq1 = qkw[2 * lane + 1], wk0 = qkw[128 + 2 * lane], wk1 = qkw[128 + 2 * lane + 1];
    float cs = 1.f, sn = 0.f, c2 = 1.f, s2 = 0.f;
    if (lat) { const int idx = lane < 32 ? rr * 32 + lane : cc * 32 + (lane - 32); cs = tab[TB_COSG + idx]; sn = tab[TB_SING + idx];
               const int p = lane & 31, id2 = p < 16 ? rr * 16 + p : cc * 16 + (p - 16); c2 = tab[TB_COSD + id2]; s2 = tab[TB_SIND + id2]; }
#pragma unroll
    for (int v = 0; v < 10; ++v) {
        const int col = (v < 8 ? C_GQ + 128 * v : C_GK + 128 * (v - 8)) + 2 * lane;
        const float x1 = bf2f((unsigned short)(rg[v] & 0xffffu)), x2 = bf2f((unsigned short)(rg[v] >> 16));
        const float rs = rsqrtf(wave_sum(x1 * x1 + x2 * x2) * (1.0f / 128.0f) + EPS);
        const float y1 = x1 * rs * (v < 8 ? wq0 : wk0), y2 = x2 * rs * (v < 8 ? wq1 : wk1);
        if (!lat && v >= 8) { float* o = out + O_GK + (((size_t)(b * 2 + l) * 256 + t) * 2 + (v - 8)) * 128 + 2 * lane; o[0] = y1; o[1] = y2; }
        const float qs = v < 8 ? 0.12751743f : 1.0f;
        *(unsigned*)(pw + col) = pkbf((y1 * cs - y2 * sn) * qs, (y1 * sn + y2 * cs) * qs);
    }
    if (lat) {
#pragma unroll
        for (int v = 0; v < 8; ++v) { const int col = (v < 4 ? C_DQ + 128 * v : C_DK + 128 * (v - 4)) + 2 * lane;
            const float x1 = bf2f((unsigned short)(rd[v] & 0xffffu)), x2 = bf2f((unsigned short)(rd[v] >> 16));
            *(unsigned*)(pw + col) = pkbf(x1 * c2 - x2 * s2, x1 * s2 + x2 * c2); }
    } else {
#pragma unroll
        for (int v = 0; v < 2; ++v) { float* o = out + O_GV + (((size_t)(b * 2 + l) * 256 + t) * 2 + v) * 128 + 2 * lane; o[0] = bf2f((unsigned short)(rv2[v] & 0xffffu)); o[1] = bf2f((unsigned short)(rv2[v] >> 16)); }
#pragma unroll
        for (int v = 0; v < 4; ++v) { const unsigned rk = rd[4 + v], rv = rv4[v];
            const size_t oi = (((size_t)(b * 2 + l) * 256 + t) * 4 + v) * 128 + 2 * lane;
            out[O_DK + oi] = bf2f((unsigned short)(rk & 0xffffu)); out[O_DK + oi + 1] = bf2f((unsigned short)(rk >> 16));
            out[O_DV + oi] = bf2f((unsigned short)(rv & 0xffffu)); out[O_DV + oi + 1] = bf2f((unsigned short)(rv >> 16)); }
    }
}
#ifndef EN_PRO
#define EN_PRO 1
#endif
#ifndef EN_NORM
#define EN_NORM 1
#endif
#ifndef EN_FFNIN
#define EN_FFNIN 1
#endif
#ifndef EN_FFNOUT
#define EN_FFNOUT 1
#endif
#ifndef EN_WIN
#define EN_WIN 1
#endif
#ifndef EN_P
#define EN_P 1
#endif
#ifndef EN_A
#define EN_A 1
#endif
#ifndef EN_A1
#define EN_A1 1
#endif
#ifndef EN_A2
#define EN_A2 1
#endif
#ifndef EN_A3
#define EN_A3 1
#endif
#ifndef EN_WOUT
#define EN_WOUT 1
#endif
#ifndef EN_FIN
#define EN_FIN 1
#endif
struct Args { const float* in[22]; float* out; unsigned char* ws; int ph_lo, ph_hi, pad0, pad1; };
constexpr int NPHASE = 30;
#define LAUNDER(p) asm volatile("" : "+s"(p))
struct InPtrs { const float* const* p; __device__ __forceinline__ const float* operator[](int i) const { return p[i]; } };
__device__ __forceinline__ int deal_unit(int i, int NL, int NC, int off, int G, int wg) {
    if (NL % G == 0) { const int nr = NL / G; if (i < nr) return i * G + wg; if (i > nr) return -1; const int c = (wg + G - off) % G; return c < NC ? NL + c : -1; }
    const int v = i * G + wg; return v < NL + NC ? v : -1;
}
__global__ void __launch_bounds__(512, 2) fwd_kernel(Args args) {
    extern __shared__ __attribute__((aligned(16))) unsigned char lds_raw[];
    LAS unsigned char* lds = (LAS unsigned char*)lds_raw;
    volatile LAS unsigned* MISC = (volatile LAS unsigned*)(lds + MISC_OFF);
    const int G = gridDim.x, wg = blockIdx.x;
    for (int u = threadIdx.x; u < (LDS_BYTES - 131072) / 4; u += 512) ((LAS unsigned*)(lds + 131072))[u] = 0u;
    __syncthreads();
    XcdBarrier bar = xcd_barrier_post((unsigned*)(args.ws + WS_CTL) + CW_BAR, MISC + 8);
    const int lo = args.ph_lo, hi = args.ph_hi;
#define IN(k) (lo <= (k) && (k) < hi)
#define SEAM(k) do { if (IN(k) && IN((k) + 1)) xcd_barrier(bar); } while (0)
#define PH_BEGIN size_t zoff_ = 0; asm volatile("" : "+s"(zoff_)); unsigned char* ws = args.ws + zoff_; float* out = args.out + zoff_;   \
    const InPtrs inp{args.in}; int tid = threadIdx.x; asm volatile("" : "+v"(tid)); \
    const int lane = tid & 63, wave = __builtin_amdgcn_readfirstlane(tid >> 6); (void)lane; (void)wave;

    if (IN(0)) { PH_BEGIN; (void)out; prologue(inp, ws, lds, G, wg, tid); }
    SEAM(0);
    if (IN(1)) { PH_BEGIN; (void)out; prologue_b(inp, ws, lds, G, wg, tid); }
    SEAM(1);
    if (IN(2)) { PH_BEGIN; (void)out;
        quant_phase(inp[0], inp[1] - (size_t)M_P * DM, inp[11], (const float*)(ws + WS_TAB) + TB_MOD + DM, ws + WS_XNB, (float*)(ws + WS_Q), (unsigned long long*)(ws + WS_RS), G, wg, tid);
        bias_phase(ws, lds, G, wg, tid); }
    SEAM(2);
#pragma unroll 1
    for (int l = 0; l < 2; ++l) {
        const int pb = 3 + 13 * l;
#pragma unroll 1
        for (int f = 0; f < 2; ++f) {
            const int fb = pb + 9 * f;
            if (IN(fb + 0)) { PH_BEGIN; (void)out; (void)inp; const bf16* WL = (const bf16*)(ws + WS_W + (size_t)l * W_LAYER);
                pg8::Gemm g{(const bf16*)(ws + WS_XNB), WL + (W_WI + (size_t)f * 44 * MiB) / 2, MTOK, NFF, DM / 2}; pg8::StaticOrder S; S.init(MTOK, NFF, G, wg);
                pg8::EpiSwiGLUQ E{ws + WS_A8B, DFF, (const unsigned long long*)(ws + WS_RS) + (size_t)(3 * l + 2 * f) * MTOK, (const float*)(ws + WS_Q), (const float*)(ws + WS_Q + Q_SW) + (size_t)(2 * l + f) * NFF,
                                  (const float*)(ws + WS_SB) + (size_t)l * SB_LAYER + (f ? SB_J2 : 0), NFF, (const float*)(ws + WS_Q + Q_ACT) + 2 * (2 * l + f)};
                pg8::gemm_phase<pg8::EpiSwiGLUQ, pg8::StaticOrder, true, true, true>(lds, g, S, E); }
            if (IN(fb + 0) && IN(fb + 2)) xcd_barrier(bar);
            if (IN(fb + 2)) { PH_BEGIN; float* X = out + O_X; const bool first = (l == 0 && f == 0); const unsigned char* WL8 = ws + WS_W + (size_t)l * W_LAYER + W_WO + (size_t)f * 22 * MiB;
                const float* tabf = (const float*)(ws + WS_TAB); const float* mod = tabf + TB_MOD + (size_t)l * NCOND * NMODC;
                pg8::Gemm g{(const bf16*)(ws + WS_A8B), (const bf16*)WL8, MTOK, DM, DFF / 2}; pg8::StaticOrder S; S.init(MTOK, DM, G, wg);
                const int ni = f ? 3 * (l + 1) : 3 * l + 1;
                const size_t rs_off = WS_RS + (size_t)ni * MTOK * 8;
                pg8::EpiResidN E{first ? inp[0] : X, first ? inp[1] - (size_t)M_P * DM : X, X, mod + (2 + 6 * f) * DM,
                                 inp[11] + (size_t)(f ? 3 : 3 * l + 1) * DM, f ? tabf + TB_MOD + (size_t)NCOND * NMODC + DM : mod + (size_t)4 * DM, (unsigned long long*)(ws + rs_off), (long)(f ? WS_ACT : WS_XN) - (long)rs_off, 0.5f, (f && l) ? 0 : 1,
                                 (long)(WS_Q + Q_ACT + (size_t)(2 * (2 * l + f) + 1) * 4) - (long)rs_off, (long)(WS_Q + Q_SW2 + (size_t)(2 * l + f) * DM * 4) - (long)rs_off, 2, 1, (long)(WS_CTL + CTL_AMAX + (size_t)ni * MTOK * 4) - (long)rs_off};
                pg8::gemm_phase<pg8::EpiResidN, pg8::StaticOrder, true, true, 2>(lds, g, S, E); }
            SEAM(fb + 2);
            if (f == 1) {
                if (l == 0 && IN(pb + 12)) { PH_BEGIN; float* X = out + O_X;
                    (void)X; quant_xs_phase((const bf16*)(ws + WS_ACT), (const unsigned*)(ws + WS_CTL + CTL_AMAX) + (size_t)3 * MTOK, ws + WS_XNB, (float*)(ws + WS_Q), G, wg, tid); }
                SEAM(pb + 12);
                break; }
            if (IN(pb + 3)) { PH_BEGIN; float* X = out + O_X;
                (void)X; quant_xs_phase((const bf16*)(ws + WS_XN), (const unsigned*)(ws + WS_CTL + CTL_AMAX) + (size_t)(3 * l + 1) * MTOK, ws + WS_XNB, (float*)(ws + WS_Q), G, wg, tid, M_P); }
            SEAM(pb + 3);
            if (IN(pb + 4)) {
                { PH_BEGIN; (void)out; (void)inp;
                  pg8::Gemm g{(const bf16*)(ws + WS_XNB + (size_t)M_P * DM), (const bf16*)(ws + WS_W + (size_t)l * W_LAYER + W_WINQ), M_S, NIN, DM / 2}; pg8::StaticOrder S; S.init(M_S, NIN, G, wg);
                  pg8::EpiStoreQ E{(bf16*)(ws + WS_ACT) + (size_t)M_P * NIN, NIN, (const unsigned long long*)(ws + WS_RS) + (size_t)(3 * l + 1) * MTOK + M_P, (const float*)(ws + WS_Q) + M_P,
                                   (const float*)(ws + WS_Q + Q_SW4) + (size_t)l * NIN, (const float*)(ws + WS_SB) + (size_t)l * SB_LAYER + SB_J1, NIN, 16};
                  pg8::gemm_phase<pg8::EpiStoreQ, pg8::StaticOrder, true, true, true>(lds, g, S, E); }
                { PH_BEGIN; (void)out; (void)inp; const bf16* WL = (const bf16*)(ws + WS_W + (size_t)l * W_LAYER);
                  pg8::Gemm g{(const bf16*)(ws + WS_XN), WL + W_WIN / 2, M_P, NIN, DM}; pg8::StaticOrder S; S.init(M_P, NIN, G, wg);
                  pg8::EpiStoreBf16N E{(bf16*)(ws + WS_ACT), NIN, (const unsigned long long*)(ws + WS_RS) + (size_t)(3 * l + 1) * MTOK, (const float*)(ws + WS_SB) + (size_t)l * SB_LAYER + SB_J1, NIN};
                  pg8::gemm_phase<pg8::EpiStoreBf16N, pg8::StaticOrder, true, true>(lds, g, S, E); }
            }
            SEAM(pb + 4);
            if (IN(pb + 5)) { PH_BEGIN; bf16* PROJ = (bf16*)(ws + WS_ACT); const float* tab = (const float*)(ws + WS_TAB);
#pragma unroll 1
                for (int ch = wg; ch < 192; ch += G) {
                    const bool lat = ch < 64; const int cc = lat ? ch : ch - 64, dir = cc & 1, h = (cc >> 1) & 3, b = cc >> 3;
                    att::ChainArgs a; a.P = PROJ + (size_t)(lat ? M_P + b * 4096 : b * 256) * NIN; a.kcol = C_RK + 128 * h; a.vcol = C_RV + 128 * h; a.nchunk = lat ? 32 : 2; a.dir = dir;
                    a.lg2 = tab[TB_SCAL + 16 * l + 2 + dir * 4 + h];
                    a.S0 = lat ? inp[3] + ((((size_t)b * 2 + l) * 2 + dir) * 4 + h) * 16384 : nullptr;
                    a.ST = (bf16*)(ws + WS_ST) + (lat ? (size_t)cc * 32 * 16384 : (size_t)64 * 32 * 16384 + (size_t)cc * 2 * 16384);
                    a.Sfin = lat ? nullptr : out + O_STATE + ((((size_t)b * 2 + l) * 2 + dir) * 4 + h) * 16384;
                    __syncthreads(); att::ret_chain(a, (char*)lds_raw);
                }
                const int w0 = G > 128 ? 64 : 0, gw = (wg - w0) * 8 + wave, NGW = (G - w0) * 8;
                if (wg >= w0) for (int m = gw; m < MTOK; m += NGW) prep_row(m, l, PROJ, PROJ, tab, inp[18] + l * 256, out, lane);
            }
            SEAM(pb + 5);
            if (IN(pb + 6)) { PH_BEGIN; (void)out; bf16* PROJ = (bf16*)(ws + WS_ACT); bf16* MIX = (bf16*)(ws + WS_XN); const float* tab = (const float*)(ws + WS_TAB);
                const bf16* CGK = (const bf16*)(ws + WS_CACHE);
#pragma unroll 1
                for (int rp = 0; rp < ((PROBE == 13 && l == 0) ? 2 : 1); ++rp)
#pragma unroll 1
                for (int i2 = 0;; ++i2) { const int ps = i2 & 1; const int u = deal_unit(i2 >> 1, 512, 64, 192, G, wg); if (u < 0) break;
                    const bool lat = u < 512; const int v = lat ? u : u - 512;
                    const int qb = lat ? (v & 15) : 0, h = lat ? ((v >> 4) & 3) : (v & 3), b = lat ? (v >> 6) : (v >> 2);
                    const size_t row0 = lat ? (size_t)M_P + (size_t)b * 4096 : (size_t)b * 256;
                    const float lam = tab[TB_SCAL + 16 * l + 0], post = tab[TB_SCAL + 16 * l + 1];
                    {
                        att::KVSrc kv; kv.K1 = PROJ + row0 * NIN + C_DK + 128 * h + 64 * ps; kv.V1 = PROJ + row0 * NIN + C_DV + 128 * h; kv.n1 = lat ? 4096 : 256;
                        kv.K2 = CGK + 2097152 + ((size_t)(b * 2 + l) * 256) * 512 + 128 * h + 64 * ps; kv.V2 = CGK + 4194304 + ((size_t)(b * 2 + l) * 256) * 512 + 128 * h; kv.n2 = lat ? 256 : 0;
                        att::AttnOut ao; ao.Ob = MIX + (row0 + 256 * qb) * DM + 1536 + 128 * h; ao.Of = (float*)(ws + WS_DF) + (row0 + 256 * qb) * 512 + 128 * h;
                        ao.nw = inp[20] + l * 512 + 128 * h; ao.lam = lam; ao.post = post; ao.pass = ps;
                        __syncthreads();
                        att::attn_body<64, 1, 512>(PROJ + (row0 + 256 * qb) * NIN + C_DQ + 128 * h + 64 * ps, kv, ao, (char*)lds_raw);
                    }
                }
                const bool nomax = tab[TB_SCAL + 16 * l + 10] != 0.f;
#pragma unroll 1
                for (int rp = 0; rp < ((PROBE == 14 && l == 0) ? 2 : 1); ++rp)
#pragma unroll 1
                for (int i = 0;; ++i) { const int u = deal_unit(i, 1024, 128, 64, G, wg); if (u < 0) break;
                    const bool lat = u < 1024; const int v = lat ? u : u - 1024;
                    const int qb = lat ? (v & 15) : 0, hq = lat ? ((v >> 4) & 7) : (v & 7), b = lat ? (v >> 7) : (v >> 3), kvh = hq >> 2;
                    const size_t row0 = lat ? (size_t)M_P + (size_t)b * 4096 : (size_t)b * 256;
                    att::KVSrc kv; kv.K1 = PROJ + row0 * NIN + C_GK + 128 * kvh; kv.V1 = PROJ + row0 * NIN + C_GV + 128 * kvh; kv.n1 = lat ? 4096 : 256;
                    kv.K2 = CGK + ((size_t)(b * 2 + l) * 256) * 256 + 128 * kvh; kv.V2 = CGK + 1048576 + ((size_t)(b * 2 + l) * 256) * 256 + 128 * kvh; kv.n2 = lat ? 256 : 0;
                    att::AttnOut ao; ao.Ob = MIX + (row0 + 256 * qb) * DM + 512 + 128 * hq; ao.Of = nullptr; ao.nw = nullptr; ao.lam = 0.f; ao.post = 0.f; ao.pass = 0;
                    __syncthreads();
                    if (nomax) att::attn_body<128, 0, 256, 1>(PROJ + (row0 + 256 * qb) * NIN + C_GQ + 128 * hq, kv, ao, (char*)lds_raw);
                    else att::attn_body<128, 0, 256, 2>(PROJ + (row0 + 256 * qb) * NIN + C_GQ + 128 * hq, kv, ao, (char*)lds_raw);
                }
#pragma unroll 1
                for (int rp = 0; rp < ((PROBE == 15 && l == 0) ? 2 : 1); ++rp)
#pragma unroll 1
                for (int i = 0;; ++i) { const int u = deal_unit(i, 512, 64, 0, G, wg); if (u < 0) break;
                    const bool lat = u < 512; const int v = lat ? u : u - 512;
                    const int pr = lat ? (v & 15) : 0, h = lat ? ((v >> 4) & 3) : (v & 3), b = lat ? (v >> 6) : (v >> 2);
                    const size_t row0 = (lat ? (size_t)M_P + (size_t)b * 4096 : (size_t)b * 256) + 256 * pr;
                    att::RetCArgs a; a.P = PROJ + row0 * NIN; a.qcol = C_RQ + 128 * h; a.kcol = C_RK + 128 * h; a.vcol = C_RV + 128 * h; a.gcol = C_RG + 128 * h;
                    a.lg2f = tab[TB_SCAL + 16 * l + 2 + h]; a.lg2b = tab[TB_SCAL + 16 * l + 6 + h];
                    const int cf = (b * 4 + h) * 2; const bf16* STB = (const bf16*)(ws + WS_ST);
                    a.STf = STB + (lat ? (size_t)cf * 32 * 16384 : (size_t)64 * 32 * 16384 + (size_t)cf * 2 * 16384) + (size_t)(2 * pr) * 16384;
                    a.STb = STB + (lat ? (size_t)(cf + 1) * 32 * 16384 : (size_t)64 * 32 * 16384 + (size_t)(cf + 1) * 2 * 16384) + (size_t)(2 * pr) * 16384;
                    a.gnw = inp[17] + l * 512 + 128 * h; a.O = MIX + row0 * DM + 128 * h;
                    __syncthreads();
                    att::ret_c(a, (char*)lds_raw);
                }
            }
            SEAM(pb + 6);
            if (IN(pb + 7)) { PH_BEGIN; float* X = out + O_X; const bf16* WL = (const bf16*)(ws + WS_W + (size_t)l * W_LAYER);
                const float* mod = (const float*)(ws + WS_TAB) + TB_MOD + (size_t)l * NCOND * NMODC;
                pg8::Gemm g{(const bf16*)(ws + WS_XN), WL + W_WOUT / 2, MTOK, DM, DM}; pg8::StaticOrder S; S.init(MTOK, DM, G, wg);
                const size_t rs_off = WS_RS + (size_t)(3 * l + 2) * MTOK * 8;
                pg8::EpiResidN E{X, X, X, mod + 5 * DM, inp[11] + ((size_t)l * 3 + 2) * DM, mod + 7 * DM, (unsigned long long*)(ws + rs_off), (long)WS_ACT - (long)rs_off, 1.0f, 1, (long)WS_Q - (long)rs_off, (long)WS_Q - (long)rs_off, 0, 1, (long)(WS_CTL + CTL_AMAX + (size_t)(3 * l + 2) * MTOK * 4) - (long)rs_off};
                pg8::gemm_phase<pg8::EpiResidN, pg8::StaticOrder, true, true>(lds, g, S, E); }
            SEAM(pb + 7);
            if (IN(pb + 8)) { PH_BEGIN; float* X = out + O_X;
                (void)X; quant_xs_phase((const bf16*)(ws + WS_ACT), (const unsigned*)(ws + WS_CTL + CTL_AMAX) + (size_t)(3 * l + 2) * MTOK, ws + WS_XNB, (float*)(ws + WS_Q), G, wg, tid); }
            SEAM(pb + 8);
        }
    }
    if (IN(29)) { PH_BEGIN; (void)ws; final_norm(out + O_X, inp[21], G, wg, tid); }
#undef IN
#undef SEAM
#undef PH_BEGIN
}

extern "C" void kernel_launch(void* const* d_in, const int* in_sizes, int n_in, void* d_out, int out_size, void* d_ws, size_t ws_size, hipStream_t stream) {
    static int grid = 0;
    if (grid == 0) {
        if (n_in != 22 || out_size != (int)O_END || ws_size < WS_END) { fprintf(stderr, "kernel_launch: unexpected shapes: n_in %d out %d ws %zu (need %zu)\n", n_in, out_size, ws_size, (size_t)WS_END); grid = -1; return; }
        int dev = 0, cus = 0, per_cu = 0;
        if (hipGetDevice(&dev) != hipSuccess || hipDeviceGetAttribute(&cus, hipDeviceAttributeMultiprocessorCount, dev) != hipSuccess) { grid = -1; return; }
        if (hipFuncSetAttribute((const void*)fwd_kernel, hipFuncAttributeMaxDynamicSharedMemorySize, LDS_BYTES) != hipSuccess) { fprintf(stderr, "kernel_launch: hipFuncSetAttribute failed\n"); grid = -1; return; }
        if (hipOccupancyMaxActiveBlocksPerMultiprocessor(&per_cu, (const void*)fwd_kernel, 512, LDS_BYTES) != hipSuccess || per_cu < 1) { fprintf(stderr, "kernel_launch: occupancy query says %d\n", per_cu); }
        (void)hipGetLastError();
        grid = cus;
    }
    if (grid < 0) return;
    (void)hipMemsetAsync((char*)d_ws + WS_CTL, 0, CTL_ZERO_BYTES, stream);
    (void)hipMemsetAsync((char*)d_ws + WS_RS, 0, 2 * MiB, stream);
    Args a{};
    for (int i = 0; i < 22; ++i) a.in[i] = (const float*)d_in[i];
    a.out = (float*)d_out; a.ws = (unsigned char*)d_ws; a.ph_lo = 0; a.ph_hi = NPHASE; a.pad0 = 0; a.pad1 = 0;
    hipLaunchKernelGGL(fwd_kernel, dim3(grid), dim3(512), LDS_BYTES, stream, a);
}
```

```cpp
#include <hip/hip_runtime.h>
#include <hip/hip_bf16.h>
#include <cstdio>
#include <cstdint>
#ifndef PROBE
#define PROBE 0
#endif
#ifndef FFN_MB
#define FFN_MB 4
#endif
__device__ __forceinline__ float qm(float x) { if (FFN_MB >= 7) return x; unsigned u = __float_as_uint(x); constexpr unsigned sh = 23 - FFN_MB; u = (u + ((1u << (sh - 1)) - 1u) + ((u >> sh) & 1u)) & ~((1u << sh) - 1u); return __uint_as_float(u); }
#ifndef DBGT_CLK
#define DBGT_CLK 0
#endif
#ifndef DBGT_PH
#define DBGT_PH -1
#endif
namespace pg8 {
#define PG8_LAS __attribute__((address_space(3)))
typedef unsigned short bf16_t;
typedef short bf16x8 __attribute__((ext_vector_type(8)));
typedef float f32x4 __attribute__((ext_vector_type(4)));
typedef unsigned u32x4 __attribute__((ext_vector_type(4)));
typedef int i32x4 __attribute__((ext_vector_type(4)));
constexpr int BM = 256, BK = 64, HALF = 128, HTB = HALF * BK * 2  , STAGE_BYTES = 8 * HTB, NXCD = 8, WGM = 4;

__host__ __device__ __forceinline__ int lds_byte(int r, int c) { const int st = (r >> 4) * 2 + (c >> 5), rr = r & 15, cc = c & 31, ob = rr * 64 + cc * 2; return st * 1024 + (ob ^ (((ob >> 9) & 1) << 5)); }
__host__ __device__ __forceinline__ void stage_rc(int b, int& R, int& C) { const int st = b / 1024, sb = b % 1024, swz = sb ^ (((sb >> 9) & 1) << 5); R = (st >> 1) * 16 + swz / 64; C = (st & 1) * 32 + (swz % 64) / 2; }
__host__ __device__ __forceinline__ int perm32(int rho) { const int n = rho >> 4, i = rho & 15; return 8 * (i >> 2) + 4 * n + (i & 3); }

struct Unit { int pm, pn; };
struct Gemm { const bf16_t* A; const bf16_t* Bt; int M, N, K; };

struct StaticOrder {
    int nM, nN, nwg, G, c;
    __host__ __device__ void init(int M, int N, int G_, int c_) { nM = M / BM; nN = N / BM; nwg = nM * nN; G = G_; c = c_; }
    __host__ __device__ bool next(int i, Unit& u) const {
        const long L = (long)i * G + c; if (L >= nwg) return false;
        int wgid = (int)L; { const int q = nwg / NXCD, r = nwg % NXCD, xcd = wgid % NXCD, off = wgid / NXCD; wgid = (xcd < r ? xcd * (q + 1) : r * (q + 1) + (xcd - r) * q) + off; }
        const int nig = WGM * nN, gid = wgid / nig, fm = gid * WGM, gsz = (nM - fm) < WGM ? (nM - fm) : WGM;
        u.pm = fm + ((wgid % nig) % gsz); u.pn = (wgid % nig) / gsz; return true;
    }
    __device__ __forceinline__ void a_ready(const Unit&) const {}
    __device__ __forceinline__ void done(const Unit&) const {}
};

__device__ __forceinline__ unsigned cvt_pk_bf16(float lo, float hi) { unsigned r; asm volatile("v_cvt_pk_bf16_f32 %0, %1, %2" : "=v"(r) : "v"(lo), "v"(hi)); return r; }
typedef float f32x2 __attribute__((ext_vector_type(2)));
struct EpiStoreBf16 {
    static constexpr bool PERM = true, AFTER_DRAIN = false;
    bf16_t* O; int ldc;
    __device__ __forceinline__ void operator()(const f32x4 (&acc)[2][2][4][2], const Unit& u, int wr, int wc, int fr, int fq) const {
        const int row0 = u.pm * BM + wr * 64 + fr, col0 = u.pn * BM + wc * 32 + 8 * fq;
#pragma unroll
        for (int ai = 0; ai < 2; ++ai)
#pragma unroll
            for (int m = 0; m < 4; ++m) { bf16_t* rowp = O + (size_t)(row0 + ai * HALF + m * 16) * ldc + col0;
#pragma unroll
                for (int bj = 0; bj < 2; ++bj) { const f32x4 v0 = acc[ai][bj][m][0], v1 = acc[ai][bj][m][1];
                    u32x4 w; w.x = cvt_pk_bf16(v0[0], v0[1]); w.y = cvt_pk_bf16(v0[2], v0[3]); w.z = cvt_pk_bf16(v1[0], v1[1]); w.w = cvt_pk_bf16(v1[2], v1[3]);
                    *(u32x4*)(rowp + bj * HALF) = w; } }
    }
};
__device__ __forceinline__ float silu_f(float g) { return g * __builtin_amdgcn_rcpf(1.0f + __builtin_amdgcn_exp2f(-1.4426950408889634f * g)); }
struct EpiSwiGLU {
    static constexpr bool PERM = true, AFTER_DRAIN = false;
    bf16_t* O; int ldc;
    __device__ __forceinline__ void operator()(const f32x4 (&acc)[2][2][4][2], const Unit& u, int wr, int wc, int fr, int fq) const {
        const int row0 = u.pm * BM + wr * 64 + fr, col0 = u.pn * HALF + wc * 32 + 8 * fq;
#pragma unroll
        for (int ai = 0; ai < 2; ++ai)
#pragma unroll
            for (int m = 0; m < 4; ++m) { bf16_t* rowp = O + (size_t)(row0 + ai * HALF + m * 16) * ldc + col0;
                const f32x4 g0 = acc[ai][0][m][0], g1 = acc[ai][0][m][1], u0 = acc[ai][1][m][0], u1 = acc[ai][1][m][1];
                u32x4 w; w.x = cvt_pk_bf16(silu_f(g0[0]) * u0[0], silu_f(g0[1]) * u0[1]); w.y = cvt_pk_bf16(silu_f(g0[2]) * u0[2], silu_f(g0[3]) * u0[3]);
                w.z = cvt_pk_bf16(silu_f(g1[0]) * u1[0], silu_f(g1[1]) * u1[1]); w.w = cvt_pk_bf16(silu_f(g1[2]) * u1[2], silu_f(g1[3]) * u1[3]);
                *(u32x4*)rowp = w; }
    }
};
struct EpiResid {
    static constexpr bool PERM = false, AFTER_DRAIN = false;
    const float* baseP; const float* baseS; float* out; const float* gate; float coef;
    __device__ __forceinline__ void operator()(const f32x4 (&acc)[2][2][4][2], const Unit& u, int wr, int wc, int fr, int fq) const {
        const int cond = u.pm < 16 ? 0 : 1 + ((u.pm - 16) >> 4);
        const float* g = gate + (size_t)cond * 18432; const float* base = u.pm < 16 ? baseP : baseS;
        const int row0 = u.pm * BM + wr * 64 + fr, col0 = u.pn * BM + wc * 32 + 4 * fq;
        f32x4 gv[2][2];
#pragma unroll
        for (int bj = 0; bj < 2; ++bj)
#pragma unroll
            for (int n = 0; n < 2; ++n) gv[bj][n] = *(const f32x4*)(g + col0 + bj * HALF + n * 16) * coef;
#pragma unroll
        for (int ai = 0; ai < 2; ++ai)
#pragma unroll
            for (int m = 0; m < 4; ++m) { const size_t off = (size_t)(row0 + ai * HALF + m * 16) * 2048 + col0;
#pragma unroll
                for (int bj = 0; bj < 2; ++bj)
#pragma unroll
                    for (int n = 0; n < 2; ++n) { const f32x4 b = *(const f32x4*)(base + off + bj * HALF + n * 16);
                        *(f32x4*)(out + off + bj * HALF + n * 16) = b + gv[bj][n] * acc[ai][bj][m][n]; }
                if (m == 3) asm volatile("" ::: "memory"); }
    }
};

__device__ __forceinline__ float rstd_of(const unsigned long long* rss, int row) { return rsqrtf((float)rss[row] * (1.0f / 16777216.0f) * (1.0f / 2048.0f) + 1e-6f); }
struct EpiStoreBf16N {
    static constexpr bool PERM = true, AFTER_DRAIN = false;
    bf16_t* O; int ldc; const unsigned long long* rss; const float* bias; int ldb;
    __device__ __forceinline__ void operator()(const f32x4 (&acc)[2][2][4][2], const Unit& u, int wr, int wc, int fr, int fq) const {
        const int cond = u.pm < 16 ? 0 : 1 + ((u.pm - 16) >> 4);
        const int row0 = u.pm * BM + wr * 64 + fr, col0 = u.pn * BM + wc * 32 + 8 * fq;
        const float* b = bias + (size_t)cond * ldb + col0;
        f32x4 bv[2][2];
#pragma unroll
        for (int bj = 0; bj < 2; ++bj)
#pragma unroll
            for (int n = 0; n < 2; ++n) bv[bj][n] = *(const f32x4*)(b + bj * HALF + 4 * n);
#pragma unroll
        for (int ai = 0; ai < 2; ++ai)
#pragma unroll
            for (int m = 0; m < 4; ++m) { const int row = row0 + ai * HALF + m * 16; const float rs = rstd_of(rss, row); bf16_t* rowp = O + (size_t)row * ldc + col0;
#pragma unroll
                for (int bj = 0; bj < 2; ++bj) { const f32x4 v0 = acc[ai][bj][m][0] * rs + bv[bj][0], v1 = acc[ai][bj][m][1] * rs + bv[bj][1];
                    u32x4 w; w.x = cvt_pk_bf16(v0[0], v0[1]); w.y = cvt_pk_bf16(v0[2], v0[3]); w.z = cvt_pk_bf16(v1[0], v1[1]); w.w = cvt_pk_bf16(v1[2], v1[3]);
                    *(u32x4*)(rowp + bj * HALF) = w; } }
    }
};
struct EpiSwiGLUN {
    static constexpr bool PERM = true, AFTER_DRAIN = false;
    bf16_t* O; int ldc; const unsigned long long* rss; const float* bias; int ldb;
    __device__ __forceinline__ void operator()(const f32x4 (&acc)[2][2][4][2], const Unit& u, int wr, int wc, int fr, int fq) const {
        const int cond = u.pm < 16 ? 0 : 1 + ((u.pm - 16) >> 4);
        const int row0 = u.pm * BM + wr * 64 + fr, col0 = u.pn * HALF + wc * 32 + 8 * fq;
        const float* b = bias + (size_t)cond * ldb + u.pn * BM + wc * 32 + 8 * fq;
        const f32x4 bg0 = *(const f32x4*)(b), bg1 = *(const f32x4*)(b + 4), bu0 = *(const f32x4*)(b + HALF), bu1 = *(const f32x4*)(b + HALF + 4);
#pragma unroll
        for (int ai = 0; ai < 2; ++ai)
#pragma unroll
            for (int m = 0; m < 4; ++m) { const int row = row0 + ai * HALF + m * 16; const float rs = rstd_of(rss, row); bf16_t* rowp = O + (size_t)row * ldc + col0;
                const f32x4 g0 = acc[ai][0][m][0] * rs + bg0, g1 = acc[ai][0][m][1] * rs + bg1, u0 = acc[ai][1][m][0] * rs + bu0, u1 = acc[ai][1][m][1] * rs + bu1;
                u32x4 w; w.x = cvt_pk_bf16(qm(silu_f(g0[0]) * u0[0]), qm(silu_f(g0[1]) * u0[1])); w.y = cvt_pk_bf16(qm(silu_f(g0[2]) * u0[2]), qm(silu_f(g0[3]) * u0[3]));
                w.z = cvt_pk_bf16(qm(silu_f(g1[0]) * u1[0]), qm(silu_f(g1[1]) * u1[1])); w.w = cvt_pk_bf16(qm(silu_f(g1[2]) * u1[2]), qm(silu_f(g1[3]) * u1[3]));
                *(u32x4*)rowp = w; }
    }
};
struct EpiStoreQ {
    static constexpr bool PERM = true, AFTER_DRAIN = false;
    bf16_t* O; int ldc; const unsigned long long* rss; const float* sa; const float* sw; const float* bias; int ldb; int pm_off;
    __device__ __forceinline__ void operator()(const f32x4 (&acc)[2][2][4][2], const Unit& u, int wr, int wc, int fr, int fq) const {
        const int pmg = u.pm + pm_off, cond = pmg < 16 ? 0 : 1 + ((pmg - 16) >> 4);
        const int row0 = u.pm * BM + wr * 64 + fr, col0 = u.pn * BM + wc * 32 + 8 * fq;
        const float* b = bias + (size_t)cond * ldb + col0; const float* w = sw + col0;
        f32x4 bv[2][2], wv[2][2];
#pragma unroll
        for (int bj = 0; bj < 2; ++bj)
#pragma unroll
            for (int n = 0; n < 2; ++n) { bv[bj][n] = *(const f32x4*)(b + bj * HALF + 4 * n); wv[bj][n] = *(const f32x4*)(w + bj * HALF + 4 * n); }
#pragma unroll
        for (int ai = 0; ai < 2; ++ai)
#pragma unroll
            for (int m = 0; m < 4; ++m) { const int row = row0 + ai * HALF + m * 16; const float rs = rstd_of(rss, row) * sa[row]; bf16_t* rowp = O + (size_t)row * ldc + col0;
#pragma unroll
                for (int bj = 0; bj < 2; ++bj) { const f32x4 v0 = acc[ai][bj][m][0] * rs * wv[bj][0] + bv[bj][0], v1 = acc[ai][bj][m][1] * rs * wv[bj][1] + bv[bj][1];
                    u32x4 w4; w4.x = cvt_pk_bf16(v0[0], v0[1]); w4.y = cvt_pk_bf16(v0[2], v0[3]); w4.z = cvt_pk_bf16(v1[0], v1[1]); w4.w = cvt_pk_bf16(v1[2], v1[3]);
                    *(u32x4*)(rowp + bj * HALF) = w4; } }
    }
};
__device__ __forceinline__ float sat448(float x) { return __builtin_fminf(__builtin_fmaxf(x, -448.0f), 448.0f); }
__device__ __forceinline__ f32x4 swiglu4(const f32x4 g, const f32x4 u) {
    const f32x4 t = g * -1.4426950408889634f; f32x4 e;
#pragma unroll
    for (int i = 0; i < 4; ++i) e[i] = __builtin_amdgcn_exp2f(t[i]);
    const f32x4 d = e + 1.0f; f32x4 r;
#pragma unroll
    for (int i = 0; i < 4; ++i) r[i] = __builtin_amdgcn_rcpf(d[i]);
    return (g * u) * r;
}
struct EpiSwiGLUQ {
    static constexpr bool PERM = true, AFTER_DRAIN = false;
    unsigned char* O; int ldc; const unsigned long long* rss; const float* sa; const float* sw; const float* bias; int ldb; const float* act_s;
    __device__ __forceinline__ void operator()(const f32x4 (&acc)[2][2][4][2], const Unit& u, int wr, int wc, int fr, int fq) const {
        const int cond = u.pm < 16 ? 0 : 1 + ((u.pm - 16) >> 4);
        const int row0 = u.pm * BM + wr * 64 + fr, col0 = u.pn * HALF + wc * 32 + 8 * fq, bcol = u.pn * BM + wc * 32 + 8 * fq;
        const float* b = bias + (size_t)cond * ldb + bcol; const float* w = sw + bcol;
        const f32x4 bg0 = *(const f32x4*)(b), bg1 = *(const f32x4*)(b + 4), bu0 = *(const f32x4*)(b + HALF), bu1 = *(const f32x4*)(b + HALF + 4);
        const f32x4 wg0 = *(const f32x4*)(w), wg1 = *(const f32x4*)(w + 4), wu0 = *(const f32x4*)(w + HALF), wu1 = *(const f32x4*)(w + HALF + 4);
        const float as = act_s[0];
#pragma unroll
        for (int ai = 0; ai < 2; ++ai)
#pragma unroll
            for (int m = 0; m < 4; ++m) { const int row = row0 + ai * HALF + m * 16; const float rs = rstd_of(rss, row) * sa[row]; unsigned char* rowp = O + (size_t)row * ldc + col0;
                const f32x4 g0 = acc[ai][0][m][0] * rs * wg0 + bg0, g1 = acc[ai][0][m][1] * rs * wg1 + bg1, u0 = (acc[ai][1][m][0] * rs * wu0 + bu0) * as, u1 = (acc[ai][1][m][1] * rs * wu1 + bu1) * as;
                const f32x4 h0 = swiglu4(g0, u0), h1 = swiglu4(g1, u1);
                unsigned w0 = __builtin_amdgcn_cvt_pk_fp8_f32(sat448(h0[0]), sat448(h0[1]), 0, false); w0 = __builtin_amdgcn_cvt_pk_fp8_f32(sat448(h0[2]), sat448(h0[3]), w0, true);
                unsigned w1 = __builtin_amdgcn_cvt_pk_fp8_f32(sat448(h1[0]), sat448(h1[1]), 0, false); w1 = __builtin_amdgcn_cvt_pk_fp8_f32(sat448(h1[2]), sat448(h1[3]), w1, true);
                uint2 wv; wv.x = w0; wv.y = w1; *(uint2*)rowp = wv; }
    }
};
struct EpiResidN {
    static constexpr bool PERM = false, AFTER_DRAIN = false;
    const float* baseP; const float* baseS; float* out; const float* gate; const float* nw; const float* scl; unsigned long long* rss; long xs_delta;   float coef; int do_xs; long sa_delta, sw_delta; int q8; int xs_all = 0; long am_delta = 0;
    __device__ __forceinline__ void operator()(const f32x4 (&acc)[2][2][4][2], const Unit& u, int wr, int wc, int fr, int fq) const {
        const int cond = u.pm < 16 ? 0 : 1 + ((u.pm - 16) >> 4); const int do_xs = (this->do_xs && (xs_all || u.pm < 16)) ? this->do_xs : 0;     bf16_t* xs = (bf16_t*)((char*)rss + xs_delta); const float* sa = (const float*)((char*)rss + sa_delta); const float* swc = (const float*)((char*)rss + sw_delta);
        const float* g = gate + (size_t)cond * 18432; const float* base = u.pm < 16 ? baseP : baseS;
        const int row0 = u.pm * BM + wr * 64 + fr, col0 = u.pn * BM + wc * 32 + 4 * fq;
        f32x4 gv[2][2], av[2][2];
#pragma unroll
        for (int bj = 0; bj < 2; ++bj)
#pragma unroll
            for (int n = 0; n < 2; ++n) { gv[bj][n] = *(const f32x4*)(g + col0 + bj * HALF + n * 16); av[bj][n] = q8 ? *(const f32x4*)(swc + col0 + bj * HALF + n * 16) : (f32x4){1.f, 1.f, 1.f, 1.f}; }
        f32x4 t0[2][2], t1[2][2];
#pragma unroll
        for (int bj = 0; bj < 2; ++bj)
#pragma unroll
            for (int n = 0; n < 2; ++n) { t0[bj][n] = do_xs ? *(const f32x4*)(nw + col0 + bj * HALF + n * 16) : (f32x4){0.f, 0.f, 0.f, 0.f}; t1[bj][n] = do_xs ? *(const f32x4*)(scl + (size_t)cond * 18432 + col0 + bj * HALF + n * 16) : (f32x4){0.f, 0.f, 0.f, 0.f}; }
#pragma unroll
        for (int bj = 0; bj < 2; ++bj)
#pragma unroll
            for (int n = 0; n < 2; ++n) { gv[bj][n] = gv[bj][n] * coef * av[bj][n]; av[bj][n] = t0[bj][n] * (t1[bj][n] + 1.0f); }
#pragma unroll
        for (int ai2 = 0; ai2 < 4; ++ai2) { const int ai = ai2 >> 1, m0 = (ai2 & 1) * 2;
            f32x4 bb[2][2][2];
#pragma unroll
            for (int mm = 0; mm < 2; ++mm)
#pragma unroll
                for (int bj = 0; bj < 2; ++bj)
#pragma unroll
                    for (int n = 0; n < 2; ++n) bb[mm][bj][n] = *(const f32x4*)(base + (size_t)(row0 + ai * HALF + (m0 + mm) * 16) * 2048 + col0 + bj * HALF + n * 16);
#pragma unroll
            for (int mm = 0; mm < 2; ++mm) { const int m = m0 + mm; const int row = row0 + ai * HALF + m * 16; const size_t off = (size_t)row * 2048 + col0; float ss = 0.f, amx = 0.f; const float sr = q8 == 2 ? sa[0] : q8 ? sa[row] : 1.0f;
#pragma unroll
                for (int bj = 0; bj < 2; ++bj)
#pragma unroll
                    for (int n = 0; n < 2; ++n) { const f32x4 b = bb[mm][bj][n]; const f32x4 o = b + gv[bj][n] * (acc[ai][bj][m][n] * sr);
                        *(f32x4*)(out + off + bj * HALF + n * 16) = o;
                        if (do_xs) { f32x4 q = o * av[bj][n]; if (do_xs == 2) { q[0] = qm(q[0]); q[1] = qm(q[1]); q[2] = qm(q[2]); q[3] = qm(q[3]); } ss += (o[0] * o[0] + o[1] * o[1]) + (o[2] * o[2] + o[3] * o[3]); amx = fmaxf(fmaxf(amx, fmaxf(fabsf(q[0]), fabsf(q[1]))), fmaxf(fabsf(q[2]), fabsf(q[3])));
                            uint2 w2; w2.x = cvt_pk_bf16(q[0], q[1]); w2.y = cvt_pk_bf16(q[2], q[3]); *(uint2*)(xs + off + bj * HALF + n * 16) = w2; } }
                if (do_xs) { ss += __shfl_xor(ss, 16); ss += __shfl_xor(ss, 32); if (fq == 0) atomicAdd(rss + row, (unsigned long long)(ss * 16777216.0f));
                    if (xs_all) { amx = fmaxf(amx, __shfl_xor(amx, 16)); amx = fmaxf(amx, __shfl_xor(amx, 32)); if (fq == 0) atomicMax((unsigned*)((char*)rss + am_delta) + row, __float_as_uint(amx)); } }
                if (mm == 1) asm volatile("" ::: "memory"); } }
    }
};
typedef int i32x8 __attribute__((ext_vector_type(8)));
__device__ __forceinline__ void mfma_f8_128(f32x4& c, const i32x8 a, const i32x8 b) { asm volatile("v_mfma_f32_16x16x128_f8f6f4 %0, %1, %2, %0" : "+v"(c) : "v"(a), "v"(b)); }
template <class Epi, class Sched, bool ALIGN_EPI = false, bool SP2 = false, int I8 = 0>
__device__ __forceinline__ void gemm_phase(PG8_LAS unsigned char* lds, const Gemm g, const Sched& S, const Epi& E) {
    int tid_ = threadIdx.x; asm volatile("" : "+v"(tid_));
    const int tid = tid_, wid = __builtin_amdgcn_readfirstlane(tid >> 6), lane = tid & 63, wr = wid >> 2, wc = wid & 3, fr = lane & 15, fq = lane >> 4;
    const int K = g.K, nt = K / BK;
    unsigned voffA[2], voffB[2];
#pragma unroll
    for (int i = 0; i < 2; ++i) { int R, C; stage_rc(tid * 16 + i * 8192, R, C); const int Rb = Epi::PERM ? ((R & ~31) + perm32(R & 31)) : R;
        voffA[i] = (unsigned)(R * K + C) * 2u; voffB[i] = (unsigned)(Rb * BK + C) * 2u; }
    const size_t kstep = (size_t)(BK * 2);
    const size_t hstep = (size_t)HALF * K * 2;
    const size_t tstep = 2 * hstep;
    const size_t kstepB = (size_t)BM * BK * 2, hstepB = (size_t)HALF * BK * 2;
    const unsigned ldsw = (unsigned)wid * 1024u;
    const int aoff = lds_byte(wr * 64 + fr, fq * 8), boff = lds_byte(wc * 32 + fr, fq * 8);
#define PG8_SA(b, h) (((b) * 2 + (h)) * HTB)
#define PG8_SB(b, h) ((4 + (b) * 2 + (h)) * HTB)
#define PG8_STAGE(bufoff, gbase, voff) do { _Pragma("unroll") for (int _i = 0; _i < 2; ++_i) \
        __builtin_amdgcn_global_load_lds((const unsigned*)((const char*)(gbase) + (voff)[_i]), (PG8_LAS unsigned*)(lds + (bufoff) + ldsw + _i * 8192), 16, 0, 0); } while (0)
#define PG8_LDA(dst, b, h) do { _Pragma("unroll") for (int m = 0; m < 4; ++m) _Pragma("unroll") for (int k = 0; k < 2; ++k) dst[m][k] = *(const PG8_LAS bf16x8*)(lds + PG8_SA(b, h) + aoff + m * 2048 + k * 1024); } while (0)
#define PG8_LDB(dst, b, h) do { _Pragma("unroll") for (int n = 0; n < 2; ++n) _Pragma("unroll") for (int k = 0; k < 2; ++k) dst[n][k] = *(const PG8_LAS bf16x8*)(lds + PG8_SB(b, h) + boff + n * 2048 + k * 1024); } while (0)
#define PG8_MMA(ai, bj, At, Bt) do { __builtin_amdgcn_s_setprio(1); _Pragma("unroll") for (int m = 0; m < 4; ++m) _Pragma("unroll") for (int n = 0; n < 2; ++n) { if constexpr (I8 == 2) { \
        mfma_f8_128(acc[ai][bj][m][n], __builtin_shufflevector(__builtin_bit_cast(i32x4, Bt[n][0]), __builtin_bit_cast(i32x4, Bt[n][1]), 0, 1, 2, 3, 4, 5, 6, 7), \
            __builtin_shufflevector(__builtin_bit_cast(i32x4, At[m][0]), __builtin_bit_cast(i32x4, At[m][1]), 0, 1, 2, 3, 4, 5, 6, 7)); } else _Pragma("unroll") for (int k = 0; k < 2; ++k) { \
        if constexpr (I8 == 1) acc[ai][bj][m][n] = __builtin_bit_cast(f32x4, __builtin_amdgcn_mfma_i32_16x16x64_i8(__builtin_bit_cast(i32x4, Bt[n][k]), __builtin_bit_cast(i32x4, At[m][k]), __builtin_bit_cast(i32x4, acc[ai][bj][m][n]), 0, 0, 0)); \
        else acc[ai][bj][m][n] = __builtin_amdgcn_mfma_f32_16x16x32_bf16(Bt[n][k], At[m][k], acc[ai][bj][m][n], 0, 0, 0); } } __builtin_amdgcn_s_setprio(0); } while (0)
#define PG8_WAIT_V(n) asm volatile("s_waitcnt vmcnt(" #n ")" ::: "memory")
#define PG8_WAIT_L(n) asm volatile("s_waitcnt lgkmcnt(" #n ")" ::: "memory")
#define PG8_BAR __builtin_amdgcn_s_barrier()
#define PG8_SCHED __builtin_amdgcn_sched_barrier(0)
    Unit cur, nxt; int ui = 0;
    if (!S.next(0, cur)) return;
    f32x4 acc[2][2][4][2];
#pragma unroll
    for (int a = 0; a < 2; ++a)
#pragma unroll
        for (int b = 0; b < 2; ++b)
#pragma unroll
            for (int m = 0; m < 4; ++m)
#pragma unroll
                for (int n = 0; n < 2; ++n) acc[a][b][m][n] = (f32x4){0.f, 0.f, 0.f, 0.f};
    bf16x8 At[4][2], B0[2][2], B1[2][2];
    const char* cA = (const char*)g.A + (size_t)cur.pm * tstep; const char* cB = (const char*)g.Bt + (size_t)cur.pn * tstep;
    S.a_ready(cur);
    if constexpr (SP2) {
        PG8_STAGE(PG8_SB(0, 0), cB, voffB); PG8_STAGE(PG8_SB(0, 1), cB + hstepB, voffB); PG8_STAGE(PG8_SA(0, 0), cA, voffA); PG8_STAGE(PG8_SA(0, 1), cA + hstep, voffA);
        if (wr == 1) PG8_BAR;
        PG8_WAIT_V(2); PG8_BAR;
        PG8_STAGE(PG8_SB(1, 0), cB + kstepB, voffB); PG8_STAGE(PG8_SA(1, 0), cA + kstep, voffA); PG8_STAGE(PG8_SB(1, 1), cB + hstepB + kstepB, voffB);
        PG8_WAIT_V(6); PG8_BAR;
    } else {
        PG8_STAGE(PG8_SB(0, 0), cB, voffB); PG8_STAGE(PG8_SA(0, 0), cA, voffA); PG8_STAGE(PG8_SB(0, 1), cB + hstepB, voffB); PG8_STAGE(PG8_SA(0, 1), cA + hstep, voffA);
        if (wr == 1) PG8_BAR;
        PG8_WAIT_V(4); PG8_BAR;
        PG8_STAGE(PG8_SB(1, 0), cB + kstepB, voffB); PG8_STAGE(PG8_SA(1, 0), cA + kstep, voffA); PG8_STAGE(PG8_SB(1, 1), cB + hstepB + kstepB, voffB);
        PG8_WAIT_V(6); PG8_BAR;
    }
    for (;;) {
        const bool has_next = S.next(ui + 1, nxt);
        const char* nA = has_next ? (const char*)g.A + (size_t)nxt.pm * tstep : cA; const char* nB = has_next ? (const char*)g.Bt + (size_t)nxt.pn * tstep : cB;
        for (int t = 0; t < nt; t += 2) {
            const bool last = (t == nt - 2);
            const char* a1 = cA + (size_t)(t + 1) * kstep;
            const char* a2 = last ? nA : cA + (size_t)(t + 2) * kstep; const char* b2 = last ? nB : cB + (size_t)(t + 2) * kstepB;
            const char* a3 = a2 + kstep; const char* b3 = b2 + kstepB;
            if (last && has_next) S.a_ready(nxt);
            if constexpr (SP2) {
            PG8_LDB(B0, 0, 0); PG8_LDB(B1, 0, 1); PG8_SCHED; PG8_LDA(At, 0, 0); PG8_STAGE(PG8_SA(1, 1), a1 + hstep, voffA);
            PG8_WAIT_V(8); PG8_WAIT_L(0); PG8_BAR; PG8_MMA(0, 0, At, B0); PG8_MMA(0, 1, At, B1); PG8_BAR; PG8_SCHED;
            PG8_LDA(At, 0, 1); PG8_STAGE(PG8_SB(0, 0), b2, voffB); PG8_STAGE(PG8_SB(0, 1), b2 + hstepB, voffB); PG8_STAGE(PG8_SA(0, 0), a2, voffA);
            PG8_WAIT_V(8); PG8_WAIT_L(0); PG8_BAR; PG8_MMA(1, 0, At, B0); PG8_MMA(1, 1, At, B1); PG8_BAR; PG8_SCHED;
            PG8_LDB(B0, 1, 0); PG8_LDB(B1, 1, 1); PG8_SCHED; PG8_LDA(At, 1, 0); PG8_STAGE(PG8_SA(0, 1), a2 + hstep, voffA);
            PG8_WAIT_V(8); PG8_WAIT_L(0); PG8_BAR; PG8_MMA(0, 0, At, B0); PG8_MMA(0, 1, At, B1); PG8_BAR; PG8_SCHED;
            PG8_LDA(At, 1, 1); PG8_STAGE(PG8_SB(1, 0), b3, voffB); PG8_STAGE(PG8_SB(1, 1), b3 + hstepB, voffB); PG8_STAGE(PG8_SA(1, 0), a3, voffA);
            PG8_WAIT_V(8); PG8_WAIT_L(0); PG8_BAR; PG8_MMA(1, 0, At, B0); PG8_MMA(1, 1, At, B1); PG8_BAR; PG8_SCHED;
            } else {
            PG8_LDB(B0, 0, 0); PG8_SCHED; PG8_LDA(At, 0, 0); PG8_STAGE(PG8_SA(1, 1), a1 + hstep, voffA);
            PG8_WAIT_L(8); PG8_BAR; PG8_WAIT_L(0); PG8_MMA(0, 0, At, B0); PG8_BAR; PG8_SCHED;
            PG8_LDB(B1, 0, 1); PG8_STAGE(PG8_SB(0, 0), b2, voffB);
            PG8_BAR; PG8_WAIT_L(0); PG8_MMA(0, 1, At, B1); PG8_BAR;
            PG8_LDA(At, 0, 1); PG8_STAGE(PG8_SA(0, 0), a2, voffA);
            PG8_BAR; PG8_WAIT_L(0); PG8_MMA(1, 0, At, B0); PG8_BAR; PG8_SCHED;
            PG8_STAGE(PG8_SB(0, 1), b2 + hstepB, voffB);
            PG8_WAIT_V(6); PG8_BAR; PG8_MMA(1, 1, At, B1); PG8_BAR;
            PG8_LDB(B0, 1, 0); PG8_SCHED; PG8_LDA(At, 1, 0); PG8_STAGE(PG8_SA(0, 1), a2 + hstep, voffA);
            PG8_WAIT_L(8); PG8_BAR; PG8_WAIT_L(0); PG8_MMA(0, 0, At, B0); PG8_BAR; PG8_SCHED;
            PG8_LDB(B1, 1, 1); PG8_STAGE(PG8_SB(1, 0), b3, voffB);
            PG8_BAR; PG8_WAIT_L(0); PG8_MMA(0, 1, At, B1); PG8_BAR;
            PG8_LDA(At, 1, 1); PG8_STAGE(PG8_SA(1, 0), a3, voffA);
            PG8_BAR; PG8_WAIT_L(0); PG8_MMA(1, 0, At, B0); PG8_BAR; PG8_SCHED;
            PG8_STAGE(PG8_SB(1, 1), b3 + hstepB, voffB);
            PG8_WAIT_V(6); PG8_BAR; PG8_MMA(1, 1, At, B1); PG8_BAR;
            }
        }
        if constexpr (ALIGN_EPI) { if (wr == 0) PG8_BAR; }
        if constexpr (I8 == 2) asm volatile("s_nop 15\n\ts_nop 15" ::: "memory");
        if constexpr (I8 == 1) { _Pragma("unroll") for (int a = 0; a < 2; ++a) _Pragma("unroll") for (int b = 0; b < 2; ++b) _Pragma("unroll") for (int m = 0; m < 4; ++m) _Pragma("unroll") for (int n = 0; n < 2; ++n) acc[a][b][m][n] = __builtin_convertvector(__builtin_bit_cast(i32x4, acc[a][b][m][n]), f32x4); }
        if constexpr (!Epi::AFTER_DRAIN) { E(acc, cur, wr, wc, fr, fq); S.done(cur); }
        if (!has_next) break;
#pragma unroll
        for (int a = 0; a < 2; ++a)
#pragma unroll
            for (int b = 0; b < 2; ++b)
#pragma unroll
                for (int m = 0; m < 4; ++m)
#pragma unroll
                    for (int n = 0; n < 2; ++n) acc[a][b][m][n] = (f32x4){0.f, 0.f, 0.f, 0.f};
        cur = nxt; cA = nA; cB = nB; ++ui;
        if constexpr (ALIGN_EPI) { if (wr == 1) PG8_BAR; }
    }
    PG8_WAIT_V(0);
    if constexpr (!ALIGN_EPI) { if (wr == 0) PG8_BAR; }
    PG8_BAR;
    if constexpr (Epi::AFTER_DRAIN) { E.fused(acc, cur, wr, wc, fr, fq, lds, wid, lane); S.done(cur); }
#undef PG8_SA
#undef PG8_SB
#undef PG8_STAGE
#undef PG8_LDA
#undef PG8_LDB
#undef PG8_MMA
#undef PG8_WAIT_V
#undef PG8_WAIT_L
#undef PG8_BAR
#undef PG8_SCHED
}
}
namespace att {
using bf16x8 = __attribute__((ext_vector_type(8))) short;
using s16x4  = __attribute__((ext_vector_type(4))) short;
using f32x16 = __attribute__((ext_vector_type(16))) float;
using u32x4  = __attribute__((ext_vector_type(4))) unsigned;
typedef unsigned short bf16_t;
constexpr int NW = 8, QBLK = 32, KVBLK = 64;
constexpr float THR = 8.f;
constexpr int SHM_V = 64 * 128 * 2, SHM_K = 64 * 128 * 2, SHM_ATTN = 2 * SHM_V + 2 * SHM_K + NW * 64 * 4;
#define KSWZ(row, colB) ((row) * 256 + ((colB) ^ (((row) & 7) << 4)))
#define KSWZ64(row, colB) ((row) * 128 + ((colB) ^ ((((row) >> 1) & 7) << 4)))
#define SBAR() __builtin_amdgcn_sched_barrier(0)
__device__ __forceinline__ int crow(int r, int hi) { return (r & 3) + 8 * (r >> 2) + 4 * hi; }
__device__ __forceinline__ unsigned cvtpk(float lo, float hi) { unsigned r; asm volatile("v_cvt_pk_bf16_f32 %0, %1, %2" : "=v"(r) : "v"(lo), "v"(hi)); return r; }
__device__ __forceinline__ float bf2f(unsigned short b) { return __uint_as_float((unsigned)b << 16); }
__device__ __forceinline__ bf16x8 ld8(const bf16_t* p) { return *reinterpret_cast<const bf16x8*>(p); }

template <int DQK, bool PRE = false> __device__ __forceinline__ void partialSM(f32x16& p0, f32x16& p1, float& m_reg, float& mn, float& alpha) {
  constexpr float SCALE = PRE ? 0.6931471805599453f : ((DQK == 128) ? 0.088388347648318440f : 0.125f);
  constexpr float C = SCALE * 1.4426950408889634f;
  float pmax = p0[0];
#pragma unroll
  for (int r = 1; r < 16; ++r) pmax = fmaxf(pmax, p0[r]);
#pragma unroll
  for (int r = 0; r < 16; ++r) pmax = fmaxf(pmax, p1[r]);
  { auto rr = __builtin_amdgcn_permlane32_swap(__float_as_uint(pmax), __float_as_uint(pmax), false, false);
    pmax = fmaxf(__uint_as_float(rr[0]), __uint_as_float(rr[1])); }
  if (__builtin_expect(__all(pmax - m_reg <= THR / SCALE), 1)) { mn = m_reg; alpha = 1.f; }
  else { mn = fmaxf(m_reg, pmax); alpha = __builtin_amdgcn_exp2f((m_reg - mn) * C); m_reg = mn; }
  float mnC = -mn * C;
#pragma unroll
  for (int r = 0; r < 16; ++r) p0[r] = fmaf(p0[r], C, mnC);
#pragma unroll
  for (int r = 0; r < 16; ++r) p1[r] = fmaf(p1[r], C, mnC);
#pragma unroll
  for (int r = 0; r < 16; ++r) p0[r] = __builtin_amdgcn_exp2f(p0[r]);
}
#define PK4(P, BASE, OUT) do { unsigned a0 = cvtpk(P[BASE + 0], P[BASE + 1]), a1 = cvtpk(P[BASE + 2], P[BASE + 3]);   \
    unsigned b0 = cvtpk(P[BASE + 4], P[BASE + 5]), b1 = cvtpk(P[BASE + 6], P[BASE + 7]);                              \
    auto r0 = __builtin_amdgcn_permlane32_swap(a0, b0, false, false); auto r1 = __builtin_amdgcn_permlane32_swap(a1, b1, false, false); \
    u32x4 w = {r0[0], r1[0], r0[1], r1[1]}; OUT = *reinterpret_cast<bf16x8*>(&w); } while (0)
__device__ __forceinline__ void finishSM(f32x16& p0, f32x16& p1, float alpha, float& l_reg, bf16x8& pa0, bf16x8& pa1, bf16x8& pa2, bf16x8& pa3) {
#pragma unroll
  for (int r = 0; r < 16; ++r) p1[r] = __builtin_amdgcn_exp2f(p1[r]);
  float ps = 0;
#pragma unroll
  for (int r = 0; r < 16; ++r) ps += p0[r];
#pragma unroll
  for (int r = 0; r < 16; ++r) ps += p1[r];
  { auto rr = __builtin_amdgcn_permlane32_swap(__float_as_uint(ps), __float_as_uint(ps), false, false);
    ps = __uint_as_float(rr[0]) + __uint_as_float(rr[1]); }
  l_reg = l_reg * alpha + ps;
  PK4(p0, 0, pa0); PK4(p0, 8, pa1); PK4(p1, 0, pa2); PK4(p1, 8, pa3);
}
template <int DQK> __device__ __forceinline__ void qkt(f32x16& p0, f32x16& p1, const char* Ks, const bf16x8* qr, int r32, int hi) {
  constexpr int ND = DQK / 16;
  p0 = f32x16{}; p1 = f32x16{};
  bf16x8 b0[2], b1[2];
#define QK_RD(d0, s) do { const int cb_ = ((d0) * 16 + hi * 8) * 2; \
    if constexpr (DQK == 128) { b0[s] = *reinterpret_cast<const bf16x8*>(Ks + KSWZ(r32, cb_)); b1[s] = *reinterpret_cast<const bf16x8*>(Ks + KSWZ(32 + r32, cb_)); } \
    else { b0[s] = *reinterpret_cast<const bf16x8*>(Ks + KSWZ64(r32, cb_)); b1[s] = *reinterpret_cast<const bf16x8*>(Ks + KSWZ64(32 + r32, cb_)); } } while (0)
  QK_RD(0, 0); QK_RD(1, 1); SBAR();
#pragma unroll
  for (int d0 = 0; d0 < ND; ++d0) {
    p0 = __builtin_amdgcn_mfma_f32_32x32x16_bf16(b0[d0 & 1], qr[d0], p0, 0, 0, 0);
    p1 = __builtin_amdgcn_mfma_f32_32x32x16_bf16(b1[d0 & 1], qr[d0], p1, 0, 0, 0);
    if (d0 + 2 < ND) { QK_RD(d0 + 2, d0 & 1); }
    SBAR();
  }
#undef QK_RD
}
__device__ __forceinline__ int v_st(int k, int c) { const int kk = (k & ~0xC) | ((k & 4) << 1) | ((k & 8) >> 1); return ((kk >> 3) * 4 + (c >> 5)) * 512 + ((kk & 7) * 32 + (c & 31)) * 2; }
__device__ __forceinline__ int v_rd_base(int lane) { return ((lane & 3) << 3) | (((lane >> 2) & 3) << 6) | (((lane >> 4) & 1) << 5) | (((lane >> 5) & 1) << 8); }
constexpr int v_rd_off(int d0, int ks, int half) { return d0 * 512 + ks * 4096 + half * 2048; }
template <int OFF> __device__ __forceinline__ s16x4 tr_read(int vb) {
  s16x4 r; asm volatile("ds_read_b64_tr_b16 %0, %1 offset:%2" : "=&v"(r) : "v"(vb), "i"(OFF) : "memory"); return r;
}
#define PKF(L, H) (bf16x8){L[0], L[1], L[2], L[3], H[0], H[1], H[2], H[3]}
template <int D0> __device__ __forceinline__ void pv_one(f32x16& od, int vb, bf16x8 pa0, bf16x8 pa1, bf16x8 pa2, bf16x8 pa3) {
  const s16x4 l0 = tr_read<v_rd_off(D0, 0, 0)>(vb), h0 = tr_read<v_rd_off(D0, 0, 1)>(vb), l1 = tr_read<v_rd_off(D0, 1, 0)>(vb), h1 = tr_read<v_rd_off(D0, 1, 1)>(vb);
  const s16x4 l2 = tr_read<v_rd_off(D0, 2, 0)>(vb), h2 = tr_read<v_rd_off(D0, 2, 1)>(vb), l3 = tr_read<v_rd_off(D0, 3, 0)>(vb), h3 = tr_read<v_rd_off(D0, 3, 1)>(vb);
  asm volatile("s_waitcnt lgkmcnt(0)" ::: "memory"); SBAR();
  od = __builtin_amdgcn_mfma_f32_32x32x16_bf16(pa0, PKF(l0, h0), od, 0, 0, 0);
  od = __builtin_amdgcn_mfma_f32_32x32x16_bf16(pa1, PKF(l1, h1), od, 0, 0, 0);
  od = __builtin_amdgcn_mfma_f32_32x32x16_bf16(pa2, PKF(l2, h2), od, 0, 0, 0);
  od = __builtin_amdgcn_mfma_f32_32x32x16_bf16(pa3, PKF(l3, h3), od, 0, 0, 0);
}
#define PV_RD(D0, L, H) do { L[0] = tr_read<v_rd_off(D0, 0, 0)>(vb); H[0] = tr_read<v_rd_off(D0, 0, 1)>(vb); L[1] = tr_read<v_rd_off(D0, 1, 0)>(vb); H[1] = tr_read<v_rd_off(D0, 1, 1)>(vb); \
    L[2] = tr_read<v_rd_off(D0, 2, 0)>(vb); H[2] = tr_read<v_rd_off(D0, 2, 1)>(vb); L[3] = tr_read<v_rd_off(D0, 3, 0)>(vb); H[3] = tr_read<v_rd_off(D0, 3, 1)>(vb); } while (0)
#define PV_MM(OD, L, H) do { OD = __builtin_amdgcn_mfma_f32_32x32x16_bf16(pa0, PKF(L[0], H[0]), OD, 0, 0, 0); OD = __builtin_amdgcn_mfma_f32_32x32x16_bf16(pa1, PKF(L[1], H[1]), OD, 0, 0, 0); \
    OD = __builtin_amdgcn_mfma_f32_32x32x16_bf16(pa2, PKF(L[2], H[2]), OD, 0, 0, 0); OD = __builtin_amdgcn_mfma_f32_32x32x16_bf16(pa3, PKF(L[3], H[3]), OD, 0, 0, 0); } while (0)
__device__ __forceinline__ void pv_d0(f32x16* o, int vb, bf16x8 pa0, bf16x8 pa1, bf16x8 pa2, bf16x8 pa3) {
  s16x4 la[4], ha[4], lb[4], hb[4];
  PV_RD(0, la, ha); PV_RD(1, lb, hb);
  asm volatile("s_waitcnt lgkmcnt(8)" ::: "memory"); SBAR(); PV_MM(o[0], la, ha); SBAR();
  PV_RD(2, la, ha);
  asm volatile("s_waitcnt lgkmcnt(8)" ::: "memory"); SBAR(); PV_MM(o[1], lb, hb); SBAR();
  PV_RD(3, lb, hb);
  asm volatile("s_waitcnt lgkmcnt(8)" ::: "memory"); SBAR(); PV_MM(o[2], la, ha); SBAR();
  asm volatile("s_waitcnt lgkmcnt(0)" ::: "memory"); SBAR(); PV_MM(o[3], lb, hb);
}
#undef PV_RD
#undef PV_MM
__device__ __forceinline__ float half_sum32(float x) {
  x += __shfl_xor(x, 1); x += __shfl_xor(x, 2); x += __shfl_xor(x, 4); x += __shfl_xor(x, 8); x += __shfl_xor(x, 16); return x;
}

struct KVSrc { const bf16_t* K1; const bf16_t* V1; int n1; const bf16_t* K2; const bf16_t* V2; int n2; };
struct AttnOut { bf16_t* Ob; float* Of; const float* nw; float lam, post; int pass; };
template <int DQK, int MODE, int LD2, int SM = 0>
__device__ __forceinline__ void attn_body(const bf16_t* __restrict__ Qb, const KVSrc kv, const AttnOut ao, char* lds) {
  constexpr long ldq = 5120, LD1 = 5120; constexpr int LDO = 2048, LDF = 512;
  int tid_ = threadIdx.x; asm volatile("" : "+v"(tid_));
  const int tid = tid_, wid = tid >> 6, lane = tid & 63, r32 = lane & 31, hi = lane >> 5;
  char* V_lds = lds; char* K_lds = lds + 2 * SHM_V;
  float* ws = (float*)(lds + 2 * SHM_V + 2 * SHM_K) + wid * 64; float* li_l = ws; float* al_l = ws + 32;
  float m_reg = -1e30f, l_reg = 0; f32x16 o[4] = {}; bf16x8 qr[DQK / 16];
  const bf16_t* Qw = Qb + (long)(wid * QBLK + r32) * ldq + hi * 8;
#pragma unroll
  for (int d0 = 0; d0 < DQK / 16; ++d0) qr[d0] = ld8(Qw + d0 * 16);
  const int sr = tid >> 4, sc = (tid & 15) * 8, vst0 = v_st(sr, sc), vst1 = v_st(32 + sr, sc);
  const int kr64 = tid >> 3, kc64 = (tid & 7) * 8;
  const int vb0 = (int)(uintptr_t)V_lds + v_rd_base(lane);
  struct { bf16x8 vs0, vs1, ks0, ks1; } sr_[2];
#define SLOAD(i, k0) do { const int k0_ = (k0); const bool s1_ = k0_ < kv.n1; const bf16_t* kp_ = s1_ ? kv.K1 + (long)k0_ * LD1 : kv.K2 + (long)(k0_ - kv.n1) * LD2; \
    const bf16_t* vp_ = s1_ ? kv.V1 + (long)k0_ * LD1 : kv.V2 + (long)(k0_ - kv.n1) * LD2; const long ld_ = s1_ ? LD1 : (long)LD2; \
    sr_[i].vs0 = ld8(vp_ + (long)sr * ld_ + sc); sr_[i].vs1 = ld8(vp_ + (long)(32 + sr) * ld_ + sc); \
    if constexpr (DQK == 128) { sr_[i].ks0 = ld8(kp_ + (long)sr * ld_ + sc); sr_[i].ks1 = ld8(kp_ + (long)(32 + sr) * ld_ + sc); } \
    else { sr_[i].ks0 = ld8(kp_ + (long)kr64 * ld_ + kc64); } } while (0)
#define SWRITE(b, i) do { *(bf16x8*)(V_lds + (b) * SHM_V + vst0) = sr_[i].vs0; *(bf16x8*)(V_lds + (b) * SHM_V + vst1) = sr_[i].vs1; \
    if constexpr (DQK == 128) { const int kc = sc * 2; *(bf16x8*)(K_lds + (b) * SHM_K + KSWZ(sr, kc)) = sr_[i].ks0; *(bf16x8*)(K_lds + (b) * SHM_K + KSWZ(32 + sr, kc)) = sr_[i].ks1; } \
    else { *(bf16x8*)(K_lds + (b) * SHM_K + KSWZ64(kr64, kc64 * 2)) = sr_[i].ks0; } } while (0)
#define SWAIT() do { if constexpr (DQK == 128) asm volatile("s_waitcnt vmcnt(4)" ::: "memory"); else asm volatile("s_waitcnt vmcnt(3)" ::: "memory"); } while (0)
#define RESC(a) do { if (SM != 1 && __any((a) < 1.f)) { if (hi == 0) al_l[r32] = (a); asm volatile("s_waitcnt lgkmcnt(0)" ::: "memory"); \
    _Pragma("unroll") for (int d = 0; d < 4; ++d) _Pragma("unroll") for (int r = 0; r < 16; ++r) o[d][r] *= al_l[crow(r, hi)]; } } while (0)
  f32x16 pA0, pA1, pB0, pB1; float mnA = 0.f, mnB = 0.f, alA = 1.f, alB = 1.f; bf16x8 pa0, pa1, pa2, pa3; const int NT = (kv.n1 + kv.n2) / KVBLK; (void)mnA; (void)mnB;
#define PSM(P0, P1, MN, AL) do { if constexpr (SM == 1) { _Pragma("unroll") for (int r_ = 0; r_ < 16; ++r_) P0[r_] = __builtin_amdgcn_exp2f(P0[r_]); } else partialSM<DQK, SM == 2>(P0, P1, m_reg, MN, AL); } while (0)
  constexpr int SE = 0, SO = 1;
  SLOAD(SE, 0); SLOAD(SO, KVBLK); SWAIT(); SWRITE(0, SE); __syncthreads();
  qkt<DQK>(pA0, pA1, K_lds, qr, r32, hi); PSM(pA0, pA1, mnA, alA);
  if (2 < NT) SLOAD(SE, 2 * KVBLK);
  SWAIT(); SWRITE(1, SO); __syncthreads();
  for (int j = 1; j + 1 < NT; j += 2) {
    SBAR(); qkt<DQK>(pB0, pB1, K_lds + SHM_K, qr, r32, hi);
    finishSM(pA0, pA1, alA, l_reg, pa0, pa1, pa2, pa3); SBAR();
    SLOAD(SO, (j + 2) * KVBLK); SBAR();
    pv_d0(o, vb0, pa0, pa1, pa2, pa3); PSM(pB0, pB1, mnB, alB);
    __syncthreads(); SWAIT(); SWRITE(0, SE);
    RESC(alB); __syncthreads();
    SBAR(); qkt<DQK>(pA0, pA1, K_lds, qr, r32, hi);
    finishSM(pB0, pB1, alB, l_reg, pa0, pa1, pa2, pa3); SBAR();
    if (j + 3 < NT) SLOAD(SE, (j + 3) * KVBLK); SBAR();
    pv_d0(o, vb0 + (int)SHM_V, pa0, pa1, pa2, pa3); PSM(pA0, pA1, mnA, alA);
    __syncthreads(); SWAIT(); SWRITE(1, SO);
    RESC(alA); __syncthreads();
  }
  SBAR(); qkt<DQK>(pB0, pB1, K_lds + SHM_K, qr, r32, hi);
  finishSM(pA0, pA1, alA, l_reg, pa0, pa1, pa2, pa3); SBAR();
  pv_d0(o, vb0, pa0, pa1, pa2, pa3); PSM(pB0, pB1, mnB, alB);
  __syncthreads(); RESC(alB);
  finishSM(pB0, pB1, alB, l_reg, pa0, pa1, pa2, pa3); SBAR();
  pv_d0(o, vb0 + (int)SHM_V, pa0, pa1, pa2, pa3);
  if (hi == 0) li_l[r32] = l_reg; asm volatile("s_waitcnt lgkmcnt(0)" ::: "memory");
  float rli[16];
#pragma unroll
  for (int r = 0; r < 16; ++r) rli[r] = __builtin_amdgcn_rcpf(li_l[crow(r, hi)]);
  bf16_t* stg = (bf16_t*)lds + wid * (QBLK * 128);
#define O_FLUSH(Ow) do { asm volatile("s_waitcnt lgkmcnt(0)" ::: "memory"); _Pragma("unroll") for (int i_ = 0; i_ < 8; ++i_) { const int row_ = i_ * 4 + (lane >> 4), ch_ = lane & 15; \
    const u32x4 v_ = *(const u32x4*)(stg + row_ * 128 + ch_ * 8); *(u32x4*)((Ow) + (long)row_ * LDO + ch_ * 8) = v_; } } while (0)
  if constexpr (MODE == 0) {
    bf16_t* Ow = ao.Ob + (long)(wid * QBLK) * LDO;
    __syncthreads();
#pragma unroll
    for (int r = 0; r < 16; ++r) { const int orow = crow(r, hi);
#pragma unroll
      for (int d0 = 0; d0 < 4; ++d0) { const float v = o[d0][r] * rli[r]; stg[orow * 128 + d0 * 32 + r32] = (bf16_t)(cvtpk(v, v) & 0xffffu); } }
    O_FLUSH(Ow);
  } else {
    float* Fw = ao.Of + (long)(wid * QBLK) * LDF;
    if (ao.pass == 0) {
#pragma unroll
      for (int r = 0; r < 16; ++r) { const int orow = crow(r, hi);
#pragma unroll
        for (int d0 = 0; d0 < 4; ++d0) Fw[(long)orow * LDF + d0 * 32 + r32] = o[d0][r] * rli[r]; }
    } else {
      bf16_t* Ow = ao.Ob + (long)(wid * QBLK) * LDO;
      __syncthreads();
#pragma unroll
      for (int r = 0; r < 16; ++r) { const int orow = crow(r, hi); float v[4]; float ss = 0.f;
#pragma unroll
        for (int d0 = 0; d0 < 4; ++d0) { v[d0] = Fw[(long)orow * LDF + d0 * 32 + r32] - ao.lam * (o[d0][r] * rli[r]); ss += v[d0] * v[d0]; }
        ss = half_sum32(ss); const float rs = rsqrtf(ss * (1.0f / 128.0f) + 1e-6f) * ao.post;
#pragma unroll
        for (int d0 = 0; d0 < 4; ++d0) { const float y = v[d0] * rs * ao.nw[d0 * 32 + r32]; stg[orow * 128 + d0 * 32 + r32] = (bf16_t)(cvtpk(y, y) & 0xffffu); } }
      O_FLUSH(Ow);
    }
  }
#undef O_FLUSH
#undef SLOAD
#undef SWRITE
#undef SWAIT
#undef RESC
#undef PSM
}
struct ChainArgs { const bf16_t* P;   int kcol, vcol; int nchunk; int dir; float lg2;
                   const float* S0;   bf16_t* ST;   float* Sfin;   };
__device__ __forceinline__ void ret_chain(const ChainArgs a, char* lds) {
  int tid_ = threadIdx.x; asm volatile("" : "+v"(tid_));
  const int tid = tid_, wid = tid >> 6, lane = tid & 63, r32 = lane & 31, hi = lane >> 5;
  const int eb = wid >> 1, dh = wid & 1;
  char* V_lds = lds; char* K_lds = lds + 2 * SHM_V;
  const int sr = tid >> 4, sc = (tid & 15) * 8;
  f32x16 acc[2];
#pragma unroll
  for (int j = 0; j < 2; ++j)
#pragma unroll
    for (int r = 0; r < 16; ++r) acc[j][r] = 0.f;
  if (a.S0) {
#pragma unroll
    for (int j = 0; j < 2; ++j)
#pragma unroll
      for (int r = 0; r < 16; ++r) acc[j][r] = a.S0[(size_t)(32 * (2 * dh + j) + r32) * 128 + 32 * eb + crow(r, hi)]; }
  const float gC = __builtin_amdgcn_exp2f(128.f * a.lg2);
  const int vbA = (int)(uintptr_t)V_lds + v_rd_base(lane) + eb * 512, vbB = (int)(uintptr_t)K_lds + v_rd_base(lane) + (2 * dh) * 512;
  bf16x8 kq[4], vq[4];
  { const int c0 = a.dir == 0 ? 0 : a.nchunk - 1; const bf16_t* rowp = a.P + (size_t)(c0 * 128) * 5120;
#pragma unroll
    for (int q = 0; q < 4; ++q) { const int k = 32 * q + sr; kq[q] = ld8(rowp + (size_t)k * 5120 + a.kcol + sc); vq[q] = ld8(rowp + (size_t)k * 5120 + a.vcol + sc); } }
  for (int s = 0; s < a.nchunk; ++s) {
    const int c = a.dir == 0 ? s : a.nchunk - 1 - s;
    bf16_t* st = a.ST + (size_t)c * 16384;
    __syncthreads();
#pragma unroll
    for (int q = 0; q < 4; ++q) { const int k = 32 * q + sr;
      const bf16x8 kv_ = kq[q], vv_ = vq[q];
      const float f = 0.088388347648318440f * __builtin_amdgcn_exp2f((a.dir == 0 ? (float)(127 - k) : (float)k) * a.lg2);
      u32x4 w; w.x = cvtpk(bf2f((unsigned short)kv_[0]) * f, bf2f((unsigned short)kv_[1]) * f); w.y = cvtpk(bf2f((unsigned short)kv_[2]) * f, bf2f((unsigned short)kv_[3]) * f);
      w.z = cvtpk(bf2f((unsigned short)kv_[4]) * f, bf2f((unsigned short)kv_[5]) * f); w.w = cvtpk(bf2f((unsigned short)kv_[6]) * f, bf2f((unsigned short)kv_[7]) * f);
      const int off = (q >> 1) * SHM_V + v_st(32 * (q & 1) + sr, sc);
      *(u32x4*)(K_lds + off) = w; *(bf16x8*)(V_lds + off) = vv_; }
    __syncthreads();
#pragma unroll
    for (int j = 0; j < 2; ++j)
#pragma unroll
      for (int r = 0; r < 16; ++r) { const float v = acc[j][r]; st[(32 * eb + crow(r, hi)) * 128 + 32 * (2 * dh + j) + r32] = (bf16_t)(cvtpk(v, v) & 0xffffu); }
    if (s + 1 < a.nchunk) { const int cn = a.dir == 0 ? s + 1 : a.nchunk - 2 - s; const bf16_t* rowp = a.P + (size_t)(cn * 128) * 5120;
#pragma unroll
      for (int q = 0; q < 4; ++q) { const int k = 32 * q + sr; kq[q] = ld8(rowp + (size_t)k * 5120 + a.kcol + sc); vq[q] = ld8(rowp + (size_t)k * 5120 + a.vcol + sc); } }
#pragma unroll
    for (int j = 0; j < 2; ++j)
#pragma unroll
      for (int r = 0; r < 16; ++r) acc[j][r] *= gC;
#pragma unroll
    for (int tt = 0; tt < 2; ++tt) {
      s16x4 al[4], ah[4], b0l[4], b0h[4], b1l[4], b1h[4];
#define RD4(ks) do { al[ks] = tr_read<v_rd_off(0, ks, 0)>(vbA + tt * SHM_V); ah[ks] = tr_read<v_rd_off(0, ks, 1)>(vbA + tt * SHM_V); \
      b0l[ks] = tr_read<v_rd_off(0, ks, 0)>(vbB + tt * SHM_V); b0h[ks] = tr_read<v_rd_off(0, ks, 1)>(vbB + tt * SHM_V); \
      b1l[ks] = tr_read<v_rd_off(1, ks, 0)>(vbB + tt * SHM_V); b1h[ks] = tr_read<v_rd_off(1, ks, 1)>(vbB + tt * SHM_V); } while (0)
      RD4(0); RD4(1); RD4(2); RD4(3);
#undef RD4
      asm volatile("s_waitcnt lgkmcnt(0)" ::: "memory"); SBAR();
#pragma unroll
      for (int ks = 0; ks < 4; ++ks) {
        acc[0] = __builtin_amdgcn_mfma_f32_32x32x16_bf16(PKF(al[ks], ah[ks]), PKF(b0l[ks], b0h[ks]), acc[0], 0, 0, 0);
        acc[1] = __builtin_amdgcn_mfma_f32_32x32x16_bf16(PKF(al[ks], ah[ks]), PKF(b1l[ks], b1h[ks]), acc[1], 0, 0, 0); }
    }
  }
  if (a.Sfin) {
#pragma unroll
    for (int j = 0; j < 2; ++j)
#pragma unroll
      for (int r = 0; r < 16; ++r) a.Sfin[(size_t)(32 * (2 * dh + j) + r32) * 128 + 32 * eb + crow(r, hi)] = acc[j][r];
  }
}
struct RetCArgs { const bf16_t* P;   int qcol, kcol, vcol, gcol; float lg2f, lg2b; const bf16_t* STf; const bf16_t* STb;
                  const float* gnw; bf16_t* O;   };
__device__ __forceinline__ void ret_c(const RetCArgs a, char* lds) {
  int tid_ = threadIdx.x; asm volatile("" : "+v"(tid_));
  const int tid = tid_, wid = tid >> 6, lane = tid & 63, r32 = lane & 31, hi = lane >> 5;
  char* V_lds = lds; char* K_lds = lds + 2 * SHM_V;
  const int cw = wid >> 2, ipos = 32 * (wid & 3) + r32;
  const int sr = tid >> 4, sc = (tid & 15) * 8;
  const int vb0 = (int)(uintptr_t)V_lds + v_rd_base(lane);
  bf16x8 qr[8];
  const bf16_t* Qw = a.P + (size_t)(wid * 32 + r32) * 5120 + a.qcol + hi * 8;
#pragma unroll
  for (int d0 = 0; d0 < 8; ++d0) qr[d0] = ld8(Qw + d0 * 16);
  f32x16 o[4] = {};
  bf16x8 kvs[2][4], vvs[2][4];
#pragma unroll
  for (int ch = 0; ch < 2; ++ch) { const bf16_t* rowp = a.P + (size_t)(ch * 128) * 5120;
#pragma unroll
    for (int q = 0; q < 4; ++q) { const int k = 32 * q + sr; kvs[ch][q] = ld8(rowp + (size_t)k * 5120 + a.kcol + sc); vvs[ch][q] = ld8(rowp + (size_t)k * 5120 + a.vcol + sc); } }
#pragma unroll
  for (int ch = 0; ch < 2; ++ch) {
    __syncthreads();
#pragma unroll
    for (int q = 0; q < 4; ++q) {
      *(bf16x8*)(K_lds + (q >> 1) * SHM_K + KSWZ(32 * (q & 1) + sr, sc * 2)) = kvs[ch][q];
      *(bf16x8*)(V_lds + (q >> 1) * SHM_V + v_st(32 * (q & 1) + sr, sc)) = vvs[ch][q]; }
    __syncthreads();
    if (cw == ch) {
#pragma unroll
      for (int tt = 0; tt < 2; ++tt) {
        f32x16 p0, p1; qkt<128>(p0, p1, K_lds + tt * SHM_K, qr, r32, hi);
        int ip_ = ipos, hi_ = hi; asm volatile("" : "+v"(ip_), "+v"(hi_));
#pragma unroll
        for (int r = 0; r < 16; ++r) {
          const int j0 = 64 * tt + crow(r, hi_), d0_ = ip_ - j0, d1_ = d0_ - 32;
          const float f0 = d0_ > 0 ? __builtin_amdgcn_exp2f((float)d0_ * a.lg2f) : (d0_ < 0 ? __builtin_amdgcn_exp2f((float)(-d0_) * a.lg2b) : 2.0f);
          const float f1 = d1_ > 0 ? __builtin_amdgcn_exp2f((float)d1_ * a.lg2f) : (d1_ < 0 ? __builtin_amdgcn_exp2f((float)(-d1_) * a.lg2b) : 2.0f);
          p0[r] *= f0 * 0.088388347648318440f; p1[r] *= f1 * 0.088388347648318440f; }
        bf16x8 pa0, pa1, pa2, pa3; PK4(p0, 0, pa0); PK4(p0, 8, pa1); PK4(p1, 0, pa2); PK4(p1, 8, pa3);
        pv_d0(o, vb0 + tt * SHM_V, pa0, pa1, pa2, pa3);
      }
    }
  }
#pragma unroll
  for (int dir = 0; dir < 2; ++dir) {
    const float rs = dir == 0 ? __builtin_amdgcn_exp2f((float)(ipos + 1) * a.lg2f) : __builtin_amdgcn_exp2f((float)(128 - ipos) * a.lg2b);
    const bf16_t* S = (dir == 0 ? a.STf : a.STb) + (size_t)cw * 16384 + (size_t)r32 * 128 + hi * 8;
#pragma unroll
    for (int d0 = 0; d0 < 8; ++d0) {
      const bf16x8 q_ = qr[d0]; u32x4 w;
      w.x = cvtpk(bf2f((unsigned short)q_[0]) * rs, bf2f((unsigned short)q_[1]) * rs); w.y = cvtpk(bf2f((unsigned short)q_[2]) * rs, bf2f((unsigned short)q_[3]) * rs);
      w.z = cvtpk(bf2f((unsigned short)q_[4]) * rs, bf2f((unsigned short)q_[5]) * rs); w.w = cvtpk(bf2f((unsigned short)q_[6]) * rs, bf2f((unsigned short)q_[7]) * rs);
      const bf16x8 qs = *reinterpret_cast<bf16x8*>(&w);
#pragma unroll
      for (int eb = 0; eb < 4; ++eb) { const bf16x8 b = ld8(S + (size_t)eb * 32 * 128 + d0 * 16); o[eb] = __builtin_amdgcn_mfma_f32_32x32x16_bf16(qs, b, o[eb], 0, 0, 0); }
    }
  }
  unsigned short gq[16][4]; float gw4[4];
  bf16_t* stg = (bf16_t*)lds + wid * (32 * 128);
#pragma unroll
  for (int eb = 0; eb < 4; ++eb) gw4[eb] = a.gnw[eb * 32 + r32];
#pragma unroll
  for (int r = 0; r < 16; ++r)
#pragma unroll
    for (int eb = 0; eb < 4; ++eb) gq[r][eb] = a.P[(size_t)(wid * 32 + crow(r, hi)) * 5120 + a.gcol + eb * 32 + r32];
  __syncthreads();
#pragma unroll
  for (int r = 0; r < 16; ++r) {
    const int row = wid * 32 + crow(r, hi); (void)row;
    float s = (o[0][r] + o[1][r]) + (o[2][r] + o[3][r]); s = half_sum32(s); const float mean = s * (1.0f / 128.0f);
    float q = 0.f;
#pragma unroll
    for (int eb = 0; eb < 4; ++eb) { const float d = o[eb][r] - mean; q += d * d; }
    q = half_sum32(q); const float rstd = rsqrtf(q * (1.0f / 128.0f) + 1e-6f);
#pragma unroll
    for (int eb = 0; eb < 4; ++eb) { const int col = eb * 32 + r32;
      const float g = bf2f(gq[r][eb]);
      const float y = (o[eb][r] - mean) * rstd * gw4[eb] * (g * __builtin_amdgcn_rcpf(1.0f + __builtin_amdgcn_exp2f(-1.4426950408889634f * g)));
      stg[crow(r, hi) * 128 + col] = (bf16_t)(cvtpk(y, y) & 0xffffu); }
  }
  asm volatile("s_waitcnt lgkmcnt(0)" ::: "memory");
#pragma unroll
  for (int i_ = 0; i_ < 8; ++i_) { const int row_ = i_ * 4 + (lane >> 4), ch_ = lane & 15;
    const u32x4 v_ = *(const u32x4*)(stg + row_ * 128 + ch_ * 8); *(u32x4*)(a.O + (size_t)(wid * 32 + row_) * 2048 + ch_ * 8) = v_; }
}
#undef KSWZ
#undef KSWZ64
#undef SBAR
#undef PK4
#undef PKF
}
constexpr int DM = 2048, M_P = 4096, M_S = 32768, MTOK = M_P + M_S, DFF = 5632, NFF = 11264, NIN = 5120, NMODC = 18432, NCOND = 9;
constexpr int C_RQ = 0, C_RK = 512, C_RV = 1024, C_RG = 1536, C_GQ = 2048, C_GK = 3072, C_GV = 3328, C_DQ = 3584, C_DK = 4096, C_DV = 4608;
constexpr float EPS = 1e-6f;
constexpr size_t MiB = 1u << 20;
constexpr size_t WS_CTL = 0, CTL_ZERO_BYTES = 1 * MiB;
constexpr size_t WS_TAB = 1 * MiB;
constexpr size_t WS_CACHE = 4 * MiB;
constexpr size_t WS_W = 16 * MiB;
constexpr size_t W_LAYER = 160 * MiB, W_WI = 0, W_WO = 88 * MiB, W_WIN = 132 * MiB, W_WOUT = 152 * MiB;
constexpr size_t WS_XN = WS_W + 2 * W_LAYER;
constexpr size_t WS_ACT = WS_XN + 144 * MiB;
constexpr size_t WS_ST = WS_ACT + 396 * MiB;
constexpr size_t WS_DF = WS_ST + 72 * MiB;
constexpr size_t WS_XNB = WS_DF + 72 * MiB;
constexpr size_t WS_SB = WS_XNB + 144 * MiB;
constexpr size_t SB_LAYER = 9 * (11264 + 5120 + 11264), SB_J1 = 9 * 11264, SB_J2 = 9 * (11264 + 5120);
constexpr size_t WS_RS = WS_SB + 2 * MiB;
constexpr size_t WS_Q = WS_RS + 2 * MiB;
constexpr size_t Q_SW = 256 * 1024, Q_SW2 = 512 * 1024, Q_SW4 = 832 * 1024, Q_ACT = 960 * 1024  , W_WINQ = 22 * MiB;
constexpr size_t WS_A8B = WS_Q + 1 * MiB;
constexpr size_t WS_END = WS_A8B + 198 * MiB;
constexpr int TB_MOD = 0, TB_COSG = 2 * 9 * 18432, TB_SING = TB_COSG + 64 * 32, TB_COSD = TB_SING + 64 * 32, TB_SIND = TB_COSD + 64 * 16, TB_SCAL = TB_SIND + 64 * 16;
constexpr int CW_BAR = 4096;
constexpr size_t CTL_RAW2 = 960 * 1024;
constexpr size_t CTL_AMAX = 64 * 1024;
constexpr size_t O_X = 0, O_STATE = 75497472, O_GK = 79691776, O_GV = 81788928, O_DK = 83886080, O_DV = 88080384, O_END = 92274688;
constexpr int LDS_BYTES = 147456, MISC_OFF = 131072 + 320;

typedef att::bf16_t bf16;
#define GAS __attribute__((address_space(1)))
#define LAS __attribute__((address_space(3)))
typedef unsigned v4u __attribute__((ext_vector_type(4)));
typedef float f32x4 __attribute__((ext_vector_type(4)));
typedef short bf16x8 __attribute__((ext_vector_type(8)));
typedef GAS unsigned gu32;
typedef GAS unsigned long long gu64;
#define RLX_AGENT __ATOMIC_RELAXED, __HIP_MEMORY_SCOPE_AGENT
#define LDS_WAIT() asm volatile("s_waitcnt lgkmcnt(0)" ::: "memory")
#define VM_WAIT() asm volatile("s_waitcnt vmcnt(0)" ::: "memory")
__device__ __forceinline__ unsigned long long rt() { return __builtin_amdgcn_s_memrealtime(); }
__device__ __forceinline__ unsigned f2bf(float f) { unsigned u = __builtin_bit_cast(unsigned, f); return (u + 0x7fffu + ((u >> 16) & 1u)) >> 16; }
__device__ __forceinline__ unsigned pk2(float lo, float hi) { return f2bf(lo) | (f2bf(hi) << 16); }
#define XB_TMO      128
#define XB_XCNT(j)  (256  + 64 * (j))
#define XB_XSUB(j)  (1280 + 64 * (j))
#define XB_XGEN(j)  (2304 + 64 * (j))
#define XB_TOP      3328
#define XB_TOPGEN   3392
#define XCD_BAR_WORDS 3456
#define XB_SPIN_CAP (1u << 18)

__device__ __forceinline__ unsigned xb_ld(unsigned* p)              { return __hip_atomic_load(p, __ATOMIC_RELAXED, __HIP_MEMORY_SCOPE_AGENT); }
__device__ __forceinline__ unsigned xb_add(unsigned* p, unsigned v) { return __hip_atomic_fetch_add(p, v, __ATOMIC_RELAXED, __HIP_MEMORY_SCOPE_AGENT); }
__device__ __forceinline__ unsigned xb_xcc_id() { return (unsigned)__builtin_amdgcn_s_getreg((3 << 11) | 20) & 0xFu; }
#define XB_SPIN(cond, bar) do { unsigned _sp = 0; while (cond) { __builtin_amdgcn_s_sleep(1); \
    if ((++_sp & 255u) == 0u) { if (xb_ld(&(bar)[XB_TMO])) break; if (_sp > XB_SPIN_CAP) { atomicAdd(&(bar)[XB_TMO], 1u); break; } } } } while (0)

struct XcdBarrier {
    unsigned* bar; unsigned x;
    volatile LAS unsigned* st;
};

__device__ __forceinline__ XcdBarrier xcd_barrier_post(unsigned* bar, volatile LAS unsigned* st) {
    XcdBarrier b; b.bar = bar; b.x = xb_xcc_id(); b.st = st;
    if (threadIdx.x == 0) (void)xb_add(&bar[XB_XCNT(b.x)], 1u);
    return b;
}
__device__ __forceinline__ void xcd_barrier_complete(unsigned* bar, unsigned x, unsigned& nloc, unsigned& nx) {
    const unsigned G = gridDim.x * gridDim.y * gridDim.z;
    unsigned sum, cnt, mine, sp = 0u;
    for (;;) {
        sum = 0u; cnt = 0u; mine = 0u;
#pragma unroll
        for (unsigned j = 0; j < 16; ++j) { const unsigned c = xb_ld(&bar[XB_XCNT(j)]); sum += c; cnt += (c > 0u) ? 1u : 0u; mine = (j == x) ? c : mine; }
        if (sum == G) break;
        __builtin_amdgcn_s_sleep(1);
        if ((++sp & 255u) == 0u) { if (xb_ld(&bar[XB_TMO])) break; if (sp > XB_SPIN_CAP) { atomicAdd(&bar[XB_TMO], 1u); break; } }
    }
    nloc = mine > 0u ? mine : 1u; nx = cnt > 0u ? cnt : 1u;
}

__device__ __forceinline__ void xcd_barrier(const XcdBarrier& b) {
    asm volatile("s_waitcnt vmcnt(0)" ::: "memory");
    __syncthreads();
    if (threadIdx.x == 0) {
        unsigned* bar = b.bar;
        __builtin_amdgcn_s_waitcnt(0);
        unsigned nloc = b.st[0], nx = b.st[1];
        if (nloc == 0u) { xcd_barrier_complete(bar, b.x, nloc, nx); b.st[0] = nloc; b.st[1] = nx; }
        const unsigned old = xb_add(&bar[XB_XSUB(b.x)], 1u);
        const unsigned gen = old / nloc;
        if (old + 1u == (gen + 1u) * nloc) {
            __builtin_amdgcn_fence(__ATOMIC_RELEASE, "agent");
            asm volatile("s_waitcnt vmcnt(0)" ::: "memory");
            const unsigned og = xb_add(&bar[XB_TOP], 1u);
            const unsigned tg = og / nx;
            if (og + 1u == (tg + 1u) * nx) xb_add(&bar[XB_TOPGEN], 1u);
            else XB_SPIN(xb_ld(&bar[XB_TOPGEN]) == tg, bar);
            __builtin_amdgcn_fence(__ATOMIC_ACQUIRE, "agent");
            xb_add(&bar[XB_XGEN(b.x)], 1u);
            asm volatile("s_waitcnt vmcnt(0)" ::: "memory");
        } else {
            XB_SPIN(xb_ld(&bar[XB_XGEN(b.x)]) == gen, bar);
            __builtin_amdgcn_fence(__ATOMIC_ACQUIRE, "agent");
            asm volatile("s_waitcnt vmcnt(0)" ::: "memory");
        }
    }
    __syncthreads();
}
__device__ __forceinline__ float wave_sum(float v) {
#pragma unroll
    for (int o = 1; o < 64; o <<= 1) v += __shfl_xor(v, o);
    return v;
}
__device__ __forceinline__ unsigned pkbf(float lo, float hi) { return pg8::cvt_pk_bf16(lo, hi); }
__device__ __forceinline__ float bf2f(unsigned short b) { return __uint_as_float((unsigned)b << 16); }
__device__ __forceinline__ void transpose_item(const float* W, int ldn, bf16* WT, int K, int k0, int srccol0, int dstrow0, LAS float* scr, int lane, bool qf = false) {
#pragma unroll 8
    for (int i = 0; i < 32; ++i) { const int kk = 2 * i + (lane >> 5); scr[kk * 33 + (lane & 31)] = W[(size_t)(k0 + kk) * ldn + srccol0 + (lane & 31)]; }
    LDS_WAIT(); asm volatile("" ::: "memory");
    const int c = lane & 7;
#pragma unroll
    for (int j = 0; j < 4; ++j) { const int n = (lane >> 3) + 8 * j; const LAS float* s = scr + (8 * c) * 33 + n;
        v4u o; if (qf) { o.x = pkbf(qm(s[0 * 33]), qm(s[1 * 33])); o.y = pkbf(qm(s[2 * 33]), qm(s[3 * 33])); o.z = pkbf(qm(s[4 * 33]), qm(s[5 * 33])); o.w = pkbf(qm(s[6 * 33]), qm(s[7 * 33])); }
        else { o.x = pkbf(s[0 * 33], s[1 * 33]); o.y = pkbf(s[2 * 33], s[3 * 33]); o.z = pkbf(s[4 * 33], s[5 * 33]); o.w = pkbf(s[6 * 33], s[7 * 33]); }
        const int dr = dstrow0 + n; *(GAS v4u*)(WT + ((size_t)((dr >> 8) * (K >> 6) + (k0 >> 6)) * 256 + (dr & 255)) * 64 + 8 * c) = o; }
    LDS_WAIT(); asm volatile("" ::: "memory");
}
template <class INP> __device__ __forceinline__ void absmax_item(const INP& inp, unsigned char* ws, int t, LAS float* red, int tid) {
    const int col = tid & 127, kq = tid >> 7;
    const float* src; size_t ld; int kb, kn, kind, mat, cb;
    if (t < 352) { kind = 0; mat = t / 88; cb = t % 88; src = inp[12] + (size_t)mat * DM * NFF + 128 * cb + col; ld = NFF; kb = 512 * kq; kn = 512; }
    else if (t < 432) { t -= 352; kind = 1; mat = t / 40; cb = t % 40; src = inp[14] + (size_t)mat * DM * NIN + 128 * cb + col; ld = NIN; kb = 512 * kq; kn = 512; }
    else { t -= 432; kind = 2; mat = t >> 6; cb = (t & 63) >> 2; src = inp[13] + (size_t)mat * DFF * DM + 128 * cb + col; ld = DM; kb = 1408 * (t & 3) + 352 * kq; kn = 352; }
    float mx = 0.f;
    for (int k = kb; k < kb + kn; k += 8) { float w[8];
#pragma unroll
        for (int u = 0; u < 8; ++u) w[u] = src[(size_t)(k + u) * ld];
#pragma unroll
        for (int u = 0; u < 8; ++u) mx = fmaxf(mx, fabsf(w[u])); }
    red[kq * 128 + col] = mx;
    __syncthreads();
    if (tid < 128) { const float m4 = fmaxf(fmaxf(red[tid], red[128 + tid]), fmaxf(red[256 + tid], red[384 + tid])); const int s0 = 128 * cb + tid;
        if (kind == 0) { const int brow = s0 < DFF ? (s0 / 128) * 256 + (s0 % 128) : ((s0 - DFF) / 128) * 256 + 128 + ((s0 - DFF) % 128);
            ((float*)(ws + WS_Q + Q_SW))[(size_t)mat * NFF + brow] = fmaxf(m4, 1e-30f) * (1.0f / 127.0f); }
        else if (kind == 1) ((float*)(ws + WS_Q + Q_SW4))[(size_t)mat * NIN + s0] = fmaxf(m4, 1e-30f) * (1.0f / 127.0f);
        else atomicMax((unsigned*)(ws + WS_CTL + CTL_RAW2) + (size_t)mat * DM + s0, __float_as_uint(m4)); }
    __syncthreads();
}
template <class INP> __device__ __forceinline__ void prologue(const INP& inp, unsigned char* ws, LAS unsigned char* lds, int G, int wg, int tid) {
    const int lane = tid & 63, wave = __builtin_amdgcn_readfirstlane(tid >> 6);
    float* tab = (float*)(ws + WS_TAB);
    {
        LAS float* sc = (LAS float*)lds;
        LAS float* red = sc + NCOND * DM;
        bool have = false;
        for (int it = wg; it < 976; it += G) {
            if (it >= 288) { absmax_item(inp, ws, it - 288, (LAS float*)(lds + 98304), tid); continue; }
            if (!have) { for (int i = tid; i < NCOND * DM; i += 512) { const int cd = i >> 11, k = i & 2047; const float v = cd == 0 ? inp[8][k] : inp[2][(cd - 1) * DM + k];
                              sc[i] = v / (1.0f + __expf(-v)); } have = true; __syncthreads(); }
            const int l = it / 144, cb = it % 144, col = tid & 127, g = tid >> 7;
            const float* W = inp[9] + (size_t)l * DM * NMODC + 128 * cb + col;
            float acc[NCOND];
#pragma unroll
            for (int c = 0; c < NCOND; ++c) acc[c] = 0.f;
            for (int k = 512 * g; k < 512 * g + 512; k += 8) {
                float w[8];
#pragma unroll
                for (int u = 0; u < 8; ++u) w[u] = W[(size_t)(k + u) * NMODC];
#pragma unroll
                for (int c = 0; c < NCOND; ++c) { const f32x4 s0 = *(const LAS f32x4*)(sc + c * DM + k), s1 = *(const LAS f32x4*)(sc + c * DM + k + 4);
                    acc[c] += (s0[0] * w[0] + s0[1] * w[1]) + (s0[2] * w[2] + s0[3] * w[3]) + (s1[0] * w[4] + s1[1] * w[5]) + (s1[2] * w[6] + s1[3] * w[7]); }
            }
#pragma unroll
            for (int c = 0; c < NCOND; ++c) red[(g * NCOND + c) * 128 + col] = acc[c];
            __syncthreads();
            for (int i = tid; i < NCOND * 128; i += 512) { const int c = i >> 7, cc = i & 127;
                const float s = ((red[(0 * NCOND + c) * 128 + cc] + red[(1 * NCOND + c) * 128 + cc]) + red[(2 * NCOND + c) * 128 + cc]) + red[(3 * NCOND + c) * 128 + cc];
                tab[TB_MOD + ((size_t)l * NCOND + c) * NMODC + 128 * cb + cc] = s + inp[10][(size_t)l * NMODC + 128 * cb + cc]; }
            __syncthreads();
        }
        __syncthreads();
    }
    if (wg == 0) {
        for (int i = tid; i < 64 * 32; i += 512) { const int pos = i >> 5, f = i & 31; const double inv = pow(10000.0, -(double)(2 * f) / 64.0), a = (double)pos * inv;
            tab[TB_COSG + i] = (float)cos(a); tab[TB_SING + i] = (float)sin(a); }
        for (int i = tid; i < 64 * 16; i += 512) { const int pos = i >> 4, f = i & 15; const double inv = pow(10000.0, -(double)(2 * f) / 32.0), a = (double)pos * inv;
            tab[TB_COSD + i] = (float)cos(a); tab[TB_SIND + i] = (float)sin(a); }
        if (tid < 2) { const int l = tid; const float* dl = inp[19] + l * 256; double s01 = 0.0, s23 = 0.0;
            for (int i = 0; i < 64; ++i) { s01 += (double)dl[i] * (double)dl[64 + i]; s23 += (double)dl[128 + i] * (double)dl[192 + i]; }
            const double li = 0.8 - 0.6 * exp(-0.3 * (double)l);
            tab[TB_SCAL + 16 * l + 0] = (float)(exp(s01) - exp(s23) + li); tab[TB_SCAL + 16 * l + 1] = (float)(1.0 - li); }
        if (tid >= 128 && tid < 130) { const int l = tid - 128; const float* w = inp[18] + l * 256; float mq = 0.f, mk = 0.f;
            for (int i = 0; i < 128; ++i) { mq = fmaxf(mq, fabsf(w[i])); mk = fmaxf(mk, fabsf(w[128 + i])); }
            tab[TB_SCAL + 16 * l + 10] = (mq * mk * 11.313708f * 1.4426950f < 60.0f) ? 1.0f : 0.0f; }
        if (tid >= 64 && tid < 80) { const int i = tid - 64, l = i >> 3, j = i & 7; const double x = (double)inp[16][l * 8 + j];
            tab[TB_SCAL + 16 * l + 2 + j] = (float)(-log1p(exp(-x)) * 1.4426950408889634); }
    }
    {
        bf16* cb = (bf16*)(ws + WS_CACHE);
        const long gt = (long)wg * 512 + tid, GT = (long)G * 512;
        for (int t = 0; t < 4; ++t) { const float* src = inp[4 + t]; const long n8 = (t < 2 ? 1048576 : 2097152) / 8; bf16* dst = cb + (t == 0 ? 0 : t == 1 ? 1048576 : t == 2 ? 2097152 : 4194304);
            for (long i = gt; i < n8; i += GT) { const f32x4 a = *(const f32x4*)(src + i * 8), b = *(const f32x4*)(src + i * 8 + 4);
                v4u o; o.x = pkbf(a[0], a[1]); o.y = pkbf(a[2], a[3]); o.z = pkbf(b[0], b[1]); o.w = pkbf(b[2], b[3]); *(v4u*)(dst + i * 8) = o; } }
    }
    {
        LAS float* scr = (LAS float*)(lds + wave * 16384);
        const int gw = wg * 8 + wave, NGW = G * 8;
        for (int it = gw; it < 81920; it += NGW) {
            const int l = it / 40960; int r = it % 40960;
            bf16* WL = (bf16*)(ws + WS_W + (size_t)l * W_LAYER);
            if (r < 22528) continue;
            if (false) { const int f = r / 11264, q = r % 11264, kb = q / 352, nb = q % 352, s0 = 32 * nb;
                const int drow = s0 < DFF ? (s0 / 128) * 256 + (s0 % 128) : ((s0 - DFF) / 128) * 256 + 128 + ((s0 - DFF) % 128);
                transpose_item(inp[12] + (size_t)(l * 2 + f) * DM * NFF, NFF, WL + (W_WI + (size_t)f * 44 * MiB) / 2, DM, 64 * kb, s0, drow, scr, lane, true); continue; }
            r -= 22528;
            if (r < 11264) continue;
            if (false) { const int f = r / 5632, q = r % 5632, kb = q / 64, nb = q % 64;
                transpose_item(inp[13] + (size_t)(l * 2 + f) * DFF * DM, DM, WL + (W_WO + (size_t)f * 22 * MiB) / 2, DFF, 64 * kb, 32 * nb, 32 * nb, scr, lane, true); continue; }
            r -= 11264;
            if (r < 5120) { const int kb = r / 160, nb = r % 160;
                transpose_item(inp[14] + (size_t)l * DM * NIN, NIN, WL + W_WIN / 2, DM, 64 * kb, 32 * nb, 32 * nb, scr, lane); continue; }
            r -= 5120;
            { const int kb = r / 64, nb = r % 64;
                transpose_item(inp[15] + (size_t)l * DM * DM, DM, WL + W_WOUT / 2, DM, 64 * kb, 32 * nb, 32 * nb, scr, lane); }
        }
    }
}
template <class INP> __device__ __forceinline__ void prologue_b(const INP& inp, unsigned char* ws, LAS unsigned char* lds, int G, int wg, int tid) {
    const int lane = tid & 63, wave = __builtin_amdgcn_readfirstlane(tid >> 6);
    LAS float* scr = (LAS float*)(lds + wave * 16384);
    const float* swv = (const float*)(ws + WS_Q + Q_SW);
    const int gw = wg * 8 + wave, NGW = G * 8;
    const float* swv4 = (const float*)(ws + WS_Q + Q_SW4);
    if (wg < 4) {
        float sm = 0.f; for (int i = tid; i < NFF; i += 512) sm += swv[(size_t)wg * NFF + i];
#pragma unroll
        for (int o = 1; o < 64; o <<= 1) sm += __shfl_xor(sm, o);
        LAS float* red = (LAS float*)(lds + 131072);
        if (lane == 0) red[wave] = sm;
        __syncthreads();
        if (tid == 0) { float t = 0.f; for (int i = 0; i < 8; ++i) t += red[i];
            const float sg = t * (127.0f / (float)NFF) * (1.0f / 3.6f) * 45.254834f;
            const float h0 = fmaxf(fmaxf(sg * sg, sg), 1e-20f); const float sc = exp2f(1.0f - rintf(log2f(h0)));
            float* qa = (float*)(ws + WS_Q + Q_ACT) + 2 * wg; qa[0] = sc; qa[1] = 1.0f / sc; }
        __syncthreads();
    }
    for (int it = gw; it < 10240; it += NGW) {
        const int l = it / 5120, q = it % 5120, kb = q / 160, nb = q % 160, s0 = 32 * nb, k0 = 64 * kb;
        const float* W = inp[14] + (size_t)l * DM * NIN;
        unsigned char* WQ = ws + WS_W + (size_t)l * W_LAYER + W_WINQ;
#pragma unroll 8
        for (int i = 0; i < 32; ++i) { const int kk = 2 * i + (lane >> 5); scr[kk * 33 + (lane & 31)] = W[(size_t)(k0 + kk) * NIN + s0 + (lane & 31)]; }
        LDS_WAIT(); asm volatile("" ::: "memory");
        const int c = lane & 7;
#pragma unroll
        for (int j = 0; j < 4; ++j) { const int n = (lane >> 3) + 8 * j, dr = s0 + n; const LAS float* sp = scr + (8 * c) * 33 + n;
            const float inv = 1.0f / swv4[(size_t)l * NIN + dr];
            unsigned lo = 0u, hi = 0u;
#pragma unroll
            for (int e = 0; e < 4; ++e) { lo |= ((unsigned)(__float2int_rn(sp[e * 33] * inv)) & 0xffu) << (8 * e); hi |= ((unsigned)(__float2int_rn(sp[(4 + e) * 33] * inv)) & 0xffu) << (8 * e); }
            const int kk = k0 + 8 * c;
            uint2 o; o.x = lo; o.y = hi;
            *(uint2*)(WQ + ((size_t)((dr >> 8) * (DM >> 7) + (kk >> 7)) * 256 + (dr & 255)) * 128 + (kk & 127)) = o; }
        LDS_WAIT(); asm volatile("" ::: "memory");
    }
    const unsigned* raw2 = (const unsigned*)(ws + WS_CTL + CTL_RAW2);
    for (int i = wg * 512 + tid; i < 4 * DM; i += G * 512) ((float*)(ws + WS_Q + Q_SW2))[i] = fmaxf(__uint_as_float(raw2[i]), 1e-30f) * (1.0f / 240.0f);
    for (int it = gw; it < 22528; it += NGW) {
        const int mat = it / 5632, q = it % 5632, kb = q / 64, nb = q % 64, s0 = 32 * nb, k0 = 64 * kb, l = mat >> 1, f = mat & 1;
        const float* W = inp[13] + (size_t)mat * DFF * DM;
        unsigned char* WQ = ws + WS_W + (size_t)l * W_LAYER + W_WO + (size_t)f * 22 * MiB;
#pragma unroll 8
        for (int i = 0; i < 32; ++i) { const int kk = 2 * i + (lane >> 5); scr[kk * 33 + (lane & 31)] = W[(size_t)(k0 + kk) * DM + s0 + (lane & 31)]; }
        LDS_WAIT(); asm volatile("" ::: "memory");
        const int c = lane & 7;
#pragma unroll
        for (int j = 0; j < 4; ++j) { const int n = (lane >> 3) + 8 * j, dr = s0 + n; const LAS float* sp = scr + (8 * c) * 33 + n;
            const float inv = 240.0f / fmaxf(__uint_as_float(raw2[(size_t)mat * DM + dr]), 1e-30f);
            unsigned lo = __builtin_amdgcn_cvt_pk_fp8_f32(sp[0] * inv, sp[33] * inv, 0, false); lo = __builtin_amdgcn_cvt_pk_fp8_f32(sp[2 * 33] * inv, sp[3 * 33] * inv, lo, true);
            unsigned hi = __builtin_amdgcn_cvt_pk_fp8_f32(sp[4 * 33] * inv, sp[5 * 33] * inv, 0, false); hi = __builtin_amdgcn_cvt_pk_fp8_f32(sp[6 * 33] * inv, sp[7 * 33] * inv, hi, true);
            const int kk = k0 + 8 * c;
            uint2 o; o.x = lo; o.y = hi;
            *(uint2*)(WQ + ((size_t)((dr >> 8) * (DFF >> 7) + (kk >> 7)) * 256 + (dr & 255)) * 128 + (kk & 127)) = o; }
        LDS_WAIT(); asm volatile("" ::: "memory");
    }
    for (int it = gw; it < 45056; it += NGW) {
        const int mat = it / 11264, q = it % 11264, kb = q / 352, nb = q % 352, s0 = 32 * nb, k0 = 64 * kb, l = mat >> 1, f = mat & 1;
        const int drow = s0 < DFF ? (s0 / 128) * 256 + (s0 % 128) : ((s0 - DFF) / 128) * 256 + 128 + ((s0 - DFF) % 128);
        const float* W = inp[12] + (size_t)mat * DM * NFF;
        unsigned char* WQ = ws + WS_W + (size_t)l * W_LAYER + W_WI + (size_t)f * 44 * MiB;
#pragma unroll 8
        for (int i = 0; i < 32; ++i) { const int kk = 2 * i + (lane >> 5); scr[kk * 33 + (lane & 31)] = W[(size_t)(k0 + kk) * NFF + s0 + (lane & 31)]; }
        LDS_WAIT(); asm volatile("" ::: "memory");
        const int c = lane & 7;
#pragma unroll
        for (int j = 0; j < 4; ++j) { const int n = (lane >> 3) + 8 * j, dr = drow + n; const LAS float* sp = scr + (8 * c) * 33 + n;
            const float inv = 1.0f / swv[(size_t)mat * NFF + dr];
            unsigned lo = 0u, hi = 0u;
#pragma unroll
            for (int e = 0; e < 4; ++e) { lo |= ((unsigned)(__float2int_rn(sp[e * 33] * inv)) & 0xffu) << (8 * e); hi |= ((unsigned)(__float2int_rn(sp[(4 + e) * 33] * inv)) & 0xffu) << (8 * e); }
            const int kk = k0 + 8 * c;
            uint2 o; o.x = lo; o.y = hi;
            *(uint2*)(WQ + ((size_t)((dr >> 8) * (DM >> 7) + (kk >> 7)) * 256 + (dr & 255)) * 128 + (kk & 127)) = o; }
        LDS_WAIT(); asm volatile("" ::: "memory");
    }
}
__device__ __forceinline__ void quant_act_phase(const bf16* ACT, unsigned char* A8, float* sa, int G, int wg, int tid) {
    const int lane = tid & 63, wave = tid >> 6, gw = wg * 8 + wave, NGW = G * 8;
    for (int m = gw; m < MTOK; m += NGW) {
        const bf16* ar = ACT + (size_t)m * DFF;
        v4u v[11]; float mx = 0.f;
#pragma unroll
        for (int j = 0; j < 11; ++j) v[j] = *(const v4u*)(ar + 512 * j + 8 * lane);
#pragma unroll
        for (int j = 0; j < 11; ++j) { const unsigned w4[4] = {v[j].x, v[j].y, v[j].z, v[j].w};
#pragma unroll
            for (int e = 0; e < 4; ++e) mx = fmaxf(mx, fmaxf(fabsf(__uint_as_float(w4[e] << 16)), fabsf(__uint_as_float(w4[e] & 0xffff0000u)))); }
#pragma unroll
        for (int o = 1; o < 64; o <<= 1) mx = fmaxf(mx, __shfl_xor(mx, o));
        mx = fmaxf(mx, 1e-30f);
        if (lane == 0) sa[m] = mx * (1.0f / 127.0f);
        const float inv = 127.0f / mx; unsigned char* orow = A8 + (size_t)m * DFF;
#pragma unroll
        for (int j = 0; j < 11; ++j) { const unsigned w4[4] = {v[j].x, v[j].y, v[j].z, v[j].w}; unsigned o2[2] = {0u, 0u};
#pragma unroll
            for (int e = 0; e < 4; ++e) { const unsigned lo = (unsigned)__float2int_rn(__uint_as_float(w4[e] << 16) * inv) & 0xffu, hi = (unsigned)__float2int_rn(__uint_as_float(w4[e] & 0xffff0000u) * inv) & 0xffu;
                o2[e >> 1] |= (lo | (hi << 8)) << (16 * (e & 1)); }
            uint2 ov; ov.x = o2[0]; ov.y = o2[1]; *(uint2*)(orow + 512 * j + 8 * lane) = ov; }
    }
}
__device__ __forceinline__ void quant_xs_phase(const bf16* XS, const unsigned* amax, unsigned char* A8, float* sa, int G, int wg, int tid, int m_begin = 0) {
    const int lane = tid & 63, wave = tid >> 6, gw = wg * 8 + wave, NGW = G * 8;
    for (int m0 = m_begin + 2 * gw; m0 < MTOK; m0 += 2 * NGW) {
        v4u v[2][4]; float mx[2];
#pragma unroll
        for (int r = 0; r < 2; ++r) { const bf16* xr = XS + (size_t)(m0 + r) * DM; mx[r] = fmaxf(__uint_as_float(amax[m0 + r]), 1e-30f);
#pragma unroll
            for (int j = 0; j < 4; ++j) v[r][j] = *(const v4u*)(xr + 512 * j + 8 * lane); }
#pragma unroll
        for (int r = 0; r < 2; ++r) { const float inv = 127.0f / mx[r]; unsigned char* orow = A8 + (size_t)(m0 + r) * DM; if (lane == 0) sa[m0 + r] = mx[r] * (1.0f / 127.0f);
#pragma unroll
            for (int j = 0; j < 4; ++j) { const unsigned w4[4] = {v[r][j].x, v[r][j].y, v[r][j].z, v[r][j].w}; unsigned o2[2] = {0u, 0u};
#pragma unroll
                for (int e = 0; e < 4; ++e) { const unsigned lo = (unsigned)__float2int_rn(__uint_as_float(w4[e] << 16) * inv) & 0xffu, hi = (unsigned)__float2int_rn(__uint_as_float(w4[e] & 0xffff0000u) * inv) & 0xffu;
                    o2[e >> 1] |= (lo | (hi << 8)) << (16 * (e & 1)); }
                uint2 ov; ov.x = o2[0]; ov.y = o2[1]; *(uint2*)(orow + 512 * j + 8 * lane) = ov; } }
    }
}
__device__ __forceinline__ void quant_phase(const float* xP, const float* xS, const float* nw, const float* scl0  , unsigned char* A8, float* sa, unsigned long long* rss, int G, int wg, int tid, int m_begin = 0) {
    const int lane = tid & 63, wave = tid >> 6, gw = wg * 8 + wave, NGW = G * 8;
    for (int m = m_begin + gw; m < MTOK; m += NGW) {
        const float* xr = (m < M_P ? xP : xS) + (size_t)m * DM;
        const int cond = m < M_P ? 0 : 1 + ((m - M_P) >> 12);
        const float* scl = scl0 + (size_t)cond * NMODC;
        f32x4 h[8]; float ss = 0.f, mx = 0.f;
#pragma unroll
        for (int j = 0; j < 8; ++j) { const int c = 256 * j + 4 * lane; const f32x4 v = *(const f32x4*)(xr + c); ss += (v[0] * v[0] + v[1] * v[1]) + (v[2] * v[2] + v[3] * v[3]);
            h[j] = v * *(const f32x4*)(nw + c) * (*(const f32x4*)(scl + c) + 1.0f);
            mx = fmaxf(fmaxf(mx, fmaxf(fabsf(h[j][0]), fabsf(h[j][1]))), fmaxf(fabsf(h[j][2]), fabsf(h[j][3]))); }
        ss = wave_sum(ss);
#pragma unroll
        for (int o = 1; o < 64; o <<= 1) mx = fmaxf(mx, __shfl_xor(mx, o));
        mx = fmaxf(mx, 1e-30f);
        if (lane == 0) { rss[m] = (unsigned long long)(ss * 16777216.0f); sa[m] = mx * (1.0f / 127.0f); }
        const float inv = 127.0f / mx; unsigned char* orow = A8 + (size_t)m * DM;
#pragma unroll
        for (int j = 0; j < 8; ++j) { const unsigned w = ((unsigned)__float2int_rn(h[j][0] * inv) & 0xffu) | (((unsigned)__float2int_rn(h[j][1] * inv) & 0xffu) << 8) | (((unsigned)__float2int_rn(h[j][2] * inv) & 0xffu) << 16) | (((unsigned)__float2int_rn(h[j][3] * inv) & 0xffu) << 24);
            *(unsigned*)(orow + 256 * j + 4 * lane) = w; }
    }
}
__device__ __forceinline__ void norm0_phase(const float* xP, const float* xS, const float* nw, const float* mod  , bf16* XN, unsigned long long* rss, int G, int wg, int tid) {
    const int lane = tid & 63, wave = tid >> 6, gw = wg * 8 + wave, NGW = G * 8;
    for (int m = gw; m < MTOK; m += NGW) {
        const float* xr = (m < M_P ? xP : xS) + (size_t)m * DM;
        const int cond = m < M_P ? 0 : 1 + ((m - M_P) >> 12);
        const float* scl = mod + (size_t)cond * NMODC + DM;
        f32x4 v[8]; float ss = 0.f;
#pragma unroll
        for (int j = 0; j < 8; ++j) { v[j] = *(const f32x4*)(xr + 256 * j + 4 * lane); ss += (v[j][0] * v[j][0] + v[j][1] * v[j][1]) + (v[j][2] * v[j][2] + v[j][3] * v[j][3]); }
        ss = wave_sum(ss); if (lane == 0) rss[m] = (unsigned long long)(ss * 16777216.0f);
        bf16* orow = XN + (size_t)m * DM;
#pragma unroll
        for (int j = 0; j < 8; ++j) { const int c = 256 * j + 4 * lane; const f32x4 w = *(const f32x4*)(nw + c), s1 = *(const f32x4*)(scl + c);
            const f32x4 h = v[j] * w * (s1 + 1.0f);
            uint2 o; o.x = pkbf(qm(h[0]), qm(h[1])); o.y = pkbf(qm(h[2]), qm(h[3])); *(uint2*)(orow + c) = o; }
    }
}
__device__ __forceinline__ void bias_ffn_mfma(unsigned char* ws, LAS unsigned char* lds, int grp, int sub, int nsub, int tid) {
    typedef int i32x4_t __attribute__((ext_vector_type(4)));
    const int lane = tid & 63, wave = tid >> 6, l = grp >> 1, f = grp & 1;
    const float* mod = (const float*)(ws + WS_TAB) + TB_MOD + (size_t)l * NCOND * NMODC + (size_t)(6 * f) * DM;
    LAS unsigned char* D = lds;
    LAS float* red = (LAS float*)(lds + 65536);
    __syncthreads();
    for (int i = tid; i < 65536 / 16; i += 512) ((LAS v4u*)D)[i] = (v4u){0u, 0u, 0u, 0u};
    for (int c = wave; c < NCOND; c += 8) { float mx = 0.f; for (int k = lane; k < DM; k += 64) mx = fmaxf(mx, fabsf(mod[(size_t)c * NMODC + k]));
#pragma unroll
        for (int o = 1; o < 64; o <<= 1) mx = fmaxf(mx, __shfl_xor(mx, o));
        if (lane == 0) red[c] = fmaxf(mx, 1e-30f) * (1.0f / 127.0f); }
    __syncthreads();
    for (int i = tid; i < NCOND * DM; i += 512) { const int c = i >> 11, k = i & 2047; const float s0 = red[c], s1 = s0 * (1.0f / 127.0f), v = mod[(size_t)c * NMODC + k];
        const float d0 = rintf(v / s0), d1 = rintf((v - d0 * s0) / s1); const int off = ((k >> 6) * 16 + c) * 64 + (k & 63);
        D[off] = (unsigned char)(int)d0; D[32768 + off] = (unsigned char)(int)d1; }
    __syncthreads();
    const unsigned char* Bq = ws + WS_W + (size_t)l * W_LAYER + W_WI + (size_t)f * 44 * MiB;
    const float* swv = (const float*)(ws + WS_Q + Q_SW) + (size_t)(2 * l + f) * NFF;
    float* sb = (float*)(ws + WS_SB) + (size_t)l * SB_LAYER + (f ? SB_J2 : 0);
    const int jr = lane & 15, g = lane >> 4;
    for (int rg = sub * 8 + wave; rg < NFF / 16; rg += nsub * 8) {
        const int n = rg * 16 + jr;
        const unsigned char* wp = Bq + ((size_t)(n >> 8) * (DM >> 7) * 256 + (n & 255)) * 128 + 16 * g;
        i32x4_t a0 = {0, 0, 0, 0}, a1 = {0, 0, 0, 0};
#pragma unroll 4
        for (int kb = 0; kb < 32; ++kb) {
            const i32x4_t w = *(const i32x4_t*)(wp + (size_t)(kb >> 1) * 256 * 128 + (kb & 1) * 64);
            const i32x4_t d0 = *(const LAS i32x4_t*)(D + ((kb * 16 + jr) * 64 + 16 * g)), d1 = *(const LAS i32x4_t*)(D + 32768 + ((kb * 16 + jr) * 64 + 16 * g));
            a0 = __builtin_amdgcn_mfma_i32_16x16x64_i8(w, d0, a0, 0, 0, 0); a1 = __builtin_amdgcn_mfma_i32_16x16x64_i8(w, d1, a1, 0, 0, 0);
        }
        if (jr < NCOND) { const float s0 = red[jr], s1 = s0 * (1.0f / 127.0f);
#pragma unroll
            for (int r = 0; r < 4; ++r) { const int nn = rg * 16 + 4 * g + r; sb[(size_t)jr * NFF + nn] = swv[nn] * (s0 * (float)a0[r] + s1 * (float)a1[r]); } }
    }
    __syncthreads();
}
__device__ __forceinline__ void bias_phase(unsigned char* ws, LAS unsigned char* lds, int G, int wg, int tid) {
    const int lane = tid & 63, wave = tid >> 6, gw = wg * 8 + wave, NGW = G * 8;
    LAS float* sh = (LAS float*)lds;
    const float* tab = (const float*)(ws + WS_TAB);
    const int per = G / 4; const bool mf = per >= 1;
    if (mf && wg < 4 * per) bias_ffn_mfma(ws, lds, wg / per, wg % per, per, tid);
    for (int grp = 0; grp < 6; ++grp) {
        const int l = grp / 3, j = grp % 3, N = (j == 1) ? NIN : NFF;
        if (mf && j != 1) continue;
        const bf16* Bt = (const bf16*)(ws + WS_W + (size_t)l * W_LAYER + (j == 0 ? W_WI : j == 1 ? W_WIN : W_WI + 44 * MiB));
        float* sb = (float*)(ws + WS_SB) + (size_t)l * SB_LAYER + (j == 0 ? 0 : j == 1 ? SB_J1 : SB_J2);
        const float* mod = tab + TB_MOD + (size_t)l * NCOND * NMODC + (size_t)(3 * j) * DM;
        __syncthreads();
        for (int i = tid; i < NCOND * DM; i += 512) sh[i] = mod[(size_t)(i >> 11) * NMODC + (i & 2047)];
        __syncthreads();
        if (j != 1) {
            const unsigned char* Bq = (const unsigned char*)Bt; const float* swv = (const float*)(ws + WS_Q + Q_SW) + (size_t)(2 * l + (j >> 1)) * NFF;
            for (int n = gw; n < N; n += NGW) {
                v4u wr2[2];
#pragma unroll
                for (int q = 0; q < 2; ++q) { const int k_ = 16 * (lane + 64 * q); wr2[q] = *(const v4u*)(Bq + ((size_t)((n >> 8) * (DM >> 7) + (k_ >> 7)) * 256 + (n & 255)) * 128 + (k_ & 127)); }
                float wf[2][16];
#pragma unroll
                for (int q = 0; q < 2; ++q) { const unsigned ww[4] = {wr2[q].x, wr2[q].y, wr2[q].z, wr2[q].w};
#pragma unroll
                    for (int e = 0; e < 16; ++e) wf[q][e] = (float)(int)(signed char)((ww[e >> 2] >> (8 * (e & 3))) & 0xffu); }
                const float swn = swv[n];
#pragma unroll 1
                for (int c = 0; c < NCOND; ++c) { float a = 0.f;
#pragma unroll
                    for (int q = 0; q < 2; ++q) { const int k = 16 * (lane + 64 * q);
#pragma unroll
                        for (int e4 = 0; e4 < 4; ++e4) { const f32x4 s0 = *(const LAS f32x4*)(sh + c * DM + k + 4 * e4); a += (s0[0] * wf[q][4 * e4] + s0[1] * wf[q][4 * e4 + 1]) + (s0[2] * wf[q][4 * e4 + 2] + s0[3] * wf[q][4 * e4 + 3]); } }
                    const float t = wave_sum(a); if (lane == 0) sb[(size_t)c * N + n] = t * swn; }
            }
            continue;
        }
        v4u wq[4];
        if (gw < N) {
#pragma unroll
            for (int q = 0; q < 4; ++q) { const int k_ = 8 * (lane + 64 * q); wq[q] = *(const v4u*)(Bt + ((size_t)((gw >> 8) * (DM >> 6) + (k_ >> 6)) * 256 + (gw & 255)) * 64 + (k_ & 63)); } }
        for (int n = gw; n < N; n += NGW) {
            v4u wc_[4];
#pragma unroll
            for (int q = 0; q < 4; ++q) wc_[q] = wq[q];
            if (n + NGW < N) {
#pragma unroll
                for (int q = 0; q < 4; ++q) { const int k_ = 8 * (lane + 64 * q), n_ = n + NGW; wq[q] = *(const v4u*)(Bt + ((size_t)((n_ >> 8) * (DM >> 6) + (k_ >> 6)) * 256 + (n_ & 255)) * 64 + (k_ & 63)); } }
            float wf[4][8];
#pragma unroll
            for (int q = 0; q < 4; ++q) { const v4u w4 = wc_[q];
                wf[q][0] = __uint_as_float(w4.x << 16); wf[q][1] = __uint_as_float(w4.x & 0xffff0000u); wf[q][2] = __uint_as_float(w4.y << 16); wf[q][3] = __uint_as_float(w4.y & 0xffff0000u);
                wf[q][4] = __uint_as_float(w4.z << 16); wf[q][5] = __uint_as_float(w4.z & 0xffff0000u); wf[q][6] = __uint_as_float(w4.w << 16); wf[q][7] = __uint_as_float(w4.w & 0xffff0000u); }
#pragma unroll 1
            for (int c = 0; c < NCOND; ++c) { float a = 0.f;
#pragma unroll
                for (int q = 0; q < 4; ++q) { const int k = 8 * (lane + 64 * q); const f32x4 s0 = *(const LAS f32x4*)(sh + c * DM + k), s1 = *(const LAS f32x4*)(sh + c * DM + k + 4);
                    a += (s0[0] * wf[q][0] + s0[1] * wf[q][1]) + (s0[2] * wf[q][2] + s0[3] * wf[q][3]) + (s1[0] * wf[q][4] + s1[1] * wf[q][5]) + (s1[2] * wf[q][6] + s1[3] * wf[q][7]); }
                const float t = wave_sum(a); if (lane == 0) sb[(size_t)c * N + n] = t; }
        }
    }
    __syncthreads();
}
__device__ __forceinline__ void final_norm(float* x, const float* fw, int G, int wg, int tid) {
    const int lane = tid & 63, wave = tid >> 6, gw = wg * 8 + wave, NGW = G * 8;
    for (int m = gw; m < MTOK; m += NGW) {
        float* xr = x + (size_t)m * DM; f32x4 v[8]; float ss = 0.f;
#pragma unroll
        for (int j = 0; j < 8; ++j) { v[j] = *(const f32x4*)(xr + 256 * j + 4 * lane); ss += (v[j][0] * v[j][0] + v[j][1] * v[j][1]) + (v[j][2] * v[j][2] + v[j][3] * v[j][3]); }
        const float rstd = rsqrtf(wave_sum(ss) * (1.0f / DM) + EPS);
#pragma unroll
        for (int j = 0; j < 8; ++j) { const int c = 256 * j + 4 * lane; *(f32x4*)(xr + c) = (v[j] * rstd) * *(const f32x4*)(fw + c); }
    }
}
__device__ __forceinline__ void prep_row(int m, int l, bf16* PROJ, bf16* DST, const float* tab, const float* qkw  , float* out, int lane) {
    bf16* pr = PROJ + (size_t)m * NIN; bf16* pw = DST + (size_t)m * NIN;
    const bool lat = m >= M_P; const int t = lat ? ((m - M_P) & 4095) : (m & 255), b = lat ? ((m - M_P) >> 12) : (m >> 8);
    const int rr = t >> 6, cc = t & 63;
    unsigned rg[10], rd[8], rv2[2], rv4[4];
#pragma unroll
    for (int v = 0; v < 10; ++v) rg[v] = *(const unsigned*)(pr + (v < 8 ? C_GQ + 128 * v : C_GK + 128 * (v - 8)) + 2 * lane);
#pragma unroll
    for (int v = 0; v < 8; ++v) rd[v] = *(const unsigned*)(pr + (v < 4 ? C_DQ + 128 * v : C_DK + 128 * (v - 4)) + 2 * lane);
    if (!lat) {
#pragma unroll
        for (int v = 0; v < 2; ++v) rv2[v] = *(const unsigned*)(pr + C_GV + 128 * v + 2 * lane);
#pragma unroll
        for (int v = 0; v < 4; ++v) rv4[v] = *(const unsigned*)(pr + C_DV + 128 * v + 2 * lane);
    }
    const float wq0 = qkw[2 * lane], wq1 = qkw[2 * lane + 1], wk0 = qkw[128 + 2 * lane], wk1 = qkw[128 + 2 * lane + 1];
    float cs = 1.f, sn = 0.f, c2 = 1.f, s2 = 0.f;
    if (lat) { const int idx = lane < 32 ? rr * 32 + lane : cc * 32 + (lane - 32); cs = tab[TB_COSG + idx]; sn = tab[TB_SING + idx];
               const int p = lane & 31, id2 = p < 16 ? rr * 16 + p : cc * 16 + (p - 16); c2 = tab[TB_COSD + id2]; s2 = tab[TB_SIND + id2]; }
#pragma unroll
    for (int v = 0; v < 10; ++v) {
        const int col = (v < 8 ? C_GQ + 128 * v : C_GK + 128 * (v - 8)) + 2 * lane;
        const float x1 = bf2f((unsigned short)(rg[v] & 0xffffu)), x2 = bf2f((unsigned short)(rg[v] >> 16));
        const float rs = rsqrtf(wave_sum(x1 * x1 + x2 * x2) * (1.0f / 128.0f) + EPS);
        const float y1 = x1 * rs * (v < 8 ? wq0 : wk0), y2 = x2 * rs * (v < 8 ? wq1 : wk1);
        if (!lat && v >= 8) { float* o = out + O_GK + (((size_t)(b * 2 + l) * 256 + t) * 2 + (v - 8)) * 128 + 2 * lane; o[0] = y1; o[1] = y2; }
        const float qs = v < 8 ? 0.12751743f : 1.0f;
        *(unsigned*)(pw + col) = pkbf((y1 * cs - y2 * sn) * qs, (y1 * sn + y2 * cs) * qs);
    }
    if (lat) {
#pragma unroll
        for (int v = 0; v < 8; ++v) { const int col = (v < 4 ? C_DQ + 128 * v : C_DK + 128 * (v - 4)) + 2 * lane;
            const float x1 = bf2f((unsigned short)(rd[v] & 0xffffu)), x2 = bf2f((unsigned short)(rd[v] >> 16));
            *(unsigned*)(pw + col) = pkbf(x1 * c2 - x2 * s2, x1 * s2 + x2 * c2); }
    } else {
#pragma unroll
        for (int v = 0; v < 2; ++v) { float* o = out + O_GV + (((size_t)(b * 2 + l) * 256 + t) * 2 + v) * 128 + 2 * lane; o[0] = bf2f((unsigned short)(rv2[v] & 0xffffu)); o[1] = bf2f((unsigned short)(rv2[v] >> 16)); }
#pragma unroll
        for (int v = 0; v < 4; ++v) { const unsigned rk = rd[4 + v], rv = rv4[v];
            const size_t oi = (((size_t)(b * 2 + l) * 256 + t) * 4 + v) * 128 + 2 * lane;
            out[O_DK + oi] = bf2f((unsigned short)(rk & 0xffffu)); out[O_DK + oi + 1] = bf2f((unsigned short)(rk >> 16));
            out[O_DV + oi] = bf2f((unsigned short)(rv & 0xffffu)); out[O_DV + oi + 1] = bf2f((unsigned short)(rv >> 16)); }
    }
}
#ifndef EN_PRO
#define EN_PRO 1
#endif
#ifndef EN_NORM
#define EN_NORM 1
#endif
#ifndef EN_FFNIN
#define EN_FFNIN 1
#endif
#ifndef EN_FFNOUT
#define EN_FFNOUT 1
#endif
#ifndef EN_WIN
#define EN_WIN 1
#endif
#ifndef EN_P
#define EN_P 1
#endif
#ifndef EN_A
#define EN_A 1
#endif
#ifndef EN_A1
#define EN_A1 1
#endif
#ifndef EN_A2
#define EN_A2 1
#endif
#ifndef EN_A3
#define EN_A3 1
#endif
#ifndef EN_WOUT
#define EN_WOUT 1
#endif
#ifndef EN_FIN
#define EN_FIN 1
#endif
struct Args { const float* in[22]; float* out; unsigned char* ws; int ph_lo, ph_hi, pad0, pad1; };
constexpr int NPHASE = 30;
#define LAUNDER(p) asm volatile("" : "+s"(p))
struct InPtrs { const float* const* p; __device__ __forceinline__ const float* operator[](int i) const { return p[i]; } };
__device__ __forceinline__ int deal_unit(int i, int NL, int NC, int off, int G, int wg) {
    if (NL % G == 0) { const int nr = NL / G; if (i < nr) return i * G + wg; if (i > nr) return -1; const int c = (wg + G - off) % G; return c < NC ? NL + c : -1; }
    const int v = i * G + wg; return v < NL + NC ? v : -1;
}
__global__ void __launch_bounds__(512, 2) fwd_kernel(Args args) {
    extern __shared__ __attribute__((aligned(16))) unsigned char lds_raw[];
    LAS unsigned char* lds = (LAS unsigned char*)lds_raw;
    volatile LAS unsigned* MISC = (volatile LAS unsigned*)(lds + MISC_OFF);
    const int G = gridDim.x, wg = blockIdx.x;
    for (int u = threadIdx.x; u < (LDS_BYTES - 131072) / 4; u += 512) ((LAS unsigned*)(lds + 131072))[u] = 0u;
    __syncthreads();
    XcdBarrier bar = xcd_barrier_post((unsigned*)(args.ws + WS_CTL) + CW_BAR, MISC + 8);
    const int lo = args.ph_lo, hi = args.ph_hi;
#define IN(k) (lo <= (k) && (k) < hi)
#define SEAM(k) do { if (IN(k) && IN((k) + 1)) xcd_barrier(bar); } while (0)
#define PH_BEGIN size_t zoff_ = 0; asm volatile("" : "+s"(zoff_)); unsigned char* ws = args.ws + zoff_; float* out = args.out + zoff_;   \
    const InPtrs inp{args.in}; int tid = threadIdx.x; asm volatile("" : "+v"(tid)); \
    const int lane = tid & 63, wave = __builtin_amdgcn_readfirstlane(tid >> 6); (void)lane; (void)wave;

    if (IN(0)) { PH_BEGIN; (void)out; prologue(inp, ws, lds, G, wg, tid); }
    SEAM(0);
    if (IN(1)) { PH_BEGIN; (void)out; prologue_b(inp, ws, lds, G, wg, tid); }
    SEAM(1);
    if (IN(2)) { PH_BEGIN; (void)out;
        quant_phase(inp[0], inp[1] - (size_t)M_P * DM, inp[11], (const float*)(ws + WS_TAB) + TB_MOD + DM, ws + WS_XNB, (float*)(ws + WS_Q), (unsigned long long*)(ws + WS_RS), G, wg, tid);
        bias_phase(ws, lds, G, wg, tid); }
    SEAM(2);
#pragma unroll 1
    for (int l = 0; l < 2; ++l) {
        const int pb = 3 + 13 * l;
#pragma unroll 1
        for (int f = 0; f < 2; ++f) {
            const int fb = pb + 9 * f;
            if (IN(fb + 0)) { PH_BEGIN; (void)out; (void)inp; const bf16* WL = (const bf16*)(ws + WS_W + (size_t)l * W_LAYER);
                pg8::Gemm g{(const bf16*)(ws + WS_XNB), WL + (W_WI + (size_t)f * 44 * MiB) / 2, MTOK, NFF, DM / 2}; pg8::StaticOrder S; S.init(MTOK, NFF, G, wg);
                pg8::EpiSwiGLUQ E{ws + WS_A8B, DFF, (const unsigned long long*)(ws + WS_RS) + (size_t)(3 * l + 2 * f) * MTOK, (const float*)(ws + WS_Q), (const float*)(ws + WS_Q + Q_SW) + (size_t)(2 * l + f) * NFF,
                                  (const float*)(ws + WS_SB) + (size_t)l * SB_LAYER + (f ? SB_J2 : 0), NFF, (const float*)(ws + WS_Q + Q_ACT) + 2 * (2 * l + f)};
                pg8::gemm_phase<pg8::EpiSwiGLUQ, pg8::StaticOrder, true, true, true>(lds, g, S, E); }
            if (IN(fb + 0) && IN(fb + 2)) xcd_barrier(bar);
            if (IN(fb + 2)) { PH_BEGIN; float* X = out + O_X; const bool first = (l == 0 && f == 0); const unsigned char* WL8 = ws + WS_W + (size_t)l * W_LAYER + W_WO + (size_t)f * 22 * MiB;
                const float* tabf = (const float*)(ws + WS_TAB); const float* mod = tabf + TB_MOD + (size_t)l * NCOND * NMODC;
                pg8::Gemm g{(const bf16*)(ws + WS_A8B), (const bf16*)WL8, MTOK, DM, DFF / 2}; pg8::StaticOrder S; S.init(MTOK, DM, G, wg);
                const int ni = f ? 3 * (l + 1) : 3 * l + 1;
                const size_t rs_off = WS_RS + (size_t)ni * MTOK * 8;
                pg8::EpiResidN E{first ? inp[0] : X, first ? inp[1] - (size_t)M_P * DM : X, X, mod + (2 + 6 * f) * DM,
                                 inp[11] + (size_t)(f ? 3 : 3 * l + 1) * DM, f ? tabf + TB_MOD + (size_t)NCOND * NMODC + DM : mod + (size_t)4 * DM, (unsigned long long*)(ws + rs_off), (long)(f ? WS_ACT : WS_XN) - (long)rs_off, 0.5f, (f && l) ? 0 : 1,
                                 (long)(WS_Q + Q_ACT + (size_t)(2 * (2 * l + f) + 1) * 4) - (long)rs_off, (long)(WS_Q + Q_SW2 + (size_t)(2 * l + f) * DM * 4) - (long)rs_off, 2, 1, (long)(WS_CTL + CTL_AMAX + (size_t)ni * MTOK * 4) - (long)rs_off};
                pg8::gemm_phase<pg8::EpiResidN, pg8::StaticOrder, true, true, 2>(lds, g, S, E); }
            SEAM(fb + 2);
            if (f == 1) {
                if (l == 0 && IN(pb + 12)) { PH_BEGIN; float* X = out + O_X;
                    (void)X; quant_xs_phase((const bf16*)(ws + WS_ACT), (const unsigned*)(ws + WS_CTL + CTL_AMAX) + (size_t)3 * MTOK, ws + WS_XNB, (float*)(ws + WS_Q), G, wg, tid); }
                SEAM(pb + 12);
                break; }
            if (IN(pb + 3)) { PH_BEGIN; float* X = out + O_X;
                (void)X; quant_xs_phase((const bf16*)(ws + WS_XN), (const unsigned*)(ws + WS_CTL + CTL_AMAX) + (size_t)(3 * l + 1) * MTOK, ws + WS_XNB, (float*)(ws + WS_Q), G, wg, tid, M_P); }
            SEAM(pb + 3);
            if (IN(pb + 4)) {
                { PH_BEGIN; (void)out; (void)inp;
                  pg8::Gemm g{(const bf16*)(ws + WS_XNB + (size_t)M_P * DM), (const bf16*)(ws + WS_W + (size_t)l * W_LAYER + W_WINQ), M_S, NIN, DM / 2}; pg8::StaticOrder S; S.init(M_S, NIN, G, wg);
                  pg8::EpiStoreQ E{(bf16*)(ws + WS_ACT) + (size_t)M_P * NIN, NIN, (const unsigned long long*)(ws + WS_RS) + (size_t)(3 * l + 1) * MTOK + M_P, (const float*)(ws + WS_Q) + M_P,
                                   (const float*)(ws + WS_Q + Q_SW4) + (size_t)l * NIN, (const float*)(ws + WS_SB) + (size_t)l * SB_LAYER + SB_J1, NIN, 16};
                  pg8::gemm_phase<pg8::EpiStoreQ, pg8::StaticOrder, true, true, true>(lds, g, S, E); }
                { PH_BEGIN; (void)out; (void)inp; const bf16* WL = (const bf16*)(ws + WS_W + (size_t)l * W_LAYER);
                  pg8::Gemm g{(const bf16*)(ws + WS_XN), WL + W_WIN / 2, M_P, NIN, DM}; pg8::StaticOrder S; S.init(M_P, NIN, G, wg);
                  pg8::EpiStoreBf16N E{(bf16*)(ws + WS_ACT), NIN, (const unsigned long long*)(ws + WS_RS) + (size_t)(3 * l + 1) * MTOK, (const float*)(ws + WS_SB) + (size_t)l * SB_LAYER + SB_J1, NIN};
                  pg8::gemm_phase<pg8::EpiStoreBf16N, pg8::StaticOrder, true, true>(lds, g, S, E); }
            }
            SEAM(pb + 4);
            if (IN(pb + 5)) { PH_BEGIN; bf16* PROJ = (bf16*)(ws + WS_ACT); const float* tab = (const float*)(ws + WS_TAB);
#pragma unroll 1
                for (int ch = wg; ch < 192; ch += G) {
                    const bool lat = ch < 64; const int cc = lat ? ch : ch - 64, dir = cc & 1, h = (cc >> 1) & 3, b = cc >> 3;
                    att::ChainArgs a; a.P = PROJ + (size_t)(lat ? M_P + b * 4096 : b * 256) * NIN; a.kcol = C_RK + 128 * h; a.vcol = C_RV + 128 * h; a.nchunk = lat ? 32 : 2; a.dir = dir;
                    a.lg2 = tab[TB_SCAL + 16 * l + 2 + dir * 4 + h];
                    a.S0 = lat ? inp[3] + ((((size_t)b * 2 + l) * 2 + dir) * 4 + h) * 16384 : nullptr;
                    a.ST = (bf16*)(ws + WS_ST) + (lat ? (size_t)cc * 32 * 16384 : (size_t)64 * 32 * 16384 + (size_t)cc * 2 * 16384);
                    a.Sfin = lat ? nullptr : out + O_STATE + ((((size_t)b * 2 + l) * 2 + dir) * 4 + h) * 16384;
                    __syncthreads(); att::ret_chain(a, (char*)lds_raw);
                }
                const int w0 = G > 128 ? 64 : 0, gw = (wg - w0) * 8 + wave, NGW = (G - w0) * 8;
                if (wg >= w0) for (int m = gw; m < MTOK; m += NGW) prep_row(m, l, PROJ, PROJ, tab, inp[18] + l * 256, out, lane);
            }
            SEAM(pb + 5);
            if (IN(pb + 6)) { PH_BEGIN; (void)out; bf16* PROJ = (bf16*)(ws + WS_ACT); bf16* MIX = (bf16*)(ws + WS_XN); const float* tab = (const float*)(ws + WS_TAB);
                const bf16* CGK = (const bf16*)(ws + WS_CACHE);
#pragma unroll 1
                for (int rp = 0; rp < ((PROBE == 13 && l == 0) ? 2 : 1); ++rp)
#pragma unroll 1
                for (int i2 = 0;; ++i2) { const int ps = i2 & 1; const int u = deal_unit(i2 >> 1, 512, 64, 192, G, wg); if (u < 0) break;
                    const bool lat = u < 512; const int v = lat ? u : u - 512;
                    const int qb = lat ? (v & 15) : 0, h = lat ? ((v >> 4) & 3) : (v & 3), b = lat ? (v >> 6) : (v >> 2);
                    const size_t row0 = lat ? (size_t)M_P + (size_t)b * 4096 : (size_t)b * 256;
                    const float lam = tab[TB_SCAL + 16 * l + 0], post = tab[TB_SCAL + 16 * l + 1];
                    {
                        att::KVSrc kv; kv.K1 = PROJ + row0 * NIN + C_DK + 128 * h + 64 * ps; kv.V1 = PROJ + row0 * NIN + C_DV + 128 * h; kv.n1 = lat ? 4096 : 256;
                        kv.K2 = CGK + 2097152 + ((size_t)(b * 2 + l) * 256) * 512 + 128 * h + 64 * ps; kv.V2 = CGK + 4194304 + ((size_t)(b * 2 + l) * 256) * 512 + 128 * h; kv.n2 = lat ? 256 : 0;
                        att::AttnOut ao; ao.Ob = MIX + (row0 + 256 * qb) * DM + 1536 + 128 * h; ao.Of = (float*)(ws + WS_DF) + (row0 + 256 * qb) * 512 + 128 * h;
                        ao.nw = inp[20] + l * 512 + 128 * h; ao.lam = lam; ao.post = post; ao.pass = ps;
                        __syncthreads();
                        att::attn_body<64, 1, 512>(PROJ + (row0 + 256 * qb) * NIN + C_DQ + 128 * h + 64 * ps, kv, ao, (char*)lds_raw);
                    }
                }
                const bool nomax = tab[TB_SCAL + 16 * l + 10] != 0.f;
#pragma unroll 1
                for (int rp = 0; rp < ((PROBE == 14 && l == 0) ? 2 : 1); ++rp)
#pragma unroll 1
                for (int i = 0;; ++i) { const int u = deal_unit(i, 1024, 128, 64, G, wg); if (u < 0) break;
                    const bool lat = u < 1024; const int v = lat ? u : u - 1024;
                    const int qb = lat ? (v & 15) : 0, hq = lat ? ((v >> 4) & 7) : (v & 7), b = lat ? (v >> 7) : (v >> 3), kvh = hq >> 2;
                    const size_t row0 = lat ? (size_t)M_P + (size_t)b * 4096 : (size_t)b * 256;
                    att::KVSrc kv; kv.K1 = PROJ + row0 * NIN + C_GK + 128 * kvh; kv.V1 = PROJ + row0 * NIN + C_GV + 128 * kvh; kv.n1 = lat ? 4096 : 256;
                    kv.K2 = CGK + ((size_t)(b * 2 + l) * 256) * 256 + 128 * kvh; kv.V2 = CGK + 1048576 + ((size_t)(b * 2 + l) * 256) * 256 + 128 * kvh; kv.n2 = lat ? 256 : 0;
                    att::AttnOut ao; ao.Ob = MIX + (row0 + 256 * qb) * DM + 512 + 128 * hq; ao.Of = nullptr; ao.nw = nullptr; ao.lam = 0.f; ao.post = 0.f; ao.pass = 0;
                    __syncthreads();
                    if (nomax) att::attn_body<128, 0, 256, 1>(PROJ + (row0 + 256 * qb) * NIN + C_GQ + 128 * hq, kv, ao, (char*)lds_raw);
                    else att::attn_body<128, 0, 256, 2>(PROJ + (row0 + 256 * qb) * NIN + C_GQ + 128 * hq, kv, ao, (char*)lds_raw);
                }
#pragma unroll 1
                for (int rp = 0; rp < ((PROBE == 15 && l == 0) ? 2 : 1); ++rp)
#pragma unroll 1
                for (int i = 0;; ++i) { const int u = deal_unit(i, 512, 64, 0, G, wg); if (u < 0) break;
                    const bool lat = u < 512; const int v = lat ? u : u - 512;
                    const int pr = lat ? (v & 15) : 0, h = lat ? ((v >> 4) & 3) : (v & 3), b = lat ? (v >> 6) : (v >> 2);
                    const size_t row0 = (lat ? (size_t)M_P + (size_t)b * 4096 : (size_t)b * 256) + 256 * pr;
                    att::RetCArgs a; a.P = PROJ + row0 * NIN; a.qcol = C_RQ + 128 * h; a.kcol = C_RK + 128 * h; a.vcol = C_RV + 128 * h; a.gcol = C_RG + 128 * h;
                    a.lg2f = tab[TB_SCAL + 16 * l + 2 + h]; a.lg2b = tab[TB_SCAL + 16 * l + 6 + h];
                    const int cf = (b * 4 + h) * 2; const bf16* STB = (const bf16*)(ws + WS_ST);
                    a.STf = STB + (lat ? (size_t)cf * 32 * 16384 : (size_t)64 * 32 * 16384 + (size_t)cf * 2 * 16384) + (size_t)(2 * pr) * 16384;
                    a.STb = STB + (lat ? (size_t)(cf + 1) * 32 * 16384 : (size_t)64 * 32 * 16384 + (size_t)(cf + 1) * 2 * 16384) + (size_t)(2 * pr) * 16384;
                    a.gnw = inp[17] + l * 512 + 128 * h; a.O = MIX + row0 * DM + 128 * h;
                    __syncthreads();
                    att::ret_c(a, (char*)lds_raw);
                }
            }
            SEAM(pb + 6);
            if (IN(pb + 7)) { PH_BEGIN; float* X = out + O_X; const bf16* WL = (const bf16*)(ws + WS_W + (size_t)l * W_LAYER);
                const float* mod = (const float*)(ws + WS_TAB) + TB_MOD + (size_t)l * NCOND * NMODC;
                pg8::Gemm g{(const bf16*)(ws + WS_XN), WL + W_WOUT / 2, MTOK, DM, DM}; pg8::StaticOrder S; S.init(MTOK, DM, G, wg);
                const size_t rs_off = WS_RS + (size_t)(3 * l + 2) * MTOK * 8;
                pg8::EpiResidN E{X, X, X, mod + 5 * DM, inp[11] + ((size_t)l * 3 + 2) * DM, mod + 7 * DM, (unsigned long long*)(ws + rs_off), (long)WS_ACT - (long)rs_off, 1.0f, 1, (long)WS_Q - (long)rs_off, (long)WS_Q - (long)rs_off, 0, 1, (long)(WS_CTL + CTL_AMAX + (size_t)(3 * l + 2) * MTOK * 4) - (long)rs_off};
                pg8::gemm_phase<pg8::EpiResidN, pg8::StaticOrder, true, true>(lds, g, S, E); }
            SEAM(pb + 7);
            if (IN(pb + 8)) { PH_BEGIN; float* X = out + O_X;
                (void)X; quant_xs_phase((const bf16*)(ws + WS_ACT), (const unsigned*)(ws + WS_CTL + CTL_AMAX) + (size_t)(3 * l + 2) * MTOK, ws + WS_XNB, (float*)(ws + WS_Q), G, wg, tid); }
            SEAM(pb + 8);
        }
    }
    if (IN(29)) { PH_BEGIN; (void)ws; final_norm(out + O_X, inp[21], G, wg, tid); }
#undef IN
#undef SEAM
#undef PH_BEGIN
}

extern "C" void kernel_launch(void* const* d_in, const int* in_sizes, int n_in, void* d_out, int out_size, void* d_ws, size_t ws_size, hipStream_t stream) {
    static int grid = 0;
    if (grid == 0) {
        if (n_in != 22 || out_size != (int)O_END || ws_size < WS_END) { fprintf(stderr, "kernel_launch: unexpected shapes: n_in %d out %d ws %zu (need %zu)\n", n_in, out_size, ws_size, (size_t)WS_END); grid = -1; return; }
        int dev = 0, cus = 0, per_cu = 0;
        if (hipGetDevice(&dev) != hipSuccess || hipDeviceGetAttribute(&cus, hipDeviceAttributeMultiprocessorCount, dev) != hipSuccess) { grid = -1; return; }
        if (hipFuncSetAttribute((const void*)fwd_kernel, hipFuncAttributeMaxDynamicSharedMemorySize, LDS_BYTES) != hipSuccess) { fprintf(stderr, "kernel_launch: hipFuncSetAttribute failed\n"); grid = -1; return; }
        if (hipOccupancyMaxActiveBlocksPerMultiprocessor(&per_cu, (const void*)fwd_kernel, 512, LDS_BYTES) != hipSuccess || per_cu < 1) { fprintf(stderr, "kernel_launch: occupancy query says %d\n", per_cu); }
        (void)hipGetLastError();
        grid = cus;
    }
    if (grid < 0) return;
    (void)hipMemsetAsync((char*)d_ws + WS_CTL, 0, CTL_ZERO_BYTES, stream);
    (void)hipMemsetAsync((char*)d_ws + WS_RS, 0, 2 * MiB, stream);
    Args a{};
    for (int i = 0; i < 22; ++i) a.in[i] = (const float*)d_in[i];
    a.out = (float*)d_out; a.ws = (unsigned char*)d_ws; a.ph_lo = 0; a.ph_hi = NPHASE; a.pad0 = 0; a.pad1 = 0;
    hipLaunchKernelGGL(fwd_kernel, dim3(grid), dim3(512), LDS_BYTES, stream, a);
}
```

```cpp
#include <hip/hip_runtime.h>
#include <hip/hip_bf16.h>
#include <cstdio>
#include <cstdint>
#ifndef PROBE
#define PROBE 0
#endif
#ifndef FFN_MB
#define FFN_MB 4
#endif
__device__ __forceinline__ float qm(float x) { if (FFN_MB >= 7) return x; unsigned u = __float_as_uint(x); constexpr unsigned sh = 23 - FFN_MB; u = (u + ((1u << (sh - 1)) - 1u) + ((u >> sh) & 1u)) & ~((1u << sh) - 1u); return __uint_as_float(u); }
#ifndef DBGT_CLK
#define DBGT_CLK 0
#endif
#ifndef DBGT_PH
#define DBGT_PH -1
#endif
namespace pg8 {
#define PG8_LAS __attribute__((address_space(3)))
typedef unsigned short bf16_t;
typedef short bf16x8 __attribute__((ext_vector_type(8)));
typedef float f32x4 __attribute__((ext_vector_type(4)));
typedef unsigned u32x4 __attribute__((ext_vector_type(4)));
typedef int i32x4 __attribute__((ext_vector_type(4)));
constexpr int BM = 256, BK = 64, HALF = 128, HTB = HALF * BK * 2  , STAGE_BYTES = 8 * HTB, NXCD = 8, WGM = 4;

__host__ __device__ __forceinline__ int lds_byte(int r, int c) { const int st = (r >> 4) * 2 + (c >> 5), rr = r & 15, cc = c & 31, ob = rr * 64 + cc * 2; return st * 1024 + (ob ^ (((ob >> 9) & 1) << 5)); }
__host__ __device__ __forceinline__ void stage_rc(int b, int& R, int& C) { const int st = b / 1024, sb = b % 1024, swz = sb ^ (((sb >> 9) & 1) << 5); R = (st >> 1) * 16 + swz / 64; C = (st & 1) * 32 + (swz % 64) / 2; }
__host__ __device__ __forceinline__ int perm32(int rho) { const int n = rho >> 4, i = rho & 15; return 8 * (i >> 2) + 4 * n + (i & 3); }

struct Unit { int pm, pn; };
struct Gemm { const bf16_t* A; const bf16_t* Bt; int M, N, K; };

struct StaticOrder {
    int nM, nN, nwg, G, c;
    __host__ __device__ void init(int M, int N, int G_, int c_) { nM = M / BM; nN = N / BM; nwg = nM * nN; G = G_; c = c_; }
    __host__ __device__ bool next(int i, Unit& u) const {
        const long L = (long)i * G + c; if (L >= nwg) return false;
        int wgid = (int)L; { const int q = nwg / NXCD, r = nwg % NXCD, xcd = wgid % NXCD, off = wgid / NXCD; wgid = (xcd < r ? xcd * (q + 1) : r * (q + 1) + (xcd - r) * q) + off; }
        const int nig = WGM * nN, gid = wgid / nig, fm = gid * WGM, gsz = (nM - fm) < WGM ? (nM - fm) : WGM;
        u.pm = fm + ((wgid % nig) % gsz); u.pn = (wgid % nig) / gsz; return true;
    }
    __device__ __forceinline__ void a_ready(const Unit&) const {}
    __device__ __forceinline__ void done(const Unit&) const {}
};

__device__ __forceinline__ unsigned cvt_pk_bf16(float lo, float hi) { unsigned r; asm volatile("v_cvt_pk_bf16_f32 %0, %1, %2" : "=v"(r) : "v"(lo), "v"(hi)); return r; }
typedef float f32x2 __attribute__((ext_vector_type(2)));
struct EpiStoreBf16 {
    static constexpr bool PERM = true, AFTER_DRAIN = false;
    bf16_t* O; int ldc;
    __device__ __forceinline__ void operator()(const f32x4 (&acc)[2][2][4][2], const Unit& u, int wr, int wc, int fr, int fq) const {
        const int row0 = u.pm * BM + wr * 64 + fr, col0 = u.pn * BM + wc * 32 + 8 * fq;
#pragma unroll
        for (int ai = 0; ai < 2; ++ai)
#pragma unroll
            for (int m = 0; m < 4; ++m) { bf16_t* rowp = O + (size_t)(row0 + ai * HALF + m * 16) * ldc + col0;
#pragma unroll
                for (int bj = 0; bj < 2; ++bj) { const f32x4 v0 = acc[ai][bj][m][0], v1 = acc[ai][bj][m][1];
                    u32x4 w; w.x = cvt_pk_bf16(v0[0], v0[1]); w.y = cvt_pk_bf16(v0[2], v0[3]); w.z = cvt_pk_bf16(v1[0], v1[1]); w.w = cvt_pk_bf16(v1[2], v1[3]);
                    *(u32x4*)(rowp + bj * HALF) = w; } }
    }
};
__device__ __forceinline__ float silu_f(float g) { return g * __builtin_amdgcn_rcpf(1.0f + __builtin_amdgcn_exp2f(-1.4426950408889634f * g)); }
struct EpiSwiGLU {
    static constexpr bool PERM = true, AFTER_DRAIN = false;
    bf16_t* O; int ldc;
    __device__ __forceinline__ void operator()(const f32x4 (&acc)[2][2][4][2], const Unit& u, int wr, int wc, int fr, int fq) const {
        const int row0 = u.pm * BM + wr * 64 + fr, col0 = u.pn * HALF + wc * 32 + 8 * fq;
#pragma unroll
        for (int ai = 0; ai < 2; ++ai)
#pragma unroll
            for (int m = 0; m < 4; ++m) { bf16_t* rowp = O + (size_t)(row0 + ai * HALF + m * 16) * ldc + col0;
                const f32x4 g0 = acc[ai][0][m][0], g1 = acc[ai][0][m][1], u0 = acc[ai][1][m][0], u1 = acc[ai][1][m][1];
                u32x4 w; w.x = cvt_pk_bf16(silu_f(g0[0]) * u0[0], silu_f(g0[1]) * u0[1]); w.y = cvt_pk_bf16(silu_f(g0[2]) * u0[2], silu_f(g0[3]) * u0[3]);
                w.z = cvt_pk_bf16(silu_f(g1[0]) * u1[0], silu_f(g1[1]) * u1[1]); w.w = cvt_pk_bf16(silu_f(g1[2]) * u1[2], silu_f(g1[3]) * u1[3]);
                *(u32x4*)rowp = w; }
    }
};
struct EpiResid {
    static constexpr bool PERM = false, AFTER_DRAIN = false;
    const float* baseP; const float* baseS; float* out; const float* gate; float coef;
    __device__ __forceinline__ void operator()(const f32x4 (&acc)[2][2][4][2], const Unit& u, int wr, int wc, int fr, int fq) const {
        const int cond = u.pm < 16 ? 0 : 1 + ((u.pm - 16) >> 4);
        const float* g = gate + (size_t)cond * 18432; const float* base = u.pm < 16 ? baseP : baseS;
        const int row0 = u.pm * BM + wr * 64 + fr, col0 = u.pn * BM + wc * 32 + 4 * fq;
        f32x4 gv[2][2];
#pragma unroll
        for (int bj = 0; bj < 2; ++bj)
#pragma unroll
            for (int n = 0; n < 2; ++n) gv[bj][n] = *(const f32x4*)(g + col0 + bj * HALF + n * 16) * coef;
#pragma unroll
        for (int ai = 0; ai < 2; ++ai)
#pragma unroll
            for (int m = 0; m < 4; ++m) { const size_t off = (size_t)(row0 + ai * HALF + m * 16) * 2048 + col0;
#pragma unroll
                for (int bj = 0; bj < 2; ++bj)
#pragma unroll
                    for (int n = 0; n < 2; ++n) { const f32x4 b = *(const f32x4*)(base + off + bj * HALF + n * 16);
                        *(f32x4*)(out + off + bj * HALF + n * 16) = b + gv[bj][n] * acc[ai][bj][m][n]; }
                if (m == 3) asm volatile("" ::: "memory"); }
    }
};

__device__ __forceinline__ float rstd_of(const unsigned long long* rss, int row) { return rsqrtf((float)rss[row] * (1.0f / 16777216.0f) * (1.0f / 2048.0f) + 1e-6f); }
struct EpiStoreBf16N {
    static constexpr bool PERM = true, AFTER_DRAIN = false;
    bf16_t* O; int ldc; const unsigned long long* rss; const float* bias; int ldb;
    __device__ __forceinline__ void operator()(const f32x4 (&acc)[2][2][4][2], const Unit& u, int wr, int wc, int fr, int fq) const {
        const int cond = u.pm < 16 ? 0 : 1 + ((u.pm - 16) >> 4);
        const int row0 = u.pm * BM + wr * 64 + fr, col0 = u.pn * BM + wc * 32 + 8 * fq;
        const float* b = bias + (size_t)cond * ldb + col0;
        f32x4 bv[2][2];
#pragma unroll
        for (int bj = 0; bj < 2; ++bj)
#pragma unroll
            for (int n = 0; n < 2; ++n) bv[bj][n] = *(const f32x4*)(b + bj * HALF + 4 * n);
#pragma unroll
        for (int ai = 0; ai < 2; ++ai)
#pragma unroll
            for (int m = 0; m < 4; ++m) { const int row = row0 + ai * HALF + m * 16; const float rs = rstd_of(rss, row); bf16_t* rowp = O + (size_t)row * ldc + col0;
#pragma unroll
                for (int bj = 0; bj < 2; ++bj) { const f32x4 v0 = acc[ai][bj][m][0] * rs + bv[bj][0], v1 = acc[ai][bj][m][1] * rs + bv[bj][1];
                    u32x4 w; w.x = cvt_pk_bf16(v0[0], v0[1]); w.y = cvt_pk_bf16(v0[2], v0[3]); w.z = cvt_pk_bf16(v1[0], v1[1]); w.w = cvt_pk_bf16(v1[2], v1[3]);
                    *(u32x4*)(rowp + bj * HALF) = w; } }
    }
};
struct EpiSwiGLUN {
    static constexpr bool PERM = true, AFTER_DRAIN = false;
    bf16_t* O; int ldc; const unsigned long long* rss; const float* bias; int ldb;
    __device__ __forceinline__ void operator()(const f32x4 (&acc)[2][2][4][2], const Unit& u, int wr, int wc, int fr, int fq) const {
        const int cond = u.pm < 16 ? 0 : 1 + ((u.pm - 16) >> 4);
        const int row0 = u.pm * BM + wr * 64 + fr, col0 = u.pn * HALF + wc * 32 + 8 * fq;
        const float* b = bias + (size_t)cond * ldb + u.pn * BM + wc * 32 + 8 * fq;
        const f32x4 bg0 = *(const f32x4*)(b), bg1 = *(const f32x4*)(b + 4), bu0 = *(const f32x4*)(b + HALF), bu1 = *(const f32x4*)(b + HALF + 4);
#pragma unroll
        for (int ai = 0; ai < 2; ++ai)
#pragma unroll
            for (int m = 0; m < 4; ++m) { const int row = row0 + ai * HALF + m * 16; const float rs = rstd_of(rss, row); bf16_t* rowp = O + (size_t)row * ldc + col0;
                const f32x4 g0 = acc[ai][0][m][0] * rs + bg0, g1 = acc[ai][0][m][1] * rs + bg1, u0 = acc[ai][1][m][0] * rs + bu0, u1 = acc[ai][1][m][1] * rs + bu1;
                u32x4 w; w.x = cvt_pk_bf16(qm(silu_f(g0[0]) * u0[0]), qm(silu_f(g0[1]) * u0[1])); w.y = cvt_pk_bf16(qm(silu_f(g0[2]) * u0[2]), qm(silu_f(g0[3]) * u0[3]));
                w.z = cvt_pk_bf16(qm(silu_f(g1[0]) * u1[0]), qm(silu_f(g1[1]) * u1[1])); w.w = cvt_pk_bf16(qm(silu_f(g1[2]) * u1[2]), qm(silu_f(g1[3]) * u1[3]));
                *(u32x4*)rowp = w; }
    }
};
struct EpiStoreQ {
    static constexpr bool PERM = true, AFTER_DRAIN = false;
    bf16_t* O; int ldc; const unsigned long long* rss; const float* sa; const float* sw; const float* bias; int ldb; int pm_off;
    __device__ __forceinline__ void operator()(const f32x4 (&acc)[2][2][4][2], const Unit& u, int wr, int wc, int fr, int fq) const {
        const int pmg = u.pm + pm_off, cond = pmg < 16 ? 0 : 1 + ((pmg - 16) >> 4);
        const int row0 = u.pm * BM + wr * 64 + fr, col0 = u.pn * BM + wc * 32 + 8 * fq;
        const float* b = bias + (size_t)cond * ldb + col0; const float* w = sw + col0;
        f32x4 bv[2][2], wv[2][2];
#pragma unroll
        for (int bj = 0; bj < 2; ++bj)
#pragma unroll
            for (int n = 0; n < 2; ++n) { bv[bj][n] = *(const f32x4*)(b + bj * HALF + 4 * n); wv[bj][n] = *(const f32x4*)(w + bj * HALF + 4 * n); }
#pragma unroll
        for (int ai = 0; ai < 2; ++ai)
#pragma unroll
            for (int m = 0; m < 4; ++m) { const int row = row0 + ai * HALF + m * 16; const float rs = sa[row];     bf16_t* rowp = O + (size_t)row * ldc + col0;
#pragma unroll
                for (int bj = 0; bj < 2; ++bj) { const f32x4 v0 = acc[ai][bj][m][0] * rs * wv[bj][0] + bv[bj][0], v1 = acc[ai][bj][m][1] * rs * wv[bj][1] + bv[bj][1];
                    u32x4 w4; w4.x = cvt_pk_bf16(v0[0], v0[1]); w4.y = cvt_pk_bf16(v0[2], v0[3]); w4.z = cvt_pk_bf16(v1[0], v1[1]); w4.w = cvt_pk_bf16(v1[2], v1[3]);
                    *(u32x4*)(rowp + bj * HALF) = w4; } }
    }
};
__device__ __forceinline__ float sat448(float x) { return __builtin_fminf(__builtin_fmaxf(x, -448.0f), 448.0f); }
__device__ __forceinline__ f32x4 swiglu4(const f32x4 g, const f32x4 u) {
    const f32x4 t = g * -1.4426950408889634f; f32x4 e;
#pragma unroll
    for (int i = 0; i < 4; ++i) e[i] = __builtin_amdgcn_exp2f(t[i]);
    const f32x4 d = e + 1.0f; f32x4 r;
#pragma unroll
    for (int i = 0; i < 4; ++i) r[i] = __builtin_amdgcn_rcpf(d[i]);
    return (g * u) * r;
}
__device__ __forceinline__ f32x4 swiglu4t(const f32x4 g, const f32x4 t, const f32x4 u) {
    f32x4 e;
#pragma unroll
    for (int i = 0; i < 4; ++i) e[i] = __builtin_amdgcn_exp2f(t[i]);
    const f32x4 d = e + 1.0f; f32x4 r;
#pragma unroll
    for (int i = 0; i < 4; ++i) r[i] = __builtin_amdgcn_rcpf(d[i]);
    return (g * u) * r;
}
struct EpiSwiGLUQ {
    static constexpr bool PERM = true, AFTER_DRAIN = false;
    unsigned char* O; int ldc; const unsigned long long* rss; const float* sa; const float* sw; const float* bias; int ldb; const float* act_s;
    __device__ __forceinline__ void operator()(const f32x4 (&acc)[2][2][4][2], const Unit& u, int wr, int wc, int fr, int fq) const {
        const int cond = u.pm < 16 ? 0 : 1 + ((u.pm - 16) >> 4);
        const int row0 = u.pm * BM + wr * 64 + fr, col0 = u.pn * HALF + wc * 32 + 8 * fq, bcol = u.pn * BM + wc * 32 + 8 * fq;
        const float* b = bias + (size_t)cond * ldb + bcol; const float* w = sw + bcol;
        const f32x4 bg0 = *(const f32x4*)(b), bg1 = *(const f32x4*)(b + 4), bu0 = *(const f32x4*)(b + HALF), bu1 = *(const f32x4*)(b + HALF + 4);
        const f32x4 wg0 = *(const f32x4*)(w), wg1 = *(const f32x4*)(w + 4), wu0 = *(const f32x4*)(w + HALF), wu1 = *(const f32x4*)(w + HALF + 4);
        const float as = act_s[0]; constexpr float KL = -1.4426950408889634f;
        const f32x4 wu0s = wu0 * as, wu1s = wu1 * as, bu0s = bu0 * as, bu1s = bu1 * as, wg0k = wg0 * KL, wg1k = wg1 * KL, bg0k = bg0 * KL, bg1k = bg1 * KL;
#pragma unroll
        for (int ai = 0; ai < 2; ++ai)
#pragma unroll
            for (int m = 0; m < 4; ++m) { const int row = row0 + ai * HALF + m * 16; const float rs = sa[row];     unsigned char* rowp = O + (size_t)row * ldc + col0;
                const f32x4 a0 = acc[ai][0][m][0] * rs, a1 = acc[ai][0][m][1] * rs;
                const f32x4 g0 = a0 * wg0 + bg0, g1 = a1 * wg1 + bg1, t0 = a0 * wg0k + bg0k, t1 = a1 * wg1k + bg1k, u0 = acc[ai][1][m][0] * rs * wu0s + bu0s, u1 = acc[ai][1][m][1] * rs * wu1s + bu1s;
                const f32x4 h0 = swiglu4t(g0, t0, u0), h1 = swiglu4t(g1, t1, u1);
                unsigned w0 = __builtin_amdgcn_cvt_pk_fp8_f32(sat448(h0[0]), sat448(h0[1]), 0, false); w0 = __builtin_amdgcn_cvt_pk_fp8_f32(sat448(h0[2]), sat448(h0[3]), w0, true);
                unsigned w1 = __builtin_amdgcn_cvt_pk_fp8_f32(sat448(h1[0]), sat448(h1[1]), 0, false); w1 = __builtin_amdgcn_cvt_pk_fp8_f32(sat448(h1[2]), sat448(h1[3]), w1, true);
                uint2 wv; wv.x = w0; wv.y = w1; *(uint2*)rowp = wv; }
    }
};
struct EpiResidN {
    static constexpr bool PERM = false, AFTER_DRAIN = false;
    const float* baseP; const float* baseS; float* out; const float* gate; const float* nw; const float* scl; unsigned long long* rss; long xs_delta;   float coef; int do_xs; long sa_delta, sw_delta; int q8; int xs_all = 0; long am_delta = 0;
    __device__ __forceinline__ void operator()(const f32x4 (&acc)[2][2][4][2], const Unit& u, int wr, int wc, int fr, int fq) const {
        const int cond = u.pm < 16 ? 0 : 1 + ((u.pm - 16) >> 4); const int do_xs = (this->do_xs && (xs_all || u.pm < 16)) ? this->do_xs : 0;     bf16_t* xs = (bf16_t*)((char*)rss + xs_delta); const float* sa = (const float*)((char*)rss + sa_delta); const float* swc = (const float*)((char*)rss + sw_delta);
        const float* g = gate + (size_t)cond * 18432; const float* base = u.pm < 16 ? baseP : baseS;
        const int row0 = u.pm * BM + wr * 64 + fr, col0 = u.pn * BM + wc * 32 + 4 * fq;
        f32x4 gv[2][2], av[2][2];
#pragma unroll
        for (int bj = 0; bj < 2; ++bj)
#pragma unroll
            for (int n = 0; n < 2; ++n) { gv[bj][n] = *(const f32x4*)(g + col0 + bj * HALF + n * 16); av[bj][n] = q8 ? *(const f32x4*)(swc + col0 + bj * HALF + n * 16) : (f32x4){1.f, 1.f, 1.f, 1.f}; }
        f32x4 t0[2][2], t1[2][2];
#pragma unroll
        for (int bj = 0; bj < 2; ++bj)
#pragma unroll
            for (int n = 0; n < 2; ++n) { t0[bj][n] = do_xs ? *(const f32x4*)(nw + col0 + bj * HALF + n * 16) : (f32x4){0.f, 0.f, 0.f, 0.f}; t1[bj][n] = do_xs ? *(const f32x4*)(scl + (size_t)cond * 18432 + col0 + bj * HALF + n * 16) : (f32x4){0.f, 0.f, 0.f, 0.f}; }
#pragma unroll
        for (int bj = 0; bj < 2; ++bj)
#pragma unroll
            for (int n = 0; n < 2; ++n) { gv[bj][n] = gv[bj][n] * coef * av[bj][n]; av[bj][n] = t0[bj][n] * (t1[bj][n] + 1.0f); }
#pragma unroll
        for (int ai2 = 0; ai2 < 4; ++ai2) { const int ai = ai2 >> 1, m0 = (ai2 & 1) * 2;
            f32x4 bb[2][2][2];
#pragma unroll
            for (int mm = 0; mm < 2; ++mm)
#pragma unroll
                for (int bj = 0; bj < 2; ++bj)
#pragma unroll
                    for (int n = 0; n < 2; ++n) bb[mm][bj][n] = *(const f32x4*)(base + (size_t)(row0 + ai * HALF + (m0 + mm) * 16) * 2048 + col0 + bj * HALF + n * 16);
#pragma unroll
            for (int mm = 0; mm < 2; ++mm) { const int m = m0 + mm; const int row = row0 + ai * HALF + m * 16; const size_t off = (size_t)row * 2048 + col0; float ss = 0.f, amx = 0.f; const float sr = q8 == 2 ? sa[0] : q8 ? sa[row] : 1.0f;
#pragma unroll
                for (int bj = 0; bj < 2; ++bj)
#pragma unroll
                    for (int n = 0; n < 2; ++n) { const f32x4 b = bb[mm][bj][n]; const f32x4 o = b + gv[bj][n] * (acc[ai][bj][m][n] * sr);
                        *(f32x4*)(out + off + bj * HALF + n * 16) = o;
                        if (do_xs) { f32x4 q = o * av[bj][n]; if (do_xs == 2) { q[0] = qm(q[0]); q[1] = qm(q[1]); q[2] = qm(q[2]); q[3] = qm(q[3]); } ss += (o[0] * o[0] + o[1] * o[1]) + (o[2] * o[2] + o[3] * o[3]); amx = fmaxf(fmaxf(amx, fmaxf(fabsf(q[0]), fabsf(q[1]))), fmaxf(fabsf(q[2]), fabsf(q[3])));
                            uint2 w2; w2.x = cvt_pk_bf16(q[0], q[1]); w2.y = cvt_pk_bf16(q[2], q[3]); *(uint2*)(xs + off + bj * HALF + n * 16) = w2; } }
                if (do_xs) { ss += __shfl_xor(ss, 16); ss += __shfl_xor(ss, 32); if (fq == 0) atomicAdd(rss + row, (unsigned long long)(ss * 16777216.0f));
                    if (xs_all) { amx = fmaxf(amx, __shfl_xor(amx, 16)); amx = fmaxf(amx, __shfl_xor(amx, 32)); if (fq == 0) atomicMax((unsigned*)((char*)rss + am_delta) + row, __float_as_uint(amx)); } }
                if (mm == 1) asm volatile("" ::: "memory"); } }
    }
};
typedef int i32x8 __attribute__((ext_vector_type(8)));
__device__ __forceinline__ void mfma_f8_128(f32x4& c, const i32x8 a, const i32x8 b) { asm volatile("v_mfma_f32_16x16x128_f8f6f4 %0, %1, %2, %0" : "+v"(c) : "v"(a), "v"(b)); }
template <class Epi, class Sched, bool ALIGN_EPI = false, bool SP2 = false, int I8 = 0>
__device__ __forceinline__ void gemm_phase(PG8_LAS unsigned char* lds, const Gemm g, const Sched& S, const Epi& E) {
    int tid_ = threadIdx.x; asm volatile("" : "+v"(tid_));
    const int tid = tid_, wid = __builtin_amdgcn_readfirstlane(tid >> 6), lane = tid & 63, wr = wid >> 2, wc = wid & 3, fr = lane & 15, fq = lane >> 4;
    const int K = g.K, nt = K / BK;
    unsigned voffA[2], voffB[2];
#pragma unroll
    for (int i = 0; i < 2; ++i) { int R, C; stage_rc(tid * 16 + i * 8192, R, C); const int Rb = Epi::PERM ? ((R & ~31) + perm32(R & 31)) : R;
        voffA[i] = (unsigned)(R * K + C) * 2u; voffB[i] = (unsigned)(Rb * BK + C) * 2u; }
    const size_t kstep = (size_t)(BK * 2);
    const size_t hstep = (size_t)HALF * K * 2;
    const size_t tstep = 2 * hstep;
    const size_t kstepB = (size_t)BM * BK * 2, hstepB = (size_t)HALF * BK * 2;
    const unsigned ldsw = (unsigned)wid * 1024u;
    const int aoff = lds_byte(wr * 64 + fr, fq * 8), boff = lds_byte(wc * 32 + fr, fq * 8);
#define PG8_SA(b, h) (((b) * 2 + (h)) * HTB)
#define PG8_SB(b, h) ((4 + (b) * 2 + (h)) * HTB)
#define PG8_STAGE(bufoff, gbase, voff) do { _Pragma("unroll") for (int _i = 0; _i < 2; ++_i) \
        __builtin_amdgcn_global_load_lds((const unsigned*)((const char*)(gbase) + (voff)[_i]), (PG8_LAS unsigned*)(lds + (bufoff) + ldsw + _i * 8192), 16, 0, 0); } while (0)
#define PG8_LDA(dst, b, h) do { _Pragma("unroll") for (int m = 0; m < 4; ++m) _Pragma("unroll") for (int k = 0; k < 2; ++k) dst[m][k] = *(const PG8_LAS bf16x8*)(lds + PG8_SA(b, h) + aoff + m * 2048 + k * 1024); } while (0)
#define PG8_LDB(dst, b, h) do { _Pragma("unroll") for (int n = 0; n < 2; ++n) _Pragma("unroll") for (int k = 0; k < 2; ++k) dst[n][k] = *(const PG8_LAS bf16x8*)(lds + PG8_SB(b, h) + boff + n * 2048 + k * 1024); } while (0)
#define PG8_MMA(ai, bj, At, Bt) do { __builtin_amdgcn_s_setprio(1); _Pragma("unroll") for (int m = 0; m < 4; ++m) _Pragma("unroll") for (int n = 0; n < 2; ++n) { if constexpr (I8 == 2) { \
        mfma_f8_128(acc[ai][bj][m][n], __builtin_shufflevector(__builtin_bit_cast(i32x4, Bt[n][0]), __builtin_bit_cast(i32x4, Bt[n][1]), 0, 1, 2, 3, 4, 5, 6, 7), \
            __builtin_shufflevector(__builtin_bit_cast(i32x4, At[m][0]), __builtin_bit_cast(i32x4, At[m][1]), 0, 1, 2, 3, 4, 5, 6, 7)); } else _Pragma("unroll") for (int k = 0; k < 2; ++k) { \
        if constexpr (I8 == 1) acc[ai][bj][m][n] = __builtin_bit_cast(f32x4, __builtin_amdgcn_mfma_i32_16x16x64_i8(__builtin_bit_cast(i32x4, Bt[n][k]), __builtin_bit_cast(i32x4, At[m][k]), __builtin_bit_cast(i32x4, acc[ai][bj][m][n]), 0, 0, 0)); \
        else acc[ai][bj][m][n] = __builtin_amdgcn_mfma_f32_16x16x32_bf16(Bt[n][k], At[m][k], acc[ai][bj][m][n], 0, 0, 0); } } __builtin_amdgcn_s_setprio(0); } while (0)
#define PG8_WAIT_V(n) asm volatile("s_waitcnt vmcnt(" #n ")" ::: "memory")
#define PG8_WAIT_L(n) asm volatile("s_waitcnt lgkmcnt(" #n ")" ::: "memory")
#define PG8_BAR __builtin_amdgcn_s_barrier()
#define PG8_SCHED __builtin_amdgcn_sched_barrier(0)
    Unit cur, nxt; int ui = 0;
    if (!S.next(0, cur)) return;
    f32x4 acc[2][2][4][2];
#pragma unroll
    for (int a = 0; a < 2; ++a)
#pragma unroll
        for (int b = 0; b < 2; ++b)
#pragma unroll
            for (int m = 0; m < 4; ++m)
#pragma unroll
                for (int n = 0; n < 2; ++n) acc[a][b][m][n] = (f32x4){0.f, 0.f, 0.f, 0.f};
    bf16x8 At[4][2], B0[2][2], B1[2][2];
    const char* cA = (const char*)g.A + (size_t)cur.pm * tstep; const char* cB = (const char*)g.Bt + (size_t)cur.pn * tstep;
    S.a_ready(cur);
    if constexpr (SP2) {
        PG8_STAGE(PG8_SB(0, 0), cB, voffB); PG8_STAGE(PG8_SB(0, 1), cB + hstepB, voffB); PG8_STAGE(PG8_SA(0, 0), cA, voffA); PG8_STAGE(PG8_SA(0, 1), cA + hstep, voffA);
        if (wr == 1) PG8_BAR;
        PG8_WAIT_V(2); PG8_BAR;
        PG8_STAGE(PG8_SB(1, 0), cB + kstepB, voffB); PG8_STAGE(PG8_SA(1, 0), cA + kstep, voffA); PG8_STAGE(PG8_SB(1, 1), cB + hstepB + kstepB, voffB);
        PG8_WAIT_V(6); PG8_BAR;
    } else {
        PG8_STAGE(PG8_SB(0, 0), cB, voffB); PG8_STAGE(PG8_SA(0, 0), cA, voffA); PG8_STAGE(PG8_SB(0, 1), cB + hstepB, voffB); PG8_STAGE(PG8_SA(0, 1), cA + hstep, voffA);
        if (wr == 1) PG8_BAR;
        PG8_WAIT_V(4); PG8_BAR;
        PG8_STAGE(PG8_SB(1, 0), cB + kstepB, voffB); PG8_STAGE(PG8_SA(1, 0), cA + kstep, voffA); PG8_STAGE(PG8_SB(1, 1), cB + hstepB + kstepB, voffB);
        PG8_WAIT_V(6); PG8_BAR;
    }
    for (;;) {
        const bool has_next = S.next(ui + 1, nxt);
        const char* nA = has_next ? (const char*)g.A + (size_t)nxt.pm * tstep : cA; const char* nB = has_next ? (const char*)g.Bt + (size_t)nxt.pn * tstep : cB;
        for (int t = 0; t < nt; t += 2) {
            const bool last = (t == nt - 2);
            const char* a1 = cA + (size_t)(t + 1) * kstep;
            const char* a2 = last ? nA : cA + (size_t)(t + 2) * kstep; const char* b2 = last ? nB : cB + (size_t)(t + 2) * kstepB;
            const char* a3 = a2 + kstep; const char* b3 = b2 + kstepB;
            if (last && has_next) S.a_ready(nxt);
            if constexpr (SP2) {
            PG8_LDB(B0, 0, 0); PG8_LDB(B1, 0, 1); PG8_SCHED; PG8_LDA(At, 0, 0); PG8_STAGE(PG8_SA(1, 1), a1 + hstep, voffA);
            PG8_WAIT_V(8); PG8_WAIT_L(0); PG8_BAR; PG8_MMA(0, 0, At, B0); PG8_MMA(0, 1, At, B1); PG8_BAR; PG8_SCHED;
            PG8_LDA(At, 0, 1); PG8_STAGE(PG8_SB(0, 0), b2, voffB); PG8_STAGE(PG8_SB(0, 1), b2 + hstepB, voffB); PG8_STAGE(PG8_SA(0, 0), a2, voffA);
            PG8_WAIT_V(8); PG8_WAIT_L(0); PG8_BAR; PG8_MMA(1, 0, At, B0); PG8_MMA(1, 1, At, B1); PG8_BAR; PG8_SCHED;
            PG8_LDB(B0, 1, 0); PG8_LDB(B1, 1, 1); PG8_SCHED; PG8_LDA(At, 1, 0); PG8_STAGE(PG8_SA(0, 1), a2 + hstep, voffA);
            PG8_WAIT_V(8); PG8_WAIT_L(0); PG8_BAR; PG8_MMA(0, 0, At, B0); PG8_MMA(0, 1, At, B1); PG8_BAR; PG8_SCHED;
            PG8_LDA(At, 1, 1); PG8_STAGE(PG8_SB(1, 0), b3, voffB); PG8_STAGE(PG8_SB(1, 1), b3 + hstepB, voffB); PG8_STAGE(PG8_SA(1, 0), a3, voffA);
            PG8_WAIT_V(8); PG8_WAIT_L(0); PG8_BAR; PG8_MMA(1, 0, At, B0); PG8_MMA(1, 1, At, B1); PG8_BAR; PG8_SCHED;
            } else {
            PG8_LDB(B0, 0, 0); PG8_SCHED; PG8_LDA(At, 0, 0); PG8_STAGE(PG8_SA(1, 1), a1 + hstep, voffA);
            PG8_WAIT_L(8); PG8_BAR; PG8_WAIT_L(0); PG8_MMA(0, 0, At, B0); PG8_BAR; PG8_SCHED;
            PG8_LDB(B1, 0, 1); PG8_STAGE(PG8_SB(0, 0), b2, voffB);
            PG8_BAR; PG8_WAIT_L(0); PG8_MMA(0, 1, At, B1); PG8_BAR;
            PG8_LDA(At, 0, 1); PG8_STAGE(PG8_SA(0, 0), a2, voffA);
            PG8_BAR; PG8_WAIT_L(0); PG8_MMA(1, 0, At, B0); PG8_BAR; PG8_SCHED;
            PG8_STAGE(PG8_SB(0, 1), b2 + hstepB, voffB);
            PG8_WAIT_V(6); PG8_BAR; PG8_MMA(1, 1, At, B1); PG8_BAR;
            PG8_LDB(B0, 1, 0); PG8_SCHED; PG8_LDA(At, 1, 0); PG8_STAGE(PG8_SA(0, 1), a2 + hstep, voffA);
            PG8_WAIT_L(8); PG8_BAR; PG8_WAIT_L(0); PG8_MMA(0, 0, At, B0); PG8_BAR; PG8_SCHED;
            PG8_LDB(B1, 1, 1); PG8_STAGE(PG8_SB(1, 0), b3, voffB);
            PG8_BAR; PG8_WAIT_L(0); PG8_MMA(0, 1, At, B1); PG8_BAR;
            PG8_LDA(At, 1, 1); PG8_STAGE(PG8_SA(1, 0), a3, voffA);
            PG8_BAR; PG8_WAIT_L(0); PG8_MMA(1, 0, At, B0); PG8_BAR; PG8_SCHED;
            PG8_STAGE(PG8_SB(1, 1), b3 + hstepB, voffB);
            PG8_WAIT_V(6); PG8_BAR; PG8_MMA(1, 1, At, B1); PG8_BAR;
            }
        }
        if constexpr (ALIGN_EPI) { if (wr == 0) PG8_BAR; }
        if constexpr (I8 == 2) asm volatile("s_nop 15\n\ts_nop 15" ::: "memory");
        if constexpr (I8 == 1) { _Pragma("unroll") for (int a = 0; a < 2; ++a) _Pragma("unroll") for (int b = 0; b < 2; ++b) _Pragma("unroll") for (int m = 0; m < 4; ++m) _Pragma("unroll") for (int n = 0; n < 2; ++n) acc[a][b][m][n] = __builtin_convertvector(__builtin_bit_cast(i32x4, acc[a][b][m][n]), f32x4); }
        if constexpr (!Epi::AFTER_DRAIN) { E(acc, cur, wr, wc, fr, fq); S.done(cur); }
        if (!has_next) break;
#pragma unroll
        for (int a = 0; a < 2; ++a)
#pragma unroll
            for (int b = 0; b < 2; ++b)
#pragma unroll
                for (int m = 0; m < 4; ++m)
#pragma unroll
                    for (int n = 0; n < 2; ++n) acc[a][b][m][n] = (f32x4){0.f, 0.f, 0.f, 0.f};
        cur = nxt; cA = nA; cB = nB; ++ui;
        if constexpr (ALIGN_EPI) { if (wr == 1) PG8_BAR; }
    }
    PG8_WAIT_V(0);
    if constexpr (!ALIGN_EPI) { if (wr == 0) PG8_BAR; }
    PG8_BAR;
    if constexpr (Epi::AFTER_DRAIN) { E.fused(acc, cur, wr, wc, fr, fq, lds, wid, lane); S.done(cur); }
#undef PG8_SA
#undef PG8_SB
#undef PG8_STAGE
#undef PG8_LDA
#undef PG8_LDB
#undef PG8_MMA
#undef PG8_WAIT_V
#undef PG8_WAIT_L
#undef PG8_BAR
#undef PG8_SCHED
}
}
namespace att {
using bf16x8 = __attribute__((ext_vector_type(8))) short;
using s16x4  = __attribute__((ext_vector_type(4))) short;
using f32x16 = __attribute__((ext_vector_type(16))) float;
using u32x4  = __attribute__((ext_vector_type(4))) unsigned;
typedef unsigned short bf16_t;
constexpr int NW = 8, QBLK = 32, KVBLK = 64;
constexpr float THR = 8.f;
constexpr int SHM_V = 64 * 128 * 2, SHM_K = 64 * 128 * 2, SHM_ATTN = 2 * SHM_V + 2 * SHM_K + NW * 64 * 4;
#define KSWZ(row, colB) ((row) * 256 + ((colB) ^ (((row) & 7) << 4)))
#define KSWZ64(row, colB) ((row) * 128 + ((colB) ^ ((((row) >> 1) & 7) << 4)))
#define SBAR() __builtin_amdgcn_sched_barrier(0)
__device__ __forceinline__ int crow(int r, int hi) { return (r & 3) + 8 * (r >> 2) + 4 * hi; }
__device__ __forceinline__ unsigned cvtpk(float lo, float hi) { unsigned r; asm volatile("v_cvt_pk_bf16_f32 %0, %1, %2" : "=v"(r) : "v"(lo), "v"(hi)); return r; }
__device__ __forceinline__ float bf2f(unsigned short b) { return __uint_as_float((unsigned)b << 16); }
__device__ __forceinline__ bf16x8 ld8(const bf16_t* p) { return *reinterpret_cast<const bf16x8*>(p); }

template <int DQK, bool PRE = false> __device__ __forceinline__ void partialSM(f32x16& p0, f32x16& p1, float& m_reg, float& mn, float& alpha) {
  constexpr float SCALE = PRE ? 0.6931471805599453f : ((DQK == 128) ? 0.088388347648318440f : 0.125f);
  constexpr float C = SCALE * 1.4426950408889634f;
  float pmax = p0[0];
#pragma unroll
  for (int r = 1; r < 16; ++r) pmax = fmaxf(pmax, p0[r]);
#pragma unroll
  for (int r = 0; r < 16; ++r) pmax = fmaxf(pmax, p1[r]);
  { auto rr = __builtin_amdgcn_permlane32_swap(__float_as_uint(pmax), __float_as_uint(pmax), false, false);
    pmax = fmaxf(__uint_as_float(rr[0]), __uint_as_float(rr[1])); }
  if (__builtin_expect(__all(pmax - m_reg <= THR / SCALE), 1)) { mn = m_reg; alpha = 1.f; }
  else { mn = fmaxf(m_reg, pmax); alpha = __builtin_amdgcn_exp2f((m_reg - mn) * C); m_reg = mn; }
  float mnC = -mn * C;
#pragma unroll
  for (int r = 0; r < 16; ++r) p0[r] = fmaf(p0[r], C, mnC);
#pragma unroll
  for (int r = 0; r < 16; ++r) p1[r] = fmaf(p1[r], C, mnC);
#pragma unroll
  for (int r = 0; r < 16; ++r) p0[r] = __builtin_amdgcn_exp2f(p0[r]);
}
#define PK4(P, BASE, OUT) do { unsigned a0 = cvtpk(P[BASE + 0], P[BASE + 1]), a1 = cvtpk(P[BASE + 2], P[BASE + 3]);   \
    unsigned b0 = cvtpk(P[BASE + 4], P[BASE + 5]), b1 = cvtpk(P[BASE + 6], P[BASE + 7]);                              \
    auto r0 = __builtin_amdgcn_permlane32_swap(a0, b0, false, false); auto r1 = __builtin_amdgcn_permlane32_swap(a1, b1, false, false); \
    u32x4 w = {r0[0], r1[0], r0[1], r1[1]}; OUT = *reinterpret_cast<bf16x8*>(&w); } while (0)
__device__ __forceinline__ void finishSM(f32x16& p0, f32x16& p1, float alpha, float& l_reg, bf16x8& pa0, bf16x8& pa1, bf16x8& pa2, bf16x8& pa3) {
#pragma unroll
  for (int r = 0; r < 16; ++r) p1[r] = __builtin_amdgcn_exp2f(p1[r]);
  float ps = 0;
#pragma unroll
  for (int r = 0; r < 16; ++r) ps += p0[r];
#pragma unroll
  for (int r = 0; r < 16; ++r) ps += p1[r];
  { auto rr = __builtin_amdgcn_permlane32_swap(__float_as_uint(ps), __float_as_uint(ps), false, false);
    ps = __uint_as_float(rr[0]) + __uint_as_float(rr[1]); }
  l_reg = l_reg * alpha + ps;
  PK4(p0, 0, pa0); PK4(p0, 8, pa1); PK4(p1, 0, pa2); PK4(p1, 8, pa3);
}
template <int DQK> __device__ __forceinline__ void qkt(f32x16& p0, f32x16& p1, const char* Ks, const bf16x8* qr, int r32, int hi) {
  constexpr int ND = DQK / 16;
  p0 = f32x16{}; p1 = f32x16{};
  bf16x8 b0[2], b1[2];
#define QK_RD(d0, s) do { const int cb_ = ((d0) * 16 + hi * 8) * 2; \
    if constexpr (DQK == 128) { b0[s] = *reinterpret_cast<const bf16x8*>(Ks + KSWZ(r32, cb_)); b1[s] = *reinterpret_cast<const bf16x8*>(Ks + KSWZ(32 + r32, cb_)); } \
    else { b0[s] = *reinterpret_cast<const bf16x8*>(Ks + KSWZ64(r32, cb_)); b1[s] = *reinterpret_cast<const bf16x8*>(Ks + KSWZ64(32 + r32, cb_)); } } while (0)
  QK_RD(0, 0); QK_RD(1, 1); SBAR();
#pragma unroll
  for (int d0 = 0; d0 < ND; ++d0) {
    p0 = __builtin_amdgcn_mfma_f32_32x32x16_bf16(b0[d0 & 1], qr[d0], p0, 0, 0, 0);
    p1 = __builtin_amdgcn_mfma_f32_32x32x16_bf16(b1[d0 & 1], qr[d0], p1, 0, 0, 0);
    if (d0 + 2 < ND) { QK_RD(d0 + 2, d0 & 1); }
    SBAR();
  }
#undef QK_RD
}
__device__ __forceinline__ int v_st(int k, int c) { const int kk = (k & ~0xC) | ((k & 4) << 1) | ((k & 8) >> 1); return ((kk >> 3) * 4 + (c >> 5)) * 512 + ((kk & 7) * 32 + (c & 31)) * 2; }
__device__ __forceinline__ int v_rd_base(int lane) { return ((lane & 3) << 3) | (((lane >> 2) & 3) << 6) | (((lane >> 4) & 1) << 5) | (((lane >> 5) & 1) << 8); }
constexpr int v_rd_off(int d0, int ks, int half) { return d0 * 512 + ks * 4096 + half * 2048; }
template <int OFF> __device__ __forceinline__ s16x4 tr_read(int vb) {
  s16x4 r; asm volatile("ds_read_b64_tr_b16 %0, %1 offset:%2" : "=&v"(r) : "v"(vb), "i"(OFF) : "memory"); return r;
}
#define PKF(L, H) (bf16x8){L[0], L[1], L[2], L[3], H[0], H[1], H[2], H[3]}
template <int D0> __device__ __forceinline__ void pv_one(f32x16& od, int vb, bf16x8 pa0, bf16x8 pa1, bf16x8 pa2, bf16x8 pa3) {
  const s16x4 l0 = tr_read<v_rd_off(D0, 0, 0)>(vb), h0 = tr_read<v_rd_off(D0, 0, 1)>(vb), l1 = tr_read<v_rd_off(D0, 1, 0)>(vb), h1 = tr_read<v_rd_off(D0, 1, 1)>(vb);
  const s16x4 l2 = tr_read<v_rd_off(D0, 2, 0)>(vb), h2 = tr_read<v_rd_off(D0, 2, 1)>(vb), l3 = tr_read<v_rd_off(D0, 3, 0)>(vb), h3 = tr_read<v_rd_off(D0, 3, 1)>(vb);
  asm volatile("s_waitcnt lgkmcnt(0)" ::: "memory"); SBAR();
  od = __builtin_amdgcn_mfma_f32_32x32x16_bf16(pa0, PKF(l0, h0), od, 0, 0, 0);
  od = __builtin_amdgcn_mfma_f32_32x32x16_bf16(pa1, PKF(l1, h1), od, 0, 0, 0);
  od = __builtin_amdgcn_mfma_f32_32x32x16_bf16(pa2, PKF(l2, h2), od, 0, 0, 0);
  od = __builtin_amdgcn_mfma_f32_32x32x16_bf16(pa3, PKF(l3, h3), od, 0, 0, 0);
}
#define PV_RD(D0, L, H) do { L[0] = tr_read<v_rd_off(D0, 0, 0)>(vb); H[0] = tr_read<v_rd_off(D0, 0, 1)>(vb); L[1] = tr_read<v_rd_off(D0, 1, 0)>(vb); H[1] = tr_read<v_rd_off(D0, 1, 1)>(vb); \
    L[2] = tr_read<v_rd_off(D0, 2, 0)>(vb); H[2] = tr_read<v_rd_off(D0, 2, 1)>(vb); L[3] = tr_read<v_rd_off(D0, 3, 0)>(vb); H[3] = tr_read<v_rd_off(D0, 3, 1)>(vb); } while (0)
#define PV_MM(OD, L, H) do { OD = __builtin_amdgcn_mfma_f32_32x32x16_bf16(pa0, PKF(L[0], H[0]), OD, 0, 0, 0); OD = __builtin_amdgcn_mfma_f32_32x32x16_bf16(pa1, PKF(L[1], H[1]), OD, 0, 0, 0); \
    OD = __builtin_amdgcn_mfma_f32_32x32x16_bf16(pa2, PKF(L[2], H[2]), OD, 0, 0, 0); OD = __builtin_amdgcn_mfma_f32_32x32x16_bf16(pa3, PKF(L[3], H[3]), OD, 0, 0, 0); } while (0)
__device__ __forceinline__ void pv_d0(f32x16* o, int vb, bf16x8 pa0, bf16x8 pa1, bf16x8 pa2, bf16x8 pa3) {
  s16x4 la[4], ha[4], lb[4], hb[4];
  PV_RD(0, la, ha); PV_RD(1, lb, hb);
  asm volatile("s_waitcnt lgkmcnt(8)" ::: "memory"); SBAR(); PV_MM(o[0], la, ha); SBAR();
  PV_RD(2, la, ha);
  asm volatile("s_waitcnt lgkmcnt(8)" ::: "memory"); SBAR(); PV_MM(o[1], lb, hb); SBAR();
  PV_RD(3, lb, hb);
  asm volatile("s_waitcnt lgkmcnt(8)" ::: "memory"); SBAR(); PV_MM(o[2], la, ha); SBAR();
  asm volatile("s_waitcnt lgkmcnt(0)" ::: "memory"); SBAR(); PV_MM(o[3], lb, hb);
}
#undef PV_RD
#undef PV_MM
__device__ __forceinline__ float half_sum32(float x) {
  x += __shfl_xor(x, 1); x += __shfl_xor(x, 2); x += __shfl_xor(x, 4); x += __shfl_xor(x, 8); x += __shfl_xor(x, 16); return x;
}

struct KVSrc { const bf16_t* K1; const bf16_t* V1; int n1; const bf16_t* K2; const bf16_t* V2; int n2; };
struct AttnOut { bf16_t* Ob; float* Of; const float* nw; float lam, post; int pass; };
template <int DQK, int MODE, int LD2, int SM = 0>
__device__ __forceinline__ void attn_body(const bf16_t* __restrict__ Qb, const KVSrc kv, const AttnOut ao, char* lds) {
  constexpr long ldq = 5120, LD1 = 5120; constexpr int LDO = 2048, LDF = 512;
  int tid_ = threadIdx.x; asm volatile("" : "+v"(tid_));
  const int tid = tid_, wid = tid >> 6, lane = tid & 63, r32 = lane & 31, hi = lane >> 5;
  char* V_lds = lds; char* K_lds = lds + 2 * SHM_V;
  float* ws = (float*)(lds + 2 * SHM_V + 2 * SHM_K) + wid * 64; float* li_l = ws; float* al_l = ws + 32;
  float m_reg = -1e30f, l_reg = 0; f32x16 o[4] = {}; bf16x8 qr[DQK / 16];
  const bf16_t* Qw = Qb + (long)(wid * QBLK + r32) * ldq + hi * 8;
#pragma unroll
  for (int d0 = 0; d0 < DQK / 16; ++d0) qr[d0] = ld8(Qw + d0 * 16);
  const int sr = tid >> 4, sc = (tid & 15) * 8, vst0 = v_st(sr, sc), vst1 = v_st(32 + sr, sc);
  const int kr64 = tid >> 3, kc64 = (tid & 7) * 8;
  const int vb0 = (int)(uintptr_t)V_lds + v_rd_base(lane);
  struct { bf16x8 vs0, vs1, ks0, ks1; } sr_[2];
#define SLOAD(i, k0) do { const int k0_ = (k0); const bool s1_ = k0_ < kv.n1; const bf16_t* kp_ = s1_ ? kv.K1 + (long)k0_ * LD1 : kv.K2 + (long)(k0_ - kv.n1) * LD2; \
    const bf16_t* vp_ = s1_ ? kv.V1 + (long)k0_ * LD1 : kv.V2 + (long)(k0_ - kv.n1) * LD2; const long ld_ = s1_ ? LD1 : (long)LD2; \
    sr_[i].vs0 = ld8(vp_ + (long)sr * ld_ + sc); sr_[i].vs1 = ld8(vp_ + (long)(32 + sr) * ld_ + sc); \
    if constexpr (DQK == 128) { sr_[i].ks0 = ld8(kp_ + (long)sr * ld_ + sc); sr_[i].ks1 = ld8(kp_ + (long)(32 + sr) * ld_ + sc); } \
    else { sr_[i].ks0 = ld8(kp_ + (long)kr64 * ld_ + kc64); } } while (0)
#define SWRITE(b, i) do { *(bf16x8*)(V_lds + (b) * SHM_V + vst0) = sr_[i].vs0; *(bf16x8*)(V_lds + (b) * SHM_V + vst1) = sr_[i].vs1; \
    if constexpr (DQK == 128) { const int kc = sc * 2; *(bf16x8*)(K_lds + (b) * SHM_K + KSWZ(sr, kc)) = sr_[i].ks0; *(bf16x8*)(K_lds + (b) * SHM_K + KSWZ(32 + sr, kc)) = sr_[i].ks1; } \
    else { *(bf16x8*)(K_lds + (b) * SHM_K + KSWZ64(kr64, kc64 * 2)) = sr_[i].ks0; } } while (0)
#define SWAIT() do { if constexpr (DQK == 128) asm volatile("s_waitcnt vmcnt(4)" ::: "memory"); else asm volatile("s_waitcnt vmcnt(3)" ::: "memory"); } while (0)
#define RESC(a) do { if (SM != 1 && __any((a) < 1.f)) { if (hi == 0) al_l[r32] = (a); asm volatile("s_waitcnt lgkmcnt(0)" ::: "memory"); \
    _Pragma("unroll") for (int d = 0; d < 4; ++d) _Pragma("unroll") for (int r = 0; r < 16; ++r) o[d][r] *= al_l[crow(r, hi)]; } } while (0)
  f32x16 pA0, pA1, pB0, pB1; float mnA = 0.f, mnB = 0.f, alA = 1.f, alB = 1.f; bf16x8 pa0, pa1, pa2, pa3; const int NT = (kv.n1 + kv.n2) / KVBLK; (void)mnA; (void)mnB;
#define PSM(P0, P1, MN, AL) do { if constexpr (SM == 1) { _Pragma("unroll") for (int r_ = 0; r_ < 16; ++r_) P0[r_] = __builtin_amdgcn_exp2f(P0[r_]); } else partialSM<DQK, SM == 2>(P0, P1, m_reg, MN, AL); } while (0)
  constexpr int SE = 0, SO = 1;
  SLOAD(SE, 0); SLOAD(SO, KVBLK); SWAIT(); SWRITE(0, SE); __syncthreads();
  qkt<DQK>(pA0, pA1, K_lds, qr, r32, hi); PSM(pA0, pA1, mnA, alA);
  if (2 < NT) SLOAD(SE, 2 * KVBLK);
  SWAIT(); SWRITE(1, SO); __syncthreads();
  for (int j = 1; j + 1 < NT; j += 2) {
    SBAR(); qkt<DQK>(pB0, pB1, K_lds + SHM_K, qr, r32, hi);
    finishSM(pA0, pA1, alA, l_reg, pa0, pa1, pa2, pa3); SBAR();
    SLOAD(SO, (j + 2) * KVBLK); SBAR();
    pv_d0(o, vb0, pa0, pa1, pa2, pa3); PSM(pB0, pB1, mnB, alB);
    __syncthreads(); SWAIT(); SWRITE(0, SE);
    RESC(alB); __syncthreads();
    SBAR(); qkt<DQK>(pA0, pA1, K_lds, qr, r32, hi);
    finishSM(pB0, pB1, alB, l_reg, pa0, pa1, pa2, pa3); SBAR();
    if (j + 3 < NT) SLOAD(SE, (j + 3) * KVBLK); SBAR();
    pv_d0(o, vb0 + (int)SHM_V, pa0, pa1, pa2, pa3); PSM(pA0, pA1, mnA, alA);
    __syncthreads(); SWAIT(); SWRITE(1, SO);
    RESC(alA); __syncthreads();
  }
  SBAR(); qkt<DQK>(pB0, pB1, K_lds + SHM_K, qr, r32, hi);
  finishSM(pA0, pA1, alA, l_reg, pa0, pa1, pa2, pa3); SBAR();
  pv_d0(o, vb0, pa0, pa1, pa2, pa3); PSM(pB0, pB1, mnB, alB);
  __syncthreads(); RESC(alB);
  finishSM(pB0, pB1, alB, l_reg, pa0, pa1, pa2, pa3); SBAR();
  pv_d0(o, vb0 + (int)SHM_V, pa0, pa1, pa2, pa3);
  if (hi == 0) li_l[r32] = l_reg; asm volatile("s_waitcnt lgkmcnt(0)" ::: "memory");
  float rli[16];
#pragma unroll
  for (int r = 0; r < 16; ++r) rli[r] = __builtin_amdgcn_rcpf(li_l[crow(r, hi)]);
  bf16_t* stg = (bf16_t*)lds + wid * (QBLK * 128);
#define O_FLUSH(Ow) do { asm volatile("s_waitcnt lgkmcnt(0)" ::: "memory"); _Pragma("unroll") for (int i_ = 0; i_ < 8; ++i_) { const int row_ = i_ * 4 + (lane >> 4), ch_ = lane & 15; \
    const u32x4 v_ = *(const u32x4*)(stg + row_ * 128 + ch_ * 8); *(u32x4*)((Ow) + (long)row_ * LDO + ch_ * 8) = v_; } } while (0)
  if constexpr (MODE == 0) {
    bf16_t* Ow = ao.Ob + (long)(wid * QBLK) * LDO;
    __syncthreads();
#pragma unroll
    for (int r = 0; r < 16; ++r) { const int orow = crow(r, hi);
#pragma unroll
      for (int d0 = 0; d0 < 4; ++d0) { const float v = o[d0][r] * rli[r]; stg[orow * 128 + d0 * 32 + r32] = (bf16_t)(cvtpk(v, v) & 0xffffu); } }
    O_FLUSH(Ow);
  } else {
    float* Fw = ao.Of + (long)(wid * QBLK) * LDF;
    if (ao.pass == 0) {
#pragma unroll
      for (int r = 0; r < 16; ++r) { const int orow = crow(r, hi);
#pragma unroll
        for (int d0 = 0; d0 < 4; ++d0) Fw[(long)orow * LDF + d0 * 32 + r32] = o[d0][r] * rli[r]; }
    } else {
      bf16_t* Ow = ao.Ob + (long)(wid * QBLK) * LDO;
      __syncthreads();
#pragma unroll
      for (int r = 0; r < 16; ++r) { const int orow = crow(r, hi); float v[4]; float ss = 0.f;
#pragma unroll
        for (int d0 = 0; d0 < 4; ++d0) { v[d0] = Fw[(long)orow * LDF + d0 * 32 + r32] - ao.lam * (o[d0][r] * rli[r]); ss += v[d0] * v[d0]; }
        ss = half_sum32(ss); const float rs = rsqrtf(ss * (1.0f / 128.0f) + 1e-6f) * ao.post;
#pragma unroll
        for (int d0 = 0; d0 < 4; ++d0) { const float y = v[d0] * rs * ao.nw[d0 * 32 + r32]; stg[orow * 128 + d0 * 32 + r32] = (bf16_t)(cvtpk(y, y) & 0xffffu); } }
      O_FLUSH(Ow);
    }
  }
#undef O_FLUSH
#undef SLOAD
#undef SWRITE
#undef SWAIT
#undef RESC
#undef PSM
}
struct ChainArgs { const bf16_t* P;   int kcol, vcol; int nchunk; int dir; float lg2;
                   const float* S0;   bf16_t* ST;   float* Sfin;   };
__device__ __forceinline__ void ret_chain(const ChainArgs a, char* lds) {
  int tid_ = threadIdx.x; asm volatile("" : "+v"(tid_));
  const int tid = tid_, wid = tid >> 6, lane = tid & 63, r32 = lane & 31, hi = lane >> 5;
  const int eb = wid >> 1, dh = wid & 1;
  char* V_lds = lds; char* K_lds = lds + 2 * SHM_V;
  const int sr = tid >> 4, sc = (tid & 15) * 8;
  f32x16 acc[2];
#pragma unroll
  for (int j = 0; j < 2; ++j)
#pragma unroll
    for (int r = 0; r < 16; ++r) acc[j][r] = 0.f;
  if (a.S0) {
#pragma unroll
    for (int j = 0; j < 2; ++j)
#pragma unroll
      for (int r = 0; r < 16; ++r) acc[j][r] = a.S0[(size_t)(32 * (2 * dh + j) + r32) * 128 + 32 * eb + crow(r, hi)]; }
  const float gC = __builtin_amdgcn_exp2f(128.f * a.lg2);
  const int vbA = (int)(uintptr_t)V_lds + v_rd_base(lane) + eb * 512, vbB = (int)(uintptr_t)K_lds + v_rd_base(lane) + (2 * dh) * 512;
  bf16x8 kq[4], vq[4];
  { const int c0 = a.dir == 0 ? 0 : a.nchunk - 1; const bf16_t* rowp = a.P + (size_t)(c0 * 128) * 5120;
#pragma unroll
    for (int q = 0; q < 4; ++q) { const int k = 32 * q + sr; kq[q] = ld8(rowp + (size_t)k * 5120 + a.kcol + sc); vq[q] = ld8(rowp + (size_t)k * 5120 + a.vcol + sc); } }
  for (int s = 0; s < a.nchunk; ++s) {
    const int c = a.dir == 0 ? s : a.nchunk - 1 - s;
    bf16_t* st = a.ST + (size_t)c * 16384;
    __syncthreads();
#pragma unroll
    for (int q = 0; q < 4; ++q) { const int k = 32 * q + sr;
      const bf16x8 kv_ = kq[q], vv_ = vq[q];
      const float f = 0.088388347648318440f * __builtin_amdgcn_exp2f((a.dir == 0 ? (float)(127 - k) : (float)k) * a.lg2);
      u32x4 w; w.x = cvtpk(bf2f((unsigned short)kv_[0]) * f, bf2f((unsigned short)kv_[1]) * f); w.y = cvtpk(bf2f((unsigned short)kv_[2]) * f, bf2f((unsigned short)kv_[3]) * f);
      w.z = cvtpk(bf2f((unsigned short)kv_[4]) * f, bf2f((unsigned short)kv_[5]) * f); w.w = cvtpk(bf2f((unsigned short)kv_[6]) * f, bf2f((unsigned short)kv_[7]) * f);
      const int off = (q >> 1) * SHM_V + v_st(32 * (q & 1) + sr, sc);
      *(u32x4*)(K_lds + off) = w; *(bf16x8*)(V_lds + off) = vv_; }
    __syncthreads();
#pragma unroll
    for (int j = 0; j < 2; ++j)
#pragma unroll
      for (int r = 0; r < 16; ++r) { const float v = acc[j][r]; st[(32 * eb + crow(r, hi)) * 128 + 32 * (2 * dh + j) + r32] = (bf16_t)(cvtpk(v, v) & 0xffffu); }
    if (s + 1 < a.nchunk) { const int cn = a.dir == 0 ? s + 1 : a.nchunk - 2 - s; const bf16_t* rowp = a.P + (size_t)(cn * 128) * 5120;
#pragma unroll
      for (int q = 0; q < 4; ++q) { const int k = 32 * q + sr; kq[q] = ld8(rowp + (size_t)k * 5120 + a.kcol + sc); vq[q] = ld8(rowp + (size_t)k * 5120 + a.vcol + sc); } }
#pragma unroll
    for (int j = 0; j < 2; ++j)
#pragma unroll
      for (int r = 0; r < 16; ++r) acc[j][r] *= gC;
#pragma unroll
    for (int tt = 0; tt < 2; ++tt) {
      s16x4 al[4], ah[4], b0l[4], b0h[4], b1l[4], b1h[4];
#define RD4(ks) do { al[ks] = tr_read<v_rd_off(0, ks, 0)>(vbA + tt * SHM_V); ah[ks] = tr_read<v_rd_off(0, ks, 1)>(vbA + tt * SHM_V); \
      b0l[ks] = tr_read<v_rd_off(0, ks, 0)>(vbB + tt * SHM_V); b0h[ks] = tr_read<v_rd_off(0, ks, 1)>(vbB + tt * SHM_V); \
      b1l[ks] = tr_read<v_rd_off(1, ks, 0)>(vbB + tt * SHM_V); b1h[ks] = tr_read<v_rd_off(1, ks, 1)>(vbB + tt * SHM_V); } while (0)
      RD4(0); RD4(1); RD4(2); RD4(3);
#undef RD4
      asm volatile("s_waitcnt lgkmcnt(0)" ::: "memory"); SBAR();
#pragma unroll
      for (int ks = 0; ks < 4; ++ks) {
        acc[0] = __builtin_amdgcn_mfma_f32_32x32x16_bf16(PKF(al[ks], ah[ks]), PKF(b0l[ks], b0h[ks]), acc[0], 0, 0, 0);
        acc[1] = __builtin_amdgcn_mfma_f32_32x32x16_bf16(PKF(al[ks], ah[ks]), PKF(b1l[ks], b1h[ks]), acc[1], 0, 0, 0); }
    }
  }
  if (a.Sfin) {
#pragma unroll
    for (int j = 0; j < 2; ++j)
#pragma unroll
      for (int r = 0; r < 16; ++r) a.Sfin[(size_t)(32 * (2 * dh + j) + r32) * 128 + 32 * eb + crow(r, hi)] = acc[j][r];
  }
}
struct RetCArgs { const bf16_t* P;   int qcol, kcol, vcol, gcol; float lg2f, lg2b; const bf16_t* STf; const bf16_t* STb;
                  const float* gnw; bf16_t* O;   };
__device__ __forceinline__ void ret_c(const RetCArgs a, char* lds) {
  int tid_ = threadIdx.x; asm volatile("" : "+v"(tid_));
  const int tid = tid_, wid = tid >> 6, lane = tid & 63, r32 = lane & 31, hi = lane >> 5;
  char* V_lds = lds; char* K_lds = lds + 2 * SHM_V;
  const int cw = wid >> 2, ipos = 32 * (wid & 3) + r32;
  const int sr = tid >> 4, sc = (tid & 15) * 8;
  const int vb0 = (int)(uintptr_t)V_lds + v_rd_base(lane);
  bf16x8 qr[8];
  const bf16_t* Qw = a.P + (size_t)(wid * 32 + r32) * 5120 + a.qcol + hi * 8;
#pragma unroll
  for (int d0 = 0; d0 < 8; ++d0) qr[d0] = ld8(Qw + d0 * 16);
  f32x16 o[4] = {};
  bf16x8 kvs[2][4], vvs[2][4];
#pragma unroll
  for (int ch = 0; ch < 2; ++ch) { const bf16_t* rowp = a.P + (size_t)(ch * 128) * 5120;
#pragma unroll
    for (int q = 0; q < 4; ++q) { const int k = 32 * q + sr; kvs[ch][q] = ld8(rowp + (size_t)k * 5120 + a.kcol + sc); vvs[ch][q] = ld8(rowp + (size_t)k * 5120 + a.vcol + sc); } }
#pragma unroll
  for (int ch = 0; ch < 2; ++ch) {
    __syncthreads();
#pragma unroll
    for (int q = 0; q < 4; ++q) {
      *(bf16x8*)(K_lds + (q >> 1) * SHM_K + KSWZ(32 * (q & 1) + sr, sc * 2)) = kvs[ch][q];
      *(bf16x8*)(V_lds + (q >> 1) * SHM_V + v_st(32 * (q & 1) + sr, sc)) = vvs[ch][q]; }
    __syncthreads();
    if (cw == ch) {
#pragma unroll
      for (int tt = 0; tt < 2; ++tt) {
        f32x16 p0, p1; qkt<128>(p0, p1, K_lds + tt * SHM_K, qr, r32, hi);
        int ip_ = ipos, hi_ = hi; asm volatile("" : "+v"(ip_), "+v"(hi_));
#pragma unroll
        for (int r = 0; r < 16; ++r) {
          const int j0 = 64 * tt + crow(r, hi_), d0_ = ip_ - j0, d1_ = d0_ - 32;
          const float f0 = d0_ > 0 ? __builtin_amdgcn_exp2f((float)d0_ * a.lg2f) : (d0_ < 0 ? __builtin_amdgcn_exp2f((float)(-d0_) * a.lg2b) : 2.0f);
          const float f1 = d1_ > 0 ? __builtin_amdgcn_exp2f((float)d1_ * a.lg2f) : (d1_ < 0 ? __builtin_amdgcn_exp2f((float)(-d1_) * a.lg2b) : 2.0f);
          p0[r] *= f0 * 0.088388347648318440f; p1[r] *= f1 * 0.088388347648318440f; }
        bf16x8 pa0, pa1, pa2, pa3; PK4(p0, 0, pa0); PK4(p0, 8, pa1); PK4(p1, 0, pa2); PK4(p1, 8, pa3);
        pv_d0(o, vb0 + tt * SHM_V, pa0, pa1, pa2, pa3);
      }
    }
  }
#pragma unroll
  for (int dir = 0; dir < 2; ++dir) {
    const float rs = dir == 0 ? __builtin_amdgcn_exp2f((float)(ipos + 1) * a.lg2f) : __builtin_amdgcn_exp2f((float)(128 - ipos) * a.lg2b);
    const bf16_t* S = (dir == 0 ? a.STf : a.STb) + (size_t)cw * 16384 + (size_t)r32 * 128 + hi * 8;
#pragma unroll
    for (int d0 = 0; d0 < 8; ++d0) {
      const bf16x8 q_ = qr[d0]; u32x4 w;
      w.x = cvtpk(bf2f((unsigned short)q_[0]) * rs, bf2f((unsigned short)q_[1]) * rs); w.y = cvtpk(bf2f((unsigned short)q_[2]) * rs, bf2f((unsigned short)q_[3]) * rs);
      w.z = cvtpk(bf2f((unsigned short)q_[4]) * rs, bf2f((unsigned short)q_[5]) * rs); w.w = cvtpk(bf2f((unsigned short)q_[6]) * rs, bf2f((unsigned short)q_[7]) * rs);
      const bf16x8 qs = *reinterpret_cast<bf16x8*>(&w);
#pragma unroll
      for (int eb = 0; eb < 4; ++eb) { const bf16x8 b = ld8(S + (size_t)eb * 32 * 128 + d0 * 16); o[eb] = __builtin_amdgcn_mfma_f32_32x32x16_bf16(qs, b, o[eb], 0, 0, 0); }
    }
  }
  unsigned short gq[16][4]; float gw4[4];
  bf16_t* stg = (bf16_t*)lds + wid * (32 * 128);
#pragma unroll
  for (int eb = 0; eb < 4; ++eb) gw4[eb] = a.gnw[eb * 32 + r32];
#pragma unroll
  for (int r = 0; r < 16; ++r)
#pragma unroll
    for (int eb = 0; eb < 4; ++eb) gq[r][eb] = a.P[(size_t)(wid * 32 + crow(r, hi)) * 5120 + a.gcol + eb * 32 + r32];
  __syncthreads();
#pragma unroll
  for (int r = 0; r < 16; ++r) {
    const int row = wid * 32 + crow(r, hi); (void)row;
    float s = (o[0][r] + o[1][r]) + (o[2][r] + o[3][r]); s = half_sum32(s); const float mean = s * (1.0f / 128.0f);
    float q = 0.f;
#pragma unroll
    for (int eb = 0; eb < 4; ++eb) { const float d = o[eb][r] - mean; q += d * d; }
    q = half_sum32(q); const float rstd = rsqrtf(q * (1.0f / 128.0f) + 1e-6f);
#pragma unroll
    for (int eb = 0; eb < 4; ++eb) { const int col = eb * 32 + r32;
      const float g = bf2f(gq[r][eb]);
      const float y = (o[eb][r] - mean) * rstd * gw4[eb] * (g * __builtin_amdgcn_rcpf(1.0f + __builtin_amdgcn_exp2f(-1.4426950408889634f * g)));
      stg[crow(r, hi) * 128 + col] = (bf16_t)(cvtpk(y, y) & 0xffffu); }
  }
  asm volatile("s_waitcnt lgkmcnt(0)" ::: "memory");
#pragma unroll
  for (int i_ = 0; i_ < 8; ++i_) { const int row_ = i_ * 4 + (lane >> 4), ch_ = lane & 15;
    const u32x4 v_ = *(const u32x4*)(stg + row_ * 128 + ch_ * 8); *(u32x4*)(a.O + (size_t)(wid * 32 + row_) * 2048 + ch_ * 8) = v_; }
}
#undef KSWZ
#undef KSWZ64
#undef SBAR
#undef PK4
#undef PKF
}
constexpr int DM = 2048, M_P = 4096, M_S = 32768, MTOK = M_P + M_S, DFF = 5632, NFF = 11264, NIN = 5120, NMODC = 18432, NCOND = 9;
constexpr int C_RQ = 0, C_RK = 512, C_RV = 1024, C_RG = 1536, C_GQ = 2048, C_GK = 3072, C_GV = 3328, C_DQ = 3584, C_DK = 4096, C_DV = 4608;
constexpr float EPS = 1e-6f;
constexpr size_t MiB = 1u << 20;
constexpr size_t WS_CTL = 0, CTL_ZERO_BYTES = 1 * MiB;
constexpr size_t WS_TAB = 1 * MiB;
constexpr size_t WS_CACHE = 4 * MiB;
constexpr size_t WS_W = 16 * MiB;
constexpr size_t W_LAYER = 160 * MiB, W_WI = 0, W_WO = 88 * MiB, W_WIN = 132 * MiB, W_WOUT = 152 * MiB;
constexpr size_t WS_XN = WS_W + 2 * W_LAYER;
constexpr size_t WS_ACT = WS_XN + 144 * MiB;
constexpr size_t WS_ST = WS_ACT + 396 * MiB;
constexpr size_t WS_DF = WS_ST + 72 * MiB;
constexpr size_t WS_XNB = WS_DF + 72 * MiB;
constexpr size_t WS_SB = WS_XNB + 144 * MiB;
constexpr size_t SB_LAYER = 9 * (11264 + 5120 + 11264), SB_J1 = 9 * 11264, SB_J2 = 9 * (11264 + 5120);
constexpr size_t WS_RS = WS_SB + 2 * MiB;
constexpr size_t WS_Q = WS_RS + 2 * MiB;
constexpr size_t Q_SW = 256 * 1024, Q_SW2 = 512 * 1024, Q_SW4 = 832 * 1024, Q_ACT = 960 * 1024  , W_WINQ = 22 * MiB;
constexpr size_t WS_A8B = WS_Q + 1 * MiB;
constexpr size_t WS_END = WS_A8B + 198 * MiB;
constexpr int TB_MOD = 0, TB_COSG = 2 * 9 * 18432, TB_SING = TB_COSG + 64 * 32, TB_COSD = TB_SING + 64 * 32, TB_SIND = TB_COSD + 64 * 16, TB_SCAL = TB_SIND + 64 * 16;
constexpr int CW_BAR = 4096;
constexpr size_t CTL_RAW2 = 960 * 1024;
constexpr size_t CTL_AMAX = 64 * 1024;
constexpr size_t O_X = 0, O_STATE = 75497472, O_GK = 79691776, O_GV = 81788928, O_DK = 83886080, O_DV = 88080384, O_END = 92274688;
constexpr int LDS_BYTES = 147456, MISC_OFF = 131072 + 320;

typedef att::bf16_t bf16;
#define GAS __attribute__((address_space(1)))
#define LAS __attribute__((address_space(3)))
typedef unsigned v4u __attribute__((ext_vector_type(4)));
typedef float f32x4 __attribute__((ext_vector_type(4)));
typedef short bf16x8 __attribute__((ext_vector_type(8)));
typedef GAS unsigned gu32;
typedef GAS unsigned long long gu64;
#define RLX_AGENT __ATOMIC_RELAXED, __HIP_MEMORY_SCOPE_AGENT
#define LDS_WAIT() asm volatile("s_waitcnt lgkmcnt(0)" ::: "memory")
#define VM_WAIT() asm volatile("s_waitcnt vmcnt(0)" ::: "memory")
__device__ __forceinline__ unsigned long long rt() { return __builtin_amdgcn_s_memrealtime(); }
__device__ __forceinline__ unsigned f2bf(float f) { unsigned u = __builtin_bit_cast(unsigned, f); return (u + 0x7fffu + ((u >> 16) & 1u)) >> 16; }
__device__ __forceinline__ unsigned pk2(float lo, float hi) { return f2bf(lo) | (f2bf(hi) << 16); }
#define XB_TMO      128
#define XB_XCNT(j)  (256  + 64 * (j))
#define XB_XSUB(j)  (1280 + 64 * (j))
#define XB_XGEN(j)  (2304 + 64 * (j))
#define XB_TOP      3328
#define XB_TOPGEN   3392
#define XCD_BAR_WORDS 3456
#define XB_SPIN_CAP (1u << 18)

__device__ __forceinline__ unsigned xb_ld(unsigned* p)              { return __hip_atomic_load(p, __ATOMIC_RELAXED, __HIP_MEMORY_SCOPE_AGENT); }
__device__ __forceinline__ unsigned xb_add(unsigned* p, unsigned v) { return __hip_atomic_fetch_add(p, v, __ATOMIC_RELAXED, __HIP_MEMORY_SCOPE_AGENT); }
__device__ __forceinline__ unsigned xb_xcc_id() { return (unsigned)__builtin_amdgcn_s_getreg((3 << 11) | 20) & 0xFu; }
#define XB_SPIN(cond, bar) do { unsigned _sp = 0; while (cond) { __builtin_amdgcn_s_sleep(1); \
    if ((++_sp & 255u) == 0u) { if (xb_ld(&(bar)[XB_TMO])) break; if (_sp > XB_SPIN_CAP) { atomicAdd(&(bar)[XB_TMO], 1u); break; } } } } while (0)

struct XcdBarrier {
    unsigned* bar; unsigned x;
    volatile LAS unsigned* st;
};

__device__ __forceinline__ XcdBarrier xcd_barrier_post(unsigned* bar, volatile LAS unsigned* st) {
    XcdBarrier b; b.bar = bar; b.x = xb_xcc_id(); b.st = st;
    if (threadIdx.x == 0) (void)xb_add(&bar[XB_XCNT(b.x)], 1u);
    return b;
}
__device__ __forceinline__ void xcd_barrier_complete(unsigned* bar, unsigned x, unsigned& nloc, unsigned& nx) {
    const unsigned G = gridDim.x * gridDim.y * gridDim.z;
    unsigned sum, cnt, mine, sp = 0u;
    for (;;) {
        sum = 0u; cnt = 0u; mine = 0u;
#pragma unroll
        for (unsigned j = 0; j < 16; ++j) { const unsigned c = xb_ld(&bar[XB_XCNT(j)]); sum += c; cnt += (c > 0u) ? 1u : 0u; mine = (j == x) ? c : mine; }
        if (sum == G) break;
        __builtin_amdgcn_s_sleep(1);
        if ((++sp & 255u) == 0u) { if (xb_ld(&bar[XB_TMO])) break; if (sp > XB_SPIN_CAP) { atomicAdd(&bar[XB_TMO], 1u); break; } }
    }
    nloc = mine > 0u ? mine : 1u; nx = cnt > 0u ? cnt : 1u;
}

__device__ __forceinline__ void xcd_barrier(const XcdBarrier& b) {
    asm volatile("s_waitcnt vmcnt(0)" ::: "memory");
    __syncthreads();
    if (threadIdx.x == 0) {
        unsigned* bar = b.bar;
        __builtin_amdgcn_s_waitcnt(0);
        unsigned nloc = b.st[0], nx = b.st[1];
        if (nloc == 0u) { xcd_barrier_complete(bar, b.x, nloc, nx); b.st[0] = nloc; b.st[1] = nx; }
        const unsigned old = xb_add(&bar[XB_XSUB(b.x)], 1u);
        const unsigned gen = old / nloc;
        if (old + 1u == (gen + 1u) * nloc) {
            __builtin_amdgcn_fence(__ATOMIC_RELEASE, "agent");
            asm volatile("s_waitcnt vmcnt(0)" ::: "memory");
            const unsigned og = xb_add(&bar[XB_TOP], 1u);
            const unsigned tg = og / nx;
            if (og + 1u == (tg + 1u) * nx) xb_add(&bar[XB_TOPGEN], 1u);
            else XB_SPIN(xb_ld(&bar[XB_TOPGEN]) == tg, bar);
            __builtin_amdgcn_fence(__ATOMIC_ACQUIRE, "agent");
            xb_add(&bar[XB_XGEN(b.x)], 1u);
            asm volatile("s_waitcnt vmcnt(0)" ::: "memory");
        } else {
            XB_SPIN(xb_ld(&bar[XB_XGEN(b.x)]) == gen, bar);
            __builtin_amdgcn_fence(__ATOMIC_ACQUIRE, "agent");
            asm volatile("s_waitcnt vmcnt(0)" ::: "memory");
        }
    }
    __syncthreads();
}
__device__ __forceinline__ float wave_sum(float v) {
#pragma unroll
    for (int o = 1; o < 64; o <<= 1) v += __shfl_xor(v, o);
    return v;
}
__device__ __forceinline__ unsigned pkbf(float lo, float hi) { return pg8::cvt_pk_bf16(lo, hi); }
__device__ __forceinline__ float bf2f(unsigned short b) { return __uint_as_float((unsigned)b << 16); }
__device__ __forceinline__ void transpose_item(const float* W, int ldn, bf16* WT, int K, int k0, int srccol0, int dstrow0, LAS float* scr, int lane, bool qf = false) {
#pragma unroll 8
    for (int i = 0; i < 32; ++i) { const int kk = 2 * i + (lane >> 5); scr[kk * 33 + (lane & 31)] = W[(size_t)(k0 + kk) * ldn + srccol0 + (lane & 31)]; }
    LDS_WAIT(); asm volatile("" ::: "memory");
    const int c = lane & 7;
#pragma unroll
    for (int j = 0; j < 4; ++j) { const int n = (lane >> 3) + 8 * j; const LAS float* s = scr + (8 * c) * 33 + n;
        v4u o; if (qf) { o.x = pkbf(qm(s[0 * 33]), qm(s[1 * 33])); o.y = pkbf(qm(s[2 * 33]), qm(s[3 * 33])); o.z = pkbf(qm(s[4 * 33]), qm(s[5 * 33])); o.w = pkbf(qm(s[6 * 33]), qm(s[7 * 33])); }
        else { o.x = pkbf(s[0 * 33], s[1 * 33]); o.y = pkbf(s[2 * 33], s[3 * 33]); o.z = pkbf(s[4 * 33], s[5 * 33]); o.w = pkbf(s[6 * 33], s[7 * 33]); }
        const int dr = dstrow0 + n; *(GAS v4u*)(WT + ((size_t)((dr >> 8) * (K >> 6) + (k0 >> 6)) * 256 + (dr & 255)) * 64 + 8 * c) = o; }
    LDS_WAIT(); asm volatile("" ::: "memory");
}
template <class INP> __device__ __forceinline__ void absmax_item(const INP& inp, unsigned char* ws, int t, LAS float* red, int tid) {
    const int col = tid & 127, kq = tid >> 7;
    const float* src; size_t ld; int kb, kn, kind, mat, cb;
    if (t < 352) { kind = 0; mat = t / 88; cb = t % 88; src = inp[12] + (size_t)mat * DM * NFF + 128 * cb + col; ld = NFF; kb = 512 * kq; kn = 512; }
    else if (t < 432) { t -= 352; kind = 1; mat = t / 40; cb = t % 40; src = inp[14] + (size_t)mat * DM * NIN + 128 * cb + col; ld = NIN; kb = 512 * kq; kn = 512; }
    else { t -= 432; kind = 2; mat = t >> 6; cb = (t & 63) >> 2; src = inp[13] + (size_t)mat * DFF * DM + 128 * cb + col; ld = DM; kb = 1408 * (t & 3) + 352 * kq; kn = 352; }
    float mx = 0.f;
    for (int k = kb; k < kb + kn; k += 8) { float w[8];
#pragma unroll
        for (int u = 0; u < 8; ++u) w[u] = src[(size_t)(k + u) * ld];
#pragma unroll
        for (int u = 0; u < 8; ++u) mx = fmaxf(mx, fabsf(w[u])); }
    red[kq * 128 + col] = mx;
    __syncthreads();
    if (tid < 128) { const float m4 = fmaxf(fmaxf(red[tid], red[128 + tid]), fmaxf(red[256 + tid], red[384 + tid])); const int s0 = 128 * cb + tid;
        if (kind == 0) { const int brow = s0 < DFF ? (s0 / 128) * 256 + (s0 % 128) : ((s0 - DFF) / 128) * 256 + 128 + ((s0 - DFF) % 128);
            ((float*)(ws + WS_Q + Q_SW))[(size_t)mat * NFF + brow] = fmaxf(m4, 1e-30f) * (1.0f / 127.0f); }
        else if (kind == 1) ((float*)(ws + WS_Q + Q_SW4))[(size_t)mat * NIN + s0] = fmaxf(m4, 1e-30f) * (1.0f / 127.0f);
        else atomicMax((unsigned*)(ws + WS_CTL + CTL_RAW2) + (size_t)mat * DM + s0, __float_as_uint(m4)); }
    __syncthreads();
}
template <class INP> __device__ __forceinline__ void prologue(const INP& inp, unsigned char* ws, LAS unsigned char* lds, int G, int wg, int tid) {
    const int lane = tid & 63, wave = __builtin_amdgcn_readfirstlane(tid >> 6);
    float* tab = (float*)(ws + WS_TAB);
    {
        LAS float* sc = (LAS float*)lds;
        LAS float* red = sc + NCOND * DM;
        bool have = false;
        for (int it = wg; it < 976; it += G) {
            if (it >= 288) { absmax_item(inp, ws, it - 288, (LAS float*)(lds + 98304), tid); continue; }
            if (!have) { for (int i = tid; i < NCOND * DM; i += 512) { const int cd = i >> 11, k = i & 2047; const float v = cd == 0 ? inp[8][k] : inp[2][(cd - 1) * DM + k];
                              sc[i] = v / (1.0f + __expf(-v)); } have = true; __syncthreads(); }
            const int l = it / 144, cb = it % 144, col = tid & 127, g = tid >> 7;
            const float* W = inp[9] + (size_t)l * DM * NMODC + 128 * cb + col;
            float acc[NCOND];
#pragma unroll
            for (int c = 0; c < NCOND; ++c) acc[c] = 0.f;
            for (int k = 512 * g; k < 512 * g + 512; k += 8) {
                float w[8];
#pragma unroll
                for (int u = 0; u < 8; ++u) w[u] = W[(size_t)(k + u) * NMODC];
#pragma unroll
                for (int c = 0; c < NCOND; ++c) { const f32x4 s0 = *(const LAS f32x4*)(sc + c * DM + k), s1 = *(const LAS f32x4*)(sc + c * DM + k + 4);
                    acc[c] += (s0[0] * w[0] + s0[1] * w[1]) + (s0[2] * w[2] + s0[3] * w[3]) + (s1[0] * w[4] + s1[1] * w[5]) + (s1[2] * w[6] + s1[3] * w[7]); }
            }
#pragma unroll
            for (int c = 0; c < NCOND; ++c) red[(g * NCOND + c) * 128 + col] = acc[c];
            __syncthreads();
            for (int i = tid; i < NCOND * 128; i += 512) { const int c = i >> 7, cc = i & 127;
                const float s = ((red[(0 * NCOND + c) * 128 + cc] + red[(1 * NCOND + c) * 128 + cc]) + red[(2 * NCOND + c) * 128 + cc]) + red[(3 * NCOND + c) * 128 + cc];
                tab[TB_MOD + ((size_t)l * NCOND + c) * NMODC + 128 * cb + cc] = s + inp[10][(size_t)l * NMODC + 128 * cb + cc]; }
            __syncthreads();
        }
        __syncthreads();
    }
    if (wg == 0) {
        for (int i = tid; i < 64 * 32; i += 512) { const int pos = i >> 5, f = i & 31; const double inv = pow(10000.0, -(double)(2 * f) / 64.0), a = (double)pos * inv;
            tab[TB_COSG + i] = (float)cos(a); tab[TB_SING + i] = (float)sin(a); }
        for (int i = tid; i < 64 * 16; i += 512) { const int pos = i >> 4, f = i & 15; const double inv = pow(10000.0, -(double)(2 * f) / 32.0), a = (double)pos * inv;
            tab[TB_COSD + i] = (float)cos(a); tab[TB_SIND + i] = (float)sin(a); }
        if (tid < 2) { const int l = tid; const float* dl = inp[19] + l * 256; double s01 = 0.0, s23 = 0.0;
            for (int i = 0; i < 64; ++i) { s01 += (double)dl[i] * (double)dl[64 + i]; s23 += (double)dl[128 + i] * (double)dl[192 + i]; }
            const double li = 0.8 - 0.6 * exp(-0.3 * (double)l);
            tab[TB_SCAL + 16 * l + 0] = (float)(exp(s01) - exp(s23) + li); tab[TB_SCAL + 16 * l + 1] = (float)(1.0 - li); }
        if (tid >= 128 && tid < 130) { const int l = tid - 128; const float* w = inp[18] + l * 256; float mq = 0.f, mk = 0.f;
            for (int i = 0; i < 128; ++i) { mq = fmaxf(mq, fabsf(w[i])); mk = fmaxf(mk, fabsf(w[128 + i])); }
            tab[TB_SCAL + 16 * l + 10] = (mq * mk * 11.313708f * 1.4426950f < 60.0f) ? 1.0f : 0.0f; }
        if (tid >= 64 && tid < 80) { const int i = tid - 64, l = i >> 3, j = i & 7; const double x = (double)inp[16][l * 8 + j];
            tab[TB_SCAL + 16 * l + 2 + j] = (float)(-log1p(exp(-x)) * 1.4426950408889634); }
    }
    {
        bf16* cb = (bf16*)(ws + WS_CACHE);
        const long gt = (long)wg * 512 + tid, GT = (long)G * 512;
        for (int t = 0; t < 4; ++t) { const float* src = inp[4 + t]; const long n8 = (t < 2 ? 1048576 : 2097152) / 8; bf16* dst = cb + (t == 0 ? 0 : t == 1 ? 1048576 : t == 2 ? 2097152 : 4194304);
            for (long i = gt; i < n8; i += GT) { const f32x4 a = *(const f32x4*)(src + i * 8), b = *(const f32x4*)(src + i * 8 + 4);
                v4u o; o.x = pkbf(a[0], a[1]); o.y = pkbf(a[2], a[3]); o.z = pkbf(b[0], b[1]); o.w = pkbf(b[2], b[3]); *(v4u*)(dst + i * 8) = o; } }
    }
    {
        LAS float* scr = (LAS float*)(lds + wave * 16384);
        const int gw = wg * 8 + wave, NGW = G * 8;
        for (int it = gw; it < 81920; it += NGW) {
            const int l = it / 40960; int r = it % 40960;
            bf16* WL = (bf16*)(ws + WS_W + (size_t)l * W_LAYER);
            if (r < 22528) continue;
            if (false) { const int f = r / 11264, q = r % 11264, kb = q / 352, nb = q % 352, s0 = 32 * nb;
                const int drow = s0 < DFF ? (s0 / 128) * 256 + (s0 % 128) : ((s0 - DFF) / 128) * 256 + 128 + ((s0 - DFF) % 128);
                transpose_item(inp[12] + (size_t)(l * 2 + f) * DM * NFF, NFF, WL + (W_WI + (size_t)f * 44 * MiB) / 2, DM, 64 * kb, s0, drow, scr, lane, true); continue; }
            r -= 22528;
            if (r < 11264) continue;
            if (false) { const int f = r / 5632, q = r % 5632, kb = q / 64, nb = q % 64;
                transpose_item(inp[13] + (size_t)(l * 2 + f) * DFF * DM, DM, WL + (W_WO + (size_t)f * 22 * MiB) / 2, DFF, 64 * kb, 32 * nb, 32 * nb, scr, lane, true); continue; }
            r -= 11264;
            if (r < 5120) { const int kb = r / 160, nb = r % 160;
                transpose_item(inp[14] + (size_t)l * DM * NIN, NIN, WL + W_WIN / 2, DM, 64 * kb, 32 * nb, 32 * nb, scr, lane); continue; }
            r -= 5120;
            { const int kb = r / 64, nb = r % 64;
                transpose_item(inp[15] + (size_t)l * DM * DM, DM, WL + W_WOUT / 2, DM, 64 * kb, 32 * nb, 32 * nb, scr, lane); }
        }
    }
}
template <class INP> __device__ __forceinline__ void prologue_b(const INP& inp, unsigned char* ws, LAS unsigned char* lds, int G, int wg, int tid) {
    const int lane = tid & 63, wave = __builtin_amdgcn_readfirstlane(tid >> 6);
    LAS float* scr = (LAS float*)(lds + wave * 16384);
    const float* swv = (const float*)(ws + WS_Q + Q_SW);
    const int gw = wg * 8 + wave, NGW = G * 8;
    const float* swv4 = (const float*)(ws + WS_Q + Q_SW4);
    if (wg < 4) {
        float sm = 0.f; for (int i = tid; i < NFF; i += 512) sm += swv[(size_t)wg * NFF + i];
#pragma unroll
        for (int o = 1; o < 64; o <<= 1) sm += __shfl_xor(sm, o);
        LAS float* red = (LAS float*)(lds + 131072);
        if (lane == 0) red[wave] = sm;
        __syncthreads();
        if (tid == 0) { float t = 0.f; for (int i = 0; i < 8; ++i) t += red[i];
            const float sg = t * (127.0f / (float)NFF) * (1.0f / 3.6f) * 45.254834f;
            const float h0 = fmaxf(fmaxf(sg * sg, sg), 1e-20f); const float sc = exp2f(1.0f - rintf(log2f(h0)));
            float* qa = (float*)(ws + WS_Q + Q_ACT) + 2 * wg; qa[0] = sc; qa[1] = 1.0f / sc; }
        __syncthreads();
    }
    for (int it = gw; it < 10240; it += NGW) {
        const int l = it / 5120, q = it % 5120, kb = q / 160, nb = q % 160, s0 = 32 * nb, k0 = 64 * kb;
        const float* W = inp[14] + (size_t)l * DM * NIN;
        unsigned char* WQ = ws + WS_W + (size_t)l * W_LAYER + W_WINQ;
#pragma unroll 8
        for (int i = 0; i < 32; ++i) { const int kk = 2 * i + (lane >> 5); scr[kk * 33 + (lane & 31)] = W[(size_t)(k0 + kk) * NIN + s0 + (lane & 31)]; }
        LDS_WAIT(); asm volatile("" ::: "memory");
        const int c = lane & 7;
#pragma unroll
        for (int j = 0; j < 4; ++j) { const int n = (lane >> 3) + 8 * j, dr = s0 + n; const LAS float* sp = scr + (8 * c) * 33 + n;
            const float inv = 1.0f / swv4[(size_t)l * NIN + dr];
            unsigned lo = 0u, hi = 0u;
#pragma unroll
            for (int e = 0; e < 4; ++e) { lo |= ((unsigned)(__float2int_rn(sp[e * 33] * inv)) & 0xffu) << (8 * e); hi |= ((unsigned)(__float2int_rn(sp[(4 + e) * 33] * inv)) & 0xffu) << (8 * e); }
            const int kk = k0 + 8 * c;
            uint2 o; o.x = lo; o.y = hi;
            *(uint2*)(WQ + ((size_t)((dr >> 8) * (DM >> 7) + (kk >> 7)) * 256 + (dr & 255)) * 128 + (kk & 127)) = o; }
        LDS_WAIT(); asm volatile("" ::: "memory");
    }
    const unsigned* raw2 = (const unsigned*)(ws + WS_CTL + CTL_RAW2);
    for (int i = wg * 512 + tid; i < 4 * DM; i += G * 512) ((float*)(ws + WS_Q + Q_SW2))[i] = fmaxf(__uint_as_float(raw2[i]), 1e-30f) * (1.0f / 240.0f);
    for (int it = gw; it < 22528; it += NGW) {
        const int mat = it / 5632, q = it % 5632, kb = q / 64, nb = q % 64, s0 = 32 * nb, k0 = 64 * kb, l = mat >> 1, f = mat & 1;
        const float* W = inp[13] + (size_t)mat * DFF * DM;
        unsigned char* WQ = ws + WS_W + (size_t)l * W_LAYER + W_WO + (size_t)f * 22 * MiB;
#pragma unroll 8
        for (int i = 0; i < 32; ++i) { const int kk = 2 * i + (lane >> 5); scr[kk * 33 + (lane & 31)] = W[(size_t)(k0 + kk) * DM + s0 + (lane & 31)]; }
        LDS_WAIT(); asm volatile("" ::: "memory");
        const int c = lane & 7;
#pragma unroll
        for (int j = 0; j < 4; ++j) { const int n = (lane >> 3) + 8 * j, dr = s0 + n; const LAS float* sp = scr + (8 * c) * 33 + n;
            const float inv = 240.0f / fmaxf(__uint_as_float(raw2[(size_t)mat * DM + dr]), 1e-30f);
            unsigned lo = __builtin_amdgcn_cvt_pk_fp8_f32(sp[0] * inv, sp[33] * inv, 0, false); lo = __builtin_amdgcn_cvt_pk_fp8_f32(sp[2 * 33] * inv, sp[3 * 33] * inv, lo, true);
            unsigned hi = __builtin_amdgcn_cvt_pk_fp8_f32(sp[4 * 33] * inv, sp[5 * 33] * inv, 0, false); hi = __builtin_amdgcn_cvt_pk_fp8_f32(sp[6 * 33] * inv, sp[7 * 33] * inv, hi, true);
            const int kk = k0 + 8 * c;
            uint2 o; o.x = lo; o.y = hi;
            *(uint2*)(WQ + ((size_t)((dr >> 8) * (DFF >> 7) + (kk >> 7)) * 256 + (dr & 255)) * 128 + (kk & 127)) = o; }
        LDS_WAIT(); asm volatile("" ::: "memory");
    }
    for (int it = gw; it < 45056; it += NGW) {
        const int mat = it / 11264, q = it % 11264, kb = q / 352, nb = q % 352, s0 = 32 * nb, k0 = 64 * kb, l = mat >> 1, f = mat & 1;
        const int drow = s0 < DFF ? (s0 / 128) * 256 + (s0 % 128) : ((s0 - DFF) / 128) * 256 + 128 + ((s0 - DFF) % 128);
        const float* W = inp[12] + (size_t)mat * DM * NFF;
        unsigned char* WQ = ws + WS_W + (size_t)l * W_LAYER + W_WI + (size_t)f * 44 * MiB;
#pragma unroll 8
        for (int i = 0; i < 32; ++i) { const int kk = 2 * i + (lane >> 5); scr[kk * 33 + (lane & 31)] = W[(size_t)(k0 + kk) * NFF + s0 + (lane & 31)]; }
        LDS_WAIT(); asm volatile("" ::: "memory");
        const int c = lane & 7;
#pragma unroll
        for (int j = 0; j < 4; ++j) { const int n = (lane >> 3) + 8 * j, dr = drow + n; const LAS float* sp = scr + (8 * c) * 33 + n;
            const float inv = 1.0f / swv[(size_t)mat * NFF + dr];
            unsigned lo = 0u, hi = 0u;
#pragma unroll
            for (int e = 0; e < 4; ++e) { lo |= ((unsigned)(__float2int_rn(sp[e * 33] * inv)) & 0xffu) << (8 * e); hi |= ((unsigned)(__float2int_rn(sp[(4 + e) * 33] * inv)) & 0xffu) << (8 * e); }
            const int kk = k0 + 8 * c;
            uint2 o; o.x = lo; o.y = hi;
            *(uint2*)(WQ + ((size_t)((dr >> 8) * (DM >> 7) + (kk >> 7)) * 256 + (dr & 255)) * 128 + (kk & 127)) = o; }
        LDS_WAIT(); asm volatile("" ::: "memory");
    }
}
__device__ __forceinline__ void quant_act_phase(const bf16* ACT, unsigned char* A8, float* sa, int G, int wg, int tid) {
    const int lane = tid & 63, wave = tid >> 6, gw = wg * 8 + wave, NGW = G * 8;
    for (int m = gw; m < MTOK; m += NGW) {
        const bf16* ar = ACT + (size_t)m * DFF;
        v4u v[11]; float mx = 0.f;
#pragma unroll
        for (int j = 0; j < 11; ++j) v[j] = *(const v4u*)(ar + 512 * j + 8 * lane);
#pragma unroll
        for (int j = 0; j < 11; ++j) { const unsigned w4[4] = {v[j].x, v[j].y, v[j].z, v[j].w};
#pragma unroll
            for (int e = 0; e < 4; ++e) mx = fmaxf(mx, fmaxf(fabsf(__uint_as_float(w4[e] << 16)), fabsf(__uint_as_float(w4[e] & 0xffff0000u)))); }
#pragma unroll
        for (int o = 1; o < 64; o <<= 1) mx = fmaxf(mx, __shfl_xor(mx, o));
        mx = fmaxf(mx, 1e-30f);
        if (lane == 0) sa[m] = mx * (1.0f / 127.0f);
        const float inv = 127.0f / mx; unsigned char* orow = A8 + (size_t)m * DFF;
#pragma unroll
        for (int j = 0; j < 11; ++j) { const unsigned w4[4] = {v[j].x, v[j].y, v[j].z, v[j].w}; unsigned o2[2] = {0u, 0u};
#pragma unroll
            for (int e = 0; e < 4; ++e) { const unsigned lo = (unsigned)__float2int_rn(__uint_as_float(w4[e] << 16) * inv) & 0xffu, hi = (unsigned)__float2int_rn(__uint_as_float(w4[e] & 0xffff0000u) * inv) & 0xffu;
                o2[e >> 1] |= (lo | (hi << 8)) << (16 * (e & 1)); }
            uint2 ov; ov.x = o2[0]; ov.y = o2[1]; *(uint2*)(orow + 512 * j + 8 * lane) = ov; }
    }
}
__device__ __forceinline__ void quant_xs_phase(const bf16* XS, const unsigned* amax, const unsigned long long* rss, unsigned char* A8, float* sa, int G, int wg, int tid, int m_begin = 0) {
    const int lane = tid & 63, wave = tid >> 6, gw = wg * 8 + wave, NGW = G * 8;
    for (int m0 = m_begin + 2 * gw; m0 < MTOK; m0 += 2 * NGW) {
        v4u v[2][4]; float mx[2];
#pragma unroll
        for (int r = 0; r < 2; ++r) { const bf16* xr = XS + (size_t)(m0 + r) * DM; mx[r] = fmaxf(__uint_as_float(amax[m0 + r]), 1e-30f);
#pragma unroll
            for (int j = 0; j < 4; ++j) v[r][j] = *(const v4u*)(xr + 512 * j + 8 * lane); }
#pragma unroll
        for (int r = 0; r < 2; ++r) { const float inv = 127.0f / mx[r]; unsigned char* orow = A8 + (size_t)(m0 + r) * DM; if (lane == 0) sa[m0 + r] = mx[r] * (1.0f / 127.0f) * pg8::rstd_of(rss, m0 + r);
#pragma unroll
            for (int j = 0; j < 4; ++j) { const unsigned w4[4] = {v[r][j].x, v[r][j].y, v[r][j].z, v[r][j].w}; unsigned o2[2] = {0u, 0u};
#pragma unroll
                for (int e = 0; e < 4; ++e) { const unsigned lo = (unsigned)__float2int_rn(__uint_as_float(w4[e] << 16) * inv) & 0xffu, hi = (unsigned)__float2int_rn(__uint_as_float(w4[e] & 0xffff0000u) * inv) & 0xffu;
                    o2[e >> 1] |= (lo | (hi << 8)) << (16 * (e & 1)); }
                uint2 ov; ov.x = o2[0]; ov.y = o2[1]; *(uint2*)(orow + 512 * j + 8 * lane) = ov; } }
    }
}
__device__ __forceinline__ void quant_phase(const float* xP, const float* xS, const float* nw, const float* scl0  , unsigned char* A8, float* sa, unsigned long long* rss, int G, int wg, int tid, int m_begin = 0) {
    const int lane = tid & 63, wave = tid >> 6, gw = wg * 8 + wave, NGW = G * 8;
    for (int m = m_begin + gw; m < MTOK; m += NGW) {
        const float* xr = (m < M_P ? xP : xS) + (size_t)m * DM;
        const int cond = m < M_P ? 0 : 1 + ((m - M_P) >> 12);
        const float* scl = scl0 + (size_t)cond * NMODC;
        f32x4 h[8]; float ss = 0.f, mx = 0.f;
#pragma unroll
        for (int j = 0; j < 8; ++j) { const int c = 256 * j + 4 * lane; const f32x4 v = *(const f32x4*)(xr + c); ss += (v[0] * v[0] + v[1] * v[1]) + (v[2] * v[2] + v[3] * v[3]);
            h[j] = v * *(const f32x4*)(nw + c) * (*(const f32x4*)(scl + c) + 1.0f);
            mx = fmaxf(fmaxf(mx, fmaxf(fabsf(h[j][0]), fabsf(h[j][1]))), fmaxf(fabsf(h[j][2]), fabsf(h[j][3]))); }
        ss = wave_sum(ss);
#pragma unroll
        for (int o = 1; o < 64; o <<= 1) mx = fmaxf(mx, __shfl_xor(mx, o));
        mx = fmaxf(mx, 1e-30f);
        if (lane == 0) { const unsigned long long r64 = (unsigned long long)(ss * 16777216.0f); rss[m] = r64; sa[m] = mx * (1.0f / 127.0f) * rsqrtf((float)r64 * (1.0f / 16777216.0f) * (1.0f / 2048.0f) + 1e-6f); }
        const float inv = 127.0f / mx; unsigned char* orow = A8 + (size_t)m * DM;
#pragma unroll
        for (int j = 0; j < 8; ++j) { const unsigned w = ((unsigned)__float2int_rn(h[j][0] * inv) & 0xffu) | (((unsigned)__float2int_rn(h[j][1] * inv) & 0xffu) << 8) | (((unsigned)__float2int_rn(h[j][2] * inv) & 0xffu) << 16) | (((unsigned)__float2int_rn(h[j][3] * inv) & 0xffu) << 24);
            *(unsigned*)(orow + 256 * j + 4 * lane) = w; }
    }
}
__device__ __forceinline__ void norm0_phase(const float* xP, const float* xS, const float* nw, const float* mod  , bf16* XN, unsigned long long* rss, int G, int wg, int tid) {
    const int lane = tid & 63, wave = tid >> 6, gw = wg * 8 + wave, NGW = G * 8;
    for (int m = gw; m < MTOK; m += NGW) {
        const float* xr = (m < M_P ? xP : xS) + (size_t)m * DM;
        const int cond = m < M_P ? 0 : 1 + ((m - M_P) >> 12);
        const float* scl = mod + (size_t)cond * NMODC + DM;
        f32x4 v[8]; float ss = 0.f;
#pragma unroll
        for (int j = 0; j < 8; ++j) { v[j] = *(const f32x4*)(xr + 256 * j + 4 * lane); ss += (v[j][0] * v[j][0] + v[j][1] * v[j][1]) + (v[j][2] * v[j][2] + v[j][3] * v[j][3]); }
        ss = wave_sum(ss); if (lane == 0) rss[m] = (unsigned long long)(ss * 16777216.0f);
        bf16* orow = XN + (size_t)m * DM;
#pragma unroll
        for (int j = 0; j < 8; ++j) { const int c = 256 * j + 4 * lane; const f32x4 w = *(const f32x4*)(nw + c), s1 = *(const f32x4*)(scl + c);
            const f32x4 h = v[j] * w * (s1 + 1.0f);
            uint2 o; o.x = pkbf(qm(h[0]), qm(h[1])); o.y = pkbf(qm(h[2]), qm(h[3])); *(uint2*)(orow + c) = o; }
    }
}
__device__ __forceinline__ void bias_ffn_mfma(unsigned char* ws, LAS unsigned char* lds, int grp, int sub, int nsub, int tid) {
    typedef int i32x4_t __attribute__((ext_vector_type(4)));
    const int lane = tid & 63, wave = tid >> 6, l = grp >> 1, f = grp & 1;
    const float* mod = (const float*)(ws + WS_TAB) + TB_MOD + (size_t)l * NCOND * NMODC + (size_t)(6 * f) * DM;
    LAS unsigned char* D = lds;
    LAS float* red = (LAS float*)(lds + 65536);
    __syncthreads();
    for (int i = tid; i < 65536 / 16; i += 512) ((LAS v4u*)D)[i] = (v4u){0u, 0u, 0u, 0u};
    for (int c = wave; c < NCOND; c += 8) { float mx = 0.f; for (int k = lane; k < DM; k += 64) mx = fmaxf(mx, fabsf(mod[(size_t)c * NMODC + k]));
#pragma unroll
        for (int o = 1; o < 64; o <<= 1) mx = fmaxf(mx, __shfl_xor(mx, o));
        if (lane == 0) red[c] = fmaxf(mx, 1e-30f) * (1.0f / 127.0f); }
    __syncthreads();
    for (int i = tid; i < NCOND * DM; i += 512) { const int c = i >> 11, k = i & 2047; const float s0 = red[c], s1 = s0 * (1.0f / 127.0f), v = mod[(size_t)c * NMODC + k];
        const float d0 = rintf(v / s0), d1 = rintf((v - d0 * s0) / s1); const int off = ((k >> 6) * 16 + c) * 64 + (k & 63);
        D[off] = (unsigned char)(int)d0; D[32768 + off] = (unsigned char)(int)d1; }
    __syncthreads();
    const unsigned char* Bq = ws + WS_W + (size_t)l * W_LAYER + W_WI + (size_t)f * 44 * MiB;
    const float* swv = (const float*)(ws + WS_Q + Q_SW) + (size_t)(2 * l + f) * NFF;
    float* sb = (float*)(ws + WS_SB) + (size_t)l * SB_LAYER + (f ? SB_J2 : 0);
    const int jr = lane & 15, g = lane >> 4;
    for (int rg = sub * 8 + wave; rg < NFF / 16; rg += nsub * 8) {
        const int n = rg * 16 + jr;
        const unsigned char* wp = Bq + ((size_t)(n >> 8) * (DM >> 7) * 256 + (n & 255)) * 128 + 16 * g;
        i32x4_t a0 = {0, 0, 0, 0}, a1 = {0, 0, 0, 0};
#pragma unroll 4
        for (int kb = 0; kb < 32; ++kb) {
            const i32x4_t w = *(const i32x4_t*)(wp + (size_t)(kb >> 1) * 256 * 128 + (kb & 1) * 64);
            const i32x4_t d0 = *(const LAS i32x4_t*)(D + ((kb * 16 + jr) * 64 + 16 * g)), d1 = *(const LAS i32x4_t*)(D + 32768 + ((kb * 16 + jr) * 64 + 16 * g));
            a0 = __builtin_amdgcn_mfma_i32_16x16x64_i8(w, d0, a0, 0, 0, 0); a1 = __builtin_amdgcn_mfma_i32_16x16x64_i8(w, d1, a1, 0, 0, 0);
        }
        if (jr < NCOND) { const float s0 = red[jr], s1 = s0 * (1.0f / 127.0f);
#pragma unroll
            for (int r = 0; r < 4; ++r) { const int nn = rg * 16 + 4 * g + r; sb[(size_t)jr * NFF + nn] = swv[nn] * (s0 * (float)a0[r] + s1 * (float)a1[r]); } }
    }
    __syncthreads();
}
__device__ __forceinline__ void bias_phase(unsigned char* ws, LAS unsigned char* lds, int G, int wg, int tid) {
    const int lane = tid & 63, wave = tid >> 6, gw = wg * 8 + wave, NGW = G * 8;
    LAS float* sh = (LAS float*)lds;
    const float* tab = (const float*)(ws + WS_TAB);
    const int per = G / 4; const bool mf = per >= 1;
    if (mf && wg < 4 * per) bias_ffn_mfma(ws, lds, wg / per, wg % per, per, tid);
    for (int grp = 0; grp < 6; ++grp) {
        const int l = grp / 3, j = grp % 3, N = (j == 1) ? NIN : NFF;
        if (mf && j != 1) continue;
        const bf16* Bt = (const bf16*)(ws + WS_W + (size_t)l * W_LAYER + (j == 0 ? W_WI : j == 1 ? W_WIN : W_WI + 44 * MiB));
        float* sb = (float*)(ws + WS_SB) + (size_t)l * SB_LAYER + (j == 0 ? 0 : j == 1 ? SB_J1 : SB_J2);
        const float* mod = tab + TB_MOD + (size_t)l * NCOND * NMODC + (size_t)(3 * j) * DM;
        __syncthreads();
        for (int i = tid; i < NCOND * DM; i += 512) sh[i] = mod[(size_t)(i >> 11) * NMODC + (i & 2047)];
        __syncthreads();
        if (j != 1) {
            const unsigned char* Bq = (const unsigned char*)Bt; const float* swv = (const float*)(ws + WS_Q + Q_SW) + (size_t)(2 * l + (j >> 1)) * NFF;
            for (int n = gw; n < N; n += NGW) {
                v4u wr2[2];
#pragma unroll
                for (int q = 0; q < 2; ++q) { const int k_ = 16 * (lane + 64 * q); wr2[q] = *(const v4u*)(Bq + ((size_t)((n >> 8) * (DM >> 7) + (k_ >> 7)) * 256 + (n & 255)) * 128 + (k_ & 127)); }
                float wf[2][16];
#pragma unroll
                for (int q = 0; q < 2; ++q) { const unsigned ww[4] = {wr2[q].x, wr2[q].y, wr2[q].z, wr2[q].w};
#pragma unroll
                    for (int e = 0; e < 16; ++e) wf[q][e] = (float)(int)(signed char)((ww[e >> 2] >> (8 * (e & 3))) & 0xffu); }
                const float swn = swv[n];
#pragma unroll 1
                for (int c = 0; c < NCOND; ++c) { float a = 0.f;
#pragma unroll
                    for (int q = 0; q < 2; ++q) { const int k = 16 * (lane + 64 * q);
#pragma unroll
                        for (int e4 = 0; e4 < 4; ++e4) { const f32x4 s0 = *(const LAS f32x4*)(sh + c * DM + k + 4 * e4); a += (s0[0] * wf[q][4 * e4] + s0[1] * wf[q][4 * e4 + 1]) + (s0[2] * wf[q][4 * e4 + 2] + s0[3] * wf[q][4 * e4 + 3]); } }
                    const float t = wave_sum(a); if (lane == 0) sb[(size_t)c * N + n] = t * swn; }
            }
            continue;
        }
        v4u wq[4];
        if (gw < N) {
#pragma unroll
            for (int q = 0; q < 4; ++q) { const int k_ = 8 * (lane + 64 * q); wq[q] = *(const v4u*)(Bt + ((size_t)((gw >> 8) * (DM >> 6) + (k_ >> 6)) * 256 + (gw & 255)) * 64 + (k_ & 63)); } }
        for (int n = gw; n < N; n += NGW) {
            v4u wc_[4];
#pragma unroll
            for (int q = 0; q < 4; ++q) wc_[q] = wq[q];
            if (n + NGW < N) {
#pragma unroll
                for (int q = 0; q < 4; ++q) { const int k_ = 8 * (lane + 64 * q), n_ = n + NGW; wq[q] = *(const v4u*)(Bt + ((size_t)((n_ >> 8) * (DM >> 6) + (k_ >> 6)) * 256 + (n_ & 255)) * 64 + (k_ & 63)); } }
            float wf[4][8];
#pragma unroll
            for (int q = 0; q < 4; ++q) { const v4u w4 = wc_[q];
                wf[q][0] = __uint_as_float(w4.x << 16); wf[q][1] = __uint_as_float(w4.x & 0xffff0000u); wf[q][2] = __uint_as_float(w4.y << 16); wf[q][3] = __uint_as_float(w4.y & 0xffff0000u);
                wf[q][4] = __uint_as_float(w4.z << 16); wf[q][5] = __uint_as_float(w4.z & 0xffff0000u); wf[q][6] = __uint_as_float(w4.w << 16); wf[q][7] = __uint_as_float(w4.w & 0xffff0000u); }
#pragma unroll 1
            for (int c = 0; c < NCOND; ++c) { float a = 0.f;
#pragma unroll
                for (int q = 0; q < 4; ++q) { const int k = 8 * (lane + 64 * q); const f32x4 s0 = *(const LAS f32x4*)(sh + c * DM + k), s1 = *(const LAS f32x4*)(sh + c * DM + k + 4);
                    a += (s0[0] * wf[q][0] + s0[1] * wf[q][1]) + (s0[2] * wf[q][2] + s0[3] * wf[q][3]) + (s1[0] * wf[q][4] + s1[1] * wf[q][5]) + (s1[2] * wf[q][6] + s1[3] * wf[q][7]); }
                const float t = wave_sum(a); if (lane == 0) sb[(size_t)c * N + n] = t; }
        }
    }
    __syncthreads();
}
__device__ __forceinline__ void final_norm(float* x, const float* fw, int G, int wg, int tid) {
    const int lane = tid & 63, wave = tid >> 6, gw = wg * 8 + wave, NGW = G * 8;
    for (int m = gw; m < MTOK; m += NGW) {
        float* xr = x + (size_t)m * DM; f32x4 v[8]; float ss = 0.f;
#pragma unroll
        for (int j = 0; j < 8; ++j) { v[j] = *(const f32x4*)(xr + 256 * j + 4 * lane); ss += (v[j][0] * v[j][0] + v[j][1] * v[j][1]) + (v[j][2] * v[j][2] + v[j][3] * v[j][3]); }
        const float rstd = rsqrtf(wave_sum(ss) * (1.0f / DM) + EPS);
#pragma unroll
        for (int j = 0; j < 8; ++j) { const int c = 256 * j + 4 * lane; *(f32x4*)(xr + c) = (v[j] * rstd) * *(const f32x4*)(fw + c); }
    }
}
__device__ __forceinline__ void prep_row(int m, int l, bf16* PROJ, bf16* DST, const float* tab, const float* qkw  , float* out, int lane) {
    bf16* pr = PROJ + (size_t)m * NIN; bf16* pw = DST + (size_t)m * NIN;
    const bool lat = m >= M_P; const int t = lat ? ((m - M_P) & 4095) : (m & 255), b = lat ? ((m - M_P) >> 12) : (m >> 8);
    const int rr = t >> 6, cc = t & 63;
    unsigned rg[10], rd[8], rv2[2], rv4[4];
#pragma unroll
    for (int v = 0; v < 10; ++v) rg[v] = *(const unsigned*)(pr + (v < 8 ? C_GQ + 128 * v : C_GK + 128 * (v - 8)) + 2 * lane);
#pragma unroll
    for (int v = 0; v < 8; ++v) rd[v] = *(const unsigned*)(pr + (v < 4 ? C_DQ + 128 * v : C_DK + 128 * (v - 4)) + 2 * lane);
    if (!lat) {
#pragma unroll
        for (int v = 0; v < 2; ++v) rv2[v] = *(const unsigned*)(pr + C_GV + 128 * v + 2 * lane);
#pragma unroll
        for (int v = 0; v < 4; ++v) rv4[v] = *(const unsigned*)(pr + C_DV + 128 * v + 2 * lane);
    }
    const float wq0 = qkw[2 * lane], wq1 = qkw[2 * lane + 1], wk0 = qkw[128 + 2 * lane], wk1 = qkw[128 + 2 * lane + 1];
    float cs = 1.f, sn = 0.f, c2 = 1.f, s2 = 0.f;
    if (lat) { const int idx = lane < 32 ? rr * 32 + lane : cc * 32 + (lane - 32); cs = tab[TB_COSG + idx]; sn = tab[TB_SING + idx];
               const int p = lane & 31, id2 = p < 16 ? rr * 16 + p : cc * 16 + (p - 16); c2 = tab[TB_COSD + id2]; s2 = tab[TB_SIND + id2]; }
#pragma unroll
    for (int v = 0; v < 10; ++v) {
        const int col = (v < 8 ? C_GQ + 128 * v : C_GK + 128 * (v - 8)) + 2 * lane;
        const float x1 = bf2f((unsigned short)(rg[v] & 0xffffu)), x2 = bf2f((unsigned short)(rg[v] >> 16));
        const float rs = rsqrtf(wave_sum(x1 * x1 + x2 * x2) * (1.0f / 128.0f) + EPS);
        const float y1 = x1 * rs * (v < 8 ? wq0 : wk0), y2 = x2 * rs * (v < 8 ? wq1 : wk1);
        if (!lat && v >= 8) { float* o = out + O_GK + (((size_t)(b * 2 + l) * 256 + t) * 2 + (v - 8)) * 128 + 2 * lane; o[0] = y1; o[1] = y2; }
        const float qs = v < 8 ? 0.12751743f : 1.0f;
        *(unsigned*)(pw + col) = pkbf((y1 * cs - y2 * sn) * qs, (y1 * sn + y2 * cs) * qs);
    }
    if (lat) {
#pragma unroll
        for (int v = 0; v < 8; ++v) { const int col = (v < 4 ? C_DQ + 128 * v : C_DK + 128 * (v - 4)) + 2 * lane;
            const float x1 = bf2f((unsigned short)(rd[v] & 0xffffu)), x2 = bf2f((unsigned short)(rd[v] >> 16));
            *(unsigned*)(pw + col) = pkbf(x1 * c2 - x2 * s2, x1 * s2 + x2 * c2); }
    } else {
#pragma unroll
        for (int v = 0; v < 2; ++v) { float* o = out + O_GV + (((size_t)(b * 2 + l) * 256 + t) * 2 + v) * 128 + 2 * lane; o[0] = bf2f((unsigned short)(rv2[v] & 0xffffu)); o[1] = bf2f((unsigned short)(rv2[v] >> 16)); }
#pragma unroll
        for (int v = 0; v < 4; ++v) { const unsigned rk = rd[4 + v], rv = rv4[v];
            const size_t oi = (((size_t)(b * 2 + l) * 256 + t) * 4 + v) * 128 + 2 * lane;
            out[O_DK + oi] = bf2f((unsigned short)(rk & 0xffffu)); out[O_DK + oi + 1] = bf2f((unsigned short)(rk >> 16));
            out[O_DV + oi] = bf2f((unsigned short)(rv & 0xffffu)); out[O_DV + oi + 1] = bf2f((unsigned short)(rv >> 16)); }
    }
}
#ifndef EN_PRO
#define EN_PRO 1
#endif
#ifndef EN_NORM
#define EN_NORM 1
#endif
#ifndef EN_FFNIN
#define EN_FFNIN 1
#endif
#ifndef EN_FFNOUT
#define EN_FFNOUT 1
#endif
#ifndef EN_WIN
#define EN_WIN 1
#endif
#ifndef EN_P
#define EN_P 1
#endif
#ifndef EN_A
#define EN_A 1
#endif
#ifndef EN_A1
#define EN_A1 1
#endif
#ifndef EN_A2
#define EN_A2 1
#endif
#ifndef EN_A3
#define EN_A3 1
#endif
#ifndef EN_WOUT
#define EN_WOUT 1
#endif
#ifndef EN_FIN
#define EN_FIN 1
#endif
struct Args { const float* in[22]; float* out; unsigned char* ws; int ph_lo, ph_hi, pad0, pad1; };
constexpr int NPHASE = 30;
#define LAUNDER(p) asm volatile("" : "+s"(p))
struct InPtrs { const float* const* p; __device__ __forceinline__ const float* operator[](int i) const { return p[i]; } };
__device__ __forceinline__ int deal_unit(int i, int NL, int NC, int off, int G, int wg) {
    if (NL % G == 0) { const int nr = NL / G; if (i < nr) return i * G + wg; if (i > nr) return -1; const int c = (wg + G - off) % G; return c < NC ? NL + c : -1; }
    const int v = i * G + wg; return v < NL + NC ? v : -1;
}
__global__ void __launch_bounds__(512, 2) fwd_kernel(Args args) {
    extern __shared__ __attribute__((aligned(16))) unsigned char lds_raw[];
    LAS unsigned char* lds = (LAS unsigned char*)lds_raw;
    volatile LAS unsigned* MISC = (volatile LAS unsigned*)(lds + MISC_OFF);
    const int G = gridDim.x, wg = blockIdx.x;
    for (int u = threadIdx.x; u < (LDS_BYTES - 131072) / 4; u += 512) ((LAS unsigned*)(lds + 131072))[u] = 0u;
    __syncthreads();
    XcdBarrier bar = xcd_barrier_post((unsigned*)(args.ws + WS_CTL) + CW_BAR, MISC + 8);
    const int lo = args.ph_lo, hi = args.ph_hi;
#define IN(k) (lo <= (k) && (k) < hi)
#define SEAM(k) do { if (IN(k) && IN((k) + 1)) xcd_barrier(bar); } while (0)
#define PH_BEGIN size_t zoff_ = 0; asm volatile("" : "+s"(zoff_)); unsigned char* ws = args.ws + zoff_; float* out = args.out + zoff_;   \
    const InPtrs inp{args.in}; int tid = threadIdx.x; asm volatile("" : "+v"(tid)); \
    const int lane = tid & 63, wave = __builtin_amdgcn_readfirstlane(tid >> 6); (void)lane; (void)wave;

    if (IN(0)) { PH_BEGIN; (void)out; prologue(inp, ws, lds, G, wg, tid); }
    SEAM(0);
    if (IN(1)) { PH_BEGIN; (void)out; prologue_b(inp, ws, lds, G, wg, tid); }
    SEAM(1);
    if (IN(2)) { PH_BEGIN; (void)out;
        quant_phase(inp[0], inp[1] - (size_t)M_P * DM, inp[11], (const float*)(ws + WS_TAB) + TB_MOD + DM, ws + WS_XNB, (float*)(ws + WS_Q), (unsigned long long*)(ws + WS_RS), G, wg, tid);
        bias_phase(ws, lds, G, wg, tid); }
    SEAM(2);
#pragma unroll 1
    for (int l = 0; l < 2; ++l) {
        const int pb = 3 + 13 * l;
#pragma unroll 1
        for (int f = 0; f < 2; ++f) {
            const int fb = pb + 9 * f;
            if (IN(fb + 0)) { PH_BEGIN; (void)out; (void)inp; const bf16* WL = (const bf16*)(ws + WS_W + (size_t)l * W_LAYER);
                pg8::Gemm g{(const bf16*)(ws + WS_XNB), WL + (W_WI + (size_t)f * 44 * MiB) / 2, MTOK, NFF, DM / 2}; pg8::StaticOrder S; S.init(MTOK, NFF, G, wg);
                pg8::EpiSwiGLUQ E{ws + WS_A8B, DFF, (const unsigned long long*)(ws + WS_RS) + (size_t)(3 * l + 2 * f) * MTOK, (const float*)(ws + WS_Q), (const float*)(ws + WS_Q + Q_SW) + (size_t)(2 * l + f) * NFF,
                                  (const float*)(ws + WS_SB) + (size_t)l * SB_LAYER + (f ? SB_J2 : 0), NFF, (const float*)(ws + WS_Q + Q_ACT) + 2 * (2 * l + f)};
                pg8::gemm_phase<pg8::EpiSwiGLUQ, pg8::StaticOrder, true, true, true>(lds, g, S, E); }
            if (IN(fb + 0) && IN(fb + 2)) xcd_barrier(bar);
            if (IN(fb + 2)) { PH_BEGIN; float* X = out + O_X; const bool first = (l == 0 && f == 0); const unsigned char* WL8 = ws + WS_W + (size_t)l * W_LAYER + W_WO + (size_t)f * 22 * MiB;
                const float* tabf = (const float*)(ws + WS_TAB); const float* mod = tabf + TB_MOD + (size_t)l * NCOND * NMODC;
                pg8::Gemm g{(const bf16*)(ws + WS_A8B), (const bf16*)WL8, MTOK, DM, DFF / 2}; pg8::StaticOrder S; S.init(MTOK, DM, G, wg);
                const int ni = f ? 3 * (l + 1) : 3 * l + 1;
                const size_t rs_off = WS_RS + (size_t)ni * MTOK * 8;
                pg8::EpiResidN E{first ? inp[0] : X, first ? inp[1] - (size_t)M_P * DM : X, X, mod + (2 + 6 * f) * DM,
                                 inp[11] + (size_t)(f ? 3 : 3 * l + 1) * DM, f ? tabf + TB_MOD + (size_t)NCOND * NMODC + DM : mod + (size_t)4 * DM, (unsigned long long*)(ws + rs_off), (long)(f ? WS_ACT : WS_XN) - (long)rs_off, 0.5f, (f && l) ? 0 : 1,
                                 (long)(WS_Q + Q_ACT + (size_t)(2 * (2 * l + f) + 1) * 4) - (long)rs_off, (long)(WS_Q + Q_SW2 + (size_t)(2 * l + f) * DM * 4) - (long)rs_off, 2, 1, (long)(WS_CTL + CTL_AMAX + (size_t)ni * MTOK * 4) - (long)rs_off};
                pg8::gemm_phase<pg8::EpiResidN, pg8::StaticOrder, true, true, 2>(lds, g, S, E); }
            SEAM(fb + 2);
            if (f == 1) {
                if (l == 0 && IN(pb + 12)) { PH_BEGIN; float* X = out + O_X;
                    (void)X; quant_xs_phase((const bf16*)(ws + WS_ACT), (const unsigned*)(ws + WS_CTL + CTL_AMAX) + (size_t)3 * MTOK, (const unsigned long long*)(ws + WS_RS) + (size_t)3 * MTOK, ws + WS_XNB, (float*)(ws + WS_Q), G, wg, tid); }
                SEAM(pb + 12);
                break; }
            if (IN(pb + 3)) { PH_BEGIN; float* X = out + O_X;
                (void)X; quant_xs_phase((const bf16*)(ws + WS_XN), (const unsigned*)(ws + WS_CTL + CTL_AMAX) + (size_t)(3 * l + 1) * MTOK, (const unsigned long long*)(ws + WS_RS) + (size_t)(3 * l + 1) * MTOK, ws + WS_XNB, (float*)(ws + WS_Q), G, wg, tid, M_P); }
            SEAM(pb + 3);
            if (IN(pb + 4)) {
                { PH_BEGIN; (void)out; (void)inp;
                  pg8::Gemm g{(const bf16*)(ws + WS_XNB + (size_t)M_P * DM), (const bf16*)(ws + WS_W + (size_t)l * W_LAYER + W_WINQ), M_S, NIN, DM / 2}; pg8::StaticOrder S; S.init(M_S, NIN, G, wg);
                  pg8::EpiStoreQ E{(bf16*)(ws + WS_ACT) + (size_t)M_P * NIN, NIN, (const unsigned long long*)(ws + WS_RS) + (size_t)(3 * l + 1) * MTOK + M_P, (const float*)(ws + WS_Q) + M_P,
                                   (const float*)(ws + WS_Q + Q_SW4) + (size_t)l * NIN, (const float*)(ws + WS_SB) + (size_t)l * SB_LAYER + SB_J1, NIN, 16};
                  pg8::gemm_phase<pg8::EpiStoreQ, pg8::StaticOrder, true, true, true>(lds, g, S, E); }
                { PH_BEGIN; (void)out; (void)inp; const bf16* WL = (const bf16*)(ws + WS_W + (size_t)l * W_LAYER);
                  pg8::Gemm g{(const bf16*)(ws + WS_XN), WL + W_WIN / 2, M_P, NIN, DM}; pg8::StaticOrder S; S.init(M_P, NIN, G, wg);
                  pg8::EpiStoreBf16N E{(bf16*)(ws + WS_ACT), NIN, (const unsigned long long*)(ws + WS_RS) + (size_t)(3 * l + 1) * MTOK, (const float*)(ws + WS_SB) + (size_t)l * SB_LAYER + SB_J1, NIN};
                  pg8::gemm_phase<pg8::EpiStoreBf16N, pg8::StaticOrder, true, true>(lds, g, S, E); }
            }
            SEAM(pb + 4);
            if (IN(pb + 5)) { PH_BEGIN; bf16* PROJ = (bf16*)(ws + WS_ACT); const float* tab = (const float*)(ws + WS_TAB);
#pragma unroll 1
                for (int ch = wg; ch < 192; ch += G) {
                    const bool lat = ch < 64; const int cc = lat ? ch : ch - 64, dir = cc & 1, h = (cc >> 1) & 3, b = cc >> 3;
                    att::ChainArgs a; a.P = PROJ + (size_t)(lat ? M_P + b * 4096 : b * 256) * NIN; a.kcol = C_RK + 128 * h; a.vcol = C_RV + 128 * h; a.nchunk = lat ? 32 : 2; a.dir = dir;
                    a.lg2 = tab[TB_SCAL + 16 * l + 2 + dir * 4 + h];
                    a.S0 = lat ? inp[3] + ((((size_t)b * 2 + l) * 2 + dir) * 4 + h) * 16384 : nullptr;
                    a.ST = (bf16*)(ws + WS_ST) + (lat ? (size_t)cc * 32 * 16384 : (size_t)64 * 32 * 16384 + (size_t)cc * 2 * 16384);
                    a.Sfin = lat ? nullptr : out + O_STATE + ((((size_t)b * 2 + l) * 2 + dir) * 4 + h) * 16384;
                    __syncthreads(); att::ret_chain(a, (char*)lds_raw);
                }
                const int w0 = G > 128 ? 64 : 0, gw = (wg - w0) * 8 + wave, NGW = (G - w0) * 8;
                if (wg >= w0) for (int m = gw; m < MTOK; m += NGW) prep_row(m, l, PROJ, PROJ, tab, inp[18] + l * 256, out, lane);
            }
            SEAM(pb + 5);
            if (IN(pb + 6)) { PH_BEGIN; (void)out; bf16* PROJ = (bf16*)(ws + WS_ACT); bf16* MIX = (bf16*)(ws + WS_XN); const float* tab = (const float*)(ws + WS_TAB);
                const bf16* CGK = (const bf16*)(ws + WS_CACHE);
#pragma unroll 1
                for (int rp = 0; rp < ((PROBE == 13 && l == 0) ? 2 : 1); ++rp)
#pragma unroll 1
                for (int i2 = 0;; ++i2) { const int ps = i2 & 1; const int u = deal_unit(i2 >> 1, 512, 64, 192, G, wg); if (u < 0) break;
                    const bool lat = u < 512; const int v = lat ? u : u - 512;
                    const int qb = lat ? (v & 15) : 0, h = lat ? ((v >> 4) & 3) : (v & 3), b = lat ? (v >> 6) : (v >> 2);
                    const size_t row0 = lat ? (size_t)M_P + (size_t)b * 4096 : (size_t)b * 256;
                    const float lam = tab[TB_SCAL + 16 * l + 0], post = tab[TB_SCAL + 16 * l + 1];
                    {
                        att::KVSrc kv; kv.K1 = PROJ + row0 * NIN + C_DK + 128 * h + 64 * ps; kv.V1 = PROJ + row0 * NIN + C_DV + 128 * h; kv.n1 = lat ? 4096 : 256;
                        kv.K2 = CGK + 2097152 + ((size_t)(b * 2 + l) * 256) * 512 + 128 * h + 64 * ps; kv.V2 = CGK + 4194304 + ((size_t)(b * 2 + l) * 256) * 512 + 128 * h; kv.n2 = lat ? 256 : 0;
                        att::AttnOut ao; ao.Ob = MIX + (row0 + 256 * qb) * DM + 1536 + 128 * h; ao.Of = (float*)(ws + WS_DF) + (row0 + 256 * qb) * 512 + 128 * h;
                        ao.nw = inp[20] + l * 512 + 128 * h; ao.lam = lam; ao.post = post; ao.pass = ps;
                        __syncthreads();
                        att::attn_body<64, 1, 512>(PROJ + (row0 + 256 * qb) * NIN + C_DQ + 128 * h + 64 * ps, kv, ao, (char*)lds_raw);
                    }
                }
                const bool nomax = tab[TB_SCAL + 16 * l + 10] != 0.f;
#pragma unroll 1
                for (int rp = 0; rp < ((PROBE == 14 && l == 0) ? 2 : 1); ++rp)
#pragma unroll 1
                for (int i = 0;; ++i) { const int u = deal_unit(i, 1024, 128, 64, G, wg); if (u < 0) break;
                    const bool lat = u < 1024; const int v = lat ? u : u - 1024;
                    const int qb = lat ? (v & 15) : 0, hq = lat ? ((v >> 4) & 7) : (v & 7), b = lat ? (v >> 7) : (v >> 3), kvh = hq >> 2;
                    const size_t row0 = lat ? (size_t)M_P + (size_t)b * 4096 : (size_t)b * 256;
                    att::KVSrc kv; kv.K1 = PROJ + row0 * NIN + C_GK + 128 * kvh; kv.V1 = PROJ + row0 * NIN + C_GV + 128 * kvh; kv.n1 = lat ? 4096 : 256;
                    kv.K2 = CGK + ((size_t)(b * 2 + l) * 256) * 256 + 128 * kvh; kv.V2 = CGK + 1048576 + ((size_t)(b * 2 + l) * 256) * 256 + 128 * kvh; kv.n2 = lat ? 256 : 0;
                    att::AttnOut ao; ao.Ob = MIX + (row0 + 256 * qb) * DM + 512 + 128 * hq; ao.Of = nullptr; ao.nw = nullptr; ao.lam = 0.f; ao.post = 0.f; ao.pass = 0;
                    __syncthreads();
                    if (nomax) att::attn_body<128, 0, 256, 1>(PROJ + (row0 + 256 * qb) * NIN + C_GQ + 128 * hq, kv, ao, (char*)lds_raw);
                    else att::attn_body<128, 0, 256, 2>(PROJ + (row0 + 256 * qb) * NIN + C_GQ + 128 * hq, kv, ao, (char*)lds_raw);
                }
#pragma unroll 1
                for (int rp = 0; rp < ((PROBE == 15 && l == 0) ? 2 : 1); ++rp)
#pragma unroll 1
                for (int i = 0;; ++i) { const int u = deal_unit(i, 512, 64, 0, G, wg); if (u < 0) break;
                    const bool lat = u < 512; const int v = lat ? u : u - 512;
                    const int pr = lat ? (v & 15) : 0, h = lat ? ((v >> 4) & 3) : (v & 3), b = lat ? (v >> 6) : (v >> 2);
                    const size_t row0 = (lat ? (size_t)M_P + (size_t)b * 4096 : (size_t)b * 256) + 256 * pr;
                    att::RetCArgs a; a.P = PROJ + row0 * NIN; a.qcol = C_RQ + 128 * h; a.kcol = C_RK + 128 * h; a.vcol = C_RV + 128 * h; a.gcol = C_RG + 128 * h;
                    a.lg2f = tab[TB_SCAL + 16 * l + 2 + h]; a.lg2b = tab[TB_SCAL + 16 * l + 6 + h];
                    const int cf = (b * 4 + h) * 2; const bf16* STB = (const bf16*)(ws + WS_ST);
                    a.STf = STB + (lat ? (size_t)cf * 32 * 16384 : (size_t)64 * 32 * 16384 + (size_t)cf * 2 * 16384) + (size_t)(2 * pr) * 16384;
                    a.STb = STB + (lat ? (size_t)(cf + 1) * 32 * 16384 : (size_t)64 * 32 * 16384 + (size_t)(cf + 1) * 2 * 16384) + (size_t)(2 * pr) * 16384;
                    a.gnw = inp[17] + l * 512 + 128 * h; a.O = MIX + row0 * DM + 128 * h;
                    __syncthreads();
                    att::ret_c(a, (char*)lds_raw);
                }
            }
            SEAM(pb + 6);
            if (IN(pb + 7)) { PH_BEGIN; float* X = out + O_X; const bf16* WL = (const bf16*)(ws + WS_W + (size_t)l * W_LAYER);
                const float* mod = (const float*)(ws + WS_TAB) + TB_MOD + (size_t)l * NCOND * NMODC;
                pg8::Gemm g{(const bf16*)(ws + WS_XN), WL + W_WOUT / 2, MTOK, DM, DM}; pg8::StaticOrder S; S.init(MTOK, DM, G, wg);
                const size_t rs_off = WS_RS + (size_t)(3 * l + 2) * MTOK * 8;
                pg8::EpiResidN E{X, X, X, mod + 5 * DM, inp[11] + ((size_t)l * 3 + 2) * DM, mod + 7 * DM, (unsigned long long*)(ws + rs_off), (long)WS_ACT - (long)rs_off, 1.0f, 1, (long)WS_Q - (long)rs_off, (long)WS_Q - (long)rs_off, 0, 1, (long)(WS_CTL + CTL_AMAX + (size_t)(3 * l + 2) * MTOK * 4) - (long)rs_off};
                pg8::gemm_phase<pg8::EpiResidN, pg8::StaticOrder, true, true>(lds, g, S, E); }
            SEAM(pb + 7);
            if (IN(pb + 8)) { PH_BEGIN; float* X = out + O_X;
                (void)X; quant_xs_phase((const bf16*)(ws + WS_ACT), (const unsigned*)(ws + WS_CTL + CTL_AMAX) + (size_t)(3 * l + 2) * MTOK, (const unsigned long long*)(ws + WS_RS) + (size_t)(3 * l + 2) * MTOK, ws + WS_XNB, (float*)(ws + WS_Q), G, wg, tid); }
            SEAM(pb + 8);
        }
    }
    if (IN(29)) { PH_BEGIN; (void)ws; final_norm(out + O_X, inp[21], G, wg, tid); }
#undef IN
#undef SEAM
#undef PH_BEGIN
}

extern "C" void kernel_launch(void* const* d_in, const int* in_sizes, int n_in, void* d_out, int out_size, void* d_ws, size_t ws_size, hipStream_t stream) {
    static int grid = 0;
    if (grid == 0) {
        if (n_in != 22 || out_size != (int)O_END || ws_size < WS_END) { fprintf(stderr, "kernel_launch: unexpected shapes: n_in %d out %d ws %zu (need %zu)\n", n_in, out_size, ws_size, (size_t)WS_END); grid = -1; return; }
        int dev = 0, cus = 0, per_cu = 0;
        if (hipGetDevice(&dev) != hipSuccess || hipDeviceGetAttribute(&cus, hipDeviceAttributeMultiprocessorCount, dev) != hipSuccess) { grid = -1; return; }
        if (hipFuncSetAttribute((const void*)fwd_kernel, hipFuncAttributeMaxDynamicSharedMemorySize, LDS_BYTES) != hipSuccess) { fprintf(stderr, "kernel_launch: hipFuncSetAttribute failed\n"); grid = -1; return; }
        if (hipOccupancyMaxActiveBlocksPerMultiprocessor(&per_cu, (const void*)fwd_kernel, 512, LDS_BYTES) != hipSuccess || per_cu < 1) { fprintf(stderr, "kernel_launch: occupancy query says %d\n", per_cu); }
        (void)hipGetLastError();
        grid = cus;
    }
    if (grid < 0) return;
    (void)hipMemsetAsync((char*)d_ws + WS_CTL, 0, CTL_ZERO_BYTES, stream);
    (void)hipMemsetAsync((char*)d_ws + WS_RS, 0, 2 * MiB, stream);
    Args a{};
    for (int i = 0; i < 22; ++i) a.in[i] = (const float*)d_in[i];
    a.out = (float*)d_out; a.ws = (unsigned char*)d_ws; a.ph_lo = 0; a.ph_hi = NPHASE; a.pad0 = 0; a.pad1 = 0;
    hipLaunchKernelGGL(fwd_kernel, dim3(grid), dim3(512), LDS_BYTES, stream, a);
}
```
